# Optimizing an MI355X kernel written in HIP

```python
import jax
import jax.numpy as jnp
from jax import lax
import numpy as np

D_MODEL = 1024
BATCH = 8
SEQ = 4096
DEPTH = 2

MEM_LEN = 256
EPS = 1e-6
N_EVEN = (DEPTH + 1) // 2
N_ODD = DEPTH // 2

HEAD_DIM = 64
SWA_Q_HEADS = (D_MODEL // 2) // HEAD_DIM
SWA_KV_HEADS = SWA_Q_HEADS // 4
WINDOW = 128
SWA_Q_COLS = SWA_Q_HEADS * HEAD_DIM
SWA_KV_COLS = SWA_KV_HEADS * HEAD_DIM
SWA_COLS = SWA_Q_COLS + 2 * SWA_KV_COLS

RWKV_HEADS = (D_MODEL // 2) // HEAD_DIM
RWKV_WIDTH = RWKV_HEADS * HEAD_DIM
RWKV_DECAY_RANK = 64
RWKV_A_RANK = 64
RWKV_GATE_RANK = 128
RWKV_COLS = 3 * RWKV_WIDTH + RWKV_DECAY_RANK + RWKV_A_RANK + RWKV_GATE_RANK
RWKV_LN_EPS = 64e-5
EVEN_IN_COLS = SWA_COLS + RWKV_COLS
EVEN_MIX_WIDTH = SWA_Q_COLS + RWKV_WIDTH

GLA_HEADS = 4
GLA_KEY_WIDTH = D_MODEL // 2
GLA_VAL_WIDTH = D_MODEL
GLA_DK = GLA_KEY_WIDTH // GLA_HEADS
GLA_DV = GLA_VAL_WIDTH // GLA_HEADS
GLA_GATE_RANK = 16
GLA_GATE_NORM = 16.0
GLA_CHUNK = 64
ODD_IN_COLS = 2 * GLA_KEY_WIDTH + 2 * GLA_VAL_WIDTH + GLA_GATE_RANK

XA_HEADS = 4
XA_HEAD_DIM = 128
XA_WIDTH = XA_HEADS * XA_HEAD_DIM

MOE_GROUPS = 4
MOE_EXPERTS_PER_GROUP = 8
MOE_EXPERTS = MOE_GROUPS * MOE_EXPERTS_PER_GROUP
MOE_TOPK = 2
MOE_FF = 512
MOE_BLOCK = 128

kernel_name = 'hybrid_swa_rwkv7_gla_hmoe_trunk'


def rmsnorm(x, g, eps=EPS):
    xf = x.astype(jnp.float32)
    y = xf * lax.rsqrt(jnp.mean(xf * xf, axis=-1, keepdims=True) + eps)
    return (y * g.astype(jnp.float32)).astype(x.dtype)


def swa_with_sinks(q, k, v, sinks):
    B, S, HQ, Dh = q.shape
    HKV = k.shape[2]
    G = HQ // HKV
    W = WINDOW
    nb = S // W
    qb = q.astype(jnp.float32).reshape(B, nb, W, HKV, G, Dh)

    def band(t):
        tp = jnp.pad(t.astype(jnp.float32), ((0, 0), (W, 0), (0, 0), (0, 0))).reshape(B, nb + 1, W, HKV, Dh)
        return jnp.concatenate([tp[:, :-1], tp[:, 1:]], axis=2)

    kb, vb = band(k), band(v)
    s = jnp.einsum('bnqhgd,bnkhd->bnhgqk', qb, kb) * (Dh ** -0.5)
    qpos = jnp.arange(W)[:, None] + W
    kpos = jnp.arange(2 * W)[None, :]
    rel = qpos - kpos
    gkey = jnp.arange(nb)[:, None, None] * W + kpos[None] - W
    valid = (rel >= 0)[None] & (rel < W)[None] & (gkey >= 0)
    s = jnp.where(valid[None, :, None, None], s, -jnp.inf)
    sink = sinks.astype(jnp.float32).reshape(1, 1, HKV, G, 1, 1)
    m = jnp.maximum(jnp.max(s, axis=-1, keepdims=True), sink)
    pr = jnp.exp(s - m)
    den = jnp.sum(pr, axis=-1, keepdims=True) + jnp.exp(sink - m)
    o = jnp.einsum('bnhgqk,bnkhd->bnqhgd', pr / den, vb)
    return o.reshape(B, S, HQ * Dh)


def rwkv7_scan(r, decay, k, v, a_vec, b_vec):
    B, S, H, N = r.shape

    def step(state, inp):
        r_t, w_t, k_t, v_t, a_t, b_t = inp
        sa = jnp.einsum('bhvk,bhk->bhv', state, a_t)
        state = state * w_t[:, :, None, :] + sa[..., None] * b_t[:, :, None, :] + v_t[..., None] * k_t[:, :, None, :]
        y = jnp.einsum('bhvk,bhk->bhv', state, r_t)
        return state, y

    xs = tuple(jnp.moveaxis(t, 1, 0) for t in (r, decay, k, v, a_vec, b_vec))
    _, ys = lax.scan(step, jnp.zeros((B, H, N, N), jnp.float32), xs)
    return jnp.moveaxis(ys, 0, 1)


def rwkv7_time_mix(p, mu, w0, w2, a0, a2, g2, k_k, k_a, r_k, lnx_w, lnx_b):
    B, S, _ = p.shape
    C = RWKV_WIDTH
    p = p.astype(jnp.float32)
    p_prev = jnp.pad(p, ((0, 0), (1, 0), (0, 0)))[:, :-1]
    p = p + (p_prev - p) * mu
    r = p[..., :C]
    k = p[..., C:2 * C]
    v = p[..., 2 * C:3 * C]
    o = 3 * C
    xw = p[..., o:o + RWKV_DECAY_RANK]
    o += RWKV_DECAY_RANK
    xa = p[..., o:o + RWKV_A_RANK]
    o += RWKV_A_RANK
    xg = p[..., o:]
    w = -jax.nn.softplus(-(w0 + jnp.tanh(xw) @ w2)) - 0.5
    decay = jnp.exp(-jnp.exp(w))
    a = jax.nn.sigmoid(a0 + xa @ a2)
    g = jax.nn.sigmoid(xg) @ g2
    kk = (k * k_k).reshape(B, S, RWKV_HEADS, HEAD_DIM)
    kk = kk / jnp.maximum(jnp.sqrt(jnp.sum(kk * kk, axis=-1, keepdims=True)), 1e-12)
    k = k * (1.0 + (a - 1.0) * k_a)

    def heads(t):
        return t.reshape(B, S, RWKV_HEADS, HEAD_DIM)

    r, k, v, decay, a = heads(r), heads(k), heads(v), heads(decay), heads(a)
    y = rwkv7_scan(r, decay, k, v, -kk, kk * a)
    mean = jnp.mean(y, axis=-1, keepdims=True)
    var = jnp.mean(jnp.square(y - mean), axis=-1, keepdims=True)
    y = ((y - mean) * lax.rsqrt(var + RWKV_LN_EPS)).reshape(B, S, C) * lnx_w + lnx_b
    bonus = jnp.sum(r * k * r_k, axis=-1, keepdims=True) * v
    y = y + bonus.reshape(B, S, C)
    return y * g


def even_mixer(h, w_in, sinks, mu, w0, w2, a0, a2, g2, k_k, k_a, r_k, lnx_w, lnx_b, w_out):
    B, S, _ = h.shape
    p = h @ w_in
    q = p[..., :SWA_Q_COLS].reshape(B, S, SWA_Q_HEADS, HEAD_DIM)
    k = p[..., SWA_Q_COLS:SWA_Q_COLS + SWA_KV_COLS].reshape(B, S, SWA_KV_HEADS, HEAD_DIM)
    v = p[..., SWA_Q_COLS + SWA_KV_COLS:SWA_COLS].reshape(B, S, SWA_KV_HEADS, HEAD_DIM)
    o_a = swa_with_sinks(q, k, v, sinks).astype(h.dtype)
    o_b = rwkv7_time_mix(p[..., SWA_COLS:], mu, w0, w2, a0, a2, g2, k_k, k_a, r_k, lnx_w, lnx_b).astype(h.dtype)
    return jnp.concatenate([o_a, o_b], axis=-1) @ w_out


def gla_chunked(q, k, v, gk):
    B, S, _ = q.shape
    H, C = GLA_HEADS, GLA_CHUNK
    nc = S // C

    def chunks(t, d):
        return t.reshape(B, nc, C, H, d).transpose(1, 0, 3, 2, 4)

    qc, kc, gc = chunks(q, GLA_DK), chunks(k, GLA_DK), chunks(gk, GLA_DK)
    vc = chunks(v, GLA_DV)
    causal = jnp.tril(jnp.ones((C, C), dtype=bool))

    def step(state, inp):
        qi, ki, vi, gi = inp
        b = jnp.cumsum(gi, axis=2)
        o_inter = jnp.einsum('bhcd,bhde->bhce', qi * jnp.exp(b), state)
        diff = b[:, :, :, None, :] - b[:, :, None, :, :]
        diff = jnp.where(causal[:, :, None], diff, -jnp.inf)
        att = jnp.einsum('bhid,bhjd,bhijd->bhij', qi, ki, jnp.exp(diff))
        o_intra = jnp.einsum('bhij,bhje->bhie', att, vi)
        b_last = b[:, :, -1:, :]
        state = state * jnp.exp(b_last)[:, :, 0, :, None] + jnp.einsum('bhcd,bhce->bhde', ki * jnp.exp(b_last - b), vi)
        return state, o_inter + o_intra

    _, oc = lax.scan(step, jnp.zeros((B, H, GLA_DK, GLA_DV), jnp.float32), (qc, kc, vc, gc))
    return oc.transpose(1, 0, 3, 2, 4).reshape(B, S, H, GLA_DV)


def odd_mixer(h, w_in, gate_up, gate_b, onorm, w_out):
    B, S, _ = h.shape
    KW, VW, R = GLA_KEY_WIDTH, GLA_VAL_WIDTH, GLA_GATE_RANK
    p = h @ w_in
    q = p[..., :KW].astype(jnp.float32) * (GLA_DK ** -0.5)
    k = p[..., KW:2 * KW].astype(jnp.float32)
    v = p[..., 2 * KW:2 * KW + VW].astype(jnp.float32)
    gd = p[..., 2 * KW + VW:2 * KW + VW + R]
    og = p[..., 2 * KW + VW + R:].astype(jnp.float32)
    gk = jax.nn.log_sigmoid((gd @ gate_up + gate_b).astype(jnp.float32)) / GLA_GATE_NORM
    o = gla_chunked(q, k, v, gk)
    o = rmsnorm(o, onorm).reshape(B, S, VW) * jax.nn.silu(og)
    return o.astype(h.dtype) @ w_out


def memory_kv(mem, mem_norm, wk, wv):
    B, M, _ = mem.shape
    m = rmsnorm(mem, mem_norm)
    mk = (m @ wk).reshape(B, M, XA_HEADS, XA_HEAD_DIM)
    mv = (m @ wv).reshape(B, M, XA_HEADS, XA_HEAD_DIM)
    return mk, mv


def cross_attention(h, mk, mv, wq, wo):
    B, S, _ = h.shape
    q = (h @ wq).reshape(B, S, XA_HEADS, XA_HEAD_DIM).astype(jnp.float32)
    s = jnp.einsum('bshd,bmhd->bhsm', q, mk.astype(jnp.float32)) * (XA_HEAD_DIM ** -0.5)
    pr = jax.nn.softmax(s, axis=-1)
    o = jnp.einsum('bhsm,bmhd->bshd', pr, mv.astype(jnp.float32)).reshape(B, S, XA_WIDTH)
    return o.astype(h.dtype) @ wo


def hierarchical_moe(h, w_group, b_group, w_expert, b_expert, w1, w3, w2):
    B, S, D = h.shape
    T = B * S
    hf = h.reshape(T, D)
    g_logits = (hf @ w_group).astype(jnp.float32) + b_group.astype(jnp.float32)
    g_prob = jax.nn.softmax(g_logits, axis=-1)
    _, g_top = lax.top_k(g_logits, 1)
    p_group = jnp.take_along_axis(g_prob, g_top, axis=-1)
    e_logits = ((hf @ w_expert).astype(jnp.float32) + b_expert.astype(jnp.float32)).reshape(T, MOE_GROUPS, MOE_EXPERTS_PER_GROUP)
    idx = jnp.broadcast_to(g_top[:, :, None], (T, 1, MOE_EXPERTS_PER_GROUP))
    e_in = jnp.take_along_axis(e_logits, idx, axis=1)[:, 0]
    e_prob = jax.nn.softmax(e_in, axis=-1)
    top_p, top_i = lax.top_k(e_prob, MOE_TOPK)
    gate = p_group * top_p / jnp.sum(top_p, axis=-1, keepdims=True)
    expert = g_top * MOE_EXPERTS_PER_GROUP + top_i

    A = T * MOE_TOPK
    P = A + MOE_EXPERTS * MOE_BLOCK
    NB = P // MOE_BLOCK
    e_flat = expert.reshape(A)
    order = jnp.argsort(e_flat)
    e_s = e_flat[order]
    tok_s = (order // MOE_TOPK).astype(jnp.int32)
    w_s = gate.reshape(A)[order]
    counts = jnp.bincount(e_flat, length=MOE_EXPERTS)
    starts = jnp.cumsum(counts) - counts
    padded = (counts + MOE_BLOCK - 1) // MOE_BLOCK * MOE_BLOCK
    pends = jnp.cumsum(padded)
    pstarts = pends - padded
    dest = pstarts[e_s] + jnp.arange(A) - starts[e_s]
    buf_tok = jnp.zeros((P,), jnp.int32).at[dest].set(tok_s)
    buf_w = jnp.zeros((P,), jnp.float32).at[dest].set(w_s)
    block_e = jnp.minimum(jnp.searchsorted(pends, jnp.arange(NB) * MOE_BLOCK, side='right'), MOE_EXPERTS - 1)
    xb = hf[buf_tok].reshape(NB, MOE_BLOCK, D)

    def expert_block(args):
        xe, e = args
        return (jax.nn.silu(xe @ w1[e]) * (xe @ w3[e])) @ w2[e]

    yb = lax.map(expert_block, (xb, block_e)).reshape(P, D)
    y = jnp.zeros((T, D), jnp.float32).at[buf_tok].add(yb.astype(jnp.float32) * buf_w[:, None])
    return y.astype(h.dtype).reshape(B, S, D)


def setup_inputs(seed: int = 0) -> dict:
    key = jax.random.key(seed)
    ks = iter(jax.random.split(key, 64))
    D = D_MODEL

    def nrm(shape, scale):
        return jax.random.normal(next(ks), shape, jnp.float32) * scale

    def unif(shape, lo, hi):
        return jax.random.uniform(next(ks), shape, jnp.float32, lo, hi)

    def gain(shape):
        return 1.0 + nrm(shape, 0.02)

    return {
        'x': nrm((BATCH, SEQ, D), 1.0),
        'mem': nrm((BATCH, MEM_LEN, D), 1.0),
        'norm_mix': gain((DEPTH, D)),
        'norm_xattn': gain((DEPTH, D)),
        'norm_moe': gain((DEPTH, D)),
        'norm_final': gain((D,)),
        'ev_w_in': nrm((N_EVEN, D, EVEN_IN_COLS), D ** -0.5),
        'ev_sinks': nrm((N_EVEN, SWA_Q_HEADS), 0.5),
        'ev_mu': unif((N_EVEN, RWKV_COLS), 0.0, 1.0),
        'ev_w0': unif((N_EVEN, RWKV_WIDTH), -4.0, 0.0),
        'ev_w2': nrm((N_EVEN, RWKV_DECAY_RANK, RWKV_WIDTH), 0.1),
        'ev_a0': nrm((N_EVEN, RWKV_WIDTH), 0.1),
        'ev_a2': nrm((N_EVEN, RWKV_A_RANK, RWKV_WIDTH), 0.1),
        'ev_g2': nrm((N_EVEN, RWKV_GATE_RANK, RWKV_WIDTH), RWKV_GATE_RANK ** -0.5),
        'ev_k_k': 0.85 + nrm((N_EVEN, RWKV_WIDTH), 0.02),
        'ev_k_a': gain((N_EVEN, RWKV_WIDTH)),
        'ev_r_k': nrm((N_EVEN, RWKV_HEADS, HEAD_DIM), 0.1),
        'ev_lnx_w': gain((N_EVEN, RWKV_WIDTH)),
        'ev_lnx_b': nrm((N_EVEN, RWKV_WIDTH), 0.02),
        'ev_w_out': nrm((N_EVEN, EVEN_MIX_WIDTH, D), EVEN_MIX_WIDTH ** -0.5),
        'od_w_in': nrm((N_ODD, D, ODD_IN_COLS), D ** -0.5),
        'od_gate_up': nrm((N_ODD, GLA_GATE_RANK, GLA_KEY_WIDTH), GLA_GATE_RANK ** -0.5),
        'od_gate_b': nrm((N_ODD, GLA_KEY_WIDTH), 0.1),
        'od_onorm': gain((N_ODD, GLA_DV)),
        'od_w_out': nrm((N_ODD, GLA_VAL_WIDTH, D), GLA_VAL_WIDTH ** -0.5),
        'mem_norm': gain((D,)),
        'mem_wk': nrm((D, XA_WIDTH), D ** -0.5),
        'mem_wv': nrm((D, XA_WIDTH), D ** -0.5),
        'xa_wq': nrm((DEPTH, D, XA_WIDTH), D ** -0.5),
        'xa_wo': nrm((DEPTH, XA_WIDTH, D), XA_WIDTH ** -0.5),
        'moe_w_group': nrm((DEPTH, D, MOE_GROUPS), D ** -0.5),
        'moe_b_group': nrm((DEPTH, MOE_GROUPS), 0.01),
        'moe_w_expert': nrm((DEPTH, D, MOE_EXPERTS), D ** -0.5),
        'moe_b_expert': nrm((DEPTH, MOE_EXPERTS), 0.01),
        'moe_w1': nrm((DEPTH, MOE_EXPERTS, D, MOE_FF), D ** -0.5),
        'moe_w3': nrm((DEPTH, MOE_EXPERTS, D, MOE_FF), D ** -0.5),
        'moe_w2': nrm((DEPTH, MOE_EXPERTS, MOE_FF, D), MOE_FF ** -0.5),
    }


def reference(x, mem, norm_mix, norm_xattn, norm_moe, norm_final,
              ev_w_in, ev_sinks, ev_mu, ev_w0, ev_w2, ev_a0, ev_a2, ev_g2, ev_k_k, ev_k_a, ev_r_k,
              ev_lnx_w, ev_lnx_b, ev_w_out,
              od_w_in, od_gate_up, od_gate_b, od_onorm, od_w_out,
              mem_norm, mem_wk, mem_wv, xa_wq, xa_wo,
              moe_w_group, moe_b_group, moe_w_expert, moe_b_expert, moe_w1, moe_w3, moe_w2):
    mk, mv = memory_kv(mem, mem_norm, mem_wk, mem_wv)
    for layer in range(DEPTH):
        i = layer // 2
        h = rmsnorm(x, norm_mix[layer])
        if layer % 2 == 0:
            mix = even_mixer(h, ev_w_in[i], ev_sinks[i], ev_mu[i], ev_w0[i], ev_w2[i], ev_a0[i], ev_a2[i],
                             ev_g2[i], ev_k_k[i], ev_k_a[i], ev_r_k[i], ev_lnx_w[i], ev_lnx_b[i], ev_w_out[i])
        else:
            mix = odd_mixer(h, od_w_in[i], od_gate_up[i], od_gate_b[i], od_onorm[i], od_w_out[i])
        x = x + mix
        x = x + cross_attention(rmsnorm(x, norm_xattn[layer]), mk, mv, xa_wq[layer], xa_wo[layer])
        x = x + hierarchical_moe(rmsnorm(x, norm_moe[layer]), moe_w_group[layer], moe_b_group[layer],
                                 moe_w_expert[layer], moe_b_expert[layer], moe_w1[layer], moe_w3[layer], moe_w2[layer])
    return rmsnorm(x, norm_final)
```

```cpp
#include <hip/hip_runtime.h>
#include <cstdint>
#include <cstdio>

#define LAS __attribute__((address_space(3)))
typedef unsigned short bf16_t;
typedef float f32x4 __attribute__((ext_vector_type(4)));
typedef float f32x2 __attribute__((ext_vector_type(2)));
typedef unsigned u32x4 __attribute__((ext_vector_type(4)));
typedef unsigned u32x2 __attribute__((ext_vector_type(2)));

constexpr int T_TOK = 32768, DM = 1024, SEQ = 4096, NB = 8, MEMLEN = 256;
constexpr int EV_IN = 2560, OD_IN = 3072  , OD_IN_SRC = 3088;
constexpr int NEXP = 32, MOE_FF = 512, PMAX = 65536 + NEXP * 256;

constexpr size_t MiB = 1024 * 1024;
constexpr size_t OFF_CTL = 0;
constexpr size_t CTL_ZERO_BYTES = 64 * 1024;
constexpr size_t CTL_CNT = 16384;
constexpr size_t CTL_CUR = 16384 + 1024;
constexpr size_t CTL_BLK = 128 * 1024;
constexpr size_t OFF_ROUTE = 1 * MiB;
constexpr size_t OFF_WSMALL = 2 * MiB;
constexpr size_t OFF_MKV = 3 * MiB;
constexpr size_t OFF_WD = 7 * MiB;
constexpr size_t OFF_WMOE = 28 * MiB;
constexpr size_t OFF_H = 124 * MiB;
constexpr size_t OFF_P = 188 * MiB;
constexpr size_t OFF_R = 380 * MiB;
constexpr size_t WS_NEED = 452 * MiB;
constexpr size_t WE_EV_IN = 0, WE_EV_OUT = 2560ull * 1024, WE_OD_IN = 3584ull * 1024, WE_OD_OUT = 6656ull * 1024, WE_MKV = 7680ull * 1024, WE_WQ = 8704ull * 1024, WE_WO = 9728ull * 1024;

struct Params {
    const float *x, *mem, *norm_mix, *norm_xattn, *norm_moe, *norm_final;
    const float *ev_w_in, *ev_sinks, *ev_mu, *ev_w0, *ev_w2, *ev_a0, *ev_a2, *ev_g2, *ev_k_k, *ev_k_a, *ev_r_k, *ev_lnx_w, *ev_lnx_b, *ev_w_out;
    const float *od_w_in, *od_gate_up, *od_gate_b, *od_onorm, *od_w_out;
    const float *mem_norm, *mem_wk, *mem_wv, *xa_wq, *xa_wo;
    const float *moe_w_group, *moe_b_group, *moe_w_expert, *moe_b_expert, *moe_w1, *moe_w3, *moe_w2;
    float* out; unsigned char* ws; int ph_lo, ph_hi;
};

#define XB_TMO      128
#define XB_XCNT(j)  (256  + 64 * (j))
#define XB_XSUB(j)  (1280 + 64 * (j))
#define XB_XGEN(j)  (2304 + 64 * (j))
#define XB_TOP      3328
#define XB_TOPGEN   3392
#define XCD_BAR_WORDS 3456
#define XB_SPIN_CAP (1u << 18)
#define LAS __attribute__((address_space(3)))

__device__ __forceinline__ unsigned xb_ld(unsigned* p)              { return __hip_atomic_load(p, __ATOMIC_RELAXED, __HIP_MEMORY_SCOPE_AGENT); }
__device__ __forceinline__ unsigned xb_add(unsigned* p, unsigned v) { return __hip_atomic_fetch_add(p, v, __ATOMIC_RELAXED, __HIP_MEMORY_SCOPE_AGENT); }
__device__ __forceinline__ unsigned xb_xcc_id() { return (unsigned)__builtin_amdgcn_s_getreg((3 << 11) | 20) & 0xFu; }
#define XB_SPIN(cond, bar) do { unsigned _sp = 0; while (cond) { __builtin_amdgcn_s_sleep(1); \
    if ((++_sp & 255u) == 0u) { if (xb_ld(&(bar)[XB_TMO])) break; if (_sp > XB_SPIN_CAP) { atomicAdd(&(bar)[XB_TMO], 1u); break; } } } } while (0)

struct XcdBarrier {
    unsigned* bar; unsigned x;
    volatile LAS unsigned* st;
};

__device__ __forceinline__ XcdBarrier xcd_barrier_post(unsigned* bar, volatile LAS unsigned* st) {
    XcdBarrier b; b.bar = bar; b.x = xb_xcc_id(); b.st = st;
    if (threadIdx.x == 0) (void)xb_add(&bar[XB_XCNT(b.x)], 1u);
    return b;
}
__device__ __forceinline__ void xcd_barrier_complete(unsigned* bar, unsigned x, unsigned& nloc, unsigned& nx) {
    const unsigned G = gridDim.x * gridDim.y * gridDim.z;
    unsigned sum, cnt, mine, sp = 0u;
    for (;;) {
        sum = 0u; cnt = 0u; mine = 0u;
#pragma unroll
        for (unsigned j = 0; j < 16; ++j) { const unsigned c = xb_ld(&bar[XB_XCNT(j)]); sum += c; cnt += (c > 0u) ? 1u : 0u; mine = (j == x) ? c : mine; }
        if (sum == G) break;
        __builtin_amdgcn_s_sleep(1);
        if ((++sp & 255u) == 0u) { if (xb_ld(&bar[XB_TMO])) break; if (sp > XB_SPIN_CAP) { atomicAdd(&bar[XB_TMO], 1u); break; } }
    }
    nloc = mine > 0u ? mine : 1u; nx = cnt > 0u ? cnt : 1u;
}

__device__ __forceinline__ void xcd_barrier(const XcdBarrier& b) {
    asm volatile("s_waitcnt vmcnt(0)" ::: "memory");
    __syncthreads();
    if (threadIdx.x == 0) {
        unsigned* bar = b.bar;
        __builtin_amdgcn_s_waitcnt(0);
        unsigned nloc = b.st[0], nx = b.st[1];
        if (nloc == 0u) { xcd_barrier_complete(bar, b.x, nloc, nx); b.st[0] = nloc; b.st[1] = nx; }
        const unsigned old = xb_add(&bar[XB_XSUB(b.x)], 1u);
        const unsigned gen = old / nloc;
        if (old + 1u == (gen + 1u) * nloc) {
            __builtin_amdgcn_fence(__ATOMIC_RELEASE, "agent");
            asm volatile("s_waitcnt vmcnt(0)" ::: "memory");
            const unsigned og = xb_add(&bar[XB_TOP], 1u);
            const unsigned tg = og / nx;
            if (og + 1u == (tg + 1u) * nx) xb_add(&bar[XB_TOPGEN], 1u);
            else XB_SPIN(xb_ld(&bar[XB_TOPGEN]) == tg, bar);
            __builtin_amdgcn_fence(__ATOMIC_ACQUIRE, "agent");
            xb_add(&bar[XB_XGEN(b.x)], 1u);
            asm volatile("s_waitcnt vmcnt(0)" ::: "memory");
        } else {
            XB_SPIN(xb_ld(&bar[XB_XGEN(b.x)]) == gen, bar);
            __builtin_amdgcn_fence(__ATOMIC_ACQUIRE, "agent");
            asm volatile("s_waitcnt vmcnt(0)" ::: "memory");
        }
    }
    __syncthreads();
}
namespace pg8 {
#define PG8_LAS __attribute__((address_space(3)))
typedef unsigned short bf16_t;
typedef short bf16x8 __attribute__((ext_vector_type(8)));
typedef float f32x4 __attribute__((ext_vector_type(4)));
typedef unsigned u32x4 __attribute__((ext_vector_type(4)));
constexpr int BM = 256, BK = 64, HALF = 128, HTB = HALF * BK * 2  , STAGE_BYTES = 8 * HTB, NXCD = 8, WGM = 8;

__host__ __device__ __forceinline__ int lds_byte(int r, int c) { const int st = (r >> 4) * 2 + (c >> 5), rr = r & 15, cc = c & 31, ob = rr * 64 + cc * 2; return st * 1024 + (ob ^ (((ob >> 9) & 1) << 5)); }
__host__ __device__ __forceinline__ void stage_rc(int b, int& R, int& C) { const int st = b / 1024, sb = b % 1024, swz = sb ^ (((sb >> 9) & 1) << 5); R = (st >> 1) * 16 + swz / 64; C = (st & 1) * 32 + (swz % 64) / 2; }
__host__ __device__ __forceinline__ int perm32(int rho) { const int n = rho >> 4, i = rho & 15; return 8 * (i >> 2) + 4 * n + (i & 3); }

struct Unit { int pm, pn, e; };
struct Gemm { const bf16_t* A; const bf16_t* Bt; int M, N, K; size_t bexp; };

struct StaticOrder {
    int nM, nN, nwg, G, c;
    __host__ __device__ void init(int M, int N, int G_, int c_) { nM = M / BM; nN = N / BM; nwg = nM * nN; G = G_; c = c_; }
    __host__ __device__ bool next(int i, Unit& u) const {
        const long L = (long)i * G + c; if (L >= nwg) return false;
        int wgid = (int)L; { const int q = nwg / NXCD, r = nwg % NXCD, xcd = wgid % NXCD, off = wgid / NXCD; wgid = (xcd < r ? xcd * (q + 1) : r * (q + 1) + (xcd - r) * q) + off; }
        const int nig = WGM * nN, gid = wgid / nig, fm = gid * WGM, gsz = (nM - fm) < WGM ? (nM - fm) : WGM;
        u.pm = fm + ((wgid % nig) % gsz); u.pn = (wgid % nig) / gsz; u.e = 0; return true;
    }
    __device__ __forceinline__ void a_ready(const Unit&) const {}
    __device__ __forceinline__ void done(const Unit&) const {}
};
__device__ __forceinline__ unsigned cvt_pk_bf16(float lo, float hi) { unsigned r; asm volatile("v_cvt_pk_bf16_f32 %0, %1, %2" : "=v"(r) : "v"(lo), "v"(hi)); return r; }

struct EpiB16 {
    static constexpr bool PERM = true, AFTER_DRAIN = false;
    bf16_t* O; int ldc;
    __device__ __forceinline__ void operator()(const f32x4 (&acc)[2][2][4][2], const Unit& u, int wr, int wc, int fr, int fq) const {
        const int row0 = u.pm * BM + wr * 64 + fr, col0 = u.pn * BM + wc * 32 + 8 * fq;
#pragma unroll
        for (int ai = 0; ai < 2; ++ai)
#pragma unroll
            for (int m = 0; m < 4; ++m) { bf16_t* rowp = O + (size_t)(row0 + ai * HALF + m * 16) * ldc + col0;
#pragma unroll
                for (int bj = 0; bj < 2; ++bj) { const f32x4 v0 = acc[ai][bj][m][0], v1 = acc[ai][bj][m][1];
                    u32x4 w; w.x = cvt_pk_bf16(v0[0], v0[1]); w.y = cvt_pk_bf16(v0[2], v0[3]); w.z = cvt_pk_bf16(v1[0], v1[1]); w.w = cvt_pk_bf16(v1[2], v1[3]);
                    *(u32x4*)(rowp + bj * HALF) = w; } }
    }
};
struct EpiRes {
    static constexpr bool PERM = false, AFTER_DRAIN = false;
    const float* base; float* out; int ldc;
    __device__ __forceinline__ void operator()(const f32x4 (&acc)[2][2][4][2], const Unit& u, int wr, int wc, int fr, int fq) const {
        const int row0 = u.pm * BM + wr * 64 + fr, col0 = u.pn * BM + wc * 32 + 4 * fq;
#pragma unroll
        for (int ai = 0; ai < 2; ++ai)
#pragma unroll
            for (int m = 0; m < 4; ++m) { const size_t off = (size_t)(row0 + ai * HALF + m * 16) * ldc + col0;
#pragma unroll
                for (int bj = 0; bj < 2; ++bj)
#pragma unroll
                    for (int n = 0; n < 2; ++n) { const f32x4 bs = *(const f32x4*)(base + off + bj * HALF + n * 16); *(f32x4*)(out + off + bj * HALF + n * 16) = bs + acc[ai][bj][m][n]; } }
    }
};
struct EpiSwiglu {
    static constexpr bool PERM = true, AFTER_DRAIN = false;
    bf16_t* O; int ldc;
    __device__ __forceinline__ void operator()(const f32x4 (&acc)[2][2][4][2], const Unit& u, int wr, int wc, int fr, int fq) const {
        const int row0 = u.pm * BM + wr * 64 + fr, col0 = (u.pn * BM + wc * 32 + 8 * fq) >> 1;
        typedef unsigned u32x2v __attribute__((ext_vector_type(2)));
#pragma unroll
        for (int ai = 0; ai < 2; ++ai)
#pragma unroll
            for (int m = 0; m < 4; ++m) { bf16_t* rowp = O + (size_t)(row0 + ai * HALF + m * 16) * ldc + col0;
#pragma unroll
                for (int bj = 0; bj < 2; ++bj) { const f32x4 a = acc[ai][bj][m][0], b = acc[ai][bj][m][1]; float h[4];
#pragma unroll
                    for (int i = 0; i < 4; ++i) h[i] = a[i] * __builtin_amdgcn_rcpf(1.0f + __expf(-a[i])) * b[i];
                    u32x2v w; w.x = cvt_pk_bf16(h[0], h[1]); w.y = cvt_pk_bf16(h[2], h[3]);
                    *(u32x2v*)(rowp + bj * (HALF / 2)) = w; } }
    }
};
struct MoeOrder {
    const int* blk_e; int nunits, nN, G, c;
    __device__ __forceinline__ bool next(int i, Unit& u) const {
        const long L = (long)i * G + c; if (L >= nunits) return false;
        u.pm = (int)(L / nN); u.pn = (int)(L % nN); u.e = blk_e[u.pm]; return true;
    }
    __device__ __forceinline__ void a_ready(const Unit&) const {}
    __device__ __forceinline__ void done(const Unit&) const {}
};
template <class Epi, class Sched, bool ALIGN_EPI = false, bool SP2 = false>
__device__ __forceinline__ void gemm_phase(PG8_LAS unsigned char* lds, const Gemm g, const Sched& S, const Epi& E) {
    int tid_ = threadIdx.x; asm volatile("" : "+v"(tid_));
    const int tid = tid_, wid = __builtin_amdgcn_readfirstlane(tid >> 6), lane = tid & 63, wr = wid >> 2, wc = wid & 3, fr = lane & 15, fq = lane >> 4;
    const int K = g.K, nt = K / BK;
    unsigned voffA[2], voffB[2];
#pragma unroll
    for (int i = 0; i < 2; ++i) { int R, C; stage_rc(tid * 16 + i * 8192, R, C); const int Rb = Epi::PERM ? ((R & ~31) + perm32(R & 31)) : R;
        voffA[i] = (unsigned)(R * K + C) * 2u; voffB[i] = (unsigned)(Rb * K + C) * 2u; }
    const size_t kstep = (size_t)(BK * 2);
    const size_t hstep = (size_t)HALF * K * 2;
    const size_t tstep = 2 * hstep;
    const unsigned ldsw = (unsigned)wid * 1024u;
    const int aoff = lds_byte(wr * 64 + fr, fq * 8), boff = lds_byte(wc * 32 + fr, fq * 8);
#define PG8_SA(b, h) (((b) * 2 + (h)) * HTB)
#define PG8_SB(b, h) ((4 + (b) * 2 + (h)) * HTB)
#define PG8_STAGE(bufoff, gbase, voff) do { _Pragma("unroll") for (int _i = 0; _i < 2; ++_i) \
        __builtin_amdgcn_global_load_lds((const unsigned*)((const char*)(gbase) + (voff)[_i]), (PG8_LAS unsigned*)(lds + (bufoff) + ldsw + _i * 8192), 16, 0, 0); } while (0)
#define PG8_LDA(dst, b, h) do { _Pragma("unroll") for (int m = 0; m < 4; ++m) _Pragma("unroll") for (int k = 0; k < 2; ++k) dst[m][k] = *(const PG8_LAS bf16x8*)(lds + PG8_SA(b, h) + aoff + m * 2048 + k * 1024); } while (0)
#define PG8_LDB(dst, b, h) do { _Pragma("unroll") for (int n = 0; n < 2; ++n) _Pragma("unroll") for (int k = 0; k < 2; ++k) dst[n][k] = *(const PG8_LAS bf16x8*)(lds + PG8_SB(b, h) + boff + n * 2048 + k * 1024); } while (0)
#define PG8_MMA(ai, bj, At, Bt) do { __builtin_amdgcn_s_setprio(1); _Pragma("unroll") for (int m = 0; m < 4; ++m) _Pragma("unroll") for (int n = 0; n < 2; ++n) _Pragma("unroll") for (int k = 0; k < 2; ++k) \
        acc[ai][bj][m][n] = __builtin_amdgcn_mfma_f32_16x16x32_bf16(Bt[n][k], At[m][k], acc[ai][bj][m][n], 0, 0, 0); __builtin_amdgcn_s_setprio(0); } while (0)
#define PG8_WAIT_V(n) asm volatile("s_waitcnt vmcnt(" #n ")" ::: "memory")
#define PG8_WAIT_L(n) asm volatile("s_waitcnt lgkmcnt(" #n ")" ::: "memory")
#define PG8_BAR __builtin_amdgcn_s_barrier()
#define PG8_SCHED __builtin_amdgcn_sched_barrier(0)
    Unit cur, nxt; int ui = 0;
    if (!S.next(0, cur)) return;
    f32x4 acc[2][2][4][2];
#pragma unroll
    for (int a = 0; a < 2; ++a)
#pragma unroll
        for (int b = 0; b < 2; ++b)
#pragma unroll
            for (int m = 0; m < 4; ++m)
#pragma unroll
                for (int n = 0; n < 2; ++n) acc[a][b][m][n] = (f32x4){0.f, 0.f, 0.f, 0.f};
    bf16x8 At[4][2], B0[2][2], B1[2][2];
    const char* cA = (const char*)g.A + (size_t)cur.pm * tstep; const char* cB = (const char*)g.Bt + (size_t)cur.pn * tstep + (size_t)cur.e * g.bexp;
    S.a_ready(cur);
    if constexpr (SP2) {
        PG8_STAGE(PG8_SB(0, 0), cB, voffB); PG8_STAGE(PG8_SB(0, 1), cB + hstep, voffB); PG8_STAGE(PG8_SA(0, 0), cA, voffA); PG8_STAGE(PG8_SA(0, 1), cA + hstep, voffA);
        if (wr == 1) PG8_BAR;
        PG8_WAIT_V(2); PG8_BAR;
        PG8_STAGE(PG8_SB(1, 0), cB + kstep, voffB); PG8_STAGE(PG8_SA(1, 0), cA + kstep, voffA); PG8_STAGE(PG8_SB(1, 1), cB + hstep + kstep, voffB);
        PG8_WAIT_V(6); PG8_BAR;
    } else {
        PG8_STAGE(PG8_SB(0, 0), cB, voffB); PG8_STAGE(PG8_SA(0, 0), cA, voffA); PG8_STAGE(PG8_SB(0, 1), cB + hstep, voffB); PG8_STAGE(PG8_SA(0, 1), cA + hstep, voffA);
        if (wr == 1) PG8_BAR;
        PG8_WAIT_V(4); PG8_BAR;
        PG8_STAGE(PG8_SB(1, 0), cB + kstep, voffB); PG8_STAGE(PG8_SA(1, 0), cA + kstep, voffA); PG8_STAGE(PG8_SB(1, 1), cB + hstep + kstep, voffB);
        PG8_WAIT_V(6); PG8_BAR;
    }
    for (;;) {
        const bool has_next = S.next(ui + 1, nxt);
        const char* nA = has_next ? (const char*)g.A + (size_t)nxt.pm * tstep : cA; const char* nB = has_next ? (const char*)g.Bt + (size_t)nxt.pn * tstep + (size_t)nxt.e * g.bexp : cB;
        for (int t = 0; t < nt; t += 2) {
            const bool last = (t == nt - 2);
            const char* a1 = cA + (size_t)(t + 1) * kstep;
            const char* a2 = last ? nA : cA + (size_t)(t + 2) * kstep; const char* b2 = last ? nB : cB + (size_t)(t + 2) * kstep;
            const char* a3 = a2 + kstep; const char* b3 = b2 + kstep;
            if (last && has_next) S.a_ready(nxt);
            if constexpr (SP2) {
            PG8_LDB(B0, 0, 0); PG8_LDB(B1, 0, 1); PG8_SCHED; PG8_LDA(At, 0, 0); PG8_STAGE(PG8_SA(1, 1), a1 + hstep, voffA);
            PG8_WAIT_V(8); PG8_WAIT_L(0); PG8_BAR; PG8_MMA(0, 0, At, B0); PG8_MMA(0, 1, At, B1); PG8_BAR; PG8_SCHED;
            PG8_LDA(At, 0, 1); PG8_STAGE(PG8_SB(0, 0), b2, voffB); PG8_STAGE(PG8_SB(0, 1), b2 + hstep, voffB); PG8_STAGE(PG8_SA(0, 0), a2, voffA);
            PG8_WAIT_V(8); PG8_WAIT_L(0); PG8_BAR; PG8_MMA(1, 0, At, B0); PG8_MMA(1, 1, At, B1); PG8_BAR; PG8_SCHED;
            PG8_LDB(B0, 1, 0); PG8_LDB(B1, 1, 1); PG8_SCHED; PG8_LDA(At, 1, 0); PG8_STAGE(PG8_SA(0, 1), a2 + hstep, voffA);
            PG8_WAIT_V(8); PG8_WAIT_L(0); PG8_BAR; PG8_MMA(0, 0, At, B0); PG8_MMA(0, 1, At, B1); PG8_BAR; PG8_SCHED;
            PG8_LDA(At, 1, 1); PG8_STAGE(PG8_SB(1, 0), b3, voffB); PG8_STAGE(PG8_SB(1, 1), b3 + hstep, voffB); PG8_STAGE(PG8_SA(1, 0), a3, voffA);
            PG8_WAIT_V(8); PG8_WAIT_L(0); PG8_BAR; PG8_MMA(1, 0, At, B0); PG8_MMA(1, 1, At, B1); PG8_BAR; PG8_SCHED;
            } else {
            PG8_LDB(B0, 0, 0); PG8_SCHED; PG8_LDA(At, 0, 0); PG8_STAGE(PG8_SA(1, 1), a1 + hstep, voffA);
            PG8_WAIT_L(8); PG8_BAR; PG8_WAIT_L(0); PG8_MMA(0, 0, At, B0); PG8_BAR; PG8_SCHED;
            PG8_LDB(B1, 0, 1); PG8_STAGE(PG8_SB(0, 0), b2, voffB);
            PG8_BAR; PG8_WAIT_L(0); PG8_MMA(0, 1, At, B1); PG8_BAR;
            PG8_LDA(At, 0, 1); PG8_STAGE(PG8_SA(0, 0), a2, voffA);
            PG8_BAR; PG8_WAIT_L(0); PG8_MMA(1, 0, At, B0); PG8_BAR; PG8_SCHED;
            PG8_STAGE(PG8_SB(0, 1), b2 + hstep, voffB);
            PG8_WAIT_V(6); PG8_BAR; PG8_MMA(1, 1, At, B1); PG8_BAR;
            PG8_LDB(B0, 1, 0); PG8_SCHED; PG8_LDA(At, 1, 0); PG8_STAGE(PG8_SA(0, 1), a2 + hstep, voffA);
            PG8_WAIT_L(8); PG8_BAR; PG8_WAIT_L(0); PG8_MMA(0, 0, At, B0); PG8_BAR; PG8_SCHED;
            PG8_LDB(B1, 1, 1); PG8_STAGE(PG8_SB(1, 0), b3, voffB);
            PG8_BAR; PG8_WAIT_L(0); PG8_MMA(0, 1, At, B1); PG8_BAR;
            PG8_LDA(At, 1, 1); PG8_STAGE(PG8_SA(1, 0), a3, voffA);
            PG8_BAR; PG8_WAIT_L(0); PG8_MMA(1, 0, At, B0); PG8_BAR; PG8_SCHED;
            PG8_STAGE(PG8_SB(1, 1), b3 + hstep, voffB);
            PG8_WAIT_V(6); PG8_BAR; PG8_MMA(1, 1, At, B1); PG8_BAR;
            }
        }
        if constexpr (ALIGN_EPI) { if (wr == 0) PG8_BAR; }
        if constexpr (!Epi::AFTER_DRAIN) { E(acc, cur, wr, wc, fr, fq); S.done(cur); }
        if (!has_next) break;
#pragma unroll
        for (int a = 0; a < 2; ++a)
#pragma unroll
            for (int b = 0; b < 2; ++b)
#pragma unroll
                for (int m = 0; m < 4; ++m)
#pragma unroll
                    for (int n = 0; n < 2; ++n) acc[a][b][m][n] = (f32x4){0.f, 0.f, 0.f, 0.f};
        cur = nxt; cA = nA; cB = nB; ++ui;
        if constexpr (ALIGN_EPI) { if (wr == 1) PG8_BAR; }
    }
    PG8_WAIT_V(0);
    if constexpr (!ALIGN_EPI) { if (wr == 0) PG8_BAR; }
    PG8_BAR;
    if constexpr (Epi::AFTER_DRAIN) { E.fused(acc, cur, wr, wc, fr, fq, lds, wid, lane); S.done(cur); }
#undef PG8_SA
#undef PG8_SB
#undef PG8_STAGE
#undef PG8_LDA
#undef PG8_LDB
#undef PG8_MMA
#undef PG8_WAIT_V
#undef PG8_WAIT_L
#undef PG8_BAR
#undef PG8_SCHED
}
}
__device__ __forceinline__ float bf2f(unsigned v) { return __uint_as_float(v << 16); }
__device__ __forceinline__ unsigned f2bf(float f) { unsigned u = __float_as_uint(f); u += 0x7FFFu + ((u >> 16) & 1u); return u >> 16; }
__device__ __forceinline__ unsigned pk2(float lo, float hi) { return f2bf(lo) | (f2bf(hi) << 16); }
__device__ __forceinline__ float bflo(unsigned w) { return __uint_as_float(w << 16); }
__device__ __forceinline__ float bfhi(unsigned w) { return __uint_as_float(w & 0xFFFF0000u); }
__device__ __forceinline__ float wave_sum(float v) {
#pragma unroll
    for (int o = 1; o < 64; o <<= 1) v += __shfl_xor(v, o);
    return v;
}
__device__ __forceinline__ float wave_max(float v) {
#pragma unroll
    for (int o = 1; o < 64; o <<= 1) v = fmaxf(v, __shfl_xor(v, o));
    return v;
}
__device__ __forceinline__ float sigmoidf_(float x) { return 1.0f / (1.0f + __expf(-x)); }
#define LDS_WAIT() asm volatile("s_waitcnt lgkmcnt(0)" ::: "memory")

struct Ctx { int tid, wave, lane, gw, ngw; unsigned char* shm; };

__device__ __forceinline__ int tr_src_col(int mode, int n, int scol0) { return mode == 1 ? (n < 2048 ? n : n + 16) : scol0 + n; }
__device__ __forceinline__ int tr_dst_row(int mode, int n, int drow0) { return mode == 2 ? 8 * (n >> 2) + (n & 3) : (mode == 3 ? 8 * (n >> 2) + 4 + (n & 3) : drow0 + n); }
__device__ __forceinline__ void tr_item(const float* W, int ldw, int scol0, int K, bf16_t* WT, int drow0, int mode, LAS float* scr, int item, int nblk, int lane) {
    const int kb = item / nblk, nb = item % nblk, k0 = 64 * kb, n0 = 32 * nb;
    const int sc = tr_src_col(mode, n0 + (lane & 31), scol0);
#pragma unroll 8
    for (int i = 0; i < 32; ++i) { const int kk = 2 * i + (lane >> 5); scr[kk * 33 + (lane & 31)] = W[(size_t)(k0 + kk) * ldw + sc]; }
    LDS_WAIT(); asm volatile("" ::: "memory");
    const int c = lane & 7;
#pragma unroll
    for (int j = 0; j < 4; ++j) { const int n = (lane >> 3) + 8 * j; const LAS float* s = scr + (8 * c) * 33 + n;
        u32x4 o; o.x = pk2(s[0 * 33], s[1 * 33]); o.y = pk2(s[2 * 33], s[3 * 33]); o.z = pk2(s[4 * 33], s[5 * 33]); o.w = pk2(s[6 * 33], s[7 * 33]);
        *(u32x4*)(WT + (size_t)tr_dst_row(mode, n0 + n, drow0) * K + k0 + 8 * c) = o; }
    LDS_WAIT(); asm volatile("" ::: "memory");
}
__device__ __forceinline__ void tr_matrix(const Ctx& c, const float* W, int ldw, int scol0, int K, int ncols, bf16_t* WT, int drow0, int mode) {
    LAS float* scr = (LAS float*)(c.shm) + c.wave * (64 * 33);
    const int nblk = ncols / 32, nitems = (K / 64) * nblk;
    for (int it = c.gw; it < nitems; it += c.ngw) tr_item(W, ldw, scol0, K, WT, drow0, mode, scr, it, nblk, c.lane);
}
__device__ __forceinline__ void tr_moe_layer(const Ctx& c, const Params& p, int layer) {
    LAS float* scr = (LAS float*)(c.shm) + c.wave * (64 * 33);
    bf16_t* w13t = (bf16_t*)(p.ws + OFF_WMOE); bf16_t* w2t = (bf16_t*)(p.ws + OFF_WMOE + 64 * MiB);
    const float* w1 = p.moe_w1 + (size_t)layer * NEXP * 1024 * 512; const float* w3 = p.moe_w3 + (size_t)layer * NEXP * 1024 * 512; const float* w2 = p.moe_w2 + (size_t)layer * NEXP * 512 * 1024;
    for (int it = c.gw; it < NEXP * 768; it += c.ngw) {
        const int e = it / 768, r = it % 768;
        if (r < 256) tr_item(w1 + (size_t)e * 1024 * 512, 512, 0, 1024, w13t + (size_t)e * 1024 * 1024, 0, 2, scr, r, 16, c.lane);
        else if (r < 512) tr_item(w3 + (size_t)e * 1024 * 512, 512, 0, 1024, w13t + (size_t)e * 1024 * 1024, 0, 3, scr, r - 256, 16, c.lane);
        else tr_item(w2 + (size_t)e * 512 * 1024, 1024, 0, 512, w2t + (size_t)e * 1024 * 512, 0, 0, scr, r - 512, 32, c.lane);
    }
}

__device__ __forceinline__ void row_load(const float* row, int lane, f32x4 (&v)[4]) {
#pragma unroll
    for (int j = 0; j < 4; ++j) v[j] = *((const f32x4*)row + lane + 64 * j);
}
__device__ __forceinline__ float row_rstd(const f32x4 (&v)[4]) {
    float s = 0.f;
#pragma unroll
    for (int j = 0; j < 4; ++j) s += (v[j].x * v[j].x + v[j].y * v[j].y) + (v[j].z * v[j].z + v[j].w * v[j].w);
    return 1.0f / sqrtf(wave_sum(s) * (1.0f / 1024.0f) + 1e-6f);
}
__device__ __forceinline__ void row_scale(f32x4 (&v)[4], float rstd, const float* gain, int lane) {
#pragma unroll
    for (int j = 0; j < 4; ++j) { const f32x4 g = *((const f32x4*)gain + lane + 64 * j); v[j] = v[j] * rstd * g; }
}
__device__ __forceinline__ void row_store_bf16(bf16_t* orow, int lane, const f32x4 (&v)[4]) {
#pragma unroll
    for (int j = 0; j < 4; ++j) { u32x2 o; o.x = pk2(v[j].x, v[j].y); o.y = pk2(v[j].z, v[j].w); *((u32x2*)orow + lane + 64 * j) = o; }
}
__device__ __forceinline__ void row_store_f32(float* orow, int lane, const f32x4 (&v)[4]) {
#pragma unroll
    for (int j = 0; j < 4; ++j) *((f32x4*)orow + lane + 64 * j) = v[j];
}
__device__ __forceinline__ void row_combine(f32x4 (&v)[4], const bf16_t* yb, int p0, int p1, float g0, float g1, int lane) {
    const u32x2* r0 = (const u32x2*)(yb + (size_t)p0 * 1024); const u32x2* r1 = (const u32x2*)(yb + (size_t)p1 * 1024);
#pragma unroll
    for (int j = 0; j < 4; ++j) { const u32x2 a = r0[lane + 64 * j], b = r1[lane + 64 * j];
        v[j].x += g0 * bflo(a.x) + g1 * bflo(b.x); v[j].y += g0 * bfhi(a.x) + g1 * bfhi(b.x);
        v[j].z += g0 * bflo(a.y) + g1 * bflo(b.y); v[j].w += g0 * bfhi(a.y) + g1 * bfhi(b.y); }
}
__device__ __forceinline__ void row_logits(const f32x4 (&v)[4], const float* wT, int lane, int NL, LAS float* lg) {
#pragma unroll 1
    for (int o = 0; o < NL; ++o) { float s = 0.f;
#pragma unroll
        for (int j = 0; j < 4; ++j) { const f32x4 w = *((const f32x4*)(wT + o * 1024) + lane + 64 * j); s += (v[j].x * w.x + v[j].y * w.y) + (v[j].z * w.z + v[j].w * w.w); }
        s = wave_sum(s); if (lane == 0) lg[o] = s; }
    LDS_WAIT();
}

__device__ __forceinline__ void norm_plain(const Ctx& c, const float* src, const float* gain, bf16_t* H, int nrows) {
    for (int r = c.gw; r < nrows; r += c.ngw) { f32x4 v[4]; row_load(src + (size_t)r * 1024, c.lane, v); const float rs = row_rstd(v); row_scale(v, rs, gain, c.lane); row_store_bf16(H + (size_t)r * 1024, c.lane, v); }
}
__device__ __forceinline__ void route_row(const LAS float* lg, const float* bg, const float* be, int& e0, int& e1, float& g0, float& g1) {
    float gl[4]; int gt = 0; float gm;
#pragma unroll
    for (int i = 0; i < 4; ++i) gl[i] = lg[i] + bg[i];
    gm = gl[0];
#pragma unroll
    for (int i = 1; i < 4; ++i) if (gl[i] > gm) { gm = gl[i]; gt = i; }
    float gs = 0.f;
#pragma unroll
    for (int i = 0; i < 4; ++i) gs += __expf(gl[i] - gm);
    const float pg = 1.0f / gs;
    float el[8];
#pragma unroll
    for (int i = 0; i < 8; ++i) el[i] = lg[4 + 8 * gt + i] + be[8 * gt + i];
    int i0 = 0; float m0 = el[0];
#pragma unroll
    for (int i = 1; i < 8; ++i) if (el[i] > m0) { m0 = el[i]; i0 = i; }
    int i1 = -1; float m1 = -3.0e38f;
#pragma unroll
    for (int i = 0; i < 8; ++i) if (i != i0 && el[i] > m1) { m1 = el[i]; i1 = i; }
    const float q1 = __expf(m1 - m0); const float inv = 1.0f / (1.0f + q1);
    e0 = gt * 8 + i0; e1 = gt * 8 + i1; g0 = pg * inv; g1 = pg * q1 * inv;
}
constexpr int RW_AS = 64 * 68;
__device__ __forceinline__ void rwkv_naive(const Ctx& c, const Params& p, int bh) {
    const int b = bh >> 3, hd = bh & 7, tid = c.tid, lane = c.lane, wv = c.wave;
    LAS float* L = (LAS float*)c.shm;
    LAS float* aR = L; LAS float* aK = L + RW_AS; LAS float* aV = L + 2 * RW_AS; LAS float* aW = L + 3 * RW_AS; LAS float* aA = L + 4 * RW_AS;
    LAS float* aB = L + 5 * RW_AS; LAS float* aG = L + 6 * RW_AS; LAS float* aY = L + 7 * RW_AS; LAS float* red = L + 8 * RW_AS;
    const bf16_t* P = (const bf16_t*)(p.ws + OFF_P); bf16_t* MIX = (bf16_t*)(p.ws + OFF_H);
    LAS f32x4* SL = (LAS f32x4*)(L + 8 * RW_AS + 1536);
    if (wv == 0) {
#pragma unroll
        for (int j4 = 0; j4 < 16; ++j4) SL[j4 * 64 + lane] = (f32x4){0.f, 0.f, 0.f, 0.f}; }
    const int t = lane, cg = wv;
    const int ch0 = hd * 64 + cg * 8;
    for (int tb = 0; tb < 64; ++tb) {
        const size_t tg0 = (size_t)b * SEQ + (size_t)tb * 64;
#pragma unroll 1
        for (int i = 0; i < 7; ++i) {
            const int task = tid + 512 * i, tt = task / 56, q = task % 56;
            int col; LAS float* dst; int kind = 0;
            if (q < 8) { col = hd * 64 + 8 * q; dst = aR + tt * 68 + 8 * q; }
            else if (q < 16) { col = 512 + hd * 64 + 8 * (q - 8); dst = aK + tt * 68 + 8 * (q - 8); }
            else if (q < 24) { col = 1024 + hd * 64 + 8 * (q - 16); dst = aV + tt * 68 + 8 * (q - 16); }
            else if (q < 32) { col = 1536 + 8 * (q - 24); dst = aW + tt * 68 + 8 * (q - 24); kind = 1; }
            else if (q < 40) { col = 1600 + 8 * (q - 32); dst = aA + tt * 68 + 8 * (q - 32); }
            else if (q < 48) { col = 1664 + 8 * (q - 40); dst = aB + tt * 68 + 8 * (q - 40); kind = 2; }
            else { col = 1664 + 8 * (q - 40); dst = aG + tt * 68 + 8 * (q - 48); kind = 2; }
            const bf16_t* src = P + (tg0 + tt) * EV_IN + 768 + col;
            const u32x4 cur = *(const u32x4*)src;
            u32x4 prv = (u32x4){0u, 0u, 0u, 0u};
            if (tb * 64 + tt > 0) prv = *(const u32x4*)(src - EV_IN);
            const f32x4 m0 = *(const f32x4*)(p.ev_mu + col), m1 = *(const f32x4*)(p.ev_mu + col + 4);
            float v[8];
            const unsigned cw[4] = {cur.x, cur.y, cur.z, cur.w}, pw[4] = {prv.x, prv.y, prv.z, prv.w};
            const float mu[8] = {m0.x, m0.y, m0.z, m0.w, m1.x, m1.y, m1.z, m1.w};
#pragma unroll
            for (int k = 0; k < 4; ++k) { const float c0 = bflo(cw[k]), c1 = bfhi(cw[k]), p0 = bflo(pw[k]), p1 = bfhi(pw[k]);
                v[2 * k] = c0 + (p0 - c0) * mu[2 * k]; v[2 * k + 1] = c1 + (p1 - c1) * mu[2 * k + 1]; }
            if (kind == 1) {
#pragma unroll
                for (int k = 0; k < 8; ++k) v[k] = tanhf(v[k]); }
            if (kind == 2) {
#pragma unroll
                for (int k = 0; k < 8; ++k) v[k] = sigmoidf_(v[k]); }
            *(LAS f32x4*)dst = (f32x4){v[0], v[1], v[2], v[3]}; *(LAS f32x4*)(dst + 4) = (f32x4){v[4], v[5], v[6], v[7]};
        }
        __syncthreads();
        float zw[8], za[8], gg[8];
#pragma unroll
        for (int i = 0; i < 8; ++i) { zw[i] = 0.f; za[i] = 0.f; gg[i] = 0.f; }
#pragma unroll 2
        for (int j4 = 0; j4 < 16; ++j4) {
            const f32x4 xw = *(const LAS f32x4*)(aW + t * 68 + 4 * j4), xa = *(const LAS f32x4*)(aA + t * 68 + 4 * j4);
            const f32x4 g0 = *(const LAS f32x4*)(aB + t * 68 + 4 * j4), g1 = *(const LAS f32x4*)(aG + t * 68 + 4 * j4);
#pragma unroll
            for (int jj = 0; jj < 4; ++jj) { const int j = 4 * j4 + jj;
                const f32x4 w2a = *(const f32x4*)(p.ev_w2 + (size_t)j * 512 + ch0), w2b = *(const f32x4*)(p.ev_w2 + (size_t)j * 512 + ch0 + 4);
                const f32x4 a2a = *(const f32x4*)(p.ev_a2 + (size_t)j * 512 + ch0), a2b = *(const f32x4*)(p.ev_a2 + (size_t)j * 512 + ch0 + 4);
                const f32x4 gla = *(const f32x4*)(p.ev_g2 + (size_t)j * 512 + ch0), glb = *(const f32x4*)(p.ev_g2 + (size_t)j * 512 + ch0 + 4);
                const f32x4 gha = *(const f32x4*)(p.ev_g2 + (size_t)(64 + j) * 512 + ch0), ghb = *(const f32x4*)(p.ev_g2 + (size_t)(64 + j) * 512 + ch0 + 4);
                const float xwv = xw[jj], xav = xa[jj], g0v = g0[jj], g1v = g1[jj];
#pragma unroll
                for (int i = 0; i < 4; ++i) { zw[i] += xwv * w2a[i]; zw[4 + i] += xwv * w2b[i]; za[i] += xav * a2a[i]; za[4 + i] += xav * a2b[i];
                    gg[i] += g0v * gla[i] + g1v * gha[i]; gg[4 + i] += g0v * glb[i] + g1v * ghb[i]; } }
        }
        float av[8], kkv[8]; float ss = 0.f;
        {
            const f32x4 kA = *(const LAS f32x4*)(aK + t * 68 + cg * 8), kB = *(const LAS f32x4*)(aK + t * 68 + cg * 8 + 4);
            const float kv[8] = {kA.x, kA.y, kA.z, kA.w, kB.x, kB.y, kB.z, kB.w};
            float dec[8], kp[8];
#pragma unroll
            for (int i = 0; i < 8; ++i) { const int ch = ch0 + i;
                const float u = -(p.ev_w0[ch] + zw[i]); const float sp = (u > 20.f) ? u : log1pf(__expf(u));
                const float w = -sp - 0.5f; dec[i] = __expf(-__expf(w));
                av[i] = sigmoidf_(p.ev_a0[ch] + za[i]);
                kkv[i] = kv[i] * p.ev_k_k[ch]; ss += kkv[i] * kkv[i];
                kp[i] = kv[i] * (1.0f + (av[i] - 1.0f) * p.ev_k_a[ch]); }
            red[t * 8 + cg] = ss;
            __syncthreads();
            *(LAS f32x4*)(aW + t * 68 + cg * 8) = (f32x4){dec[0], dec[1], dec[2], dec[3]}; *(LAS f32x4*)(aW + t * 68 + cg * 8 + 4) = (f32x4){dec[4], dec[5], dec[6], dec[7]};
            *(LAS f32x4*)(aK + t * 68 + cg * 8) = (f32x4){kp[0], kp[1], kp[2], kp[3]}; *(LAS f32x4*)(aK + t * 68 + cg * 8 + 4) = (f32x4){kp[4], kp[5], kp[6], kp[7]};
            *(LAS f32x4*)(aG + t * 68 + cg * 8) = (f32x4){gg[0], gg[1], gg[2], gg[3]}; *(LAS f32x4*)(aG + t * 68 + cg * 8 + 4) = (f32x4){gg[4], gg[5], gg[6], gg[7]};
            float tot = 0.f;
#pragma unroll
            for (int i = 0; i < 8; ++i) tot += red[t * 8 + i];
            const float inv = 1.0f / fmaxf(sqrtf(tot), 1e-12f);
            float an[8], bn[8];
#pragma unroll
            for (int i = 0; i < 8; ++i) { const float kn = kkv[i] * inv; an[i] = -kn; bn[i] = kn * av[i]; }
            *(LAS f32x4*)(aA + t * 68 + cg * 8) = (f32x4){an[0], an[1], an[2], an[3]}; *(LAS f32x4*)(aA + t * 68 + cg * 8 + 4) = (f32x4){an[4], an[5], an[6], an[7]};
            *(LAS f32x4*)(aB + t * 68 + cg * 8) = (f32x4){bn[0], bn[1], bn[2], bn[3]}; *(LAS f32x4*)(aB + t * 68 + cg * 8 + 4) = (f32x4){bn[4], bn[5], bn[6], bn[7]};
        }
        __syncthreads();
        if (wv == 0) {
            float S[64];
#pragma unroll
            for (int j4 = 0; j4 < 16; ++j4) { const f32x4 s4 = SL[j4 * 64 + lane]; S[4 * j4] = s4.x; S[4 * j4 + 1] = s4.y; S[4 * j4 + 2] = s4.z; S[4 * j4 + 3] = s4.w; }
#pragma unroll 1
            for (int tt = 0; tt < 64; ++tt) {
                const float vv = aV[tt * 68 + lane];
                float sa = 0.f;
#pragma unroll
                for (int j4 = 0; j4 < 16; ++j4) { const f32x4 a4 = *(const LAS f32x4*)(aA + tt * 68 + 4 * j4);
                    sa += S[4 * j4] * a4.x; sa += S[4 * j4 + 1] * a4.y; sa += S[4 * j4 + 2] * a4.z; sa += S[4 * j4 + 3] * a4.w; }
                float y = 0.f;
#pragma unroll
                for (int j4 = 0; j4 < 16; ++j4) {
                    const f32x4 d4 = *(const LAS f32x4*)(aW + tt * 68 + 4 * j4), b4 = *(const LAS f32x4*)(aB + tt * 68 + 4 * j4);
                    const f32x4 k4 = *(const LAS f32x4*)(aK + tt * 68 + 4 * j4), r4 = *(const LAS f32x4*)(aR + tt * 68 + 4 * j4);
#pragma unroll
                    for (int jj = 0; jj < 4; ++jj) { const int j = 4 * j4 + jj; S[j] = S[j] * d4[jj] + sa * b4[jj] + vv * k4[jj]; y += S[j] * r4[jj]; } }
                aY[tt * 68 + lane] = y;
            }
#pragma unroll
            for (int j4 = 0; j4 < 16; ++j4) SL[j4 * 64 + lane] = (f32x4){S[4 * j4], S[4 * j4 + 1], S[4 * j4 + 2], S[4 * j4 + 3]};
        }
        __syncthreads();
        {
            const f32x4 yA = *(const LAS f32x4*)(aY + t * 68 + cg * 8), yB = *(const LAS f32x4*)(aY + t * 68 + cg * 8 + 4);
            const f32x4 rA = *(const LAS f32x4*)(aR + t * 68 + cg * 8), rB = *(const LAS f32x4*)(aR + t * 68 + cg * 8 + 4);
            const f32x4 kA = *(const LAS f32x4*)(aK + t * 68 + cg * 8), kB = *(const LAS f32x4*)(aK + t * 68 + cg * 8 + 4);
            const f32x4 vA = *(const LAS f32x4*)(aV + t * 68 + cg * 8), vB = *(const LAS f32x4*)(aV + t * 68 + cg * 8 + 4);
            const f32x4 gA = *(const LAS f32x4*)(aG + t * 68 + cg * 8), gB = *(const LAS f32x4*)(aG + t * 68 + cg * 8 + 4);
            const float y[8] = {yA.x, yA.y, yA.z, yA.w, yB.x, yB.y, yB.z, yB.w}, r[8] = {rA.x, rA.y, rA.z, rA.w, rB.x, rB.y, rB.z, rB.w};
            const float k[8] = {kA.x, kA.y, kA.z, kA.w, kB.x, kB.y, kB.z, kB.w}, v[8] = {vA.x, vA.y, vA.z, vA.w, vB.x, vB.y, vB.z, vB.w};
            const float g[8] = {gA.x, gA.y, gA.z, gA.w, gB.x, gB.y, gB.z, gB.w};
            float s1 = 0.f, sb = 0.f;
#pragma unroll
            for (int i = 0; i < 8; ++i) { s1 += y[i]; sb += r[i] * k[i] * p.ev_r_k[ch0 + i]; }
            red[t * 8 + cg] = s1; red[512 + t * 8 + cg] = sb;
            __syncthreads();
            float m = 0.f, bon = 0.f;
#pragma unroll
            for (int i = 0; i < 8; ++i) { m += red[t * 8 + i]; bon += red[512 + t * 8 + i]; }
            m *= (1.0f / 64.0f);
            float s2 = 0.f;
#pragma unroll
            for (int i = 0; i < 8; ++i) s2 += (y[i] - m) * (y[i] - m);
            red[1024 + t * 8 + cg] = s2;
            __syncthreads();
            float var = 0.f;
#pragma unroll
            for (int i = 0; i < 8; ++i) var += red[1024 + t * 8 + i];
            const float rs = 1.0f / sqrtf(var * (1.0f / 64.0f) + 64e-5f);
            float o[8];
#pragma unroll
            for (int i = 0; i < 8; ++i) o[i] = ((y[i] - m) * rs * p.ev_lnx_w[ch0 + i] + p.ev_lnx_b[ch0 + i] + bon * v[i]) * g[i];
            u32x4 w; w.x = pk2(o[0], o[1]); w.y = pk2(o[2], o[3]); w.z = pk2(o[4], o[5]); w.w = pk2(o[6], o[7]);
            *(u32x4*)(MIX + (tg0 + t) * 1024 + 512 + ch0) = w;
        }
        __syncthreads();
    }
}

__device__ __forceinline__ void swa_naive(const Ctx& c, const Params& p, int unit) {
    const int b = unit >> 6, g = (unit >> 5) & 1, n = unit & 31, tid = c.tid, lane = c.lane, wv = c.wave;
    LAS bf16_t* Ks = (LAS bf16_t*)c.shm;
    LAS bf16_t* Vs = (LAS bf16_t*)(c.shm + 256 * 144);
    LAS float* qf = (LAS float*)(c.shm + 256 * 144 + 256 * 128) + wv * 320;
    LAS float* pr = qf + 64;
    const bf16_t* P = (const bf16_t*)(p.ws + OFF_P); bf16_t* MIX = (bf16_t*)(p.ws + OFF_H);
    __syncthreads();
#pragma unroll 1
    for (int i = 0; i < 8; ++i) {
        const int task = tid + 512 * i, which = task >> 11, r = (task >> 3) & 255, ck = task & 7;
        const int tk = n * 128 - 128 + r;
        u32x4 d = (u32x4){0u, 0u, 0u, 0u};
        if (tk >= 0) d = *(const u32x4*)(P + ((size_t)b * SEQ + tk) * EV_IN + 512 + which * 128 + g * 64 + ck * 8);
        if (which == 0) *(LAS u32x4*)(Ks + r * 72 + ck * 8) = d; else *(LAS u32x4*)(Vs + r * 64 + ck * 8) = d;
    }
    __syncthreads();
    const int head = g * 4 + (wv >> 1);
    const float sink = p.ev_sinks[head];
#pragma unroll 1
    for (int qq = 0; qq < 64; ++qq) {
        const int qi = (wv & 1) * 64 + qq;
        const size_t tq = (size_t)b * SEQ + n * 128 + qi;
        qf[lane] = bf2f(P[tq * EV_IN + head * 64 + lane]) * 0.125f;
        LDS_WAIT();
        float s[4];
#pragma unroll
        for (int j = 0; j < 4; ++j) { const int kp = lane + 64 * j; float a = 0.f;
#pragma unroll
            for (int ck = 0; ck < 8; ++ck) { const u32x4 kk = *(const LAS u32x4*)(Ks + kp * 72 + ck * 8);
                const f32x4 q0 = *(const LAS f32x4*)(qf + ck * 8), q1 = *(const LAS f32x4*)(qf + ck * 8 + 4);
                a += bflo(kk.x) * q0.x + bfhi(kk.x) * q0.y + bflo(kk.y) * q0.z + bfhi(kk.y) * q0.w + bflo(kk.z) * q1.x + bfhi(kk.z) * q1.y + bflo(kk.w) * q1.z + bfhi(kk.w) * q1.w; }
            const bool valid = (kp >= qi + 1) && (kp <= qi + 128) && (n > 0 || kp >= 128);
            s[j] = valid ? a : -INFINITY; }
        float m = fmaxf(fmaxf(s[0], s[1]), fmaxf(s[2], s[3])); m = fmaxf(wave_max(m), sink);
        float den = 0.f;
#pragma unroll
        for (int j = 0; j < 4; ++j) { const float e = __expf(s[j] - m); pr[lane + 64 * j] = e; den += e; }
        den = wave_sum(den) + __expf(sink - m);
        LDS_WAIT();
        float o = 0.f;
#pragma unroll 8
        for (int kp = qi + 1; kp <= qi + 128; ++kp) o += pr[kp] * bf2f(Vs[kp * 64 + lane]);
        MIX[tq * 1024 + head * 64 + lane] = (bf16_t)f2bf(o / den);
    }
}
__device__ __forceinline__ void gla_naive(const Ctx& c, const Params& p, int bh) {
    const int b = bh >> 2, hd = bh & 3, tid = c.tid, lane = c.lane, wv = c.wave;
    LAS float* qs = (LAS float*)c.shm; LAS float* ks = qs + 32 * 128; LAS float* es = ks + 32 * 128; LAS float* vs = es + 32 * 128; LAS float* os = vs + 32 * 256;
    const bf16_t* P = (const bf16_t*)(p.ws + OFF_P); const float* GK = (const float*)(p.ws + OFF_R); bf16_t* MIX = (bf16_t*)(p.ws + OFF_H);
    float S[128];
#pragma unroll
    for (int j = 0; j < 128; ++j) S[j] = 0.f;
    for (int tb = 0; tb < 128; ++tb) {
        const size_t tg0 = (size_t)b * SEQ + (size_t)tb * 32;
#pragma unroll 1
        for (int i = 0; i < 8; ++i) { const int idx = tid + 512 * i, tt = idx >> 7, j = idx & 127;
            const bf16_t* row = P + (tg0 + tt) * OD_IN;
            qs[idx] = bf2f(row[hd * 128 + j]) * 0.08838834764831845f; ks[idx] = bf2f(row[512 + hd * 128 + j]); es[idx] = __expf(GK[(tg0 + tt) * 512 + hd * 128 + j]); }
#pragma unroll 1
        for (int i = 0; i < 16; ++i) { const int idx = tid + 512 * i, tt = idx >> 8, j = idx & 255; vs[idx] = bf2f(P[(tg0 + tt) * OD_IN + 1024 + hd * 256 + j]); }
        __syncthreads();
        if (wv < 4) {
#pragma unroll 1
            for (int tt = 0; tt < 32; ++tt) {
                const float vv = vs[tt * 256 + tid]; float o = 0.f;
#pragma unroll
                for (int j4 = 0; j4 < 32; ++j4) {
                    const f32x4 e4 = *(const LAS f32x4*)(es + tt * 128 + 4 * j4), k4 = *(const LAS f32x4*)(ks + tt * 128 + 4 * j4), q4 = *(const LAS f32x4*)(qs + tt * 128 + 4 * j4);
#pragma unroll
                    for (int jj = 0; jj < 4; ++jj) { const int j = 4 * j4 + jj; S[j] = S[j] * e4[jj] + k4[jj] * vv; o += q4[jj] * S[j]; } }
                os[tt * 256 + tid] = o;
            }
        }
        __syncthreads();
#pragma unroll 1
        for (int i = 0; i < 4; ++i) { const int tt = wv + 8 * i;
            const f32x4 o4 = *(const LAS f32x4*)(os + tt * 256 + 4 * lane);
            const float ss = wave_sum(o4.x * o4.x + o4.y * o4.y + o4.z * o4.z + o4.w * o4.w);
            const float rs = 1.0f / sqrtf(ss * (1.0f / 256.0f) + 1e-6f);
            const f32x4 gn = *(const f32x4*)(p.od_onorm + 4 * lane);
            const u32x2 og = *(const u32x2*)(P + (tg0 + tt) * OD_IN + 2048 + hd * 256 + 4 * lane);
            const float g0 = bflo(og.x), g1 = bfhi(og.x), g2 = bflo(og.y), g3 = bfhi(og.y);
            u32x2 w; w.x = pk2(o4.x * rs * gn.x * g0 * sigmoidf_(g0), o4.y * rs * gn.y * g1 * sigmoidf_(g1)); w.y = pk2(o4.z * rs * gn.z * g2 * sigmoidf_(g2), o4.w * rs * gn.w * g3 * sigmoidf_(g3));
            *(u32x2*)(MIX + (tg0 + tt) * 1024 + hd * 256 + 4 * lane) = w; }
        __syncthreads();
    }
}

__device__ __forceinline__ void xattn_naive(const Ctx& c, const Params& p, int unit) {
    const int b = unit >> 5, hh = (unit >> 3) & 3, tblk = unit & 7, tid = c.tid, lane = c.lane, wv = c.wave;
    LAS bf16_t* Ks = (LAS bf16_t*)c.shm;
    LAS bf16_t* Vs = (LAS bf16_t*)(c.shm + 256 * 272);
    LAS float* qf = (LAS float*)(c.shm + 256 * 272 + 256 * 256) + wv * 384;
    LAS float* pr = qf + 128;
    const bf16_t* MKV = (const bf16_t*)(p.ws + OFF_MKV); const bf16_t* Q = (const bf16_t*)(p.ws + OFF_P); bf16_t* OA = (bf16_t*)(p.ws + OFF_P + 32 * MiB);
    __syncthreads();
#pragma unroll 1
    for (int i = 0; i < 16; ++i) {
        const int task = tid + 512 * i, which = task >> 12, r = (task >> 4) & 255, ck = task & 15;
        const u32x4 d = *(const u32x4*)(MKV + ((size_t)b * MEMLEN + r) * 1024 + which * 512 + hh * 128 + ck * 8);
        if (which == 0) *(LAS u32x4*)(Ks + r * 136 + ck * 8) = d; else *(LAS u32x4*)(Vs + r * 128 + ck * 8) = d;
    }
    __syncthreads();
#pragma unroll 1
    for (int qq = 0; qq < 64; ++qq) {
        const size_t tq = (size_t)b * SEQ + tblk * 512 + wv * 64 + qq;
        qf[lane] = bf2f(Q[tq * 512 + hh * 128 + lane]) * 0.08838834764831845f; qf[lane + 64] = bf2f(Q[tq * 512 + hh * 128 + 64 + lane]) * 0.08838834764831845f;
        LDS_WAIT();
        float s[4];
#pragma unroll
        for (int j = 0; j < 4; ++j) { const int kp = lane + 64 * j; float a = 0.f;
#pragma unroll
            for (int ck = 0; ck < 16; ++ck) { const u32x4 kk = *(const LAS u32x4*)(Ks + kp * 136 + ck * 8);
                const f32x4 q0 = *(const LAS f32x4*)(qf + ck * 8), q1 = *(const LAS f32x4*)(qf + ck * 8 + 4);
                a += bflo(kk.x) * q0.x + bfhi(kk.x) * q0.y + bflo(kk.y) * q0.z + bfhi(kk.y) * q0.w + bflo(kk.z) * q1.x + bfhi(kk.z) * q1.y + bflo(kk.w) * q1.z + bfhi(kk.w) * q1.w; }
            s[j] = a; }
        const float m = wave_max(fmaxf(fmaxf(s[0], s[1]), fmaxf(s[2], s[3])));
        float den = 0.f;
#pragma unroll
        for (int j = 0; j < 4; ++j) { const float e = __expf(s[j] - m); pr[lane + 64 * j] = e; den += e; }
        den = wave_sum(den);
        LDS_WAIT();
        float o0 = 0.f, o1 = 0.f;
#pragma unroll 4
        for (int k4 = 0; k4 < 64; ++k4) { const f32x4 p4 = *(const LAS f32x4*)(pr + 4 * k4);
#pragma unroll
            for (int kk = 0; kk < 4; ++kk) { const unsigned vv = *(const LAS unsigned*)(Vs + (4 * k4 + kk) * 128 + 2 * lane); o0 += p4[kk] * bflo(vv); o1 += p4[kk] * bfhi(vv); } }
        const float inv = 1.0f / den;
        *(unsigned*)(OA + tq * 512 + hh * 128 + 2 * lane) = pk2(o0 * inv, o1 * inv);
    }
}

__device__ __forceinline__ void moe_slots(const Ctx& c, const Params& p, int layer) {
    LAS int* sh = (LAS int*)c.shm;
    const int* cnt = (const int*)(p.ws + OFF_CTL + CTL_CNT) + layer * 32; int* cur = (int*)(p.ws + OFF_CTL + CTL_CUR) + layer * 32;
    int* blk = (int*)(p.ws + OFF_CTL + CTL_BLK) + layer * 1024;
    __syncthreads();
    if (c.tid == 0) { int acc = 0; for (int e = 0; e < NEXP; ++e) { sh[e] = acc; acc += (cnt[e] + 255) / 256 * 256; } sh[32] = acc; }
    __syncthreads();
    if (blockIdx.x == 0 && c.tid < NEXP) { const int e = c.tid, s = sh[e] / 256, en = (e == NEXP - 1 ? sh[32] : sh[e + 1]) / 256; for (int i = s; i < en; ++i) blk[1 + i] = e; if (e == 0) blk[0] = sh[32] / 256; }
    const int2* RE = (const int2*)(p.ws + OFF_ROUTE); int2* RP = (int2*)(p.ws + OFF_ROUTE + 512 * 1024);
    const bf16_t* H = (const bf16_t*)(p.ws + OFF_H); bf16_t* XB = (bf16_t*)(p.ws + OFF_P);
    for (int ck = c.gw; ck < T_TOK / 64; ck += c.ngw) {
        const int t = ck * 64 + c.lane; const int2 ee = RE[t]; int pos0 = 0, pos1 = 0;
#pragma unroll 1
        for (int e = 0; e < NEXP; ++e) {
            const unsigned long long m0 = __ballot(ee.x == e), m1 = __ballot(ee.y == e);
            const int n0 = __popcll(m0), n1 = __popcll(m1);
            if (n0 + n1 == 0) continue;
            int base = 0; if (c.lane == 0) base = atomicAdd(&cur[e], n0 + n1);
            base = __shfl(base, 0) + sh[e];
            const unsigned long long lt = (1ull << c.lane) - 1ull;
            if (ee.x == e) pos0 = base + __popcll(m0 & lt);
            if (ee.y == e) pos1 = base + n0 + __popcll(m1 & lt);
        }
        RP[t] = make_int2(pos0, pos1);
#pragma unroll 1
        for (int i = 0; i < 64; ++i) { const int ti = ck * 64 + i, q0 = __shfl(pos0, i), q1 = __shfl(pos1, i);
            const u32x4 a = *((const u32x4*)(H + (size_t)ti * 1024) + c.lane), bq = *((const u32x4*)(H + (size_t)ti * 1024) + 64 + c.lane);
            *((u32x4*)(XB + (size_t)q0 * 1024) + c.lane) = a; *((u32x4*)(XB + (size_t)q0 * 1024) + 64 + c.lane) = bq;
            *((u32x4*)(XB + (size_t)q1 * 1024) + c.lane) = a; *((u32x4*)(XB + (size_t)q1 * 1024) + 64 + c.lane) = bq; }
    }
}
constexpr int LDS_BYTES = 160 * 1024 - 64;
constexpr int N_PHASES = 25;

typedef const __attribute__((address_space(4))) Params* KParamsPtr;
__device__ __forceinline__ Params kparams() {
#if defined(__HIP_DEVICE_COMPILE__)
    KParamsPtr k = (KParamsPtr)__builtin_amdgcn_kernarg_segment_ptr(); asm volatile("" : "+s"(k)); return *k;
#else
    return Params{};
#endif
}
__device__ __forceinline__ Ctx mkctx(unsigned char* shm) {
    int tz = threadIdx.x; asm volatile("" : "+v"(tz));
    Ctx c; c.tid = tz; c.wave = __builtin_amdgcn_readfirstlane(tz >> 6); c.lane = tz & 63; c.gw = blockIdx.x * 8 + c.wave; c.ngw = gridDim.x * 8; c.shm = shm; return c;
}
__global__ void __launch_bounds__(512, 2) hybrid_fwd(Params p_in) {
    extern __shared__ __attribute__((aligned(16))) unsigned char shm[];
    const int G = gridDim.x, bid = blockIdx.x;
    uint4* xbw = (uint4*)(shm + LDS_BYTES - 16);
    if (threadIdx.x == 0) *xbw = make_uint4(0u, 0u, 0u, 0u);
    __syncthreads();
    XcdBarrier bar = xcd_barrier_post((unsigned*)(kparams().ws + OFF_CTL), (volatile LAS unsigned*)xbw);
    const int lo = p_in.ph_lo, hi = p_in.ph_hi;
#ifndef KEEPMASK
#define KEEPMASK 0xFFFFFFFFu
#endif
#define IN(k) (lo <= (k) && (k) < hi)
#define INS(k, s) ((((KEEPMASK) >> (s)) & 1u) && IN(k))
#define SEAM(k) do { if ((k) + 1 < hi) { XcdBarrier b2 = bar; b2.bar = (unsigned*)(kparams().ws + OFF_CTL); xcd_barrier(b2); } } while (0)
#define PHASE_BEGIN const Params p = kparams(); const Ctx c = mkctx(shm); unsigned char* const ws = p.ws; (void)c; (void)ws;
#define glds ((PG8_LAS unsigned char*)shm)
#define WD ((bf16_t*)(ws + OFF_WD))
#define H ((bf16_t*)(ws + OFF_H))
#define P ((bf16_t*)(ws + OFF_P))
#define WS_F ((float*)(ws + OFF_WSMALL))
#define RE ((int2*)(ws + OFF_ROUTE))
#define RG ((float2*)(ws + OFF_ROUTE + 256 * 1024))
#define RP ((int2*)(ws + OFF_ROUTE + 512 * 1024))

    for (int layer = 0; layer < 2; ++layer) {
        const int pb = layer * 12;
        if (layer == 0) {
            if (INS(0, 0)) { PHASE_BEGIN
                tr_matrix(c, p.ev_w_in, EV_IN, 0, 1024, EV_IN, WD + WE_EV_IN, 0, 0);
                tr_matrix(c, p.ev_w_out, 1024, 0, 1024, 1024, WD + WE_EV_OUT, 0, 0);
                tr_matrix(c, p.od_w_in, OD_IN_SRC, 0, 1024, OD_IN, WD + WE_OD_IN, 0, 1);
                tr_matrix(c, p.od_w_out, 1024, 0, 1024, 1024, WD + WE_OD_OUT, 0, 0);
                tr_matrix(c, p.mem_wk, 512, 0, 1024, 512, WD + WE_MKV, 0, 0);
                tr_matrix(c, p.mem_wv, 512, 0, 1024, 512, WD + WE_MKV, 512, 0);
                for (int l = 0; l < 2; ++l) {
                    tr_matrix(c, p.xa_wq + (size_t)l * 1024 * 512, 512, 0, 1024, 512, WD + WE_WQ + (size_t)l * 512 * 1024, 0, 0);
                    tr_matrix(c, p.xa_wo + (size_t)l * 512 * 1024, 1024, 0, 512, 1024, WD + WE_WO + (size_t)l * 1024 * 512, 0, 0);
                }
                tr_moe_layer(c, p, 0);
                for (int i = bid * 512 + c.tid; i < 2 * 36 * 1024 + 16 * 1024; i += G * 512) {
                    if (i < 2 * 36 * 1024) { const int l = i / (36 * 1024), r = i % (36 * 1024), o = r >> 10, k = r & 1023;
                        WS_F[i] = o < 4 ? p.moe_w_group[((size_t)l * 1024 + k) * 4 + o] : p.moe_w_expert[((size_t)l * 1024 + k) * 32 + (o - 4)]; }
                    else { const int r = i - 2 * 36 * 1024, o = r >> 10, k = r & 1023; WS_F[i] = p.od_w_in[(size_t)k * OD_IN_SRC + 2048 + o]; }
                }
                norm_plain(c, p.mem, p.mem_norm, (bf16_t*)(ws + OFF_R), NB * MEMLEN);
                norm_plain(c, p.x, p.norm_mix, H, T_TOK);
                __syncthreads();
                SEAM(0);
            }
            if (INS(1, 1)) { PHASE_BEGIN
                { pg8::Gemm g{H, WD + WE_EV_IN, T_TOK, EV_IN, 1024, 0}; pg8::StaticOrder S; S.init(T_TOK, EV_IN, G, bid);
                  pg8::EpiB16 E{P, EV_IN}; pg8::gemm_phase<pg8::EpiB16, pg8::StaticOrder, true, true>(glds, g, S, E); }
                SEAM(1);
            }
            if (INS(2, 2)) { PHASE_BEGIN
#ifndef NO_RWKV
                if (bid < 64) rwkv_naive(c, p, bid);
                else
#endif
                {
#ifndef NO_SWA
                    for (int u = bid - 64; u < 512; u += G - 64) swa_naive(c, p, u);
#endif
                    __syncthreads();
#ifndef NO_MKV
                    if (bid < 96) {
                        pg8::Gemm g{(const bf16_t*)(ws + OFF_R), WD + WE_MKV, NB * MEMLEN, 1024, 1024, 0}; pg8::StaticOrder S; S.init(NB * MEMLEN, 1024, 32, bid - 64);
                        pg8::EpiB16 E{(bf16_t*)(ws + OFF_MKV), 1024}; pg8::gemm_phase<pg8::EpiB16, pg8::StaticOrder, true, true>(glds, g, S, E); }
#endif
                }
                __syncthreads();
                SEAM(2);
            }
        } else {
            if (INS(12, 12)) { PHASE_BEGIN
                const bf16_t* YB = P; const float* gdT = WS_F + 2 * 36 * 1024; float* GK = (float*)(ws + OFF_R);
                for (int r = c.gw; r < T_TOK; r += c.ngw) {
                    f32x4 v[4]; row_load(p.out + (size_t)r * 1024, c.lane, v);
                    const int2 ps = RP[r]; const float2 gt = RG[r];
                    row_combine(v, YB, ps.x, ps.y, gt.x, gt.y, c.lane);
                    row_store_f32(p.out + (size_t)r * 1024, c.lane, v);
                    const float rs = row_rstd(v); row_scale(v, rs, p.norm_mix + 1024, c.lane); row_store_bf16(H + (size_t)r * 1024, c.lane, v);
                    LAS float* gd = (LAS float*)shm + c.wave * 64; row_logits(v, gdT, c.lane, 16, gd);
                    float acc[8];
#pragma unroll
                    for (int i = 0; i < 8; ++i) acc[i] = p.od_gate_b[8 * c.lane + i];
#pragma unroll
                    for (int j = 0; j < 16; ++j) { const f32x4 u0 = *(const f32x4*)(p.od_gate_up + j * 512 + 8 * c.lane), u1 = *(const f32x4*)(p.od_gate_up + j * 512 + 8 * c.lane + 4);
                        acc[0] += gd[j] * u0.x; acc[1] += gd[j] * u0.y; acc[2] += gd[j] * u0.z; acc[3] += gd[j] * u0.w; acc[4] += gd[j] * u1.x; acc[5] += gd[j] * u1.y; acc[6] += gd[j] * u1.z; acc[7] += gd[j] * u1.w; }
#pragma unroll
                    for (int i = 0; i < 8; ++i) { const float xx = acc[i]; acc[i] = (fminf(xx, 0.f) - log1pf(__expf(-fabsf(xx)))) * (1.0f / 16.0f); }
                    *(f32x4*)(GK + (size_t)r * 512 + 8 * c.lane) = (f32x4){acc[0], acc[1], acc[2], acc[3]}; *(f32x4*)(GK + (size_t)r * 512 + 8 * c.lane + 4) = (f32x4){acc[4], acc[5], acc[6], acc[7]};
                }
                tr_moe_layer(c, p, 1);
                __syncthreads();
                SEAM(12);
            }
            if (INS(13, 13)) { PHASE_BEGIN
                pg8::Gemm g{H, WD + WE_OD_IN, T_TOK, OD_IN, 1024, 0}; pg8::StaticOrder S; S.init(T_TOK, OD_IN, G, bid);
                pg8::EpiB16 E{P, OD_IN}; pg8::gemm_phase<pg8::EpiB16, pg8::StaticOrder, true, true>(glds, g, S, E);
                SEAM(13);
            }
            if (INS(14, 14)) { PHASE_BEGIN
                if (bid < 32) gla_naive(c, p, bid);
                __syncthreads();
                SEAM(14);
            }
        }
        if (INS(pb + 3, 3)) { PHASE_BEGIN
            pg8::Gemm g{H, WD + (layer == 0 ? WE_EV_OUT : WE_OD_OUT), T_TOK, 1024, 1024, 0}; pg8::StaticOrder S; S.init(T_TOK, 1024, G, bid);
            pg8::EpiRes E{layer == 0 ? p.x : p.out, p.out, 1024}; pg8::gemm_phase<pg8::EpiRes, pg8::StaticOrder, true, true>(glds, g, S, E);
            SEAM(pb + 3);
        }
        if (INS(pb + 4, 4)) { PHASE_BEGIN norm_plain(c, p.out, p.norm_xattn + layer * 1024, H, T_TOK); __syncthreads(); SEAM(pb + 4); }
        if (INS(pb + 5, 5)) { PHASE_BEGIN
            pg8::Gemm g{H, WD + WE_WQ + (size_t)layer * 512 * 1024, T_TOK, 512, 1024, 0}; pg8::StaticOrder S; S.init(T_TOK, 512, G, bid);
            pg8::EpiB16 E{P, 512}; pg8::gemm_phase<pg8::EpiB16, pg8::StaticOrder, true, true>(glds, g, S, E);
            SEAM(pb + 5);
        }
        if (INS(pb + 6, 6)) { PHASE_BEGIN for (int u = bid; u < 256; u += G) xattn_naive(c, p, u); __syncthreads(); SEAM(pb + 6); }
        if (INS(pb + 7, 7)) { PHASE_BEGIN
            pg8::Gemm g{(const bf16_t*)(ws + OFF_P + 32 * MiB), WD + WE_WO + (size_t)layer * 1024 * 512, T_TOK, 1024, 512, 0}; pg8::StaticOrder S; S.init(T_TOK, 1024, G, bid);
            pg8::EpiRes E{p.out, p.out, 1024}; pg8::gemm_phase<pg8::EpiRes, pg8::StaticOrder, true, true>(glds, g, S, E);
            SEAM(pb + 7);
        }
        if (INS(pb + 8, 8)) { PHASE_BEGIN
            const float* wT = WS_F + (size_t)layer * 36 * 1024; int* cnt = (int*)(ws + OFF_CTL + CTL_CNT) + layer * 32;
            for (int r = c.gw; r < T_TOK; r += c.ngw) {
                f32x4 v[4]; row_load(p.out + (size_t)r * 1024, c.lane, v);
                const float rs = row_rstd(v); row_scale(v, rs, p.norm_moe + layer * 1024, c.lane); row_store_bf16(H + (size_t)r * 1024, c.lane, v);
                LAS float* lg = (LAS float*)shm + c.wave * 64; row_logits(v, wT, c.lane, 36, lg);
                int e0, e1; float g0, g1; route_row(lg, p.moe_b_group + layer * 4, p.moe_b_expert + layer * 32, e0, e1, g0, g1);
                if (c.lane == 0) { RE[r] = make_int2(e0, e1); RG[r] = make_float2(g0, g1); atomicAdd(&cnt[e0], 1); atomicAdd(&cnt[e1], 1); }
            }
            __syncthreads();
            SEAM(pb + 8);
        }
        if (INS(pb + 9, 9)) { PHASE_BEGIN moe_slots(c, p, layer); __syncthreads(); SEAM(pb + 9); }
        if (INS(pb + 10, 10)) { PHASE_BEGIN
            const int* blk = (const int*)(ws + OFF_CTL + CTL_BLK) + layer * 1024; const int nblk = blk[0];
            pg8::Gemm g{P, (const bf16_t*)(ws + OFF_WMOE), nblk * 256, 1024, 1024, (size_t)1024 * 1024 * 2}; pg8::MoeOrder S{blk + 1, nblk * 4, 4, G, bid};
            pg8::EpiSwiglu E{(bf16_t*)(ws + OFF_R), 512}; pg8::gemm_phase<pg8::EpiSwiglu, pg8::MoeOrder, true, true>(glds, g, S, E);
            SEAM(pb + 10);
        }
        if (INS(pb + 11, 11)) { PHASE_BEGIN
            const int* blk = (const int*)(ws + OFF_CTL + CTL_BLK) + layer * 1024; const int nblk = blk[0];
            pg8::Gemm g{(const bf16_t*)(ws + OFF_R), (const bf16_t*)(ws + OFF_WMOE + 64 * MiB), nblk * 256, 1024, 512, (size_t)1024 * 512 * 2}; pg8::MoeOrder S{blk + 1, nblk * 4, 4, G, bid};
            pg8::EpiB16 E{P, 1024}; pg8::gemm_phase<pg8::EpiB16, pg8::MoeOrder, true, true>(glds, g, S, E);
            SEAM(pb + 11);
        }
    }
    if (INS(24, 15)) { PHASE_BEGIN
        for (int r = c.gw; r < T_TOK; r += c.ngw) {
            f32x4 v[4]; row_load(p.out + (size_t)r * 1024, c.lane, v);
            const int2 ps = RP[r]; const float2 gt = RG[r];
            row_combine(v, P, ps.x, ps.y, gt.x, gt.y, c.lane);
            const float rs = row_rstd(v); row_scale(v, rs, p.norm_final, c.lane); row_store_f32(p.out + (size_t)r * 1024, c.lane, v);
        }
    }
}

extern "C" void kernel_launch(void* const* d_in, const int* in_sizes, int n_in, void* d_out, int out_size, void* d_ws, size_t ws_size, hipStream_t stream) {
    static int ready = 0;
    if (ready == 0) {
        if (n_in != 37 || out_size != T_TOK * DM || ws_size < WS_NEED) { fprintf(stderr, "kernel_launch: unexpected problem (n_in %d, out %d, ws %zu)\n", n_in, out_size, ws_size); ready = -1; return; }
        if (hipFuncSetAttribute((const void*)hybrid_fwd, hipFuncAttributeMaxDynamicSharedMemorySize, LDS_BYTES) != hipSuccess) { fprintf(stderr, "kernel_launch: hipFuncSetAttribute failed\n"); ready = -1; return; }
        ready = 1;
    }
    if (ready < 0) return;
    hipMemsetAsync((char*)d_ws + OFF_CTL, 0, CTL_ZERO_BYTES, stream);
    Params p{};
    const float** f = (const float**)&p;
    for (int i = 0; i < 37; ++i) f[i] = (const float*)d_in[i];
    p.out = (float*)d_out; p.ws = (unsigned char*)d_ws; p.ph_lo = 0; p.ph_hi = N_PHASES;
    hipLaunchKernelGGL(hybrid_fwd, dim3(256), dim3(512), LDS_BYTES, stream, p);
}
```

```cpp
#include <hip/hip_runtime.h>
#include <cstdint>
#include <cstdio>

#define LAS __attribute__((address_space(3)))
typedef unsigned short bf16_t;
typedef float f32x4 __attribute__((ext_vector_type(4)));
typedef float f32x2 __attribute__((ext_vector_type(2)));
typedef unsigned u32x4 __attribute__((ext_vector_type(4)));
typedef unsigned u32x2 __attribute__((ext_vector_type(2)));

constexpr int T_TOK = 32768, DM = 1024, SEQ = 4096, NB = 8, MEMLEN = 256;
constexpr int EV_IN = 2560, OD_IN = 3072  , OD_IN_SRC = 3088;
constexpr int NEXP = 32, MOE_FF = 512, PMAX = 65536 + NEXP * 256;

constexpr size_t MiB = 1024 * 1024;
constexpr size_t OFF_CTL = 0;
constexpr size_t CTL_ZERO_BYTES = 64 * 1024;
constexpr size_t CTL_CNT = 16384;
constexpr size_t CTL_CUR = 16384 + 1024;
constexpr size_t CTL_BLK = 128 * 1024;
constexpr size_t OFF_ROUTE = 1 * MiB;
constexpr size_t OFF_WSMALL = 2 * MiB;
constexpr size_t OFF_MKV = 3 * MiB;
constexpr size_t OFF_WD = 7 * MiB;
constexpr size_t OFF_WMOE = 28 * MiB;
constexpr size_t OFF_H = 124 * MiB;
constexpr size_t OFF_P = 188 * MiB;
constexpr size_t OFF_R = 380 * MiB;
constexpr size_t WS_NEED = 452 * MiB;
constexpr size_t WE_EV_IN = 0, WE_EV_OUT = 2560ull * 1024, WE_OD_IN = 3584ull * 1024, WE_OD_OUT = 6656ull * 1024, WE_MKV = 7680ull * 1024, WE_WQ = 8704ull * 1024, WE_WO = 9728ull * 1024;

struct Params {
    const float *x, *mem, *norm_mix, *norm_xattn, *norm_moe, *norm_final;
    const float *ev_w_in, *ev_sinks, *ev_mu, *ev_w0, *ev_w2, *ev_a0, *ev_a2, *ev_g2, *ev_k_k, *ev_k_a, *ev_r_k, *ev_lnx_w, *ev_lnx_b, *ev_w_out;
    const float *od_w_in, *od_gate_up, *od_gate_b, *od_onorm, *od_w_out;
    const float *mem_norm, *mem_wk, *mem_wv, *xa_wq, *xa_wo;
    const float *moe_w_group, *moe_b_group, *moe_w_expert, *moe_b_expert, *moe_w1, *moe_w3, *moe_w2;
    float* out; unsigned char* ws; int ph_lo, ph_hi;
};

#define XB_TMO      128
#define XB_XCNT(j)  (256  + 64 * (j))
#define XB_XSUB(j)  (1280 + 64 * (j))
#define XB_XGEN(j)  (2304 + 64 * (j))
#define XB_TOP      3328
#define XB_TOPGEN   3392
#define XCD_BAR_WORDS 3456
#define XB_SPIN_CAP (1u << 18)
#define LAS __attribute__((address_space(3)))

__device__ __forceinline__ unsigned xb_ld(unsigned* p)              { return __hip_atomic_load(p, __ATOMIC_RELAXED, __HIP_MEMORY_SCOPE_AGENT); }
__device__ __forceinline__ unsigned xb_add(unsigned* p, unsigned v) { return __hip_atomic_fetch_add(p, v, __ATOMIC_RELAXED, __HIP_MEMORY_SCOPE_AGENT); }
__device__ __forceinline__ unsigned xb_xcc_id() { return (unsigned)__builtin_amdgcn_s_getreg((3 << 11) | 20) & 0xFu; }
#define XB_SPIN(cond, bar) do { unsigned _sp = 0; while (cond) { __builtin_amdgcn_s_sleep(1); \
    if ((++_sp & 255u) == 0u) { if (xb_ld(&(bar)[XB_TMO])) break; if (_sp > XB_SPIN_CAP) { atomicAdd(&(bar)[XB_TMO], 1u); break; } } } } while (0)

struct XcdBarrier {
    unsigned* bar; unsigned x;
    volatile LAS unsigned* st;
};

__device__ __forceinline__ XcdBarrier xcd_barrier_post(unsigned* bar, volatile LAS unsigned* st) {
    XcdBarrier b; b.bar = bar; b.x = xb_xcc_id(); b.st = st;
    if (threadIdx.x == 0) (void)xb_add(&bar[XB_XCNT(b.x)], 1u);
    return b;
}
__device__ __forceinline__ void xcd_barrier_complete(unsigned* bar, unsigned x, unsigned& nloc, unsigned& nx) {
    const unsigned G = gridDim.x * gridDim.y * gridDim.z;
    unsigned sum, cnt, mine, sp = 0u;
    for (;;) {
        sum = 0u; cnt = 0u; mine = 0u;
#pragma unroll
        for (unsigned j = 0; j < 16; ++j) { const unsigned c = xb_ld(&bar[XB_XCNT(j)]); sum += c; cnt += (c > 0u) ? 1u : 0u; mine = (j == x) ? c : mine; }
        if (sum == G) break;
        __builtin_amdgcn_s_sleep(1);
        if ((++sp & 255u) == 0u) { if (xb_ld(&bar[XB_TMO])) break; if (sp > XB_SPIN_CAP) { atomicAdd(&bar[XB_TMO], 1u); break; } }
    }
    nloc = mine > 0u ? mine : 1u; nx = cnt > 0u ? cnt : 1u;
}

__device__ __forceinline__ void xcd_barrier(const XcdBarrier& b) {
    asm volatile("s_waitcnt vmcnt(0)" ::: "memory");
    __syncthreads();
    if (threadIdx.x == 0) {
        unsigned* bar = b.bar;
        __builtin_amdgcn_s_waitcnt(0);
        unsigned nloc = b.st[0], nx = b.st[1];
        if (nloc == 0u) { xcd_barrier_complete(bar, b.x, nloc, nx); b.st[0] = nloc; b.st[1] = nx; }
        const unsigned old = xb_add(&bar[XB_XSUB(b.x)], 1u);
        const unsigned gen = old / nloc;
        if (old + 1u == (gen + 1u) * nloc) {
            __builtin_amdgcn_fence(__ATOMIC_RELEASE, "agent");
            asm volatile("s_waitcnt vmcnt(0)" ::: "memory");
            const unsigned og = xb_add(&bar[XB_TOP], 1u);
            const unsigned tg = og / nx;
            if (og + 1u == (tg + 1u) * nx) xb_add(&bar[XB_TOPGEN], 1u);
            else XB_SPIN(xb_ld(&bar[XB_TOPGEN]) == tg, bar);
            __builtin_amdgcn_fence(__ATOMIC_ACQUIRE, "agent");
            xb_add(&bar[XB_XGEN(b.x)], 1u);
            asm volatile("s_waitcnt vmcnt(0)" ::: "memory");
        } else {
            XB_SPIN(xb_ld(&bar[XB_XGEN(b.x)]) == gen, bar);
            __builtin_amdgcn_fence(__ATOMIC_ACQUIRE, "agent");
            asm volatile("s_waitcnt vmcnt(0)" ::: "memory");
        }
    }
    __syncthreads();
}
namespace pg8 {
#define PG8_LAS __attribute__((address_space(3)))
typedef unsigned short bf16_t;
typedef short bf16x8 __attribute__((ext_vector_type(8)));
typedef float f32x4 __attribute__((ext_vector_type(4)));
typedef unsigned u32x4 __attribute__((ext_vector_type(4)));
constexpr int BM = 256, BK = 64, HALF = 128, HTB = HALF * BK * 2  , STAGE_BYTES = 8 * HTB, NXCD = 8, WGM = 8;

__host__ __device__ __forceinline__ int lds_byte(int r, int c) { const int st = (r >> 4) * 2 + (c >> 5), rr = r & 15, cc = c & 31, ob = rr * 64 + cc * 2; return st * 1024 + (ob ^ (((ob >> 9) & 1) << 5)); }
__host__ __device__ __forceinline__ void stage_rc(int b, int& R, int& C) { const int st = b / 1024, sb = b % 1024, swz = sb ^ (((sb >> 9) & 1) << 5); R = (st >> 1) * 16 + swz / 64; C = (st & 1) * 32 + (swz % 64) / 2; }
__host__ __device__ __forceinline__ int perm32(int rho) { const int n = rho >> 4, i = rho & 15; return 8 * (i >> 2) + 4 * n + (i & 3); }

struct Unit { int pm, pn, e; };
struct Gemm { const bf16_t* A; const bf16_t* Bt; int M, N, K; size_t bexp; };

struct StaticOrder {
    int nM, nN, nwg, G, c;
    __host__ __device__ void init(int M, int N, int G_, int c_) { nM = M / BM; nN = N / BM; nwg = nM * nN; G = G_; c = c_; }
    __host__ __device__ bool next(int i, Unit& u) const {
        const long L = (long)i * G + c; if (L >= nwg) return false;
        int wgid = (int)L; { const int q = nwg / NXCD, r = nwg % NXCD, xcd = wgid % NXCD, off = wgid / NXCD; wgid = (xcd < r ? xcd * (q + 1) : r * (q + 1) + (xcd - r) * q) + off; }
        const int nig = WGM * nN, gid = wgid / nig, fm = gid * WGM, gsz = (nM - fm) < WGM ? (nM - fm) : WGM;
        u.pm = fm + ((wgid % nig) % gsz); u.pn = (wgid % nig) / gsz; u.e = 0; return true;
    }
    __device__ __forceinline__ void a_ready(const Unit&) const {}
    __device__ __forceinline__ void done(const Unit&) const {}
};
__device__ __forceinline__ unsigned cvt_pk_bf16(float lo, float hi) { unsigned r; asm volatile("v_cvt_pk_bf16_f32 %0, %1, %2" : "=v"(r) : "v"(lo), "v"(hi)); return r; }

struct EpiB16 {
    static constexpr bool PERM = true, AFTER_DRAIN = false;
    bf16_t* O; int ldc;
    __device__ __forceinline__ void operator()(const f32x4 (&acc)[2][2][4][2], const Unit& u, int wr, int wc, int fr, int fq) const {
        const int row0 = u.pm * BM + wr * 64 + fr, col0 = u.pn * BM + wc * 32 + 8 * fq;
#pragma unroll
        for (int ai = 0; ai < 2; ++ai)
#pragma unroll
            for (int m = 0; m < 4; ++m) { bf16_t* rowp = O + (size_t)(row0 + ai * HALF + m * 16) * ldc + col0;
#pragma unroll
                for (int bj = 0; bj < 2; ++bj) { const f32x4 v0 = acc[ai][bj][m][0], v1 = acc[ai][bj][m][1];
                    u32x4 w; w.x = cvt_pk_bf16(v0[0], v0[1]); w.y = cvt_pk_bf16(v0[2], v0[3]); w.z = cvt_pk_bf16(v1[0], v1[1]); w.w = cvt_pk_bf16(v1[2], v1[3]);
                    *(u32x4*)(rowp + bj * HALF) = w; } }
    }
};
struct EpiRes {
    static constexpr bool PERM = false, AFTER_DRAIN = false;
    const float* base; float* out; int ldc;
    __device__ __forceinline__ void operator()(const f32x4 (&acc)[2][2][4][2], const Unit& u, int wr, int wc, int fr, int fq) const {
        const int row0 = u.pm * BM + wr * 64 + fr, col0 = u.pn * BM + wc * 32 + 4 * fq;
#pragma unroll
        for (int ai = 0; ai < 2; ++ai)
#pragma unroll
            for (int m = 0; m < 4; ++m) { const size_t off = (size_t)(row0 + ai * HALF + m * 16) * ldc + col0;
#pragma unroll
                for (int bj = 0; bj < 2; ++bj)
#pragma unroll
                    for (int n = 0; n < 2; ++n) { const f32x4 bs = *(const f32x4*)(base + off + bj * HALF + n * 16); *(f32x4*)(out + off + bj * HALF + n * 16) = bs + acc[ai][bj][m][n]; } }
    }
};
struct EpiSwiglu {
    static constexpr bool PERM = true, AFTER_DRAIN = false;
    bf16_t* O; int ldc;
    __device__ __forceinline__ void operator()(const f32x4 (&acc)[2][2][4][2], const Unit& u, int wr, int wc, int fr, int fq) const {
        const int row0 = u.pm * BM + wr * 64 + fr, col0 = (u.pn * BM + wc * 32 + 8 * fq) >> 1;
        typedef unsigned u32x2v __attribute__((ext_vector_type(2)));
#pragma unroll
        for (int ai = 0; ai < 2; ++ai)
#pragma unroll
            for (int m = 0; m < 4; ++m) { bf16_t* rowp = O + (size_t)(row0 + ai * HALF + m * 16) * ldc + col0;
#pragma unroll
                for (int bj = 0; bj < 2; ++bj) { const f32x4 a = acc[ai][bj][m][0], b = acc[ai][bj][m][1]; float h[4];
#pragma unroll
                    for (int i = 0; i < 4; ++i) h[i] = a[i] * __builtin_amdgcn_rcpf(1.0f + __expf(-a[i])) * b[i];
                    u32x2v w; w.x = cvt_pk_bf16(h[0], h[1]); w.y = cvt_pk_bf16(h[2], h[3]);
                    *(u32x2v*)(rowp + bj * (HALF / 2)) = w; } }
    }
};
struct MoeOrder {
    const int* blk_e; int nunits, nN, G, c;
    __device__ __forceinline__ bool next(int i, Unit& u) const {
        const long L = (long)i * G + c; if (L >= nunits) return false;
        u.pm = (int)(L / nN); u.pn = (int)(L % nN); u.e = blk_e[u.pm]; return true;
    }
    __device__ __forceinline__ void a_ready(const Unit&) const {}
    __device__ __forceinline__ void done(const Unit&) const {}
};
template <class Epi, class Sched, bool ALIGN_EPI = false, bool SP2 = false>
__device__ __forceinline__ void gemm_phase(PG8_LAS unsigned char* lds, const Gemm g, const Sched& S, const Epi& E) {
    int tid_ = threadIdx.x; asm volatile("" : "+v"(tid_));
    const int tid = tid_, wid = __builtin_amdgcn_readfirstlane(tid >> 6), lane = tid & 63, wr = wid >> 2, wc = wid & 3, fr = lane & 15, fq = lane >> 4;
    const int K = g.K, nt = K / BK;
    unsigned voffA[2], voffB[2];
#pragma unroll
    for (int i = 0; i < 2; ++i) { int R, C; stage_rc(tid * 16 + i * 8192, R, C); const int Rb = Epi::PERM ? ((R & ~31) + perm32(R & 31)) : R;
        voffA[i] = (unsigned)(R * K + C) * 2u; voffB[i] = (unsigned)(Rb * K + C) * 2u; }
    const size_t kstep = (size_t)(BK * 2);
    const size_t hstep = (size_t)HALF * K * 2;
    const size_t tstep = 2 * hstep;
    const unsigned ldsw = (unsigned)wid * 1024u;
    const int aoff = lds_byte(wr * 64 + fr, fq * 8), boff = lds_byte(wc * 32 + fr, fq * 8);
#define PG8_SA(b, h) (((b) * 2 + (h)) * HTB)
#define PG8_SB(b, h) ((4 + (b) * 2 + (h)) * HTB)
#define PG8_STAGE(bufoff, gbase, voff) do { _Pragma("unroll") for (int _i = 0; _i < 2; ++_i) \
        __builtin_amdgcn_global_load_lds((const unsigned*)((const char*)(gbase) + (voff)[_i]), (PG8_LAS unsigned*)(lds + (bufoff) + ldsw + _i * 8192), 16, 0, 0); } while (0)
#define PG8_LDA(dst, b, h) do { _Pragma("unroll") for (int m = 0; m < 4; ++m) _Pragma("unroll") for (int k = 0; k < 2; ++k) dst[m][k] = *(const PG8_LAS bf16x8*)(lds + PG8_SA(b, h) + aoff + m * 2048 + k * 1024); } while (0)
#define PG8_LDB(dst, b, h) do { _Pragma("unroll") for (int n = 0; n < 2; ++n) _Pragma("unroll") for (int k = 0; k < 2; ++k) dst[n][k] = *(const PG8_LAS bf16x8*)(lds + PG8_SB(b, h) + boff + n * 2048 + k * 1024); } while (0)
#define PG8_MMA(ai, bj, At, Bt) do { __builtin_amdgcn_s_setprio(1); _Pragma("unroll") for (int m = 0; m < 4; ++m) _Pragma("unroll") for (int n = 0; n < 2; ++n) _Pragma("unroll") for (int k = 0; k < 2; ++k) \
        acc[ai][bj][m][n] = __builtin_amdgcn_mfma_f32_16x16x32_bf16(Bt[n][k], At[m][k], acc[ai][bj][m][n], 0, 0, 0); __builtin_amdgcn_s_setprio(0); } while (0)
#define PG8_WAIT_V(n) asm volatile("s_waitcnt vmcnt(" #n ")" ::: "memory")
#define PG8_WAIT_L(n) asm volatile("s_waitcnt lgkmcnt(" #n ")" ::: "memory")
#define PG8_BAR __builtin_amdgcn_s_barrier()
#define PG8_SCHED __builtin_amdgcn_sched_barrier(0)
    Unit cur, nxt; int ui = 0;
    if (!S.next(0, cur)) return;
    f32x4 acc[2][2][4][2];
#pragma unroll
    for (int a = 0; a < 2; ++a)
#pragma unroll
        for (int b = 0; b < 2; ++b)
#pragma unroll
            for (int m = 0; m < 4; ++m)
#pragma unroll
                for (int n = 0; n < 2; ++n) acc[a][b][m][n] = (f32x4){0.f, 0.f, 0.f, 0.f};
    bf16x8 At[4][2], B0[2][2], B1[2][2];
    const char* cA = (const char*)g.A + (size_t)cur.pm * tstep; const char* cB = (const char*)g.Bt + (size_t)cur.pn * tstep + (size_t)cur.e * g.bexp;
    S.a_ready(cur);
    if constexpr (SP2) {
        PG8_STAGE(PG8_SB(0, 0), cB, voffB); PG8_STAGE(PG8_SB(0, 1), cB + hstep, voffB); PG8_STAGE(PG8_SA(0, 0), cA, voffA); PG8_STAGE(PG8_SA(0, 1), cA + hstep, voffA);
        if (wr == 1) PG8_BAR;
        PG8_WAIT_V(2); PG8_BAR;
        PG8_STAGE(PG8_SB(1, 0), cB + kstep, voffB); PG8_STAGE(PG8_SA(1, 0), cA + kstep, voffA); PG8_STAGE(PG8_SB(1, 1), cB + hstep + kstep, voffB);
        PG8_WAIT_V(6); PG8_BAR;
    } else {
        PG8_STAGE(PG8_SB(0, 0), cB, voffB); PG8_STAGE(PG8_SA(0, 0), cA, voffA); PG8_STAGE(PG8_SB(0, 1), cB + hstep, voffB); PG8_STAGE(PG8_SA(0, 1), cA + hstep, voffA);
        if (wr == 1) PG8_BAR;
        PG8_WAIT_V(4); PG8_BAR;
        PG8_STAGE(PG8_SB(1, 0), cB + kstep, voffB); PG8_STAGE(PG8_SA(1, 0), cA + kstep, voffA); PG8_STAGE(PG8_SB(1, 1), cB + hstep + kstep, voffB);
        PG8_WAIT_V(6); PG8_BAR;
    }
    for (;;) {
        const bool has_next = S.next(ui + 1, nxt);
        const char* nA = has_next ? (const char*)g.A + (size_t)nxt.pm * tstep : cA; const char* nB = has_next ? (const char*)g.Bt + (size_t)nxt.pn * tstep + (size_t)nxt.e * g.bexp : cB;
        for (int t = 0; t < nt; t += 2) {
            const bool last = (t == nt - 2);
            const char* a1 = cA + (size_t)(t + 1) * kstep;
            const char* a2 = last ? nA : cA + (size_t)(t + 2) * kstep; const char* b2 = last ? nB : cB + (size_t)(t + 2) * kstep;
            const char* a3 = a2 + kstep; const char* b3 = b2 + kstep;
            if (last && has_next) S.a_ready(nxt);
            if constexpr (SP2) {
            PG8_LDB(B0, 0, 0); PG8_LDB(B1, 0, 1); PG8_SCHED; PG8_LDA(At, 0, 0); PG8_STAGE(PG8_SA(1, 1), a1 + hstep, voffA);
            PG8_WAIT_V(8); PG8_WAIT_L(0); PG8_BAR; PG8_MMA(0, 0, At, B0); PG8_MMA(0, 1, At, B1); PG8_BAR; PG8_SCHED;
            PG8_LDA(At, 0, 1); PG8_STAGE(PG8_SB(0, 0), b2, voffB); PG8_STAGE(PG8_SB(0, 1), b2 + hstep, voffB); PG8_STAGE(PG8_SA(0, 0), a2, voffA);
            PG8_WAIT_V(8); PG8_WAIT_L(0); PG8_BAR; PG8_MMA(1, 0, At, B0); PG8_MMA(1, 1, At, B1); PG8_BAR; PG8_SCHED;
            PG8_LDB(B0, 1, 0); PG8_LDB(B1, 1, 1); PG8_SCHED; PG8_LDA(At, 1, 0); PG8_STAGE(PG8_SA(0, 1), a2 + hstep, voffA);
            PG8_WAIT_V(8); PG8_WAIT_L(0); PG8_BAR; PG8_MMA(0, 0, At, B0); PG8_MMA(0, 1, At, B1); PG8_BAR; PG8_SCHED;
            PG8_LDA(At, 1, 1); PG8_STAGE(PG8_SB(1, 0), b3, voffB); PG8_STAGE(PG8_SB(1, 1), b3 + hstep, voffB); PG8_STAGE(PG8_SA(1, 0), a3, voffA);
            PG8_WAIT_V(8); PG8_WAIT_L(0); PG8_BAR; PG8_MMA(1, 0, At, B0); PG8_MMA(1, 1, At, B1); PG8_BAR; PG8_SCHED;
            } else {
            PG8_LDB(B0, 0, 0); PG8_SCHED; PG8_LDA(At, 0, 0); PG8_STAGE(PG8_SA(1, 1), a1 + hstep, voffA);
            PG8_WAIT_L(8); PG8_BAR; PG8_WAIT_L(0); PG8_MMA(0, 0, At, B0); PG8_BAR; PG8_SCHED;
            PG8_LDB(B1, 0, 1); PG8_STAGE(PG8_SB(0, 0), b2, voffB);
            PG8_BAR; PG8_WAIT_L(0); PG8_MMA(0, 1, At, B1); PG8_BAR;
            PG8_LDA(At, 0, 1); PG8_STAGE(PG8_SA(0, 0), a2, voffA);
            PG8_BAR; PG8_WAIT_L(0); PG8_MMA(1, 0, At, B0); PG8_BAR; PG8_SCHED;
            PG8_STAGE(PG8_SB(0, 1), b2 + hstep, voffB);
            PG8_WAIT_V(6); PG8_BAR; PG8_MMA(1, 1, At, B1); PG8_BAR;
            PG8_LDB(B0, 1, 0); PG8_SCHED; PG8_LDA(At, 1, 0); PG8_STAGE(PG8_SA(0, 1), a2 + hstep, voffA);
            PG8_WAIT_L(8); PG8_BAR; PG8_WAIT_L(0); PG8_MMA(0, 0, At, B0); PG8_BAR; PG8_SCHED;
            PG8_LDB(B1, 1, 1); PG8_STAGE(PG8_SB(1, 0), b3, voffB);
            PG8_BAR; PG8_WAIT_L(0); PG8_MMA(0, 1, At, B1); PG8_BAR;
            PG8_LDA(At, 1, 1); PG8_STAGE(PG8_SA(1, 0), a3, voffA);
            PG8_BAR; PG8_WAIT_L(0); PG8_MMA(1, 0, At, B0); PG8_BAR; PG8_SCHED;
            PG8_STAGE(PG8_SB(1, 1), b3 + hstep, voffB);
            PG8_WAIT_V(6); PG8_BAR; PG8_MMA(1, 1, At, B1); PG8_BAR;
            }
        }
        if constexpr (ALIGN_EPI) { if (wr == 0) PG8_BAR; }
        if constexpr (!Epi::AFTER_DRAIN) { E(acc, cur, wr, wc, fr, fq); S.done(cur); }
        if (!has_next) break;
#pragma unroll
        for (int a = 0; a < 2; ++a)
#pragma unroll
            for (int b = 0; b < 2; ++b)
#pragma unroll
                for (int m = 0; m < 4; ++m)
#pragma unroll
                    for (int n = 0; n < 2; ++n) acc[a][b][m][n] = (f32x4){0.f, 0.f, 0.f, 0.f};
        cur = nxt; cA = nA; cB = nB; ++ui;
        if constexpr (ALIGN_EPI) { if (wr == 1) PG8_BAR; }
    }
    PG8_WAIT_V(0);
    if constexpr (!ALIGN_EPI) { if (wr == 0) PG8_BAR; }
    PG8_BAR;
    if constexpr (Epi::AFTER_DRAIN) { E.fused(acc, cur, wr, wc, fr, fq, lds, wid, lane); S.done(cur); }
#undef PG8_SA
#undef PG8_SB
#undef PG8_STAGE
#undef PG8_LDA
#undef PG8_LDB
#undef PG8_MMA
#undef PG8_WAIT_V
#undef PG8_WAIT_L
#undef PG8_BAR
#undef PG8_SCHED
}
}
__device__ __forceinline__ float bf2f(unsigned v) { return __uint_as_float(v << 16); }
__device__ __forceinline__ unsigned f2bf(float f) { unsigned u = __float_as_uint(f); u += 0x7FFFu + ((u >> 16) & 1u); return u >> 16; }
__device__ __forceinline__ unsigned pk2(float lo, float hi) { return f2bf(lo) | (f2bf(hi) << 16); }
__device__ __forceinline__ float bflo(unsigned w) { return __uint_as_float(w << 16); }
__device__ __forceinline__ float bfhi(unsigned w) { return __uint_as_float(w & 0xFFFF0000u); }
__device__ __forceinline__ float wave_sum(float v) {
#pragma unroll
    for (int o = 1; o < 64; o <<= 1) v += __shfl_xor(v, o);
    return v;
}
__device__ __forceinline__ float wave_max(float v) {
#pragma unroll
    for (int o = 1; o < 64; o <<= 1) v = fmaxf(v, __shfl_xor(v, o));
    return v;
}
__device__ __forceinline__ float sigmoidf_(float x) { return 1.0f / (1.0f + __expf(-x)); }
#define LDS_WAIT() asm volatile("s_waitcnt lgkmcnt(0)" ::: "memory")

struct Ctx { int tid, wave, lane, gw, ngw; unsigned char* shm; };

__device__ __forceinline__ int tr_src_col(int mode, int n, int scol0) { return mode == 1 ? (n < 2048 ? n : n + 16) : scol0 + n; }
__device__ __forceinline__ int tr_dst_row(int mode, int n, int drow0) { return mode == 2 ? 8 * (n >> 2) + (n & 3) : (mode == 3 ? 8 * (n >> 2) + 4 + (n & 3) : drow0 + n); }
__device__ __forceinline__ void tr_item(const float* W, int ldw, int scol0, int K, bf16_t* WT, int drow0, int mode, LAS float* scr, int item, int nblk, int lane) {
    const int kb = item / nblk, nb = item % nblk, k0 = 64 * kb, n0 = 32 * nb;
    const int sc = tr_src_col(mode, n0 + (lane & 31), scol0);
#pragma unroll 8
    for (int i = 0; i < 32; ++i) { const int kk = 2 * i + (lane >> 5); scr[kk * 33 + (lane & 31)] = W[(size_t)(k0 + kk) * ldw + sc]; }
    LDS_WAIT(); asm volatile("" ::: "memory");
    const int c = lane & 7;
#pragma unroll
    for (int j = 0; j < 4; ++j) { const int n = (lane >> 3) + 8 * j; const LAS float* s = scr + (8 * c) * 33 + n;
        u32x4 o; o.x = pk2(s[0 * 33], s[1 * 33]); o.y = pk2(s[2 * 33], s[3 * 33]); o.z = pk2(s[4 * 33], s[5 * 33]); o.w = pk2(s[6 * 33], s[7 * 33]);
        *(u32x4*)(WT + (size_t)tr_dst_row(mode, n0 + n, drow0) * K + k0 + 8 * c) = o; }
    LDS_WAIT(); asm volatile("" ::: "memory");
}
__device__ __forceinline__ void tr_matrix(const Ctx& c, const float* W, int ldw, int scol0, int K, int ncols, bf16_t* WT, int drow0, int mode) {
    LAS float* scr = (LAS float*)(c.shm) + c.wave * (64 * 33);
    const int nblk = ncols / 32, nitems = (K / 64) * nblk;
    for (int it = c.gw; it < nitems; it += c.ngw) tr_item(W, ldw, scol0, K, WT, drow0, mode, scr, it, nblk, c.lane);
}
__device__ __forceinline__ void tr_moe_layer(const Ctx& c, const Params& p, int layer) {
    LAS float* scr = (LAS float*)(c.shm) + c.wave * (64 * 33);
    bf16_t* w13t = (bf16_t*)(p.ws + OFF_WMOE); bf16_t* w2t = (bf16_t*)(p.ws + OFF_WMOE + 64 * MiB);
    const float* w1 = p.moe_w1 + (size_t)layer * NEXP * 1024 * 512; const float* w3 = p.moe_w3 + (size_t)layer * NEXP * 1024 * 512; const float* w2 = p.moe_w2 + (size_t)layer * NEXP * 512 * 1024;
    for (int it = c.gw; it < NEXP * 768; it += c.ngw) {
        const int e = it / 768, r = it % 768;
        if (r < 256) tr_item(w1 + (size_t)e * 1024 * 512, 512, 0, 1024, w13t + (size_t)e * 1024 * 1024, 0, 2, scr, r, 16, c.lane);
        else if (r < 512) tr_item(w3 + (size_t)e * 1024 * 512, 512, 0, 1024, w13t + (size_t)e * 1024 * 1024, 0, 3, scr, r - 256, 16, c.lane);
        else tr_item(w2 + (size_t)e * 512 * 1024, 1024, 0, 512, w2t + (size_t)e * 1024 * 512, 0, 0, scr, r - 512, 32, c.lane);
    }
}

__device__ __forceinline__ void row_load(const float* row, int lane, f32x4 (&v)[4]) {
#pragma unroll
    for (int j = 0; j < 4; ++j) v[j] = *((const f32x4*)row + lane + 64 * j);
}
__device__ __forceinline__ float row_rstd(const f32x4 (&v)[4]) {
    float s = 0.f;
#pragma unroll
    for (int j = 0; j < 4; ++j) s += (v[j].x * v[j].x + v[j].y * v[j].y) + (v[j].z * v[j].z + v[j].w * v[j].w);
    return 1.0f / sqrtf(wave_sum(s) * (1.0f / 1024.0f) + 1e-6f);
}
__device__ __forceinline__ void row_scale(f32x4 (&v)[4], float rstd, const float* gain, int lane) {
#pragma unroll
    for (int j = 0; j < 4; ++j) { const f32x4 g = *((const f32x4*)gain + lane + 64 * j); v[j] = v[j] * rstd * g; }
}
__device__ __forceinline__ void row_store_bf16(bf16_t* orow, int lane, const f32x4 (&v)[4]) {
#pragma unroll
    for (int j = 0; j < 4; ++j) { u32x2 o; o.x = pk2(v[j].x, v[j].y); o.y = pk2(v[j].z, v[j].w); *((u32x2*)orow + lane + 64 * j) = o; }
}
__device__ __forceinline__ void row_store_f32(float* orow, int lane, const f32x4 (&v)[4]) {
#pragma unroll
    for (int j = 0; j < 4; ++j) *((f32x4*)orow + lane + 64 * j) = v[j];
}
__device__ __forceinline__ void row_combine(f32x4 (&v)[4], const bf16_t* yb, int p0, int p1, float g0, float g1, int lane) {
    const u32x2* r0 = (const u32x2*)(yb + (size_t)p0 * 1024); const u32x2* r1 = (const u32x2*)(yb + (size_t)p1 * 1024);
#pragma unroll
    for (int j = 0; j < 4; ++j) { const u32x2 a = r0[lane + 64 * j], b = r1[lane + 64 * j];
        v[j].x += g0 * bflo(a.x) + g1 * bflo(b.x); v[j].y += g0 * bfhi(a.x) + g1 * bfhi(b.x);
        v[j].z += g0 * bflo(a.y) + g1 * bflo(b.y); v[j].w += g0 * bfhi(a.y) + g1 * bfhi(b.y); }
}
__device__ __forceinline__ void row_logits(const f32x4 (&v)[4], const float* wT, int lane, int NL, LAS float* lg) {
#pragma unroll 1
    for (int o = 0; o < NL; ++o) { float s = 0.f;
#pragma unroll
        for (int j = 0; j < 4; ++j) { const f32x4 w = *((const f32x4*)(wT + o * 1024) + lane + 64 * j); s += (v[j].x * w.x + v[j].y * w.y) + (v[j].z * w.z + v[j].w * w.w); }
        s = wave_sum(s); if (lane == 0) lg[o] = s; }
    LDS_WAIT();
}

__device__ __forceinline__ void norm_plain(const Ctx& c, const float* src, const float* gain, bf16_t* H, int nrows) {
    for (int r = c.gw; r < nrows; r += c.ngw) { f32x4 v[4]; row_load(src + (size_t)r * 1024, c.lane, v); const float rs = row_rstd(v); row_scale(v, rs, gain, c.lane); row_store_bf16(H + (size_t)r * 1024, c.lane, v); }
}
__device__ __forceinline__ void route_row(const LAS float* lg, const float* bg, const float* be, int& e0, int& e1, float& g0, float& g1) {
    float gl[4]; int gt = 0; float gm;
#pragma unroll
    for (int i = 0; i < 4; ++i) gl[i] = lg[i] + bg[i];
    gm = gl[0];
#pragma unroll
    for (int i = 1; i < 4; ++i) if (gl[i] > gm) { gm = gl[i]; gt = i; }
    float gs = 0.f;
#pragma unroll
    for (int i = 0; i < 4; ++i) gs += __expf(gl[i] - gm);
    const float pg = 1.0f / gs;
    float el[8];
#pragma unroll
    for (int i = 0; i < 8; ++i) el[i] = lg[4 + 8 * gt + i] + be[8 * gt + i];
    int i0 = 0; float m0 = el[0];
#pragma unroll
    for (int i = 1; i < 8; ++i) if (el[i] > m0) { m0 = el[i]; i0 = i; }
    int i1 = -1; float m1 = -3.0e38f;
#pragma unroll
    for (int i = 0; i < 8; ++i) if (i != i0 && el[i] > m1) { m1 = el[i]; i1 = i; }
    float one = 1.0f; asm volatile("" : "+v"(one));
    const float q1 = __expf(m1 - m0); const float inv = one / (one + q1);
    e0 = gt * 8 + i0; e1 = gt * 8 + i1; g0 = pg * inv; g1 = pg * q1 * inv;
}
constexpr int RW_AS = 64 * 68;
__device__ __forceinline__ void rwkv_naive(const Ctx& c, const Params& p, int bh) {
    const int b = bh >> 3, hd = bh & 7, tid = c.tid, lane = c.lane, wv = c.wave;
    LAS float* L = (LAS float*)c.shm;
    LAS float* aR = L; LAS float* aK = L + RW_AS; LAS float* aV = L + 2 * RW_AS; LAS float* aW = L + 3 * RW_AS; LAS float* aA = L + 4 * RW_AS;
    LAS float* aB = L + 5 * RW_AS; LAS float* aG = L + 6 * RW_AS; LAS float* aY = L + 7 * RW_AS; LAS float* red = L + 8 * RW_AS;
    const bf16_t* P = (const bf16_t*)(p.ws + OFF_P); bf16_t* MIX = (bf16_t*)(p.ws + OFF_H);
    LAS f32x4* SL = (LAS f32x4*)(L + 8 * RW_AS + 1536);
    if (wv == 0) {
#pragma unroll
        for (int j4 = 0; j4 < 16; ++j4) SL[j4 * 64 + lane] = (f32x4){0.f, 0.f, 0.f, 0.f}; }
    const int t = lane, cg = wv;
    const int ch0 = hd * 64 + cg * 8;
    for (int tb = 0; tb < 64; ++tb) {
        const size_t tg0 = (size_t)b * SEQ + (size_t)tb * 64;
#pragma unroll 1
        for (int i = 0; i < 7; ++i) {
            const int task = tid + 512 * i, tt = task / 56, q = task % 56;
            int col; LAS float* dst; int kind = 0;
            if (q < 8) { col = hd * 64 + 8 * q; dst = aR + tt * 68 + 8 * q; }
            else if (q < 16) { col = 512 + hd * 64 + 8 * (q - 8); dst = aK + tt * 68 + 8 * (q - 8); }
            else if (q < 24) { col = 1024 + hd * 64 + 8 * (q - 16); dst = aV + tt * 68 + 8 * (q - 16); }
            else if (q < 32) { col = 1536 + 8 * (q - 24); dst = aW + tt * 68 + 8 * (q - 24); kind = 1; }
            else if (q < 40) { col = 1600 + 8 * (q - 32); dst = aA + tt * 68 + 8 * (q - 32); }
            else if (q < 48) { col = 1664 + 8 * (q - 40); dst = aB + tt * 68 + 8 * (q - 40); kind = 2; }
            else { col = 1664 + 8 * (q - 40); dst = aG + tt * 68 + 8 * (q - 48); kind = 2; }
            const bf16_t* src = P + (tg0 + tt) * EV_IN + 768 + col;
            const u32x4 cur = *(const u32x4*)src;
            u32x4 prv = (u32x4){0u, 0u, 0u, 0u};
            if (tb * 64 + tt > 0) prv = *(const u32x4*)(src - EV_IN);
            const f32x4 m0 = *(const f32x4*)(p.ev_mu + col), m1 = *(const f32x4*)(p.ev_mu + col + 4);
            float v[8];
            const unsigned cw[4] = {cur.x, cur.y, cur.z, cur.w}, pw[4] = {prv.x, prv.y, prv.z, prv.w};
            const float mu[8] = {m0.x, m0.y, m0.z, m0.w, m1.x, m1.y, m1.z, m1.w};
#pragma unroll
            for (int k = 0; k < 4; ++k) { const float c0 = bflo(cw[k]), c1 = bfhi(cw[k]), p0 = bflo(pw[k]), p1 = bfhi(pw[k]);
                v[2 * k] = c0 + (p0 - c0) * mu[2 * k]; v[2 * k + 1] = c1 + (p1 - c1) * mu[2 * k + 1]; }
            if (kind == 1) {
#pragma unroll
                for (int k = 0; k < 8; ++k) v[k] = tanhf(v[k]); }
            if (kind == 2) {
#pragma unroll
                for (int k = 0; k < 8; ++k) v[k] = sigmoidf_(v[k]); }
            *(LAS f32x4*)dst = (f32x4){v[0], v[1], v[2], v[3]}; *(LAS f32x4*)(dst + 4) = (f32x4){v[4], v[5], v[6], v[7]};
        }
        __syncthreads();
        float zw[8], za[8], gg[8];
#pragma unroll
        for (int i = 0; i < 8; ++i) { zw[i] = 0.f; za[i] = 0.f; gg[i] = 0.f; }
#pragma unroll 2
        for (int j4 = 0; j4 < 16; ++j4) {
            const f32x4 xw = *(const LAS f32x4*)(aW + t * 68 + 4 * j4), xa = *(const LAS f32x4*)(aA + t * 68 + 4 * j4);
            const f32x4 g0 = *(const LAS f32x4*)(aB + t * 68 + 4 * j4), g1 = *(const LAS f32x4*)(aG + t * 68 + 4 * j4);
#pragma unroll
            for (int jj = 0; jj < 4; ++jj) { const int j = 4 * j4 + jj;
                const f32x4 w2a = *(const f32x4*)(p.ev_w2 + (size_t)j * 512 + ch0), w2b = *(const f32x4*)(p.ev_w2 + (size_t)j * 512 + ch0 + 4);
                const f32x4 a2a = *(const f32x4*)(p.ev_a2 + (size_t)j * 512 + ch0), a2b = *(const f32x4*)(p.ev_a2 + (size_t)j * 512 + ch0 + 4);
                const f32x4 gla = *(const f32x4*)(p.ev_g2 + (size_t)j * 512 + ch0), glb = *(const f32x4*)(p.ev_g2 + (size_t)j * 512 + ch0 + 4);
                const f32x4 gha = *(const f32x4*)(p.ev_g2 + (size_t)(64 + j) * 512 + ch0), ghb = *(const f32x4*)(p.ev_g2 + (size_t)(64 + j) * 512 + ch0 + 4);
                const float xwv = xw[jj], xav = xa[jj], g0v = g0[jj], g1v = g1[jj];
#pragma unroll
                for (int i = 0; i < 4; ++i) { zw[i] += xwv * w2a[i]; zw[4 + i] += xwv * w2b[i]; za[i] += xav * a2a[i]; za[4 + i] += xav * a2b[i];
                    gg[i] += g0v * gla[i] + g1v * gha[i]; gg[4 + i] += g0v * glb[i] + g1v * ghb[i]; } }
        }
        float av[8], kkv[8]; float ss = 0.f;
        {
            const f32x4 kA = *(const LAS f32x4*)(aK + t * 68 + cg * 8), kB = *(const LAS f32x4*)(aK + t * 68 + cg * 8 + 4);
            const float kv[8] = {kA.x, kA.y, kA.z, kA.w, kB.x, kB.y, kB.z, kB.w};
            float dec[8], kp[8];
#pragma unroll
            for (int i = 0; i < 8; ++i) { const int ch = ch0 + i;
                const float u = -(p.ev_w0[ch] + zw[i]); const float sp = (u > 20.f) ? u : log1pf(__expf(u));
                const float w = -sp - 0.5f; dec[i] = __expf(-__expf(w));
                av[i] = sigmoidf_(p.ev_a0[ch] + za[i]);
                kkv[i] = kv[i] * p.ev_k_k[ch]; ss += kkv[i] * kkv[i];
                kp[i] = kv[i] * (1.0f + (av[i] - 1.0f) * p.ev_k_a[ch]); }
            red[t * 8 + cg] = ss;
            __syncthreads();
            *(LAS f32x4*)(aW + t * 68 + cg * 8) = (f32x4){dec[0], dec[1], dec[2], dec[3]}; *(LAS f32x4*)(aW + t * 68 + cg * 8 + 4) = (f32x4){dec[4], dec[5], dec[6], dec[7]};
            *(LAS f32x4*)(aK + t * 68 + cg * 8) = (f32x4){kp[0], kp[1], kp[2], kp[3]}; *(LAS f32x4*)(aK + t * 68 + cg * 8 + 4) = (f32x4){kp[4], kp[5], kp[6], kp[7]};
            *(LAS f32x4*)(aG + t * 68 + cg * 8) = (f32x4){gg[0], gg[1], gg[2], gg[3]}; *(LAS f32x4*)(aG + t * 68 + cg * 8 + 4) = (f32x4){gg[4], gg[5], gg[6], gg[7]};
            float tot = 0.f;
#pragma unroll
            for (int i = 0; i < 8; ++i) tot += red[t * 8 + i];
            const float inv = 1.0f / fmaxf(sqrtf(tot), 1e-12f);
            float an[8], bn[8];
#pragma unroll
            for (int i = 0; i < 8; ++i) { const float kn = kkv[i] * inv; an[i] = -kn; bn[i] = kn * av[i]; }
            *(LAS f32x4*)(aA + t * 68 + cg * 8) = (f32x4){an[0], an[1], an[2], an[3]}; *(LAS f32x4*)(aA + t * 68 + cg * 8 + 4) = (f32x4){an[4], an[5], an[6], an[7]};
            *(LAS f32x4*)(aB + t * 68 + cg * 8) = (f32x4){bn[0], bn[1], bn[2], bn[3]}; *(LAS f32x4*)(aB + t * 68 + cg * 8 + 4) = (f32x4){bn[4], bn[5], bn[6], bn[7]};
        }
        __syncthreads();
        if (wv == 0) {
            float S[64];
#pragma unroll
            for (int j4 = 0; j4 < 16; ++j4) { const f32x4 s4 = SL[j4 * 64 + lane]; S[4 * j4] = s4.x; S[4 * j4 + 1] = s4.y; S[4 * j4 + 2] = s4.z; S[4 * j4 + 3] = s4.w; }
#pragma unroll 1
            for (int tt = 0; tt < 64; ++tt) {
                const float vv = aV[tt * 68 + lane];
                float sa = 0.f;
#pragma unroll
                for (int j4 = 0; j4 < 16; ++j4) { const f32x4 a4 = *(const LAS f32x4*)(aA + tt * 68 + 4 * j4);
                    sa += S[4 * j4] * a4.x; sa += S[4 * j4 + 1] * a4.y; sa += S[4 * j4 + 2] * a4.z; sa += S[4 * j4 + 3] * a4.w; }
                float y = 0.f;
#pragma unroll
                for (int j4 = 0; j4 < 16; ++j4) {
                    const f32x4 d4 = *(const LAS f32x4*)(aW + tt * 68 + 4 * j4), b4 = *(const LAS f32x4*)(aB + tt * 68 + 4 * j4);
                    const f32x4 k4 = *(const LAS f32x4*)(aK + tt * 68 + 4 * j4), r4 = *(const LAS f32x4*)(aR + tt * 68 + 4 * j4);
#pragma unroll
                    for (int jj = 0; jj < 4; ++jj) { const int j = 4 * j4 + jj; S[j] = S[j] * d4[jj] + sa * b4[jj] + vv * k4[jj]; y += S[j] * r4[jj]; } }
                aY[tt * 68 + lane] = y;
            }
#pragma unroll
            for (int j4 = 0; j4 < 16; ++j4) SL[j4 * 64 + lane] = (f32x4){S[4 * j4], S[4 * j4 + 1], S[4 * j4 + 2], S[4 * j4 + 3]};
        }
        __syncthreads();
        {
            const f32x4 yA = *(const LAS f32x4*)(aY + t * 68 + cg * 8), yB = *(const LAS f32x4*)(aY + t * 68 + cg * 8 + 4);
            const f32x4 rA = *(const LAS f32x4*)(aR + t * 68 + cg * 8), rB = *(const LAS f32x4*)(aR + t * 68 + cg * 8 + 4);
            const f32x4 kA = *(const LAS f32x4*)(aK + t * 68 + cg * 8), kB = *(const LAS f32x4*)(aK + t * 68 + cg * 8 + 4);
            const f32x4 vA = *(const LAS f32x4*)(aV + t * 68 + cg * 8), vB = *(const LAS f32x4*)(aV + t * 68 + cg * 8 + 4);
            const f32x4 gA = *(const LAS f32x4*)(aG + t * 68 + cg * 8), gB = *(const LAS f32x4*)(aG + t * 68 + cg * 8 + 4);
            const float y[8] = {yA.x, yA.y, yA.z, yA.w, yB.x, yB.y, yB.z, yB.w}, r[8] = {rA.x, rA.y, rA.z, rA.w, rB.x, rB.y, rB.z, rB.w};
            const float k[8] = {kA.x, kA.y, kA.z, kA.w, kB.x, kB.y, kB.z, kB.w}, v[8] = {vA.x, vA.y, vA.z, vA.w, vB.x, vB.y, vB.z, vB.w};
            const float g[8] = {gA.x, gA.y, gA.z, gA.w, gB.x, gB.y, gB.z, gB.w};
            float s1 = 0.f, sb = 0.f;
#pragma unroll
            for (int i = 0; i < 8; ++i) { s1 += y[i]; sb += r[i] * k[i] * p.ev_r_k[ch0 + i]; }
            red[t * 8 + cg] = s1; red[512 + t * 8 + cg] = sb;
            __syncthreads();
            float m = 0.f, bon = 0.f;
#pragma unroll
            for (int i = 0; i < 8; ++i) { m += red[t * 8 + i]; bon += red[512 + t * 8 + i]; }
            m *= (1.0f / 64.0f);
            float s2 = 0.f;
#pragma unroll
            for (int i = 0; i < 8; ++i) s2 += (y[i] - m) * (y[i] - m);
            red[1024 + t * 8 + cg] = s2;
            __syncthreads();
            float var = 0.f;
#pragma unroll
            for (int i = 0; i < 8; ++i) var += red[1024 + t * 8 + i];
            const float rs = 1.0f / sqrtf(var * (1.0f / 64.0f) + 64e-5f);
            float o[8];
#pragma unroll
            for (int i = 0; i < 8; ++i) o[i] = ((y[i] - m) * rs * p.ev_lnx_w[ch0 + i] + p.ev_lnx_b[ch0 + i] + bon * v[i]) * g[i];
            u32x4 w; w.x = pk2(o[0], o[1]); w.y = pk2(o[2], o[3]); w.z = pk2(o[4], o[5]); w.w = pk2(o[6], o[7]);
            *(u32x4*)(MIX + (tg0 + t) * 1024 + 512 + ch0) = w;
        }
        __syncthreads();
    }
}

__device__ __forceinline__ void swa_naive(const Ctx& c, const Params& p, int unit) {
    const int b = unit >> 6, g = (unit >> 5) & 1, n = unit & 31, tid = c.tid, lane = c.lane, wv = c.wave;
    LAS bf16_t* Ks = (LAS bf16_t*)c.shm;
    LAS bf16_t* Vs = (LAS bf16_t*)(c.shm + 256 * 144);
    LAS float* qf = (LAS float*)(c.shm + 256 * 144 + 256 * 128) + wv * 320;
    LAS float* pr = qf + 64;
    const bf16_t* P = (const bf16_t*)(p.ws + OFF_P); bf16_t* MIX = (bf16_t*)(p.ws + OFF_H);
    __syncthreads();
#pragma unroll 1
    for (int i = 0; i < 8; ++i) {
        const int task = tid + 512 * i, which = task >> 11, r = (task >> 3) & 255, ck = task & 7;
        const int tk = n * 128 - 128 + r;
        u32x4 d = (u32x4){0u, 0u, 0u, 0u};
        if (tk >= 0) d = *(const u32x4*)(P + ((size_t)b * SEQ + tk) * EV_IN + 512 + which * 128 + g * 64 + ck * 8);
        if (which == 0) *(LAS u32x4*)(Ks + r * 72 + ck * 8) = d; else *(LAS u32x4*)(Vs + r * 64 + ck * 8) = d;
    }
    __syncthreads();
    const int head = g * 4 + (wv >> 1);
    const float sink = p.ev_sinks[head];
#pragma unroll 1
    for (int qq = 0; qq < 64; ++qq) {
        const int qi = (wv & 1) * 64 + qq;
        const size_t tq = (size_t)b * SEQ + n * 128 + qi;
        qf[lane] = bf2f(P[tq * EV_IN + head * 64 + lane]) * 0.125f;
        LDS_WAIT();
        float s[4];
#pragma unroll
        for (int j = 0; j < 4; ++j) { const int kp = lane + 64 * j; float a = 0.f;
#pragma unroll
            for (int ck = 0; ck < 8; ++ck) { const u32x4 kk = *(const LAS u32x4*)(Ks + kp * 72 + ck * 8);
                const f32x4 q0 = *(const LAS f32x4*)(qf + ck * 8), q1 = *(const LAS f32x4*)(qf + ck * 8 + 4);
                a += bflo(kk.x) * q0.x + bfhi(kk.x) * q0.y + bflo(kk.y) * q0.z + bfhi(kk.y) * q0.w + bflo(kk.z) * q1.x + bfhi(kk.z) * q1.y + bflo(kk.w) * q1.z + bfhi(kk.w) * q1.w; }
            const bool valid = (kp >= qi + 1) && (kp <= qi + 128) && (n > 0 || kp >= 128);
            s[j] = valid ? a : -INFINITY; }
        float m = fmaxf(fmaxf(s[0], s[1]), fmaxf(s[2], s[3])); m = fmaxf(wave_max(m), sink);
        float den = 0.f;
#pragma unroll
        for (int j = 0; j < 4; ++j) { const float e = __expf(s[j] - m); pr[lane + 64 * j] = e; den += e; }
        den = wave_sum(den) + __expf(sink - m);
        LDS_WAIT();
        float o = 0.f;
#pragma unroll 8
        for (int kp = qi + 1; kp <= qi + 128; ++kp) o += pr[kp] * bf2f(Vs[kp * 64 + lane]);
        MIX[tq * 1024 + head * 64 + lane] = (bf16_t)f2bf(o / den);
    }
}
__device__ __forceinline__ void gla_naive(const Ctx& c, const Params& p, int bh) {
    const int b = bh >> 2, hd = bh & 3, tid = c.tid, lane = c.lane, wv = c.wave;
    LAS float* qs = (LAS float*)c.shm; LAS float* ks = qs + 32 * 128; LAS float* es = ks + 32 * 128; LAS float* vs = es + 32 * 128; LAS float* os = vs + 32 * 256;
    const bf16_t* P = (const bf16_t*)(p.ws + OFF_P); const float* GK = (const float*)(p.ws + OFF_R); bf16_t* MIX = (bf16_t*)(p.ws + OFF_H);
    float S[128];
#pragma unroll
    for (int j = 0; j < 128; ++j) S[j] = 0.f;
    for (int tb = 0; tb < 128; ++tb) {
        const size_t tg0 = (size_t)b * SEQ + (size_t)tb * 32;
#pragma unroll 1
        for (int i = 0; i < 8; ++i) { const int idx = tid + 512 * i, tt = idx >> 7, j = idx & 127;
            const bf16_t* row = P + (tg0 + tt) * OD_IN;
            qs[idx] = bf2f(row[hd * 128 + j]) * 0.08838834764831845f; ks[idx] = bf2f(row[512 + hd * 128 + j]); es[idx] = __expf(GK[(tg0 + tt) * 512 + hd * 128 + j]); }
#pragma unroll 1
        for (int i = 0; i < 16; ++i) { const int idx = tid + 512 * i, tt = idx >> 8, j = idx & 255; vs[idx] = bf2f(P[(tg0 + tt) * OD_IN + 1024 + hd * 256 + j]); }
        __syncthreads();
        if (wv < 4) {
#pragma unroll 1
            for (int tt = 0; tt < 32; ++tt) {
                const float vv = vs[tt * 256 + tid]; float o = 0.f;
#pragma unroll
                for (int j4 = 0; j4 < 32; ++j4) {
                    const f32x4 e4 = *(const LAS f32x4*)(es + tt * 128 + 4 * j4), k4 = *(const LAS f32x4*)(ks + tt * 128 + 4 * j4), q4 = *(const LAS f32x4*)(qs + tt * 128 + 4 * j4);
#pragma unroll
                    for (int jj = 0; jj < 4; ++jj) { const int j = 4 * j4 + jj; S[j] = S[j] * e4[jj] + k4[jj] * vv; o += q4[jj] * S[j]; } }
                os[tt * 256 + tid] = o;
            }
        }
        __syncthreads();
#pragma unroll 1
        for (int i = 0; i < 4; ++i) { const int tt = wv + 8 * i;
            const f32x4 o4 = *(const LAS f32x4*)(os + tt * 256 + 4 * lane);
            const float ss = wave_sum(o4.x * o4.x + o4.y * o4.y + o4.z * o4.z + o4.w * o4.w);
            const float rs = 1.0f / sqrtf(ss * (1.0f / 256.0f) + 1e-6f);
            const f32x4 gn = *(const f32x4*)(p.od_onorm + 4 * lane);
            const u32x2 og = *(const u32x2*)(P + (tg0 + tt) * OD_IN + 2048 + hd * 256 + 4 * lane);
            const float g0 = bflo(og.x), g1 = bfhi(og.x), g2 = bflo(og.y), g3 = bfhi(og.y);
            u32x2 w; w.x = pk2(o4.x * rs * gn.x * g0 * sigmoidf_(g0), o4.y * rs * gn.y * g1 * sigmoidf_(g1)); w.y = pk2(o4.z * rs * gn.z * g2 * sigmoidf_(g2), o4.w * rs * gn.w * g3 * sigmoidf_(g3));
            *(u32x2*)(MIX + (tg0 + tt) * 1024 + hd * 256 + 4 * lane) = w; }
        __syncthreads();
    }
}

__device__ __forceinline__ void xattn_naive(const Ctx& c, const Params& p, int unit) {
    const int b = unit >> 5, hh = (unit >> 3) & 3, tblk = unit & 7, tid = c.tid, lane = c.lane, wv = c.wave;
    LAS bf16_t* Ks = (LAS bf16_t*)c.shm;
    LAS bf16_t* Vs = (LAS bf16_t*)(c.shm + 256 * 272);
    LAS float* qf = (LAS float*)(c.shm + 256 * 272 + 256 * 256) + wv * 384;
    LAS float* pr = qf + 128;
    const bf16_t* MKV = (const bf16_t*)(p.ws + OFF_MKV); const bf16_t* Q = (const bf16_t*)(p.ws + OFF_P); bf16_t* OA = (bf16_t*)(p.ws + OFF_P + 32 * MiB);
    __syncthreads();
#pragma unroll 1
    for (int i = 0; i < 16; ++i) {
        const int task = tid + 512 * i, which = task >> 12, r = (task >> 4) & 255, ck = task & 15;
        const u32x4 d = *(const u32x4*)(MKV + ((size_t)b * MEMLEN + r) * 1024 + which * 512 + hh * 128 + ck * 8);
        if (which == 0) *(LAS u32x4*)(Ks + r * 136 + ck * 8) = d; else *(LAS u32x4*)(Vs + r * 128 + ck * 8) = d;
    }
    __syncthreads();
#pragma unroll 1
    for (int qq = 0; qq < 64; ++qq) {
        const size_t tq = (size_t)b * SEQ + tblk * 512 + wv * 64 + qq;
        qf[lane] = bf2f(Q[tq * 512 + hh * 128 + lane]) * 0.08838834764831845f; qf[lane + 64] = bf2f(Q[tq * 512 + hh * 128 + 64 + lane]) * 0.08838834764831845f;
        LDS_WAIT();
        float s[4];
#pragma unroll
        for (int j = 0; j < 4; ++j) { const int kp = lane + 64 * j; float a = 0.f;
#pragma unroll
            for (int ck = 0; ck < 16; ++ck) { const u32x4 kk = *(const LAS u32x4*)(Ks + kp * 136 + ck * 8);
                const f32x4 q0 = *(const LAS f32x4*)(qf + ck * 8), q1 = *(const LAS f32x4*)(qf + ck * 8 + 4);
                a += bflo(kk.x) * q0.x + bfhi(kk.x) * q0.y + bflo(kk.y) * q0.z + bfhi(kk.y) * q0.w + bflo(kk.z) * q1.x + bfhi(kk.z) * q1.y + bflo(kk.w) * q1.z + bfhi(kk.w) * q1.w; }
            s[j] = a; }
        const float m = wave_max(fmaxf(fmaxf(s[0], s[1]), fmaxf(s[2], s[3])));
        float den = 0.f;
#pragma unroll
        for (int j = 0; j < 4; ++j) { const float e = __expf(s[j] - m); pr[lane + 64 * j] = e; den += e; }
        den = wave_sum(den);
        LDS_WAIT();
        float o0 = 0.f, o1 = 0.f;
#pragma unroll 4
        for (int k4 = 0; k4 < 64; ++k4) { const f32x4 p4 = *(const LAS f32x4*)(pr + 4 * k4);
#pragma unroll
            for (int kk = 0; kk < 4; ++kk) { const unsigned vv = *(const LAS unsigned*)(Vs + (4 * k4 + kk) * 128 + 2 * lane); o0 += p4[kk] * bflo(vv); o1 += p4[kk] * bfhi(vv); } }
        const float inv = 1.0f / den;
        *(unsigned*)(OA + tq * 512 + hh * 128 + 2 * lane) = pk2(o0 * inv, o1 * inv);
    }
}

__device__ __forceinline__ void moe_slots(const Ctx& c, const Params& p, int layer) {
    LAS int* sh = (LAS int*)c.shm;
    const int* cnt = (const int*)(p.ws + OFF_CTL + CTL_CNT) + layer * 32; int* cur = (int*)(p.ws + OFF_CTL + CTL_CUR) + layer * 32;
    int* blk = (int*)(p.ws + OFF_CTL + CTL_BLK) + layer * 1024;
    __syncthreads();
    if (c.tid == 0) { int acc = 0; for (int e = 0; e < NEXP; ++e) { sh[e] = acc; acc += (cnt[e] + 255) / 256 * 256; } sh[32] = acc; }
    __syncthreads();
    if (blockIdx.x == 0 && c.tid < NEXP) { const int e = c.tid, s = sh[e] / 256, en = (e == NEXP - 1 ? sh[32] : sh[e + 1]) / 256; for (int i = s; i < en; ++i) blk[1 + i] = e; if (e == 0) blk[0] = sh[32] / 256; }
    const int2* RE = (const int2*)(p.ws + OFF_ROUTE); int2* RP = (int2*)(p.ws + OFF_ROUTE + 512 * 1024);
    const bf16_t* H = (const bf16_t*)(p.ws + OFF_H); bf16_t* XB = (bf16_t*)(p.ws + OFF_P);
    for (int ck = c.gw; ck < T_TOK / 64; ck += c.ngw) {
        const int t = ck * 64 + c.lane; const int2 ee = RE[t]; int pos0 = 0, pos1 = 0;
#pragma unroll 1
        for (int e = 0; e < NEXP; ++e) {
            const unsigned long long m0 = __ballot(ee.x == e), m1 = __ballot(ee.y == e);
            const int n0 = __popcll(m0), n1 = __popcll(m1);
            if (n0 + n1 == 0) continue;
            int base = 0; if (c.lane == 0) base = atomicAdd(&cur[e], n0 + n1);
            base = __shfl(base, 0) + sh[e];
            const unsigned long long lt = (1ull << c.lane) - 1ull;
            if (ee.x == e) pos0 = base + __popcll(m0 & lt);
            if (ee.y == e) pos1 = base + n0 + __popcll(m1 & lt);
        }
        RP[t] = make_int2(pos0, pos1);
#pragma unroll 1
        for (int i = 0; i < 64; ++i) { const int ti = ck * 64 + i, q0 = __shfl(pos0, i), q1 = __shfl(pos1, i);
            const u32x4 a = *((const u32x4*)(H + (size_t)ti * 1024) + c.lane), bq = *((const u32x4*)(H + (size_t)ti * 1024) + 64 + c.lane);
            *((u32x4*)(XB + (size_t)q0 * 1024) + c.lane) = a; *((u32x4*)(XB + (size_t)q0 * 1024) + 64 + c.lane) = bq;
            *((u32x4*)(XB + (size_t)q1 * 1024) + c.lane) = a; *((u32x4*)(XB + (size_t)q1 * 1024) + 64 + c.lane) = bq; }
    }
}
typedef short bf16x8_t __attribute__((ext_vector_type(8)));
constexpr size_t R_GK = 0, R_QT = 64 * MiB, R_ATT = 96 * MiB, R_KHT = 112 * MiB, R_GDEC = 144 * MiB;
__device__ __forceinline__ float wave_scan_incl(float x, int lane) {
#pragma unroll
    for (int d = 1; d < 64; d <<= 1) { const float y = __shfl_up(x, d); if (lane >= d) x += y; }
    return x;
}
__device__ __forceinline__ bf16x8_t pack8(const float (&v)[8]) {
    u32x4 w; w.x = pk2(v[0], v[1]); w.y = pk2(v[2], v[3]); w.z = pk2(v[4], v[5]); w.w = pk2(v[6], v[7]);
    return __builtin_bit_cast(bf16x8_t, w);
}
__device__ __forceinline__ void gla_prep(const Ctx& c, const Params& p, int unit) {
    const int bh = unit >> 6, ck = unit & 63, b = bh >> 2, hd = bh & 3, lane = c.lane, wv = c.wave;
    LAS bf16_t* Qs = (LAS bf16_t*)c.shm;
    LAS bf16_t* Ks = Qs + 64 * 136;
    const bf16_t* P = (const bf16_t*)(p.ws + OFF_P); unsigned char* R = p.ws + OFF_R;
    const float* GK = (const float*)(R + R_GK); bf16_t* QT = (bf16_t*)(R + R_QT) + (size_t)unit * 64 * 128; bf16_t* ATT = (bf16_t*)(R + R_ATT) + (size_t)unit * 64 * 64;
    bf16_t* KHT = (bf16_t*)(R + R_KHT) + (size_t)unit * 128 * 64; float* GDEC = (float*)(R + R_GDEC) + (size_t)unit * 128;
    const size_t tg = (size_t)b * SEQ + ck * 64 + lane; const int d0 = wv * 16;
    __syncthreads();
    {
        const bf16_t* row = P + tg * OD_IN;
        const u32x4 qa = *(const u32x4*)(row + hd * 128 + d0), qb = *(const u32x4*)(row + hd * 128 + d0 + 8);
        const u32x4 ka = *(const u32x4*)(row + 512 + hd * 128 + d0), kb = *(const u32x4*)(row + 512 + hd * 128 + d0 + 8);
        const unsigned qw[8] = {qa.x, qa.y, qa.z, qa.w, qb.x, qb.y, qb.z, qb.w}, kw[8] = {ka.x, ka.y, ka.z, ka.w, kb.x, kb.y, kb.z, kb.w};
        float qt[16], kt[16], kh[16];
#pragma unroll
        for (int i4 = 0; i4 < 4; ++i4) { const f32x4 g4 = *(const f32x4*)(GK + tg * 512 + hd * 128 + d0 + 4 * i4);
#pragma unroll
            for (int ii = 0; ii < 4; ++ii) { const int i = 4 * i4 + ii;
                const float bb = wave_scan_incl(g4[ii], lane); const float bl = __shfl(bb, 63);
                const float qv = (i & 1) ? bfhi(qw[i >> 1]) : bflo(qw[i >> 1]), kv = (i & 1) ? bfhi(kw[i >> 1]) : bflo(kw[i >> 1]);
                qt[i] = qv * 0.08838834764831845f * __expf(bb); kt[i] = kv * __expf(-bb); kh[i] = kv * __expf(bl - bb);
                if (lane == 63) GDEC[d0 + i] = __expf(bl); } }
        { u32x4 w0, w1; w0.x = pk2(qt[0], qt[1]); w0.y = pk2(qt[2], qt[3]); w0.z = pk2(qt[4], qt[5]); w0.w = pk2(qt[6], qt[7]); w1.x = pk2(qt[8], qt[9]); w1.y = pk2(qt[10], qt[11]); w1.z = pk2(qt[12], qt[13]); w1.w = pk2(qt[14], qt[15]);
          *(LAS u32x4*)(Qs + lane * 136 + d0) = w0; *(LAS u32x4*)(Qs + lane * 136 + d0 + 8) = w1; }
        { u32x4 w0, w1; w0.x = pk2(kt[0], kt[1]); w0.y = pk2(kt[2], kt[3]); w0.z = pk2(kt[4], kt[5]); w0.w = pk2(kt[6], kt[7]); w1.x = pk2(kt[8], kt[9]); w1.y = pk2(kt[10], kt[11]); w1.z = pk2(kt[12], kt[13]); w1.w = pk2(kt[14], kt[15]);
          *(LAS u32x4*)(Ks + lane * 136 + d0) = w0; *(LAS u32x4*)(Ks + lane * 136 + d0 + 8) = w1; }
        { const int sg = d0 >> 5, hb = (d0 >> 4) & 1;
#pragma unroll
          for (int x4 = 0; x4 < 4; ++x4) { u32x2 w; w.x = pk2(qt[4 * x4], qt[4 * x4 + 1]); w.y = pk2(qt[4 * x4 + 2], qt[4 * x4 + 3]);
              *(u32x2*)(QT + lane * 128 + 32 * sg + 8 * x4 + 4 * hb) = w; } }
#pragma unroll
        for (int i = 0; i < 16; ++i) KHT[(d0 + i) * 64 + lane] = (bf16_t)f2bf(kh[i]);
    }
    __syncthreads();
    const int fr = lane & 15, fq = lane >> 4;
#pragma unroll
    for (int h2 = 0; h2 < 2; ++h2) { const int tile = 2 * wv + h2, si = tile >> 2, ti = tile & 3;
        f32x4 acc = (f32x4){0.f, 0.f, 0.f, 0.f};
        if (si <= ti) {
#pragma unroll
            for (int kk = 0; kk < 4; ++kk) { const bf16x8_t a = *(const LAS bf16x8_t*)(Ks + (16 * si + fr) * 136 + 32 * kk + 8 * fq), bq = *(const LAS bf16x8_t*)(Qs + (16 * ti + fr) * 136 + 32 * kk + 8 * fq);
                acc = __builtin_amdgcn_mfma_f32_16x16x32_bf16(a, bq, acc, 0, 0, 0); } }
        const int t = 16 * ti + fr, s0 = 16 * si + 4 * fq;
        u32x2 w; w.x = pk2(s0 <= t ? acc[0] : 0.f, s0 + 1 <= t ? acc[1] : 0.f); w.y = pk2(s0 + 2 <= t ? acc[2] : 0.f, s0 + 3 <= t ? acc[3] : 0.f);
        *(u32x2*)(ATT + t * 64 + s0) = w; }
}
__device__ __forceinline__ void gla_state(const Ctx& c, const Params& p, int bh, int jt) {
    const int b = bh >> 2, hd = bh & 3, lane = c.lane, fr = lane & 15, fq = lane >> 4;
    const bf16_t* P = (const bf16_t*)(p.ws + OFF_P); unsigned char* R = p.ws + OFF_R; bf16_t* O = (bf16_t*)(p.ws + OFF_H);
    f32x4 S[8];
#pragma unroll
    for (int i = 0; i < 8; ++i) S[i] = (f32x4){0.f, 0.f, 0.f, 0.f};
#pragma unroll 1
    for (int ck = 0; ck < 64; ++ck) {
        const int unit = bh * 64 + ck; const size_t t0 = (size_t)b * SEQ + ck * 64;
        const bf16_t* QT = (const bf16_t*)(R + R_QT) + (size_t)unit * 64 * 128; const bf16_t* ATT = (const bf16_t*)(R + R_ATT) + (size_t)unit * 64 * 64;
        const bf16_t* KHT = (const bf16_t*)(R + R_KHT) + (size_t)unit * 128 * 64; const float* GDEC = (const float*)(R + R_GDEC) + (size_t)unit * 128;
        bf16x8_t vf[2];
#pragma unroll
        for (int s2 = 0; s2 < 2; ++s2) { unsigned short e[8];
#pragma unroll
            for (int k = 0; k < 8; ++k) e[k] = P[(t0 + 32 * s2 + 8 * fq + k) * OD_IN + 1024 + hd * 256 + 16 * jt + fr];
            u32x4 w; w.x = e[0] | ((unsigned)e[1] << 16); w.y = e[2] | ((unsigned)e[3] << 16); w.z = e[4] | ((unsigned)e[5] << 16); w.w = e[6] | ((unsigned)e[7] << 16);
            vf[s2] = __builtin_bit_cast(bf16x8_t, w); }
        f32x4 acc[4];
#pragma unroll
        for (int ti = 0; ti < 4; ++ti) acc[ti] = (f32x4){0.f, 0.f, 0.f, 0.f};
#pragma unroll
        for (int sg = 0; sg < 4; ++sg) { const float sv[8] = {S[2 * sg][0], S[2 * sg][1], S[2 * sg][2], S[2 * sg][3], S[2 * sg + 1][0], S[2 * sg + 1][1], S[2 * sg + 1][2], S[2 * sg + 1][3]};
            const bf16x8_t a = pack8(sv);
#pragma unroll
            for (int ti = 0; ti < 4; ++ti) { const bf16x8_t bq = *(const bf16x8_t*)(QT + (16 * ti + fr) * 128 + 32 * sg + 8 * fq); acc[ti] = __builtin_amdgcn_mfma_f32_16x16x32_bf16(a, bq, acc[ti], 0, 0, 0); } }
#pragma unroll
        for (int s2 = 0; s2 < 2; ++s2)
#pragma unroll
            for (int ti = 0; ti < 4; ++ti) { const bf16x8_t bq = *(const bf16x8_t*)(ATT + (16 * ti + fr) * 64 + 32 * s2 + 8 * fq); acc[ti] = __builtin_amdgcn_mfma_f32_16x16x32_bf16(vf[s2], bq, acc[ti], 0, 0, 0); }
#pragma unroll
        for (int ti = 0; ti < 4; ++ti) { u32x2 w; w.x = pk2(acc[ti][0], acc[ti][1]); w.y = pk2(acc[ti][2], acc[ti][3]);
            *(u32x2*)(O + (t0 + 16 * ti + fr) * 1024 + hd * 256 + 16 * jt + 4 * fq) = w; }
#pragma unroll
        for (int rt = 0; rt < 8; ++rt) { const f32x4 g4 = *(const f32x4*)(GDEC + 16 * rt + 4 * fq); f32x4 s = S[rt] * g4;
#pragma unroll
            for (int s2 = 0; s2 < 2; ++s2) { const bf16x8_t a = *(const bf16x8_t*)(KHT + (16 * rt + fr) * 64 + 32 * s2 + 8 * fq); s = __builtin_amdgcn_mfma_f32_16x16x32_bf16(a, vf[s2], s, 0, 0, 0); }
            S[rt] = s; }
    }
}
__device__ __forceinline__ void gla_finish(const Ctx& c, const Params& p) {
    const bf16_t* P = (const bf16_t*)(p.ws + OFF_P); bf16_t* O = (bf16_t*)(p.ws + OFF_H);
    for (int r = c.gw; r < T_TOK; r += c.ngw) {
#pragma unroll
        for (int j = 0; j < 4; ++j) {
            const u32x2 ow = *((const u32x2*)(O + (size_t)r * 1024 + 256 * j) + c.lane), gw = *((const u32x2*)(P + (size_t)r * OD_IN + 2048 + 256 * j) + c.lane);
            const float o0 = bflo(ow.x), o1 = bfhi(ow.x), o2 = bflo(ow.y), o3 = bfhi(ow.y);
            const float ss = wave_sum(o0 * o0 + o1 * o1 + o2 * o2 + o3 * o3); const float rs = 1.0f / sqrtf(ss * (1.0f / 256.0f) + 1e-6f);
            const f32x4 gn = *((const f32x4*)p.od_onorm + c.lane);
            const float g0 = bflo(gw.x), g1 = bfhi(gw.x), g2 = bflo(gw.y), g3 = bfhi(gw.y);
            u32x2 w; w.x = pk2(o0 * rs * gn.x * g0 * sigmoidf_(g0), o1 * rs * gn.y * g1 * sigmoidf_(g1)); w.y = pk2(o2 * rs * gn.z * g2 * sigmoidf_(g2), o3 * rs * gn.w * g3 * sigmoidf_(g3));
            *((u32x2*)(O + (size_t)r * 1024 + 256 * j) + c.lane) = w; }
    }
}

constexpr size_t R_MG = 0, R_NT = 32 * MiB, R_QG = 64 * MiB, R_Y0 = 96 * MiB, R_Z0 = 128 * MiB, R_GAM = 160 * MiB, R_BON = 161 * MiB, R_MEMN = 164 * MiB;
constexpr size_t WSM_G2T = 512 * 1024;
constexpr int XI = 64 * 72 * 2;
constexpr int X_RHS = 11 * XI, X_DIAG = X_RHS + 34816, X_TI = X_DIAG + 4352, X_RED = X_TI + 3072;
__device__ __forceinline__ bf16x8_t lds_frag(const LAS bf16_t* img, int pitch, int row, int col) { return *(const LAS bf16x8_t*)(img + row * pitch + col); }
__device__ __forceinline__ bf16x8_t zero_frag() { return (bf16x8_t){0, 0, 0, 0, 0, 0, 0, 0}; }

__device__ __forceinline__ void rwkv_x(const Ctx& c, const Params& p, int unit) {
    const int bh = unit >> 6, ck = unit & 63, b = bh >> 3, hd = bh & 7, tid = c.tid, lane = c.lane, wv = c.wave, fr = lane & 15, fq = lane >> 4;
    unsigned char* sm = c.shm;
    LAS bf16_t* At = (LAS bf16_t*)sm; LAS bf16_t* Bt = (LAS bf16_t*)(sm + XI); LAS bf16_t* Kt = (LAS bf16_t*)(sm + 2 * XI); LAS bf16_t* Rt = (LAS bf16_t*)(sm + 3 * XI);
    LAS bf16_t* BH = (LAS bf16_t*)(sm + 4 * XI); LAS bf16_t* KH = (LAS bf16_t*)(sm + 5 * XI); LAS bf16_t* VT = (LAS bf16_t*)(sm + 6 * XI);
    LAS bf16_t* AAB = (LAS bf16_t*)(sm + 7 * XI); LAS bf16_t* AAK = (LAS bf16_t*)(sm + 8 * XI); LAS bf16_t* ARB = (LAS bf16_t*)(sm + 9 * XI); LAS bf16_t* ARK = (LAS bf16_t*)(sm + 10 * XI);
    LAS bf16_t* XT = At;
    LAS bf16_t* YT = Kt;
    LAS float* RHS = (LAS float*)(sm + X_RHS);
    LAS float* sXW = RHS; LAS float* sXA = RHS + 64 * 68;
    LAS float* DIAG = (LAS float*)(sm + X_DIAG);
    LAS bf16_t* TI = (LAS bf16_t*)(sm + X_TI);
    LAS float* red = (LAS float*)(sm + X_RED);
    const bf16_t* P = (const bf16_t*)(p.ws + OFF_P); unsigned char* R = p.ws + OFF_R;
    const size_t tg0 = (size_t)b * SEQ + (size_t)ck * 64;
    const int t = lane, cg = wv, ch0 = hd * 64 + cg * 8;
    __syncthreads();
#pragma unroll 1
    for (int i = 0; i < 2; ++i) {
        const int task = tid + 512 * i, tt = task >> 4, q = task & 15;
        const int col = 1536 + 8 * q; LAS float* dst = (q < 8 ? sXW + tt * 68 + 8 * q : sXA + tt * 68 + 8 * (q - 8));
        const bf16_t* src = P + (tg0 + tt) * EV_IN + 768 + col;
        const u32x4 cur = *(const u32x4*)src; u32x4 prv = (u32x4){0u, 0u, 0u, 0u};
        if (ck * 64 + tt > 0) prv = *(const u32x4*)(src - EV_IN);
        const f32x4 m0 = *(const f32x4*)(p.ev_mu + col), m1 = *(const f32x4*)(p.ev_mu + col + 4);
        const unsigned cw[4] = {cur.x, cur.y, cur.z, cur.w}, pw[4] = {prv.x, prv.y, prv.z, prv.w}; const float mu[8] = {m0.x, m0.y, m0.z, m0.w, m1.x, m1.y, m1.z, m1.w};
        float v[8];
#pragma unroll
        for (int k = 0; k < 4; ++k) { const float c0 = bflo(cw[k]), c1 = bfhi(cw[k]), p0 = bflo(pw[k]), p1 = bfhi(pw[k]); v[2 * k] = c0 + (p0 - c0) * mu[2 * k]; v[2 * k + 1] = c1 + (p1 - c1) * mu[2 * k + 1]; }
        if (q < 8) {
#pragma unroll
            for (int k = 0; k < 8; ++k) v[k] = tanhf(v[k]); }
        *(LAS f32x4*)dst = (f32x4){v[0], v[1], v[2], v[3]}; *(LAS f32x4*)(dst + 4) = (f32x4){v[4], v[5], v[6], v[7]};
    }
    float rv[8], kv[8], vv[8];
    {
        const bf16_t* src = P + (tg0 + t) * EV_IN + 768 + ch0; const bool hp = (ck * 64 + t > 0);
#pragma unroll
        for (int w3 = 0; w3 < 3; ++w3) { const u32x4 cur = *(const u32x4*)(src + 512 * w3); u32x4 prv = (u32x4){0u, 0u, 0u, 0u}; if (hp) prv = *(const u32x4*)(src + 512 * w3 - EV_IN);
            const f32x4 m0 = *(const f32x4*)(p.ev_mu + 512 * w3 + ch0), m1 = *(const f32x4*)(p.ev_mu + 512 * w3 + ch0 + 4);
            const unsigned cw[4] = {cur.x, cur.y, cur.z, cur.w}, pw[4] = {prv.x, prv.y, prv.z, prv.w}; const float mu[8] = {m0.x, m0.y, m0.z, m0.w, m1.x, m1.y, m1.z, m1.w};
#pragma unroll
            for (int k = 0; k < 4; ++k) { const float c0 = bflo(cw[k]), c1 = bfhi(cw[k]), p0 = bflo(pw[k]), p1 = bfhi(pw[k]);
                const float x0 = c0 + (p0 - c0) * mu[2 * k], x1 = c1 + (p1 - c1) * mu[2 * k + 1];
                if (w3 == 0) { rv[2 * k] = x0; rv[2 * k + 1] = x1; } else if (w3 == 1) { kv[2 * k] = x0; kv[2 * k + 1] = x1; } else { vv[2 * k] = x0; vv[2 * k + 1] = x1; } } }
    }
    __syncthreads();
    float zw[8], za[8];
#pragma unroll
    for (int i = 0; i < 8; ++i) { zw[i] = 0.f; za[i] = 0.f; }
#pragma unroll 2
    for (int j4 = 0; j4 < 16; ++j4) {
        const f32x4 xw = *(const LAS f32x4*)(sXW + t * 68 + 4 * j4), xa = *(const LAS f32x4*)(sXA + t * 68 + 4 * j4);
#pragma unroll
        for (int jj = 0; jj < 4; ++jj) { const int j = 4 * j4 + jj;
            const f32x4 w2a = *(const f32x4*)(p.ev_w2 + (size_t)j * 512 + ch0), w2b = *(const f32x4*)(p.ev_w2 + (size_t)j * 512 + ch0 + 4);
            const f32x4 a2a = *(const f32x4*)(p.ev_a2 + (size_t)j * 512 + ch0), a2b = *(const f32x4*)(p.ev_a2 + (size_t)j * 512 + ch0 + 4);
            const float xwv = xw[jj], xav = xa[jj];
#pragma unroll
            for (int i = 0; i < 4; ++i) { zw[i] += xwv * w2a[i]; zw[4 + i] += xwv * w2b[i]; za[i] += xav * a2a[i]; za[4 + i] += xav * a2b[i]; } }
    }
    float lw[8], av[8], kkv[8], kp[8]; float ss = 0.f, sb = 0.f;
#pragma unroll
    for (int i = 0; i < 8; ++i) { const int ch = ch0 + i;
        const float u = -(p.ev_w0[ch] + zw[i]); const float sp = (u > 20.f) ? u : log1pf(__expf(u));
        lw[i] = -__expf(-sp - 0.5f);
        av[i] = sigmoidf_(p.ev_a0[ch] + za[i]);
        kkv[i] = kv[i] * p.ev_k_k[ch]; ss += kkv[i] * kkv[i];
        kp[i] = kv[i] * (1.0f + (av[i] - 1.0f) * p.ev_k_a[ch]);
        sb += rv[i] * kp[i] * p.ev_r_k[ch]; }
    red[t * 8 + cg] = ss; red[512 + t * 8 + cg] = sb;
    __syncthreads();
    {
        float tot = 0.f, bon = 0.f;
#pragma unroll
        for (int i = 0; i < 8; ++i) { tot += red[t * 8 + i]; bon += red[512 + t * 8 + i]; }
        if (cg == 0) ((float*)(R + R_BON))[(tg0 + t) * 8 + hd] = bon;
        const float inv = 1.0f / fmaxf(sqrtf(tot), 1e-12f);
        float at[8], rt_[8], bt[8], kt[8], bh_[8], kh_[8];
#pragma unroll
        for (int i = 0; i < 8; ++i) {
            const float cl = wave_scan_incl(lw[i], lane); const float cl63 = __shfl(cl, 63);
            const float e1 = __expf(cl), e0 = __expf(cl - lw[i]), en = __expf(-cl), eh = __expf(cl63 - cl);
            const float kn = kkv[i] * inv, A = -kn, Bv = kn * av[i];
            at[i] = A * e0; rt_[i] = rv[i] * e1; bt[i] = Bv * en; kt[i] = kp[i] * en; bh_[i] = Bv * eh; kh_[i] = kp[i] * eh;
            if (lane == 63) ((float*)(R + R_GAM))[(size_t)unit * 64 + cg * 8 + i] = __expf(cl63); }
        { u32x4 w; w.x = pk2(at[0], at[1]); w.y = pk2(at[2], at[3]); w.z = pk2(at[4], at[5]); w.w = pk2(at[6], at[7]); *(LAS u32x4*)(At + t * 72 + cg * 8) = w; }
        { u32x4 w; w.x = pk2(rt_[0], rt_[1]); w.y = pk2(rt_[2], rt_[3]); w.z = pk2(rt_[4], rt_[5]); w.w = pk2(rt_[6], rt_[7]); *(LAS u32x4*)(Rt + t * 72 + cg * 8) = w; }
        { u32x4 w; w.x = pk2(bt[0], bt[1]); w.y = pk2(bt[2], bt[3]); w.z = pk2(bt[4], bt[5]); w.w = pk2(bt[6], bt[7]); *(LAS u32x4*)(Bt + t * 72 + cg * 8) = w; }
        { u32x4 w; w.x = pk2(kt[0], kt[1]); w.y = pk2(kt[2], kt[3]); w.z = pk2(kt[4], kt[5]); w.w = pk2(kt[6], kt[7]); *(LAS u32x4*)(Kt + t * 72 + cg * 8) = w; }
        *(LAS f32x4*)(RHS + t * 132 + 64 + cg * 8) = (f32x4){at[0], at[1], at[2], at[3]}; *(LAS f32x4*)(RHS + t * 132 + 64 + cg * 8 + 4) = (f32x4){at[4], at[5], at[6], at[7]};
#pragma unroll
        for (int i = 0; i < 8; ++i) { BH[(cg * 8 + i) * 72 + t] = (bf16_t)f2bf(bh_[i]); KH[(cg * 8 + i) * 72 + t] = (bf16_t)f2bf(kh_[i]); VT[(cg * 8 + i) * 72 + t] = (bf16_t)f2bf(vv[i]); }
    }
    __syncthreads();
    {
        const int mat = wv >> 1;
        const LAS bf16_t* Ximg = (mat < 2) ? At : Rt; const LAS bf16_t* Yimg = (mat & 1) ? Kt : Bt;
        LAS bf16_t* Oimg = mat == 0 ? AAB : (mat == 1 ? AAK : (mat == 2 ? ARB : ARK));
#pragma unroll 1
        for (int n = 0; n < 8; ++n) { const int idx = (wv & 1) * 8 + n, si = idx >> 2, ti = idx & 3;
            f32x4 acc = (f32x4){0.f, 0.f, 0.f, 0.f};
            if (si <= ti) {
#pragma unroll
                for (int kk = 0; kk < 2; ++kk) acc = __builtin_amdgcn_mfma_f32_16x16x32_bf16(lds_frag(Yimg, 72, 16 * si + fr, 32 * kk + 8 * fq), lds_frag(Ximg, 72, 16 * ti + fr, 32 * kk + 8 * fq), acc, 0, 0, 0); }
            const int tt = 16 * ti + fr, s0 = 16 * si + 4 * fq; const int lim = (mat < 2) ? tt - 1 : tt;
            const float o0 = s0 <= lim ? acc[0] : 0.f, o1 = s0 + 1 <= lim ? acc[1] : 0.f, o2 = s0 + 2 <= lim ? acc[2] : 0.f, o3 = s0 + 3 <= lim ? acc[3] : 0.f;
            u32x2 w; w.x = pk2(o0, o1); w.y = pk2(o2, o3); *(LAS u32x2*)(Oimg + tt * 72 + s0) = w;
            if (mat == 0 && si == ti) { LAS float* d = DIAG + si * 272 + fr * 17 + 4 * fq; d[0] = o0; d[1] = o1; d[2] = o2; d[3] = o3; } }
    }
    __syncthreads();
    {
#pragma unroll
        for (int h2 = 0; h2 < 2; ++h2) { const int tile = 2 * wv + h2, ti = tile >> 2, ji = tile & 3;
            f32x4 acc = (f32x4){0.f, 0.f, 0.f, 0.f};
#pragma unroll
            for (int kk = 0; kk < 2; ++kk) acc = __builtin_amdgcn_mfma_f32_16x16x32_bf16(lds_frag(AAK, 72, 16 * ti + fr, 32 * kk + 8 * fq), lds_frag(VT, 72, 16 * ji + fr, 32 * kk + 8 * fq), acc, 0, 0, 0);
#pragma unroll
            for (int r = 0; r < 4; ++r) RHS[(16 * ti + 4 * fq + r) * 132 + 16 * ji + fr] = acc[r]; }
        if (wv < 4 && lane < 16) { const LAS float* d = DIAG + wv * 272; float T[16];
#pragma unroll
            for (int r = 0; r < 16; ++r) { float s = (r == lane) ? 1.f : 0.f;
#pragma unroll
                for (int q = 0; q < r; ++q) s += d[r * 17 + q] * T[q];
                T[r] = s; TI[wv * 384 + r * 24 + lane] = (bf16_t)f2bf(s); } }
    }
    __syncthreads();
#pragma unroll 1
    for (int I = 0; I < 4; ++I) {
        f32x4 acc;
#pragma unroll
        for (int r = 0; r < 4; ++r) acc[r] = RHS[(16 * I + 4 * fq + r) * 132 + 16 * wv + fr];
#pragma unroll 1
        for (int kk = 0; 32 * kk < 16 * I; ++kk) { const bool ok = (32 * kk + 8 * fq) < 16 * I;
            bf16x8_t a = zero_frag(), bq = zero_frag();
            if (ok) { a = lds_frag(AAB, 72, 16 * I + fr, 32 * kk + 8 * fq); bq = lds_frag(XT, 72, 16 * wv + fr, 32 * kk + 8 * fq); }
            acc = __builtin_amdgcn_mfma_f32_16x16x32_bf16(a, bq, acc, 0, 0, 0); }
        { u32x2 w; w.x = pk2(acc[0], acc[1]); w.y = pk2(acc[2], acc[3]); *(LAS u32x2*)(YT + (16 * wv + fr) * 24 + 4 * fq) = w; }
        __syncthreads();
        { bf16x8_t a = zero_frag(), bq = zero_frag();
          if (fq < 2) { a = *(const LAS bf16x8_t*)(TI + I * 384 + fr * 24 + 8 * fq); bq = *(const LAS bf16x8_t*)(YT + (16 * wv + fr) * 24 + 8 * fq); }
          f32x4 x = __builtin_amdgcn_mfma_f32_16x16x32_bf16(a, bq, (f32x4){0.f, 0.f, 0.f, 0.f}, 0, 0, 0);
          u32x2 w; w.x = pk2(x[0], x[1]); w.y = pk2(x[2], x[3]); *(LAS u32x2*)(XT + (16 * wv + fr) * 72 + 16 * I + 4 * fq) = w; }
        __syncthreads();
    }
    {
        const int mat = wv >> 1;
        bf16_t* MG = (bf16_t*)(R + R_MG) + (size_t)unit * 4096; bf16_t* NT = (bf16_t*)(R + R_NT) + (size_t)unit * 4096;
        bf16_t* QG = (bf16_t*)(R + R_QG) + (size_t)unit * 4096; bf16_t* Y0G = (bf16_t*)(R + R_Y0) + (size_t)unit * 4096;
#pragma unroll 1
        for (int n = 0; n < 8; ++n) { const int idx = (wv & 1) * 8 + n, rt = idx >> 2, ct = idx & 3;
            f32x4 acc = (f32x4){0.f, 0.f, 0.f, 0.f};
            if (mat == 2) { const u32x2 r2 = *(const LAS u32x2*)(Rt + (16 * ct + fr) * 72 + 16 * rt + 4 * fq); acc = (f32x4){bflo(r2.x), bfhi(r2.x), bflo(r2.y), bfhi(r2.y)}; }
#pragma unroll
            for (int kk = 0; kk < 2; ++kk) { const int kc = 32 * kk + 8 * fq;
                if (mat == 0) acc = __builtin_amdgcn_mfma_f32_16x16x32_bf16(lds_frag(XT, 72, 64 + 16 * rt + fr, kc), lds_frag(BH, 72, 16 * ct + fr, kc), acc, 0, 0, 0);
                else if (mat == 1) { acc = __builtin_amdgcn_mfma_f32_16x16x32_bf16(lds_frag(BH, 72, 16 * rt + fr, kc), lds_frag(XT, 72, 16 * ct + fr, kc), acc, 0, 0, 0);
                                     acc = __builtin_amdgcn_mfma_f32_16x16x32_bf16(lds_frag(KH, 72, 16 * rt + fr, kc), lds_frag(VT, 72, 16 * ct + fr, kc), acc, 0, 0, 0); }
                else if (mat == 2) acc = __builtin_amdgcn_mfma_f32_16x16x32_bf16(lds_frag(XT, 72, 64 + 16 * rt + fr, kc), lds_frag(ARB, 72, 16 * ct + fr, kc), acc, 0, 0, 0);
                else { acc = __builtin_amdgcn_mfma_f32_16x16x32_bf16(lds_frag(XT, 72, 16 * rt + fr, kc), lds_frag(ARB, 72, 16 * ct + fr, kc), acc, 0, 0, 0);
                       acc = __builtin_amdgcn_mfma_f32_16x16x32_bf16(lds_frag(VT, 72, 16 * rt + fr, kc), lds_frag(ARK, 72, 16 * ct + fr, kc), acc, 0, 0, 0); } }
            u32x2 w; w.x = pk2(acc[0], acc[1]); w.y = pk2(acc[2], acc[3]);
            if (mat == 0) *(u32x2*)(MG + (16 * ct + fr) * 64 + 32 * (rt >> 1) + 8 * fq + 4 * (rt & 1)) = w;
            else if (mat == 1) *(u32x2*)(NT + (16 * ct + fr) * 64 + 16 * rt + 4 * fq) = w;
            else if (mat == 2) *(u32x2*)(QG + (16 * ct + fr) * 64 + 16 * rt + 4 * fq) = w;
            else *(u32x2*)(Y0G + (16 * ct + fr) * 64 + 16 * rt + 4 * fq) = w; }
    }
}

__device__ __forceinline__ void rwkv_y(const Ctx& c, const Params& p, int bh, int jb) {
    const int lane = c.lane, fr = lane & 15, fq = lane >> 4; unsigned char* R = p.ws + OFF_R;
    f32x4 Z[4];
#pragma unroll
    for (int i = 0; i < 4; ++i) Z[i] = (f32x4){0.f, 0.f, 0.f, 0.f};
#pragma unroll 1
    for (int ck = 0; ck < 64; ++ck) { const size_t unit = (size_t)bh * 64 + ck;
        const bf16_t* MG = (const bf16_t*)(R + R_MG) + unit * 4096; const bf16_t* NT = (const bf16_t*)(R + R_NT) + unit * 4096; bf16_t* Z0 = (bf16_t*)(R + R_Z0) + unit * 4096;
        const float* GAM = (const float*)(R + R_GAM) + unit * 64;
        f32x4 acc[4];
#pragma unroll
        for (int rt = 0; rt < 4; ++rt) { u32x2 w; w.x = pk2(Z[rt][0], Z[rt][1]); w.y = pk2(Z[rt][2], Z[rt][3]); *(u32x2*)(Z0 + (16 * jb + fr) * 64 + 16 * rt + 4 * fq) = w;
            const u32x2 n2 = *(const u32x2*)(NT + (16 * jb + fr) * 64 + 16 * rt + 4 * fq); const f32x4 g4 = *(const f32x4*)(GAM + 16 * rt + 4 * fq);
            acc[rt] = (f32x4){bflo(n2.x), bfhi(n2.x), bflo(n2.y), bfhi(n2.y)} + g4 * Z[rt]; }
        bf16x8_t zb[2];
#pragma unroll
        for (int sg = 0; sg < 2; ++sg) { const float zv[8] = {Z[2 * sg][0], Z[2 * sg][1], Z[2 * sg][2], Z[2 * sg][3], Z[2 * sg + 1][0], Z[2 * sg + 1][1], Z[2 * sg + 1][2], Z[2 * sg + 1][3]}; zb[sg] = pack8(zv); }
#pragma unroll
        for (int rt = 0; rt < 4; ++rt)
#pragma unroll
            for (int sg = 0; sg < 2; ++sg) { const bf16x8_t a = *(const bf16x8_t*)(MG + (16 * rt + fr) * 64 + 32 * sg + 8 * fq); acc[rt] = __builtin_amdgcn_mfma_f32_16x16x32_bf16(a, zb[sg], acc[rt], 0, 0, 0); }
#pragma unroll
        for (int rt = 0; rt < 4; ++rt) Z[rt] = acc[rt];
    }
}

__device__ __forceinline__ void rwkv_z(const Ctx& c, const Params& p, int unit) {
    const int bh = unit >> 6, ck = unit & 63, b = bh >> 3, hd = bh & 7, lane = c.lane, fr = lane & 15, fq = lane >> 4; unsigned char* R = p.ws + OFF_R;
    const bf16_t* P = (const bf16_t*)(p.ws + OFF_P); bf16_t* MIX = (bf16_t*)(p.ws + OFF_H);
    const bf16_t* QG = (const bf16_t*)(R + R_QG) + (size_t)unit * 4096; const bf16_t* Y0G = (const bf16_t*)(R + R_Y0) + (size_t)unit * 4096; const bf16_t* Z0 = (const bf16_t*)(R + R_Z0) + (size_t)unit * 4096;
    const bf16_t* G2T = (const bf16_t*)(p.ws + OFF_WSMALL + WSM_G2T);
    const size_t tg0 = (size_t)b * SEQ + (size_t)ck * 64;
    f32x4 y[4][4], g[4][4];
#pragma unroll
    for (int jt = 0; jt < 4; ++jt)
#pragma unroll
        for (int tt = 0; tt < 4; ++tt) { const u32x2 w = *(const u32x2*)(Y0G + (16 * tt + fr) * 64 + 16 * jt + 4 * fq); y[jt][tt] = (f32x4){bflo(w.x), bfhi(w.x), bflo(w.y), bfhi(w.y)}; g[jt][tt] = (f32x4){0.f, 0.f, 0.f, 0.f}; }
#pragma unroll
    for (int sg = 0; sg < 2; ++sg) { bf16x8_t qb[4];
#pragma unroll
        for (int tt = 0; tt < 4; ++tt) qb[tt] = *(const bf16x8_t*)(QG + (16 * tt + fr) * 64 + 32 * sg + 8 * fq);
#pragma unroll
        for (int jt = 0; jt < 4; ++jt) { const bf16x8_t a = *(const bf16x8_t*)(Z0 + (16 * jt + fr) * 64 + 32 * sg + 8 * fq);
#pragma unroll
            for (int tt = 0; tt < 4; ++tt) y[jt][tt] = __builtin_amdgcn_mfma_f32_16x16x32_bf16(a, qb[tt], y[jt][tt], 0, 0, 0); } }
#pragma unroll 1
    for (int kk = 0; kk < 4; ++kk) { bf16x8_t sgf[4];
        const int col = 1664 + 32 * kk + 8 * fq; const f32x4 m0 = *(const f32x4*)(p.ev_mu + col), m1 = *(const f32x4*)(p.ev_mu + col + 4); const float mu[8] = {m0.x, m0.y, m0.z, m0.w, m1.x, m1.y, m1.z, m1.w};
#pragma unroll
        for (int tt = 0; tt < 4; ++tt) { const int tl = 16 * tt + fr; const bf16_t* src = P + (tg0 + tl) * EV_IN + 768 + col;
            const u32x4 cur = *(const u32x4*)src; u32x4 prv = (u32x4){0u, 0u, 0u, 0u}; if (ck * 64 + tl > 0) prv = *(const u32x4*)(src - EV_IN);
            const unsigned cw[4] = {cur.x, cur.y, cur.z, cur.w}, pw[4] = {prv.x, prv.y, prv.z, prv.w}; float v[8];
#pragma unroll
            for (int k = 0; k < 4; ++k) { const float c0 = bflo(cw[k]), c1 = bfhi(cw[k]), p0 = bflo(pw[k]), p1 = bfhi(pw[k]); v[2 * k] = sigmoidf_(c0 + (p0 - c0) * mu[2 * k]); v[2 * k + 1] = sigmoidf_(c1 + (p1 - c1) * mu[2 * k + 1]); }
            sgf[tt] = pack8(v); }
#pragma unroll
        for (int jt = 0; jt < 4; ++jt) { const bf16x8_t a = *(const bf16x8_t*)(G2T + (size_t)(hd * 64 + 16 * jt + fr) * 128 + 32 * kk + 8 * fq);
#pragma unroll
            for (int tt = 0; tt < 4; ++tt) g[jt][tt] = __builtin_amdgcn_mfma_f32_16x16x32_bf16(a, sgf[tt], g[jt][tt], 0, 0, 0); } }
#pragma unroll
    for (int tt = 0; tt < 4; ++tt) { const int tl = 16 * tt + fr;
        float s1 = 0.f;
#pragma unroll
        for (int jt = 0; jt < 4; ++jt) s1 += (y[jt][tt][0] + y[jt][tt][1]) + (y[jt][tt][2] + y[jt][tt][3]);
        s1 += __shfl_xor(s1, 16); s1 += __shfl_xor(s1, 32); const float mean = s1 * (1.0f / 64.0f);
        float s2 = 0.f;
#pragma unroll
        for (int jt = 0; jt < 4; ++jt)
#pragma unroll
            for (int r = 0; r < 4; ++r) { const float d = y[jt][tt][r] - mean; s2 += d * d; }
        s2 += __shfl_xor(s2, 16); s2 += __shfl_xor(s2, 32); const float rs = 1.0f / sqrtf(s2 * (1.0f / 64.0f) + 64e-5f);
        const float bon = ((const float*)(R + R_BON))[(tg0 + tl) * 8 + hd]; const bool hp = (ck * 64 + tl > 0);
#pragma unroll
        for (int jt = 0; jt < 4; ++jt) { const int ch = hd * 64 + 16 * jt + 4 * fq;
            const bf16_t* src = P + (tg0 + tl) * EV_IN + 768 + 1024 + ch; const u32x2 cur = *(const u32x2*)src; u32x2 prv; prv.x = 0u; prv.y = 0u; if (hp) prv = *(const u32x2*)(src - EV_IN);
            const f32x4 mu = *(const f32x4*)(p.ev_mu + 1024 + ch), lw4 = *(const f32x4*)(p.ev_lnx_w + ch), lb4 = *(const f32x4*)(p.ev_lnx_b + ch);
            const float c0 = bflo(cur.x), c1 = bfhi(cur.x), c2 = bflo(cur.y), c3 = bfhi(cur.y), p0 = bflo(prv.x), p1 = bfhi(prv.x), p2 = bflo(prv.y), p3 = bfhi(prv.y);
            const float v0 = c0 + (p0 - c0) * mu.x, v1 = c1 + (p1 - c1) * mu.y, v2 = c2 + (p2 - c2) * mu.z, v3 = c3 + (p3 - c3) * mu.w;
            const f32x4 yy = y[jt][tt], gg = g[jt][tt];
            const float o0 = ((yy[0] - mean) * rs * lw4.x + lb4.x + bon * v0) * gg[0], o1 = ((yy[1] - mean) * rs * lw4.y + lb4.y + bon * v1) * gg[1];
            const float o2 = ((yy[2] - mean) * rs * lw4.z + lb4.z + bon * v2) * gg[2], o3 = ((yy[3] - mean) * rs * lw4.w + lb4.w + bon * v3) * gg[3];
            u32x2 w; w.x = pk2(o0, o1); w.y = pk2(o2, o3); *(u32x2*)(MIX + (tg0 + tl) * 1024 + 512 + ch) = w; } }
}

__device__ __forceinline__ int key_perm(int key) { const int kq = key & 31; return (key & ~31) + 8 * ((kq >> 2) & 3) + 4 * ((kq >> 4) & 1) + (kq & 3); }
__device__ __forceinline__ void xattn_mfma(const Ctx& c, const Params& p, int unit) {
    const int b = unit >> 5, hh = (unit >> 3) & 3, tblk = unit & 7, tid = c.tid, lane = c.lane, wv = c.wave, fr = lane & 15, fq = lane >> 4;
    LAS bf16_t* Ks = (LAS bf16_t*)c.shm;
    LAS bf16_t* VTp = (LAS bf16_t*)(c.shm + 256 * 272);
    const bf16_t* MKV = (const bf16_t*)(p.ws + OFF_MKV); const bf16_t* Q = (const bf16_t*)(p.ws + OFF_P); bf16_t* OA = (bf16_t*)(p.ws + OFF_P + 32 * MiB);
    __syncthreads();
#pragma unroll 1
    for (int i = 0; i < 16; ++i) {
        const int task = tid + 512 * i, which = task >> 12, r = (task >> 4) & 255, ck = task & 15;
        const u32x4 d = *(const u32x4*)(MKV + ((size_t)b * MEMLEN + r) * 1024 + which * 512 + hh * 128 + ck * 8);
        if (which == 0) *(LAS u32x4*)(Ks + r * 136 + ck * 8) = d;
        else { const int kc = key_perm(r); const unsigned w[4] = {d.x, d.y, d.z, d.w};
#pragma unroll
            for (int k = 0; k < 4; ++k) { VTp[(ck * 8 + 2 * k) * 264 + kc] = (bf16_t)(w[k] & 0xFFFFu); VTp[(ck * 8 + 2 * k + 1) * 264 + kc] = (bf16_t)(w[k] >> 16); } }
    }
    __syncthreads();
#pragma unroll 1
    for (int qt = 0; qt < 4; ++qt) {
        const size_t tq = (size_t)b * SEQ + tblk * 512 + wv * 64 + qt * 16 + fr;
        bf16x8_t qf[4];
#pragma unroll
        for (int kk = 0; kk < 4; ++kk) qf[kk] = *(const bf16x8_t*)(Q + tq * 512 + hh * 128 + 32 * kk + 8 * fq);
        f32x4 s[16];
#pragma unroll
        for (int kt = 0; kt < 16; ++kt) { s[kt] = (f32x4){0.f, 0.f, 0.f, 0.f};
#pragma unroll
            for (int kk = 0; kk < 4; ++kk) s[kt] = __builtin_amdgcn_mfma_f32_16x16x32_bf16(lds_frag(Ks, 136, 16 * kt + fr, 32 * kk + 8 * fq), qf[kk], s[kt], 0, 0, 0);
            if (kt & 1) __builtin_amdgcn_sched_barrier(0); }
        float m = s[0][0];
#pragma unroll
        for (int kt = 0; kt < 16; ++kt) m = fmaxf(fmaxf(fmaxf(m, s[kt][0]), fmaxf(s[kt][1], s[kt][2])), s[kt][3]);
        m = fmaxf(m, __shfl_xor(m, 16)); m = fmaxf(m, __shfl_xor(m, 32));
        float den = 0.f;
#pragma unroll
        for (int kt = 0; kt < 16; ++kt)
#pragma unroll
            for (int r = 0; r < 4; ++r) { const float e = __expf((s[kt][r] - m) * 0.08838834764831845f); s[kt][r] = e; den += e; }
        den += __shfl_xor(den, 16); den += __shfl_xor(den, 32);
        f32x4 o[8];
#pragma unroll
        for (int dt = 0; dt < 8; ++dt) o[dt] = (f32x4){0.f, 0.f, 0.f, 0.f};
#pragma unroll
        for (int sg = 0; sg < 8; ++sg) { const float pv[8] = {s[2 * sg][0], s[2 * sg][1], s[2 * sg][2], s[2 * sg][3], s[2 * sg + 1][0], s[2 * sg + 1][1], s[2 * sg + 1][2], s[2 * sg + 1][3]};
            const bf16x8_t pb = pack8(pv);
#pragma unroll
            for (int dt = 0; dt < 8; ++dt) o[dt] = __builtin_amdgcn_mfma_f32_16x16x32_bf16(lds_frag(VTp, 264, 16 * dt + fr, 32 * sg + 8 * fq), pb, o[dt], 0, 0, 0);
            __builtin_amdgcn_sched_barrier(0); }
        const float inv = 1.0f / den;
#pragma unroll
        for (int dt = 0; dt < 8; ++dt) { u32x2 w; w.x = pk2(o[dt][0] * inv, o[dt][1] * inv); w.y = pk2(o[dt][2] * inv, o[dt][3] * inv); *(u32x2*)(OA + tq * 512 + hh * 128 + 16 * dt + 4 * fq) = w; }
    }
}
__device__ __forceinline__ void swa_mfma(const Ctx& c, const Params& p, int unit) {
    const int b = unit >> 6, g = (unit >> 5) & 1, n = unit & 31, tid = c.tid, lane = c.lane, wv = c.wave, fr = lane & 15, fq = lane >> 4;
    LAS bf16_t* Ks = (LAS bf16_t*)c.shm;
    LAS bf16_t* VTp = (LAS bf16_t*)(c.shm + 256 * 144);
    const bf16_t* P = (const bf16_t*)(p.ws + OFF_P); bf16_t* MIX = (bf16_t*)(p.ws + OFF_H);
    __syncthreads();
#pragma unroll 1
    for (int i = 0; i < 8; ++i) {
        const int task = tid + 512 * i, which = task >> 11, r = (task >> 3) & 255, ck = task & 7;
        const int tk = n * 128 - 128 + r;
        u32x4 d = (u32x4){0u, 0u, 0u, 0u};
        if (tk >= 0) d = *(const u32x4*)(P + ((size_t)b * SEQ + tk) * EV_IN + 512 + which * 128 + g * 64 + ck * 8);
        if (which == 0) *(LAS u32x4*)(Ks + r * 72 + ck * 8) = d;
        else { const int kc = key_perm(r); const unsigned w[4] = {d.x, d.y, d.z, d.w};
#pragma unroll
            for (int k = 0; k < 4; ++k) { VTp[(ck * 8 + 2 * k) * 264 + kc] = (bf16_t)(w[k] & 0xFFFFu); VTp[(ck * 8 + 2 * k + 1) * 264 + kc] = (bf16_t)(w[k] >> 16); } }
    }
    __syncthreads();
#pragma unroll 1
    for (int it = 0; it < 4; ++it) {
        const int tile = wv * 4 + it, hql = tile >> 3, qb = tile & 7, head = g * 4 + hql, sg0 = qb >> 1;
        const int qi = 16 * qb + fr; const size_t tq = (size_t)b * SEQ + n * 128 + qi;
        const float sink = p.ev_sinks[head];
        bf16x8_t qf[2];
#pragma unroll
        for (int kk = 0; kk < 2; ++kk) qf[kk] = *(const bf16x8_t*)(P + tq * EV_IN + head * 64 + 32 * kk + 8 * fq);
        f32x4 s[10]; float m = sink;
#pragma unroll
        for (int i = 0; i < 10; ++i) { const int kt = 2 * sg0 + i; s[i] = (f32x4){0.f, 0.f, 0.f, 0.f};
#pragma unroll
            for (int kk = 0; kk < 2; ++kk) s[i] = __builtin_amdgcn_mfma_f32_16x16x32_bf16(lds_frag(Ks, 72, 16 * kt + fr, 32 * kk + 8 * fq), qf[kk], s[i], 0, 0, 0);
#pragma unroll
            for (int r = 0; r < 4; ++r) { const int kp = 16 * kt + 4 * fq + r; const bool valid = (kp >= qi + 1) && (kp <= qi + 128) && (n > 0 || kp >= 128);
                s[i][r] = valid ? s[i][r] * 0.125f : -INFINITY; m = fmaxf(m, s[i][r]); } }
        m = fmaxf(m, __shfl_xor(m, 16)); m = fmaxf(m, __shfl_xor(m, 32));
        float den = 0.f;
#pragma unroll
        for (int i = 0; i < 10; ++i)
#pragma unroll
            for (int r = 0; r < 4; ++r) { const float e = __expf(s[i][r] - m); s[i][r] = e; den += e; }
        den += __shfl_xor(den, 16); den += __shfl_xor(den, 32); den += __expf(sink - m);
        f32x4 o[4];
#pragma unroll
        for (int dt = 0; dt < 4; ++dt) o[dt] = (f32x4){0.f, 0.f, 0.f, 0.f};
#pragma unroll
        for (int i2 = 0; i2 < 5; ++i2) { const float pv[8] = {s[2 * i2][0], s[2 * i2][1], s[2 * i2][2], s[2 * i2][3], s[2 * i2 + 1][0], s[2 * i2 + 1][1], s[2 * i2 + 1][2], s[2 * i2 + 1][3]};
            const bf16x8_t pb = pack8(pv);
#pragma unroll
            for (int dt = 0; dt < 4; ++dt) o[dt] = __builtin_amdgcn_mfma_f32_16x16x32_bf16(lds_frag(VTp, 264, 16 * dt + fr, 32 * (sg0 + i2) + 8 * fq), pb, o[dt], 0, 0, 0); }
        const float inv = 1.0f / den;
#pragma unroll
        for (int dt = 0; dt < 4; ++dt) { u32x2 w; w.x = pk2(o[dt][0] * inv, o[dt][1] * inv); w.y = pk2(o[dt][2] * inv, o[dt][3] * inv); *(u32x2*)(MIX + tq * 1024 + head * 64 + 16 * dt + 4 * fq) = w; }
    }
}

constexpr int LDS_BYTES = 160 * 1024 - 64;
constexpr int N_PHASES = 25;

typedef const __attribute__((address_space(4))) Params* KParamsPtr;
__device__ __forceinline__ Params kparams() {
#if defined(__HIP_DEVICE_COMPILE__)
    KParamsPtr k = (KParamsPtr)__builtin_amdgcn_kernarg_segment_ptr(); asm volatile("" : "+s"(k)); return *k;
#else
    return Params{};
#endif
}
__device__ __forceinline__ Ctx mkctx(unsigned char* shm) {
    int tz = threadIdx.x; asm volatile("" : "+v"(tz));
    Ctx c; c.tid = tz; c.wave = __builtin_amdgcn_readfirstlane(tz >> 6); c.lane = tz & 63; c.gw = blockIdx.x * 8 + c.wave; c.ngw = 2048; c.shm = shm; return c;
}
__global__ void __launch_bounds__(512, 2) hybrid_fwd(Params p_in) {
    extern __shared__ __attribute__((aligned(16))) unsigned char shm[];
    constexpr int G = 256; const int bid = blockIdx.x;
    uint4* xbw = (uint4*)(shm + LDS_BYTES - 16);
    if (threadIdx.x == 0) *xbw = make_uint4(0u, 0u, 0u, 0u);
    __syncthreads();
    XcdBarrier bar = xcd_barrier_post((unsigned*)(kparams().ws + OFF_CTL), (volatile LAS unsigned*)xbw);
#ifndef KEEPMASK
#define KEEPMASK 0xFFFFFFFFu
#endif
#define INS(k, s) (((KEEPMASK) >> (s)) & 1u)
#define SEAM(k) do { XcdBarrier b2 = bar; b2.bar = (unsigned*)(kparams().ws + OFF_CTL); xcd_barrier(b2); } while (0)
#define PHASE_BEGIN const Params p = kparams(); const Ctx c = mkctx(shm); unsigned char* const ws = p.ws; (void)c; (void)ws;
#define glds ((PG8_LAS unsigned char*)shm)
#define WD ((bf16_t*)(ws + OFF_WD))
#define H ((bf16_t*)(ws + OFF_H))
#define P ((bf16_t*)(ws + OFF_P))
#define WS_F ((float*)(ws + OFF_WSMALL))
#define RE ((int2*)(ws + OFF_ROUTE))
#define RG ((float2*)(ws + OFF_ROUTE + 256 * 1024))
#define RP ((int2*)(ws + OFF_ROUTE + 512 * 1024))

    for (int layer = 0; layer < 2; ++layer) {
        const int pb = layer * 12;
        if (layer == 0) {
            if (INS(0, 0)) { PHASE_BEGIN
                tr_matrix(c, p.ev_w_in, EV_IN, 0, 1024, EV_IN, WD + WE_EV_IN, 0, 0);
                tr_matrix(c, p.ev_w_out, 1024, 0, 1024, 1024, WD + WE_EV_OUT, 0, 0);
                tr_matrix(c, p.od_w_in, OD_IN_SRC, 0, 1024, OD_IN, WD + WE_OD_IN, 0, 1);
                tr_matrix(c, p.od_w_out, 1024, 0, 1024, 1024, WD + WE_OD_OUT, 0, 0);
                tr_matrix(c, p.mem_wk, 512, 0, 1024, 512, WD + WE_MKV, 0, 0);
                tr_matrix(c, p.mem_wv, 512, 0, 1024, 512, WD + WE_MKV, 512, 0);
                for (int l = 0; l < 2; ++l) {
                    tr_matrix(c, p.xa_wq + (size_t)l * 1024 * 512, 512, 0, 1024, 512, WD + WE_WQ + (size_t)l * 512 * 1024, 0, 0);
                    tr_matrix(c, p.xa_wo + (size_t)l * 512 * 1024, 1024, 0, 512, 1024, WD + WE_WO + (size_t)l * 1024 * 512, 0, 0);
                }
                tr_moe_layer(c, p, 0);
                for (int i = bid * 512 + c.tid; i < 2 * 36 * 1024 + 16 * 1024; i += G * 512) {
                    if (i < 2 * 36 * 1024) { const int l = i / (36 * 1024), r = i % (36 * 1024), o = r >> 10, k = r & 1023;
                        WS_F[i] = o < 4 ? p.moe_w_group[((size_t)l * 1024 + k) * 4 + o] : p.moe_w_expert[((size_t)l * 1024 + k) * 32 + (o - 4)]; }
                    else { const int r = i - 2 * 36 * 1024, o = r >> 10, k = r & 1023; WS_F[i] = p.od_w_in[(size_t)k * OD_IN_SRC + 2048 + o]; }
                }
                norm_plain(c, p.mem, p.mem_norm, (bf16_t*)(ws + OFF_R + R_MEMN), NB * MEMLEN);
                for (int i = bid * 512 + c.tid; i < 512 * 128; i += G * 512) { const int ch = i >> 7, m = i & 127; ((bf16_t*)(ws + OFF_WSMALL + WSM_G2T))[i] = (bf16_t)f2bf(p.ev_g2[(size_t)m * 512 + ch]); }
                norm_plain(c, p.x, p.norm_mix, H, T_TOK);
                __syncthreads();
                SEAM(0);
            }
            if (INS(1, 1)) { PHASE_BEGIN
                { pg8::Gemm g{H, WD + WE_EV_IN, T_TOK, EV_IN, 1024, 0}; pg8::StaticOrder S; S.init(T_TOK, EV_IN, G, bid);
                  pg8::EpiB16 E{P, EV_IN}; pg8::gemm_phase<pg8::EpiB16, pg8::StaticOrder, true, true>(glds, g, S, E); }
                SEAM(1);
            }
            if (INS(2, 2)) { PHASE_BEGIN
#ifdef RWKV_NAIVE
                if (bid < 64) rwkv_naive(c, p, bid);
                else
#else
                for (int u = bid; u < 4096; u += G) rwkv_x(c, p, u);
                __syncthreads();
                SEAM(2);
            }
            if (INS(2, 2)) { PHASE_BEGIN
                if (bid < 64) { if (c.wave < 4) rwkv_y(c, p, bid, c.wave); }
                else
#endif
                {
                    for (int u = bid - 64; u < 512; u += G - 64) swa_mfma(c, p, u);
                    __syncthreads();
                    if (bid < 96) {
                        pg8::Gemm g{(const bf16_t*)(ws + OFF_R + R_MEMN), WD + WE_MKV, NB * MEMLEN, 1024, 1024, 0}; pg8::StaticOrder S; S.init(NB * MEMLEN, 1024, 32, bid - 64);
                        pg8::EpiB16 E{(bf16_t*)(ws + OFF_MKV), 1024}; pg8::gemm_phase<pg8::EpiB16, pg8::StaticOrder, true, true>(glds, g, S, E); }
                }
#ifndef RWKV_NAIVE
                __syncthreads();
                SEAM(2);
            }
            if (INS(2, 2)) { PHASE_BEGIN
                for (int u = c.gw; u < 4096; u += c.ngw) rwkv_z(c, p, u);
#endif
                __syncthreads();
                SEAM(2);
            }
        } else {
            if (INS(12, 12)) { PHASE_BEGIN
                const bf16_t* YB = P; const float* gdT = WS_F + 2 * 36 * 1024; float* GK = (float*)(ws + OFF_R);
                for (int r = c.gw; r < T_TOK; r += c.ngw) {
                    f32x4 v[4]; row_load(p.out + (size_t)r * 1024, c.lane, v);
                    const int2 ps = RP[r]; const float2 gt = RG[r];
                    row_combine(v, YB, ps.x, ps.y, gt.x, gt.y, c.lane);
                    row_store_f32(p.out + (size_t)r * 1024, c.lane, v);
                    const float rs = row_rstd(v); row_scale(v, rs, p.norm_mix + 1024, c.lane); row_store_bf16(H + (size_t)r * 1024, c.lane, v);
                    LAS float* gd = (LAS float*)shm + c.wave * 64; row_logits(v, gdT, c.lane, 16, gd);
                    float acc[8];
#pragma unroll
                    for (int i = 0; i < 8; ++i) acc[i] = p.od_gate_b[8 * c.lane + i];
#pragma unroll
                    for (int j = 0; j < 16; ++j) { const f32x4 u0 = *(const f32x4*)(p.od_gate_up + j * 512 + 8 * c.lane), u1 = *(const f32x4*)(p.od_gate_up + j * 512 + 8 * c.lane + 4);
                        acc[0] += gd[j] * u0.x; acc[1] += gd[j] * u0.y; acc[2] += gd[j] * u0.z; acc[3] += gd[j] * u0.w; acc[4] += gd[j] * u1.x; acc[5] += gd[j] * u1.y; acc[6] += gd[j] * u1.z; acc[7] += gd[j] * u1.w; }
#pragma unroll
                    for (int i = 0; i < 8; ++i) { const float xx = acc[i]; acc[i] = (fminf(xx, 0.f) - log1pf(__expf(-fabsf(xx)))) * (1.0f / 16.0f); }
                    *(f32x4*)(GK + (size_t)r * 512 + 8 * c.lane) = (f32x4){acc[0], acc[1], acc[2], acc[3]}; *(f32x4*)(GK + (size_t)r * 512 + 8 * c.lane + 4) = (f32x4){acc[4], acc[5], acc[6], acc[7]};
                }
                tr_moe_layer(c, p, 1);
                __syncthreads();
                SEAM(12);
            }
            if (INS(13, 13)) { PHASE_BEGIN
                pg8::Gemm g{H, WD + WE_OD_IN, T_TOK, OD_IN, 1024, 0}; pg8::StaticOrder S; S.init(T_TOK, OD_IN, G, bid);
                pg8::EpiB16 E{P, OD_IN}; pg8::gemm_phase<pg8::EpiB16, pg8::StaticOrder, true, true>(glds, g, S, E);
                SEAM(13);
            }
            if (INS(14, 14)) { PHASE_BEGIN
#ifdef GLA_NAIVE
                if (bid < 32) gla_naive(c, p, bid);
                __syncthreads();
                SEAM(14);
#else
                for (int u = bid; u < 2048; u += G) gla_prep(c, p, u);
                __syncthreads();
                SEAM(14);
                if (c.wave < 2) gla_state(c, p, bid >> 3, (bid & 7) * 2 + c.wave);
                __syncthreads();
                SEAM(14);
                gla_finish(c, p);
                __syncthreads();
                SEAM(14);
#endif
            }
        }
        if (INS(pb + 3, 3)) { PHASE_BEGIN
            pg8::Gemm g{H, WD + (layer == 0 ? WE_EV_OUT : WE_OD_OUT), T_TOK, 1024, 1024, 0}; pg8::StaticOrder S; S.init(T_TOK, 1024, G, bid);
            pg8::EpiRes E{layer == 0 ? p.x : p.out, p.out, 1024}; pg8::gemm_phase<pg8::EpiRes, pg8::StaticOrder, true, true>(glds, g, S, E);
            SEAM(pb + 3);
        }
        if (INS(pb + 4, 4)) { PHASE_BEGIN norm_plain(c, p.out, p.norm_xattn + layer * 1024, H, T_TOK); __syncthreads(); SEAM(pb + 4); }
        if (INS(pb + 5, 5)) { PHASE_BEGIN
            pg8::Gemm g{H, WD + WE_WQ + (size_t)layer * 512 * 1024, T_TOK, 512, 1024, 0}; pg8::StaticOrder S; S.init(T_TOK, 512, G, bid);
            pg8::EpiB16 E{P, 512}; pg8::gemm_phase<pg8::EpiB16, pg8::StaticOrder, true, true>(glds, g, S, E);
            SEAM(pb + 5);
        }
        if (INS(pb + 6, 6)) { PHASE_BEGIN for (int u = bid; u < 256; u += G) xattn_mfma(c, p, u); __syncthreads(); SEAM(pb + 6); }
        if (INS(pb + 7, 7)) { PHASE_BEGIN
            pg8::Gemm g{(const bf16_t*)(ws + OFF_P + 32 * MiB), WD + WE_WO + (size_t)layer * 1024 * 512, T_TOK, 1024, 512, 0}; pg8::StaticOrder S; S.init(T_TOK, 1024, G, bid);
            pg8::EpiRes E{p.out, p.out, 1024}; pg8::gemm_phase<pg8::EpiRes, pg8::StaticOrder, true, true>(glds, g, S, E);
            SEAM(pb + 7);
        }
        if (INS(pb + 8, 8)) { PHASE_BEGIN
            const float* wT = WS_F + (size_t)layer * 36 * 1024; int* cnt = (int*)(ws + OFF_CTL + CTL_CNT) + layer * 32;
            for (int r = c.gw; r < T_TOK; r += c.ngw) {
                f32x4 v[4]; row_load(p.out + (size_t)r * 1024, c.lane, v);
                const float rs = row_rstd(v); row_scale(v, rs, p.norm_moe + layer * 1024, c.lane); row_store_bf16(H + (size_t)r * 1024, c.lane, v);
                LAS float* lg = (LAS float*)shm + c.wave * 64; row_logits(v, wT, c.lane, 36, lg);
                int e0, e1; float g0, g1; route_row(lg, p.moe_b_group + layer * 4, p.moe_b_expert + layer * 32, e0, e1, g0, g1);
                if (c.lane == 0) { RE[r] = make_int2(e0, e1); RG[r] = make_float2(g0, g1); atomicAdd(&cnt[e0], 1); atomicAdd(&cnt[e1], 1); }
            }
            __syncthreads();
            SEAM(pb + 8);
        }
        if (INS(pb + 9, 9)) { PHASE_BEGIN moe_slots(c, p, layer); __syncthreads(); SEAM(pb + 9); }
        if (INS(pb + 10, 10)) { PHASE_BEGIN
            const int* blk = (const int*)(ws + OFF_CTL + CTL_BLK) + layer * 1024; const int nblk = blk[0];
            pg8::Gemm g{P, (const bf16_t*)(ws + OFF_WMOE), nblk * 256, 1024, 1024, (size_t)1024 * 1024 * 2}; pg8::MoeOrder S{blk + 1, nblk * 4, 4, G, bid};
            pg8::EpiSwiglu E{(bf16_t*)(ws + OFF_R), 512}; pg8::gemm_phase<pg8::EpiSwiglu, pg8::MoeOrder, true, true>(glds, g, S, E);
            SEAM(pb + 10);
        }
        if (INS(pb + 11, 11)) { PHASE_BEGIN
            const int* blk = (const int*)(ws + OFF_CTL + CTL_BLK) + layer * 1024; const int nblk = blk[0];
            pg8::Gemm g{(const bf16_t*)(ws + OFF_R), (const bf16_t*)(ws + OFF_WMOE + 64 * MiB), nblk * 256, 1024, 512, (size_t)1024 * 512 * 2}; pg8::MoeOrder S{blk + 1, nblk * 4, 4, G, bid};
            pg8::EpiB16 E{P, 1024}; pg8::gemm_phase<pg8::EpiB16, pg8::MoeOrder, true, true>(glds, g, S, E);
            SEAM(pb + 11);
        }
    }
    if (INS(24, 15)) { PHASE_BEGIN
        for (int r = c.gw; r < T_TOK; r += c.ngw) {
            f32x4 v[4]; row_load(p.out + (size_t)r * 1024, c.lane, v);
            const int2 ps = RP[r]; const float2 gt = RG[r];
            row_combine(v, P, ps.x, ps.y, gt.x, gt.y, c.lane);
            const float rs = row_rstd(v); row_scale(v, rs, p.norm_final, c.lane); row_store_f32(p.out + (size_t)r * 1024, c.lane, v);
        }
    }
}

extern "C" void kernel_launch(void* const* d_in, const int* in_sizes, int n_in, void* d_out, int out_size, void* d_ws, size_t ws_size, hipStream_t stream) {
    static int ready = 0;
    if (ready == 0) {
        if (n_in != 37 || out_size != T_TOK * DM || ws_size < WS_NEED) { fprintf(stderr, "kernel_launch: unexpected problem (n_in %d, out %d, ws %zu)\n", n_in, out_size, ws_size); ready = -1; return; }
        if (hipFuncSetAttribute((const void*)hybrid_fwd, hipFuncAttributeMaxDynamicSharedMemorySize, LDS_BYTES) != hipSuccess) { fprintf(stderr, "kernel_launch: hipFuncSetAttribute failed\n"); ready = -1; return; }
        ready = 1;
    }
    if (ready < 0) return;
    hipMemsetAsync((char*)d_ws + OFF_CTL, 0, CTL_ZERO_BYTES, stream);
    Params p{};
    const float** f = (const float**)&p;
    for (int i = 0; i < 37; ++i) f[i] = (const float*)d_in[i];
    p.out = (float*)d_out; p.ws = (unsigned char*)d_ws; p.ph_lo = 0; p.ph_hi = N_PHASES;
    hipLaunchKernelGGL(hybrid_fwd, dim3(256), dim3(512), LDS_BYTES, stream, p);
}
```

```cpp
#include <hip/hip_runtime.h>
#include <cstdint>
#include <cstdio>

#define LAS __attribute__((address_space(3)))
typedef unsigned short bf16_t;
typedef float f32x4 __attribute__((ext_vector_type(4)));
typedef float f32x2 __attribute__((ext_vector_type(2)));
typedef unsigned u32x4 __attribute__((ext_vector_type(4)));
typedef unsigned u32x2 __attribute__((ext_vector_type(2)));

constexpr int T_TOK = 32768, DM = 1024, SEQ = 4096, NB = 8, MEMLEN = 256;
constexpr int EV_IN = 2560, OD_IN = 3072  , OD_IN_SRC = 3088;
constexpr int NEXP = 32, MOE_FF = 512, PMAX = 65536 + NEXP * 256;

constexpr size_t MiB = 1024 * 1024;
constexpr size_t OFF_CTL = 0;
constexpr size_t CTL_ZERO_BYTES = 64 * 1024;
constexpr size_t CTL_CNT = 16384;
constexpr size_t CTL_CUR = 16384 + 1024;
constexpr size_t CTL_BLK = 128 * 1024;
constexpr size_t OFF_ROUTE = 1 * MiB;
constexpr size_t OFF_WSMALL = 2 * MiB;
constexpr size_t OFF_MKV = 3 * MiB;
constexpr size_t OFF_WD = 7 * MiB;
constexpr size_t OFF_WMOE = 28 * MiB;
constexpr size_t OFF_H = 124 * MiB;
constexpr size_t OFF_P = 188 * MiB;
constexpr size_t OFF_R = 380 * MiB;
constexpr size_t WS_NEED = 452 * MiB;
constexpr size_t WE_EV_IN = 0, WE_EV_OUT = 2560ull * 1024, WE_OD_IN = 3584ull * 1024, WE_OD_OUT = 6656ull * 1024, WE_MKV = 7680ull * 1024, WE_WQ = 8704ull * 1024, WE_WO = 9728ull * 1024;

struct Params {
    const float *x, *mem, *norm_mix, *norm_xattn, *norm_moe, *norm_final;
    const float *ev_w_in, *ev_sinks, *ev_mu, *ev_w0, *ev_w2, *ev_a0, *ev_a2, *ev_g2, *ev_k_k, *ev_k_a, *ev_r_k, *ev_lnx_w, *ev_lnx_b, *ev_w_out;
    const float *od_w_in, *od_gate_up, *od_gate_b, *od_onorm, *od_w_out;
    const float *mem_norm, *mem_wk, *mem_wv, *xa_wq, *xa_wo;
    const float *moe_w_group, *moe_b_group, *moe_w_expert, *moe_b_expert, *moe_w1, *moe_w3, *moe_w2;
    float* out; unsigned char* ws; int ph_lo, ph_hi;
};

#define XB_TMO      128
#define XB_XCNT(j)  (256  + 64 * (j))
#define XB_XSUB(j)  (1280 + 64 * (j))
#define XB_XGEN(j)  (2304 + 64 * (j))
#define XB_TOP      3328
#define XB_TOPGEN   3392
#define XCD_BAR_WORDS 3456
#define XB_SPIN_CAP (1u << 18)
#define LAS __attribute__((address_space(3)))

__device__ __forceinline__ unsigned xb_ld(unsigned* p)              { return __hip_atomic_load(p, __ATOMIC_RELAXED, __HIP_MEMORY_SCOPE_AGENT); }
__device__ __forceinline__ unsigned xb_add(unsigned* p, unsigned v) { return __hip_atomic_fetch_add(p, v, __ATOMIC_RELAXED, __HIP_MEMORY_SCOPE_AGENT); }
__device__ __forceinline__ unsigned xb_xcc_id() { return (unsigned)__builtin_amdgcn_s_getreg((3 << 11) | 20) & 0xFu; }
#define XB_SPIN(cond, bar) do { unsigned _sp = 0; while (cond) { __builtin_amdgcn_s_sleep(1); \
    if ((++_sp & 255u) == 0u) { if (xb_ld(&(bar)[XB_TMO])) break; if (_sp > XB_SPIN_CAP) { atomicAdd(&(bar)[XB_TMO], 1u); break; } } } } while (0)

struct XcdBarrier {
    unsigned* bar; unsigned x;
    volatile LAS unsigned* st;
};

__device__ __forceinline__ XcdBarrier xcd_barrier_post(unsigned* bar, volatile LAS unsigned* st) {
    XcdBarrier b; b.bar = bar; b.x = xb_xcc_id(); b.st = st;
    if (threadIdx.x == 0) (void)xb_add(&bar[XB_XCNT(b.x)], 1u);
    return b;
}
__device__ __forceinline__ void xcd_barrier_complete(unsigned* bar, unsigned x, unsigned& nloc, unsigned& nx) {
    const unsigned G = gridDim.x * gridDim.y * gridDim.z;
    unsigned sum, cnt, mine, sp = 0u;
    for (;;) {
        sum = 0u; cnt = 0u; mine = 0u;
#pragma unroll
        for (unsigned j = 0; j < 16; ++j) { const unsigned c = xb_ld(&bar[XB_XCNT(j)]); sum += c; cnt += (c > 0u) ? 1u : 0u; mine = (j == x) ? c : mine; }
        if (sum == G) break;
        __builtin_amdgcn_s_sleep(1);
        if ((++sp & 255u) == 0u) { if (xb_ld(&bar[XB_TMO])) break; if (sp > XB_SPIN_CAP) { atomicAdd(&bar[XB_TMO], 1u); break; } }
    }
    nloc = mine > 0u ? mine : 1u; nx = cnt > 0u ? cnt : 1u;
}

__device__ __forceinline__ void xcd_barrier(const XcdBarrier& b) {
    asm volatile("s_waitcnt vmcnt(0)" ::: "memory");
    __syncthreads();
    if (threadIdx.x == 0) {
        unsigned* bar = b.bar;
        __builtin_amdgcn_s_waitcnt(0);
        unsigned nloc = b.st[0], nx = b.st[1];
        if (nloc == 0u) { xcd_barrier_complete(bar, b.x, nloc, nx); b.st[0] = nloc; b.st[1] = nx; }
        const unsigned old = xb_add(&bar[XB_XSUB(b.x)], 1u);
        const unsigned gen = old / nloc;
        if (old + 1u == (gen + 1u) * nloc) {
            __builtin_amdgcn_fence(__ATOMIC_RELEASE, "agent");
            asm volatile("s_waitcnt vmcnt(0)" ::: "memory");
            const unsigned og = xb_add(&bar[XB_TOP], 1u);
            const unsigned tg = og / nx;
            if (og + 1u == (tg + 1u) * nx) xb_add(&bar[XB_TOPGEN], 1u);
            else XB_SPIN(xb_ld(&bar[XB_TOPGEN]) == tg, bar);
            __builtin_amdgcn_fence(__ATOMIC_ACQUIRE, "agent");
            xb_add(&bar[XB_XGEN(b.x)], 1u);
            asm volatile("s_waitcnt vmcnt(0)" ::: "memory");
        } else {
            XB_SPIN(xb_ld(&bar[XB_XGEN(b.x)]) == gen, bar);
            __builtin_amdgcn_fence(__ATOMIC_ACQUIRE, "agent");
            asm volatile("s_waitcnt vmcnt(0)" ::: "memory");
        }
    }
    __syncthreads();
}
namespace pg8 {
#define PG8_LAS __attribute__((address_space(3)))
typedef unsigned short bf16_t;
typedef short bf16x8 __attribute__((ext_vector_type(8)));
typedef float f32x4 __attribute__((ext_vector_type(4)));
typedef unsigned u32x4 __attribute__((ext_vector_type(4)));
constexpr int BM = 256, BK = 64, HALF = 128, HTB = HALF * BK * 2  , STAGE_BYTES = 8 * HTB, NXCD = 8, WGM = 8;

__host__ __device__ __forceinline__ int lds_byte(int r, int c) { const int st = (r >> 4) * 2 + (c >> 5), rr = r & 15, cc = c & 31, ob = rr * 64 + cc * 2; return st * 1024 + (ob ^ (((ob >> 9) & 1) << 5)); }
__host__ __device__ __forceinline__ void stage_rc(int b, int& R, int& C) { const int st = b / 1024, sb = b % 1024, swz = sb ^ (((sb >> 9) & 1) << 5); R = (st >> 1) * 16 + swz / 64; C = (st & 1) * 32 + (swz % 64) / 2; }
__host__ __device__ __forceinline__ int perm32(int rho) { const int n = rho >> 4, i = rho & 15; return 8 * (i >> 2) + 4 * n + (i & 3); }

struct Unit { int pm, pn, e; };
struct Gemm { const bf16_t* A; const bf16_t* Bt; int M, N, K; size_t bexp; };

struct StaticOrder {
    int nM, nN, nwg, G, c;
    __host__ __device__ void init(int M, int N, int G_, int c_) { nM = M / BM; nN = N / BM; nwg = nM * nN; G = G_; c = c_; }
    __host__ __device__ bool next(int i, Unit& u) const {
        const long L = (long)i * G + c; if (L >= nwg) return false;
        int wgid = (int)L; { const int q = nwg / NXCD, r = nwg % NXCD, xcd = wgid % NXCD, off = wgid / NXCD; wgid = (xcd < r ? xcd * (q + 1) : r * (q + 1) + (xcd - r) * q) + off; }
        const int nig = WGM * nN, gid = wgid / nig, fm = gid * WGM, gsz = (nM - fm) < WGM ? (nM - fm) : WGM;
        u.pm = fm + ((wgid % nig) % gsz); u.pn = (wgid % nig) / gsz; u.e = 0; return true;
    }
    __device__ __forceinline__ void a_ready(const Unit&) const {}
    __device__ __forceinline__ void done(const Unit&) const {}
};
__device__ __forceinline__ unsigned cvt_pk_bf16(float lo, float hi) { unsigned r; asm volatile("v_cvt_pk_bf16_f32 %0, %1, %2" : "=v"(r) : "v"(lo), "v"(hi)); return r; }

struct EpiB16 {
    static constexpr bool PERM = true, AFTER_DRAIN = false;
    bf16_t* O; int ldc;
    __device__ __forceinline__ void operator()(const f32x4 (&acc)[2][2][4][2], const Unit& u, int wr, int wc, int fr, int fq) const {
        const int row0 = u.pm * BM + wr * 64 + fr, col0 = u.pn * BM + wc * 32 + 8 * fq;
#pragma unroll
        for (int ai = 0; ai < 2; ++ai)
#pragma unroll
            for (int m = 0; m < 4; ++m) { bf16_t* rowp = O + (size_t)(row0 + ai * HALF + m * 16) * ldc + col0;
#pragma unroll
                for (int bj = 0; bj < 2; ++bj) { const f32x4 v0 = acc[ai][bj][m][0], v1 = acc[ai][bj][m][1];
                    u32x4 w; w.x = cvt_pk_bf16(v0[0], v0[1]); w.y = cvt_pk_bf16(v0[2], v0[3]); w.z = cvt_pk_bf16(v1[0], v1[1]); w.w = cvt_pk_bf16(v1[2], v1[3]);
                    *(u32x4*)(rowp + bj * HALF) = w; } }
    }
};
struct EpiRes {
    static constexpr bool PERM = false, AFTER_DRAIN = false;
    const float* base; float* out; int ldc;
    __device__ __forceinline__ void operator()(const f32x4 (&acc)[2][2][4][2], const Unit& u, int wr, int wc, int fr, int fq) const {
        const int row0 = u.pm * BM + wr * 64 + fr, col0 = u.pn * BM + wc * 32 + 4 * fq;
#pragma unroll
        for (int ai = 0; ai < 2; ++ai)
#pragma unroll
            for (int m = 0; m < 4; ++m) { const size_t off = (size_t)(row0 + ai * HALF + m * 16) * ldc + col0;
#pragma unroll
                for (int bj = 0; bj < 2; ++bj)
#pragma unroll
                    for (int n = 0; n < 2; ++n) { const f32x4 bs = *(const f32x4*)(base + off + bj * HALF + n * 16); *(f32x4*)(out + off + bj * HALF + n * 16) = bs + acc[ai][bj][m][n]; } }
    }
};
struct EpiSwiglu {
    static constexpr bool PERM = true, AFTER_DRAIN = false;
    bf16_t* O; int ldc;
    __device__ __forceinline__ void operator()(const f32x4 (&acc)[2][2][4][2], const Unit& u, int wr, int wc, int fr, int fq) const {
        const int row0 = u.pm * BM + wr * 64 + fr, col0 = (u.pn * BM + wc * 32 + 8 * fq) >> 1;
        typedef unsigned u32x2v __attribute__((ext_vector_type(2)));
#pragma unroll
        for (int ai = 0; ai < 2; ++ai)
#pragma unroll
            for (int m = 0; m < 4; ++m) { bf16_t* rowp = O + (size_t)(row0 + ai * HALF + m * 16) * ldc + col0;
#pragma unroll
                for (int bj = 0; bj < 2; ++bj) { const f32x4 a = acc[ai][bj][m][0], b = acc[ai][bj][m][1]; float h[4];
#pragma unroll
                    for (int i = 0; i < 4; ++i) h[i] = a[i] * __builtin_amdgcn_rcpf(1.0f + __expf(-a[i])) * b[i];
                    u32x2v w; w.x = cvt_pk_bf16(h[0], h[1]); w.y = cvt_pk_bf16(h[2], h[3]);
                    *(u32x2v*)(rowp + bj * (HALF / 2)) = w; } }
    }
};
struct MoeOrder {
    const int* blk_e; int nunits, nN, G, c;
    __device__ __forceinline__ bool next(int i, Unit& u) const {
        const long L = (long)i * G + c; if (L >= nunits) return false;
        u.pm = (int)(L / nN); u.pn = (int)(L % nN); u.e = blk_e[u.pm]; return true;
    }
    __device__ __forceinline__ void a_ready(const Unit&) const {}
    __device__ __forceinline__ void done(const Unit&) const {}
};
template <class Epi, class Sched, bool ALIGN_EPI = false, bool SP2 = false>
__device__ __forceinline__ void gemm_phase(PG8_LAS unsigned char* lds, const Gemm g, const Sched& S, const Epi& E) {
    int tid_ = threadIdx.x; asm volatile("" : "+v"(tid_));
    const int tid = tid_, wid = __builtin_amdgcn_readfirstlane(tid >> 6), lane = tid & 63, wr = wid >> 2, wc = wid & 3, fr = lane & 15, fq = lane >> 4;
    const int K = g.K, nt = K / BK;
    unsigned voffA[2], voffB[2];
#pragma unroll
    for (int i = 0; i < 2; ++i) { int R, C; stage_rc(tid * 16 + i * 8192, R, C); const int Rb = Epi::PERM ? ((R & ~31) + perm32(R & 31)) : R;
        voffA[i] = (unsigned)(R * K + C) * 2u; voffB[i] = (unsigned)(Rb * K + C) * 2u; }
    const size_t kstep = (size_t)(BK * 2);
    const size_t hstep = (size_t)HALF * K * 2;
    const size_t tstep = 2 * hstep;
    const unsigned ldsw = (unsigned)wid * 1024u;
    const int aoff = lds_byte(wr * 64 + fr, fq * 8), boff = lds_byte(wc * 32 + fr, fq * 8);
#define PG8_SA(b, h) (((b) * 2 + (h)) * HTB)
#define PG8_SB(b, h) ((4 + (b) * 2 + (h)) * HTB)
#define PG8_STAGE(bufoff, gbase, voff) do { _Pragma("unroll") for (int _i = 0; _i < 2; ++_i) \
        __builtin_amdgcn_global_load_lds((const unsigned*)((const char*)(gbase) + (voff)[_i]), (PG8_LAS unsigned*)(lds + (bufoff) + ldsw + _i * 8192), 16, 0, 0); } while (0)
#define PG8_LDA(dst, b, h) do { _Pragma("unroll") for (int m = 0; m < 4; ++m) _Pragma("unroll") for (int k = 0; k < 2; ++k) dst[m][k] = *(const PG8_LAS bf16x8*)(lds + PG8_SA(b, h) + aoff + m * 2048 + k * 1024); } while (0)
#define PG8_LDB(dst, b, h) do { _Pragma("unroll") for (int n = 0; n < 2; ++n) _Pragma("unroll") for (int k = 0; k < 2; ++k) dst[n][k] = *(const PG8_LAS bf16x8*)(lds + PG8_SB(b, h) + boff + n * 2048 + k * 1024); } while (0)
#define PG8_MMA(ai, bj, At, Bt) do { __builtin_amdgcn_s_setprio(1); _Pragma("unroll") for (int m = 0; m < 4; ++m) _Pragma("unroll") for (int n = 0; n < 2; ++n) _Pragma("unroll") for (int k = 0; k < 2; ++k) \
        acc[ai][bj][m][n] = __builtin_amdgcn_mfma_f32_16x16x32_bf16(Bt[n][k], At[m][k], acc[ai][bj][m][n], 0, 0, 0); __builtin_amdgcn_s_setprio(0); } while (0)
#define PG8_WAIT_V(n) asm volatile("s_waitcnt vmcnt(" #n ")" ::: "memory")
#define PG8_WAIT_L(n) asm volatile("s_waitcnt lgkmcnt(" #n ")" ::: "memory")
#define PG8_BAR __builtin_amdgcn_s_barrier()
#define PG8_SCHED __builtin_amdgcn_sched_barrier(0)
    Unit cur, nxt; int ui = 0;
    if (!S.next(0, cur)) return;
    f32x4 acc[2][2][4][2];
#pragma unroll
    for (int a = 0; a < 2; ++a)
#pragma unroll
        for (int b = 0; b < 2; ++b)
#pragma unroll
            for (int m = 0; m < 4; ++m)
#pragma unroll
                for (int n = 0; n < 2; ++n) acc[a][b][m][n] = (f32x4){0.f, 0.f, 0.f, 0.f};
    bf16x8 At[4][2], B0[2][2], B1[2][2];
    const char* cA = (const char*)g.A + (size_t)cur.pm * tstep; const char* cB = (const char*)g.Bt + (size_t)cur.pn * tstep + (size_t)cur.e * g.bexp;
    S.a_ready(cur);
    if constexpr (SP2) {
        PG8_STAGE(PG8_SB(0, 0), cB, voffB); PG8_STAGE(PG8_SB(0, 1), cB + hstep, voffB); PG8_STAGE(PG8_SA(0, 0), cA, voffA); PG8_STAGE(PG8_SA(0, 1), cA + hstep, voffA);
        if (wr == 1) PG8_BAR;
        PG8_WAIT_V(2); PG8_BAR;
        PG8_STAGE(PG8_SB(1, 0), cB + kstep, voffB); PG8_STAGE(PG8_SA(1, 0), cA + kstep, voffA); PG8_STAGE(PG8_SB(1, 1), cB + hstep + kstep, voffB);
        PG8_WAIT_V(6); PG8_BAR;
    } else {
        PG8_STAGE(PG8_SB(0, 0), cB, voffB); PG8_STAGE(PG8_SA(0, 0), cA, voffA); PG8_STAGE(PG8_SB(0, 1), cB + hstep, voffB); PG8_STAGE(PG8_SA(0, 1), cA + hstep, voffA);
        if (wr == 1) PG8_BAR;
        PG8_WAIT_V(4); PG8_BAR;
        PG8_STAGE(PG8_SB(1, 0), cB + kstep, voffB); PG8_STAGE(PG8_SA(1, 0), cA + kstep, voffA); PG8_STAGE(PG8_SB(1, 1), cB + hstep + kstep, voffB);
        PG8_WAIT_V(6); PG8_BAR;
    }
    for (;;) {
        const bool has_next = S.next(ui + 1, nxt);
        const char* nA = has_next ? (const char*)g.A + (size_t)nxt.pm * tstep : cA; const char* nB = has_next ? (const char*)g.Bt + (size_t)nxt.pn * tstep + (size_t)nxt.e * g.bexp : cB;
        for (int t = 0; t < nt; t += 2) {
            const bool last = (t == nt - 2);
            const char* a1 = cA + (size_t)(t + 1) * kstep;
            const char* a2 = last ? nA : cA + (size_t)(t + 2) * kstep; const char* b2 = last ? nB : cB + (size_t)(t + 2) * kstep;
            const char* a3 = a2 + kstep; const char* b3 = b2 + kstep;
            if (last && has_next) S.a_ready(nxt);
            if constexpr (SP2) {
            PG8_LDB(B0, 0, 0); PG8_LDB(B1, 0, 1); PG8_SCHED; PG8_LDA(At, 0, 0); PG8_STAGE(PG8_SA(1, 1), a1 + hstep, voffA);
            PG8_WAIT_V(8); PG8_WAIT_L(0); PG8_BAR; PG8_MMA(0, 0, At, B0); PG8_MMA(0, 1, At, B1); PG8_BAR; PG8_SCHED;
            PG8_LDA(At, 0, 1); PG8_STAGE(PG8_SB(0, 0), b2, voffB); PG8_STAGE(PG8_SB(0, 1), b2 + hstep, voffB); PG8_STAGE(PG8_SA(0, 0), a2, voffA);
            PG8_WAIT_V(8); PG8_WAIT_L(0); PG8_BAR; PG8_MMA(1, 0, At, B0); PG8_MMA(1, 1, At, B1); PG8_BAR; PG8_SCHED;
            PG8_LDB(B0, 1, 0); PG8_LDB(B1, 1, 1); PG8_SCHED; PG8_LDA(At, 1, 0); PG8_STAGE(PG8_SA(0, 1), a2 + hstep, voffA);
            PG8_WAIT_V(8); PG8_WAIT_L(0); PG8_BAR; PG8_MMA(0, 0, At, B0); PG8_MMA(0, 1, At, B1); PG8_BAR; PG8_SCHED;
            PG8_LDA(At, 1, 1); PG8_STAGE(PG8_SB(1, 0), b3, voffB); PG8_STAGE(PG8_SB(1, 1), b3 + hstep, voffB); PG8_STAGE(PG8_SA(1, 0), a3, voffA);
            PG8_WAIT_V(8); PG8_WAIT_L(0); PG8_BAR; PG8_MMA(1, 0, At, B0); PG8_MMA(1, 1, At, B1); PG8_BAR; PG8_SCHED;
            } else {
            PG8_LDB(B0, 0, 0); PG8_SCHED; PG8_LDA(At, 0, 0); PG8_STAGE(PG8_SA(1, 1), a1 + hstep, voffA);
            PG8_WAIT_L(8); PG8_BAR; PG8_WAIT_L(0); PG8_MMA(0, 0, At, B0); PG8_BAR; PG8_SCHED;
            PG8_LDB(B1, 0, 1); PG8_STAGE(PG8_SB(0, 0), b2, voffB);
            PG8_BAR; PG8_WAIT_L(0); PG8_MMA(0, 1, At, B1); PG8_BAR;
            PG8_LDA(At, 0, 1); PG8_STAGE(PG8_SA(0, 0), a2, voffA);
            PG8_BAR; PG8_WAIT_L(0); PG8_MMA(1, 0, At, B0); PG8_BAR; PG8_SCHED;
            PG8_STAGE(PG8_SB(0, 1), b2 + hstep, voffB);
            PG8_WAIT_V(6); PG8_BAR; PG8_MMA(1, 1, At, B1); PG8_BAR;
            PG8_LDB(B0, 1, 0); PG8_SCHED; PG8_LDA(At, 1, 0); PG8_STAGE(PG8_SA(0, 1), a2 + hstep, voffA);
            PG8_WAIT_L(8); PG8_BAR; PG8_WAIT_L(0); PG8_MMA(0, 0, At, B0); PG8_BAR; PG8_SCHED;
            PG8_LDB(B1, 1, 1); PG8_STAGE(PG8_SB(1, 0), b3, voffB);
            PG8_BAR; PG8_WAIT_L(0); PG8_MMA(0, 1, At, B1); PG8_BAR;
            PG8_LDA(At, 1, 1); PG8_STAGE(PG8_SA(1, 0), a3, voffA);
            PG8_BAR; PG8_WAIT_L(0); PG8_MMA(1, 0, At, B0); PG8_BAR; PG8_SCHED;
            PG8_STAGE(PG8_SB(1, 1), b3 + hstep, voffB);
            PG8_WAIT_V(6); PG8_BAR; PG8_MMA(1, 1, At, B1); PG8_BAR;
            }
        }
        if constexpr (ALIGN_EPI) { if (wr == 0) PG8_BAR; }
        if constexpr (!Epi::AFTER_DRAIN) { E(acc, cur, wr, wc, fr, fq); S.done(cur); }
        if (!has_next) break;
#pragma unroll
        for (int a = 0; a < 2; ++a)
#pragma unroll
            for (int b = 0; b < 2; ++b)
#pragma unroll
                for (int m = 0; m < 4; ++m)
#pragma unroll
                    for (int n = 0; n < 2; ++n) acc[a][b][m][n] = (f32x4){0.f, 0.f, 0.f, 0.f};
        cur = nxt; cA = nA; cB = nB; ++ui;
        if constexpr (ALIGN_EPI) { if (wr == 1) PG8_BAR; }
    }
    PG8_WAIT_V(0);
    if constexpr (!ALIGN_EPI) { if (wr == 0) PG8_BAR; }
    PG8_BAR;
    if constexpr (Epi::AFTER_DRAIN) { E.fused(acc, cur, wr, wc, fr, fq, lds, wid, lane); S.done(cur); }
#undef PG8_SA
#undef PG8_SB
#undef PG8_STAGE
#undef PG8_LDA
#undef PG8_LDB
#undef PG8_MMA
#undef PG8_WAIT_V
#undef PG8_WAIT_L
#undef PG8_BAR
#undef PG8_SCHED
}
}
__device__ __forceinline__ float bf2f(unsigned v) { return __uint_as_float(v << 16); }
__device__ __forceinline__ unsigned f2bf(float f) { unsigned u = __float_as_uint(f); u += 0x7FFFu + ((u >> 16) & 1u); return u >> 16; }
__device__ __forceinline__ unsigned pk2(float lo, float hi) { return f2bf(lo) | (f2bf(hi) << 16); }
__device__ __forceinline__ float bflo(unsigned w) { return __uint_as_float(w << 16); }
__device__ __forceinline__ float bfhi(unsigned w) { return __uint_as_float(w & 0xFFFF0000u); }
__device__ __forceinline__ float wave_sum(float v) {
#pragma unroll
    for (int o = 1; o < 64; o <<= 1) v += __shfl_xor(v, o);
    return v;
}
__device__ __forceinline__ float wave_max(float v) {
#pragma unroll
    for (int o = 1; o < 64; o <<= 1) v = fmaxf(v, __shfl_xor(v, o));
    return v;
}
__device__ __forceinline__ float sigmoidf_(float x) { return __builtin_amdgcn_rcpf(1.0f + __expf(-x)); }
__device__ __forceinline__ float tanhf_(float x) { return 1.0f - 2.0f * __builtin_amdgcn_rcpf(__expf(2.0f * x) + 1.0f); }
#define LDS_WAIT() asm volatile("s_waitcnt lgkmcnt(0)" ::: "memory")

struct Ctx { int tid, wave, lane, gw, ngw; unsigned char* shm; };

__device__ __forceinline__ int tr_src_col(int mode, int n, int scol0) { return mode == 1 ? (n < 2048 ? n : n + 16) : scol0 + n; }
__device__ __forceinline__ int tr_dst_row(int mode, int n, int drow0) { return mode == 2 ? 8 * (n >> 2) + (n & 3) : (mode == 3 ? 8 * (n >> 2) + 4 + (n & 3) : drow0 + n); }
__device__ __forceinline__ void tr_item(const float* W, int ldw, int scol0, int K, bf16_t* WT, int drow0, int mode, LAS float* scr, int item, int nblk, int lane) {
    const int kb = item / nblk, nb = item % nblk, k0 = 64 * kb, n0 = 32 * nb;
    const int sc = tr_src_col(mode, n0 + (lane & 31), scol0);
#pragma unroll 8
    for (int i = 0; i < 32; ++i) { const int kk = 2 * i + (lane >> 5); scr[kk * 33 + (lane & 31)] = W[(size_t)(k0 + kk) * ldw + sc]; }
    LDS_WAIT(); asm volatile("" ::: "memory");
    const int c = lane & 7;
#pragma unroll
    for (int j = 0; j < 4; ++j) { const int n = (lane >> 3) + 8 * j; const LAS float* s = scr + (8 * c) * 33 + n;
        u32x4 o; o.x = pk2(s[0 * 33], s[1 * 33]); o.y = pk2(s[2 * 33], s[3 * 33]); o.z = pk2(s[4 * 33], s[5 * 33]); o.w = pk2(s[6 * 33], s[7 * 33]);
        *(u32x4*)(WT + (size_t)tr_dst_row(mode, n0 + n, drow0) * K + k0 + 8 * c) = o; }
    LDS_WAIT(); asm volatile("" ::: "memory");
}
__device__ __forceinline__ void tr_matrix(const Ctx& c, const float* W, int ldw, int scol0, int K, int ncols, bf16_t* WT, int drow0, int mode) {
    LAS float* scr = (LAS float*)(c.shm) + c.wave * (64 * 33);
    const int nblk = ncols / 32, nitems = (K / 64) * nblk;
    for (int it = c.gw; it < nitems; it += c.ngw) tr_item(W, ldw, scol0, K, WT, drow0, mode, scr, it, nblk, c.lane);
}
__device__ __forceinline__ void tr_moe_layer(const Ctx& c, const Params& p, int layer) {
    LAS float* scr = (LAS float*)(c.shm) + c.wave * (64 * 33);
    bf16_t* w13t = (bf16_t*)(p.ws + OFF_WMOE); bf16_t* w2t = (bf16_t*)(p.ws + OFF_WMOE + 64 * MiB);
    const float* w1 = p.moe_w1 + (size_t)layer * NEXP * 1024 * 512; const float* w3 = p.moe_w3 + (size_t)layer * NEXP * 1024 * 512; const float* w2 = p.moe_w2 + (size_t)layer * NEXP * 512 * 1024;
    for (int it = c.gw; it < NEXP * 768; it += c.ngw) {
        const int e = it / 768, r = it % 768;
        if (r < 256) tr_item(w1 + (size_t)e * 1024 * 512, 512, 0, 1024, w13t + (size_t)e * 1024 * 1024, 0, 2, scr, r, 16, c.lane);
        else if (r < 512) tr_item(w3 + (size_t)e * 1024 * 512, 512, 0, 1024, w13t + (size_t)e * 1024 * 1024, 0, 3, scr, r - 256, 16, c.lane);
        else tr_item(w2 + (size_t)e * 512 * 1024, 1024, 0, 512, w2t + (size_t)e * 1024 * 512, 0, 0, scr, r - 512, 32, c.lane);
    }
}

__device__ __forceinline__ void row_load(const float* row, int lane, f32x4 (&v)[4]) {
#pragma unroll
    for (int j = 0; j < 4; ++j) v[j] = *((const f32x4*)row + lane + 64 * j);
}
__device__ __forceinline__ float row_rstd(const f32x4 (&v)[4]) {
    float s = 0.f;
#pragma unroll
    for (int j = 0; j < 4; ++j) s += (v[j].x * v[j].x + v[j].y * v[j].y) + (v[j].z * v[j].z + v[j].w * v[j].w);
    return 1.0f / sqrtf(wave_sum(s) * (1.0f / 1024.0f) + 1e-6f);
}
__device__ __forceinline__ void row_scale(f32x4 (&v)[4], float rstd, const float* gain, int lane) {
#pragma unroll
    for (int j = 0; j < 4; ++j) { const f32x4 g = *((const f32x4*)gain + lane + 64 * j); v[j] = v[j] * rstd * g; }
}
__device__ __forceinline__ void row_store_bf16(bf16_t* orow, int lane, const f32x4 (&v)[4]) {
#pragma unroll
    for (int j = 0; j < 4; ++j) { u32x2 o; o.x = pk2(v[j].x, v[j].y); o.y = pk2(v[j].z, v[j].w); *((u32x2*)orow + lane + 64 * j) = o; }
}
__device__ __forceinline__ void row_store_f32(float* orow, int lane, const f32x4 (&v)[4]) {
#pragma unroll
    for (int j = 0; j < 4; ++j) *((f32x4*)orow + lane + 64 * j) = v[j];
}
__device__ __forceinline__ void row_combine(f32x4 (&v)[4], const bf16_t* yb, int p0, int p1, float g0, float g1, int lane) {
    const u32x2* r0 = (const u32x2*)(yb + (size_t)p0 * 1024); const u32x2* r1 = (const u32x2*)(yb + (size_t)p1 * 1024);
#pragma unroll
    for (int j = 0; j < 4; ++j) { const u32x2 a = r0[lane + 64 * j], b = r1[lane + 64 * j];
        v[j].x += g0 * bflo(a.x) + g1 * bflo(b.x); v[j].y += g0 * bfhi(a.x) + g1 * bfhi(b.x);
        v[j].z += g0 * bflo(a.y) + g1 * bflo(b.y); v[j].w += g0 * bfhi(a.y) + g1 * bfhi(b.y); }
}
__device__ __forceinline__ void row_logits(const f32x4 (&v)[4], const float* wT, int lane, int NL, LAS float* lg) {
#pragma unroll 1
    for (int o = 0; o < NL; ++o) { float s = 0.f;
#pragma unroll
        for (int j = 0; j < 4; ++j) { const f32x4 w = *((const f32x4*)(wT + o * 1024) + lane + 64 * j); s += (v[j].x * w.x + v[j].y * w.y) + (v[j].z * w.z + v[j].w * w.w); }
        s = wave_sum(s); if (lane == 0) lg[o] = s; }
    LDS_WAIT();
}

__device__ __forceinline__ void norm_plain(const Ctx& c, const float* src, const float* gain, bf16_t* H, int nrows) {
    for (int r = c.gw; r < nrows; r += c.ngw) { f32x4 v[4]; row_load(src + (size_t)r * 1024, c.lane, v); const float rs = row_rstd(v); row_scale(v, rs, gain, c.lane); row_store_bf16(H + (size_t)r * 1024, c.lane, v); }
}
__device__ __forceinline__ void route_row(const LAS float* lg, const float* bg, const float* be, int& e0, int& e1, float& g0, float& g1) {
    float gl[4]; int gt = 0; float gm;
#pragma unroll
    for (int i = 0; i < 4; ++i) gl[i] = lg[i] + bg[i];
    gm = gl[0];
#pragma unroll
    for (int i = 1; i < 4; ++i) if (gl[i] > gm) { gm = gl[i]; gt = i; }
    float gs = 0.f;
#pragma unroll
    for (int i = 0; i < 4; ++i) gs += __expf(gl[i] - gm);
    const float pg = 1.0f / gs;
    float el[8];
#pragma unroll
    for (int i = 0; i < 8; ++i) el[i] = lg[4 + 8 * gt + i] + be[8 * gt + i];
    int i0 = 0; float m0 = el[0];
#pragma unroll
    for (int i = 1; i < 8; ++i) if (el[i] > m0) { m0 = el[i]; i0 = i; }
    int i1 = -1; float m1 = -3.0e38f;
#pragma unroll
    for (int i = 0; i < 8; ++i) if (i != i0 && el[i] > m1) { m1 = el[i]; i1 = i; }
    float one = 1.0f; asm volatile("" : "+v"(one));
    const float q1 = __expf(m1 - m0); const float inv = one / (one + q1);
    e0 = gt * 8 + i0; e1 = gt * 8 + i1; g0 = pg * inv; g1 = pg * q1 * inv;
}
constexpr int RW_AS = 64 * 68;
__device__ __forceinline__ void rwkv_naive(const Ctx& c, const Params& p, int bh) {
    const int b = bh >> 3, hd = bh & 7, tid = c.tid, lane = c.lane, wv = c.wave;
    LAS float* L = (LAS float*)c.shm;
    LAS float* aR = L; LAS float* aK = L + RW_AS; LAS float* aV = L + 2 * RW_AS; LAS float* aW = L + 3 * RW_AS; LAS float* aA = L + 4 * RW_AS;
    LAS float* aB = L + 5 * RW_AS; LAS float* aG = L + 6 * RW_AS; LAS float* aY = L + 7 * RW_AS; LAS float* red = L + 8 * RW_AS;
    const bf16_t* P = (const bf16_t*)(p.ws + OFF_P); bf16_t* MIX = (bf16_t*)(p.ws + OFF_H);
    LAS f32x4* SL = (LAS f32x4*)(L + 8 * RW_AS + 1536);
    if (wv == 0) {
#pragma unroll
        for (int j4 = 0; j4 < 16; ++j4) SL[j4 * 64 + lane] = (f32x4){0.f, 0.f, 0.f, 0.f}; }
    const int t = lane, cg = wv;
    const int ch0 = hd * 64 + cg * 8;
    for (int tb = 0; tb < 64; ++tb) {
        const size_t tg0 = (size_t)b * SEQ + (size_t)tb * 64;
#pragma unroll 1
        for (int i = 0; i < 7; ++i) {
            const int task = tid + 512 * i, tt = task / 56, q = task % 56;
            int col; LAS float* dst; int kind = 0;
            if (q < 8) { col = hd * 64 + 8 * q; dst = aR + tt * 68 + 8 * q; }
            else if (q < 16) { col = 512 + hd * 64 + 8 * (q - 8); dst = aK + tt * 68 + 8 * (q - 8); }
            else if (q < 24) { col = 1024 + hd * 64 + 8 * (q - 16); dst = aV + tt * 68 + 8 * (q - 16); }
            else if (q < 32) { col = 1536 + 8 * (q - 24); dst = aW + tt * 68 + 8 * (q - 24); kind = 1; }
            else if (q < 40) { col = 1600 + 8 * (q - 32); dst = aA + tt * 68 + 8 * (q - 32); }
            else if (q < 48) { col = 1664 + 8 * (q - 40); dst = aB + tt * 68 + 8 * (q - 40); kind = 2; }
            else { col = 1664 + 8 * (q - 40); dst = aG + tt * 68 + 8 * (q - 48); kind = 2; }
            const bf16_t* src = P + (tg0 + tt) * EV_IN + 768 + col;
            const u32x4 cur = *(const u32x4*)src;
            u32x4 prv = (u32x4){0u, 0u, 0u, 0u};
            if (tb * 64 + tt > 0) prv = *(const u32x4*)(src - EV_IN);
            const f32x4 m0 = *(const f32x4*)(p.ev_mu + col), m1 = *(const f32x4*)(p.ev_mu + col + 4);
            float v[8];
            const unsigned cw[4] = {cur.x, cur.y, cur.z, cur.w}, pw[4] = {prv.x, prv.y, prv.z, prv.w};
            const float mu[8] = {m0.x, m0.y, m0.z, m0.w, m1.x, m1.y, m1.z, m1.w};
#pragma unroll
            for (int k = 0; k < 4; ++k) { const float c0 = bflo(cw[k]), c1 = bfhi(cw[k]), p0 = bflo(pw[k]), p1 = bfhi(pw[k]);
                v[2 * k] = c0 + (p0 - c0) * mu[2 * k]; v[2 * k + 1] = c1 + (p1 - c1) * mu[2 * k + 1]; }
            if (kind == 1) {
#pragma unroll
                for (int k = 0; k < 8; ++k) v[k] = tanhf(v[k]); }
            if (kind == 2) {
#pragma unroll
                for (int k = 0; k < 8; ++k) v[k] = sigmoidf_(v[k]); }
            *(LAS f32x4*)dst = (f32x4){v[0], v[1], v[2], v[3]}; *(LAS f32x4*)(dst + 4) = (f32x4){v[4], v[5], v[6], v[7]};
        }
        __syncthreads();
        float zw[8], za[8], gg[8];
#pragma unroll
        for (int i = 0; i < 8; ++i) { zw[i] = 0.f; za[i] = 0.f; gg[i] = 0.f; }
#pragma unroll 2
        for (int j4 = 0; j4 < 16; ++j4) {
            const f32x4 xw = *(const LAS f32x4*)(aW + t * 68 + 4 * j4), xa = *(const LAS f32x4*)(aA + t * 68 + 4 * j4);
            const f32x4 g0 = *(const LAS f32x4*)(aB + t * 68 + 4 * j4), g1 = *(const LAS f32x4*)(aG + t * 68 + 4 * j4);
#pragma unroll
            for (int jj = 0; jj < 4; ++jj) { const int j = 4 * j4 + jj;
                const f32x4 w2a = *(const f32x4*)(p.ev_w2 + (size_t)j * 512 + ch0), w2b = *(const f32x4*)(p.ev_w2 + (size_t)j * 512 + ch0 + 4);
                const f32x4 a2a = *(const f32x4*)(p.ev_a2 + (size_t)j * 512 + ch0), a2b = *(const f32x4*)(p.ev_a2 + (size_t)j * 512 + ch0 + 4);
                const f32x4 gla = *(const f32x4*)(p.ev_g2 + (size_t)j * 512 + ch0), glb = *(const f32x4*)(p.ev_g2 + (size_t)j * 512 + ch0 + 4);
                const f32x4 gha = *(const f32x4*)(p.ev_g2 + (size_t)(64 + j) * 512 + ch0), ghb = *(const f32x4*)(p.ev_g2 + (size_t)(64 + j) * 512 + ch0 + 4);
                const float xwv = xw[jj], xav = xa[jj], g0v = g0[jj], g1v = g1[jj];
#pragma unroll
                for (int i = 0; i < 4; ++i) { zw[i] += xwv * w2a[i]; zw[4 + i] += xwv * w2b[i]; za[i] += xav * a2a[i]; za[4 + i] += xav * a2b[i];
                    gg[i] += g0v * gla[i] + g1v * gha[i]; gg[4 + i] += g0v * glb[i] + g1v * ghb[i]; } }
        }
        float av[8], kkv[8]; float ss = 0.f;
        {
            const f32x4 kA = *(const LAS f32x4*)(aK + t * 68 + cg * 8), kB = *(const LAS f32x4*)(aK + t * 68 + cg * 8 + 4);
            const float kv[8] = {kA.x, kA.y, kA.z, kA.w, kB.x, kB.y, kB.z, kB.w};
            float dec[8], kp[8];
#pragma unroll
            for (int i = 0; i < 8; ++i) { const int ch = ch0 + i;
                const float u = -(p.ev_w0[ch] + zw[i]); const float sp = (u > 20.f) ? u : log1pf(__expf(u));
                const float w = -sp - 0.5f; dec[i] = __expf(-__expf(w));
                av[i] = sigmoidf_(p.ev_a0[ch] + za[i]);
                kkv[i] = kv[i] * p.ev_k_k[ch]; ss += kkv[i] * kkv[i];
                kp[i] = kv[i] * (1.0f + (av[i] - 1.0f) * p.ev_k_a[ch]); }
            red[t * 8 + cg] = ss;
            __syncthreads();
            *(LAS f32x4*)(aW + t * 68 + cg * 8) = (f32x4){dec[0], dec[1], dec[2], dec[3]}; *(LAS f32x4*)(aW + t * 68 + cg * 8 + 4) = (f32x4){dec[4], dec[5], dec[6], dec[7]};
            *(LAS f32x4*)(aK + t * 68 + cg * 8) = (f32x4){kp[0], kp[1], kp[2], kp[3]}; *(LAS f32x4*)(aK + t * 68 + cg * 8 + 4) = (f32x4){kp[4], kp[5], kp[6], kp[7]};
            *(LAS f32x4*)(aG + t * 68 + cg * 8) = (f32x4){gg[0], gg[1], gg[2], gg[3]}; *(LAS f32x4*)(aG + t * 68 + cg * 8 + 4) = (f32x4){gg[4], gg[5], gg[6], gg[7]};
            float tot = 0.f;
#pragma unroll
            for (int i = 0; i < 8; ++i) tot += red[t * 8 + i];
            const float inv = 1.0f / fmaxf(sqrtf(tot), 1e-12f);
            float an[8], bn[8];
#pragma unroll
            for (int i = 0; i < 8; ++i) { const float kn = kkv[i] * inv; an[i] = -kn; bn[i] = kn * av[i]; }
            *(LAS f32x4*)(aA + t * 68 + cg * 8) = (f32x4){an[0], an[1], an[2], an[3]}; *(LAS f32x4*)(aA + t * 68 + cg * 8 + 4) = (f32x4){an[4], an[5], an[6], an[7]};
            *(LAS f32x4*)(aB + t * 68 + cg * 8) = (f32x4){bn[0], bn[1], bn[2], bn[3]}; *(LAS f32x4*)(aB + t * 68 + cg * 8 + 4) = (f32x4){bn[4], bn[5], bn[6], bn[7]};
        }
        __syncthreads();
        if (wv == 0) {
            float S[64];
#pragma unroll
            for (int j4 = 0; j4 < 16; ++j4) { const f32x4 s4 = SL[j4 * 64 + lane]; S[4 * j4] = s4.x; S[4 * j4 + 1] = s4.y; S[4 * j4 + 2] = s4.z; S[4 * j4 + 3] = s4.w; }
#pragma unroll 1
            for (int tt = 0; tt < 64; ++tt) {
                const float vv = aV[tt * 68 + lane];
                float sa = 0.f;
#pragma unroll
                for (int j4 = 0; j4 < 16; ++j4) { const f32x4 a4 = *(const LAS f32x4*)(aA + tt * 68 + 4 * j4);
                    sa += S[4 * j4] * a4.x; sa += S[4 * j4 + 1] * a4.y; sa += S[4 * j4 + 2] * a4.z; sa += S[4 * j4 + 3] * a4.w; }
                float y = 0.f;
#pragma unroll
                for (int j4 = 0; j4 < 16; ++j4) {
                    const f32x4 d4 = *(const LAS f32x4*)(aW + tt * 68 + 4 * j4), b4 = *(const LAS f32x4*)(aB + tt * 68 + 4 * j4);
                    const f32x4 k4 = *(const LAS f32x4*)(aK + tt * 68 + 4 * j4), r4 = *(const LAS f32x4*)(aR + tt * 68 + 4 * j4);
#pragma unroll
                    for (int jj = 0; jj < 4; ++jj) { const int j = 4 * j4 + jj; S[j] = S[j] * d4[jj] + sa * b4[jj] + vv * k4[jj]; y += S[j] * r4[jj]; } }
                aY[tt * 68 + lane] = y;
            }
#pragma unroll
            for (int j4 = 0; j4 < 16; ++j4) SL[j4 * 64 + lane] = (f32x4){S[4 * j4], S[4 * j4 + 1], S[4 * j4 + 2], S[4 * j4 + 3]};
        }
        __syncthreads();
        {
            const f32x4 yA = *(const LAS f32x4*)(aY + t * 68 + cg * 8), yB = *(const LAS f32x4*)(aY + t * 68 + cg * 8 + 4);
            const f32x4 rA = *(const LAS f32x4*)(aR + t * 68 + cg * 8), rB = *(const LAS f32x4*)(aR + t * 68 + cg * 8 + 4);
            const f32x4 kA = *(const LAS f32x4*)(aK + t * 68 + cg * 8), kB = *(const LAS f32x4*)(aK + t * 68 + cg * 8 + 4);
            const f32x4 vA = *(const LAS f32x4*)(aV + t * 68 + cg * 8), vB = *(const LAS f32x4*)(aV + t * 68 + cg * 8 + 4);
            const f32x4 gA = *(const LAS f32x4*)(aG + t * 68 + cg * 8), gB = *(const LAS f32x4*)(aG + t * 68 + cg * 8 + 4);
            const float y[8] = {yA.x, yA.y, yA.z, yA.w, yB.x, yB.y, yB.z, yB.w}, r[8] = {rA.x, rA.y, rA.z, rA.w, rB.x, rB.y, rB.z, rB.w};
            const float k[8] = {kA.x, kA.y, kA.z, kA.w, kB.x, kB.y, kB.z, kB.w}, v[8] = {vA.x, vA.y, vA.z, vA.w, vB.x, vB.y, vB.z, vB.w};
            const float g[8] = {gA.x, gA.y, gA.z, gA.w, gB.x, gB.y, gB.z, gB.w};
            float s1 = 0.f, sb = 0.f;
#pragma unroll
            for (int i = 0; i < 8; ++i) { s1 += y[i]; sb += r[i] * k[i] * p.ev_r_k[ch0 + i]; }
            red[t * 8 + cg] = s1; red[512 + t * 8 + cg] = sb;
            __syncthreads();
            float m = 0.f, bon = 0.f;
#pragma unroll
            for (int i = 0; i < 8; ++i) { m += red[t * 8 + i]; bon += red[512 + t * 8 + i]; }
            m *= (1.0f / 64.0f);
            float s2 = 0.f;
#pragma unroll
            for (int i = 0; i < 8; ++i) s2 += (y[i] - m) * (y[i] - m);
            red[1024 + t * 8 + cg] = s2;
            __syncthreads();
            float var = 0.f;
#pragma unroll
            for (int i = 0; i < 8; ++i) var += red[1024 + t * 8 + i];
            const float rs = 1.0f / sqrtf(var * (1.0f / 64.0f) + 64e-5f);
            float o[8];
#pragma unroll
            for (int i = 0; i < 8; ++i) o[i] = ((y[i] - m) * rs * p.ev_lnx_w[ch0 + i] + p.ev_lnx_b[ch0 + i] + bon * v[i]) * g[i];
            u32x4 w; w.x = pk2(o[0], o[1]); w.y = pk2(o[2], o[3]); w.z = pk2(o[4], o[5]); w.w = pk2(o[6], o[7]);
            *(u32x4*)(MIX + (tg0 + t) * 1024 + 512 + ch0) = w;
        }
        __syncthreads();
    }
}

__device__ __forceinline__ void swa_naive(const Ctx& c, const Params& p, int unit) {
    const int b = unit >> 6, g = (unit >> 5) & 1, n = unit & 31, tid = c.tid, lane = c.lane, wv = c.wave;
    LAS bf16_t* Ks = (LAS bf16_t*)c.shm;
    LAS bf16_t* Vs = (LAS bf16_t*)(c.shm + 256 * 144);
    LAS float* qf = (LAS float*)(c.shm + 256 * 144 + 256 * 128) + wv * 320;
    LAS float* pr = qf + 64;
    const bf16_t* P = (const bf16_t*)(p.ws + OFF_P); bf16_t* MIX = (bf16_t*)(p.ws + OFF_H);
    __syncthreads();
#pragma unroll 1
    for (int i = 0; i < 8; ++i) {
        const int task = tid + 512 * i, which = task >> 11, r = (task >> 3) & 255, ck = task & 7;
        const int tk = n * 128 - 128 + r;
        u32x4 d = (u32x4){0u, 0u, 0u, 0u};
        if (tk >= 0) d = *(const u32x4*)(P + ((size_t)b * SEQ + tk) * EV_IN + 512 + which * 128 + g * 64 + ck * 8);
        if (which == 0) *(LAS u32x4*)(Ks + r * 72 + ck * 8) = d; else *(LAS u32x4*)(Vs + r * 64 + ck * 8) = d;
    }
    __syncthreads();
    const int head = g * 4 + (wv >> 1);
    const float sink = p.ev_sinks[head];
#pragma unroll 1
    for (int qq = 0; qq < 64; ++qq) {
        const int qi = (wv & 1) * 64 + qq;
        const size_t tq = (size_t)b * SEQ + n * 128 + qi;
        qf[lane] = bf2f(P[tq * EV_IN + head * 64 + lane]) * 0.125f;
        LDS_WAIT();
        float s[4];
#pragma unroll
        for (int j = 0; j < 4; ++j) { const int kp = lane + 64 * j; float a = 0.f;
#pragma unroll
            for (int ck = 0; ck < 8; ++ck) { const u32x4 kk = *(const LAS u32x4*)(Ks + kp * 72 + ck * 8);
                const f32x4 q0 = *(const LAS f32x4*)(qf + ck * 8), q1 = *(const LAS f32x4*)(qf + ck * 8 + 4);
                a += bflo(kk.x) * q0.x + bfhi(kk.x) * q0.y + bflo(kk.y) * q0.z + bfhi(kk.y) * q0.w + bflo(kk.z) * q1.x + bfhi(kk.z) * q1.y + bflo(kk.w) * q1.z + bfhi(kk.w) * q1.w; }
            const bool valid = (kp >= qi + 1) && (kp <= qi + 128) && (n > 0 || kp >= 128);
            s[j] = valid ? a : -INFINITY; }
        float m = fmaxf(fmaxf(s[0], s[1]), fmaxf(s[2], s[3])); m = fmaxf(wave_max(m), sink);
        float den = 0.f;
#pragma unroll
        for (int j = 0; j < 4; ++j) { const float e = __expf(s[j] - m); pr[lane + 64 * j] = e; den += e; }
        den = wave_sum(den) + __expf(sink - m);
        LDS_WAIT();
        float o = 0.f;
#pragma unroll 8
        for (int kp = qi + 1; kp <= qi + 128; ++kp) o += pr[kp] * bf2f(Vs[kp * 64 + lane]);
        MIX[tq * 1024 + head * 64 + lane] = (bf16_t)f2bf(o / den);
    }
}
__device__ __forceinline__ void gla_naive(const Ctx& c, const Params& p, int bh) {
    const int b = bh >> 2, hd = bh & 3, tid = c.tid, lane = c.lane, wv = c.wave;
    LAS float* qs = (LAS float*)c.shm; LAS float* ks = qs + 32 * 128; LAS float* es = ks + 32 * 128; LAS float* vs = es + 32 * 128; LAS float* os = vs + 32 * 256;
    const bf16_t* P = (const bf16_t*)(p.ws + OFF_P); const float* GK = (const float*)(p.ws + OFF_R); bf16_t* MIX = (bf16_t*)(p.ws + OFF_H);
    float S[128];
#pragma unroll
    for (int j = 0; j < 128; ++j) S[j] = 0.f;
    for (int tb = 0; tb < 128; ++tb) {
        const size_t tg0 = (size_t)b * SEQ + (size_t)tb * 32;
#pragma unroll 1
        for (int i = 0; i < 8; ++i) { const int idx = tid + 512 * i, tt = idx >> 7, j = idx & 127;
            const bf16_t* row = P + (tg0 + tt) * OD_IN;
            qs[idx] = bf2f(row[hd * 128 + j]) * 0.08838834764831845f; ks[idx] = bf2f(row[512 + hd * 128 + j]); es[idx] = __expf(GK[(tg0 + tt) * 512 + hd * 128 + j]); }
#pragma unroll 1
        for (int i = 0; i < 16; ++i) { const int idx = tid + 512 * i, tt = idx >> 8, j = idx & 255; vs[idx] = bf2f(P[(tg0 + tt) * OD_IN + 1024 + hd * 256 + j]); }
        __syncthreads();
        if (wv < 4) {
#pragma unroll 1
            for (int tt = 0; tt < 32; ++tt) {
                const float vv = vs[tt * 256 + tid]; float o = 0.f;
#pragma unroll
                for (int j4 = 0; j4 < 32; ++j4) {
                    const f32x4 e4 = *(const LAS f32x4*)(es + tt * 128 + 4 * j4), k4 = *(const LAS f32x4*)(ks + tt * 128 + 4 * j4), q4 = *(const LAS f32x4*)(qs + tt * 128 + 4 * j4);
#pragma unroll
                    for (int jj = 0; jj < 4; ++jj) { const int j = 4 * j4 + jj; S[j] = S[j] * e4[jj] + k4[jj] * vv; o += q4[jj] * S[j]; } }
                os[tt * 256 + tid] = o;
            }
        }
        __syncthreads();
#pragma unroll 1
        for (int i = 0; i < 4; ++i) { const int tt = wv + 8 * i;
            const f32x4 o4 = *(const LAS f32x4*)(os + tt * 256 + 4 * lane);
            const float ss = wave_sum(o4.x * o4.x + o4.y * o4.y + o4.z * o4.z + o4.w * o4.w);
            const float rs = 1.0f / sqrtf(ss * (1.0f / 256.0f) + 1e-6f);
            const f32x4 gn = *(const f32x4*)(p.od_onorm + 4 * lane);
            const u32x2 og = *(const u32x2*)(P + (tg0 + tt) * OD_IN + 2048 + hd * 256 + 4 * lane);
            const float g0 = bflo(og.x), g1 = bfhi(og.x), g2 = bflo(og.y), g3 = bfhi(og.y);
            u32x2 w; w.x = pk2(o4.x * rs * gn.x * g0 * sigmoidf_(g0), o4.y * rs * gn.y * g1 * sigmoidf_(g1)); w.y = pk2(o4.z * rs * gn.z * g2 * sigmoidf_(g2), o4.w * rs * gn.w * g3 * sigmoidf_(g3));
            *(u32x2*)(MIX + (tg0 + tt) * 1024 + hd * 256 + 4 * lane) = w; }
        __syncthreads();
    }
}

__device__ __forceinline__ void xattn_naive(const Ctx& c, const Params& p, int unit) {
    const int b = unit >> 5, hh = (unit >> 3) & 3, tblk = unit & 7, tid = c.tid, lane = c.lane, wv = c.wave;
    LAS bf16_t* Ks = (LAS bf16_t*)c.shm;
    LAS bf16_t* Vs = (LAS bf16_t*)(c.shm + 256 * 272);
    LAS float* qf = (LAS float*)(c.shm + 256 * 272 + 256 * 256) + wv * 384;
    LAS float* pr = qf + 128;
    const bf16_t* MKV = (const bf16_t*)(p.ws + OFF_MKV); const bf16_t* Q = (const bf16_t*)(p.ws + OFF_P); bf16_t* OA = (bf16_t*)(p.ws + OFF_P + 32 * MiB);
    __syncthreads();
#pragma unroll 1
    for (int i = 0; i < 16; ++i) {
        const int task = tid + 512 * i, which = task >> 12, r = (task >> 4) & 255, ck = task & 15;
        const u32x4 d = *(const u32x4*)(MKV + ((size_t)b * MEMLEN + r) * 1024 + which * 512 + hh * 128 + ck * 8);
        if (which == 0) *(LAS u32x4*)(Ks + r * 136 + ck * 8) = d; else *(LAS u32x4*)(Vs + r * 128 + ck * 8) = d;
    }
    __syncthreads();
#pragma unroll 1
    for (int qq = 0; qq < 64; ++qq) {
        const size_t tq = (size_t)b * SEQ + tblk * 512 + wv * 64 + qq;
        qf[lane] = bf2f(Q[tq * 512 + hh * 128 + lane]) * 0.08838834764831845f; qf[lane + 64] = bf2f(Q[tq * 512 + hh * 128 + 64 + lane]) * 0.08838834764831845f;
        LDS_WAIT();
        float s[4];
#pragma unroll
        for (int j = 0; j < 4; ++j) { const int kp = lane + 64 * j; float a = 0.f;
#pragma unroll
            for (int ck = 0; ck < 16; ++ck) { const u32x4 kk = *(const LAS u32x4*)(Ks + kp * 136 + ck * 8);
                const f32x4 q0 = *(const LAS f32x4*)(qf + ck * 8), q1 = *(const LAS f32x4*)(qf + ck * 8 + 4);
                a += bflo(kk.x) * q0.x + bfhi(kk.x) * q0.y + bflo(kk.y) * q0.z + bfhi(kk.y) * q0.w + bflo(kk.z) * q1.x + bfhi(kk.z) * q1.y + bflo(kk.w) * q1.z + bfhi(kk.w) * q1.w; }
            s[j] = a; }
        const float m = wave_max(fmaxf(fmaxf(s[0], s[1]), fmaxf(s[2], s[3])));
        float den = 0.f;
#pragma unroll
        for (int j = 0; j < 4; ++j) { const float e = __expf(s[j] - m); pr[lane + 64 * j] = e; den += e; }
        den = wave_sum(den);
        LDS_WAIT();
        float o0 = 0.f, o1 = 0.f;
#pragma unroll 4
        for (int k4 = 0; k4 < 64; ++k4) { const f32x4 p4 = *(const LAS f32x4*)(pr + 4 * k4);
#pragma unroll
            for (int kk = 0; kk < 4; ++kk) { const unsigned vv = *(const LAS unsigned*)(Vs + (4 * k4 + kk) * 128 + 2 * lane); o0 += p4[kk] * bflo(vv); o1 += p4[kk] * bfhi(vv); } }
        const float inv = 1.0f / den;
        *(unsigned*)(OA + tq * 512 + hh * 128 + 2 * lane) = pk2(o0 * inv, o1 * inv);
    }
}

__device__ __forceinline__ void moe_slots(const Ctx& c, const Params& p, int layer) {
    LAS int* sh = (LAS int*)c.shm;
    const int* cnt = (const int*)(p.ws + OFF_CTL + CTL_CNT) + layer * 32; int* cur = (int*)(p.ws + OFF_CTL + CTL_CUR) + layer * 32;
    int* blk = (int*)(p.ws + OFF_CTL + CTL_BLK) + layer * 1024;
    __syncthreads();
    if (c.tid == 0) { int acc = 0; for (int e = 0; e < NEXP; ++e) { sh[e] = acc; acc += (cnt[e] + 255) / 256 * 256; } sh[32] = acc; }
    __syncthreads();
    if (blockIdx.x == 0 && c.tid < NEXP) { const int e = c.tid, s = sh[e] / 256, en = (e == NEXP - 1 ? sh[32] : sh[e + 1]) / 256; for (int i = s; i < en; ++i) blk[1 + i] = e; if (e == 0) blk[0] = sh[32] / 256; }
    const int2* RE = (const int2*)(p.ws + OFF_ROUTE); int2* RP = (int2*)(p.ws + OFF_ROUTE + 512 * 1024);
    const bf16_t* H = (const bf16_t*)(p.ws + OFF_H); bf16_t* XB = (bf16_t*)(p.ws + OFF_P);
    for (int ck = c.gw; ck < T_TOK / 64; ck += c.ngw) {
        const int t = ck * 64 + c.lane; const int2 ee = RE[t]; int pos0 = 0, pos1 = 0;
#pragma unroll 1
        for (int e = 0; e < NEXP; ++e) {
            const unsigned long long m0 = __ballot(ee.x == e), m1 = __ballot(ee.y == e);
            const int n0 = __popcll(m0), n1 = __popcll(m1);
            if (n0 + n1 == 0) continue;
            int base = 0; if (c.lane == 0) base = atomicAdd(&cur[e], n0 + n1);
            base = __shfl(base, 0) + sh[e];
            const unsigned long long lt = (1ull << c.lane) - 1ull;
            if (ee.x == e) pos0 = base + __popcll(m0 & lt);
            if (ee.y == e) pos1 = base + n0 + __popcll(m1 & lt);
        }
        RP[t] = make_int2(pos0, pos1);
#pragma unroll 1
        for (int i = 0; i < 64; ++i) { const int ti = ck * 64 + i, q0 = __shfl(pos0, i), q1 = __shfl(pos1, i);
            const u32x4 a = *((const u32x4*)(H + (size_t)ti * 1024) + c.lane), bq = *((const u32x4*)(H + (size_t)ti * 1024) + 64 + c.lane);
            *((u32x4*)(XB + (size_t)q0 * 1024) + c.lane) = a; *((u32x4*)(XB + (size_t)q0 * 1024) + 64 + c.lane) = bq;
            *((u32x4*)(XB + (size_t)q1 * 1024) + c.lane) = a; *((u32x4*)(XB + (size_t)q1 * 1024) + 64 + c.lane) = bq; }
    }
}
typedef short bf16x8_t __attribute__((ext_vector_type(8)));
constexpr size_t R_GK = 0, R_QT = 64 * MiB, R_ATT = 96 * MiB, R_KHT = 112 * MiB, R_GDEC = 144 * MiB;
template <int CTRL, int RMASK> __device__ __forceinline__ float dpp_get0(float x) {
    return __builtin_bit_cast(float, __builtin_amdgcn_update_dpp(0, __builtin_bit_cast(int, x), CTRL, RMASK, 0xF, false)); }
__device__ __forceinline__ float wave_scan_incl(float x, int lane) {
    (void)lane;
    x += dpp_get0<0x111, 0xF>(x); x += dpp_get0<0x112, 0xF>(x); x += dpp_get0<0x114, 0xF>(x); x += dpp_get0<0x118, 0xF>(x);
    x += dpp_get0<0x142, 0xA>(x); x += dpp_get0<0x143, 0xC>(x);
    return x;
}
__device__ __forceinline__ float lane63(float x) { return __builtin_bit_cast(float, __builtin_amdgcn_readlane(__builtin_bit_cast(int, x), 63)); }
__device__ __forceinline__ int key_perm(int key) { const int kq = key & 31; return (key & ~31) + 8 * ((kq >> 2) & 3) + 4 * ((kq >> 4) & 1) + (kq & 3); }
__device__ __forceinline__ bf16x8_t zero_frag() { return (bf16x8_t){0, 0, 0, 0, 0, 0, 0, 0}; }
__device__ __forceinline__ bf16x8_t lds_frag(const LAS bf16_t* img, int pitch, int row, int col) { return *(const LAS bf16x8_t*)(img + row * pitch + col); }
__device__ __forceinline__ bf16x8_t pack8(const float (&v)[8]) {
    u32x4 w; w.x = pk2(v[0], v[1]); w.y = pk2(v[2], v[3]); w.z = pk2(v[4], v[5]); w.w = pk2(v[6], v[7]);
    return __builtin_bit_cast(bf16x8_t, w);
}
__device__ __forceinline__ void gla_prep(const Ctx& c, const Params& p, int unit) {
    const int bh = unit >> 6, ck = unit & 63, b = bh >> 2, hd = bh & 3, lane = c.lane, wv = c.wave;
    LAS bf16_t* Qs = (LAS bf16_t*)c.shm;
    LAS bf16_t* Ks = Qs + 64 * 136;
    const bf16_t* P = (const bf16_t*)(p.ws + OFF_P); unsigned char* R = p.ws + OFF_R;
    const float* GK = (const float*)(R + R_GK); bf16_t* QT = (bf16_t*)(R + R_QT) + (size_t)unit * 64 * 128; bf16_t* ATT = (bf16_t*)(R + R_ATT) + (size_t)unit * 64 * 64;
    bf16_t* KHT = (bf16_t*)(R + R_KHT) + (size_t)unit * 128 * 64; float* GDEC = (float*)(R + R_GDEC) + (size_t)unit * 128;
    const size_t tg = (size_t)b * SEQ + ck * 64 + lane; const int d0 = wv * 16;
    __syncthreads();
    {
        const bf16_t* row = P + tg * OD_IN;
        const u32x4 qa = *(const u32x4*)(row + hd * 128 + d0), qb = *(const u32x4*)(row + hd * 128 + d0 + 8);
        const u32x4 ka = *(const u32x4*)(row + 512 + hd * 128 + d0), kb = *(const u32x4*)(row + 512 + hd * 128 + d0 + 8);
        const unsigned qw[8] = {qa.x, qa.y, qa.z, qa.w, qb.x, qb.y, qb.z, qb.w}, kw[8] = {ka.x, ka.y, ka.z, ka.w, kb.x, kb.y, kb.z, kb.w};
        float qt[16], kt[16], kh[16];
#pragma unroll
        for (int i4 = 0; i4 < 4; ++i4) { const f32x4 g4 = *(const f32x4*)(GK + tg * 512 + hd * 128 + d0 + 4 * i4);
#pragma unroll
            for (int ii = 0; ii < 4; ++ii) { const int i = 4 * i4 + ii;
                const float bb = wave_scan_incl(g4[ii], lane); const float bl = lane63(bb);
                const float qv = (i & 1) ? bfhi(qw[i >> 1]) : bflo(qw[i >> 1]), kv = (i & 1) ? bfhi(kw[i >> 1]) : bflo(kw[i >> 1]);
                qt[i] = qv * 0.08838834764831845f * __expf(bb); kt[i] = kv * __expf(-bb); kh[i] = kv * __expf(bl - bb);
                if (lane == 63) GDEC[d0 + i] = __expf(bl); } }
        { u32x4 w0, w1; w0.x = pk2(qt[0], qt[1]); w0.y = pk2(qt[2], qt[3]); w0.z = pk2(qt[4], qt[5]); w0.w = pk2(qt[6], qt[7]); w1.x = pk2(qt[8], qt[9]); w1.y = pk2(qt[10], qt[11]); w1.z = pk2(qt[12], qt[13]); w1.w = pk2(qt[14], qt[15]);
          *(LAS u32x4*)(Qs + lane * 136 + d0) = w0; *(LAS u32x4*)(Qs + lane * 136 + d0 + 8) = w1; }
        { u32x4 w0, w1; w0.x = pk2(kt[0], kt[1]); w0.y = pk2(kt[2], kt[3]); w0.z = pk2(kt[4], kt[5]); w0.w = pk2(kt[6], kt[7]); w1.x = pk2(kt[8], kt[9]); w1.y = pk2(kt[10], kt[11]); w1.z = pk2(kt[12], kt[13]); w1.w = pk2(kt[14], kt[15]);
          *(LAS u32x4*)(Ks + lane * 136 + d0) = w0; *(LAS u32x4*)(Ks + lane * 136 + d0 + 8) = w1; }
        { const int sg = d0 >> 5, hb = (d0 >> 4) & 1;
#pragma unroll
          for (int x4 = 0; x4 < 4; ++x4) { u32x2 w; w.x = pk2(qt[4 * x4], qt[4 * x4 + 1]); w.y = pk2(qt[4 * x4 + 2], qt[4 * x4 + 3]);
              *(u32x2*)(QT + lane * 128 + 32 * sg + 8 * x4 + 4 * hb) = w; } }
        { const int sc = key_perm(lane);
#pragma unroll
          for (int i = 0; i < 16; ++i) KHT[(d0 + i) * 64 + sc] = (bf16_t)f2bf(kh[i]); }
    }
    __syncthreads();
    const int fr = lane & 15, fq = lane >> 4;
#pragma unroll
    for (int h2 = 0; h2 < 2; ++h2) { const int tile = 2 * wv + h2, si = tile >> 2, ti = tile & 3;
        f32x4 acc = (f32x4){0.f, 0.f, 0.f, 0.f};
        if (si <= ti) {
#pragma unroll
            for (int kk = 0; kk < 4; ++kk) { const bf16x8_t a = *(const LAS bf16x8_t*)(Ks + (16 * si + fr) * 136 + 32 * kk + 8 * fq), bq = *(const LAS bf16x8_t*)(Qs + (16 * ti + fr) * 136 + 32 * kk + 8 * fq);
                acc = __builtin_amdgcn_mfma_f32_16x16x32_bf16(a, bq, acc, 0, 0, 0); } }
        const int t = 16 * ti + fr, s0 = 16 * si + 4 * fq;
        u32x2 w; w.x = pk2(s0 <= t ? acc[0] : 0.f, s0 + 1 <= t ? acc[1] : 0.f); w.y = pk2(s0 + 2 <= t ? acc[2] : 0.f, s0 + 3 <= t ? acc[3] : 0.f);
        *(u32x2*)(ATT + t * 64 + 32 * (si >> 1) + 8 * fq + 4 * (si & 1)) = w; }
}
constexpr int GB_QT = 0, GB_ATT = 64 * 136 * 2, GB_KHT = GB_ATT + 64 * 72 * 2, GB_GD = GB_KHT + 128 * 72 * 2, GB_BYTES = GB_GD + 512;
__device__ __forceinline__ void gla_state_fill(const Params& p, unsigned char* buf, int unit, int ptid) {
    const unsigned char* R = p.ws + OFF_R;
    const bf16_t* QT = (const bf16_t*)(R + R_QT) + (size_t)unit * 64 * 128; const bf16_t* ATT = (const bf16_t*)(R + R_ATT) + (size_t)unit * 64 * 64;
    const bf16_t* KHT = (const bf16_t*)(R + R_KHT) + (size_t)unit * 128 * 64; const float* GDEC = (const float*)(R + R_GDEC) + (size_t)unit * 128;
    u32x4 r[11];
#pragma unroll
    for (int i = 0; i < 4; ++i) r[i] = *((const u32x4*)QT + ptid + 256 * i);
#pragma unroll
    for (int i = 0; i < 2; ++i) r[4 + i] = *((const u32x4*)ATT + ptid + 256 * i);
#pragma unroll
    for (int i = 0; i < 4; ++i) r[6 + i] = *((const u32x4*)KHT + ptid + 256 * i);
    if (ptid < 32) r[10] = *((const u32x4*)GDEC + ptid);
#pragma unroll
    for (int i = 0; i < 4; ++i) { const int idx = ptid + 256 * i; *(LAS u32x4*)(buf + GB_QT + (idx >> 4) * 272 + (idx & 15) * 16) = r[i]; }
#pragma unroll
    for (int i = 0; i < 2; ++i) { const int idx = ptid + 256 * i; *(LAS u32x4*)(buf + GB_ATT + (idx >> 3) * 144 + (idx & 7) * 16) = r[4 + i]; }
#pragma unroll
    for (int i = 0; i < 4; ++i) { const int idx = ptid + 256 * i; *(LAS u32x4*)(buf + GB_KHT + (idx >> 3) * 144 + (idx & 7) * 16) = r[6 + i]; }
    if (ptid < 32) *(LAS u32x4*)(buf + GB_GD + ptid * 16) = r[10];
}
__device__ __forceinline__ void gla_state(const Ctx& c, const Params& p, int bh, int slice) {
    const int b = bh >> 2, hd = bh & 3, lane = c.lane, wv = c.wave, fr = lane & 15, fq = lane >> 4, jt = slice * 4 + (wv & 3);
    const bf16_t* P = (const bf16_t*)(p.ws + OFF_P); bf16_t* O = (bf16_t*)(p.ws + OFF_H);
    unsigned char* sm = c.shm;
    f32x4 S[8];
#pragma unroll
    for (int i = 0; i < 8; ++i) S[i] = (f32x4){0.f, 0.f, 0.f, 0.f};
    bf16x8_t idf;
    { float iv[8];
#pragma unroll
      for (int e = 0; e < 8; ++e) iv[e] = (8 * fq + e == fr) ? 1.0f : 0.0f;
      idf = pack8(iv); }
    const size_t tb = (size_t)b * SEQ; const bf16_t* vcol = P + 1024 + hd * 256 + 16 * jt + 8 * fq;
    bf16x8_t vraw[4];
#pragma unroll
    for (int st = 0; st < 4; ++st) { vraw[st] = zero_frag(); if (wv < 4 && fq < 2) vraw[st] = *(const bf16x8_t*)(vcol + (tb + 16 * st + fr) * OD_IN); }
    __syncthreads();
    if (wv >= 4) gla_state_fill(p, sm, bh * 64, c.tid - 256);
    __syncthreads();
#pragma unroll 1
    for (int ck = 0; ck < 64; ++ck) {
        unsigned char* buf = sm + (ck & 1) * GB_BYTES;
        if (wv >= 4) { if (ck + 1 < 64) gla_state_fill(p, sm + ((ck + 1) & 1) * GB_BYTES, bh * 64 + ck + 1, c.tid - 256); }
        else {
            const size_t t0 = tb + ck * 64;
            const LAS bf16_t* QT = (const LAS bf16_t*)(buf + GB_QT); const LAS bf16_t* ATT = (const LAS bf16_t*)(buf + GB_ATT); const LAS bf16_t* KHT = (const LAS bf16_t*)(buf + GB_KHT); const LAS float* GD = (const LAS float*)(buf + GB_GD);
            bf16x8_t vf[2];
            { f32x4 vt[4];
#pragma unroll
              for (int st = 0; st < 4; ++st) vt[st] = __builtin_amdgcn_mfma_f32_16x16x32_bf16(vraw[st], idf, (f32x4){0.f, 0.f, 0.f, 0.f}, 0, 0, 0);
#pragma unroll
              for (int s2 = 0; s2 < 2; ++s2) { const float vv[8] = {vt[2 * s2][0], vt[2 * s2][1], vt[2 * s2][2], vt[2 * s2][3], vt[2 * s2 + 1][0], vt[2 * s2 + 1][1], vt[2 * s2 + 1][2], vt[2 * s2 + 1][3]}; vf[s2] = pack8(vv); } }
            if (ck + 1 < 64) {
#pragma unroll
                for (int st = 0; st < 4; ++st) if (fq < 2) vraw[st] = *(const bf16x8_t*)(vcol + (t0 + 64 + 16 * st + fr) * OD_IN); }
            f32x4 acc[4];
#pragma unroll
            for (int ti = 0; ti < 4; ++ti) acc[ti] = (f32x4){0.f, 0.f, 0.f, 0.f};
#pragma unroll
            for (int sg = 0; sg < 4; ++sg) { const float sv[8] = {S[2 * sg][0], S[2 * sg][1], S[2 * sg][2], S[2 * sg][3], S[2 * sg + 1][0], S[2 * sg + 1][1], S[2 * sg + 1][2], S[2 * sg + 1][3]};
                const bf16x8_t a = pack8(sv);
#pragma unroll
                for (int ti = 0; ti < 4; ++ti) acc[ti] = __builtin_amdgcn_mfma_f32_16x16x32_bf16(a, lds_frag(QT, 136, 16 * ti + fr, 32 * sg + 8 * fq), acc[ti], 0, 0, 0); }
#pragma unroll
            for (int s2 = 0; s2 < 2; ++s2)
#pragma unroll
                for (int ti = 0; ti < 4; ++ti) acc[ti] = __builtin_amdgcn_mfma_f32_16x16x32_bf16(vf[s2], lds_frag(ATT, 72, 16 * ti + fr, 32 * s2 + 8 * fq), acc[ti], 0, 0, 0);
#pragma unroll
            for (int ti = 0; ti < 4; ++ti) { u32x2 w; w.x = pk2(acc[ti][0], acc[ti][1]); w.y = pk2(acc[ti][2], acc[ti][3]);
                *(u32x2*)(O + (t0 + 16 * ti + fr) * 1024 + hd * 256 + 16 * jt + 4 * fq) = w; }
#pragma unroll
            for (int rt = 0; rt < 8; ++rt) { const f32x4 g4 = *(const LAS f32x4*)(GD + 16 * rt + 4 * fq); f32x4 s = S[rt] * g4;
#pragma unroll
                for (int s2 = 0; s2 < 2; ++s2) s = __builtin_amdgcn_mfma_f32_16x16x32_bf16(lds_frag(KHT, 72, 16 * rt + fr, 32 * s2 + 8 * fq), vf[s2], s, 0, 0, 0);
                S[rt] = s; }
        }
        __syncthreads();
    }
}
__device__ __forceinline__ void gla_finish(const Ctx& c, const Params& p) {
    const bf16_t* P = (const bf16_t*)(p.ws + OFF_P); bf16_t* O = (bf16_t*)(p.ws + OFF_H);
    for (int r = c.gw; r < T_TOK; r += c.ngw) {
#pragma unroll
        for (int j = 0; j < 4; ++j) {
            const u32x2 ow = *((const u32x2*)(O + (size_t)r * 1024 + 256 * j) + c.lane), gw = *((const u32x2*)(P + (size_t)r * OD_IN + 2048 + 256 * j) + c.lane);
            const float o0 = bflo(ow.x), o1 = bfhi(ow.x), o2 = bflo(ow.y), o3 = bfhi(ow.y);
            const float ss = wave_sum(o0 * o0 + o1 * o1 + o2 * o2 + o3 * o3); const float rs = 1.0f / sqrtf(ss * (1.0f / 256.0f) + 1e-6f);
            const f32x4 gn = *((const f32x4*)p.od_onorm + c.lane);
            const float g0 = bflo(gw.x), g1 = bfhi(gw.x), g2 = bflo(gw.y), g3 = bfhi(gw.y);
            u32x2 w; w.x = pk2(o0 * rs * gn.x * g0 * sigmoidf_(g0), o1 * rs * gn.y * g1 * sigmoidf_(g1)); w.y = pk2(o2 * rs * gn.z * g2 * sigmoidf_(g2), o3 * rs * gn.w * g3 * sigmoidf_(g3));
            *((u32x2*)(O + (size_t)r * 1024 + 256 * j) + c.lane) = w; }
    }
}

constexpr size_t R_MG = 0, R_NT = 32 * MiB, R_QG = 64 * MiB, R_Y0 = 96 * MiB, R_Z0 = 128 * MiB, R_GAM = 160 * MiB, R_BON = 161 * MiB, R_MEMN = 164 * MiB;
constexpr size_t WSM_W2T = 0, WSM_A2T = 64 * 1024;
constexpr size_t WSM_G2T = 512 * 1024;
constexpr int XI = 64 * 72 * 2;
constexpr int X_RHS = 11 * XI, X_DIAG = X_RHS + 34816, X_TI = X_DIAG + 4352, X_RED = X_TI + 3072;

__device__ __forceinline__ void rwkv_x(const Ctx& c, const Params& p, int unit) {
    const int bh = unit >> 6, ck = unit & 63, b = bh >> 3, hd = bh & 7, tid = c.tid, lane = c.lane, wv = c.wave, fr = lane & 15, fq = lane >> 4;
    unsigned char* sm = c.shm;
    LAS bf16_t* At = (LAS bf16_t*)sm; LAS bf16_t* Bt = (LAS bf16_t*)(sm + XI); LAS bf16_t* Kt = (LAS bf16_t*)(sm + 2 * XI); LAS bf16_t* Rt = (LAS bf16_t*)(sm + 3 * XI);
    LAS bf16_t* BH = (LAS bf16_t*)(sm + 4 * XI); LAS bf16_t* KH = (LAS bf16_t*)(sm + 5 * XI); LAS bf16_t* VT = (LAS bf16_t*)(sm + 6 * XI);
    LAS bf16_t* AAB = (LAS bf16_t*)(sm + 7 * XI); LAS bf16_t* AAK = (LAS bf16_t*)(sm + 8 * XI); LAS bf16_t* ARB = (LAS bf16_t*)(sm + 9 * XI); LAS bf16_t* ARK = (LAS bf16_t*)(sm + 10 * XI);
    LAS bf16_t* XT = At;
    LAS bf16_t* YT = Kt;
    LAS float* RHS = (LAS float*)(sm + X_RHS);
    LAS float* sXW = RHS; LAS float* sXA = RHS + 64 * 68;
    LAS float* DIAG = (LAS float*)(sm + X_DIAG);
    LAS bf16_t* TI = (LAS bf16_t*)(sm + X_TI);
    LAS float* red = (LAS float*)(sm + X_RED);
    const bf16_t* P = (const bf16_t*)(p.ws + OFF_P); unsigned char* R = p.ws + OFF_R;
    const size_t tg0 = (size_t)b * SEQ + (size_t)ck * 64;
    const int t = lane, cg = wv, ch0 = hd * 64 + cg * 8;
    __syncthreads();
#pragma unroll 1
    for (int i = 0; i < 2; ++i) {
        const int task = tid + 512 * i, tt = task >> 4, q = task & 15;
        const int col = 1536 + 8 * q; LAS bf16_t* dst = (q < 8 ? At + tt * 72 + 8 * q : Bt + tt * 72 + 8 * (q - 8));
        const bf16_t* src = P + (tg0 + tt) * EV_IN + 768 + col;
        const u32x4 cur = *(const u32x4*)src; u32x4 prv = (u32x4){0u, 0u, 0u, 0u};
        if (ck * 64 + tt > 0) prv = *(const u32x4*)(src - EV_IN);
        const f32x4 m0 = *(const f32x4*)(p.ev_mu + col), m1 = *(const f32x4*)(p.ev_mu + col + 4);
        const unsigned cw[4] = {cur.x, cur.y, cur.z, cur.w}, pw[4] = {prv.x, prv.y, prv.z, prv.w}; const float mu[8] = {m0.x, m0.y, m0.z, m0.w, m1.x, m1.y, m1.z, m1.w};
        float v[8];
#pragma unroll
        for (int k = 0; k < 4; ++k) { const float c0 = bflo(cw[k]), c1 = bfhi(cw[k]), p0 = bflo(pw[k]), p1 = bfhi(pw[k]); v[2 * k] = c0 + (p0 - c0) * mu[2 * k]; v[2 * k + 1] = c1 + (p1 - c1) * mu[2 * k + 1]; }
        if (q < 8) {
#pragma unroll
            for (int k = 0; k < 8; ++k) v[k] = tanhf_(v[k]); }
        { u32x4 w; w.x = pk2(v[0], v[1]); w.y = pk2(v[2], v[3]); w.z = pk2(v[4], v[5]); w.w = pk2(v[6], v[7]); *(LAS u32x4*)dst = w; }
    }
    float rv[8], kv[8], vv[8];
    {
        const bf16_t* src = P + (tg0 + t) * EV_IN + 768 + ch0; const bool hp = (ck * 64 + t > 0);
#pragma unroll
        for (int w3 = 0; w3 < 3; ++w3) { const u32x4 cur = *(const u32x4*)(src + 512 * w3); u32x4 prv = (u32x4){0u, 0u, 0u, 0u}; if (hp) prv = *(const u32x4*)(src + 512 * w3 - EV_IN);
            const f32x4 m0 = *(const f32x4*)(p.ev_mu + 512 * w3 + ch0), m1 = *(const f32x4*)(p.ev_mu + 512 * w3 + ch0 + 4);
            const unsigned cw[4] = {cur.x, cur.y, cur.z, cur.w}, pw[4] = {prv.x, prv.y, prv.z, prv.w}; const float mu[8] = {m0.x, m0.y, m0.z, m0.w, m1.x, m1.y, m1.z, m1.w};
#pragma unroll
            for (int k = 0; k < 4; ++k) { const float c0 = bflo(cw[k]), c1 = bfhi(cw[k]), p0 = bflo(pw[k]), p1 = bfhi(pw[k]);
                const float x0 = c0 + (p0 - c0) * mu[2 * k], x1 = c1 + (p1 - c1) * mu[2 * k + 1];
                if (w3 == 0) { rv[2 * k] = x0; rv[2 * k + 1] = x1; } else if (w3 == 1) { kv[2 * k] = x0; kv[2 * k + 1] = x1; } else { vv[2 * k] = x0; vv[2 * k + 1] = x1; } } }
    }
    __syncthreads();
    {
        const int mat = wv >> 2; const bf16_t* WT = (const bf16_t*)(p.ws + OFF_WSMALL + (mat ? WSM_A2T : WSM_W2T)); const LAS bf16_t* img = mat ? Bt : At; LAS float* dstm = mat ? sXA : sXW;
#pragma unroll
        for (int n = 0; n < 4; ++n) { const int tile = (wv & 3) * 4 + n, ct = tile >> 2, tt = tile & 3;
            f32x4 acc = (f32x4){0.f, 0.f, 0.f, 0.f};
#pragma unroll
            for (int kk = 0; kk < 2; ++kk) acc = __builtin_amdgcn_mfma_f32_16x16x32_bf16(*(const bf16x8_t*)(WT + (size_t)(hd * 64 + 16 * ct + fr) * 64 + 32 * kk + 8 * fq), lds_frag(img, 72, 16 * tt + fr, 32 * kk + 8 * fq), acc, 0, 0, 0);
            *(LAS f32x4*)(dstm + (16 * tt + fr) * 68 + 16 * ct + 4 * fq) = acc; }
    }
    __syncthreads();
    float zw[8], za[8];
    { const f32x4 a0 = *(const LAS f32x4*)(sXW + t * 68 + cg * 8), a1 = *(const LAS f32x4*)(sXW + t * 68 + cg * 8 + 4), b0 = *(const LAS f32x4*)(sXA + t * 68 + cg * 8), b1 = *(const LAS f32x4*)(sXA + t * 68 + cg * 8 + 4);
      zw[0] = a0.x; zw[1] = a0.y; zw[2] = a0.z; zw[3] = a0.w; zw[4] = a1.x; zw[5] = a1.y; zw[6] = a1.z; zw[7] = a1.w;
      za[0] = b0.x; za[1] = b0.y; za[2] = b0.z; za[3] = b0.w; za[4] = b1.x; za[5] = b1.y; za[6] = b1.z; za[7] = b1.w; }
    float lw[8], av[8], kkv[8], kp[8]; float ss = 0.f, sb = 0.f;
#pragma unroll
    for (int i = 0; i < 8; ++i) { const int ch = ch0 + i;
        const float u = -(p.ev_w0[ch] + zw[i]); const float sp = (u > 20.f) ? u : __logf(1.0f + __expf(u));
        lw[i] = -__expf(-sp - 0.5f);
        av[i] = sigmoidf_(p.ev_a0[ch] + za[i]);
        kkv[i] = kv[i] * p.ev_k_k[ch]; ss += kkv[i] * kkv[i];
        kp[i] = kv[i] * (1.0f + (av[i] - 1.0f) * p.ev_k_a[ch]);
        sb += rv[i] * kp[i] * p.ev_r_k[ch]; }
    red[t * 8 + cg] = ss; red[512 + t * 8 + cg] = sb;
    __syncthreads();
    {
        float tot = 0.f, bon = 0.f;
#pragma unroll
        for (int i = 0; i < 8; ++i) { tot += red[t * 8 + i]; bon += red[512 + t * 8 + i]; }
        if (cg == 0) ((float*)(R + R_BON))[(tg0 + t) * 8 + hd] = bon;
        const float inv = __builtin_amdgcn_rcpf(fmaxf(sqrtf(tot), 1e-12f));
        float at[8], rt_[8], bt[8], kt[8], bh_[8], kh_[8];
#pragma unroll
        for (int i = 0; i < 8; ++i) {
            const float cl = wave_scan_incl(lw[i], lane); const float cl63 = lane63(cl);
            const float e1 = __expf(cl), e0 = __expf(cl - lw[i]), en = __expf(-cl), eh = __expf(cl63 - cl);
            const float kn = kkv[i] * inv, A = -kn, Bv = kn * av[i];
            at[i] = A * e0; rt_[i] = rv[i] * e1; bt[i] = Bv * en; kt[i] = kp[i] * en; bh_[i] = Bv * eh; kh_[i] = kp[i] * eh;
            if (lane == 63) ((float*)(R + R_GAM))[(size_t)unit * 64 + cg * 8 + i] = __expf(cl63); }
        { u32x4 w; w.x = pk2(at[0], at[1]); w.y = pk2(at[2], at[3]); w.z = pk2(at[4], at[5]); w.w = pk2(at[6], at[7]); *(LAS u32x4*)(At + t * 72 + cg * 8) = w; }
        { u32x4 w; w.x = pk2(rt_[0], rt_[1]); w.y = pk2(rt_[2], rt_[3]); w.z = pk2(rt_[4], rt_[5]); w.w = pk2(rt_[6], rt_[7]); *(LAS u32x4*)(Rt + t * 72 + cg * 8) = w; }
        { u32x4 w; w.x = pk2(bt[0], bt[1]); w.y = pk2(bt[2], bt[3]); w.z = pk2(bt[4], bt[5]); w.w = pk2(bt[6], bt[7]); *(LAS u32x4*)(Bt + t * 72 + cg * 8) = w; }
        { u32x4 w; w.x = pk2(kt[0], kt[1]); w.y = pk2(kt[2], kt[3]); w.z = pk2(kt[4], kt[5]); w.w = pk2(kt[6], kt[7]); *(LAS u32x4*)(Kt + t * 72 + cg * 8) = w; }
        *(LAS f32x4*)(RHS + t * 132 + 64 + cg * 8) = (f32x4){at[0], at[1], at[2], at[3]}; *(LAS f32x4*)(RHS + t * 132 + 64 + cg * 8 + 4) = (f32x4){at[4], at[5], at[6], at[7]};
#pragma unroll
        for (int i = 0; i < 8; ++i) { BH[(cg * 8 + i) * 72 + t] = (bf16_t)f2bf(bh_[i]); KH[(cg * 8 + i) * 72 + t] = (bf16_t)f2bf(kh_[i]); VT[(cg * 8 + i) * 72 + t] = (bf16_t)f2bf(vv[i]); }
    }
    __syncthreads();
    {
        const int mat = wv >> 1;
        const LAS bf16_t* Ximg = (mat < 2) ? At : Rt; const LAS bf16_t* Yimg = (mat & 1) ? Kt : Bt;
        LAS bf16_t* Oimg = mat == 0 ? AAB : (mat == 1 ? AAK : (mat == 2 ? ARB : ARK));
#pragma unroll 1
        for (int n = 0; n < 8; ++n) { const int idx = (wv & 1) * 8 + n, si = idx >> 2, ti = idx & 3;
            f32x4 acc = (f32x4){0.f, 0.f, 0.f, 0.f};
            if (si <= ti) {
#pragma unroll
                for (int kk = 0; kk < 2; ++kk) acc = __builtin_amdgcn_mfma_f32_16x16x32_bf16(lds_frag(Yimg, 72, 16 * si + fr, 32 * kk + 8 * fq), lds_frag(Ximg, 72, 16 * ti + fr, 32 * kk + 8 * fq), acc, 0, 0, 0); }
            const int tt = 16 * ti + fr, s0 = 16 * si + 4 * fq; const int lim = (mat < 2) ? tt - 1 : tt;
            const float o0 = s0 <= lim ? acc[0] : 0.f, o1 = s0 + 1 <= lim ? acc[1] : 0.f, o2 = s0 + 2 <= lim ? acc[2] : 0.f, o3 = s0 + 3 <= lim ? acc[3] : 0.f;
            u32x2 w; w.x = pk2(o0, o1); w.y = pk2(o2, o3); *(LAS u32x2*)(Oimg + tt * 72 + s0) = w;
            if (mat == 0 && si == ti) { LAS float* d = DIAG + si * 272 + fr * 17 + 4 * fq; d[0] = o0; d[1] = o1; d[2] = o2; d[3] = o3; } }
    }
    __syncthreads();
    {
#pragma unroll
        for (int h2 = 0; h2 < 2; ++h2) { const int tile = 2 * wv + h2, ti = tile >> 2, ji = tile & 3;
            f32x4 acc = (f32x4){0.f, 0.f, 0.f, 0.f};
#pragma unroll
            for (int kk = 0; kk < 2; ++kk) acc = __builtin_amdgcn_mfma_f32_16x16x32_bf16(lds_frag(AAK, 72, 16 * ti + fr, 32 * kk + 8 * fq), lds_frag(VT, 72, 16 * ji + fr, 32 * kk + 8 * fq), acc, 0, 0, 0);
#pragma unroll
            for (int r = 0; r < 4; ++r) RHS[(16 * ti + 4 * fq + r) * 132 + 16 * ji + fr] = acc[r]; }
        if (wv < 4 && lane < 16) { const LAS float* d = DIAG + wv * 272; float T[16];
#pragma unroll
            for (int r = 0; r < 16; ++r) { float s = (r == lane) ? 1.f : 0.f;
#pragma unroll
                for (int q = 0; q < r; ++q) s += d[r * 17 + q] * T[q];
                T[r] = s; TI[wv * 384 + r * 24 + lane] = (bf16_t)f2bf(s); } }
    }
    __syncthreads();
#pragma unroll 1
    for (int I = 0; I < 4; ++I) {
        f32x4 acc;
#pragma unroll
        for (int r = 0; r < 4; ++r) acc[r] = RHS[(16 * I + 4 * fq + r) * 132 + 16 * wv + fr];
#pragma unroll 1
        for (int kk = 0; 32 * kk < 16 * I; ++kk) { const bool ok = (32 * kk + 8 * fq) < 16 * I;
            bf16x8_t a = zero_frag(), bq = zero_frag();
            if (ok) { a = lds_frag(AAB, 72, 16 * I + fr, 32 * kk + 8 * fq); bq = lds_frag(XT, 72, 16 * wv + fr, 32 * kk + 8 * fq); }
            acc = __builtin_amdgcn_mfma_f32_16x16x32_bf16(a, bq, acc, 0, 0, 0); }
        { u32x2 w; w.x = pk2(acc[0], acc[1]); w.y = pk2(acc[2], acc[3]); *(LAS u32x2*)(YT + (16 * wv + fr) * 24 + 4 * fq) = w; }
        __syncthreads();
        { bf16x8_t a = zero_frag(), bq = zero_frag();
          if (fq < 2) { a = *(const LAS bf16x8_t*)(TI + I * 384 + fr * 24 + 8 * fq); bq = *(const LAS bf16x8_t*)(YT + (16 * wv + fr) * 24 + 8 * fq); }
          f32x4 x = __builtin_amdgcn_mfma_f32_16x16x32_bf16(a, bq, (f32x4){0.f, 0.f, 0.f, 0.f}, 0, 0, 0);
          u32x2 w; w.x = pk2(x[0], x[1]); w.y = pk2(x[2], x[3]); *(LAS u32x2*)(XT + (16 * wv + fr) * 72 + 16 * I + 4 * fq) = w; }
        __syncthreads();
    }
    {
        const int mat = wv >> 1;
        bf16_t* MG = (bf16_t*)(R + R_MG) + (size_t)unit * 4096; bf16_t* NT = (bf16_t*)(R + R_NT) + (size_t)unit * 4096;
        bf16_t* QG = (bf16_t*)(R + R_QG) + (size_t)unit * 4096; bf16_t* Y0G = (bf16_t*)(R + R_Y0) + (size_t)unit * 4096;
#pragma unroll 1
        for (int n = 0; n < 8; ++n) { const int idx = (wv & 1) * 8 + n, rt = idx >> 2, ct = idx & 3;
            f32x4 acc = (f32x4){0.f, 0.f, 0.f, 0.f};
            if (mat == 2) { const u32x2 r2 = *(const LAS u32x2*)(Rt + (16 * ct + fr) * 72 + 16 * rt + 4 * fq); acc = (f32x4){bflo(r2.x), bfhi(r2.x), bflo(r2.y), bfhi(r2.y)}; }
#pragma unroll
            for (int kk = 0; kk < 2; ++kk) { const int kc = 32 * kk + 8 * fq;
                if (mat == 0) acc = __builtin_amdgcn_mfma_f32_16x16x32_bf16(lds_frag(XT, 72, 64 + 16 * rt + fr, kc), lds_frag(BH, 72, 16 * ct + fr, kc), acc, 0, 0, 0);
                else if (mat == 1) { acc = __builtin_amdgcn_mfma_f32_16x16x32_bf16(lds_frag(BH, 72, 16 * rt + fr, kc), lds_frag(XT, 72, 16 * ct + fr, kc), acc, 0, 0, 0);
                                     acc = __builtin_amdgcn_mfma_f32_16x16x32_bf16(lds_frag(KH, 72, 16 * rt + fr, kc), lds_frag(VT, 72, 16 * ct + fr, kc), acc, 0, 0, 0); }
                else if (mat == 2) acc = __builtin_amdgcn_mfma_f32_16x16x32_bf16(lds_frag(XT, 72, 64 + 16 * rt + fr, kc), lds_frag(ARB, 72, 16 * ct + fr, kc), acc, 0, 0, 0);
                else { acc = __builtin_amdgcn_mfma_f32_16x16x32_bf16(lds_frag(XT, 72, 16 * rt + fr, kc), lds_frag(ARB, 72, 16 * ct + fr, kc), acc, 0, 0, 0);
                       acc = __builtin_amdgcn_mfma_f32_16x16x32_bf16(lds_frag(VT, 72, 16 * rt + fr, kc), lds_frag(ARK, 72, 16 * ct + fr, kc), acc, 0, 0, 0); } }
            u32x2 w; w.x = pk2(acc[0], acc[1]); w.y = pk2(acc[2], acc[3]);
            if (mat == 0) *(u32x2*)(MG + (16 * ct + fr) * 64 + 32 * (rt >> 1) + 8 * fq + 4 * (rt & 1)) = w;
            else if (mat == 1) *(u32x2*)(NT + (16 * ct + fr) * 64 + 16 * rt + 4 * fq) = w;
            else if (mat == 2) *(u32x2*)(QG + (16 * ct + fr) * 64 + 16 * rt + 4 * fq) = w;
            else *(u32x2*)(Y0G + (16 * ct + fr) * 64 + 16 * rt + 4 * fq) = w; }
    }
}

struct RwkvYOps { bf16x8_t m[4][2]; u32x2 n[4]; f32x4 g[4]; };
__device__ __forceinline__ void rwkv_y_load(RwkvYOps& o, const unsigned char* R, size_t unit, int jb, int fr, int fq) {
    const bf16_t* MG = (const bf16_t*)(R + R_MG) + unit * 4096; const bf16_t* NT = (const bf16_t*)(R + R_NT) + unit * 4096; const float* GAM = (const float*)(R + R_GAM) + unit * 64;
#pragma unroll
    for (int rt = 0; rt < 4; ++rt) {
#pragma unroll
        for (int sg = 0; sg < 2; ++sg) o.m[rt][sg] = *(const bf16x8_t*)(MG + (16 * rt + fr) * 64 + 32 * sg + 8 * fq);
        o.n[rt] = *(const u32x2*)(NT + (16 * jb + fr) * 64 + 16 * rt + 4 * fq); o.g[rt] = *(const f32x4*)(GAM + 16 * rt + 4 * fq); }
}
__device__ __forceinline__ void rwkv_y(const Ctx& c, const Params& p, int bh, int jb) {
    const int lane = c.lane, fr = lane & 15, fq = lane >> 4; unsigned char* R = p.ws + OFF_R;
    f32x4 Z[4];
#pragma unroll
    for (int i = 0; i < 4; ++i) Z[i] = (f32x4){0.f, 0.f, 0.f, 0.f};
    RwkvYOps cur, nxt; rwkv_y_load(cur, R, (size_t)bh * 64, jb, fr, fq);
#pragma unroll 1
    for (int ck = 0; ck < 64; ++ck) { const size_t unit = (size_t)bh * 64 + ck;
        rwkv_y_load(nxt, R, unit + (ck + 1 < 64 ? 1 : 0), jb, fr, fq);
        bf16_t* Z0 = (bf16_t*)(R + R_Z0) + unit * 4096;
        f32x4 acc[4];
#pragma unroll
        for (int rt = 0; rt < 4; ++rt) { u32x2 w; w.x = pk2(Z[rt][0], Z[rt][1]); w.y = pk2(Z[rt][2], Z[rt][3]); *(u32x2*)(Z0 + (16 * jb + fr) * 64 + 16 * rt + 4 * fq) = w;
            acc[rt] = (f32x4){bflo(cur.n[rt].x), bfhi(cur.n[rt].x), bflo(cur.n[rt].y), bfhi(cur.n[rt].y)} + cur.g[rt] * Z[rt]; }
        bf16x8_t zb[2];
#pragma unroll
        for (int sg = 0; sg < 2; ++sg) { const float zv[8] = {Z[2 * sg][0], Z[2 * sg][1], Z[2 * sg][2], Z[2 * sg][3], Z[2 * sg + 1][0], Z[2 * sg + 1][1], Z[2 * sg + 1][2], Z[2 * sg + 1][3]}; zb[sg] = pack8(zv); }
#pragma unroll
        for (int rt = 0; rt < 4; ++rt)
#pragma unroll
            for (int sg = 0; sg < 2; ++sg) acc[rt] = __builtin_amdgcn_mfma_f32_16x16x32_bf16(cur.m[rt][sg], zb[sg], acc[rt], 0, 0, 0);
#pragma unroll
        for (int rt = 0; rt < 4; ++rt) Z[rt] = acc[rt];
        cur = nxt;
    }
}

__device__ __forceinline__ void rwkv_z(const Ctx& c, const Params& p, int unit) {
    const int bh = unit >> 6, ck = unit & 63, b = bh >> 3, hd = bh & 7, lane = c.lane, fr = lane & 15, fq = lane >> 4; unsigned char* R = p.ws + OFF_R;
    const bf16_t* P = (const bf16_t*)(p.ws + OFF_P); bf16_t* MIX = (bf16_t*)(p.ws + OFF_H);
    const bf16_t* QG = (const bf16_t*)(R + R_QG) + (size_t)unit * 4096; const bf16_t* Y0G = (const bf16_t*)(R + R_Y0) + (size_t)unit * 4096; const bf16_t* Z0 = (const bf16_t*)(R + R_Z0) + (size_t)unit * 4096;
    const bf16_t* G2T = (const bf16_t*)(p.ws + OFF_WSMALL + WSM_G2T);
    const size_t tg0 = (size_t)b * SEQ + (size_t)ck * 64;
    f32x4 y[4][4], g[4][4];
#pragma unroll
    for (int jt = 0; jt < 4; ++jt)
#pragma unroll
        for (int tt = 0; tt < 4; ++tt) { const u32x2 w = *(const u32x2*)(Y0G + (16 * tt + fr) * 64 + 16 * jt + 4 * fq); y[jt][tt] = (f32x4){bflo(w.x), bfhi(w.x), bflo(w.y), bfhi(w.y)}; g[jt][tt] = (f32x4){0.f, 0.f, 0.f, 0.f}; }
#pragma unroll
    for (int sg = 0; sg < 2; ++sg) { bf16x8_t qb[4];
#pragma unroll
        for (int tt = 0; tt < 4; ++tt) qb[tt] = *(const bf16x8_t*)(QG + (16 * tt + fr) * 64 + 32 * sg + 8 * fq);
#pragma unroll
        for (int jt = 0; jt < 4; ++jt) { const bf16x8_t a = *(const bf16x8_t*)(Z0 + (16 * jt + fr) * 64 + 32 * sg + 8 * fq);
#pragma unroll
            for (int tt = 0; tt < 4; ++tt) y[jt][tt] = __builtin_amdgcn_mfma_f32_16x16x32_bf16(a, qb[tt], y[jt][tt], 0, 0, 0); } }
#pragma unroll 1
    for (int kk = 0; kk < 4; ++kk) { bf16x8_t sgf[4];
        const int col = 1664 + 32 * kk + 8 * fq; const f32x4 m0 = *(const f32x4*)(p.ev_mu + col), m1 = *(const f32x4*)(p.ev_mu + col + 4); const float mu[8] = {m0.x, m0.y, m0.z, m0.w, m1.x, m1.y, m1.z, m1.w};
#pragma unroll
        for (int tt = 0; tt < 4; ++tt) { const int tl = 16 * tt + fr; const bf16_t* src = P + (tg0 + tl) * EV_IN + 768 + col;
            const u32x4 cur = *(const u32x4*)src; u32x4 prv = (u32x4){0u, 0u, 0u, 0u}; if (ck * 64 + tl > 0) prv = *(const u32x4*)(src - EV_IN);
            const unsigned cw[4] = {cur.x, cur.y, cur.z, cur.w}, pw[4] = {prv.x, prv.y, prv.z, prv.w}; float v[8];
#pragma unroll
            for (int k = 0; k < 4; ++k) { const float c0 = bflo(cw[k]), c1 = bfhi(cw[k]), p0 = bflo(pw[k]), p1 = bfhi(pw[k]); v[2 * k] = sigmoidf_(c0 + (p0 - c0) * mu[2 * k]); v[2 * k + 1] = sigmoidf_(c1 + (p1 - c1) * mu[2 * k + 1]); }
            sgf[tt] = pack8(v); }
#pragma unroll
        for (int jt = 0; jt < 4; ++jt) { const bf16x8_t a = *(const bf16x8_t*)(G2T + (size_t)(hd * 64 + 16 * jt + fr) * 128 + 32 * kk + 8 * fq);
#pragma unroll
            for (int tt = 0; tt < 4; ++tt) g[jt][tt] = __builtin_amdgcn_mfma_f32_16x16x32_bf16(a, sgf[tt], g[jt][tt], 0, 0, 0); } }
#pragma unroll
    for (int tt = 0; tt < 4; ++tt) { const int tl = 16 * tt + fr;
        float s1 = 0.f;
#pragma unroll
        for (int jt = 0; jt < 4; ++jt) s1 += (y[jt][tt][0] + y[jt][tt][1]) + (y[jt][tt][2] + y[jt][tt][3]);
        s1 += __shfl_xor(s1, 16); s1 += __shfl_xor(s1, 32); const float mean = s1 * (1.0f / 64.0f);
        float s2 = 0.f;
#pragma unroll
        for (int jt = 0; jt < 4; ++jt)
#pragma unroll
            for (int r = 0; r < 4; ++r) { const float d = y[jt][tt][r] - mean; s2 += d * d; }
        s2 += __shfl_xor(s2, 16); s2 += __shfl_xor(s2, 32); const float rs = 1.0f / sqrtf(s2 * (1.0f / 64.0f) + 64e-5f);
        const float bon = ((const float*)(R + R_BON))[(tg0 + tl) * 8 + hd]; const bool hp = (ck * 64 + tl > 0);
#pragma unroll
        for (int jt = 0; jt < 4; ++jt) { const int ch = hd * 64 + 16 * jt + 4 * fq;
            const bf16_t* src = P + (tg0 + tl) * EV_IN + 768 + 1024 + ch; const u32x2 cur = *(const u32x2*)src; u32x2 prv; prv.x = 0u; prv.y = 0u; if (hp) prv = *(const u32x2*)(src - EV_IN);
            const f32x4 mu = *(const f32x4*)(p.ev_mu + 1024 + ch), lw4 = *(const f32x4*)(p.ev_lnx_w + ch), lb4 = *(const f32x4*)(p.ev_lnx_b + ch);
            const float c0 = bflo(cur.x), c1 = bfhi(cur.x), c2 = bflo(cur.y), c3 = bfhi(cur.y), p0 = bflo(prv.x), p1 = bfhi(prv.x), p2 = bflo(prv.y), p3 = bfhi(prv.y);
            const float v0 = c0 + (p0 - c0) * mu.x, v1 = c1 + (p1 - c1) * mu.y, v2 = c2 + (p2 - c2) * mu.z, v3 = c3 + (p3 - c3) * mu.w;
            const f32x4 yy = y[jt][tt], gg = g[jt][tt];
            const float o0 = ((yy[0] - mean) * rs * lw4.x + lb4.x + bon * v0) * gg[0], o1 = ((yy[1] - mean) * rs * lw4.y + lb4.y + bon * v1) * gg[1];
            const float o2 = ((yy[2] - mean) * rs * lw4.z + lb4.z + bon * v2) * gg[2], o3 = ((yy[3] - mean) * rs * lw4.w + lb4.w + bon * v3) * gg[3];
            u32x2 w; w.x = pk2(o0, o1); w.y = pk2(o2, o3); *(u32x2*)(MIX + (tg0 + tl) * 1024 + 512 + ch) = w; } }
}

__device__ __forceinline__ void xattn_mfma(const Ctx& c, const Params& p, int unit) {
    const int b = unit >> 5, hh = (unit >> 3) & 3, tblk = unit & 7, tid = c.tid, lane = c.lane, wv = c.wave, fr = lane & 15, fq = lane >> 4;
    LAS bf16_t* Ks = (LAS bf16_t*)c.shm;
    LAS bf16_t* VTp = (LAS bf16_t*)(c.shm + 256 * 272);
    const bf16_t* MKV = (const bf16_t*)(p.ws + OFF_MKV); const bf16_t* Q = (const bf16_t*)(p.ws + OFF_P); bf16_t* OA = (bf16_t*)(p.ws + OFF_P + 32 * MiB);
    __syncthreads();
#pragma unroll 1
    for (int i = 0; i < 16; ++i) {
        const int task = tid + 512 * i, which = task >> 12, r = (task >> 4) & 255, ck = task & 15;
        const u32x4 d = *(const u32x4*)(MKV + ((size_t)b * MEMLEN + r) * 1024 + which * 512 + hh * 128 + ck * 8);
        if (which == 0) *(LAS u32x4*)(Ks + r * 136 + ck * 8) = d;
        else { const int kc = key_perm(r); const unsigned w[4] = {d.x, d.y, d.z, d.w};
#pragma unroll
            for (int k = 0; k < 4; ++k) { VTp[(ck * 8 + 2 * k) * 264 + kc] = (bf16_t)(w[k] & 0xFFFFu); VTp[(ck * 8 + 2 * k + 1) * 264 + kc] = (bf16_t)(w[k] >> 16); } }
    }
    __syncthreads();
#pragma unroll 1
    for (int qt = 0; qt < 4; ++qt) {
        const size_t tq = (size_t)b * SEQ + tblk * 512 + wv * 64 + qt * 16 + fr;
        bf16x8_t qf[4];
#pragma unroll
        for (int kk = 0; kk < 4; ++kk) qf[kk] = *(const bf16x8_t*)(Q + tq * 512 + hh * 128 + 32 * kk + 8 * fq);
        f32x4 s[16];
#pragma unroll
        for (int kt = 0; kt < 16; ++kt) { s[kt] = (f32x4){0.f, 0.f, 0.f, 0.f};
#pragma unroll
            for (int kk = 0; kk < 4; ++kk) s[kt] = __builtin_amdgcn_mfma_f32_16x16x32_bf16(lds_frag(Ks, 136, 16 * kt + fr, 32 * kk + 8 * fq), qf[kk], s[kt], 0, 0, 0);
            if (kt & 1) __builtin_amdgcn_sched_barrier(0); }
        float m = s[0][0];
#pragma unroll
        for (int kt = 0; kt < 16; ++kt) m = fmaxf(fmaxf(fmaxf(m, s[kt][0]), fmaxf(s[kt][1], s[kt][2])), s[kt][3]);
        m = fmaxf(m, __shfl_xor(m, 16)); m = fmaxf(m, __shfl_xor(m, 32));
        float den = 0.f;
#pragma unroll
        for (int kt = 0; kt < 16; ++kt)
#pragma unroll
            for (int r = 0; r < 4; ++r) { const float e = __expf((s[kt][r] - m) * 0.08838834764831845f); s[kt][r] = e; den += e; }
        den += __shfl_xor(den, 16); den += __shfl_xor(den, 32);
        f32x4 o[8];
#pragma unroll
        for (int dt = 0; dt < 8; ++dt) o[dt] = (f32x4){0.f, 0.f, 0.f, 0.f};
#pragma unroll
        for (int sg = 0; sg < 8; ++sg) { const float pv[8] = {s[2 * sg][0], s[2 * sg][1], s[2 * sg][2], s[2 * sg][3], s[2 * sg + 1][0], s[2 * sg + 1][1], s[2 * sg + 1][2], s[2 * sg + 1][3]};
            const bf16x8_t pb = pack8(pv);
#pragma unroll
            for (int dt = 0; dt < 8; ++dt) o[dt] = __builtin_amdgcn_mfma_f32_16x16x32_bf16(lds_frag(VTp, 264, 16 * dt + fr, 32 * sg + 8 * fq), pb, o[dt], 0, 0, 0);
            __builtin_amdgcn_sched_barrier(0); }
        const float inv = 1.0f / den;
#pragma unroll
        for (int dt = 0; dt < 8; ++dt) { u32x2 w; w.x = pk2(o[dt][0] * inv, o[dt][1] * inv); w.y = pk2(o[dt][2] * inv, o[dt][3] * inv); *(u32x2*)(OA + tq * 512 + hh * 128 + 16 * dt + 4 * fq) = w; }
    }
}
__device__ __forceinline__ void swa_mfma(const Ctx& c, const Params& p, int unit) {
    const int b = unit >> 6, g = (unit >> 5) & 1, n = unit & 31, tid = c.tid, lane = c.lane, wv = c.wave, fr = lane & 15, fq = lane >> 4;
    LAS bf16_t* Ks = (LAS bf16_t*)c.shm;
    LAS bf16_t* VTp = (LAS bf16_t*)(c.shm + 256 * 144);
    const bf16_t* P = (const bf16_t*)(p.ws + OFF_P); bf16_t* MIX = (bf16_t*)(p.ws + OFF_H);
    __syncthreads();
#pragma unroll 1
    for (int i = 0; i < 8; ++i) {
        const int task = tid + 512 * i, which = task >> 11, r = (task >> 3) & 255, ck = task & 7;
        const int tk = n * 128 - 128 + r;
        u32x4 d = (u32x4){0u, 0u, 0u, 0u};
        if (tk >= 0) d = *(const u32x4*)(P + ((size_t)b * SEQ + tk) * EV_IN + 512 + which * 128 + g * 64 + ck * 8);
        if (which == 0) *(LAS u32x4*)(Ks + r * 72 + ck * 8) = d;
        else { const int kc = key_perm(r); const unsigned w[4] = {d.x, d.y, d.z, d.w};
#pragma unroll
            for (int k = 0; k < 4; ++k) { VTp[(ck * 8 + 2 * k) * 264 + kc] = (bf16_t)(w[k] & 0xFFFFu); VTp[(ck * 8 + 2 * k + 1) * 264 + kc] = (bf16_t)(w[k] >> 16); } }
    }
    __syncthreads();
#pragma unroll 1
    for (int it = 0; it < 4; ++it) {
        const int tile = wv * 4 + it, hql = tile >> 3, qb = tile & 7, head = g * 4 + hql, sg0 = qb >> 1;
        const int qi = 16 * qb + fr; const size_t tq = (size_t)b * SEQ + n * 128 + qi;
        const float sink = p.ev_sinks[head];
        bf16x8_t qf[2];
#pragma unroll
        for (int kk = 0; kk < 2; ++kk) qf[kk] = *(const bf16x8_t*)(P + tq * EV_IN + head * 64 + 32 * kk + 8 * fq);
        f32x4 s[10]; float m = sink;
#pragma unroll
        for (int i = 0; i < 10; ++i) { const int kt = 2 * sg0 + i; s[i] = (f32x4){0.f, 0.f, 0.f, 0.f};
#pragma unroll
            for (int kk = 0; kk < 2; ++kk) s[i] = __builtin_amdgcn_mfma_f32_16x16x32_bf16(lds_frag(Ks, 72, 16 * kt + fr, 32 * kk + 8 * fq), qf[kk], s[i], 0, 0, 0);
#pragma unroll
            for (int r = 0; r < 4; ++r) { const int kp = 16 * kt + 4 * fq + r; const bool valid = (kp >= qi + 1) && (kp <= qi + 128) && (n > 0 || kp >= 128);
                s[i][r] = valid ? s[i][r] * 0.125f : -INFINITY; m = fmaxf(m, s[i][r]); } }
        m = fmaxf(m, __shfl_xor(m, 16)); m = fmaxf(m, __shfl_xor(m, 32));
        float den = 0.f;
#pragma unroll
        for (int i = 0; i < 10; ++i)
#pragma unroll
            for (int r = 0; r < 4; ++r) { const float e = __expf(s[i][r] - m); s[i][r] = e; den += e; }
        den += __shfl_xor(den, 16); den += __shfl_xor(den, 32); den += __expf(sink - m);
        f32x4 o[4];
#pragma unroll
        for (int dt = 0; dt < 4; ++dt) o[dt] = (f32x4){0.f, 0.f, 0.f, 0.f};
#pragma unroll
        for (int i2 = 0; i2 < 5; ++i2) { const float pv[8] = {s[2 * i2][0], s[2 * i2][1], s[2 * i2][2], s[2 * i2][3], s[2 * i2 + 1][0], s[2 * i2 + 1][1], s[2 * i2 + 1][2], s[2 * i2 + 1][3]};
            const bf16x8_t pb = pack8(pv);
#pragma unroll
            for (int dt = 0; dt < 4; ++dt) o[dt] = __builtin_amdgcn_mfma_f32_16x16x32_bf16(lds_frag(VTp, 264, 16 * dt + fr, 32 * (sg0 + i2) + 8 * fq), pb, o[dt], 0, 0, 0); }
        const float inv = 1.0f / den;
#pragma unroll
        for (int dt = 0; dt < 4; ++dt) { u32x2 w; w.x = pk2(o[dt][0] * inv, o[dt][1] * inv); w.y = pk2(o[dt][2] * inv, o[dt][3] * inv); *(u32x2*)(MIX + tq * 1024 + head * 64 + 16 * dt + 4 * fq) = w; }
    }
}

constexpr size_t WSM_RT = 640 * 1024;
constexpr size_t CTL_WGCNT = 256 * 1024;
__device__ __forceinline__ void split8(const f32x4 a, const f32x4 b, bf16x8_t& hi, bf16x8_t& lo) {
    const float x[8] = {a.x, a.y, a.z, a.w, b.x, b.y, b.z, b.w}; float h[8], l[8];
#pragma unroll
    for (int i = 0; i < 8; ++i) { h[i] = bf2f(f2bf(x[i])); l[i] = x[i] - h[i]; }
    hi = pack8(h); lo = pack8(l);
}
__device__ __forceinline__ void moe_route(const Ctx& c, const Params& p, int layer) {
    const int lane = c.lane, wv = c.wave, fr = lane & 15, fq = lane >> 4;
    LAS float* LG = (LAS float*)c.shm + wv * (16 * 48 + 16);
    LAS float* RS = LG + 16 * 48;
    LAS int* hist = (LAS int*)(c.shm + 32 * 1024);
    if (c.tid < 32) hist[c.tid] = 0;
    __syncthreads();
    const int t0 = blockIdx.x * 128 + wv * 16;
    const float* xr = p.out + (size_t)(t0 + fr) * 1024 + 8 * fq;
    const bf16_t* TH = (const bf16_t*)(p.ws + OFF_WSMALL + WSM_RT) + (size_t)layer * 2 * 48 * 1024; const bf16_t* TL = TH + 48 * 1024;
    f32x4 acc[3];
#pragma unroll
    for (int i = 0; i < 3; ++i) acc[i] = (f32x4){0.f, 0.f, 0.f, 0.f};
    float ss = 0.f;
#pragma unroll 2
    for (int kk = 0; kk < 32; ++kk) {
        const f32x4 a = *(const f32x4*)(xr + 32 * kk), bq = *(const f32x4*)(xr + 32 * kk + 4);
        ss += (a.x * a.x + a.y * a.y) + (a.z * a.z + a.w * a.w) + (bq.x * bq.x + bq.y * bq.y) + (bq.z * bq.z + bq.w * bq.w);
        bf16x8_t xh, xl; split8(a, bq, xh, xl);
#pragma unroll
        for (int ct = 0; ct < 3; ++ct) { const bf16x8_t wh = *(const bf16x8_t*)(TH + (size_t)(16 * ct + fr) * 1024 + 32 * kk + 8 * fq), wl = *(const bf16x8_t*)(TL + (size_t)(16 * ct + fr) * 1024 + 32 * kk + 8 * fq);
            acc[ct] = __builtin_amdgcn_mfma_f32_16x16x32_bf16(xh, wh, acc[ct], 0, 0, 0); acc[ct] = __builtin_amdgcn_mfma_f32_16x16x32_bf16(xh, wl, acc[ct], 0, 0, 0); acc[ct] = __builtin_amdgcn_mfma_f32_16x16x32_bf16(xl, wh, acc[ct], 0, 0, 0); }
    }
    ss += __shfl_xor(ss, 16); ss += __shfl_xor(ss, 32);
    const float rstd = 1.0f / sqrtf(ss * (1.0f / 1024.0f) + 1e-6f);
    if (fq == 0) RS[fr] = rstd;
    LDS_WAIT();
#pragma unroll
    for (int ct = 0; ct < 3; ++ct)
#pragma unroll
        for (int r = 0; r < 4; ++r) LG[(4 * fq + r) * 48 + 16 * ct + fr] = acc[ct][r] * RS[4 * fq + r];
    LDS_WAIT();
    if (lane < 16) { int e0, e1; float g0, g1; route_row(LG + lane * 48, p.moe_b_group + layer * 4, p.moe_b_expert + layer * 32, e0, e1, g0, g1);
        const int t = t0 + lane; ((int2*)(p.ws + OFF_ROUTE))[t] = make_int2(e0, e1); ((float2*)(p.ws + OFF_ROUTE + 256 * 1024))[t] = make_float2(g0, g1);
        atomicAdd((int*)&hist[e0], 1); atomicAdd((int*)&hist[e1], 1); }
    const float* gn = p.norm_moe + layer * 1024 + 8 * fq; bf16_t* hr = (bf16_t*)(p.ws + OFF_H) + (size_t)(t0 + fr) * 1024 + 8 * fq;
#pragma unroll 4
    for (int kk = 0; kk < 32; ++kk) {
        const f32x4 a = *(const f32x4*)(xr + 32 * kk), bq = *(const f32x4*)(xr + 32 * kk + 4), g0 = *(const f32x4*)(gn + 32 * kk), g1 = *(const f32x4*)(gn + 32 * kk + 4);
        u32x4 w; w.x = pk2(a.x * rstd * g0.x, a.y * rstd * g0.y); w.y = pk2(a.z * rstd * g0.z, a.w * rstd * g0.w); w.z = pk2(bq.x * rstd * g1.x, bq.y * rstd * g1.y); w.w = pk2(bq.z * rstd * g1.z, bq.w * rstd * g1.w);
        *(u32x4*)(hr + 32 * kk) = w;
    }
    __syncthreads();
    if (c.tid < 32) ((int*)(p.ws + OFF_CTL + CTL_WGCNT))[(layer * 256 + blockIdx.x) * 32 + c.tid] = hist[c.tid];
}
__device__ __forceinline__ void moe_slots2(const Ctx& c, const Params& p, int layer) {
    LAS int* part = (LAS int*)c.shm;
    LAS int* base = part + 1024;
    LAS int* lcnt = base + 32;
    LAS int* posl = lcnt + 32;
    LAS int* pst = posl + 256;
    const int* wc = (const int*)(p.ws + OFF_CTL + CTL_WGCNT) + layer * 256 * 32; const int bid = blockIdx.x;
    __syncthreads();
    { const int e = c.tid & 31, pt = c.tid >> 5; int sa = 0, sb = 0;
      for (int w = pt * 16; w < pt * 16 + 16; ++w) { const int v = wc[w * 32 + e]; sa += v; sb += (w < bid) ? v : 0; }
      part[pt * 32 + e] = sa; part[512 + pt * 32 + e] = sb; }
    if (c.tid < 32) lcnt[c.tid] = 0;
    __syncthreads();
    if (c.tid < 32) { int sa = 0, sb = 0; for (int q = 0; q < 16; ++q) { sa += part[q * 32 + c.tid]; sb += part[512 + q * 32 + c.tid]; } part[c.tid] = sa; part[512 + c.tid] = sb; }
    __syncthreads();
    if (c.tid == 0) { int acc = 0; for (int e = 0; e < NEXP; ++e) { pst[e] = acc; acc += (part[e] + 255) / 256 * 256; } pst[32] = acc; }
    __syncthreads();
    if (c.tid < 32) base[c.tid] = pst[c.tid] + part[512 + c.tid];
    if (bid == 0 && c.tid < NEXP) { int* blk = (int*)(p.ws + OFF_CTL + CTL_BLK) + layer * 1024; const int e = c.tid, s = pst[e] / 256, en = pst[e + 1] / 256; for (int i = s; i < en; ++i) blk[1 + i] = e; if (e == 0) blk[0] = pst[32] / 256; }
    __syncthreads();
    if (c.tid < 256) { const int t = bid * 128 + (c.tid >> 1); const int2 ee = ((const int2*)(p.ws + OFF_ROUTE))[t]; const int e = (c.tid & 1) ? ee.y : ee.x;
        const int rk = atomicAdd((int*)&lcnt[e], 1); posl[c.tid] = base[e] + rk; }
    __syncthreads();
    if (c.tid < 128) ((int2*)(p.ws + OFF_ROUTE + 512 * 1024))[bid * 128 + c.tid] = make_int2(posl[2 * c.tid], posl[2 * c.tid + 1]);
    const bf16_t* H = (const bf16_t*)(p.ws + OFF_H); bf16_t* XB = (bf16_t*)(p.ws + OFF_P);
#pragma unroll 4
    for (int i = 0; i < 16; ++i) { const int tl = c.wave * 16 + i; const size_t t = (size_t)bid * 128 + tl; const int q0 = posl[2 * tl], q1 = posl[2 * tl + 1];
        const u32x4 a = *((const u32x4*)(H + t * 1024) + c.lane), bq = *((const u32x4*)(H + t * 1024) + 64 + c.lane);
        *((u32x4*)(XB + (size_t)q0 * 1024) + c.lane) = a; *((u32x4*)(XB + (size_t)q0 * 1024) + 64 + c.lane) = bq;
        *((u32x4*)(XB + (size_t)q1 * 1024) + c.lane) = a; *((u32x4*)(XB + (size_t)q1 * 1024) + 64 + c.lane) = bq; }
}

constexpr int LDS_BYTES = 160 * 1024 - 64;
constexpr int N_PHASES = 25;

typedef const __attribute__((address_space(4))) Params* KParamsPtr;
__device__ __forceinline__ Params kparams() {
#if defined(__HIP_DEVICE_COMPILE__)
    KParamsPtr k = (KParamsPtr)__builtin_amdgcn_kernarg_segment_ptr(); asm volatile("" : "+s"(k)); return *k;
#else
    return Params{};
#endif
}
__device__ __forceinline__ Ctx mkctx(unsigned char* shm) {
    int tz = threadIdx.x; asm volatile("" : "+v"(tz));
    Ctx c; c.tid = tz; c.wave = __builtin_amdgcn_readfirstlane(tz >> 6); c.lane = tz & 63; c.gw = blockIdx.x * 8 + c.wave; c.ngw = 2048; c.shm = shm; return c;
}
__global__ void __launch_bounds__(512, 2) hybrid_fwd(Params p_in) {
    extern __shared__ __attribute__((aligned(16))) unsigned char shm[];
    constexpr int G = 256; const int bid = blockIdx.x;
    uint4* xbw = (uint4*)(shm + LDS_BYTES - 16);
    if (threadIdx.x == 0) *xbw = make_uint4(0u, 0u, 0u, 0u);
    __syncthreads();
    XcdBarrier bar = xcd_barrier_post((unsigned*)(kparams().ws + OFF_CTL), (volatile LAS unsigned*)xbw);
#ifndef KEEPMASK
#define KEEPMASK 0xFFFFFFFFu
#endif
#define INS(k, s) (((KEEPMASK) >> (s)) & 1u)
#ifndef REPMASK
#define REPMASK 0u
#endif
#define REP(s) ((((REPMASK) >> (s)) & 1u) ? 3 : 1)
#define SEAM(k) do { XcdBarrier b2 = bar; b2.bar = (unsigned*)(kparams().ws + OFF_CTL); xcd_barrier(b2); } while (0)
#define PHASE_BEGIN const Params p = kparams(); const Ctx c = mkctx(shm); unsigned char* const ws = p.ws; (void)c; (void)ws;
#define glds ((PG8_LAS unsigned char*)shm)
#define WD ((bf16_t*)(ws + OFF_WD))
#define H ((bf16_t*)(ws + OFF_H))
#define P ((bf16_t*)(ws + OFF_P))
#define WS_F ((float*)(ws + OFF_WSMALL))
#define RE ((int2*)(ws + OFF_ROUTE))
#define RG ((float2*)(ws + OFF_ROUTE + 256 * 1024))
#define RP ((int2*)(ws + OFF_ROUTE + 512 * 1024))

    for (int layer = 0; layer < 2; ++layer) {
        const int pb = layer * 12;
        if (layer == 0) {
            if (INS(0, 0)) for (int rep_ = 0; rep_ < REP(0); ++rep_) { PHASE_BEGIN
                tr_matrix(c, p.ev_w_in, EV_IN, 0, 1024, EV_IN, WD + WE_EV_IN, 0, 0);
                tr_matrix(c, p.ev_w_out, 1024, 0, 1024, 1024, WD + WE_EV_OUT, 0, 0);
                tr_matrix(c, p.od_w_in, OD_IN_SRC, 0, 1024, OD_IN, WD + WE_OD_IN, 0, 1);
                tr_matrix(c, p.od_w_out, 1024, 0, 1024, 1024, WD + WE_OD_OUT, 0, 0);
                tr_matrix(c, p.mem_wk, 512, 0, 1024, 512, WD + WE_MKV, 0, 0);
                tr_matrix(c, p.mem_wv, 512, 0, 1024, 512, WD + WE_MKV, 512, 0);
                for (int l = 0; l < 2; ++l) {
                    tr_matrix(c, p.xa_wq + (size_t)l * 1024 * 512, 512, 0, 1024, 512, WD + WE_WQ + (size_t)l * 512 * 1024, 0, 0);
                    tr_matrix(c, p.xa_wo + (size_t)l * 512 * 1024, 1024, 0, 512, 1024, WD + WE_WO + (size_t)l * 1024 * 512, 0, 0);
                }
                tr_moe_layer(c, p, 0);
                for (int i = bid * 512 + c.tid; i < 2 * 36 * 1024 + 16 * 1024; i += G * 512) {
                    if (i >= 2 * 36 * 1024) { const int r = i - 2 * 36 * 1024, o = r >> 10, k = r & 1023; WS_F[i] = p.od_w_in[(size_t)k * OD_IN_SRC + 2048 + o]; }
                }
                for (int i = bid * 512 + c.tid; i < 2 * 48 * 1024; i += G * 512) { const int l = i / (48 * 1024), r = i % (48 * 1024), o = r >> 10, k = r & 1023;
                    float w = 0.f; if (o < 4) w = p.moe_w_group[((size_t)l * 1024 + k) * 4 + o]; else if (o < 36) w = p.moe_w_expert[((size_t)l * 1024 + k) * 32 + (o - 4)];
                    w *= p.norm_moe[l * 1024 + k]; const unsigned hb = f2bf(w); bf16_t* T = (bf16_t*)(ws + OFF_WSMALL + WSM_RT) + (size_t)l * 2 * 48 * 1024;
                    T[r] = (bf16_t)hb; T[48 * 1024 + r] = (bf16_t)f2bf(w - bf2f(hb)); }
                for (int i = bid * 512 + c.tid; i < 2 * 512 * 64; i += G * 512) { const int wh = i >> 15, r = i & 32767, ch = r >> 6, k = r & 63;
                    ((bf16_t*)(ws + OFF_WSMALL + (wh ? WSM_A2T : WSM_W2T)))[r] = (bf16_t)f2bf((wh ? p.ev_a2 : p.ev_w2)[(size_t)k * 512 + ch]); }
                norm_plain(c, p.mem, p.mem_norm, (bf16_t*)(ws + OFF_R + R_MEMN), NB * MEMLEN);
                for (int i = bid * 512 + c.tid; i < 512 * 128; i += G * 512) { const int ch = i >> 7, m = i & 127; ((bf16_t*)(ws + OFF_WSMALL + WSM_G2T))[i] = (bf16_t)f2bf(p.ev_g2[(size_t)m * 512 + ch]); }
                norm_plain(c, p.x, p.norm_mix, H, T_TOK);
                __syncthreads();
                SEAM(0);
            }
            if (INS(1, 1)) for (int rep_ = 0; rep_ < REP(1); ++rep_) { PHASE_BEGIN
                { pg8::Gemm g{H, WD + WE_EV_IN, T_TOK, EV_IN, 1024, 0}; pg8::StaticOrder S; S.init(T_TOK, EV_IN, G, bid);
                  pg8::EpiB16 E{P, EV_IN}; pg8::gemm_phase<pg8::EpiB16, pg8::StaticOrder, true, true>(glds, g, S, E); }
                SEAM(1);
            }
            if (INS(2, 2)) for (int rep_ = 0; rep_ < REP(2); ++rep_) { PHASE_BEGIN
#ifdef RWKV_NAIVE
                if (bid < 64) rwkv_naive(c, p, bid);
                else
#else
                for (int u = bid; u < 4096; u += G) rwkv_x(c, p, u);
                __syncthreads();
                SEAM(2);
            }
            if (INS(2, 16)) for (int rep_ = 0; rep_ < REP(16); ++rep_) { PHASE_BEGIN
                if (bid < 64) { if (c.wave < 4) rwkv_y(c, p, bid, c.wave); }
                else
#endif
                {
                    for (int u = bid - 64; u < 512; u += G - 64) swa_mfma(c, p, u);
                    __syncthreads();
                    if (bid < 96) {
                        pg8::Gemm g{(const bf16_t*)(ws + OFF_R + R_MEMN), WD + WE_MKV, NB * MEMLEN, 1024, 1024, 0}; pg8::StaticOrder S; S.init(NB * MEMLEN, 1024, 32, bid - 64);
                        pg8::EpiB16 E{(bf16_t*)(ws + OFF_MKV), 1024}; pg8::gemm_phase<pg8::EpiB16, pg8::StaticOrder, true, true>(glds, g, S, E); }
                }
#ifndef RWKV_NAIVE
                __syncthreads();
                SEAM(2);
            }
            if (INS(2, 17)) for (int rep_ = 0; rep_ < REP(17); ++rep_) { PHASE_BEGIN
                for (int u = c.gw; u < 4096; u += c.ngw) rwkv_z(c, p, u);
#endif
                __syncthreads();
                SEAM(2);
            }
        } else {
            if (INS(12, 12)) for (int rep_ = 0; rep_ < REP(12); ++rep_) { PHASE_BEGIN
                const bf16_t* YB = P; const float* gdT = WS_F + 2 * 36 * 1024; float* GK = (float*)(ws + OFF_R);
                for (int r = c.gw; r < T_TOK; r += c.ngw) {
                    f32x4 v[4]; row_load(p.out + (size_t)r * 1024, c.lane, v);
                    const int2 ps = RP[r]; const float2 gt = RG[r];
                    row_combine(v, YB, ps.x, ps.y, gt.x, gt.y, c.lane);
                    row_store_f32(p.out + (size_t)r * 1024, c.lane, v);
                    const float rs = row_rstd(v); row_scale(v, rs, p.norm_mix + 1024, c.lane); row_store_bf16(H + (size_t)r * 1024, c.lane, v);
                    LAS float* gd = (LAS float*)shm + c.wave * 64; row_logits(v, gdT, c.lane, 16, gd);
                    float acc[8];
#pragma unroll
                    for (int i = 0; i < 8; ++i) acc[i] = p.od_gate_b[8 * c.lane + i];
#pragma unroll
                    for (int j = 0; j < 16; ++j) { const f32x4 u0 = *(const f32x4*)(p.od_gate_up + j * 512 + 8 * c.lane), u1 = *(const f32x4*)(p.od_gate_up + j * 512 + 8 * c.lane + 4);
                        acc[0] += gd[j] * u0.x; acc[1] += gd[j] * u0.y; acc[2] += gd[j] * u0.z; acc[3] += gd[j] * u0.w; acc[4] += gd[j] * u1.x; acc[5] += gd[j] * u1.y; acc[6] += gd[j] * u1.z; acc[7] += gd[j] * u1.w; }
#pragma unroll
                    for (int i = 0; i < 8; ++i) { const float xx = acc[i]; acc[i] = (fminf(xx, 0.f) - log1pf(__expf(-fabsf(xx)))) * (1.0f / 16.0f); }
                    *(f32x4*)(GK + (size_t)r * 512 + 8 * c.lane) = (f32x4){acc[0], acc[1], acc[2], acc[3]}; *(f32x4*)(GK + (size_t)r * 512 + 8 * c.lane + 4) = (f32x4){acc[4], acc[5], acc[6], acc[7]};
                }
                tr_moe_layer(c, p, 1);
                __syncthreads();
                SEAM(12);
            }
            if (INS(13, 13)) for (int rep_ = 0; rep_ < REP(13); ++rep_) { PHASE_BEGIN
                pg8::Gemm g{H, WD + WE_OD_IN, T_TOK, OD_IN, 1024, 0}; pg8::StaticOrder S; S.init(T_TOK, OD_IN, G, bid);
                pg8::EpiB16 E{P, OD_IN}; pg8::gemm_phase<pg8::EpiB16, pg8::StaticOrder, true, true>(glds, g, S, E);
                SEAM(13);
            }
            if (INS(14, 14)) for (int rep_ = 0; rep_ < REP(14); ++rep_) { PHASE_BEGIN
#ifdef GLA_NAIVE
                if (bid < 32) gla_naive(c, p, bid);
                __syncthreads();
                SEAM(14);
#else
                for (int u = bid; u < 2048; u += G) gla_prep(c, p, u);
                __syncthreads();
                SEAM(14);
#endif
            }
#ifndef GLA_NAIVE
            if (INS(14, 18)) for (int rep_ = 0; rep_ < REP(18); ++rep_) { PHASE_BEGIN
                if (bid < 128) gla_state(c, p, bid >> 2, bid & 3);
                __syncthreads();
                SEAM(14);
            }
            if (INS(14, 19)) for (int rep_ = 0; rep_ < REP(19); ++rep_) { PHASE_BEGIN
                gla_finish(c, p);
                __syncthreads();
                SEAM(14);
            }
#endif
        }
        if (INS(pb + 3, 3)) for (int rep_ = 0; rep_ < REP(3); ++rep_) { PHASE_BEGIN
            pg8::Gemm g{H, WD + (layer == 0 ? WE_EV_OUT : WE_OD_OUT), T_TOK, 1024, 1024, 0}; pg8::StaticOrder S; S.init(T_TOK, 1024, G, bid);
            pg8::EpiRes E{layer == 0 ? p.x : p.out, p.out, 1024}; pg8::gemm_phase<pg8::EpiRes, pg8::StaticOrder, true, true>(glds, g, S, E);
            SEAM(pb + 3);
        }
        if (INS(pb + 4, 4)) for (int rep_ = 0; rep_ < REP(4); ++rep_) { PHASE_BEGIN norm_plain(c, p.out, p.norm_xattn + layer * 1024, H, T_TOK); __syncthreads(); SEAM(pb + 4); }
        if (INS(pb + 5, 5)) for (int rep_ = 0; rep_ < REP(5); ++rep_) { PHASE_BEGIN
            pg8::Gemm g{H, WD + WE_WQ + (size_t)layer * 512 * 1024, T_TOK, 512, 1024, 0}; pg8::StaticOrder S; S.init(T_TOK, 512, G, bid);
            pg8::EpiB16 E{P, 512}; pg8::gemm_phase<pg8::EpiB16, pg8::StaticOrder, true, true>(glds, g, S, E);
            SEAM(pb + 5);
        }
        if (INS(pb + 6, 6)) for (int rep_ = 0; rep_ < REP(6); ++rep_) { PHASE_BEGIN for (int u = bid; u < 256; u += G) xattn_mfma(c, p, u); __syncthreads(); SEAM(pb + 6); }
        if (INS(pb + 7, 7)) for (int rep_ = 0; rep_ < REP(7); ++rep_) { PHASE_BEGIN
            pg8::Gemm g{(const bf16_t*)(ws + OFF_P + 32 * MiB), WD + WE_WO + (size_t)layer * 1024 * 512, T_TOK, 1024, 512, 0}; pg8::StaticOrder S; S.init(T_TOK, 1024, G, bid);
            pg8::EpiRes E{p.out, p.out, 1024}; pg8::gemm_phase<pg8::EpiRes, pg8::StaticOrder, true, true>(glds, g, S, E);
            SEAM(pb + 7);
        }
        if (INS(pb + 8, 8)) for (int rep_ = 0; rep_ < REP(8); ++rep_) { PHASE_BEGIN
            moe_route(c, p, layer);
            __syncthreads();
            SEAM(pb + 8);
        }
        if (INS(pb + 9, 9)) for (int rep_ = 0; rep_ < REP(9); ++rep_) { PHASE_BEGIN moe_slots2(c, p, layer); __syncthreads(); SEAM(pb + 9); }
        if (INS(pb + 10, 10)) for (int rep_ = 0; rep_ < REP(10); ++rep_) { PHASE_BEGIN
            const int* blk = (const int*)(ws + OFF_CTL + CTL_BLK) + layer * 1024; const int nblk = blk[0];
            pg8::Gemm g{P, (const bf16_t*)(ws + OFF_WMOE), nblk * 256, 1024, 1024, (size_t)1024 * 1024 * 2}; pg8::MoeOrder S{blk + 1, nblk * 4, 4, G, bid};
            pg8::EpiSwiglu E{(bf16_t*)(ws + OFF_R), 512}; pg8::gemm_phase<pg8::EpiSwiglu, pg8::MoeOrder, true, true>(glds, g, S, E);
            SEAM(pb + 10);
        }
        if (INS(pb + 11, 11)) for (int rep_ = 0; rep_ < REP(11); ++rep_) { PHASE_BEGIN
            const int* blk = (const int*)(ws + OFF_CTL + CTL_BLK) + layer * 1024; const int nblk = blk[0];
            pg8::Gemm g{(const bf16_t*)(ws + OFF_R), (const bf16_t*)(ws + OFF_WMOE + 64 * MiB), nblk * 256, 1024, 512, (size_t)1024 * 512 * 2}; pg8::MoeOrder S{blk + 1, nblk * 4, 4, G, bid};
            pg8::EpiB16 E{P, 1024}; pg8::gemm_phase<pg8::EpiB16, pg8::MoeOrder, true, true>(glds, g, S, E);
            SEAM(pb + 11);
        }
    }
    if (INS(24, 15)) for (int rep_ = 0; rep_ < REP(15); ++rep_) { PHASE_BEGIN
        for (int r = c.gw; r < T_TOK; r += c.ngw) {
            f32x4 v[4]; row_load(p.out + (size_t)r * 1024, c.lane, v);
            const int2 ps = RP[r]; const float2 gt = RG[r];
            row_combine(v, P, ps.x, ps.y, gt.x, gt.y, c.lane);
            const float rs = row_rstd(v); row_scale(v, rs, p.norm_final, c.lane); row_store_f32(p.out + (size_t)r * 1024, c.lane, v);
        }
    }
}

extern "C" void kernel_launch(void* const* d_in, const int* in_sizes, int n_in, void* d_out, int out_size, void* d_ws, size_t ws_size, hipStream_t stream) {
    static int ready = 0;
    if (ready == 0) {
        if (n_in != 37 || out_size != T_TOK * DM || ws_size < WS_NEED) { fprintf(stderr, "kernel_launch: unexpected problem (n_in %d, out %d, ws %zu)\n", n_in, out_size, ws_size); ready = -1; return; }
        if (hipFuncSetAttribute((const void*)hybrid_fwd, hipFuncAttributeMaxDynamicSharedMemorySize, LDS_BYTES) != hipSuccess) { fprintf(stderr, "kernel_launch: hipFuncSetAttribute failed\n"); ready = -1; return; }
        ready = 1;
    }
    if (ready < 0) return;
    hipMemsetAsync((char*)d_ws + OFF_CTL, 0, CTL_ZERO_BYTES, stream);
    Params p{};
    const float** f = (const float**)&p;
    for (int i = 0; i < 37; ++i) f[i] = (const float*)d_in[i];
    p.out = (float*)d_out; p.ws = (unsigned char*)d_ws; p.ph_lo = 0; p.ph_hi = N_PHASES;
    hipLaunchKernelGGL(hybrid_fwd, dim3(256), dim3(512), LDS_BYTES, stream, p);
}
```

```cpp
#include <hip/hip_runtime.h>
#include <cstdint>
#include <cstdio>

#define LAS __attribute__((address_space(3)))
typedef unsigned short bf16_t;
typedef float f32x4 __attribute__((ext_vector_type(4)));
typedef float f32x2 __attribute__((ext_vector_type(2)));
typedef unsigned u32x4 __attribute__((ext_vector_type(4)));
typedef unsigned u32x2 __attribute__((ext_vector_type(2)));

constexpr int T_TOK = 32768, DM = 1024, SEQ = 4096, NB = 8, MEMLEN = 256;
constexpr int EV_IN = 2560, OD_IN = 3072  , OD_IN_SRC = 3088;
constexpr int NEXP = 32, MOE_FF = 512, PMAX = 65536 + NEXP * 256;

constexpr size_t MiB = 1024 * 1024;
constexpr size_t OFF_CTL = 0;
constexpr size_t CTL_ZERO_BYTES = 64 * 1024;
constexpr size_t CTL_CNT = 16384;
constexpr size_t CTL_CUR = 16384 + 1024;
constexpr size_t CTL_BLK = 128 * 1024;
constexpr size_t OFF_ROUTE = 1 * MiB;
constexpr size_t OFF_WSMALL = 2 * MiB;
constexpr size_t OFF_MKV = 3 * MiB;
constexpr size_t OFF_WD = 7 * MiB;
constexpr size_t OFF_WMOE = 28 * MiB;
constexpr size_t OFF_H = 124 * MiB;
constexpr size_t OFF_P = 188 * MiB;
constexpr size_t OFF_R = 380 * MiB;
constexpr size_t WS_NEED = 452 * MiB;
constexpr size_t WE_EV_IN = 0, WE_EV_OUT = 2560ull * 1024, WE_OD_IN = 3584ull * 1024, WE_OD_OUT = 6656ull * 1024, WE_MKV = 7680ull * 1024, WE_WQ = 8704ull * 1024, WE_WO = 9728ull * 1024;

constexpr size_t ROUTE_RS = 768 * 1024;
constexpr size_t R_SSP = 0, R_RSS = 80 * MiB;
constexpr size_t P_XB1 = 64 * MiB;
struct Params {
    const float *x, *mem, *norm_mix, *norm_xattn, *norm_moe, *norm_final;
    const float *ev_w_in, *ev_sinks, *ev_mu, *ev_w0, *ev_w2, *ev_a0, *ev_a2, *ev_g2, *ev_k_k, *ev_k_a, *ev_r_k, *ev_lnx_w, *ev_lnx_b, *ev_w_out;
    const float *od_w_in, *od_gate_up, *od_gate_b, *od_onorm, *od_w_out;
    const float *mem_norm, *mem_wk, *mem_wv, *xa_wq, *xa_wo;
    const float *moe_w_group, *moe_b_group, *moe_w_expert, *moe_b_expert, *moe_w1, *moe_w3, *moe_w2;
    float* out; unsigned char* ws; int ph_lo, ph_hi;
};

#define XB_TMO      128
#define XB_XCNT(j)  (256  + 64 * (j))
#define XB_XSUB(j)  (1280 + 64 * (j))
#define XB_XGEN(j)  (2304 + 64 * (j))
#define XB_TOP      3328
#define XB_TOPGEN   3392
#define XCD_BAR_WORDS 3456
#define XB_SPIN_CAP (1u << 18)
#define LAS __attribute__((address_space(3)))

__device__ __forceinline__ unsigned xb_ld(unsigned* p)              { return __hip_atomic_load(p, __ATOMIC_RELAXED, __HIP_MEMORY_SCOPE_AGENT); }
__device__ __forceinline__ unsigned xb_add(unsigned* p, unsigned v) { return __hip_atomic_fetch_add(p, v, __ATOMIC_RELAXED, __HIP_MEMORY_SCOPE_AGENT); }
__device__ __forceinline__ unsigned xb_xcc_id() { return (unsigned)__builtin_amdgcn_s_getreg((3 << 11) | 20) & 0xFu; }
#define XB_SPIN(cond, bar) do { unsigned _sp = 0; while (cond) { __builtin_amdgcn_s_sleep(1); \
    if ((++_sp & 255u) == 0u) { if (xb_ld(&(bar)[XB_TMO])) break; if (_sp > XB_SPIN_CAP) { atomicAdd(&(bar)[XB_TMO], 1u); break; } } } } while (0)

struct XcdBarrier {
    unsigned* bar; unsigned x;
    volatile LAS unsigned* st;
};

__device__ __forceinline__ XcdBarrier xcd_barrier_post(unsigned* bar, volatile LAS unsigned* st) {
    XcdBarrier b; b.bar = bar; b.x = xb_xcc_id(); b.st = st;
    if (threadIdx.x == 0) (void)xb_add(&bar[XB_XCNT(b.x)], 1u);
    return b;
}
__device__ __forceinline__ void xcd_barrier_complete(unsigned* bar, unsigned x, unsigned& nloc, unsigned& nx) {
    const unsigned G = gridDim.x * gridDim.y * gridDim.z;
    unsigned sum, cnt, mine, sp = 0u;
    for (;;) {
        sum = 0u; cnt = 0u; mine = 0u;
#pragma unroll
        for (unsigned j = 0; j < 16; ++j) { const unsigned c = xb_ld(&bar[XB_XCNT(j)]); sum += c; cnt += (c > 0u) ? 1u : 0u; mine = (j == x) ? c : mine; }
        if (sum == G) break;
        __builtin_amdgcn_s_sleep(1);
        if ((++sp & 255u) == 0u) { if (xb_ld(&bar[XB_TMO])) break; if (sp > XB_SPIN_CAP) { atomicAdd(&bar[XB_TMO], 1u); break; } }
    }
    nloc = mine > 0u ? mine : 1u; nx = cnt > 0u ? cnt : 1u;
}

__device__ __forceinline__ void xcd_barrier(const XcdBarrier& b) {
    asm volatile("s_waitcnt vmcnt(0)" ::: "memory");
    __syncthreads();
    if (threadIdx.x == 0) {
        unsigned* bar = b.bar;
        __builtin_amdgcn_s_waitcnt(0);
        unsigned nloc = b.st[0], nx = b.st[1];
        if (nloc == 0u) { xcd_barrier_complete(bar, b.x, nloc, nx); b.st[0] = nloc; b.st[1] = nx; }
        const unsigned old = xb_add(&bar[XB_XSUB(b.x)], 1u);
        const unsigned gen = old / nloc;
        if (old + 1u == (gen + 1u) * nloc) {
            __builtin_amdgcn_fence(__ATOMIC_RELEASE, "agent");
            asm volatile("s_waitcnt vmcnt(0)" ::: "memory");
            const unsigned og = xb_add(&bar[XB_TOP], 1u);
            const unsigned tg = og / nx;
            if (og + 1u == (tg + 1u) * nx) xb_add(&bar[XB_TOPGEN], 1u);
            else XB_SPIN(xb_ld(&bar[XB_TOPGEN]) == tg, bar);
            __builtin_amdgcn_fence(__ATOMIC_ACQUIRE, "agent");
            xb_add(&bar[XB_XGEN(b.x)], 1u);
            asm volatile("s_waitcnt vmcnt(0)" ::: "memory");
        } else {
            XB_SPIN(xb_ld(&bar[XB_XGEN(b.x)]) == gen, bar);
            __builtin_amdgcn_fence(__ATOMIC_ACQUIRE, "agent");
            asm volatile("s_waitcnt vmcnt(0)" ::: "memory");
        }
    }
    __syncthreads();
}
namespace pg8 {
#define PG8_LAS __attribute__((address_space(3)))
typedef unsigned short bf16_t;
typedef short bf16x8 __attribute__((ext_vector_type(8)));
typedef float f32x4 __attribute__((ext_vector_type(4)));
typedef unsigned u32x4 __attribute__((ext_vector_type(4)));
constexpr int BM = 256, BK = 64, HALF = 128, HTB = HALF * BK * 2  , STAGE_BYTES = 8 * HTB, NXCD = 8, WGM = 8;

__host__ __device__ __forceinline__ int lds_byte(int r, int c) { const int st = (r >> 4) * 2 + (c >> 5), rr = r & 15, cc = c & 31, ob = rr * 64 + cc * 2; return st * 1024 + (ob ^ (((ob >> 9) & 1) << 5)); }
__host__ __device__ __forceinline__ void stage_rc(int b, int& R, int& C) { const int st = b / 1024, sb = b % 1024, swz = sb ^ (((sb >> 9) & 1) << 5); R = (st >> 1) * 16 + swz / 64; C = (st & 1) * 32 + (swz % 64) / 2; }
__host__ __device__ __forceinline__ int perm32(int rho) { const int n = rho >> 4, i = rho & 15; return 8 * (i >> 2) + 4 * n + (i & 3); }

struct Unit { int pm, pn, e; };
struct Gemm { const bf16_t* A; const bf16_t* Bt; int M, N, K; size_t bexp; };

struct StaticOrder {
    int nM, nN, nwg, G, c;
    __host__ __device__ void init(int M, int N, int G_, int c_) { nM = M / BM; nN = N / BM; nwg = nM * nN; G = G_; c = c_; }
    __host__ __device__ bool next(int i, Unit& u) const {
        const long L = (long)i * G + c; if (L >= nwg) return false;
        int wgid = (int)L; { const int q = nwg / NXCD, r = nwg % NXCD, xcd = wgid % NXCD, off = wgid / NXCD; wgid = (xcd < r ? xcd * (q + 1) : r * (q + 1) + (xcd - r) * q) + off; }
        const int nig = WGM * nN, gid = wgid / nig, fm = gid * WGM, gsz = (nM - fm) < WGM ? (nM - fm) : WGM;
        u.pm = fm + ((wgid % nig) % gsz); u.pn = (wgid % nig) / gsz; u.e = 0; return true;
    }
    __device__ __forceinline__ void a_ready(const Unit&) const {}
    __device__ __forceinline__ void done(const Unit&) const {}
};
typedef __bf16 bf16x2_c __attribute__((ext_vector_type(2))); typedef float f32x2_c __attribute__((ext_vector_type(2)));
__device__ __forceinline__ unsigned cvt_pk_bf16(float lo, float hi) { const f32x2_c v = {lo, hi}; return __builtin_bit_cast(unsigned, __builtin_convertvector(v, bf16x2_c)); }

struct EpiB16 {
    static constexpr bool PERM = true, AFTER_DRAIN = false;
    bf16_t* O; int ldc; const float* rs;
    __device__ __forceinline__ void operator()(const f32x4 (&acc)[2][2][4][2], const Unit& u, int wr, int wc, int fr, int fq) const {
        const int row0 = u.pm * BM + wr * 64 + fr, col0 = u.pn * BM + wc * 32 + 8 * fq;
#pragma unroll
        for (int ai = 0; ai < 2; ++ai)
#pragma unroll
            for (int m = 0; m < 4; ++m) { bf16_t* rowp = O + (size_t)(row0 + ai * HALF + m * 16) * ldc + col0; const float r1 = rs ? rs[row0 + ai * HALF + m * 16] : 1.0f;
#pragma unroll
                for (int bj = 0; bj < 2; ++bj) { const f32x4 v0 = acc[ai][bj][m][0] * r1, v1 = acc[ai][bj][m][1] * r1;
                    u32x4 w; w.x = cvt_pk_bf16(v0[0], v0[1]); w.y = cvt_pk_bf16(v0[2], v0[3]); w.z = cvt_pk_bf16(v1[0], v1[1]); w.w = cvt_pk_bf16(v1[2], v1[3]);
                    *(u32x4*)(rowp + bj * HALF) = w; } }
    }
};
struct EpiRes {
    static constexpr bool PERM = false, AFTER_DRAIN = false;
    const float* base; float* out; int ldc; bf16_t* xb; float* ssp;
    __device__ __forceinline__ void operator()(const f32x4 (&acc)[2][2][4][2], const Unit& u, int wr, int wc, int fr, int fq) const {
        const int row0 = u.pm * BM + wr * 64 + fr, col0 = u.pn * BM + wc * 32 + 4 * fq;
        typedef unsigned u32x2v __attribute__((ext_vector_type(2)));
#pragma unroll
        for (int ai = 0; ai < 2; ++ai)
#pragma unroll
            for (int m = 0; m < 4; ++m) { const int row = row0 + ai * HALF + m * 16; const size_t off = (size_t)row * ldc + col0; float ss = 0.f;
#pragma unroll
                for (int bj = 0; bj < 2; ++bj)
#pragma unroll
                    for (int n = 0; n < 2; ++n) { const f32x4 bs = *(const f32x4*)(base + off + bj * HALF + n * 16); const f32x4 o = bs + acc[ai][bj][m][n];
                        *(f32x4*)(out + off + bj * HALF + n * 16) = o;
                        u32x2v w; w.x = cvt_pk_bf16(o[0], o[1]); w.y = cvt_pk_bf16(o[2], o[3]); *(u32x2v*)(xb + off + bj * HALF + n * 16) = w;
                        ss += (o[0] * o[0] + o[1] * o[1]) + (o[2] * o[2] + o[3] * o[3]); }
                if (ssp) { ss += __shfl_xor(ss, 16); ss += __shfl_xor(ss, 32); if (fq == 0) ssp[(size_t)row * 16 + 4 * u.pn + wc] = ss; } }
    }
};
struct EpiSwiglu {
    static constexpr bool PERM = true, AFTER_DRAIN = false;
    bf16_t* O; int ldc; const float* rs;
    __device__ __forceinline__ void operator()(const f32x4 (&acc)[2][2][4][2], const Unit& u, int wr, int wc, int fr, int fq) const {
        const int row0 = u.pm * BM + wr * 64 + fr, col0 = (u.pn * BM + wc * 32 + 8 * fq) >> 1;
        typedef unsigned u32x2v __attribute__((ext_vector_type(2)));
#pragma unroll
        for (int ai = 0; ai < 2; ++ai)
#pragma unroll
            for (int m = 0; m < 4; ++m) { bf16_t* rowp = O + (size_t)(row0 + ai * HALF + m * 16) * ldc + col0; const float r1 = rs[row0 + ai * HALF + m * 16];
#pragma unroll
                for (int bj = 0; bj < 2; ++bj) { const f32x4 a = acc[ai][bj][m][0] * r1, b = acc[ai][bj][m][1] * r1; float h[4];
#pragma unroll
                    for (int i = 0; i < 4; ++i) h[i] = a[i] * __builtin_amdgcn_rcpf(1.0f + __expf(-a[i])) * b[i];
                    u32x2v w; w.x = cvt_pk_bf16(h[0], h[1]); w.y = cvt_pk_bf16(h[2], h[3]);
                    *(u32x2v*)(rowp + bj * (HALF / 2)) = w; } }
    }
};
struct MoeOrder {
    const int* blk_e; int nunits, nN, G, c;
    __device__ __forceinline__ bool next(int i, Unit& u) const {
        const long L = (long)i * G + c; if (L >= nunits) return false;
        u.pm = (int)(L / nN); u.pn = (int)(L % nN); u.e = blk_e[u.pm]; return true;
    }
    __device__ __forceinline__ void a_ready(const Unit&) const {}
    __device__ __forceinline__ void done(const Unit&) const {}
};
template <class Epi, class Sched, bool ALIGN_EPI = false, bool SP2 = false>
__device__ __forceinline__ void gemm_phase(PG8_LAS unsigned char* lds, const Gemm g, const Sched& S, const Epi& E) {
    int tid_ = threadIdx.x; asm volatile("" : "+v"(tid_));
    const int tid = tid_, wid = __builtin_amdgcn_readfirstlane(tid >> 6), lane = tid & 63, wr = wid >> 2, wc = wid & 3, fr = lane & 15, fq = lane >> 4;
    const int K = g.K, nt = K / BK;
    unsigned voffA[2], voffB[2];
#pragma unroll
    for (int i = 0; i < 2; ++i) { int R, C; stage_rc(tid * 16 + i * 8192, R, C); const int Rb = Epi::PERM ? ((R & ~31) + perm32(R & 31)) : R;
        voffA[i] = (unsigned)(R * K + C) * 2u; voffB[i] = (unsigned)(Rb * K + C) * 2u; }
    const size_t kstep = (size_t)(BK * 2);
    const size_t hstep = (size_t)HALF * K * 2;
    const size_t tstep = 2 * hstep;
    const unsigned ldsw = (unsigned)wid * 1024u;
    const int aoff = lds_byte(wr * 64 + fr, fq * 8), boff = lds_byte(wc * 32 + fr, fq * 8);
#define PG8_SA(b, h) (((b) * 2 + (h)) * HTB)
#define PG8_SB(b, h) ((4 + (b) * 2 + (h)) * HTB)
#define PG8_STAGE(bufoff, gbase, voff) do { _Pragma("unroll") for (int _i = 0; _i < 2; ++_i) \
        __builtin_amdgcn_global_load_lds((const unsigned*)((const char*)(gbase) + (voff)[_i]), (PG8_LAS unsigned*)(lds + (bufoff) + ldsw + _i * 8192), 16, 0, 0); } while (0)
#define PG8_LDA(dst, b, h) do { _Pragma("unroll") for (int m = 0; m < 4; ++m) _Pragma("unroll") for (int k = 0; k < 2; ++k) dst[m][k] = *(const PG8_LAS bf16x8*)(lds + PG8_SA(b, h) + aoff + m * 2048 + k * 1024); } while (0)
#define PG8_LDB(dst, b, h) do { _Pragma("unroll") for (int n = 0; n < 2; ++n) _Pragma("unroll") for (int k = 0; k < 2; ++k) dst[n][k] = *(const PG8_LAS bf16x8*)(lds + PG8_SB(b, h) + boff + n * 2048 + k * 1024); } while (0)
#define PG8_MMA(ai, bj, At, Bt) do { __builtin_amdgcn_s_setprio(1); _Pragma("unroll") for (int m = 0; m < 4; ++m) _Pragma("unroll") for (int n = 0; n < 2; ++n) _Pragma("unroll") for (int k = 0; k < 2; ++k) \
        acc[ai][bj][m][n] = __builtin_amdgcn_mfma_f32_16x16x32_bf16(Bt[n][k], At[m][k], acc[ai][bj][m][n], 0, 0, 0); __builtin_amdgcn_s_setprio(0); } while (0)
#define PG8_WAIT_V(n) asm volatile("s_waitcnt vmcnt(" #n ")" ::: "memory")
#define PG8_WAIT_L(n) asm volatile("s_waitcnt lgkmcnt(" #n ")" ::: "memory")
#define PG8_BAR __builtin_amdgcn_s_barrier()
#define PG8_SCHED __builtin_amdgcn_sched_barrier(0)
    Unit cur, nxt; int ui = 0;
    if (!S.next(0, cur)) return;
    f32x4 acc[2][2][4][2];
#pragma unroll
    for (int a = 0; a < 2; ++a)
#pragma unroll
        for (int b = 0; b < 2; ++b)
#pragma unroll
            for (int m = 0; m < 4; ++m)
#pragma unroll
                for (int n = 0; n < 2; ++n) acc[a][b][m][n] = (f32x4){0.f, 0.f, 0.f, 0.f};
    bf16x8 At[4][2], B0[2][2], B1[2][2];
    const char* cA = (const char*)g.A + (size_t)cur.pm * tstep; const char* cB = (const char*)g.Bt + (size_t)cur.pn * tstep + (size_t)cur.e * g.bexp;
    S.a_ready(cur);
    if constexpr (SP2) {
        PG8_STAGE(PG8_SB(0, 0), cB, voffB); PG8_STAGE(PG8_SB(0, 1), cB + hstep, voffB); PG8_STAGE(PG8_SA(0, 0), cA, voffA); PG8_STAGE(PG8_SA(0, 1), cA + hstep, voffA);
        if (wr == 1) PG8_BAR;
        PG8_WAIT_V(2); PG8_BAR;
        PG8_STAGE(PG8_SB(1, 0), cB + kstep, voffB); PG8_STAGE(PG8_SA(1, 0), cA + kstep, voffA); PG8_STAGE(PG8_SB(1, 1), cB + hstep + kstep, voffB);
        PG8_WAIT_V(6); PG8_BAR;
    } else {
        PG8_STAGE(PG8_SB(0, 0), cB, voffB); PG8_STAGE(PG8_SA(0, 0), cA, voffA); PG8_STAGE(PG8_SB(0, 1), cB + hstep, voffB); PG8_STAGE(PG8_SA(0, 1), cA + hstep, voffA);
        if (wr == 1) PG8_BAR;
        PG8_WAIT_V(4); PG8_BAR;
        PG8_STAGE(PG8_SB(1, 0), cB + kstep, voffB); PG8_STAGE(PG8_SA(1, 0), cA + kstep, voffA); PG8_STAGE(PG8_SB(1, 1), cB + hstep + kstep, voffB);
        PG8_WAIT_V(6); PG8_BAR;
    }
    for (;;) {
        const bool has_next = S.next(ui + 1, nxt);
        const char* nA = has_next ? (const char*)g.A + (size_t)nxt.pm * tstep : cA; const char* nB = has_next ? (const char*)g.Bt + (size_t)nxt.pn * tstep + (size_t)nxt.e * g.bexp : cB;
        for (int t = 0; t < nt; t += 2) {
            const bool last = (t == nt - 2);
            const char* a1 = cA + (size_t)(t + 1) * kstep;
            const char* a2 = last ? nA : cA + (size_t)(t + 2) * kstep; const char* b2 = last ? nB : cB + (size_t)(t + 2) * kstep;
            const char* a3 = a2 + kstep; const char* b3 = b2 + kstep;
            if (last && has_next) S.a_ready(nxt);
            if constexpr (SP2) {
            PG8_LDB(B0, 0, 0); PG8_LDB(B1, 0, 1); PG8_SCHED; PG8_LDA(At, 0, 0); PG8_STAGE(PG8_SA(1, 1), a1 + hstep, voffA);
            PG8_WAIT_V(8); PG8_WAIT_L(0); PG8_BAR; PG8_MMA(0, 0, At, B0); PG8_MMA(0, 1, At, B1); PG8_BAR; PG8_SCHED;
            PG8_LDA(At, 0, 1); PG8_STAGE(PG8_SB(0, 0), b2, voffB); PG8_STAGE(PG8_SB(0, 1), b2 + hstep, voffB); PG8_STAGE(PG8_SA(0, 0), a2, voffA);
            PG8_WAIT_V(8); PG8_WAIT_L(0); PG8_BAR; PG8_MMA(1, 0, At, B0); PG8_MMA(1, 1, At, B1); PG8_BAR; PG8_SCHED;
            PG8_LDB(B0, 1, 0); PG8_LDB(B1, 1, 1); PG8_SCHED; PG8_LDA(At, 1, 0); PG8_STAGE(PG8_SA(0, 1), a2 + hstep, voffA);
            PG8_WAIT_V(8); PG8_WAIT_L(0); PG8_BAR; PG8_MMA(0, 0, At, B0); PG8_MMA(0, 1, At, B1); PG8_BAR; PG8_SCHED;
            PG8_LDA(At, 1, 1); PG8_STAGE(PG8_SB(1, 0), b3, voffB); PG8_STAGE(PG8_SB(1, 1), b3 + hstep, voffB); PG8_STAGE(PG8_SA(1, 0), a3, voffA);
            PG8_WAIT_V(8); PG8_WAIT_L(0); PG8_BAR; PG8_MMA(1, 0, At, B0); PG8_MMA(1, 1, At, B1); PG8_BAR; PG8_SCHED;
            } else {
            PG8_LDB(B0, 0, 0); PG8_SCHED; PG8_LDA(At, 0, 0); PG8_STAGE(PG8_SA(1, 1), a1 + hstep, voffA);
            PG8_WAIT_L(8); PG8_BAR; PG8_WAIT_L(0); PG8_MMA(0, 0, At, B0); PG8_BAR; PG8_SCHED;
            PG8_LDB(B1, 0, 1); PG8_STAGE(PG8_SB(0, 0), b2, voffB);
            PG8_BAR; PG8_WAIT_L(0); PG8_MMA(0, 1, At, B1); PG8_BAR;
            PG8_LDA(At, 0, 1); PG8_STAGE(PG8_SA(0, 0), a2, voffA);
            PG8_BAR; PG8_WAIT_L(0); PG8_MMA(1, 0, At, B0); PG8_BAR; PG8_SCHED;
            PG8_STAGE(PG8_SB(0, 1), b2 + hstep, voffB);
            PG8_WAIT_V(6); PG8_BAR; PG8_MMA(1, 1, At, B1); PG8_BAR;
            PG8_LDB(B0, 1, 0); PG8_SCHED; PG8_LDA(At, 1, 0); PG8_STAGE(PG8_SA(0, 1), a2 + hstep, voffA);
            PG8_WAIT_L(8); PG8_BAR; PG8_WAIT_L(0); PG8_MMA(0, 0, At, B0); PG8_BAR; PG8_SCHED;
            PG8_LDB(B1, 1, 1); PG8_STAGE(PG8_SB(1, 0), b3, voffB);
            PG8_BAR; PG8_WAIT_L(0); PG8_MMA(0, 1, At, B1); PG8_BAR;
            PG8_LDA(At, 1, 1); PG8_STAGE(PG8_SA(1, 0), a3, voffA);
            PG8_BAR; PG8_WAIT_L(0); PG8_MMA(1, 0, At, B0); PG8_BAR; PG8_SCHED;
            PG8_STAGE(PG8_SB(1, 1), b3 + hstep, voffB);
            PG8_WAIT_V(6); PG8_BAR; PG8_MMA(1, 1, At, B1); PG8_BAR;
            }
        }
        if constexpr (ALIGN_EPI) { if (wr == 0) PG8_BAR; }
        if constexpr (!Epi::AFTER_DRAIN) { E(acc, cur, wr, wc, fr, fq); S.done(cur); }
        if (!has_next) break;
#pragma unroll
        for (int a = 0; a < 2; ++a)
#pragma unroll
            for (int b = 0; b < 2; ++b)
#pragma unroll
                for (int m = 0; m < 4; ++m)
#pragma unroll
                    for (int n = 0; n < 2; ++n) acc[a][b][m][n] = (f32x4){0.f, 0.f, 0.f, 0.f};
        cur = nxt; cA = nA; cB = nB; ++ui;
        if constexpr (ALIGN_EPI) { if (wr == 1) PG8_BAR; }
    }
    PG8_WAIT_V(0);
    if constexpr (!ALIGN_EPI) { if (wr == 0) PG8_BAR; }
    PG8_BAR;
    if constexpr (Epi::AFTER_DRAIN) { E.fused(acc, cur, wr, wc, fr, fq, lds, wid, lane); S.done(cur); }
#undef PG8_SA
#undef PG8_SB
#undef PG8_STAGE
#undef PG8_LDA
#undef PG8_LDB
#undef PG8_MMA
#undef PG8_WAIT_V
#undef PG8_WAIT_L
#undef PG8_BAR
#undef PG8_SCHED
}
}
__device__ __forceinline__ float bf2f(unsigned v) { return __uint_as_float(v << 16); }
__device__ __forceinline__ unsigned f2bf(float f) { unsigned u = __float_as_uint(f); u += 0x7FFFu + ((u >> 16) & 1u); return u >> 16; }
typedef __bf16 bf16x2_t __attribute__((ext_vector_type(2)));
__device__ __forceinline__ unsigned pk2(float lo, float hi) { const f32x2 v = {lo, hi}; return __builtin_bit_cast(unsigned, __builtin_convertvector(v, bf16x2_t)); }
__device__ __forceinline__ float bflo(unsigned w) { return __uint_as_float(w << 16); }
__device__ __forceinline__ float bfhi(unsigned w) { return __uint_as_float(w & 0xFFFF0000u); }
__device__ __forceinline__ float wave_sum(float v) {
#pragma unroll
    for (int o = 1; o < 64; o <<= 1) v += __shfl_xor(v, o);
    return v;
}
__device__ __forceinline__ float wave_max(float v) {
#pragma unroll
    for (int o = 1; o < 64; o <<= 1) v = fmaxf(v, __shfl_xor(v, o));
    return v;
}
__device__ __forceinline__ float sigmoidf_(float x) { return __builtin_amdgcn_rcpf(1.0f + __expf(-x)); }
__device__ __forceinline__ float tanhf_(float x) { return 1.0f - 2.0f * __builtin_amdgcn_rcpf(__expf(2.0f * x) + 1.0f); }
#define LDS_WAIT() asm volatile("s_waitcnt lgkmcnt(0)" ::: "memory")

struct Ctx { int tid, wave, lane, gw, ngw; unsigned char* shm; };

__device__ __forceinline__ int tr_src_col(int mode, int n, int scol0) { return mode == 1 ? (n < 2048 ? n : n + 16) : scol0 + n; }
__device__ __forceinline__ int tr_dst_row(int mode, int n, int drow0) { return mode == 2 ? 8 * (n >> 2) + (n & 3) : (mode == 3 ? 8 * (n >> 2) + 4 + (n & 3) : drow0 + n); }
__device__ __forceinline__ void tr_item(const float* W, int ldw, int scol0, int K, bf16_t* WT, int drow0, int mode, LAS float* scr, int item, int nblk, int lane, const float* gain = nullptr) {
    const int kb = item / nblk, nb = item % nblk, k0 = 64 * kb, n0 = 32 * nb;
    const int n4 = 4 * (lane & 7), sc = tr_src_col(mode, n0 + n4, scol0);
    f32x4 v[8];
#pragma unroll
    for (int i = 0; i < 8; ++i) v[i] = *(const f32x4*)(W + (size_t)(k0 + 8 * i + (lane >> 3)) * ldw + sc);
    if (gain) {
#pragma unroll
        for (int i = 0; i < 8; ++i) v[i] = v[i] * gain[k0 + 8 * i + (lane >> 3)]; }
#pragma unroll
    for (int i = 0; i < 8; ++i) { LAS float* d = scr + (8 * i + (lane >> 3)) * 33 + n4; d[0] = v[i].x; d[1] = v[i].y; d[2] = v[i].z; d[3] = v[i].w; }
    LDS_WAIT(); asm volatile("" ::: "memory");
    const int c = lane & 7;
#pragma unroll
    for (int j = 0; j < 4; ++j) { const int n = (lane >> 3) + 8 * j; const LAS float* s = scr + (8 * c) * 33 + n;
        u32x4 o; o.x = pk2(s[0 * 33], s[1 * 33]); o.y = pk2(s[2 * 33], s[3 * 33]); o.z = pk2(s[4 * 33], s[5 * 33]); o.w = pk2(s[6 * 33], s[7 * 33]);
        *(u32x4*)(WT + (size_t)tr_dst_row(mode, n0 + n, drow0) * K + k0 + 8 * c) = o; }
    LDS_WAIT(); asm volatile("" ::: "memory");
}
__device__ __forceinline__ void tr_matrix(const Ctx& c, const float* W, int ldw, int scol0, int K, int ncols, bf16_t* WT, int drow0, int mode, const float* gain = nullptr) {
    LAS float* scr = (LAS float*)(c.shm) + c.wave * (64 * 33);
    const int nblk = ncols / 32, nitems = (K / 64) * nblk;
    for (int it = c.gw; it < nitems; it += c.ngw) tr_item(W, ldw, scol0, K, WT, drow0, mode, scr, it, nblk, c.lane, gain);
}
__device__ __forceinline__ void tr_moe_layer(const Ctx& c, const Params& p, int layer) {
    LAS float* scr = (LAS float*)(c.shm) + c.wave * (64 * 33);
    bf16_t* w13t = (bf16_t*)(p.ws + OFF_WMOE); bf16_t* w2t = (bf16_t*)(p.ws + OFF_WMOE + 64 * MiB);
    const float* w1 = p.moe_w1 + (size_t)layer * NEXP * 1024 * 512; const float* w3 = p.moe_w3 + (size_t)layer * NEXP * 1024 * 512; const float* w2 = p.moe_w2 + (size_t)layer * NEXP * 512 * 1024;
    for (int it = c.gw; it < NEXP * 768; it += c.ngw) {
        const int e = it / 768, r = it % 768;
        if (r < 256) tr_item(w1 + (size_t)e * 1024 * 512, 512, 0, 1024, w13t + (size_t)e * 1024 * 1024, 0, 2, scr, r, 16, c.lane, p.norm_moe + layer * 1024);
        else if (r < 512) tr_item(w3 + (size_t)e * 1024 * 512, 512, 0, 1024, w13t + (size_t)e * 1024 * 1024, 0, 3, scr, r - 256, 16, c.lane, p.norm_moe + layer * 1024);
        else tr_item(w2 + (size_t)e * 512 * 1024, 1024, 0, 512, w2t + (size_t)e * 1024 * 512, 0, 0, scr, r - 512, 32, c.lane);
    }
}

__device__ __forceinline__ void row_load(const float* row, int lane, f32x4 (&v)[4]) {
#pragma unroll
    for (int j = 0; j < 4; ++j) v[j] = *((const f32x4*)row + lane + 64 * j);
}
__device__ __forceinline__ float row_rstd(const f32x4 (&v)[4]) {
    float s = 0.f;
#pragma unroll
    for (int j = 0; j < 4; ++j) s += (v[j].x * v[j].x + v[j].y * v[j].y) + (v[j].z * v[j].z + v[j].w * v[j].w);
    return 1.0f / sqrtf(wave_sum(s) * (1.0f / 1024.0f) + 1e-6f);
}
__device__ __forceinline__ void row_scale(f32x4 (&v)[4], float rstd, const float* gain, int lane) {
#pragma unroll
    for (int j = 0; j < 4; ++j) { const f32x4 g = *((const f32x4*)gain + lane + 64 * j); v[j] = v[j] * rstd * g; }
}
__device__ __forceinline__ void row_store_bf16(bf16_t* orow, int lane, const f32x4 (&v)[4]) {
#pragma unroll
    for (int j = 0; j < 4; ++j) { u32x2 o; o.x = pk2(v[j].x, v[j].y); o.y = pk2(v[j].z, v[j].w); *((u32x2*)orow + lane + 64 * j) = o; }
}
__device__ __forceinline__ void row_store_f32(float* orow, int lane, const f32x4 (&v)[4]) {
#pragma unroll
    for (int j = 0; j < 4; ++j) *((f32x4*)orow + lane + 64 * j) = v[j];
}
__device__ __forceinline__ void row_combine(f32x4 (&v)[4], const bf16_t* yb, int p0, int p1, float g0, float g1, int lane) {
    const u32x2* r0 = (const u32x2*)(yb + (size_t)p0 * 1024); const u32x2* r1 = (const u32x2*)(yb + (size_t)p1 * 1024);
#pragma unroll
    for (int j = 0; j < 4; ++j) { const u32x2 a = r0[lane + 64 * j], b = r1[lane + 64 * j];
        v[j].x += g0 * bflo(a.x) + g1 * bflo(b.x); v[j].y += g0 * bfhi(a.x) + g1 * bfhi(b.x);
        v[j].z += g0 * bflo(a.y) + g1 * bflo(b.y); v[j].w += g0 * bfhi(a.y) + g1 * bfhi(b.y); }
}
__device__ __forceinline__ void row_logits(const f32x4 (&v)[4], const float* wT, int lane, int NL, LAS float* lg) {
#pragma unroll 1
    for (int o = 0; o < NL; ++o) { float s = 0.f;
#pragma unroll
        for (int j = 0; j < 4; ++j) { const f32x4 w = *((const f32x4*)(wT + o * 1024) + lane + 64 * j); s += (v[j].x * w.x + v[j].y * w.y) + (v[j].z * w.z + v[j].w * w.w); }
        s = wave_sum(s); if (lane == 0) lg[o] = s; }
    LDS_WAIT();
}

__device__ __forceinline__ void norm_plain(const Ctx& c, const float* src, const float* gain, bf16_t* H, int nrows) {
    for (int r = c.gw; r < nrows; r += c.ngw) { f32x4 v[4]; row_load(src + (size_t)r * 1024, c.lane, v); const float rs = row_rstd(v); row_scale(v, rs, gain, c.lane); row_store_bf16(H + (size_t)r * 1024, c.lane, v); }
}
__device__ __forceinline__ void route_row(const LAS float* lg, const float* bg, const float* be, int& e0, int& e1, float& g0, float& g1) {
    float gl[4]; int gt = 0; float gm;
#pragma unroll
    for (int i = 0; i < 4; ++i) gl[i] = lg[i] + bg[i];
    gm = gl[0];
#pragma unroll
    for (int i = 1; i < 4; ++i) if (gl[i] > gm) { gm = gl[i]; gt = i; }
    float gs = 0.f;
#pragma unroll
    for (int i = 0; i < 4; ++i) gs += __expf(gl[i] - gm);
    const float pg = 1.0f / gs;
    float el[8];
#pragma unroll
    for (int i = 0; i < 8; ++i) el[i] = lg[4 + 8 * gt + i] + be[8 * gt + i];
    int i0 = 0; float m0 = el[0];
#pragma unroll
    for (int i = 1; i < 8; ++i) if (el[i] > m0) { m0 = el[i]; i0 = i; }
    int i1 = -1; float m1 = -3.0e38f;
#pragma unroll
    for (int i = 0; i < 8; ++i) if (i != i0 && el[i] > m1) { m1 = el[i]; i1 = i; }
    float one = 1.0f; asm volatile("" : "+v"(one));
    const float q1 = __expf(m1 - m0); const float inv = one / (one + q1);
    e0 = gt * 8 + i0; e1 = gt * 8 + i1; g0 = pg * inv; g1 = pg * q1 * inv;
}
constexpr int RW_AS = 64 * 68;
__device__ __forceinline__ void rwkv_naive(const Ctx& c, const Params& p, int bh) {
    const int b = bh >> 3, hd = bh & 7, tid = c.tid, lane = c.lane, wv = c.wave;
    LAS float* L = (LAS float*)c.shm;
    LAS float* aR = L; LAS float* aK = L + RW_AS; LAS float* aV = L + 2 * RW_AS; LAS float* aW = L + 3 * RW_AS; LAS float* aA = L + 4 * RW_AS;
    LAS float* aB = L + 5 * RW_AS; LAS float* aG = L + 6 * RW_AS; LAS float* aY = L + 7 * RW_AS; LAS float* red = L + 8 * RW_AS;
    const bf16_t* P = (const bf16_t*)(p.ws + OFF_P); bf16_t* MIX = (bf16_t*)(p.ws + OFF_H);
    LAS f32x4* SL = (LAS f32x4*)(L + 8 * RW_AS + 1536);
    if (wv == 0) {
#pragma unroll
        for (int j4 = 0; j4 < 16; ++j4) SL[j4 * 64 + lane] = (f32x4){0.f, 0.f, 0.f, 0.f}; }
    const int t = lane, cg = wv;
    const int ch0 = hd * 64 + cg * 8;
    for (int tb = 0; tb < 64; ++tb) {
        const size_t tg0 = (size_t)b * SEQ + (size_t)tb * 64;
#pragma unroll 1
        for (int i = 0; i < 7; ++i) {
            const int task = tid + 512 * i, tt = task / 56, q = task % 56;
            int col; LAS float* dst; int kind = 0;
            if (q < 8) { col = hd * 64 + 8 * q; dst = aR + tt * 68 + 8 * q; }
            else if (q < 16) { col = 512 + hd * 64 + 8 * (q - 8); dst = aK + tt * 68 + 8 * (q - 8); }
            else if (q < 24) { col = 1024 + hd * 64 + 8 * (q - 16); dst = aV + tt * 68 + 8 * (q - 16); }
            else if (q < 32) { col = 1536 + 8 * (q - 24); dst = aW + tt * 68 + 8 * (q - 24); kind = 1; }
            else if (q < 40) { col = 1600 + 8 * (q - 32); dst = aA + tt * 68 + 8 * (q - 32); }
            else if (q < 48) { col = 1664 + 8 * (q - 40); dst = aB + tt * 68 + 8 * (q - 40); kind = 2; }
            else { col = 1664 + 8 * (q - 40); dst = aG + tt * 68 + 8 * (q - 48); kind = 2; }
            const bf16_t* src = P + (tg0 + tt) * EV_IN + 768 + col;
            const u32x4 cur = *(const u32x4*)src;
            u32x4 prv = (u32x4){0u, 0u, 0u, 0u};
            if (tb * 64 + tt > 0) prv = *(const u32x4*)(src - EV_IN);
            const f32x4 m0 = *(const f32x4*)(p.ev_mu + col), m1 = *(const f32x4*)(p.ev_mu + col + 4);
            float v[8];
            const unsigned cw[4] = {cur.x, cur.y, cur.z, cur.w}, pw[4] = {prv.x, prv.y, prv.z, prv.w};
            const float mu[8] = {m0.x, m0.y, m0.z, m0.w, m1.x, m1.y, m1.z, m1.w};
#pragma unroll
            for (int k = 0; k < 4; ++k) { const float c0 = bflo(cw[k]), c1 = bfhi(cw[k]), p0 = bflo(pw[k]), p1 = bfhi(pw[k]);
                v[2 * k] = c0 + (p0 - c0) * mu[2 * k]; v[2 * k + 1] = c1 + (p1 - c1) * mu[2 * k + 1]; }
            if (kind == 1) {
#pragma unroll
                for (int k = 0; k < 8; ++k) v[k] = tanhf(v[k]); }
            if (kind == 2) {
#pragma unroll
                for (int k = 0; k < 8; ++k) v[k] = sigmoidf_(v[k]); }
            *(LAS f32x4*)dst = (f32x4){v[0], v[1], v[2], v[3]}; *(LAS f32x4*)(dst + 4) = (f32x4){v[4], v[5], v[6], v[7]};
        }
        __syncthreads();
        float zw[8], za[8], gg[8];
#pragma unroll
        for (int i = 0; i < 8; ++i) { zw[i] = 0.f; za[i] = 0.f; gg[i] = 0.f; }
#pragma unroll 2
        for (int j4 = 0; j4 < 16; ++j4) {
            const f32x4 xw = *(const LAS f32x4*)(aW + t * 68 + 4 * j4), xa = *(const LAS f32x4*)(aA + t * 68 + 4 * j4);
            const f32x4 g0 = *(const LAS f32x4*)(aB + t * 68 + 4 * j4), g1 = *(const LAS f32x4*)(aG + t * 68 + 4 * j4);
#pragma unroll
            for (int jj = 0; jj < 4; ++jj) { const int j = 4 * j4 + jj;
                const f32x4 w2a = *(const f32x4*)(p.ev_w2 + (size_t)j * 512 + ch0), w2b = *(const f32x4*)(p.ev_w2 + (size_t)j * 512 + ch0 + 4);
                const f32x4 a2a = *(const f32x4*)(p.ev_a2 + (size_t)j * 512 + ch0), a2b = *(const f32x4*)(p.ev_a2 + (size_t)j * 512 + ch0 + 4);
                const f32x4 gla = *(const f32x4*)(p.ev_g2 + (size_t)j * 512 + ch0), glb = *(const f32x4*)(p.ev_g2 + (size_t)j * 512 + ch0 + 4);
                const f32x4 gha = *(const f32x4*)(p.ev_g2 + (size_t)(64 + j) * 512 + ch0), ghb = *(const f32x4*)(p.ev_g2 + (size_t)(64 + j) * 512 + ch0 + 4);
                const float xwv = xw[jj], xav = xa[jj], g0v = g0[jj], g1v = g1[jj];
#pragma unroll
                for (int i = 0; i < 4; ++i) { zw[i] += xwv * w2a[i]; zw[4 + i] += xwv * w2b[i]; za[i] += xav * a2a[i]; za[4 + i] += xav * a2b[i];
                    gg[i] += g0v * gla[i] + g1v * gha[i]; gg[4 + i] += g0v * glb[i] + g1v * ghb[i]; } }
        }
        float av[8], kkv[8]; float ss = 0.f;
        {
            const f32x4 kA = *(const LAS f32x4*)(aK + t * 68 + cg * 8), kB = *(const LAS f32x4*)(aK + t * 68 + cg * 8 + 4);
            const float kv[8] = {kA.x, kA.y, kA.z, kA.w, kB.x, kB.y, kB.z, kB.w};
            float dec[8], kp[8];
#pragma unroll
            for (int i = 0; i < 8; ++i) { const int ch = ch0 + i;
                const float u = -(p.ev_w0[ch] + zw[i]); const float sp = (u > 20.f) ? u : log1pf(__expf(u));
                const float w = -sp - 0.5f; dec[i] = __expf(-__expf(w));
                av[i] = sigmoidf_(p.ev_a0[ch] + za[i]);
                kkv[i] = kv[i] * p.ev_k_k[ch]; ss += kkv[i] * kkv[i];
                kp[i] = kv[i] * (1.0f + (av[i] - 1.0f) * p.ev_k_a[ch]); }
            red[t * 8 + cg] = ss;
            __syncthreads();
            *(LAS f32x4*)(aW + t * 68 + cg * 8) = (f32x4){dec[0], dec[1], dec[2], dec[3]}; *(LAS f32x4*)(aW + t * 68 + cg * 8 + 4) = (f32x4){dec[4], dec[5], dec[6], dec[7]};
            *(LAS f32x4*)(aK + t * 68 + cg * 8) = (f32x4){kp[0], kp[1], kp[2], kp[3]}; *(LAS f32x4*)(aK + t * 68 + cg * 8 + 4) = (f32x4){kp[4], kp[5], kp[6], kp[7]};
            *(LAS f32x4*)(aG + t * 68 + cg * 8) = (f32x4){gg[0], gg[1], gg[2], gg[3]}; *(LAS f32x4*)(aG + t * 68 + cg * 8 + 4) = (f32x4){gg[4], gg[5], gg[6], gg[7]};
            float tot = 0.f;
#pragma unroll
            for (int i = 0; i < 8; ++i) tot += red[t * 8 + i];
            const float inv = 1.0f / fmaxf(sqrtf(tot), 1e-12f);
            float an[8], bn[8];
#pragma unroll
            for (int i = 0; i < 8; ++i) { const float kn = kkv[i] * inv; an[i] = -kn; bn[i] = kn * av[i]; }
            *(LAS f32x4*)(aA + t * 68 + cg * 8) = (f32x4){an[0], an[1], an[2], an[3]}; *(LAS f32x4*)(aA + t * 68 + cg * 8 + 4) = (f32x4){an[4], an[5], an[6], an[7]};
            *(LAS f32x4*)(aB + t * 68 + cg * 8) = (f32x4){bn[0], bn[1], bn[2], bn[3]}; *(LAS f32x4*)(aB + t * 68 + cg * 8 + 4) = (f32x4){bn[4], bn[5], bn[6], bn[7]};
        }
        __syncthreads();
        if (wv == 0) {
            float S[64];
#pragma unroll
            for (int j4 = 0; j4 < 16; ++j4) { const f32x4 s4 = SL[j4 * 64 + lane]; S[4 * j4] = s4.x; S[4 * j4 + 1] = s4.y; S[4 * j4 + 2] = s4.z; S[4 * j4 + 3] = s4.w; }
#pragma unroll 1
            for (int tt = 0; tt < 64; ++tt) {
                const float vv = aV[tt * 68 + lane];
                float sa = 0.f;
#pragma unroll
                for (int j4 = 0; j4 < 16; ++j4) { const f32x4 a4 = *(const LAS f32x4*)(aA + tt * 68 + 4 * j4);
                    sa += S[4 * j4] * a4.x; sa += S[4 * j4 + 1] * a4.y; sa += S[4 * j4 + 2] * a4.z; sa += S[4 * j4 + 3] * a4.w; }
                float y = 0.f;
#pragma unroll
                for (int j4 = 0; j4 < 16; ++j4) {
                    const f32x4 d4 = *(const LAS f32x4*)(aW + tt * 68 + 4 * j4), b4 = *(const LAS f32x4*)(aB + tt * 68 + 4 * j4);
                    const f32x4 k4 = *(const LAS f32x4*)(aK + tt * 68 + 4 * j4), r4 = *(const LAS f32x4*)(aR + tt * 68 + 4 * j4);
#pragma unroll
                    for (int jj = 0; jj < 4; ++jj) { const int j = 4 * j4 + jj; S[j] = S[j] * d4[jj] + sa * b4[jj] + vv * k4[jj]; y += S[j] * r4[jj]; } }
                aY[tt * 68 + lane] = y;
            }
#pragma unroll
            for (int j4 = 0; j4 < 16; ++j4) SL[j4 * 64 + lane] = (f32x4){S[4 * j4], S[4 * j4 + 1], S[4 * j4 + 2], S[4 * j4 + 3]};
        }
        __syncthreads();
        {
            const f32x4 yA = *(const LAS f32x4*)(aY + t * 68 + cg * 8), yB = *(const LAS f32x4*)(aY + t * 68 + cg * 8 + 4);
            const f32x4 rA = *(const LAS f32x4*)(aR + t * 68 + cg * 8), rB = *(const LAS f32x4*)(aR + t * 68 + cg * 8 + 4);
            const f32x4 kA = *(const LAS f32x4*)(aK + t * 68 + cg * 8), kB = *(const LAS f32x4*)(aK + t * 68 + cg * 8 + 4);
            const f32x4 vA = *(const LAS f32x4*)(aV + t * 68 + cg * 8), vB = *(const LAS f32x4*)(aV + t * 68 + cg * 8 + 4);
            const f32x4 gA = *(const LAS f32x4*)(aG + t * 68 + cg * 8), gB = *(const LAS f32x4*)(aG + t * 68 + cg * 8 + 4);
            const float y[8] = {yA.x, yA.y, yA.z, yA.w, yB.x, yB.y, yB.z, yB.w}, r[8] = {rA.x, rA.y, rA.z, rA.w, rB.x, rB.y, rB.z, rB.w};
            const float k[8] = {kA.x, kA.y, kA.z, kA.w, kB.x, kB.y, kB.z, kB.w}, v[8] = {vA.x, vA.y, vA.z, vA.w, vB.x, vB.y, vB.z, vB.w};
            const float g[8] = {gA.x, gA.y, gA.z, gA.w, gB.x, gB.y, gB.z, gB.w};
            float s1 = 0.f, sb = 0.f;
#pragma unroll
            for (int i = 0; i < 8; ++i) { s1 += y[i]; sb += r[i] * k[i] * p.ev_r_k[ch0 + i]; }
            red[t * 8 + cg] = s1; red[512 + t * 8 + cg] = sb;
            __syncthreads();
            float m = 0.f, bon = 0.f;
#pragma unroll
            for (int i = 0; i < 8; ++i) { m += red[t * 8 + i]; bon += red[512 + t * 8 + i]; }
            m *= (1.0f / 64.0f);
            float s2 = 0.f;
#pragma unroll
            for (int i = 0; i < 8; ++i) s2 += (y[i] - m) * (y[i] - m);
            red[1024 + t * 8 + cg] = s2;
            __syncthreads();
            float var = 0.f;
#pragma unroll
            for (int i = 0; i < 8; ++i) var += red[1024 + t * 8 + i];
            const float rs = 1.0f / sqrtf(var * (1.0f / 64.0f) + 64e-5f);
            float o[8];
#pragma unroll
            for (int i = 0; i < 8; ++i) o[i] = ((y[i] - m) * rs * p.ev_lnx_w[ch0 + i] + p.ev_lnx_b[ch0 + i] + bon * v[i]) * g[i];
            u32x4 w; w.x = pk2(o[0], o[1]); w.y = pk2(o[2], o[3]); w.z = pk2(o[4], o[5]); w.w = pk2(o[6], o[7]);
            *(u32x4*)(MIX + (tg0 + t) * 1024 + 512 + ch0) = w;
        }
        __syncthreads();
    }
}

__device__ __forceinline__ void swa_naive(const Ctx& c, const Params& p, int unit) {
    const int b = unit >> 6, g = (unit >> 5) & 1, n = unit & 31, tid = c.tid, lane = c.lane, wv = c.wave;
    LAS bf16_t* Ks = (LAS bf16_t*)c.shm;
    LAS bf16_t* Vs = (LAS bf16_t*)(c.shm + 256 * 144);
    LAS float* qf = (LAS float*)(c.shm + 256 * 144 + 256 * 128) + wv * 320;
    LAS float* pr = qf + 64;
    const bf16_t* P = (const bf16_t*)(p.ws + OFF_P); bf16_t* MIX = (bf16_t*)(p.ws + OFF_H);
    __syncthreads();
#pragma unroll 1
    for (int i = 0; i < 8; ++i) {
        const int task = tid + 512 * i, which = task >> 11, r = (task >> 3) & 255, ck = task & 7;
        const int tk = n * 128 - 128 + r;
        u32x4 d = (u32x4){0u, 0u, 0u, 0u};
        if (tk >= 0) d = *(const u32x4*)(P + ((size_t)b * SEQ + tk) * EV_IN + 512 + which * 128 + g * 64 + ck * 8);
        if (which == 0) *(LAS u32x4*)(Ks + r * 72 + ck * 8) = d; else *(LAS u32x4*)(Vs + r * 64 + ck * 8) = d;
    }
    __syncthreads();
    const int head = g * 4 + (wv >> 1);
    const float sink = p.ev_sinks[head];
#pragma unroll 1
    for (int qq = 0; qq < 64; ++qq) {
        const int qi = (wv & 1) * 64 + qq;
        const size_t tq = (size_t)b * SEQ + n * 128 + qi;
        qf[lane] = bf2f(P[tq * EV_IN + head * 64 + lane]) * 0.125f;
        LDS_WAIT();
        float s[4];
#pragma unroll
        for (int j = 0; j < 4; ++j) { const int kp = lane + 64 * j; float a = 0.f;
#pragma unroll
            for (int ck = 0; ck < 8; ++ck) { const u32x4 kk = *(const LAS u32x4*)(Ks + kp * 72 + ck * 8);
                const f32x4 q0 = *(const LAS f32x4*)(qf + ck * 8), q1 = *(const LAS f32x4*)(qf + ck * 8 + 4);
                a += bflo(kk.x) * q0.x + bfhi(kk.x) * q0.y + bflo(kk.y) * q0.z + bfhi(kk.y) * q0.w + bflo(kk.z) * q1.x + bfhi(kk.z) * q1.y + bflo(kk.w) * q1.z + bfhi(kk.w) * q1.w; }
            const bool valid = (kp >= qi + 1) && (kp <= qi + 128) && (n > 0 || kp >= 128);
            s[j] = valid ? a : -INFINITY; }
        float m = fmaxf(fmaxf(s[0], s[1]), fmaxf(s[2], s[3])); m = fmaxf(wave_max(m), sink);
        float den = 0.f;
#pragma unroll
        for (int j = 0; j < 4; ++j) { const float e = __expf(s[j] - m); pr[lane + 64 * j] = e; den += e; }
        den = wave_sum(den) + __expf(sink - m);
        LDS_WAIT();
        float o = 0.f;
#pragma unroll 8
        for (int kp = qi + 1; kp <= qi + 128; ++kp) o += pr[kp] * bf2f(Vs[kp * 64 + lane]);
        MIX[tq * 1024 + head * 64 + lane] = (bf16_t)f2bf(o / den);
    }
}
__device__ __forceinline__ void gla_naive(const Ctx& c, const Params& p, int bh) {
    const int b = bh >> 2, hd = bh & 3, tid = c.tid, lane = c.lane, wv = c.wave;
    LAS float* qs = (LAS float*)c.shm; LAS float* ks = qs + 32 * 128; LAS float* es = ks + 32 * 128; LAS float* vs = es + 32 * 128; LAS float* os = vs + 32 * 256;
    const bf16_t* P = (const bf16_t*)(p.ws + OFF_P); const float* GK = (const float*)(p.ws + OFF_R); bf16_t* MIX = (bf16_t*)(p.ws + OFF_H);
    float S[128];
#pragma unroll
    for (int j = 0; j < 128; ++j) S[j] = 0.f;
    for (int tb = 0; tb < 128; ++tb) {
        const size_t tg0 = (size_t)b * SEQ + (size_t)tb * 32;
#pragma unroll 1
        for (int i = 0; i < 8; ++i) { const int idx = tid + 512 * i, tt = idx >> 7, j = idx & 127;
            const bf16_t* row = P + (tg0 + tt) * OD_IN;
            qs[idx] = bf2f(row[hd * 128 + j]) * 0.08838834764831845f; ks[idx] = bf2f(row[512 + hd * 128 + j]); es[idx] = __expf(GK[(tg0 + tt) * 512 + hd * 128 + j]); }
#pragma unroll 1
        for (int i = 0; i < 16; ++i) { const int idx = tid + 512 * i, tt = idx >> 8, j = idx & 255; vs[idx] = bf2f(P[(tg0 + tt) * OD_IN + 1024 + hd * 256 + j]); }
        __syncthreads();
        if (wv < 4) {
#pragma unroll 1
            for (int tt = 0; tt < 32; ++tt) {
                const float vv = vs[tt * 256 + tid]; float o = 0.f;
#pragma unroll
                for (int j4 = 0; j4 < 32; ++j4) {
                    const f32x4 e4 = *(const LAS f32x4*)(es + tt * 128 + 4 * j4), k4 = *(const LAS f32x4*)(ks + tt * 128 + 4 * j4), q4 = *(const LAS f32x4*)(qs + tt * 128 + 4 * j4);
#pragma unroll
                    for (int jj = 0; jj < 4; ++jj) { const int j = 4 * j4 + jj; S[j] = S[j] * e4[jj] + k4[jj] * vv; o += q4[jj] * S[j]; } }
                os[tt * 256 + tid] = o;
            }
        }
        __syncthreads();
#pragma unroll 1
        for (int i = 0; i < 4; ++i) { const int tt = wv + 8 * i;
            const f32x4 o4 = *(const LAS f32x4*)(os + tt * 256 + 4 * lane);
            const float ss = wave_sum(o4.x * o4.x + o4.y * o4.y + o4.z * o4.z + o4.w * o4.w);
            const float rs = 1.0f / sqrtf(ss * (1.0f / 256.0f) + 1e-6f);
            const f32x4 gn = *(const f32x4*)(p.od_onorm + 4 * lane);
            const u32x2 og = *(const u32x2*)(P + (tg0 + tt) * OD_IN + 2048 + hd * 256 + 4 * lane);
            const float g0 = bflo(og.x), g1 = bfhi(og.x), g2 = bflo(og.y), g3 = bfhi(og.y);
            u32x2 w; w.x = pk2(o4.x * rs * gn.x * g0 * sigmoidf_(g0), o4.y * rs * gn.y * g1 * sigmoidf_(g1)); w.y = pk2(o4.z * rs * gn.z * g2 * sigmoidf_(g2), o4.w * rs * gn.w * g3 * sigmoidf_(g3));
            *(u32x2*)(MIX + (tg0 + tt) * 1024 + hd * 256 + 4 * lane) = w; }
        __syncthreads();
    }
}

__device__ __forceinline__ void xattn_naive(const Ctx& c, const Params& p, int unit) {
    const int b = unit >> 5, hh = (unit >> 3) & 3, tblk = unit & 7, tid = c.tid, lane = c.lane, wv = c.wave;
    LAS bf16_t* Ks = (LAS bf16_t*)c.shm;
    LAS bf16_t* Vs = (LAS bf16_t*)(c.shm + 256 * 272);
    LAS float* qf = (LAS float*)(c.shm + 256 * 272 + 256 * 256) + wv * 384;
    LAS float* pr = qf + 128;
    const bf16_t* MKV = (const bf16_t*)(p.ws + OFF_MKV); const bf16_t* Q = (const bf16_t*)(p.ws + OFF_P); bf16_t* OA = (bf16_t*)(p.ws + OFF_P + 32 * MiB);
    __syncthreads();
#pragma unroll 1
    for (int i = 0; i < 16; ++i) {
        const int task = tid + 512 * i, which = task >> 12, r = (task >> 4) & 255, ck = task & 15;
        const u32x4 d = *(const u32x4*)(MKV + ((size_t)b * MEMLEN + r) * 1024 + which * 512 + hh * 128 + ck * 8);
        if (which == 0) *(LAS u32x4*)(Ks + r * 136 + ck * 8) = d; else *(LAS u32x4*)(Vs + r * 128 + ck * 8) = d;
    }
    __syncthreads();
#pragma unroll 1
    for (int qq = 0; qq < 64; ++qq) {
        const size_t tq = (size_t)b * SEQ + tblk * 512 + wv * 64 + qq;
        qf[lane] = bf2f(Q[tq * 512 + hh * 128 + lane]) * 0.08838834764831845f; qf[lane + 64] = bf2f(Q[tq * 512 + hh * 128 + 64 + lane]) * 0.08838834764831845f;
        LDS_WAIT();
        float s[4];
#pragma unroll
        for (int j = 0; j < 4; ++j) { const int kp = lane + 64 * j; float a = 0.f;
#pragma unroll
            for (int ck = 0; ck < 16; ++ck) { const u32x4 kk = *(const LAS u32x4*)(Ks + kp * 136 + ck * 8);
                const f32x4 q0 = *(const LAS f32x4*)(qf + ck * 8), q1 = *(const LAS f32x4*)(qf + ck * 8 + 4);
                a += bflo(kk.x) * q0.x + bfhi(kk.x) * q0.y + bflo(kk.y) * q0.z + bfhi(kk.y) * q0.w + bflo(kk.z) * q1.x + bfhi(kk.z) * q1.y + bflo(kk.w) * q1.z + bfhi(kk.w) * q1.w; }
            s[j] = a; }
        const float m = wave_max(fmaxf(fmaxf(s[0], s[1]), fmaxf(s[2], s[3])));
        float den = 0.f;
#pragma unroll
        for (int j = 0; j < 4; ++j) { const float e = __expf(s[j] - m); pr[lane + 64 * j] = e; den += e; }
        den = wave_sum(den);
        LDS_WAIT();
        float o0 = 0.f, o1 = 0.f;
#pragma unroll 4
        for (int k4 = 0; k4 < 64; ++k4) { const f32x4 p4 = *(const LAS f32x4*)(pr + 4 * k4);
#pragma unroll
            for (int kk = 0; kk < 4; ++kk) { const unsigned vv = *(const LAS unsigned*)(Vs + (4 * k4 + kk) * 128 + 2 * lane); o0 += p4[kk] * bflo(vv); o1 += p4[kk] * bfhi(vv); } }
        const float inv = 1.0f / den;
        *(unsigned*)(OA + tq * 512 + hh * 128 + 2 * lane) = pk2(o0 * inv, o1 * inv);
    }
}

__device__ __forceinline__ void moe_slots(const Ctx& c, const Params& p, int layer) {
    LAS int* sh = (LAS int*)c.shm;
    const int* cnt = (const int*)(p.ws + OFF_CTL + CTL_CNT) + layer * 32; int* cur = (int*)(p.ws + OFF_CTL + CTL_CUR) + layer * 32;
    int* blk = (int*)(p.ws + OFF_CTL + CTL_BLK) + layer * 1024;
    __syncthreads();
    if (c.tid == 0) { int acc = 0; for (int e = 0; e < NEXP; ++e) { sh[e] = acc; acc += (cnt[e] + 255) / 256 * 256; } sh[32] = acc; }
    __syncthreads();
    if (blockIdx.x == 0 && c.tid < NEXP) { const int e = c.tid, s = sh[e] / 256, en = (e == NEXP - 1 ? sh[32] : sh[e + 1]) / 256; for (int i = s; i < en; ++i) blk[1 + i] = e; if (e == 0) blk[0] = sh[32] / 256; }
    const int2* RE = (const int2*)(p.ws + OFF_ROUTE); int2* RP = (int2*)(p.ws + OFF_ROUTE + 512 * 1024);
    const bf16_t* H = (const bf16_t*)(p.ws + OFF_H); bf16_t* XB = (bf16_t*)(p.ws + OFF_P);
    for (int ck = c.gw; ck < T_TOK / 64; ck += c.ngw) {
        const int t = ck * 64 + c.lane; const int2 ee = RE[t]; int pos0 = 0, pos1 = 0;
#pragma unroll 1
        for (int e = 0; e < NEXP; ++e) {
            const unsigned long long m0 = __ballot(ee.x == e), m1 = __ballot(ee.y == e);
            const int n0 = __popcll(m0), n1 = __popcll(m1);
            if (n0 + n1 == 0) continue;
            int base = 0; if (c.lane == 0) base = atomicAdd(&cur[e], n0 + n1);
            base = __shfl(base, 0) + sh[e];
            const unsigned long long lt = (1ull << c.lane) - 1ull;
            if (ee.x == e) pos0 = base + __popcll(m0 & lt);
            if (ee.y == e) pos1 = base + n0 + __popcll(m1 & lt);
        }
        RP[t] = make_int2(pos0, pos1);
#pragma unroll 1
        for (int i = 0; i < 64; ++i) { const int ti = ck * 64 + i, q0 = __shfl(pos0, i), q1 = __shfl(pos1, i);
            const u32x4 a = *((const u32x4*)(H + (size_t)ti * 1024) + c.lane), bq = *((const u32x4*)(H + (size_t)ti * 1024) + 64 + c.lane);
            *((u32x4*)(XB + (size_t)q0 * 1024) + c.lane) = a; *((u32x4*)(XB + (size_t)q0 * 1024) + 64 + c.lane) = bq;
            *((u32x4*)(XB + (size_t)q1 * 1024) + c.lane) = a; *((u32x4*)(XB + (size_t)q1 * 1024) + 64 + c.lane) = bq; }
    }
}
typedef short bf16x8_t __attribute__((ext_vector_type(8)));
constexpr size_t R_GK = 0, R_QT = 64 * MiB, R_ATT = 96 * MiB, R_KHT = 112 * MiB, R_GDEC = 144 * MiB;
template <int CTRL, int RMASK> __device__ __forceinline__ float dpp_get0(float x) {
    return __builtin_bit_cast(float, __builtin_amdgcn_update_dpp(0, __builtin_bit_cast(int, x), CTRL, RMASK, 0xF, false)); }
__device__ __forceinline__ float wave_scan_incl(float x, int lane) {
    (void)lane;
    x += dpp_get0<0x111, 0xF>(x); x += dpp_get0<0x112, 0xF>(x); x += dpp_get0<0x114, 0xF>(x); x += dpp_get0<0x118, 0xF>(x);
    x += dpp_get0<0x142, 0xA>(x); x += dpp_get0<0x143, 0xC>(x);
    return x;
}
__device__ __forceinline__ float lane63(float x) { return __builtin_bit_cast(float, __builtin_amdgcn_readlane(__builtin_bit_cast(int, x), 63)); }
__device__ __forceinline__ int key_perm(int key) { const int kq = key & 31; return (key & ~31) + 8 * ((kq >> 2) & 3) + 4 * ((kq >> 4) & 1) + (kq & 3); }
__device__ __forceinline__ bf16x8_t zero_frag() { return (bf16x8_t){0, 0, 0, 0, 0, 0, 0, 0}; }
__device__ __forceinline__ bf16x8_t lds_frag(const LAS bf16_t* img, int pitch, int row, int col) { return *(const LAS bf16x8_t*)(img + row * pitch + col); }
__device__ __forceinline__ bf16x8_t pack8(const float (&v)[8]) {
    u32x4 w; w.x = pk2(v[0], v[1]); w.y = pk2(v[2], v[3]); w.z = pk2(v[4], v[5]); w.w = pk2(v[6], v[7]);
    return __builtin_bit_cast(bf16x8_t, w);
}
__device__ __forceinline__ void gla_prep(const Ctx& c, const Params& p, int unit) {
    const int bh = unit >> 6, ck = unit & 63, b = bh >> 2, hd = bh & 3, lane = c.lane, wv = c.wave;
    LAS bf16_t* Qs = (LAS bf16_t*)c.shm;
    LAS bf16_t* Ks = Qs + 64 * 136;
    const bf16_t* P = (const bf16_t*)(p.ws + OFF_P); unsigned char* R = p.ws + OFF_R;
    const float* GK = (const float*)(R + R_GK); bf16_t* QT = (bf16_t*)(R + R_QT) + (size_t)unit * 64 * 128; bf16_t* ATT = (bf16_t*)(R + R_ATT) + (size_t)unit * 64 * 64;
    bf16_t* KHT = (bf16_t*)(R + R_KHT) + (size_t)unit * 128 * 64; float* GDEC = (float*)(R + R_GDEC) + (size_t)unit * 128;
    const size_t tg = (size_t)b * SEQ + ck * 64 + lane; const int d0 = wv * 16;
    __syncthreads();
    {
        const bf16_t* row = P + tg * OD_IN;
        const u32x4 qa = *(const u32x4*)(row + hd * 128 + d0), qb = *(const u32x4*)(row + hd * 128 + d0 + 8);
        const u32x4 ka = *(const u32x4*)(row + 512 + hd * 128 + d0), kb = *(const u32x4*)(row + 512 + hd * 128 + d0 + 8);
        const unsigned qw[8] = {qa.x, qa.y, qa.z, qa.w, qb.x, qb.y, qb.z, qb.w}, kw[8] = {ka.x, ka.y, ka.z, ka.w, kb.x, kb.y, kb.z, kb.w};
        float qt[16], kt[16], kh[16];
#pragma unroll
        for (int i4 = 0; i4 < 4; ++i4) { const f32x4 g4 = *(const f32x4*)(GK + tg * 512 + hd * 128 + d0 + 4 * i4);
#pragma unroll
            for (int ii = 0; ii < 4; ++ii) { const int i = 4 * i4 + ii;
                const float bb = wave_scan_incl(g4[ii], lane); const float bl = lane63(bb);
                const float qv = (i & 1) ? bfhi(qw[i >> 1]) : bflo(qw[i >> 1]), kv = (i & 1) ? bfhi(kw[i >> 1]) : bflo(kw[i >> 1]);
                qt[i] = qv * 0.08838834764831845f * __expf(bb); kt[i] = kv * __expf(-bb); kh[i] = kv * __expf(bl - bb);
                if (lane == 63) GDEC[d0 + i] = __expf(bl); } }
        { u32x4 w0, w1; w0.x = pk2(qt[0], qt[1]); w0.y = pk2(qt[2], qt[3]); w0.z = pk2(qt[4], qt[5]); w0.w = pk2(qt[6], qt[7]); w1.x = pk2(qt[8], qt[9]); w1.y = pk2(qt[10], qt[11]); w1.z = pk2(qt[12], qt[13]); w1.w = pk2(qt[14], qt[15]);
          *(LAS u32x4*)(Qs + lane * 136 + d0) = w0; *(LAS u32x4*)(Qs + lane * 136 + d0 + 8) = w1; }
        { u32x4 w0, w1; w0.x = pk2(kt[0], kt[1]); w0.y = pk2(kt[2], kt[3]); w0.z = pk2(kt[4], kt[5]); w0.w = pk2(kt[6], kt[7]); w1.x = pk2(kt[8], kt[9]); w1.y = pk2(kt[10], kt[11]); w1.z = pk2(kt[12], kt[13]); w1.w = pk2(kt[14], kt[15]);
          *(LAS u32x4*)(Ks + lane * 136 + d0) = w0; *(LAS u32x4*)(Ks + lane * 136 + d0 + 8) = w1; }
        { const int sg = d0 >> 5, hb = (d0 >> 4) & 1;
#pragma unroll
          for (int x4 = 0; x4 < 4; ++x4) { u32x2 w; w.x = pk2(qt[4 * x4], qt[4 * x4 + 1]); w.y = pk2(qt[4 * x4 + 2], qt[4 * x4 + 3]);
              *(u32x2*)(QT + lane * 128 + 32 * sg + 8 * x4 + 4 * hb) = w; } }
        { const int sc = key_perm(lane);
#pragma unroll
          for (int i = 0; i < 16; ++i) KHT[(d0 + i) * 64 + sc] = (bf16_t)f2bf(kh[i]); }
    }
    __syncthreads();
    const int fr = lane & 15, fq = lane >> 4;
#pragma unroll
    for (int h2 = 0; h2 < 2; ++h2) { const int tile = 2 * wv + h2, si = tile >> 2, ti = tile & 3;
        f32x4 acc = (f32x4){0.f, 0.f, 0.f, 0.f};
        if (si <= ti) {
#pragma unroll
            for (int kk = 0; kk < 4; ++kk) { const bf16x8_t a = *(const LAS bf16x8_t*)(Ks + (16 * si + fr) * 136 + 32 * kk + 8 * fq), bq = *(const LAS bf16x8_t*)(Qs + (16 * ti + fr) * 136 + 32 * kk + 8 * fq);
                acc = __builtin_amdgcn_mfma_f32_16x16x32_bf16(a, bq, acc, 0, 0, 0); } }
        const int t = 16 * ti + fr, s0 = 16 * si + 4 * fq;
        u32x2 w; w.x = pk2(s0 <= t ? acc[0] : 0.f, s0 + 1 <= t ? acc[1] : 0.f); w.y = pk2(s0 + 2 <= t ? acc[2] : 0.f, s0 + 3 <= t ? acc[3] : 0.f);
        *(u32x2*)(ATT + t * 64 + 32 * (si >> 1) + 8 * fq + 4 * (si & 1)) = w; }
}
constexpr int GB_QT = 0, GB_ATT = 64 * 136 * 2, GB_KHT = GB_ATT + 64 * 72 * 2, GB_GD = GB_KHT + 128 * 72 * 2, GB_BYTES = GB_GD + 512;
__device__ __forceinline__ void gla_state_fill(const Params& p, unsigned char* buf, int unit, int ptid) {
    const unsigned char* R = p.ws + OFF_R;
    const bf16_t* QT = (const bf16_t*)(R + R_QT) + (size_t)unit * 64 * 128; const bf16_t* ATT = (const bf16_t*)(R + R_ATT) + (size_t)unit * 64 * 64;
    const bf16_t* KHT = (const bf16_t*)(R + R_KHT) + (size_t)unit * 128 * 64; const float* GDEC = (const float*)(R + R_GDEC) + (size_t)unit * 128;
    u32x4 r[11];
#pragma unroll
    for (int i = 0; i < 4; ++i) r[i] = *((const u32x4*)QT + ptid + 256 * i);
#pragma unroll
    for (int i = 0; i < 2; ++i) r[4 + i] = *((const u32x4*)ATT + ptid + 256 * i);
#pragma unroll
    for (int i = 0; i < 4; ++i) r[6 + i] = *((const u32x4*)KHT + ptid + 256 * i);
    if (ptid < 32) r[10] = *((const u32x4*)GDEC + ptid);
#pragma unroll
    for (int i = 0; i < 4; ++i) { const int idx = ptid + 256 * i; *(LAS u32x4*)(buf + GB_QT + (idx >> 4) * 272 + (idx & 15) * 16) = r[i]; }
#pragma unroll
    for (int i = 0; i < 2; ++i) { const int idx = ptid + 256 * i; *(LAS u32x4*)(buf + GB_ATT + (idx >> 3) * 144 + (idx & 7) * 16) = r[4 + i]; }
#pragma unroll
    for (int i = 0; i < 4; ++i) { const int idx = ptid + 256 * i; *(LAS u32x4*)(buf + GB_KHT + (idx >> 3) * 144 + (idx & 7) * 16) = r[6 + i]; }
    if (ptid < 32) *(LAS u32x4*)(buf + GB_GD + ptid * 16) = r[10];
}
__device__ __forceinline__ void gla_state(const Ctx& c, const Params& p, int bh, int slice) {
    const int b = bh >> 2, hd = bh & 3, lane = c.lane, wv = c.wave, fr = lane & 15, fq = lane >> 4, jt = slice * 4 + (wv & 3);
    const bf16_t* P = (const bf16_t*)(p.ws + OFF_P); bf16_t* O = (bf16_t*)(p.ws + OFF_H);
    unsigned char* sm = c.shm;
    f32x4 S[8];
#pragma unroll
    for (int i = 0; i < 8; ++i) S[i] = (f32x4){0.f, 0.f, 0.f, 0.f};
    bf16x8_t idf;
    { float iv[8];
#pragma unroll
      for (int e = 0; e < 8; ++e) iv[e] = (8 * fq + e == fr) ? 1.0f : 0.0f;
      idf = pack8(iv); }
    const size_t tb = (size_t)b * SEQ; const bf16_t* vcol = P + 1024 + hd * 256 + 16 * jt + 8 * fq;
    bf16x8_t vraw[4];
#pragma unroll
    for (int st = 0; st < 4; ++st) { vraw[st] = zero_frag(); if (wv < 4 && fq < 2) vraw[st] = *(const bf16x8_t*)(vcol + (tb + 16 * st + fr) * OD_IN); }
    __syncthreads();
    if (wv >= 4) gla_state_fill(p, sm, bh * 64, c.tid - 256);
    __syncthreads();
#pragma unroll 1
    for (int ck = 0; ck < 64; ++ck) {
        unsigned char* buf = sm + (ck & 1) * GB_BYTES;
        if (wv >= 4) { if (ck + 1 < 64) gla_state_fill(p, sm + ((ck + 1) & 1) * GB_BYTES, bh * 64 + ck + 1, c.tid - 256); }
        else {
            const size_t t0 = tb + ck * 64;
            const LAS bf16_t* QT = (const LAS bf16_t*)(buf + GB_QT); const LAS bf16_t* ATT = (const LAS bf16_t*)(buf + GB_ATT); const LAS bf16_t* KHT = (const LAS bf16_t*)(buf + GB_KHT); const LAS float* GD = (const LAS float*)(buf + GB_GD);
            bf16x8_t vf[2];
            { f32x4 vt[4];
#pragma unroll
              for (int st = 0; st < 4; ++st) vt[st] = __builtin_amdgcn_mfma_f32_16x16x32_bf16(vraw[st], idf, (f32x4){0.f, 0.f, 0.f, 0.f}, 0, 0, 0);
#pragma unroll
              for (int s2 = 0; s2 < 2; ++s2) { const float vv[8] = {vt[2 * s2][0], vt[2 * s2][1], vt[2 * s2][2], vt[2 * s2][3], vt[2 * s2 + 1][0], vt[2 * s2 + 1][1], vt[2 * s2 + 1][2], vt[2 * s2 + 1][3]}; vf[s2] = pack8(vv); } }
            if (ck + 1 < 64) {
#pragma unroll
                for (int st = 0; st < 4; ++st) if (fq < 2) vraw[st] = *(const bf16x8_t*)(vcol + (t0 + 64 + 16 * st + fr) * OD_IN); }
            f32x4 acc[4];
#pragma unroll
            for (int ti = 0; ti < 4; ++ti) acc[ti] = (f32x4){0.f, 0.f, 0.f, 0.f};
#pragma unroll
            for (int sg = 0; sg < 4; ++sg) { const float sv[8] = {S[2 * sg][0], S[2 * sg][1], S[2 * sg][2], S[2 * sg][3], S[2 * sg + 1][0], S[2 * sg + 1][1], S[2 * sg + 1][2], S[2 * sg + 1][3]};
                const bf16x8_t a = pack8(sv);
#pragma unroll
                for (int ti = 0; ti < 4; ++ti) acc[ti] = __builtin_amdgcn_mfma_f32_16x16x32_bf16(a, lds_frag(QT, 136, 16 * ti + fr, 32 * sg + 8 * fq), acc[ti], 0, 0, 0); }
#pragma unroll
            for (int s2 = 0; s2 < 2; ++s2)
#pragma unroll
                for (int ti = 0; ti < 4; ++ti) acc[ti] = __builtin_amdgcn_mfma_f32_16x16x32_bf16(vf[s2], lds_frag(ATT, 72, 16 * ti + fr, 32 * s2 + 8 * fq), acc[ti], 0, 0, 0);
#pragma unroll
            for (int ti = 0; ti < 4; ++ti) { u32x2 w; w.x = pk2(acc[ti][0], acc[ti][1]); w.y = pk2(acc[ti][2], acc[ti][3]);
                *(u32x2*)(O + (t0 + 16 * ti + fr) * 1024 + hd * 256 + 16 * jt + 4 * fq) = w; }
#pragma unroll
            for (int rt = 0; rt < 8; ++rt) { const f32x4 g4 = *(const LAS f32x4*)(GD + 16 * rt + 4 * fq); f32x4 s = S[rt] * g4;
#pragma unroll
                for (int s2 = 0; s2 < 2; ++s2) s = __builtin_amdgcn_mfma_f32_16x16x32_bf16(lds_frag(KHT, 72, 16 * rt + fr, 32 * s2 + 8 * fq), vf[s2], s, 0, 0, 0);
                S[rt] = s; }
        }
        __syncthreads();
    }
}
__device__ __forceinline__ void gla_finish(const Ctx& c, const Params& p) {
    const bf16_t* P = (const bf16_t*)(p.ws + OFF_P); bf16_t* O = (bf16_t*)(p.ws + OFF_H);
    for (int r = c.gw; r < T_TOK; r += c.ngw) {
#pragma unroll
        for (int j = 0; j < 4; ++j) {
            const u32x2 ow = *((const u32x2*)(O + (size_t)r * 1024 + 256 * j) + c.lane), gw = *((const u32x2*)(P + (size_t)r * OD_IN + 2048 + 256 * j) + c.lane);
            const float o0 = bflo(ow.x), o1 = bfhi(ow.x), o2 = bflo(ow.y), o3 = bfhi(ow.y);
            const float ss = wave_sum(o0 * o0 + o1 * o1 + o2 * o2 + o3 * o3); const float rs = 1.0f / sqrtf(ss * (1.0f / 256.0f) + 1e-6f);
            const f32x4 gn = *((const f32x4*)p.od_onorm + c.lane);
            const float g0 = bflo(gw.x), g1 = bfhi(gw.x), g2 = bflo(gw.y), g3 = bfhi(gw.y);
            u32x2 w; w.x = pk2(o0 * rs * gn.x * g0 * sigmoidf_(g0), o1 * rs * gn.y * g1 * sigmoidf_(g1)); w.y = pk2(o2 * rs * gn.z * g2 * sigmoidf_(g2), o3 * rs * gn.w * g3 * sigmoidf_(g3));
            *((u32x2*)(O + (size_t)r * 1024 + 256 * j) + c.lane) = w; }
    }
}

constexpr size_t R_MG = 0, R_NT = 32 * MiB, R_QG = 64 * MiB, R_Y0 = 96 * MiB, R_Z0 = 128 * MiB, R_GAM = 160 * MiB, R_BON = 161 * MiB, R_MEMN = 164 * MiB;
constexpr size_t WSM_W2T = 0, WSM_A2T = 64 * 1024;
constexpr size_t WSM_G2T = 512 * 1024;
constexpr int XI = 64 * 72 * 2;
constexpr int X_RHS = 11 * XI, X_DIAG = X_RHS + 34816, X_TI = X_DIAG + 4352, X_RED = X_TI + 3072;

__device__ __forceinline__ void rwkv_x(const Ctx& c, const Params& p, int unit) {
    const int bh = unit >> 6, ck = unit & 63, b = bh >> 3, hd = bh & 7, tid = c.tid, lane = c.lane, wv = c.wave, fr = lane & 15, fq = lane >> 4;
    unsigned char* sm = c.shm;
    LAS bf16_t* At = (LAS bf16_t*)sm; LAS bf16_t* Bt = (LAS bf16_t*)(sm + XI); LAS bf16_t* Kt = (LAS bf16_t*)(sm + 2 * XI); LAS bf16_t* Rt = (LAS bf16_t*)(sm + 3 * XI);
    LAS bf16_t* BH = (LAS bf16_t*)(sm + 4 * XI); LAS bf16_t* KH = (LAS bf16_t*)(sm + 5 * XI); LAS bf16_t* VT = (LAS bf16_t*)(sm + 6 * XI);
    LAS bf16_t* AAB = (LAS bf16_t*)(sm + 7 * XI); LAS bf16_t* AAK = (LAS bf16_t*)(sm + 8 * XI); LAS bf16_t* ARB = (LAS bf16_t*)(sm + 9 * XI); LAS bf16_t* ARK = (LAS bf16_t*)(sm + 10 * XI);
    LAS bf16_t* XT = At;
    LAS bf16_t* YT = Kt;
    LAS float* RHS = (LAS float*)(sm + X_RHS);
    LAS float* sXW = RHS; LAS float* sXA = RHS + 64 * 68;
    LAS float* DIAG = (LAS float*)(sm + X_DIAG);
    LAS bf16_t* TI = (LAS bf16_t*)(sm + X_TI);
    LAS float* red = (LAS float*)(sm + X_RED);
    const bf16_t* P = (const bf16_t*)(p.ws + OFF_P); unsigned char* R = p.ws + OFF_R;
    const size_t tg0 = (size_t)b * SEQ + (size_t)ck * 64;
    const int t = lane, cg = wv, ch0 = hd * 64 + cg * 8;
    __syncthreads();
#pragma unroll 1
    for (int i = 0; i < 2; ++i) {
        const int task = tid + 512 * i, tt = task >> 4, q = task & 15;
        const int col = 1536 + 8 * q; LAS bf16_t* dst = (q < 8 ? At + tt * 72 + 8 * q : Bt + tt * 72 + 8 * (q - 8));
        const bf16_t* src = P + (tg0 + tt) * EV_IN + 768 + col;
        const u32x4 cur = *(const u32x4*)src; u32x4 prv = (u32x4){0u, 0u, 0u, 0u};
        if (ck * 64 + tt > 0) prv = *(const u32x4*)(src - EV_IN);
        const f32x4 m0 = *(const f32x4*)(p.ev_mu + col), m1 = *(const f32x4*)(p.ev_mu + col + 4);
        const unsigned cw[4] = {cur.x, cur.y, cur.z, cur.w}, pw[4] = {prv.x, prv.y, prv.z, prv.w}; const float mu[8] = {m0.x, m0.y, m0.z, m0.w, m1.x, m1.y, m1.z, m1.w};
        float v[8];
#pragma unroll
        for (int k = 0; k < 4; ++k) { const float c0 = bflo(cw[k]), c1 = bfhi(cw[k]), p0 = bflo(pw[k]), p1 = bfhi(pw[k]); v[2 * k] = c0 + (p0 - c0) * mu[2 * k]; v[2 * k + 1] = c1 + (p1 - c1) * mu[2 * k + 1]; }
        if (q < 8) {
#pragma unroll
            for (int k = 0; k < 8; ++k) v[k] = tanhf_(v[k]); }
        { u32x4 w; w.x = pk2(v[0], v[1]); w.y = pk2(v[2], v[3]); w.z = pk2(v[4], v[5]); w.w = pk2(v[6], v[7]); *(LAS u32x4*)dst = w; }
    }
    float rv[8], kv[8], vv[8];
    {
        const bf16_t* src = P + (tg0 + t) * EV_IN + 768 + ch0; const bool hp = (ck * 64 + t > 0);
#pragma unroll
        for (int w3 = 0; w3 < 3; ++w3) { const u32x4 cur = *(const u32x4*)(src + 512 * w3); u32x4 prv = (u32x4){0u, 0u, 0u, 0u}; if (hp) prv = *(const u32x4*)(src + 512 * w3 - EV_IN);
            const f32x4 m0 = *(const f32x4*)(p.ev_mu + 512 * w3 + ch0), m1 = *(const f32x4*)(p.ev_mu + 512 * w3 + ch0 + 4);
            const unsigned cw[4] = {cur.x, cur.y, cur.z, cur.w}, pw[4] = {prv.x, prv.y, prv.z, prv.w}; const float mu[8] = {m0.x, m0.y, m0.z, m0.w, m1.x, m1.y, m1.z, m1.w};
#pragma unroll
            for (int k = 0; k < 4; ++k) { const float c0 = bflo(cw[k]), c1 = bfhi(cw[k]), p0 = bflo(pw[k]), p1 = bfhi(pw[k]);
                const float x0 = c0 + (p0 - c0) * mu[2 * k], x1 = c1 + (p1 - c1) * mu[2 * k + 1];
                if (w3 == 0) { rv[2 * k] = x0; rv[2 * k + 1] = x1; } else if (w3 == 1) { kv[2 * k] = x0; kv[2 * k + 1] = x1; } else { vv[2 * k] = x0; vv[2 * k + 1] = x1; } } }
    }
    __syncthreads();
    {
        const int mat = wv >> 2; const bf16_t* WT = (const bf16_t*)(p.ws + OFF_WSMALL + (mat ? WSM_A2T : WSM_W2T)); const LAS bf16_t* img = mat ? Bt : At; LAS float* dstm = mat ? sXA : sXW;
#pragma unroll
        for (int n = 0; n < 4; ++n) { const int tile = (wv & 3) * 4 + n, ct = tile >> 2, tt = tile & 3;
            f32x4 acc = (f32x4){0.f, 0.f, 0.f, 0.f};
#pragma unroll
            for (int kk = 0; kk < 2; ++kk) acc = __builtin_amdgcn_mfma_f32_16x16x32_bf16(*(const bf16x8_t*)(WT + (size_t)(hd * 64 + 16 * ct + fr) * 64 + 32 * kk + 8 * fq), lds_frag(img, 72, 16 * tt + fr, 32 * kk + 8 * fq), acc, 0, 0, 0);
            *(LAS f32x4*)(dstm + (16 * tt + fr) * 68 + 16 * ct + 4 * fq) = acc; }
    }
    __syncthreads();
    float zw[8], za[8];
    { const f32x4 a0 = *(const LAS f32x4*)(sXW + t * 68 + cg * 8), a1 = *(const LAS f32x4*)(sXW + t * 68 + cg * 8 + 4), b0 = *(const LAS f32x4*)(sXA + t * 68 + cg * 8), b1 = *(const LAS f32x4*)(sXA + t * 68 + cg * 8 + 4);
      zw[0] = a0.x; zw[1] = a0.y; zw[2] = a0.z; zw[3] = a0.w; zw[4] = a1.x; zw[5] = a1.y; zw[6] = a1.z; zw[7] = a1.w;
      za[0] = b0.x; za[1] = b0.y; za[2] = b0.z; za[3] = b0.w; za[4] = b1.x; za[5] = b1.y; za[6] = b1.z; za[7] = b1.w; }
    float lw[8], av[8], kkv[8], kp[8]; float ss = 0.f, sb = 0.f;
#pragma unroll
    for (int i = 0; i < 8; ++i) { const int ch = ch0 + i;
        const float u = -(p.ev_w0[ch] + zw[i]); const float sp = (u > 20.f) ? u : __logf(1.0f + __expf(u));
        lw[i] = -__expf(-sp - 0.5f);
        av[i] = sigmoidf_(p.ev_a0[ch] + za[i]);
        kkv[i] = kv[i] * p.ev_k_k[ch]; ss += kkv[i] * kkv[i];
        kp[i] = kv[i] * (1.0f + (av[i] - 1.0f) * p.ev_k_a[ch]);
        sb += rv[i] * kp[i] * p.ev_r_k[ch]; }
    red[t * 8 + cg] = ss; red[512 + t * 8 + cg] = sb;
    __syncthreads();
    {
        float tot = 0.f, bon = 0.f;
#pragma unroll
        for (int i = 0; i < 8; ++i) { tot += red[t * 8 + i]; bon += red[512 + t * 8 + i]; }
        if (cg == 0) ((float*)(R + R_BON))[(tg0 + t) * 8 + hd] = bon;
        const float inv = __builtin_amdgcn_rcpf(fmaxf(sqrtf(tot), 1e-12f));
        float at[8], rt_[8], bt[8], kt[8], bh_[8], kh_[8];
#pragma unroll
        for (int i = 0; i < 8; ++i) {
            const float cl = wave_scan_incl(lw[i], lane); const float cl63 = lane63(cl);
            const float e1 = __expf(cl), e0 = __expf(cl - lw[i]), en = __expf(-cl), eh = __expf(cl63 - cl);
            const float kn = kkv[i] * inv, A = -kn, Bv = kn * av[i];
            at[i] = A * e0; rt_[i] = rv[i] * e1; bt[i] = Bv * en; kt[i] = kp[i] * en; bh_[i] = Bv * eh; kh_[i] = kp[i] * eh;
            if (lane == 63) ((float*)(R + R_GAM))[(size_t)unit * 64 + cg * 8 + i] = __expf(cl63); }
        { u32x4 w; w.x = pk2(at[0], at[1]); w.y = pk2(at[2], at[3]); w.z = pk2(at[4], at[5]); w.w = pk2(at[6], at[7]); *(LAS u32x4*)(At + t * 72 + cg * 8) = w; }
        { u32x4 w; w.x = pk2(rt_[0], rt_[1]); w.y = pk2(rt_[2], rt_[3]); w.z = pk2(rt_[4], rt_[5]); w.w = pk2(rt_[6], rt_[7]); *(LAS u32x4*)(Rt + t * 72 + cg * 8) = w; }
        { u32x4 w; w.x = pk2(bt[0], bt[1]); w.y = pk2(bt[2], bt[3]); w.z = pk2(bt[4], bt[5]); w.w = pk2(bt[6], bt[7]); *(LAS u32x4*)(Bt + t * 72 + cg * 8) = w; }
        { u32x4 w; w.x = pk2(kt[0], kt[1]); w.y = pk2(kt[2], kt[3]); w.z = pk2(kt[4], kt[5]); w.w = pk2(kt[6], kt[7]); *(LAS u32x4*)(Kt + t * 72 + cg * 8) = w; }
        *(LAS f32x4*)(RHS + t * 132 + 64 + cg * 8) = (f32x4){at[0], at[1], at[2], at[3]}; *(LAS f32x4*)(RHS + t * 132 + 64 + cg * 8 + 4) = (f32x4){at[4], at[5], at[6], at[7]};
#pragma unroll
        for (int i = 0; i < 8; ++i) { BH[(cg * 8 + i) * 72 + t] = (bf16_t)f2bf(bh_[i]); KH[(cg * 8 + i) * 72 + t] = (bf16_t)f2bf(kh_[i]); VT[(cg * 8 + i) * 72 + t] = (bf16_t)f2bf(vv[i]); }
    }
    __syncthreads();
    {
        const int mat = wv >> 1;
        const LAS bf16_t* Ximg = (mat < 2) ? At : Rt; const LAS bf16_t* Yimg = (mat & 1) ? Kt : Bt;
        LAS bf16_t* Oimg = mat == 0 ? AAB : (mat == 1 ? AAK : (mat == 2 ? ARB : ARK));
#pragma unroll 4
        for (int n = 0; n < 8; ++n) { const int idx = (wv & 1) * 8 + n, si = idx >> 2, ti = idx & 3;
            f32x4 acc = (f32x4){0.f, 0.f, 0.f, 0.f};
            if (si <= ti) {
#pragma unroll
                for (int kk = 0; kk < 2; ++kk) acc = __builtin_amdgcn_mfma_f32_16x16x32_bf16(lds_frag(Yimg, 72, 16 * si + fr, 32 * kk + 8 * fq), lds_frag(Ximg, 72, 16 * ti + fr, 32 * kk + 8 * fq), acc, 0, 0, 0); }
            const int tt = 16 * ti + fr, s0 = 16 * si + 4 * fq; const int lim = (mat < 2) ? tt - 1 : tt;
            const float o0 = s0 <= lim ? acc[0] : 0.f, o1 = s0 + 1 <= lim ? acc[1] : 0.f, o2 = s0 + 2 <= lim ? acc[2] : 0.f, o3 = s0 + 3 <= lim ? acc[3] : 0.f;
            u32x2 w; w.x = pk2(o0, o1); w.y = pk2(o2, o3); *(LAS u32x2*)(Oimg + tt * 72 + s0) = w;
            if (mat == 0 && si == ti) { LAS float* d = DIAG + si * 272 + fr * 17 + 4 * fq; d[0] = o0; d[1] = o1; d[2] = o2; d[3] = o3; } }
    }
    __syncthreads();
    if (wv < 4) {
#pragma unroll
        for (int ti = 0; ti < 4; ++ti) { f32x4 acc = (f32x4){0.f, 0.f, 0.f, 0.f};
#pragma unroll
            for (int kk = 0; kk < 2; ++kk) acc = __builtin_amdgcn_mfma_f32_16x16x32_bf16(lds_frag(AAK, 72, 16 * ti + fr, 32 * kk + 8 * fq), lds_frag(VT, 72, 16 * wv + fr, 32 * kk + 8 * fq), acc, 0, 0, 0);
#pragma unroll
            for (int r = 0; r < 4; ++r) RHS[(16 * ti + 4 * fq + r) * 132 + 16 * wv + fr] = acc[r]; }
    } else if (lane < 16) { const int I = wv - 4; const LAS float* d = DIAG + I * 272; float T[16];
#pragma unroll
        for (int r = 0; r < 16; ++r) { float s = (r == lane) ? 1.f : 0.f;
#pragma unroll
            for (int q = 0; q < r; ++q) s += d[r * 17 + q] * T[q];
            T[r] = s; TI[I * 384 + r * 24 + lane] = (bf16_t)f2bf(s); } }
    __syncthreads();
#pragma unroll 1
    for (int I = 0; I < 4; ++I) {
        f32x4 acc;
#pragma unroll
        for (int r = 0; r < 4; ++r) acc[r] = RHS[(16 * I + 4 * fq + r) * 132 + 16 * wv + fr];
#pragma unroll 1
        for (int kk = 0; 32 * kk < 16 * I; ++kk) { const bool ok = (32 * kk + 8 * fq) < 16 * I;
            bf16x8_t a = zero_frag(), bq = zero_frag();
            if (ok) { a = lds_frag(AAB, 72, 16 * I + fr, 32 * kk + 8 * fq); bq = lds_frag(XT, 72, 16 * wv + fr, 32 * kk + 8 * fq); }
            acc = __builtin_amdgcn_mfma_f32_16x16x32_bf16(a, bq, acc, 0, 0, 0); }
        { u32x2 w; w.x = pk2(acc[0], acc[1]); w.y = pk2(acc[2], acc[3]); *(LAS u32x2*)(YT + (16 * wv + fr) * 24 + 4 * fq) = w; }
        LDS_WAIT();
        { bf16x8_t a = zero_frag(), bq = zero_frag();
          if (fq < 2) { a = *(const LAS bf16x8_t*)(TI + I * 384 + fr * 24 + 8 * fq); bq = *(const LAS bf16x8_t*)(YT + (16 * wv + fr) * 24 + 8 * fq); }
          f32x4 x = __builtin_amdgcn_mfma_f32_16x16x32_bf16(a, bq, (f32x4){0.f, 0.f, 0.f, 0.f}, 0, 0, 0);
          u32x2 w; w.x = pk2(x[0], x[1]); w.y = pk2(x[2], x[3]); *(LAS u32x2*)(XT + (16 * wv + fr) * 72 + 16 * I + 4 * fq) = w; }
        LDS_WAIT();
    }
    __syncthreads();
    {
        const int mat = wv >> 1;
        bf16_t* MG = (bf16_t*)(R + R_MG) + (size_t)unit * 4096; bf16_t* NT = (bf16_t*)(R + R_NT) + (size_t)unit * 4096;
        bf16_t* QG = (bf16_t*)(R + R_QG) + (size_t)unit * 4096; bf16_t* Y0G = (bf16_t*)(R + R_Y0) + (size_t)unit * 4096;
#pragma unroll 4
        for (int n = 0; n < 8; ++n) { const int idx = (wv & 1) * 8 + n, rt = idx >> 2, ct = idx & 3;
            f32x4 acc = (f32x4){0.f, 0.f, 0.f, 0.f};
            if (mat == 2) { const u32x2 r2 = *(const LAS u32x2*)(Rt + (16 * ct + fr) * 72 + 16 * rt + 4 * fq); acc = (f32x4){bflo(r2.x), bfhi(r2.x), bflo(r2.y), bfhi(r2.y)}; }
#pragma unroll
            for (int kk = 0; kk < 2; ++kk) { const int kc = 32 * kk + 8 * fq;
                if (mat == 0) acc = __builtin_amdgcn_mfma_f32_16x16x32_bf16(lds_frag(XT, 72, 64 + 16 * rt + fr, kc), lds_frag(BH, 72, 16 * ct + fr, kc), acc, 0, 0, 0);
                else if (mat == 1) { acc = __builtin_amdgcn_mfma_f32_16x16x32_bf16(lds_frag(BH, 72, 16 * rt + fr, kc), lds_frag(XT, 72, 16 * ct + fr, kc), acc, 0, 0, 0);
                                     acc = __builtin_amdgcn_mfma_f32_16x16x32_bf16(lds_frag(KH, 72, 16 * rt + fr, kc), lds_frag(VT, 72, 16 * ct + fr, kc), acc, 0, 0, 0); }
                else if (mat == 2) acc = __builtin_amdgcn_mfma_f32_16x16x32_bf16(lds_frag(XT, 72, 64 + 16 * rt + fr, kc), lds_frag(ARB, 72, 16 * ct + fr, kc), acc, 0, 0, 0);
                else { acc = __builtin_amdgcn_mfma_f32_16x16x32_bf16(lds_frag(XT, 72, 16 * rt + fr, kc), lds_frag(ARB, 72, 16 * ct + fr, kc), acc, 0, 0, 0);
                       acc = __builtin_amdgcn_mfma_f32_16x16x32_bf16(lds_frag(VT, 72, 16 * rt + fr, kc), lds_frag(ARK, 72, 16 * ct + fr, kc), acc, 0, 0, 0); } }
            u32x2 w; w.x = pk2(acc[0], acc[1]); w.y = pk2(acc[2], acc[3]);
            if (mat == 0) *(u32x2*)(MG + (16 * ct + fr) * 64 + 32 * (rt >> 1) + 8 * fq + 4 * (rt & 1)) = w;
            else if (mat == 1) *(u32x2*)(NT + (16 * ct + fr) * 64 + 16 * rt + 4 * fq) = w;
            else if (mat == 2) *(u32x2*)(QG + (16 * ct + fr) * 64 + 16 * rt + 4 * fq) = w;
            else *(u32x2*)(Y0G + (16 * ct + fr) * 64 + 16 * rt + 4 * fq) = w; }
    }
}

struct RwkvYOps { bf16x8_t m[4][2]; u32x2 n[4]; f32x4 g[4]; };
__device__ __forceinline__ void rwkv_y_load(RwkvYOps& o, const unsigned char* R, size_t unit, int jb, int fr, int fq) {
    const bf16_t* MG = (const bf16_t*)(R + R_MG) + unit * 4096; const bf16_t* NT = (const bf16_t*)(R + R_NT) + unit * 4096; const float* GAM = (const float*)(R + R_GAM) + unit * 64;
#pragma unroll
    for (int rt = 0; rt < 4; ++rt) {
#pragma unroll
        for (int sg = 0; sg < 2; ++sg) o.m[rt][sg] = *(const bf16x8_t*)(MG + (16 * rt + fr) * 64 + 32 * sg + 8 * fq);
        o.n[rt] = *(const u32x2*)(NT + (16 * jb + fr) * 64 + 16 * rt + 4 * fq); o.g[rt] = *(const f32x4*)(GAM + 16 * rt + 4 * fq); }
}
__device__ __forceinline__ void rwkv_y(const Ctx& c, const Params& p, int bh, int jb) {
    const int lane = c.lane, fr = lane & 15, fq = lane >> 4; unsigned char* R = p.ws + OFF_R;
    f32x4 Z[4];
#pragma unroll
    for (int i = 0; i < 4; ++i) Z[i] = (f32x4){0.f, 0.f, 0.f, 0.f};
    RwkvYOps cur, nxt; rwkv_y_load(cur, R, (size_t)bh * 64, jb, fr, fq);
#pragma unroll 1
    for (int ck = 0; ck < 64; ++ck) { const size_t unit = (size_t)bh * 64 + ck;
        rwkv_y_load(nxt, R, unit + (ck + 1 < 64 ? 1 : 0), jb, fr, fq);
        bf16_t* Z0 = (bf16_t*)(R + R_Z0) + unit * 4096;
        f32x4 acc[4];
#pragma unroll
        for (int rt = 0; rt < 4; ++rt) { u32x2 w; w.x = pk2(Z[rt][0], Z[rt][1]); w.y = pk2(Z[rt][2], Z[rt][3]); *(u32x2*)(Z0 + (16 * jb + fr) * 64 + 16 * rt + 4 * fq) = w;
            acc[rt] = (f32x4){bflo(cur.n[rt].x), bfhi(cur.n[rt].x), bflo(cur.n[rt].y), bfhi(cur.n[rt].y)} + cur.g[rt] * Z[rt]; }
        bf16x8_t zb[2];
#pragma unroll
        for (int sg = 0; sg < 2; ++sg) { const float zv[8] = {Z[2 * sg][0], Z[2 * sg][1], Z[2 * sg][2], Z[2 * sg][3], Z[2 * sg + 1][0], Z[2 * sg + 1][1], Z[2 * sg + 1][2], Z[2 * sg + 1][3]}; zb[sg] = pack8(zv); }
#pragma unroll
        for (int rt = 0; rt < 4; ++rt)
#pragma unroll
            for (int sg = 0; sg < 2; ++sg) acc[rt] = __builtin_amdgcn_mfma_f32_16x16x32_bf16(cur.m[rt][sg], zb[sg], acc[rt], 0, 0, 0);
#pragma unroll
        for (int rt = 0; rt < 4; ++rt) Z[rt] = acc[rt];
        cur = nxt;
    }
}

__device__ __forceinline__ void rwkv_z(const Ctx& c, const Params& p, int unit) {
    const int bh = unit >> 6, ck = unit & 63, b = bh >> 3, hd = bh & 7, lane = c.lane, fr = lane & 15, fq = lane >> 4; unsigned char* R = p.ws + OFF_R;
    const bf16_t* P = (const bf16_t*)(p.ws + OFF_P); bf16_t* MIX = (bf16_t*)(p.ws + OFF_H);
    const bf16_t* QG = (const bf16_t*)(R + R_QG) + (size_t)unit * 4096; const bf16_t* Y0G = (const bf16_t*)(R + R_Y0) + (size_t)unit * 4096; const bf16_t* Z0 = (const bf16_t*)(R + R_Z0) + (size_t)unit * 4096;
    const bf16_t* G2T = (const bf16_t*)(p.ws + OFF_WSMALL + WSM_G2T);
    const size_t tg0 = (size_t)b * SEQ + (size_t)ck * 64;
    f32x4 y[4][4], g[4][4];
#pragma unroll
    for (int jt = 0; jt < 4; ++jt)
#pragma unroll
        for (int tt = 0; tt < 4; ++tt) { const u32x2 w = *(const u32x2*)(Y0G + (16 * tt + fr) * 64 + 16 * jt + 4 * fq); y[jt][tt] = (f32x4){bflo(w.x), bfhi(w.x), bflo(w.y), bfhi(w.y)}; g[jt][tt] = (f32x4){0.f, 0.f, 0.f, 0.f}; }
#pragma unroll
    for (int sg = 0; sg < 2; ++sg) { bf16x8_t qb[4];
#pragma unroll
        for (int tt = 0; tt < 4; ++tt) qb[tt] = *(const bf16x8_t*)(QG + (16 * tt + fr) * 64 + 32 * sg + 8 * fq);
#pragma unroll
        for (int jt = 0; jt < 4; ++jt) { const bf16x8_t a = *(const bf16x8_t*)(Z0 + (16 * jt + fr) * 64 + 32 * sg + 8 * fq);
#pragma unroll
            for (int tt = 0; tt < 4; ++tt) y[jt][tt] = __builtin_amdgcn_mfma_f32_16x16x32_bf16(a, qb[tt], y[jt][tt], 0, 0, 0); } }
#pragma unroll 1
    for (int kk = 0; kk < 4; ++kk) { bf16x8_t sgf[4];
        const int col = 1664 + 32 * kk + 8 * fq; const f32x4 m0 = *(const f32x4*)(p.ev_mu + col), m1 = *(const f32x4*)(p.ev_mu + col + 4); const float mu[8] = {m0.x, m0.y, m0.z, m0.w, m1.x, m1.y, m1.z, m1.w};
#pragma unroll
        for (int tt = 0; tt < 4; ++tt) { const int tl = 16 * tt + fr; const bf16_t* src = P + (tg0 + tl) * EV_IN + 768 + col;
            const u32x4 cur = *(const u32x4*)src; u32x4 prv = (u32x4){0u, 0u, 0u, 0u}; if (ck * 64 + tl > 0) prv = *(const u32x4*)(src - EV_IN);
            const unsigned cw[4] = {cur.x, cur.y, cur.z, cur.w}, pw[4] = {prv.x, prv.y, prv.z, prv.w}; float v[8];
#pragma unroll
            for (int k = 0; k < 4; ++k) { const float c0 = bflo(cw[k]), c1 = bfhi(cw[k]), p0 = bflo(pw[k]), p1 = bfhi(pw[k]); v[2 * k] = sigmoidf_(c0 + (p0 - c0) * mu[2 * k]); v[2 * k + 1] = sigmoidf_(c1 + (p1 - c1) * mu[2 * k + 1]); }
            sgf[tt] = pack8(v); }
#pragma unroll
        for (int jt = 0; jt < 4; ++jt) { const bf16x8_t a = *(const bf16x8_t*)(G2T + (size_t)(hd * 64 + 16 * jt + fr) * 128 + 32 * kk + 8 * fq);
#pragma unroll
            for (int tt = 0; tt < 4; ++tt) g[jt][tt] = __builtin_amdgcn_mfma_f32_16x16x32_bf16(a, sgf[tt], g[jt][tt], 0, 0, 0); } }
#pragma unroll
    for (int tt = 0; tt < 4; ++tt) { const int tl = 16 * tt + fr;
        float s1 = 0.f;
#pragma unroll
        for (int jt = 0; jt < 4; ++jt) s1 += (y[jt][tt][0] + y[jt][tt][1]) + (y[jt][tt][2] + y[jt][tt][3]);
        s1 += __shfl_xor(s1, 16); s1 += __shfl_xor(s1, 32); const float mean = s1 * (1.0f / 64.0f);
        float s2 = 0.f;
#pragma unroll
        for (int jt = 0; jt < 4; ++jt)
#pragma unroll
            for (int r = 0; r < 4; ++r) { const float d = y[jt][tt][r] - mean; s2 += d * d; }
        s2 += __shfl_xor(s2, 16); s2 += __shfl_xor(s2, 32); const float rs = 1.0f / sqrtf(s2 * (1.0f / 64.0f) + 64e-5f);
        const float bon = ((const float*)(R + R_BON))[(tg0 + tl) * 8 + hd]; const bool hp = (ck * 64 + tl > 0);
#pragma unroll
        for (int jt = 0; jt < 4; ++jt) { const int ch = hd * 64 + 16 * jt + 4 * fq;
            const bf16_t* src = P + (tg0 + tl) * EV_IN + 768 + 1024 + ch; const u32x2 cur = *(const u32x2*)src; u32x2 prv; prv.x = 0u; prv.y = 0u; if (hp) prv = *(const u32x2*)(src - EV_IN);
            const f32x4 mu = *(const f32x4*)(p.ev_mu + 1024 + ch), lw4 = *(const f32x4*)(p.ev_lnx_w + ch), lb4 = *(const f32x4*)(p.ev_lnx_b + ch);
            const float c0 = bflo(cur.x), c1 = bfhi(cur.x), c2 = bflo(cur.y), c3 = bfhi(cur.y), p0 = bflo(prv.x), p1 = bfhi(prv.x), p2 = bflo(prv.y), p3 = bfhi(prv.y);
            const float v0 = c0 + (p0 - c0) * mu.x, v1 = c1 + (p1 - c1) * mu.y, v2 = c2 + (p2 - c2) * mu.z, v3 = c3 + (p3 - c3) * mu.w;
            const f32x4 yy = y[jt][tt], gg = g[jt][tt];
            const float o0 = ((yy[0] - mean) * rs * lw4.x + lb4.x + bon * v0) * gg[0], o1 = ((yy[1] - mean) * rs * lw4.y + lb4.y + bon * v1) * gg[1];
            const float o2 = ((yy[2] - mean) * rs * lw4.z + lb4.z + bon * v2) * gg[2], o3 = ((yy[3] - mean) * rs * lw4.w + lb4.w + bon * v3) * gg[3];
            u32x2 w; w.x = pk2(o0, o1); w.y = pk2(o2, o3); *(u32x2*)(MIX + (tg0 + tl) * 1024 + 512 + ch) = w; } }
}

__device__ __forceinline__ void xattn_mfma(const Ctx& c, const Params& p, int unit) {
    const int b = unit >> 5, hh = (unit >> 3) & 3, tblk = unit & 7, tid = c.tid, lane = c.lane, wv = c.wave, fr = lane & 15, fq = lane >> 4;
    LAS bf16_t* Ks = (LAS bf16_t*)c.shm;
    LAS bf16_t* VTp = (LAS bf16_t*)(c.shm + 256 * 272);
    const bf16_t* MKV = (const bf16_t*)(p.ws + OFF_MKV); const bf16_t* Q = (const bf16_t*)(p.ws + OFF_P); bf16_t* OA = (bf16_t*)(p.ws + OFF_P + 32 * MiB);
    __syncthreads();
#pragma unroll 1
    for (int i = 0; i < 16; ++i) {
        const int task = tid + 512 * i, which = task >> 12, r = (task >> 4) & 255, ck = task & 15;
        const u32x4 d = *(const u32x4*)(MKV + ((size_t)b * MEMLEN + r) * 1024 + which * 512 + hh * 128 + ck * 8);
        if (which == 0) *(LAS u32x4*)(Ks + r * 136 + ck * 8) = d;
        else { const int kc = key_perm(r); const unsigned w[4] = {d.x, d.y, d.z, d.w};
#pragma unroll
            for (int k = 0; k < 4; ++k) { VTp[(ck * 8 + 2 * k) * 264 + kc] = (bf16_t)(w[k] & 0xFFFFu); VTp[(ck * 8 + 2 * k + 1) * 264 + kc] = (bf16_t)(w[k] >> 16); } }
    }
    __syncthreads();
#pragma unroll 1
    for (int qt = 0; qt < 4; ++qt) {
        const size_t tq = (size_t)b * SEQ + tblk * 512 + wv * 64 + qt * 16 + fr;
        bf16x8_t qf[4];
#pragma unroll
        for (int kk = 0; kk < 4; ++kk) qf[kk] = *(const bf16x8_t*)(Q + tq * 512 + hh * 128 + 32 * kk + 8 * fq);
        float qsc;
        { const f32x4* sp = (const f32x4*)((const float*)(p.ws + OFF_R + R_SSP) + tq * 16); const f32x4 s0 = sp[0], s1 = sp[1], s2 = sp[2], s3 = sp[3];
          const float ssq = ((s0.x + s0.y) + (s0.z + s0.w)) + ((s1.x + s1.y) + (s1.z + s1.w)) + ((s2.x + s2.y) + (s2.z + s2.w)) + ((s3.x + s3.y) + (s3.z + s3.w));
          qsc = 0.08838834764831845f / sqrtf(ssq * (1.0f / 1024.0f) + 1e-6f); }
        f32x4 s[16];
#pragma unroll
        for (int kt = 0; kt < 16; ++kt) { s[kt] = (f32x4){0.f, 0.f, 0.f, 0.f};
#pragma unroll
            for (int kk = 0; kk < 4; ++kk) s[kt] = __builtin_amdgcn_mfma_f32_16x16x32_bf16(lds_frag(Ks, 136, 16 * kt + fr, 32 * kk + 8 * fq), qf[kk], s[kt], 0, 0, 0);
            if (kt & 1) __builtin_amdgcn_sched_barrier(0); }
        float m = s[0][0];
#pragma unroll
        for (int kt = 0; kt < 16; ++kt) m = fmaxf(fmaxf(fmaxf(m, s[kt][0]), fmaxf(s[kt][1], s[kt][2])), s[kt][3]);
        m = fmaxf(m, __shfl_xor(m, 16)); m = fmaxf(m, __shfl_xor(m, 32));
        float den = 0.f;
#pragma unroll
        for (int kt = 0; kt < 16; ++kt)
#pragma unroll
            for (int r = 0; r < 4; ++r) { const float e = __expf((s[kt][r] - m) * qsc); s[kt][r] = e; den += e; }
        den += __shfl_xor(den, 16); den += __shfl_xor(den, 32);
        f32x4 o[8];
#pragma unroll
        for (int dt = 0; dt < 8; ++dt) o[dt] = (f32x4){0.f, 0.f, 0.f, 0.f};
#pragma unroll
        for (int sg = 0; sg < 8; ++sg) { const float pv[8] = {s[2 * sg][0], s[2 * sg][1], s[2 * sg][2], s[2 * sg][3], s[2 * sg + 1][0], s[2 * sg + 1][1], s[2 * sg + 1][2], s[2 * sg + 1][3]};
            const bf16x8_t pb = pack8(pv);
#pragma unroll
            for (int dt = 0; dt < 8; ++dt) o[dt] = __builtin_amdgcn_mfma_f32_16x16x32_bf16(lds_frag(VTp, 264, 16 * dt + fr, 32 * sg + 8 * fq), pb, o[dt], 0, 0, 0);
            __builtin_amdgcn_sched_barrier(0); }
        const float inv = 1.0f / den;
#pragma unroll
        for (int dt = 0; dt < 8; ++dt) { u32x2 w; w.x = pk2(o[dt][0] * inv, o[dt][1] * inv); w.y = pk2(o[dt][2] * inv, o[dt][3] * inv); *(u32x2*)(OA + tq * 512 + hh * 128 + 16 * dt + 4 * fq) = w; }
    }
}
__device__ __forceinline__ void swa_mfma(const Ctx& c, const Params& p, int unit) {
    const int b = unit >> 6, g = (unit >> 5) & 1, n = unit & 31, tid = c.tid, lane = c.lane, wv = c.wave, fr = lane & 15, fq = lane >> 4;
    LAS bf16_t* Ks = (LAS bf16_t*)c.shm;
    LAS bf16_t* VTp = (LAS bf16_t*)(c.shm + 256 * 144);
    const bf16_t* P = (const bf16_t*)(p.ws + OFF_P); bf16_t* MIX = (bf16_t*)(p.ws + OFF_H);
    __syncthreads();
#pragma unroll 1
    for (int i = 0; i < 8; ++i) {
        const int task = tid + 512 * i, which = task >> 11, r = (task >> 3) & 255, ck = task & 7;
        const int tk = n * 128 - 128 + r;
        u32x4 d = (u32x4){0u, 0u, 0u, 0u};
        if (tk >= 0) d = *(const u32x4*)(P + ((size_t)b * SEQ + tk) * EV_IN + 512 + which * 128 + g * 64 + ck * 8);
        if (which == 0) *(LAS u32x4*)(Ks + r * 72 + ck * 8) = d;
        else { const int kc = key_perm(r); const unsigned w[4] = {d.x, d.y, d.z, d.w};
#pragma unroll
            for (int k = 0; k < 4; ++k) { VTp[(ck * 8 + 2 * k) * 264 + kc] = (bf16_t)(w[k] & 0xFFFFu); VTp[(ck * 8 + 2 * k + 1) * 264 + kc] = (bf16_t)(w[k] >> 16); } }
    }
    __syncthreads();
#pragma unroll 1
    for (int it = 0; it < 4; ++it) {
        const int tile = wv * 4 + it, hql = tile >> 3, qb = tile & 7, head = g * 4 + hql, sg0 = qb >> 1;
        const int qi = 16 * qb + fr; const size_t tq = (size_t)b * SEQ + n * 128 + qi;
        const float sink = p.ev_sinks[head];
        bf16x8_t qf[2];
#pragma unroll
        for (int kk = 0; kk < 2; ++kk) qf[kk] = *(const bf16x8_t*)(P + tq * EV_IN + head * 64 + 32 * kk + 8 * fq);
        f32x4 s[10]; float m = sink;
#pragma unroll
        for (int i = 0; i < 10; ++i) { const int kt = 2 * sg0 + i; s[i] = (f32x4){0.f, 0.f, 0.f, 0.f};
#pragma unroll
            for (int kk = 0; kk < 2; ++kk) s[i] = __builtin_amdgcn_mfma_f32_16x16x32_bf16(lds_frag(Ks, 72, 16 * kt + fr, 32 * kk + 8 * fq), qf[kk], s[i], 0, 0, 0);
#pragma unroll
            for (int r = 0; r < 4; ++r) { const int kp = 16 * kt + 4 * fq + r; const bool valid = (kp >= qi + 1) && (kp <= qi + 128) && (n > 0 || kp >= 128);
                s[i][r] = valid ? s[i][r] * 0.125f : -INFINITY; m = fmaxf(m, s[i][r]); } }
        m = fmaxf(m, __shfl_xor(m, 16)); m = fmaxf(m, __shfl_xor(m, 32));
        float den = 0.f;
#pragma unroll
        for (int i = 0; i < 10; ++i)
#pragma unroll
            for (int r = 0; r < 4; ++r) { const float e = __expf(s[i][r] - m); s[i][r] = e; den += e; }
        den += __shfl_xor(den, 16); den += __shfl_xor(den, 32); den += __expf(sink - m);
        f32x4 o[4];
#pragma unroll
        for (int dt = 0; dt < 4; ++dt) o[dt] = (f32x4){0.f, 0.f, 0.f, 0.f};
#pragma unroll
        for (int i2 = 0; i2 < 5; ++i2) { const float pv[8] = {s[2 * i2][0], s[2 * i2][1], s[2 * i2][2], s[2 * i2][3], s[2 * i2 + 1][0], s[2 * i2 + 1][1], s[2 * i2 + 1][2], s[2 * i2 + 1][3]};
            const bf16x8_t pb = pack8(pv);
#pragma unroll
            for (int dt = 0; dt < 4; ++dt) o[dt] = __builtin_amdgcn_mfma_f32_16x16x32_bf16(lds_frag(VTp, 264, 16 * dt + fr, 32 * (sg0 + i2) + 8 * fq), pb, o[dt], 0, 0, 0); }
        const float inv = 1.0f / den;
#pragma unroll
        for (int dt = 0; dt < 4; ++dt) { u32x2 w; w.x = pk2(o[dt][0] * inv, o[dt][1] * inv); w.y = pk2(o[dt][2] * inv, o[dt][3] * inv); *(u32x2*)(MIX + tq * 1024 + head * 64 + 16 * dt + 4 * fq) = w; }
    }
}

constexpr size_t WSM_RT = 640 * 1024;
constexpr size_t CTL_WGCNT = 256 * 1024;
__device__ __forceinline__ void split8(const f32x4 a, const f32x4 b, bf16x8_t& hi, bf16x8_t& lo) {
    const float x[8] = {a.x, a.y, a.z, a.w, b.x, b.y, b.z, b.w}; float h[8], l[8];
#pragma unroll
    for (int i = 0; i < 8; ++i) { h[i] = bf2f(f2bf(x[i])); l[i] = x[i] - h[i]; }
    hi = pack8(h); lo = pack8(l);
}
__device__ __forceinline__ void moe_route(const Ctx& c, const Params& p, int layer) {
    const int lane = c.lane, wv = c.wave, fr = lane & 15, fq = lane >> 4;
    LAS float* LG = (LAS float*)c.shm + wv * (16 * 48 + 16);
    LAS float* RS = LG + 16 * 48;
    LAS int* hist = (LAS int*)(c.shm + 32 * 1024);
    if (c.tid < 32) hist[c.tid] = 0;
    __syncthreads();
    const int t0 = blockIdx.x * 128 + wv * 16;
    const float* xr = p.out + (size_t)(t0 + fr) * 1024 + 8 * fq;
    const bf16_t* TH = (const bf16_t*)(p.ws + OFF_WSMALL + WSM_RT) + (size_t)layer * 2 * 48 * 1024; const bf16_t* TL = TH + 48 * 1024;
    f32x4 acc[3];
#pragma unroll
    for (int i = 0; i < 3; ++i) acc[i] = (f32x4){0.f, 0.f, 0.f, 0.f};
    float ss = 0.f;
#pragma unroll 2
    for (int kk = 0; kk < 32; ++kk) {
        const f32x4 a = *(const f32x4*)(xr + 32 * kk), bq = *(const f32x4*)(xr + 32 * kk + 4);
        ss += (a.x * a.x + a.y * a.y) + (a.z * a.z + a.w * a.w) + (bq.x * bq.x + bq.y * bq.y) + (bq.z * bq.z + bq.w * bq.w);
        bf16x8_t xh, xl; split8(a, bq, xh, xl);
#pragma unroll
        for (int ct = 0; ct < 3; ++ct) { const bf16x8_t wh = *(const bf16x8_t*)(TH + (size_t)(16 * ct + fr) * 1024 + 32 * kk + 8 * fq), wl = *(const bf16x8_t*)(TL + (size_t)(16 * ct + fr) * 1024 + 32 * kk + 8 * fq);
            acc[ct] = __builtin_amdgcn_mfma_f32_16x16x32_bf16(xh, wh, acc[ct], 0, 0, 0); acc[ct] = __builtin_amdgcn_mfma_f32_16x16x32_bf16(xh, wl, acc[ct], 0, 0, 0); acc[ct] = __builtin_amdgcn_mfma_f32_16x16x32_bf16(xl, wh, acc[ct], 0, 0, 0); }
    }
    ss += __shfl_xor(ss, 16); ss += __shfl_xor(ss, 32);
    const float rstd = 1.0f / sqrtf(ss * (1.0f / 1024.0f) + 1e-6f);
    if (fq == 0) RS[fr] = rstd;
    LDS_WAIT();
#pragma unroll
    for (int ct = 0; ct < 3; ++ct)
#pragma unroll
        for (int r = 0; r < 4; ++r) LG[(4 * fq + r) * 48 + 16 * ct + fr] = acc[ct][r] * RS[4 * fq + r];
    LDS_WAIT();
    if (lane < 16) { int e0, e1; float g0, g1; route_row(LG + lane * 48, p.moe_b_group + layer * 4, p.moe_b_expert + layer * 32, e0, e1, g0, g1);
        const int t = t0 + lane; ((float*)(p.ws + OFF_ROUTE + ROUTE_RS))[t] = RS[lane]; ((int2*)(p.ws + OFF_ROUTE))[t] = make_int2(e0, e1); ((float2*)(p.ws + OFF_ROUTE + 256 * 1024))[t] = make_float2(g0, g1);
        atomicAdd((int*)&hist[e0], 1); atomicAdd((int*)&hist[e1], 1); }
    __syncthreads();
    if (c.tid < 32) ((int*)(p.ws + OFF_CTL + CTL_WGCNT))[(layer * 256 + blockIdx.x) * 32 + c.tid] = hist[c.tid];
}
__device__ __forceinline__ void moe_slots2(const Ctx& c, const Params& p, int layer) {
    LAS int* part = (LAS int*)c.shm;
    LAS int* base = part + 1024;
    LAS int* lcnt = base + 32;
    LAS int* posl = lcnt + 32;
    LAS int* pst = posl + 256;
    const int* wc = (const int*)(p.ws + OFF_CTL + CTL_WGCNT) + layer * 256 * 32; const int bid = blockIdx.x;
    __syncthreads();
    { const int e = c.tid & 31, pt = c.tid >> 5; int sa = 0, sb = 0;
      for (int w = pt * 16; w < pt * 16 + 16; ++w) { const int v = wc[w * 32 + e]; sa += v; sb += (w < bid) ? v : 0; }
      part[pt * 32 + e] = sa; part[512 + pt * 32 + e] = sb; }
    if (c.tid < 32) lcnt[c.tid] = 0;
    __syncthreads();
    if (c.tid < 32) { int sa = 0, sb = 0; for (int q = 0; q < 16; ++q) { sa += part[q * 32 + c.tid]; sb += part[512 + q * 32 + c.tid]; } part[c.tid] = sa; part[512 + c.tid] = sb; }
    __syncthreads();
    if (c.tid == 0) { int acc = 0; for (int e = 0; e < NEXP; ++e) { pst[e] = acc; acc += (part[e] + 255) / 256 * 256; } pst[32] = acc; }
    __syncthreads();
    if (c.tid < 32) base[c.tid] = pst[c.tid] + part[512 + c.tid];
    if (bid == 0 && c.tid < NEXP) { int* blk = (int*)(p.ws + OFF_CTL + CTL_BLK) + layer * 1024; const int e = c.tid, s = pst[e] / 256, en = pst[e + 1] / 256; for (int i = s; i < en; ++i) blk[1 + i] = e; if (e == 0) blk[0] = pst[32] / 256; }
    __syncthreads();
    if (c.tid < 256) { const int t = bid * 128 + (c.tid >> 1); const int2 ee = ((const int2*)(p.ws + OFF_ROUTE))[t]; const int e = (c.tid & 1) ? ee.y : ee.x;
        const int rk = atomicAdd((int*)&lcnt[e], 1); posl[c.tid] = base[e] + rk; }
    __syncthreads();
    if (c.tid < 128) ((int2*)(p.ws + OFF_ROUTE + 512 * 1024))[bid * 128 + c.tid] = make_int2(posl[2 * c.tid], posl[2 * c.tid + 1]);
    if (c.tid < 256) ((float*)(p.ws + OFF_R + R_RSS))[posl[c.tid]] = ((const float*)(p.ws + OFF_ROUTE + ROUTE_RS))[bid * 128 + (c.tid >> 1)];
    const bf16_t* H = (const bf16_t*)(p.ws + OFF_H); bf16_t* XB = (bf16_t*)(p.ws + OFF_P);
#pragma unroll 4
    for (int i = 0; i < 16; ++i) { const int tl = c.wave * 16 + i; const size_t t = (size_t)bid * 128 + tl; const int q0 = posl[2 * tl], q1 = posl[2 * tl + 1];
        const u32x4 a = *((const u32x4*)(H + t * 1024) + c.lane), bq = *((const u32x4*)(H + t * 1024) + 64 + c.lane);
        *((u32x4*)(XB + (size_t)q0 * 1024) + c.lane) = a; *((u32x4*)(XB + (size_t)q0 * 1024) + 64 + c.lane) = bq;
        *((u32x4*)(XB + (size_t)q1 * 1024) + c.lane) = a; *((u32x4*)(XB + (size_t)q1 * 1024) + 64 + c.lane) = bq; }
}


constexpr size_t WSM_TGD = 128 * 1024, WSM_GUT = 192 * 1024;
__device__ __forceinline__ void combine_gk(const Ctx& c, const Params& p) {
    const int lane = c.lane, wv = c.wave, fr = lane & 15, fq = lane >> 4;
    LAS float* LG = (LAS float*)c.shm + wv * (16 * 16 + 16);
    LAS float* RS = LG + 256;
    const int t0 = blockIdx.x * 128 + wv * 16; const int trow = t0 + fr;
    float* xr = p.out + (size_t)trow * 1024 + 8 * fq;
    const int2 ps = ((const int2*)(p.ws + OFF_ROUTE + 512 * 1024))[trow]; const float2 gt = ((const float2*)(p.ws + OFF_ROUTE + 256 * 1024))[trow];
    const bf16_t* y0 = (const bf16_t*)(p.ws + OFF_P) + (size_t)ps.x * 1024 + 8 * fq; const bf16_t* y1 = (const bf16_t*)(p.ws + OFF_P) + (size_t)ps.y * 1024 + 8 * fq;
    const bf16_t* TH = (const bf16_t*)(p.ws + OFF_WSMALL + WSM_TGD); const bf16_t* TL = TH + 16 * 1024;
    bf16_t* hr = (bf16_t*)(p.ws + OFF_H) + (size_t)trow * 1024 + 8 * fq;
    f32x4 acc = (f32x4){0.f, 0.f, 0.f, 0.f}; float ss = 0.f;
#pragma unroll 4
    for (int kk = 0; kk < 32; ++kk) {
        f32x4 a = *(const f32x4*)(xr + 32 * kk), bq = *(const f32x4*)(xr + 32 * kk + 4);
        const u32x4 u0 = *(const u32x4*)(y0 + 32 * kk), u1 = *(const u32x4*)(y1 + 32 * kk);
        a.x += gt.x * bflo(u0.x) + gt.y * bflo(u1.x); a.y += gt.x * bfhi(u0.x) + gt.y * bfhi(u1.x); a.z += gt.x * bflo(u0.y) + gt.y * bflo(u1.y); a.w += gt.x * bfhi(u0.y) + gt.y * bfhi(u1.y);
        bq.x += gt.x * bflo(u0.z) + gt.y * bflo(u1.z); bq.y += gt.x * bfhi(u0.z) + gt.y * bfhi(u1.z); bq.z += gt.x * bflo(u0.w) + gt.y * bflo(u1.w); bq.w += gt.x * bfhi(u0.w) + gt.y * bfhi(u1.w);
        *(f32x4*)(xr + 32 * kk) = a; *(f32x4*)(xr + 32 * kk + 4) = bq;
        { u32x4 w; w.x = pk2(a.x, a.y); w.y = pk2(a.z, a.w); w.z = pk2(bq.x, bq.y); w.w = pk2(bq.z, bq.w); *(u32x4*)(hr + 32 * kk) = w; }
        ss += (a.x * a.x + a.y * a.y) + (a.z * a.z + a.w * a.w) + (bq.x * bq.x + bq.y * bq.y) + (bq.z * bq.z + bq.w * bq.w);
        bf16x8_t xh, xl; split8(a, bq, xh, xl);
        const bf16x8_t wh = *(const bf16x8_t*)(TH + (size_t)fr * 1024 + 32 * kk + 8 * fq), wl = *(const bf16x8_t*)(TL + (size_t)fr * 1024 + 32 * kk + 8 * fq);
        acc = __builtin_amdgcn_mfma_f32_16x16x32_bf16(xh, wh, acc, 0, 0, 0); acc = __builtin_amdgcn_mfma_f32_16x16x32_bf16(xh, wl, acc, 0, 0, 0); acc = __builtin_amdgcn_mfma_f32_16x16x32_bf16(xl, wh, acc, 0, 0, 0);
    }
    ss += __shfl_xor(ss, 16); ss += __shfl_xor(ss, 32);
    const float rstd = 1.0f / sqrtf(ss * (1.0f / 1024.0f) + 1e-6f);
    if (fq == 0) { RS[fr] = rstd; ((float*)(p.ws + OFF_ROUTE + ROUTE_RS))[trow] = rstd; }
    LDS_WAIT();
#pragma unroll
    for (int r = 0; r < 4; ++r) LG[(4 * fq + r) * 16 + fr] = acc[r] * RS[4 * fq + r];
    LDS_WAIT();
    bf16x8_t gh = zero_frag(), gl = zero_frag();
    if (fq < 2) { const f32x4 a = *(const LAS f32x4*)(LG + fr * 16 + 8 * fq), bq = *(const LAS f32x4*)(LG + fr * 16 + 8 * fq + 4); split8(a, bq, gh, gl); }
    const bf16_t* UH = (const bf16_t*)(p.ws + OFF_WSMALL + WSM_GUT); const bf16_t* UL = UH + 512 * 16;
    float* gk = (float*)(p.ws + OFF_R + R_GK) + (size_t)trow * 512 + 4 * fq;
#pragma unroll 4
    for (int ct = 0; ct < 32; ++ct) {
        bf16x8_t uh = zero_frag(), ul = zero_frag();
        if (fq < 2) { uh = *(const bf16x8_t*)(UH + (16 * ct + fr) * 16 + 8 * fq); ul = *(const bf16x8_t*)(UL + (16 * ct + fr) * 16 + 8 * fq); }
        f32x4 g = *(const f32x4*)(p.od_gate_b + 16 * ct + 4 * fq);
        g = __builtin_amdgcn_mfma_f32_16x16x32_bf16(uh, gh, g, 0, 0, 0); g = __builtin_amdgcn_mfma_f32_16x16x32_bf16(uh, gl, g, 0, 0, 0); g = __builtin_amdgcn_mfma_f32_16x16x32_bf16(ul, gh, g, 0, 0, 0);
#pragma unroll
        for (int r = 0; r < 4; ++r) { const float xx = g[r]; g[r] = (fminf(xx, 0.f) - __logf(1.0f + __expf(-fabsf(xx)))) * (1.0f / 16.0f); }
        *(f32x4*)(gk + 16 * ct) = g;
    }
}

constexpr int LDS_BYTES = 160 * 1024 - 64;
constexpr int N_PHASES = 25;

typedef const __attribute__((address_space(4))) Params* KParamsPtr;
__device__ __forceinline__ Params kparams() {
#if defined(__HIP_DEVICE_COMPILE__)
    KParamsPtr k = (KParamsPtr)__builtin_amdgcn_kernarg_segment_ptr(); asm volatile("" : "+s"(k)); return *k;
#else
    return Params{};
#endif
}
__device__ __forceinline__ Ctx mkctx(unsigned char* shm) {
    int tz = threadIdx.x; asm volatile("" : "+v"(tz));
    Ctx c; c.tid = tz; c.wave = __builtin_amdgcn_readfirstlane(tz >> 6); c.lane = tz & 63; c.gw = blockIdx.x * 8 + c.wave; c.ngw = 2048; c.shm = shm; return c;
}
__global__ void __launch_bounds__(512, 2) hybrid_fwd(Params p_in) {
    extern __shared__ __attribute__((aligned(16))) unsigned char shm[];
    constexpr int G = 256; const int bid = blockIdx.x;
    uint4* xbw = (uint4*)(shm + LDS_BYTES - 16);
    if (threadIdx.x == 0) *xbw = make_uint4(0u, 0u, 0u, 0u);
    __syncthreads();
    XcdBarrier bar = xcd_barrier_post((unsigned*)(kparams().ws + OFF_CTL), (volatile LAS unsigned*)xbw);
#ifndef KEEPMASK
#define KEEPMASK 0xFFFFFFFFu
#endif
#define INS(k, s) (((KEEPMASK) >> (s)) & 1u)
#ifndef REPMASK
#define REPMASK 0u
#endif
#define REP(s) ((((REPMASK) >> (s)) & 1u) ? 3 : 1)
#define SEAM(k) do { XcdBarrier b2 = bar; b2.bar = (unsigned*)(kparams().ws + OFF_CTL); xcd_barrier(b2); } while (0)
#define PHASE_BEGIN const Params p = kparams(); const Ctx c = mkctx(shm); unsigned char* const ws = p.ws; (void)c; (void)ws;
#define glds ((PG8_LAS unsigned char*)shm)
#define WD ((bf16_t*)(ws + OFF_WD))
#define H ((bf16_t*)(ws + OFF_H))
#define P ((bf16_t*)(ws + OFF_P))
#define WS_F ((float*)(ws + OFF_WSMALL))
#define RE ((int2*)(ws + OFF_ROUTE))
#define RG ((float2*)(ws + OFF_ROUTE + 256 * 1024))
#define RP ((int2*)(ws + OFF_ROUTE + 512 * 1024))

    for (int layer = 0; layer < 2; ++layer) {
        const int pb = layer * 12;
        if (layer == 0) {
            if (INS(0, 0)) for (int rep_ = 0; rep_ < REP(0); ++rep_) { PHASE_BEGIN
                tr_matrix(c, p.ev_w_in, EV_IN, 0, 1024, EV_IN, WD + WE_EV_IN, 0, 0);
                tr_matrix(c, p.ev_w_out, 1024, 0, 1024, 1024, WD + WE_EV_OUT, 0, 0);
                tr_matrix(c, p.od_w_in, OD_IN_SRC, 0, 1024, OD_IN, WD + WE_OD_IN, 0, 1, p.norm_mix + 1024);
                tr_matrix(c, p.od_w_out, 1024, 0, 1024, 1024, WD + WE_OD_OUT, 0, 0);
                tr_matrix(c, p.mem_wk, 512, 0, 1024, 512, WD + WE_MKV, 0, 0);
                tr_matrix(c, p.mem_wv, 512, 0, 1024, 512, WD + WE_MKV, 512, 0);
                for (int l = 0; l < 2; ++l) {
                    tr_matrix(c, p.xa_wq + (size_t)l * 1024 * 512, 512, 0, 1024, 512, WD + WE_WQ + (size_t)l * 512 * 1024, 0, 0, p.norm_xattn + l * 1024);
                    tr_matrix(c, p.xa_wo + (size_t)l * 512 * 1024, 1024, 0, 512, 1024, WD + WE_WO + (size_t)l * 1024 * 512, 0, 0);
                }
                tr_moe_layer(c, p, 0);
                for (int i = bid * 512 + c.tid; i < 16 * 1024 + 512 * 16; i += G * 512) {
                    if (i < 16 * 1024) { const int o = i >> 10, k = i & 1023; const float w = p.od_w_in[(size_t)k * OD_IN_SRC + 2048 + o] * p.norm_mix[1024 + k]; const unsigned hb = f2bf(w);
                        bf16_t* T = (bf16_t*)(ws + OFF_WSMALL + WSM_TGD); T[i] = (bf16_t)hb; T[16 * 1024 + i] = (bf16_t)f2bf(w - bf2f(hb)); }
                    else { const int r = i - 16 * 1024, ch = r >> 4, o = r & 15; const float w = p.od_gate_up[o * 512 + ch]; const unsigned hb = f2bf(w);
                        bf16_t* T = (bf16_t*)(ws + OFF_WSMALL + WSM_GUT); T[r] = (bf16_t)hb; T[512 * 16 + r] = (bf16_t)f2bf(w - bf2f(hb)); } }
                for (int i = bid * 512 + c.tid; i < 2 * 48 * 1024; i += G * 512) { const int l = i / (48 * 1024), r = i % (48 * 1024), o = r >> 10, k = r & 1023;
                    float w = 0.f; if (o < 4) w = p.moe_w_group[((size_t)l * 1024 + k) * 4 + o]; else if (o < 36) w = p.moe_w_expert[((size_t)l * 1024 + k) * 32 + (o - 4)];
                    w *= p.norm_moe[l * 1024 + k]; const unsigned hb = f2bf(w); bf16_t* T = (bf16_t*)(ws + OFF_WSMALL + WSM_RT) + (size_t)l * 2 * 48 * 1024;
                    T[r] = (bf16_t)hb; T[48 * 1024 + r] = (bf16_t)f2bf(w - bf2f(hb)); }
                for (int i = bid * 512 + c.tid; i < 2 * 512 * 64; i += G * 512) { const int wh = i >> 15, r = i & 32767, ch = r >> 6, k = r & 63;
                    ((bf16_t*)(ws + OFF_WSMALL + (wh ? WSM_A2T : WSM_W2T)))[r] = (bf16_t)f2bf((wh ? p.ev_a2 : p.ev_w2)[(size_t)k * 512 + ch]); }
                norm_plain(c, p.mem, p.mem_norm, (bf16_t*)(ws + OFF_R + R_MEMN), NB * MEMLEN);
                for (int i = bid * 512 + c.tid; i < 512 * 128; i += G * 512) { const int ch = i >> 7, m = i & 127; ((bf16_t*)(ws + OFF_WSMALL + WSM_G2T))[i] = (bf16_t)f2bf(p.ev_g2[(size_t)m * 512 + ch]); }
                norm_plain(c, p.x, p.norm_mix, H, T_TOK);
                __syncthreads();
                SEAM(0);
            }
            if (INS(1, 1)) for (int rep_ = 0; rep_ < REP(1); ++rep_) { PHASE_BEGIN
                { pg8::Gemm g{H, WD + WE_EV_IN, T_TOK, EV_IN, 1024, 0}; pg8::StaticOrder S; S.init(T_TOK, EV_IN, G, bid);
                  pg8::EpiB16 E{P, EV_IN, nullptr}; pg8::gemm_phase<pg8::EpiB16, pg8::StaticOrder, true, true>(glds, g, S, E); }
                SEAM(1);
            }
            if (INS(2, 2)) for (int rep_ = 0; rep_ < REP(2); ++rep_) { PHASE_BEGIN
#ifdef RWKV_NAIVE
                if (bid < 64) rwkv_naive(c, p, bid);
                else
#else
                for (int u = bid; u < 4096; u += G) rwkv_x(c, p, u);
                __syncthreads();
                SEAM(2);
            }
            if (INS(2, 16)) for (int rep_ = 0; rep_ < REP(16); ++rep_) { PHASE_BEGIN
                if (bid < 64) { if (c.wave < 4) rwkv_y(c, p, bid, c.wave); }
                else
#endif
                {
                    for (int u = bid - 64; u < 512; u += G - 64) swa_mfma(c, p, u);
                    __syncthreads();
                    if (bid < 96) {
                        pg8::Gemm g{(const bf16_t*)(ws + OFF_R + R_MEMN), WD + WE_MKV, NB * MEMLEN, 1024, 1024, 0}; pg8::StaticOrder S; S.init(NB * MEMLEN, 1024, 32, bid - 64);
                        pg8::EpiB16 E{(bf16_t*)(ws + OFF_MKV), 1024, nullptr}; pg8::gemm_phase<pg8::EpiB16, pg8::StaticOrder, true, true>(glds, g, S, E); }
                }
#ifndef RWKV_NAIVE
                __syncthreads();
                SEAM(2);
            }
            if (INS(2, 17)) for (int rep_ = 0; rep_ < REP(17); ++rep_) { PHASE_BEGIN
                for (int u = c.gw; u < 4096; u += c.ngw) rwkv_z(c, p, u);
#endif
                __syncthreads();
                SEAM(2);
            }
        } else {
            if (INS(12, 12)) for (int rep_ = 0; rep_ < REP(12); ++rep_) { PHASE_BEGIN
                combine_gk(c, p);
                tr_moe_layer(c, p, 1);
                __syncthreads();
                SEAM(12);
            }
            if (INS(13, 13)) for (int rep_ = 0; rep_ < REP(13); ++rep_) { PHASE_BEGIN
                pg8::Gemm g{H, WD + WE_OD_IN, T_TOK, OD_IN, 1024, 0}; pg8::StaticOrder S; S.init(T_TOK, OD_IN, G, bid);
                pg8::EpiB16 E{P, OD_IN, (const float*)(ws + OFF_ROUTE + ROUTE_RS)};   pg8::gemm_phase<pg8::EpiB16, pg8::StaticOrder, true, true>(glds, g, S, E);
                SEAM(13);
            }
            if (INS(14, 14)) for (int rep_ = 0; rep_ < REP(14); ++rep_) { PHASE_BEGIN
#ifdef GLA_NAIVE
                if (bid < 32) gla_naive(c, p, bid);
                __syncthreads();
                SEAM(14);
#else
                for (int u = bid; u < 2048; u += G) gla_prep(c, p, u);
                __syncthreads();
                SEAM(14);
#endif
            }
#ifndef GLA_NAIVE
            if (INS(14, 18)) for (int rep_ = 0; rep_ < REP(18); ++rep_) { PHASE_BEGIN
                if (bid < 128) gla_state(c, p, bid >> 2, bid & 3);
                __syncthreads();
                SEAM(14);
            }
            if (INS(14, 19)) for (int rep_ = 0; rep_ < REP(19); ++rep_) { PHASE_BEGIN
                gla_finish(c, p);
                __syncthreads();
                SEAM(14);
            }
#endif
        }
        if (INS(pb + 3, 3)) for (int rep_ = 0; rep_ < REP(3); ++rep_) { PHASE_BEGIN
            pg8::Gemm g{H, WD + (layer == 0 ? WE_EV_OUT : WE_OD_OUT), T_TOK, 1024, 1024, 0}; pg8::StaticOrder S; S.init(T_TOK, 1024, G, bid);
            pg8::EpiRes E{layer == 0 ? p.x : p.out, p.out, 1024, (bf16_t*)(ws + OFF_P + P_XB1), (float*)(ws + OFF_R + R_SSP)}; pg8::gemm_phase<pg8::EpiRes, pg8::StaticOrder, true, true>(glds, g, S, E);
            SEAM(pb + 3);
        }
        if (INS(pb + 5, 5)) for (int rep_ = 0; rep_ < REP(5); ++rep_) { PHASE_BEGIN
            pg8::Gemm g{(const bf16_t*)(ws + OFF_P + P_XB1), WD + WE_WQ + (size_t)layer * 512 * 1024, T_TOK, 512, 1024, 0}; pg8::StaticOrder S; S.init(T_TOK, 512, G, bid);
            pg8::EpiB16 E{P, 512, nullptr}; pg8::gemm_phase<pg8::EpiB16, pg8::StaticOrder, true, true>(glds, g, S, E);
            SEAM(pb + 5);
        }
        if (INS(pb + 6, 6)) for (int rep_ = 0; rep_ < REP(6); ++rep_) { PHASE_BEGIN for (int u = bid; u < 256; u += G) xattn_mfma(c, p, u); __syncthreads(); SEAM(pb + 6); }
        if (INS(pb + 7, 7)) for (int rep_ = 0; rep_ < REP(7); ++rep_) { PHASE_BEGIN
            pg8::Gemm g{(const bf16_t*)(ws + OFF_P + 32 * MiB), WD + WE_WO + (size_t)layer * 1024 * 512, T_TOK, 1024, 512, 0}; pg8::StaticOrder S; S.init(T_TOK, 1024, G, bid);
            pg8::EpiRes E{p.out, p.out, 1024, H, nullptr};   pg8::gemm_phase<pg8::EpiRes, pg8::StaticOrder, true, true>(glds, g, S, E);
            SEAM(pb + 7);
        }
        if (INS(pb + 8, 8)) for (int rep_ = 0; rep_ < REP(8); ++rep_) { PHASE_BEGIN
            moe_route(c, p, layer);
            __syncthreads();
            SEAM(pb + 8);
        }
        if (INS(pb + 9, 9)) for (int rep_ = 0; rep_ < REP(9); ++rep_) { PHASE_BEGIN moe_slots2(c, p, layer); __syncthreads(); SEAM(pb + 9); }
        if (INS(pb + 10, 10)) for (int rep_ = 0; rep_ < REP(10); ++rep_) { PHASE_BEGIN
            const int* blk = (const int*)(ws + OFF_CTL + CTL_BLK) + layer * 1024; const int nblk = blk[0];
            pg8::Gemm g{P, (const bf16_t*)(ws + OFF_WMOE), nblk * 256, 1024, 1024, (size_t)1024 * 1024 * 2}; pg8::MoeOrder S{blk + 1, nblk * 4, 4, G, bid};
            pg8::EpiSwiglu E{(bf16_t*)(ws + OFF_R), 512, (const float*)(ws + OFF_R + R_RSS)}; pg8::gemm_phase<pg8::EpiSwiglu, pg8::MoeOrder, true, true>(glds, g, S, E);
            SEAM(pb + 10);
        }
        if (INS(pb + 11, 11)) for (int rep_ = 0; rep_ < REP(11); ++rep_) { PHASE_BEGIN
            const int* blk = (const int*)(ws + OFF_CTL + CTL_BLK) + layer * 1024; const int nblk = blk[0];
            pg8::Gemm g{(const bf16_t*)(ws + OFF_R), (const bf16_t*)(ws + OFF_WMOE + 64 * MiB), nblk * 256, 1024, 512, (size_t)1024 * 512 * 2}; pg8::MoeOrder S{blk + 1, nblk * 4, 4, G, bid};
            pg8::EpiB16 E{P, 1024, nullptr}; pg8::gemm_phase<pg8::EpiB16, pg8::MoeOrder, true, true>(glds, g, S, E);
            SEAM(pb + 11);
        }
    }
    if (INS(24, 15)) for (int rep_ = 0; rep_ < REP(15); ++rep_) { PHASE_BEGIN
        for (int r = c.gw; r < T_TOK; r += c.ngw) {
            f32x4 v[4]; row_load(p.out + (size_t)r * 1024, c.lane, v);
            const int2 ps = RP[r]; const float2 gt = RG[r];
            row_combine(v, P, ps.x, ps.y, gt.x, gt.y, c.lane);
            const float rs = row_rstd(v); row_scale(v, rs, p.norm_final, c.lane); row_store_f32(p.out + (size_t)r * 1024, c.lane, v);
        }
    }
}

extern "C" void kernel_launch(void* const* d_in, const int* in_sizes, int n_in, void* d_out, int out_size, void* d_ws, size_t ws_size, hipStream_t stream) {
    static int ready = 0;
    if (ready == 0) {
        if (n_in != 37 || out_size != T_TOK * DM || ws_size < WS_NEED) { fprintf(stderr, "kernel_launch: unexpected problem (n_in %d, out %d, ws %zu)\n", n_in, out_size, ws_size); ready = -1; return; }
        if (hipFuncSetAttribute((const void*)hybrid_fwd, hipFuncAttributeMaxDynamicSharedMemorySize, LDS_BYTES) != hipSuccess) { fprintf(stderr, "kernel_launch: hipFuncSetAttribute failed\n"); ready = -1; return; }
        ready = 1;
    }
    if (ready < 0) return;
    hipMemsetAsync((char*)d_ws + OFF_CTL, 0, CTL_ZERO_BYTES, stream);
    Params p{};
    const float** f = (const float**)&p;
    for (int i = 0; i < 37; ++i) f[i] = (const float*)d_in[i];
    p.out = (float*)d_out; p.ws = (unsigned char*)d_ws; p.ph_lo = 0; p.ph_hi = N_PHASES;
    hipLaunchKernelGGL(hybrid_fwd, dim3(256), dim3(512), LDS_BYTES, stream, p);
}
```

```cpp
#include <hip/hip_runtime.h>
#include <cstdint>
#include <cstdio>

#define LAS __attribute__((address_space(3)))
typedef unsigned short bf16_t;
typedef float f32x4 __attribute__((ext_vector_type(4)));
typedef float f32x2 __attribute__((ext_vector_type(2)));
typedef unsigned u32x4 __attribute__((ext_vector_type(4)));
typedef unsigned u32x2 __attribute__((ext_vector_type(2)));

constexpr int T_TOK = 32768, DM = 1024, SEQ = 4096, NB = 8, MEMLEN = 256;
constexpr int EV_IN = 2560, OD_IN = 3072  , OD_IN_SRC = 3088;
constexpr int NEXP = 32, MOE_FF = 512, PMAX = 65536 + NEXP * 256;

constexpr size_t MiB = 1024 * 1024;
constexpr size_t OFF_CTL = 0;
constexpr size_t CTL_ZERO_BYTES = 64 * 1024;
constexpr size_t CTL_CNT = 16384;
constexpr size_t CTL_CUR = 16384 + 1024;
constexpr size_t CTL_BLK = 128 * 1024;
constexpr size_t OFF_ROUTE = 1 * MiB;
constexpr size_t OFF_WSMALL = 2 * MiB;
constexpr size_t OFF_MKV = 3 * MiB;
constexpr size_t OFF_WD = 7 * MiB;
constexpr size_t OFF_WMOE = 28 * MiB;
constexpr size_t OFF_H = 124 * MiB;
constexpr size_t OFF_P = 188 * MiB;
constexpr size_t OFF_R = 380 * MiB;
constexpr size_t WS_NEED = 452 * MiB;
constexpr size_t WE_EV_IN = 0, WE_EV_OUT = 2560ull * 1024, WE_OD_IN = 3584ull * 1024, WE_OD_OUT = 6656ull * 1024, WE_MKV = 7680ull * 1024, WE_WQ = 8704ull * 1024, WE_WO = 9728ull * 1024;

constexpr size_t ROUTE_RS = 768 * 1024;
constexpr size_t R_SSP = 0, R_RSS = 80 * MiB;
constexpr size_t P_XB1 = 64 * MiB;
struct Params {
    const float *x, *mem, *norm_mix, *norm_xattn, *norm_moe, *norm_final;
    const float *ev_w_in, *ev_sinks, *ev_mu, *ev_w0, *ev_w2, *ev_a0, *ev_a2, *ev_g2, *ev_k_k, *ev_k_a, *ev_r_k, *ev_lnx_w, *ev_lnx_b, *ev_w_out;
    const float *od_w_in, *od_gate_up, *od_gate_b, *od_onorm, *od_w_out;
    const float *mem_norm, *mem_wk, *mem_wv, *xa_wq, *xa_wo;
    const float *moe_w_group, *moe_b_group, *moe_w_expert, *moe_b_expert, *moe_w1, *moe_w3, *moe_w2;
    float* out; unsigned char* ws; int ph_lo, ph_hi;
};

#define XB_TMO      128
#define XB_XCNT(j)  (256  + 64 * (j))
#define XB_XSUB(j)  (1280 + 64 * (j))
#define XB_XGEN(j)  (2304 + 64 * (j))
#define XB_TOP      3328
#define XB_TOPGEN   3392
#define XCD_BAR_WORDS 3456
#define XB_SPIN_CAP (1u << 18)
#define LAS __attribute__((address_space(3)))

__device__ __forceinline__ unsigned xb_ld(unsigned* p)              { return __hip_atomic_load(p, __ATOMIC_RELAXED, __HIP_MEMORY_SCOPE_AGENT); }
__device__ __forceinline__ unsigned xb_add(unsigned* p, unsigned v) { return __hip_atomic_fetch_add(p, v, __ATOMIC_RELAXED, __HIP_MEMORY_SCOPE_AGENT); }
__device__ __forceinline__ unsigned xb_xcc_id() { return (unsigned)__builtin_amdgcn_s_getreg((3 << 11) | 20) & 0xFu; }
#define XB_SPIN(cond, bar) do { unsigned _sp = 0; while (cond) { __builtin_amdgcn_s_sleep(1); \
    if ((++_sp & 255u) == 0u) { if (xb_ld(&(bar)[XB_TMO])) break; if (_sp > XB_SPIN_CAP) { atomicAdd(&(bar)[XB_TMO], 1u); break; } } } } while (0)

struct XcdBarrier {
    unsigned* bar; unsigned x;
    volatile LAS unsigned* st;
};

__device__ __forceinline__ XcdBarrier xcd_barrier_post(unsigned* bar, volatile LAS unsigned* st) {
    XcdBarrier b; b.bar = bar; b.x = xb_xcc_id(); b.st = st;
    if (threadIdx.x == 0) (void)xb_add(&bar[XB_XCNT(b.x)], 1u);
    return b;
}
__device__ __forceinline__ void xcd_barrier_complete(unsigned* bar, unsigned x, unsigned& nloc, unsigned& nx) {
    const unsigned G = gridDim.x * gridDim.y * gridDim.z;
    unsigned sum, cnt, mine, sp = 0u;
    for (;;) {
        sum = 0u; cnt = 0u; mine = 0u;
#pragma unroll
        for (unsigned j = 0; j < 16; ++j) { const unsigned c = xb_ld(&bar[XB_XCNT(j)]); sum += c; cnt += (c > 0u) ? 1u : 0u; mine = (j == x) ? c : mine; }
        if (sum == G) break;
        __builtin_amdgcn_s_sleep(1);
        if ((++sp & 255u) == 0u) { if (xb_ld(&bar[XB_TMO])) break; if (sp > XB_SPIN_CAP) { atomicAdd(&bar[XB_TMO], 1u); break; } }
    }
    nloc = mine > 0u ? mine : 1u; nx = cnt > 0u ? cnt : 1u;
}

__device__ __forceinline__ void xcd_barrier(const XcdBarrier& b) {
    asm volatile("s_waitcnt vmcnt(0)" ::: "memory");
    __syncthreads();
    if (threadIdx.x == 0) {
        unsigned* bar = b.bar;
        __builtin_amdgcn_s_waitcnt(0);
        unsigned nloc = b.st[0], nx = b.st[1];
        if (nloc == 0u) { xcd_barrier_complete(bar, b.x, nloc, nx); b.st[0] = nloc; b.st[1] = nx; }
        const unsigned old = xb_add(&bar[XB_XSUB(b.x)], 1u);
        const unsigned gen = old / nloc;
        if (old + 1u == (gen + 1u) * nloc) {
            __builtin_amdgcn_fence(__ATOMIC_RELEASE, "agent");
            asm volatile("s_waitcnt vmcnt(0)" ::: "memory");
            const unsigned og = xb_add(&bar[XB_TOP], 1u);
            const unsigned tg = og / nx;
            if (og + 1u == (tg + 1u) * nx) xb_add(&bar[XB_TOPGEN], 1u);
            else XB_SPIN(xb_ld(&bar[XB_TOPGEN]) == tg, bar);
            __builtin_amdgcn_fence(__ATOMIC_ACQUIRE, "agent");
            xb_add(&bar[XB_XGEN(b.x)], 1u);
            asm volatile("s_waitcnt vmcnt(0)" ::: "memory");
        } else {
            XB_SPIN(xb_ld(&bar[XB_XGEN(b.x)]) == gen, bar);
            __builtin_amdgcn_fence(__ATOMIC_ACQUIRE, "agent");
            asm volatile("s_waitcnt vmcnt(0)" ::: "memory");
        }
    }
    __syncthreads();
}
namespace pg8 {
#define PG8_LAS __attribute__((address_space(3)))
typedef unsigned short bf16_t;
typedef short bf16x8 __attribute__((ext_vector_type(8)));
typedef float f32x4 __attribute__((ext_vector_type(4)));
typedef unsigned u32x4 __attribute__((ext_vector_type(4)));
constexpr int BM = 256, BK = 64, HALF = 128, HTB = HALF * BK * 2  , STAGE_BYTES = 8 * HTB, NXCD = 8, WGM = 8;

__host__ __device__ __forceinline__ int lds_byte(int r, int c) { const int st = (r >> 4) * 2 + (c >> 5), rr = r & 15, cc = c & 31, ob = rr * 64 + cc * 2; return st * 1024 + (ob ^ (((ob >> 9) & 1) << 5)); }
__host__ __device__ __forceinline__ void stage_rc(int b, int& R, int& C) { const int st = b / 1024, sb = b % 1024, swz = sb ^ (((sb >> 9) & 1) << 5); R = (st >> 1) * 16 + swz / 64; C = (st & 1) * 32 + (swz % 64) / 2; }
__host__ __device__ __forceinline__ int perm32(int rho) { const int n = rho >> 4, i = rho & 15; return 8 * (i >> 2) + 4 * n + (i & 3); }

struct Unit { int pm, pn, e; };
struct Gemm { const bf16_t* A; const bf16_t* Bt; int M, N, K; size_t bexp; };

struct StaticOrder {
    int nM, nN, nwg, G, c;
    __host__ __device__ void init(int M, int N, int G_, int c_) { nM = M / BM; nN = N / BM; nwg = nM * nN; G = G_; c = c_; }
    __host__ __device__ bool next(int i, Unit& u) const {
        const long L = (long)i * G + c; if (L >= nwg) return false;
        int wgid = (int)L; { const int q = nwg / NXCD, r = nwg % NXCD, xcd = wgid % NXCD, off = wgid / NXCD; wgid = (xcd < r ? xcd * (q + 1) : r * (q + 1) + (xcd - r) * q) + off; }
        const int nig = WGM * nN, gid = wgid / nig, fm = gid * WGM, gsz = (nM - fm) < WGM ? (nM - fm) : WGM;
        u.pm = fm + ((wgid % nig) % gsz); u.pn = (wgid % nig) / gsz; u.e = 0; return true;
    }
    __device__ __forceinline__ void a_ready(const Unit&) const {}
    __device__ __forceinline__ void done(const Unit&) const {}
};
typedef __bf16 bf16x2_c __attribute__((ext_vector_type(2))); typedef float f32x2_c __attribute__((ext_vector_type(2)));
__device__ __forceinline__ unsigned cvt_pk_bf16(float lo, float hi) { const f32x2_c v = {lo, hi}; return __builtin_bit_cast(unsigned, __builtin_convertvector(v, bf16x2_c)); }

struct EpiB16 {
    static constexpr bool PERM = true, AFTER_DRAIN = false;
    bf16_t* O; int ldc; const float* rs;
    __device__ __forceinline__ void operator()(const f32x4 (&acc)[2][2][4][2], const Unit& u, int wr, int wc, int fr, int fq) const {
        const int row0 = u.pm * BM + wr * 64 + fr, col0 = u.pn * BM + wc * 32 + 8 * fq;
#pragma unroll
        for (int ai = 0; ai < 2; ++ai)
#pragma unroll
            for (int m = 0; m < 4; ++m) { bf16_t* rowp = O + (size_t)(row0 + ai * HALF + m * 16) * ldc + col0; const float r1 = rs ? rs[row0 + ai * HALF + m * 16] : 1.0f;
#pragma unroll
                for (int bj = 0; bj < 2; ++bj) { const f32x4 v0 = acc[ai][bj][m][0] * r1, v1 = acc[ai][bj][m][1] * r1;
                    u32x4 w; w.x = cvt_pk_bf16(v0[0], v0[1]); w.y = cvt_pk_bf16(v0[2], v0[3]); w.z = cvt_pk_bf16(v1[0], v1[1]); w.w = cvt_pk_bf16(v1[2], v1[3]);
                    *(u32x4*)(rowp + bj * HALF) = w; } }
    }
};
struct EpiRes {
    static constexpr bool PERM = false, AFTER_DRAIN = false;
    const float* base32; bf16_t* X; int ldc; float* ssp;
    __device__ __forceinline__ void operator()(const f32x4 (&acc)[2][2][4][2], const Unit& u, int wr, int wc, int fr, int fq) const {
        const int row0 = u.pm * BM + wr * 64 + fr, col0 = u.pn * BM + wc * 32 + 4 * fq;
        typedef unsigned u32x2v __attribute__((ext_vector_type(2)));
#pragma unroll
        for (int ai = 0; ai < 2; ++ai) {
            f32x4 bs[4][2][2];
            if (base32) {
#pragma unroll
                for (int m = 0; m < 4; ++m) { const size_t off = (size_t)(row0 + ai * HALF + m * 16) * ldc + col0;
#pragma unroll
                    for (int bj = 0; bj < 2; ++bj)
#pragma unroll
                        for (int n = 0; n < 2; ++n) bs[m][bj][n] = *(const f32x4*)(base32 + off + bj * HALF + n * 16); }
            } else {
                u32x2v rb[4][2][2];
#pragma unroll
                for (int m = 0; m < 4; ++m) { const size_t off = (size_t)(row0 + ai * HALF + m * 16) * ldc + col0;
#pragma unroll
                    for (int bj = 0; bj < 2; ++bj)
#pragma unroll
                        for (int n = 0; n < 2; ++n) rb[m][bj][n] = *(const u32x2v*)(X + off + bj * HALF + n * 16); }
#pragma unroll
                for (int m = 0; m < 4; ++m)
#pragma unroll
                    for (int bj = 0; bj < 2; ++bj)
#pragma unroll
                        for (int n = 0; n < 2; ++n) { const u32x2v w = rb[m][bj][n]; bs[m][bj][n] = (f32x4){__uint_as_float(w.x << 16), __uint_as_float(w.x & 0xFFFF0000u), __uint_as_float(w.y << 16), __uint_as_float(w.y & 0xFFFF0000u)}; }
            }
#pragma unroll
            for (int m = 0; m < 4; ++m) { const int row = row0 + ai * HALF + m * 16; const size_t off = (size_t)row * ldc + col0; float ss = 0.f;
#pragma unroll
                for (int bj = 0; bj < 2; ++bj)
#pragma unroll
                    for (int n = 0; n < 2; ++n) { const f32x4 o = bs[m][bj][n] + acc[ai][bj][m][n];
                        u32x2v w; w.x = cvt_pk_bf16(o[0], o[1]); w.y = cvt_pk_bf16(o[2], o[3]); *(u32x2v*)(X + off + bj * HALF + n * 16) = w;
                        ss += (o[0] * o[0] + o[1] * o[1]) + (o[2] * o[2] + o[3] * o[3]); }
                if (ssp) { ss += __shfl_xor(ss, 16); ss += __shfl_xor(ss, 32); if (fq == 0) ssp[(size_t)row * 16 + 4 * u.pn + wc] = ss; } }
        }
    }
};
struct EpiSwiglu {
    static constexpr bool PERM = true, AFTER_DRAIN = false;
    bf16_t* O; int ldc; const float* rs;
    __device__ __forceinline__ void operator()(const f32x4 (&acc)[2][2][4][2], const Unit& u, int wr, int wc, int fr, int fq) const {
        const int row0 = u.pm * BM + wr * 64 + fr, col0 = (u.pn * BM + wc * 32 + 8 * fq) >> 1;
        typedef unsigned u32x2v __attribute__((ext_vector_type(2)));
#pragma unroll
        for (int ai = 0; ai < 2; ++ai)
#pragma unroll
            for (int m = 0; m < 4; ++m) { bf16_t* rowp = O + (size_t)(row0 + ai * HALF + m * 16) * ldc + col0; const float r1 = rs[row0 + ai * HALF + m * 16];
#pragma unroll
                for (int bj = 0; bj < 2; ++bj) { const f32x4 a = acc[ai][bj][m][0] * r1, b = acc[ai][bj][m][1] * r1; float h[4];
#pragma unroll
                    for (int i = 0; i < 4; ++i) h[i] = a[i] * __builtin_amdgcn_rcpf(1.0f + __expf(-a[i])) * b[i];
                    u32x2v w; w.x = cvt_pk_bf16(h[0], h[1]); w.y = cvt_pk_bf16(h[2], h[3]);
                    *(u32x2v*)(rowp + bj * (HALF / 2)) = w; } }
    }
};
struct MoeOrder {
    const int* blk_e; int nunits, nN, G, c;
    __device__ __forceinline__ bool next(int i, Unit& u) const {
        const long L = (long)i * G + c; if (L >= nunits) return false;
        u.pm = (int)(L / nN); u.pn = (int)(L % nN); u.e = blk_e[u.pm]; return true;
    }
    __device__ __forceinline__ void a_ready(const Unit&) const {}
    __device__ __forceinline__ void done(const Unit&) const {}
};
template <class Epi, class Sched, bool ALIGN_EPI = false, bool SP2 = false>
__device__ __forceinline__ void gemm_phase(PG8_LAS unsigned char* lds, const Gemm g, const Sched& S, const Epi& E) {
    int tid_ = threadIdx.x; asm volatile("" : "+v"(tid_));
    const int tid = tid_, wid = __builtin_amdgcn_readfirstlane(tid >> 6), lane = tid & 63, wr = wid >> 2, wc = wid & 3, fr = lane & 15, fq = lane >> 4;
    const int K = g.K, nt = K / BK;
    unsigned voffA[2], voffB[2];
#pragma unroll
    for (int i = 0; i < 2; ++i) { int R, C; stage_rc(tid * 16 + i * 8192, R, C); const int Rb = Epi::PERM ? ((R & ~31) + perm32(R & 31)) : R;
        voffA[i] = (unsigned)(R * K + C) * 2u; voffB[i] = (unsigned)(Rb * K + C) * 2u; }
    const size_t kstep = (size_t)(BK * 2);
    const size_t hstep = (size_t)HALF * K * 2;
    const size_t tstep = 2 * hstep;
    const unsigned ldsw = (unsigned)wid * 1024u;
    const int aoff = lds_byte(wr * 64 + fr, fq * 8), boff = lds_byte(wc * 32 + fr, fq * 8);
#define PG8_SA(b, h) (((b) * 2 + (h)) * HTB)
#define PG8_SB(b, h) ((4 + (b) * 2 + (h)) * HTB)
#define PG8_STAGE(bufoff, gbase, voff) do { _Pragma("unroll") for (int _i = 0; _i < 2; ++_i) \
        __builtin_amdgcn_global_load_lds((const unsigned*)((const char*)(gbase) + (voff)[_i]), (PG8_LAS unsigned*)(lds + (bufoff) + ldsw + _i * 8192), 16, 0, 0); } while (0)
#define PG8_LDA(dst, b, h) do { _Pragma("unroll") for (int m = 0; m < 4; ++m) _Pragma("unroll") for (int k = 0; k < 2; ++k) dst[m][k] = *(const PG8_LAS bf16x8*)(lds + PG8_SA(b, h) + aoff + m * 2048 + k * 1024); } while (0)
#define PG8_LDB(dst, b, h) do { _Pragma("unroll") for (int n = 0; n < 2; ++n) _Pragma("unroll") for (int k = 0; k < 2; ++k) dst[n][k] = *(const PG8_LAS bf16x8*)(lds + PG8_SB(b, h) + boff + n * 2048 + k * 1024); } while (0)
#define PG8_MMA(ai, bj, At, Bt) do { __builtin_amdgcn_s_setprio(1); _Pragma("unroll") for (int m = 0; m < 4; ++m) _Pragma("unroll") for (int n = 0; n < 2; ++n) _Pragma("unroll") for (int k = 0; k < 2; ++k) \
        acc[ai][bj][m][n] = __builtin_amdgcn_mfma_f32_16x16x32_bf16(Bt[n][k], At[m][k], acc[ai][bj][m][n], 0, 0, 0); __builtin_amdgcn_s_setprio(0); } while (0)
#define PG8_WAIT_V(n) asm volatile("s_waitcnt vmcnt(" #n ")" ::: "memory")
#define PG8_WAIT_L(n) asm volatile("s_waitcnt lgkmcnt(" #n ")" ::: "memory")
#define PG8_BAR __builtin_amdgcn_s_barrier()
#define PG8_SCHED __builtin_amdgcn_sched_barrier(0)
    Unit cur, nxt; int ui = 0;
    if (!S.next(0, cur)) return;
    f32x4 acc[2][2][4][2];
#pragma unroll
    for (int a = 0; a < 2; ++a)
#pragma unroll
        for (int b = 0; b < 2; ++b)
#pragma unroll
            for (int m = 0; m < 4; ++m)
#pragma unroll
                for (int n = 0; n < 2; ++n) acc[a][b][m][n] = (f32x4){0.f, 0.f, 0.f, 0.f};
    bf16x8 At[4][2], B0[2][2], B1[2][2];
    const char* cA = (const char*)g.A + (size_t)cur.pm * tstep; const char* cB = (const char*)g.Bt + (size_t)cur.pn * tstep + (size_t)cur.e * g.bexp;
    S.a_ready(cur);
    if constexpr (SP2) {
        PG8_STAGE(PG8_SB(0, 0), cB, voffB); PG8_STAGE(PG8_SB(0, 1), cB + hstep, voffB); PG8_STAGE(PG8_SA(0, 0), cA, voffA); PG8_STAGE(PG8_SA(0, 1), cA + hstep, voffA);
        if (wr == 1) PG8_BAR;
        PG8_WAIT_V(2); PG8_BAR;
        PG8_STAGE(PG8_SB(1, 0), cB + kstep, voffB); PG8_STAGE(PG8_SA(1, 0), cA + kstep, voffA); PG8_STAGE(PG8_SB(1, 1), cB + hstep + kstep, voffB);
        PG8_WAIT_V(6); PG8_BAR;
    } else {
        PG8_STAGE(PG8_SB(0, 0), cB, voffB); PG8_STAGE(PG8_SA(0, 0), cA, voffA); PG8_STAGE(PG8_SB(0, 1), cB + hstep, voffB); PG8_STAGE(PG8_SA(0, 1), cA + hstep, voffA);
        if (wr == 1) PG8_BAR;
        PG8_WAIT_V(4); PG8_BAR;
        PG8_STAGE(PG8_SB(1, 0), cB + kstep, voffB); PG8_STAGE(PG8_SA(1, 0), cA + kstep, voffA); PG8_STAGE(PG8_SB(1, 1), cB + hstep + kstep, voffB);
        PG8_WAIT_V(6); PG8_BAR;
    }
    for (;;) {
        const bool has_next = S.next(ui + 1, nxt);
        const char* nA = has_next ? (const char*)g.A + (size_t)nxt.pm * tstep : cA; const char* nB = has_next ? (const char*)g.Bt + (size_t)nxt.pn * tstep + (size_t)nxt.e * g.bexp : cB;
        for (int t = 0; t < nt; t += 2) {
            const bool last = (t == nt - 2);
            const char* a1 = cA + (size_t)(t + 1) * kstep;
            const char* a2 = last ? nA : cA + (size_t)(t + 2) * kstep; const char* b2 = last ? nB : cB + (size_t)(t + 2) * kstep;
            const char* a3 = a2 + kstep; const char* b3 = b2 + kstep;
            if (last && has_next) S.a_ready(nxt);
            if constexpr (SP2) {
            PG8_LDB(B0, 0, 0); PG8_LDB(B1, 0, 1); PG8_SCHED; PG8_LDA(At, 0, 0); PG8_STAGE(PG8_SA(1, 1), a1 + hstep, voffA);
            PG8_WAIT_V(8); PG8_WAIT_L(0); PG8_BAR; PG8_MMA(0, 0, At, B0); PG8_MMA(0, 1, At, B1); PG8_BAR; PG8_SCHED;
            PG8_LDA(At, 0, 1); PG8_STAGE(PG8_SB(0, 0), b2, voffB); PG8_STAGE(PG8_SB(0, 1), b2 + hstep, voffB); PG8_STAGE(PG8_SA(0, 0), a2, voffA);
            PG8_WAIT_V(8); PG8_WAIT_L(0); PG8_BAR; PG8_MMA(1, 0, At, B0); PG8_MMA(1, 1, At, B1); PG8_BAR; PG8_SCHED;
            PG8_LDB(B0, 1, 0); PG8_LDB(B1, 1, 1); PG8_SCHED; PG8_LDA(At, 1, 0); PG8_STAGE(PG8_SA(0, 1), a2 + hstep, voffA);
            PG8_WAIT_V(8); PG8_WAIT_L(0); PG8_BAR; PG8_MMA(0, 0, At, B0); PG8_MMA(0, 1, At, B1); PG8_BAR; PG8_SCHED;
            PG8_LDA(At, 1, 1); PG8_STAGE(PG8_SB(1, 0), b3, voffB); PG8_STAGE(PG8_SB(1, 1), b3 + hstep, voffB); PG8_STAGE(PG8_SA(1, 0), a3, voffA);
            PG8_WAIT_V(8); PG8_WAIT_L(0); PG8_BAR; PG8_MMA(1, 0, At, B0); PG8_MMA(1, 1, At, B1); PG8_BAR; PG8_SCHED;
            } else {
            PG8_LDB(B0, 0, 0); PG8_SCHED; PG8_LDA(At, 0, 0); PG8_STAGE(PG8_SA(1, 1), a1 + hstep, voffA);
            PG8_WAIT_L(8); PG8_BAR; PG8_WAIT_L(0); PG8_MMA(0, 0, At, B0); PG8_BAR; PG8_SCHED;
            PG8_LDB(B1, 0, 1); PG8_STAGE(PG8_SB(0, 0), b2, voffB);
            PG8_BAR; PG8_WAIT_L(0); PG8_MMA(0, 1, At, B1); PG8_BAR;
            PG8_LDA(At, 0, 1); PG8_STAGE(PG8_SA(0, 0), a2, voffA);
            PG8_BAR; PG8_WAIT_L(0); PG8_MMA(1, 0, At, B0); PG8_BAR; PG8_SCHED;
            PG8_STAGE(PG8_SB(0, 1), b2 + hstep, voffB);
            PG8_WAIT_V(6); PG8_BAR; PG8_MMA(1, 1, At, B1); PG8_BAR;
            PG8_LDB(B0, 1, 0); PG8_SCHED; PG8_LDA(At, 1, 0); PG8_STAGE(PG8_SA(0, 1), a2 + hstep, voffA);
            PG8_WAIT_L(8); PG8_BAR; PG8_WAIT_L(0); PG8_MMA(0, 0, At, B0); PG8_BAR; PG8_SCHED;
            PG8_LDB(B1, 1, 1); PG8_STAGE(PG8_SB(1, 0), b3, voffB);
            PG8_BAR; PG8_WAIT_L(0); PG8_MMA(0, 1, At, B1); PG8_BAR;
            PG8_LDA(At, 1, 1); PG8_STAGE(PG8_SA(1, 0), a3, voffA);
            PG8_BAR; PG8_WAIT_L(0); PG8_MMA(1, 0, At, B0); PG8_BAR; PG8_SCHED;
            PG8_STAGE(PG8_SB(1, 1), b3 + hstep, voffB);
            PG8_WAIT_V(6); PG8_BAR; PG8_MMA(1, 1, At, B1); PG8_BAR;
            }
        }
        if constexpr (ALIGN_EPI) { if (wr == 0) PG8_BAR; }
        if constexpr (!Epi::AFTER_DRAIN) { E(acc, cur, wr, wc, fr, fq); S.done(cur); }
        if (!has_next) break;
#pragma unroll
        for (int a = 0; a < 2; ++a)
#pragma unroll
            for (int b = 0; b < 2; ++b)
#pragma unroll
                for (int m = 0; m < 4; ++m)
#pragma unroll
                    for (int n = 0; n < 2; ++n) acc[a][b][m][n] = (f32x4){0.f, 0.f, 0.f, 0.f};
        cur = nxt; cA = nA; cB = nB; ++ui;
        if constexpr (ALIGN_EPI) { if (wr == 1) PG8_BAR; }
    }
    PG8_WAIT_V(0);
    if constexpr (!ALIGN_EPI) { if (wr == 0) PG8_BAR; }
    PG8_BAR;
    if constexpr (Epi::AFTER_DRAIN) { E.fused(acc, cur, wr, wc, fr, fq, lds, wid, lane); S.done(cur); }
#undef PG8_SA
#undef PG8_SB
#undef PG8_STAGE
#undef PG8_LDA
#undef PG8_LDB
#undef PG8_MMA
#undef PG8_WAIT_V
#undef PG8_WAIT_L
#undef PG8_BAR
#undef PG8_SCHED
}
}
__device__ __forceinline__ float bf2f(unsigned v) { return __uint_as_float(v << 16); }
__device__ __forceinline__ unsigned f2bf(float f) { unsigned u = __float_as_uint(f); u += 0x7FFFu + ((u >> 16) & 1u); return u >> 16; }
typedef __bf16 bf16x2_t __attribute__((ext_vector_type(2)));
__device__ __forceinline__ unsigned pk2(float lo, float hi) { const f32x2 v = {lo, hi}; return __builtin_bit_cast(unsigned, __builtin_convertvector(v, bf16x2_t)); }
__device__ __forceinline__ float bflo(unsigned w) { return __uint_as_float(w << 16); }
__device__ __forceinline__ float bfhi(unsigned w) { return __uint_as_float(w & 0xFFFF0000u); }
__device__ __forceinline__ float wave_sum(float v) {
#pragma unroll
    for (int o = 1; o < 64; o <<= 1) v += __shfl_xor(v, o);
    return v;
}
__device__ __forceinline__ float wave_max(float v) {
#pragma unroll
    for (int o = 1; o < 64; o <<= 1) v = fmaxf(v, __shfl_xor(v, o));
    return v;
}
__device__ __forceinline__ float sigmoidf_(float x) { return __builtin_amdgcn_rcpf(1.0f + __expf(-x)); }
__device__ __forceinline__ float tanhf_(float x) { return 1.0f - 2.0f * __builtin_amdgcn_rcpf(__expf(2.0f * x) + 1.0f); }
#define LDS_WAIT() asm volatile("s_waitcnt lgkmcnt(0)" ::: "memory")

struct Ctx { int tid, wave, lane, gw, ngw; unsigned char* shm; };

__device__ __forceinline__ int tr_src_col(int mode, int n, int scol0) { return mode == 1 ? (n < 2048 ? n : n + 16) : scol0 + n; }
__device__ __forceinline__ int tr_dst_row(int mode, int n, int drow0) { return mode == 2 ? 8 * (n >> 2) + (n & 3) : (mode == 3 ? 8 * (n >> 2) + 4 + (n & 3) : drow0 + n); }
__device__ __forceinline__ void tr_item(const float* W, int ldw, int scol0, int K, bf16_t* WT, int drow0, int mode, LAS float* scr, int item, int nblk, int lane, const float* gain = nullptr) {
    const int kb = item / nblk, nb = item % nblk, k0 = 64 * kb, n0 = 32 * nb;
    const int n4 = 4 * (lane & 7), sc = tr_src_col(mode, n0 + n4, scol0);
    f32x4 v[8];
#pragma unroll
    for (int i = 0; i < 8; ++i) v[i] = *(const f32x4*)(W + (size_t)(k0 + 8 * i + (lane >> 3)) * ldw + sc);
    if (gain) {
#pragma unroll
        for (int i = 0; i < 8; ++i) v[i] = v[i] * gain[k0 + 8 * i + (lane >> 3)]; }
#pragma unroll
    for (int i = 0; i < 8; ++i) { LAS float* d = scr + (8 * i + (lane >> 3)) * 33 + n4; d[0] = v[i].x; d[1] = v[i].y; d[2] = v[i].z; d[3] = v[i].w; }
    LDS_WAIT(); asm volatile("" ::: "memory");
    const int c = lane & 7;
#pragma unroll
    for (int j = 0; j < 4; ++j) { const int n = (lane >> 3) + 8 * j; const LAS float* s = scr + (8 * c) * 33 + n;
        u32x4 o; o.x = pk2(s[0 * 33], s[1 * 33]); o.y = pk2(s[2 * 33], s[3 * 33]); o.z = pk2(s[4 * 33], s[5 * 33]); o.w = pk2(s[6 * 33], s[7 * 33]);
        *(u32x4*)(WT + (size_t)tr_dst_row(mode, n0 + n, drow0) * K + k0 + 8 * c) = o; }
    LDS_WAIT(); asm volatile("" ::: "memory");
}
__device__ __forceinline__ void tr_matrix(const Ctx& c, const float* W, int ldw, int scol0, int K, int ncols, bf16_t* WT, int drow0, int mode, const float* gain = nullptr) {
    LAS float* scr = (LAS float*)(c.shm) + c.wave * (64 * 33);
    const int nblk = ncols / 32, nitems = (K / 64) * nblk;
    for (int it = c.gw; it < nitems; it += c.ngw) tr_item(W, ldw, scol0, K, WT, drow0, mode, scr, it, nblk, c.lane, gain);
}
__device__ __forceinline__ void tr_moe_layer(const Ctx& c, const Params& p, int layer, int gw0, int ngw) {
    LAS float* scr = (LAS float*)(c.shm) + c.wave * (64 * 33);
    bf16_t* w13t = (bf16_t*)(p.ws + OFF_WMOE); bf16_t* w2t = (bf16_t*)(p.ws + OFF_WMOE + 64 * MiB);
    const float* w1 = p.moe_w1 + (size_t)layer * NEXP * 1024 * 512; const float* w3 = p.moe_w3 + (size_t)layer * NEXP * 1024 * 512; const float* w2 = p.moe_w2 + (size_t)layer * NEXP * 512 * 1024;
    for (int it = c.gw - gw0; it < NEXP * 768; it += ngw) {
        const int e = it / 768, r = it % 768;
        if (r < 256) tr_item(w1 + (size_t)e * 1024 * 512, 512, 0, 1024, w13t + (size_t)e * 1024 * 1024, 0, 2, scr, r, 16, c.lane, p.norm_moe + layer * 1024);
        else if (r < 512) tr_item(w3 + (size_t)e * 1024 * 512, 512, 0, 1024, w13t + (size_t)e * 1024 * 1024, 0, 3, scr, r - 256, 16, c.lane, p.norm_moe + layer * 1024);
        else tr_item(w2 + (size_t)e * 512 * 1024, 1024, 0, 512, w2t + (size_t)e * 1024 * 512, 0, 0, scr, r - 512, 32, c.lane);
    }
}

__device__ __forceinline__ void row_load(const float* row, int lane, f32x4 (&v)[4]) {
#pragma unroll
    for (int j = 0; j < 4; ++j) v[j] = *((const f32x4*)row + lane + 64 * j);
}
__device__ __forceinline__ float row_rstd(const f32x4 (&v)[4]) {
    float s = 0.f;
#pragma unroll
    for (int j = 0; j < 4; ++j) s += (v[j].x * v[j].x + v[j].y * v[j].y) + (v[j].z * v[j].z + v[j].w * v[j].w);
    return 1.0f / sqrtf(wave_sum(s) * (1.0f / 1024.0f) + 1e-6f);
}
__device__ __forceinline__ void row_scale(f32x4 (&v)[4], float rstd, const float* gain, int lane) {
#pragma unroll
    for (int j = 0; j < 4; ++j) { const f32x4 g = *((const f32x4*)gain + lane + 64 * j); v[j] = v[j] * rstd * g; }
}
__device__ __forceinline__ void row_store_bf16(bf16_t* orow, int lane, const f32x4 (&v)[4]) {
#pragma unroll
    for (int j = 0; j < 4; ++j) { u32x2 o; o.x = pk2(v[j].x, v[j].y); o.y = pk2(v[j].z, v[j].w); *((u32x2*)orow + lane + 64 * j) = o; }
}
__device__ __forceinline__ void row_store_f32(float* orow, int lane, const f32x4 (&v)[4]) {
#pragma unroll
    for (int j = 0; j < 4; ++j) *((f32x4*)orow + lane + 64 * j) = v[j];
}
__device__ __forceinline__ void row_combine(f32x4 (&v)[4], const bf16_t* yb, int p0, int p1, float g0, float g1, int lane) {
    const u32x2* r0 = (const u32x2*)(yb + (size_t)p0 * 1024); const u32x2* r1 = (const u32x2*)(yb + (size_t)p1 * 1024);
#pragma unroll
    for (int j = 0; j < 4; ++j) { const u32x2 a = r0[lane + 64 * j], b = r1[lane + 64 * j];
        v[j].x += g0 * bflo(a.x) + g1 * bflo(b.x); v[j].y += g0 * bfhi(a.x) + g1 * bfhi(b.x);
        v[j].z += g0 * bflo(a.y) + g1 * bflo(b.y); v[j].w += g0 * bfhi(a.y) + g1 * bfhi(b.y); }
}
__device__ __forceinline__ void row_logits(const f32x4 (&v)[4], const float* wT, int lane, int NL, LAS float* lg) {
#pragma unroll 1
    for (int o = 0; o < NL; ++o) { float s = 0.f;
#pragma unroll
        for (int j = 0; j < 4; ++j) { const f32x4 w = *((const f32x4*)(wT + o * 1024) + lane + 64 * j); s += (v[j].x * w.x + v[j].y * w.y) + (v[j].z * w.z + v[j].w * w.w); }
        s = wave_sum(s); if (lane == 0) lg[o] = s; }
    LDS_WAIT();
}

__device__ __forceinline__ void norm_plain(const Ctx& c, const float* src, const float* gain, bf16_t* H, int nrows) {
    for (int r0 = c.gw; r0 < nrows; r0 += 4 * c.ngw) {
        f32x4 v[4][4];
#pragma unroll
        for (int q = 0; q < 4; ++q) { const int r = r0 + q * c.ngw; if (r < nrows) row_load(src + (size_t)r * 1024, c.lane, v[q]); }
#pragma unroll
        for (int q = 0; q < 4; ++q) { const int r = r0 + q * c.ngw; if (r < nrows) { const float rs = row_rstd(v[q]); row_scale(v[q], rs, gain, c.lane); row_store_bf16(H + (size_t)r * 1024, c.lane, v[q]); } }
    }
}
__device__ __forceinline__ void route_row(const LAS float* lg, const float* bg, const float* be, int& e0, int& e1, float& g0, float& g1) {
    float gl[4]; int gt = 0; float gm;
#pragma unroll
    for (int i = 0; i < 4; ++i) gl[i] = lg[i] + bg[i];
    gm = gl[0];
#pragma unroll
    for (int i = 1; i < 4; ++i) if (gl[i] > gm) { gm = gl[i]; gt = i; }
    float gs = 0.f;
#pragma unroll
    for (int i = 0; i < 4; ++i) gs += __expf(gl[i] - gm);
    const float pg = 1.0f / gs;
    float el[8];
#pragma unroll
    for (int i = 0; i < 8; ++i) el[i] = lg[4 + 8 * gt + i] + be[8 * gt + i];
    int i0 = 0; float m0 = el[0];
#pragma unroll
    for (int i = 1; i < 8; ++i) if (el[i] > m0) { m0 = el[i]; i0 = i; }
    int i1 = -1; float m1 = -3.0e38f;
#pragma unroll
    for (int i = 0; i < 8; ++i) if (i != i0 && el[i] > m1) { m1 = el[i]; i1 = i; }
    float one = 1.0f; asm volatile("" : "+v"(one));
    const float q1 = __expf(m1 - m0); const float inv = one / (one + q1);
    e0 = gt * 8 + i0; e1 = gt * 8 + i1; g0 = pg * inv; g1 = pg * q1 * inv;
}
constexpr int RW_AS = 64 * 68;
__device__ __forceinline__ void rwkv_naive(const Ctx& c, const Params& p, int bh) {
    const int b = bh >> 3, hd = bh & 7, tid = c.tid, lane = c.lane, wv = c.wave;
    LAS float* L = (LAS float*)c.shm;
    LAS float* aR = L; LAS float* aK = L + RW_AS; LAS float* aV = L + 2 * RW_AS; LAS float* aW = L + 3 * RW_AS; LAS float* aA = L + 4 * RW_AS;
    LAS float* aB = L + 5 * RW_AS; LAS float* aG = L + 6 * RW_AS; LAS float* aY = L + 7 * RW_AS; LAS float* red = L + 8 * RW_AS;
    const bf16_t* P = (const bf16_t*)(p.ws + OFF_P); bf16_t* MIX = (bf16_t*)(p.ws + OFF_H);
    LAS f32x4* SL = (LAS f32x4*)(L + 8 * RW_AS + 1536);
    if (wv == 0) {
#pragma unroll
        for (int j4 = 0; j4 < 16; ++j4) SL[j4 * 64 + lane] = (f32x4){0.f, 0.f, 0.f, 0.f}; }
    const int t = lane, cg = wv;
    const int ch0 = hd * 64 + cg * 8;
    for (int tb = 0; tb < 64; ++tb) {
        const size_t tg0 = (size_t)b * SEQ + (size_t)tb * 64;
#pragma unroll 1
        for (int i = 0; i < 7; ++i) {
            const int task = tid + 512 * i, tt = task / 56, q = task % 56;
            int col; LAS float* dst; int kind = 0;
            if (q < 8) { col = hd * 64 + 8 * q; dst = aR + tt * 68 + 8 * q; }
            else if (q < 16) { col = 512 + hd * 64 + 8 * (q - 8); dst = aK + tt * 68 + 8 * (q - 8); }
            else if (q < 24) { col = 1024 + hd * 64 + 8 * (q - 16); dst = aV + tt * 68 + 8 * (q - 16); }
            else if (q < 32) { col = 1536 + 8 * (q - 24); dst = aW + tt * 68 + 8 * (q - 24); kind = 1; }
            else if (q < 40) { col = 1600 + 8 * (q - 32); dst = aA + tt * 68 + 8 * (q - 32); }
            else if (q < 48) { col = 1664 + 8 * (q - 40); dst = aB + tt * 68 + 8 * (q - 40); kind = 2; }
            else { col = 1664 + 8 * (q - 40); dst = aG + tt * 68 + 8 * (q - 48); kind = 2; }
            const bf16_t* src = P + (tg0 + tt) * EV_IN + 768 + col;
            const u32x4 cur = *(const u32x4*)src;
            u32x4 prv = (u32x4){0u, 0u, 0u, 0u};
            if (tb * 64 + tt > 0) prv = *(const u32x4*)(src - EV_IN);
            const f32x4 m0 = *(const f32x4*)(p.ev_mu + col), m1 = *(const f32x4*)(p.ev_mu + col + 4);
            float v[8];
            const unsigned cw[4] = {cur.x, cur.y, cur.z, cur.w}, pw[4] = {prv.x, prv.y, prv.z, prv.w};
            const float mu[8] = {m0.x, m0.y, m0.z, m0.w, m1.x, m1.y, m1.z, m1.w};
#pragma unroll
            for (int k = 0; k < 4; ++k) { const float c0 = bflo(cw[k]), c1 = bfhi(cw[k]), p0 = bflo(pw[k]), p1 = bfhi(pw[k]);
                v[2 * k] = c0 + (p0 - c0) * mu[2 * k]; v[2 * k + 1] = c1 + (p1 - c1) * mu[2 * k + 1]; }
            if (kind == 1) {
#pragma unroll
                for (int k = 0; k < 8; ++k) v[k] = tanhf(v[k]); }
            if (kind == 2) {
#pragma unroll
                for (int k = 0; k < 8; ++k) v[k] = sigmoidf_(v[k]); }
            *(LAS f32x4*)dst = (f32x4){v[0], v[1], v[2], v[3]}; *(LAS f32x4*)(dst + 4) = (f32x4){v[4], v[5], v[6], v[7]};
        }
        __syncthreads();
        float zw[8], za[8], gg[8];
#pragma unroll
        for (int i = 0; i < 8; ++i) { zw[i] = 0.f; za[i] = 0.f; gg[i] = 0.f; }
#pragma unroll 2
        for (int j4 = 0; j4 < 16; ++j4) {
            const f32x4 xw = *(const LAS f32x4*)(aW + t * 68 + 4 * j4), xa = *(const LAS f32x4*)(aA + t * 68 + 4 * j4);
            const f32x4 g0 = *(const LAS f32x4*)(aB + t * 68 + 4 * j4), g1 = *(const LAS f32x4*)(aG + t * 68 + 4 * j4);
#pragma unroll
            for (int jj = 0; jj < 4; ++jj) { const int j = 4 * j4 + jj;
                const f32x4 w2a = *(const f32x4*)(p.ev_w2 + (size_t)j * 512 + ch0), w2b = *(const f32x4*)(p.ev_w2 + (size_t)j * 512 + ch0 + 4);
                const f32x4 a2a = *(const f32x4*)(p.ev_a2 + (size_t)j * 512 + ch0), a2b = *(const f32x4*)(p.ev_a2 + (size_t)j * 512 + ch0 + 4);
                const f32x4 gla = *(const f32x4*)(p.ev_g2 + (size_t)j * 512 + ch0), glb = *(const f32x4*)(p.ev_g2 + (size_t)j * 512 + ch0 + 4);
                const f32x4 gha = *(const f32x4*)(p.ev_g2 + (size_t)(64 + j) * 512 + ch0), ghb = *(const f32x4*)(p.ev_g2 + (size_t)(64 + j) * 512 + ch0 + 4);
                const float xwv = xw[jj], xav = xa[jj], g0v = g0[jj], g1v = g1[jj];
#pragma unroll
                for (int i = 0; i < 4; ++i) { zw[i] += xwv * w2a[i]; zw[4 + i] += xwv * w2b[i]; za[i] += xav * a2a[i]; za[4 + i] += xav * a2b[i];
                    gg[i] += g0v * gla[i] + g1v * gha[i]; gg[4 + i] += g0v * glb[i] + g1v * ghb[i]; } }
        }
        float av[8], kkv[8]; float ss = 0.f;
        {
            const f32x4 kA = *(const LAS f32x4*)(aK + t * 68 + cg * 8), kB = *(const LAS f32x4*)(aK + t * 68 + cg * 8 + 4);
            const float kv[8] = {kA.x, kA.y, kA.z, kA.w, kB.x, kB.y, kB.z, kB.w};
            float dec[8], kp[8];
#pragma unroll
            for (int i = 0; i < 8; ++i) { const int ch = ch0 + i;
                const float u = -(p.ev_w0[ch] + zw[i]); const float sp = (u > 20.f) ? u : log1pf(__expf(u));
                const float w = -sp - 0.5f; dec[i] = __expf(-__expf(w));
                av[i] = sigmoidf_(p.ev_a0[ch] + za[i]);
                kkv[i] = kv[i] * p.ev_k_k[ch]; ss += kkv[i] * kkv[i];
                kp[i] = kv[i] * (1.0f + (av[i] - 1.0f) * p.ev_k_a[ch]); }
            red[t * 8 + cg] = ss;
            __syncthreads();
            *(LAS f32x4*)(aW + t * 68 + cg * 8) = (f32x4){dec[0], dec[1], dec[2], dec[3]}; *(LAS f32x4*)(aW + t * 68 + cg * 8 + 4) = (f32x4){dec[4], dec[5], dec[6], dec[7]};
            *(LAS f32x4*)(aK + t * 68 + cg * 8) = (f32x4){kp[0], kp[1], kp[2], kp[3]}; *(LAS f32x4*)(aK + t * 68 + cg * 8 + 4) = (f32x4){kp[4], kp[5], kp[6], kp[7]};
            *(LAS f32x4*)(aG + t * 68 + cg * 8) = (f32x4){gg[0], gg[1], gg[2], gg[3]}; *(LAS f32x4*)(aG + t * 68 + cg * 8 + 4) = (f32x4){gg[4], gg[5], gg[6], gg[7]};
            float tot = 0.f;
#pragma unroll
            for (int i = 0; i < 8; ++i) tot += red[t * 8 + i];
            const float inv = 1.0f / fmaxf(sqrtf(tot), 1e-12f);
            float an[8], bn[8];
#pragma unroll
            for (int i = 0; i < 8; ++i) { const float kn = kkv[i] * inv; an[i] = -kn; bn[i] = kn * av[i]; }
            *(LAS f32x4*)(aA + t * 68 + cg * 8) = (f32x4){an[0], an[1], an[2], an[3]}; *(LAS f32x4*)(aA + t * 68 + cg * 8 + 4) = (f32x4){an[4], an[5], an[6], an[7]};
            *(LAS f32x4*)(aB + t * 68 + cg * 8) = (f32x4){bn[0], bn[1], bn[2], bn[3]}; *(LAS f32x4*)(aB + t * 68 + cg * 8 + 4) = (f32x4){bn[4], bn[5], bn[6], bn[7]};
        }
        __syncthreads();
        if (wv == 0) {
            float S[64];
#pragma unroll
            for (int j4 = 0; j4 < 16; ++j4) { const f32x4 s4 = SL[j4 * 64 + lane]; S[4 * j4] = s4.x; S[4 * j4 + 1] = s4.y; S[4 * j4 + 2] = s4.z; S[4 * j4 + 3] = s4.w; }
#pragma unroll 1
            for (int tt = 0; tt < 64; ++tt) {
                const float vv = aV[tt * 68 + lane];
                float sa = 0.f;
#pragma unroll
                for (int j4 = 0; j4 < 16; ++j4) { const f32x4 a4 = *(const LAS f32x4*)(aA + tt * 68 + 4 * j4);
                    sa += S[4 * j4] * a4.x; sa += S[4 * j4 + 1] * a4.y; sa += S[4 * j4 + 2] * a4.z; sa += S[4 * j4 + 3] * a4.w; }
                float y = 0.f;
#pragma unroll
                for (int j4 = 0; j4 < 16; ++j4) {
                    const f32x4 d4 = *(const LAS f32x4*)(aW + tt * 68 + 4 * j4), b4 = *(const LAS f32x4*)(aB + tt * 68 + 4 * j4);
                    const f32x4 k4 = *(const LAS f32x4*)(aK + tt * 68 + 4 * j4), r4 = *(const LAS f32x4*)(aR + tt * 68 + 4 * j4);
#pragma unroll
                    for (int jj = 0; jj < 4; ++jj) { const int j = 4 * j4 + jj; S[j] = S[j] * d4[jj] + sa * b4[jj] + vv * k4[jj]; y += S[j] * r4[jj]; } }
                aY[tt * 68 + lane] = y;
            }
#pragma unroll
            for (int j4 = 0; j4 < 16; ++j4) SL[j4 * 64 + lane] = (f32x4){S[4 * j4], S[4 * j4 + 1], S[4 * j4 + 2], S[4 * j4 + 3]};
        }
        __syncthreads();
        {
            const f32x4 yA = *(const LAS f32x4*)(aY + t * 68 + cg * 8), yB = *(const LAS f32x4*)(aY + t * 68 + cg * 8 + 4);
            const f32x4 rA = *(const LAS f32x4*)(aR + t * 68 + cg * 8), rB = *(const LAS f32x4*)(aR + t * 68 + cg * 8 + 4);
            const f32x4 kA = *(const LAS f32x4*)(aK + t * 68 + cg * 8), kB = *(const LAS f32x4*)(aK + t * 68 + cg * 8 + 4);
            const f32x4 vA = *(const LAS f32x4*)(aV + t * 68 + cg * 8), vB = *(const LAS f32x4*)(aV + t * 68 + cg * 8 + 4);
            const f32x4 gA = *(const LAS f32x4*)(aG + t * 68 + cg * 8), gB = *(const LAS f32x4*)(aG + t * 68 + cg * 8 + 4);
            const float y[8] = {yA.x, yA.y, yA.z, yA.w, yB.x, yB.y, yB.z, yB.w}, r[8] = {rA.x, rA.y, rA.z, rA.w, rB.x, rB.y, rB.z, rB.w};
            const float k[8] = {kA.x, kA.y, kA.z, kA.w, kB.x, kB.y, kB.z, kB.w}, v[8] = {vA.x, vA.y, vA.z, vA.w, vB.x, vB.y, vB.z, vB.w};
            const float g[8] = {gA.x, gA.y, gA.z, gA.w, gB.x, gB.y, gB.z, gB.w};
            float s1 = 0.f, sb = 0.f;
#pragma unroll
            for (int i = 0; i < 8; ++i) { s1 += y[i]; sb += r[i] * k[i] * p.ev_r_k[ch0 + i]; }
            red[t * 8 + cg] = s1; red[512 + t * 8 + cg] = sb;
            __syncthreads();
            float m = 0.f, bon = 0.f;
#pragma unroll
            for (int i = 0; i < 8; ++i) { m += red[t * 8 + i]; bon += red[512 + t * 8 + i]; }
            m *= (1.0f / 64.0f);
            float s2 = 0.f;
#pragma unroll
            for (int i = 0; i < 8; ++i) s2 += (y[i] - m) * (y[i] - m);
            red[1024 + t * 8 + cg] = s2;
            __syncthreads();
            float var = 0.f;
#pragma unroll
            for (int i = 0; i < 8; ++i) var += red[1024 + t * 8 + i];
            const float rs = 1.0f / sqrtf(var * (1.0f / 64.0f) + 64e-5f);
            float o[8];
#pragma unroll
            for (int i = 0; i < 8; ++i) o[i] = ((y[i] - m) * rs * p.ev_lnx_w[ch0 + i] + p.ev_lnx_b[ch0 + i] + bon * v[i]) * g[i];
            u32x4 w; w.x = pk2(o[0], o[1]); w.y = pk2(o[2], o[3]); w.z = pk2(o[4], o[5]); w.w = pk2(o[6], o[7]);
            *(u32x4*)(MIX + (tg0 + t) * 1024 + 512 + ch0) = w;
        }
        __syncthreads();
    }
}

__device__ __forceinline__ void swa_naive(const Ctx& c, const Params& p, int unit) {
    const int b = unit >> 6, g = (unit >> 5) & 1, n = unit & 31, tid = c.tid, lane = c.lane, wv = c.wave;
    LAS bf16_t* Ks = (LAS bf16_t*)c.shm;
    LAS bf16_t* Vs = (LAS bf16_t*)(c.shm + 256 * 144);
    LAS float* qf = (LAS float*)(c.shm + 256 * 144 + 256 * 128) + wv * 320;
    LAS float* pr = qf + 64;
    const bf16_t* P = (const bf16_t*)(p.ws + OFF_P); bf16_t* MIX = (bf16_t*)(p.ws + OFF_H);
    __syncthreads();
#pragma unroll 1
    for (int i = 0; i < 8; ++i) {
        const int task = tid + 512 * i, which = task >> 11, r = (task >> 3) & 255, ck = task & 7;
        const int tk = n * 128 - 128 + r;
        u32x4 d = (u32x4){0u, 0u, 0u, 0u};
        if (tk >= 0) d = *(const u32x4*)(P + ((size_t)b * SEQ + tk) * EV_IN + 512 + which * 128 + g * 64 + ck * 8);
        if (which == 0) *(LAS u32x4*)(Ks + r * 72 + ck * 8) = d; else *(LAS u32x4*)(Vs + r * 64 + ck * 8) = d;
    }
    __syncthreads();
    const int head = g * 4 + (wv >> 1);
    const float sink = p.ev_sinks[head];
#pragma unroll 1
    for (int qq = 0; qq < 64; ++qq) {
        const int qi = (wv & 1) * 64 + qq;
        const size_t tq = (size_t)b * SEQ + n * 128 + qi;
        qf[lane] = bf2f(P[tq * EV_IN + head * 64 + lane]) * 0.125f;
        LDS_WAIT();
        float s[4];
#pragma unroll
        for (int j = 0; j < 4; ++j) { const int kp = lane + 64 * j; float a = 0.f;
#pragma unroll
            for (int ck = 0; ck < 8; ++ck) { const u32x4 kk = *(const LAS u32x4*)(Ks + kp * 72 + ck * 8);
                const f32x4 q0 = *(const LAS f32x4*)(qf + ck * 8), q1 = *(const LAS f32x4*)(qf + ck * 8 + 4);
                a += bflo(kk.x) * q0.x + bfhi(kk.x) * q0.y + bflo(kk.y) * q0.z + bfhi(kk.y) * q0.w + bflo(kk.z) * q1.x + bfhi(kk.z) * q1.y + bflo(kk.w) * q1.z + bfhi(kk.w) * q1.w; }
            const bool valid = (kp >= qi + 1) && (kp <= qi + 128) && (n > 0 || kp >= 128);
            s[j] = valid ? a : -INFINITY; }
        float m = fmaxf(fmaxf(s[0], s[1]), fmaxf(s[2], s[3])); m = fmaxf(wave_max(m), sink);
        float den = 0.f;
#pragma unroll
        for (int j = 0; j < 4; ++j) { const float e = __expf(s[j] - m); pr[lane + 64 * j] = e; den += e; }
        den = wave_sum(den) + __expf(sink - m);
        LDS_WAIT();
        float o = 0.f;
#pragma unroll 8
        for (int kp = qi + 1; kp <= qi + 128; ++kp) o += pr[kp] * bf2f(Vs[kp * 64 + lane]);
        MIX[tq * 1024 + head * 64 + lane] = (bf16_t)f2bf(o / den);
    }
}
__device__ __forceinline__ void gla_naive(const Ctx& c, const Params& p, int bh) {
    const int b = bh >> 2, hd = bh & 3, tid = c.tid, lane = c.lane, wv = c.wave;
    LAS float* qs = (LAS float*)c.shm; LAS float* ks = qs + 32 * 128; LAS float* es = ks + 32 * 128; LAS float* vs = es + 32 * 128; LAS float* os = vs + 32 * 256;
    const bf16_t* P = (const bf16_t*)(p.ws + OFF_P); const float* GK = (const float*)(p.ws + OFF_R); bf16_t* MIX = (bf16_t*)(p.ws + OFF_H);
    float S[128];
#pragma unroll
    for (int j = 0; j < 128; ++j) S[j] = 0.f;
    for (int tb = 0; tb < 128; ++tb) {
        const size_t tg0 = (size_t)b * SEQ + (size_t)tb * 32;
#pragma unroll 1
        for (int i = 0; i < 8; ++i) { const int idx = tid + 512 * i, tt = idx >> 7, j = idx & 127;
            const bf16_t* row = P + (tg0 + tt) * OD_IN;
            qs[idx] = bf2f(row[hd * 128 + j]) * 0.08838834764831845f; ks[idx] = bf2f(row[512 + hd * 128 + j]); es[idx] = __expf(GK[(tg0 + tt) * 512 + hd * 128 + j]); }
#pragma unroll 1
        for (int i = 0; i < 16; ++i) { const int idx = tid + 512 * i, tt = idx >> 8, j = idx & 255; vs[idx] = bf2f(P[(tg0 + tt) * OD_IN + 1024 + hd * 256 + j]); }
        __syncthreads();
        if (wv < 4) {
#pragma unroll 1
            for (int tt = 0; tt < 32; ++tt) {
                const float vv = vs[tt * 256 + tid]; float o = 0.f;
#pragma unroll
                for (int j4 = 0; j4 < 32; ++j4) {
                    const f32x4 e4 = *(const LAS f32x4*)(es + tt * 128 + 4 * j4), k4 = *(const LAS f32x4*)(ks + tt * 128 + 4 * j4), q4 = *(const LAS f32x4*)(qs + tt * 128 + 4 * j4);
#pragma unroll
                    for (int jj = 0; jj < 4; ++jj) { const int j = 4 * j4 + jj; S[j] = S[j] * e4[jj] + k4[jj] * vv; o += q4[jj] * S[j]; } }
                os[tt * 256 + tid] = o;
            }
        }
        __syncthreads();
#pragma unroll 1
        for (int i = 0; i < 4; ++i) { const int tt = wv + 8 * i;
            const f32x4 o4 = *(const LAS f32x4*)(os + tt * 256 + 4 * lane);
            const float ss = wave_sum(o4.x * o4.x + o4.y * o4.y + o4.z * o4.z + o4.w * o4.w);
            const float rs = 1.0f / sqrtf(ss * (1.0f / 256.0f) + 1e-6f);
            const f32x4 gn = *(const f32x4*)(p.od_onorm + 4 * lane);
            const u32x2 og = *(const u32x2*)(P + (tg0 + tt) * OD_IN + 2048 + hd * 256 + 4 * lane);
            const float g0 = bflo(og.x), g1 = bfhi(og.x), g2 = bflo(og.y), g3 = bfhi(og.y);
            u32x2 w; w.x = pk2(o4.x * rs * gn.x * g0 * sigmoidf_(g0), o4.y * rs * gn.y * g1 * sigmoidf_(g1)); w.y = pk2(o4.z * rs * gn.z * g2 * sigmoidf_(g2), o4.w * rs * gn.w * g3 * sigmoidf_(g3));
            *(u32x2*)(MIX + (tg0 + tt) * 1024 + hd * 256 + 4 * lane) = w; }
        __syncthreads();
    }
}

__device__ __forceinline__ void xattn_naive(const Ctx& c, const Params& p, int unit) {
    const int b = unit >> 5, hh = (unit >> 3) & 3, tblk = unit & 7, tid = c.tid, lane = c.lane, wv = c.wave;
    LAS bf16_t* Ks = (LAS bf16_t*)c.shm;
    LAS bf16_t* Vs = (LAS bf16_t*)(c.shm + 256 * 272);
    LAS float* qf = (LAS float*)(c.shm + 256 * 272 + 256 * 256) + wv * 384;
    LAS float* pr = qf + 128;
    const bf16_t* MKV = (const bf16_t*)(p.ws + OFF_MKV); const bf16_t* Q = (const bf16_t*)(p.ws + OFF_P); bf16_t* OA = (bf16_t*)(p.ws + OFF_P + 32 * MiB);
    __syncthreads();
#pragma unroll 1
    for (int i = 0; i < 16; ++i) {
        const int task = tid + 512 * i, which = task >> 12, r = (task >> 4) & 255, ck = task & 15;
        const u32x4 d = *(const u32x4*)(MKV + ((size_t)b * MEMLEN + r) * 1024 + which * 512 + hh * 128 + ck * 8);
        if (which == 0) *(LAS u32x4*)(Ks + r * 136 + ck * 8) = d; else *(LAS u32x4*)(Vs + r * 128 + ck * 8) = d;
    }
    __syncthreads();
#pragma unroll 1
    for (int qq = 0; qq < 64; ++qq) {
        const size_t tq = (size_t)b * SEQ + tblk * 512 + wv * 64 + qq;
        qf[lane] = bf2f(Q[tq * 512 + hh * 128 + lane]) * 0.08838834764831845f; qf[lane + 64] = bf2f(Q[tq * 512 + hh * 128 + 64 + lane]) * 0.08838834764831845f;
        LDS_WAIT();
        float s[4];
#pragma unroll
        for (int j = 0; j < 4; ++j) { const int kp = lane + 64 * j; float a = 0.f;
#pragma unroll
            for (int ck = 0; ck < 16; ++ck) { const u32x4 kk = *(const LAS u32x4*)(Ks + kp * 136 + ck * 8);
                const f32x4 q0 = *(const LAS f32x4*)(qf + ck * 8), q1 = *(const LAS f32x4*)(qf + ck * 8 + 4);
                a += bflo(kk.x) * q0.x + bfhi(kk.x) * q0.y + bflo(kk.y) * q0.z + bfhi(kk.y) * q0.w + bflo(kk.z) * q1.x + bfhi(kk.z) * q1.y + bflo(kk.w) * q1.z + bfhi(kk.w) * q1.w; }
            s[j] = a; }
        const float m = wave_max(fmaxf(fmaxf(s[0], s[1]), fmaxf(s[2], s[3])));
        float den = 0.f;
#pragma unroll
        for (int j = 0; j < 4; ++j) { const float e = __expf(s[j] - m); pr[lane + 64 * j] = e; den += e; }
        den = wave_sum(den);
        LDS_WAIT();
        float o0 = 0.f, o1 = 0.f;
#pragma unroll 4
        for (int k4 = 0; k4 < 64; ++k4) { const f32x4 p4 = *(const LAS f32x4*)(pr + 4 * k4);
#pragma unroll
            for (int kk = 0; kk < 4; ++kk) { const unsigned vv = *(const LAS unsigned*)(Vs + (4 * k4 + kk) * 128 + 2 * lane); o0 += p4[kk] * bflo(vv); o1 += p4[kk] * bfhi(vv); } }
        const float inv = 1.0f / den;
        *(unsigned*)(OA + tq * 512 + hh * 128 + 2 * lane) = pk2(o0 * inv, o1 * inv);
    }
}

__device__ __forceinline__ void moe_slots(const Ctx& c, const Params& p, int layer) {
    LAS int* sh = (LAS int*)c.shm;
    const int* cnt = (const int*)(p.ws + OFF_CTL + CTL_CNT) + layer * 32; int* cur = (int*)(p.ws + OFF_CTL + CTL_CUR) + layer * 32;
    int* blk = (int*)(p.ws + OFF_CTL + CTL_BLK) + layer * 1024;
    __syncthreads();
    if (c.tid == 0) { int acc = 0; for (int e = 0; e < NEXP; ++e) { sh[e] = acc; acc += (cnt[e] + 255) / 256 * 256; } sh[32] = acc; }
    __syncthreads();
    if (blockIdx.x == 0 && c.tid < NEXP) { const int e = c.tid, s = sh[e] / 256, en = (e == NEXP - 1 ? sh[32] : sh[e + 1]) / 256; for (int i = s; i < en; ++i) blk[1 + i] = e; if (e == 0) blk[0] = sh[32] / 256; }
    const int2* RE = (const int2*)(p.ws + OFF_ROUTE); int2* RP = (int2*)(p.ws + OFF_ROUTE + 512 * 1024);
    const bf16_t* H = (const bf16_t*)(p.ws + OFF_H); bf16_t* XB = (bf16_t*)(p.ws + OFF_P);
    for (int ck = c.gw; ck < T_TOK / 64; ck += c.ngw) {
        const int t = ck * 64 + c.lane; const int2 ee = RE[t]; int pos0 = 0, pos1 = 0;
#pragma unroll 1
        for (int e = 0; e < NEXP; ++e) {
            const unsigned long long m0 = __ballot(ee.x == e), m1 = __ballot(ee.y == e);
            const int n0 = __popcll(m0), n1 = __popcll(m1);
            if (n0 + n1 == 0) continue;
            int base = 0; if (c.lane == 0) base = atomicAdd(&cur[e], n0 + n1);
            base = __shfl(base, 0) + sh[e];
            const unsigned long long lt = (1ull << c.lane) - 1ull;
            if (ee.x == e) pos0 = base + __popcll(m0 & lt);
            if (ee.y == e) pos1 = base + n0 + __popcll(m1 & lt);
        }
        RP[t] = make_int2(pos0, pos1);
#pragma unroll 1
        for (int i = 0; i < 64; ++i) { const int ti = ck * 64 + i, q0 = __shfl(pos0, i), q1 = __shfl(pos1, i);
            const u32x4 a = *((const u32x4*)(H + (size_t)ti * 1024) + c.lane), bq = *((const u32x4*)(H + (size_t)ti * 1024) + 64 + c.lane);
            *((u32x4*)(XB + (size_t)q0 * 1024) + c.lane) = a; *((u32x4*)(XB + (size_t)q0 * 1024) + 64 + c.lane) = bq;
            *((u32x4*)(XB + (size_t)q1 * 1024) + c.lane) = a; *((u32x4*)(XB + (size_t)q1 * 1024) + 64 + c.lane) = bq; }
    }
}
typedef short bf16x8_t __attribute__((ext_vector_type(8)));
constexpr size_t R_GK = 0, R_QT = 64 * MiB, R_ATT = 96 * MiB, R_KHT = 112 * MiB, R_GDEC = 144 * MiB;
template <int CTRL, int RMASK> __device__ __forceinline__ float dpp_get0(float x) {
    return __builtin_bit_cast(float, __builtin_amdgcn_update_dpp(0, __builtin_bit_cast(int, x), CTRL, RMASK, 0xF, false)); }
__device__ __forceinline__ float wave_scan_incl(float x, int lane) {
    (void)lane;
    x += dpp_get0<0x111, 0xF>(x); x += dpp_get0<0x112, 0xF>(x); x += dpp_get0<0x114, 0xF>(x); x += dpp_get0<0x118, 0xF>(x);
    x += dpp_get0<0x142, 0xA>(x); x += dpp_get0<0x143, 0xC>(x);
    return x;
}
__device__ __forceinline__ float lane63(float x) { return __builtin_bit_cast(float, __builtin_amdgcn_readlane(__builtin_bit_cast(int, x), 63)); }
__device__ __forceinline__ int key_perm(int key) { const int kq = key & 31; return (key & ~31) + 8 * ((kq >> 2) & 3) + 4 * ((kq >> 4) & 1) + (kq & 3); }
__device__ __forceinline__ bf16x8_t zero_frag() { return (bf16x8_t){0, 0, 0, 0, 0, 0, 0, 0}; }
__device__ __forceinline__ bf16x8_t lds_frag(const LAS bf16_t* img, int pitch, int row, int col) { return *(const LAS bf16x8_t*)(img + row * pitch + col); }
__device__ __forceinline__ bf16x8_t pack8(const float (&v)[8]) {
    u32x4 w; w.x = pk2(v[0], v[1]); w.y = pk2(v[2], v[3]); w.z = pk2(v[4], v[5]); w.w = pk2(v[6], v[7]);
    return __builtin_bit_cast(bf16x8_t, w);
}
__device__ __forceinline__ void gla_prep(const Ctx& c, const Params& p, int unit) {
    const int bh = unit >> 6, ck = unit & 63, b = bh >> 2, hd = bh & 3, lane = c.lane, wv = c.wave;
    LAS bf16_t* Qs = (LAS bf16_t*)c.shm;
    LAS bf16_t* Ks = Qs + 64 * 136;
    const bf16_t* P = (const bf16_t*)(p.ws + OFF_P); unsigned char* R = p.ws + OFF_R;
    const float* GK = (const float*)(R + R_GK); bf16_t* QT = (bf16_t*)(R + R_QT) + (size_t)unit * 64 * 128; bf16_t* ATT = (bf16_t*)(R + R_ATT) + (size_t)unit * 64 * 64;
    bf16_t* KHT = (bf16_t*)(R + R_KHT) + (size_t)unit * 128 * 64; float* GDEC = (float*)(R + R_GDEC) + (size_t)unit * 128;
    const size_t tg = (size_t)b * SEQ + ck * 64 + lane; const int d0 = wv * 16;
    __syncthreads();
    {
        const bf16_t* row = P + tg * OD_IN;
        const u32x4 qa = *(const u32x4*)(row + hd * 128 + d0), qb = *(const u32x4*)(row + hd * 128 + d0 + 8);
        const u32x4 ka = *(const u32x4*)(row + 512 + hd * 128 + d0), kb = *(const u32x4*)(row + 512 + hd * 128 + d0 + 8);
        const unsigned qw[8] = {qa.x, qa.y, qa.z, qa.w, qb.x, qb.y, qb.z, qb.w}, kw[8] = {ka.x, ka.y, ka.z, ka.w, kb.x, kb.y, kb.z, kb.w};
        float qt[16], kt[16], kh[16];
#pragma unroll
        for (int i4 = 0; i4 < 4; ++i4) { const f32x4 g4 = *(const f32x4*)(GK + tg * 512 + hd * 128 + d0 + 4 * i4);
#pragma unroll
            for (int ii = 0; ii < 4; ++ii) { const int i = 4 * i4 + ii;
                const float bb = wave_scan_incl(g4[ii], lane); const float bl = lane63(bb);
                const float qv = (i & 1) ? bfhi(qw[i >> 1]) : bflo(qw[i >> 1]), kv = (i & 1) ? bfhi(kw[i >> 1]) : bflo(kw[i >> 1]);
                qt[i] = qv * 0.08838834764831845f * __expf(bb); kt[i] = kv * __expf(-bb); kh[i] = kv * __expf(bl - bb);
                if (lane == 63) GDEC[d0 + i] = __expf(bl); } }
        { u32x4 w0, w1; w0.x = pk2(qt[0], qt[1]); w0.y = pk2(qt[2], qt[3]); w0.z = pk2(qt[4], qt[5]); w0.w = pk2(qt[6], qt[7]); w1.x = pk2(qt[8], qt[9]); w1.y = pk2(qt[10], qt[11]); w1.z = pk2(qt[12], qt[13]); w1.w = pk2(qt[14], qt[15]);
          *(LAS u32x4*)(Qs + lane * 136 + d0) = w0; *(LAS u32x4*)(Qs + lane * 136 + d0 + 8) = w1; }
        { u32x4 w0, w1; w0.x = pk2(kt[0], kt[1]); w0.y = pk2(kt[2], kt[3]); w0.z = pk2(kt[4], kt[5]); w0.w = pk2(kt[6], kt[7]); w1.x = pk2(kt[8], kt[9]); w1.y = pk2(kt[10], kt[11]); w1.z = pk2(kt[12], kt[13]); w1.w = pk2(kt[14], kt[15]);
          *(LAS u32x4*)(Ks + lane * 136 + d0) = w0; *(LAS u32x4*)(Ks + lane * 136 + d0 + 8) = w1; }
        { const int sg = d0 >> 5, hb = (d0 >> 4) & 1;
#pragma unroll
          for (int x4 = 0; x4 < 4; ++x4) { u32x2 w; w.x = pk2(qt[4 * x4], qt[4 * x4 + 1]); w.y = pk2(qt[4 * x4 + 2], qt[4 * x4 + 3]);
              *(u32x2*)(QT + lane * 128 + 32 * sg + 8 * x4 + 4 * hb) = w; } }
        { const int sc = key_perm(lane);
#pragma unroll
          for (int i = 0; i < 16; ++i) KHT[(d0 + i) * 64 + sc] = (bf16_t)f2bf(kh[i]); }
    }
    __syncthreads();
    const int fr = lane & 15, fq = lane >> 4;
#pragma unroll
    for (int h2 = 0; h2 < 2; ++h2) { const int tile = 2 * wv + h2, si = tile >> 2, ti = tile & 3;
        f32x4 acc = (f32x4){0.f, 0.f, 0.f, 0.f};
        if (si <= ti) {
#pragma unroll
            for (int kk = 0; kk < 4; ++kk) { const bf16x8_t a = *(const LAS bf16x8_t*)(Ks + (16 * si + fr) * 136 + 32 * kk + 8 * fq), bq = *(const LAS bf16x8_t*)(Qs + (16 * ti + fr) * 136 + 32 * kk + 8 * fq);
                acc = __builtin_amdgcn_mfma_f32_16x16x32_bf16(a, bq, acc, 0, 0, 0); } }
        const int t = 16 * ti + fr, s0 = 16 * si + 4 * fq;
        u32x2 w; w.x = pk2(s0 <= t ? acc[0] : 0.f, s0 + 1 <= t ? acc[1] : 0.f); w.y = pk2(s0 + 2 <= t ? acc[2] : 0.f, s0 + 3 <= t ? acc[3] : 0.f);
        *(u32x2*)(ATT + t * 64 + 32 * (si >> 1) + 8 * fq + 4 * (si & 1)) = w; }
}
constexpr int GB_QT = 0, GB_ATT = 64 * 136 * 2, GB_KHT = GB_ATT + 64 * 72 * 2, GB_GD = GB_KHT + 128 * 72 * 2, GB_BYTES = GB_GD + 512;
__device__ __forceinline__ void gla_state_fill(const Params& p, unsigned char* buf, int unit, int ptid) {
    const unsigned char* R = p.ws + OFF_R;
    const bf16_t* QT = (const bf16_t*)(R + R_QT) + (size_t)unit * 64 * 128; const bf16_t* ATT = (const bf16_t*)(R + R_ATT) + (size_t)unit * 64 * 64;
    const bf16_t* KHT = (const bf16_t*)(R + R_KHT) + (size_t)unit * 128 * 64; const float* GDEC = (const float*)(R + R_GDEC) + (size_t)unit * 128;
    u32x4 r[11];
#pragma unroll
    for (int i = 0; i < 4; ++i) r[i] = *((const u32x4*)QT + ptid + 256 * i);
#pragma unroll
    for (int i = 0; i < 2; ++i) r[4 + i] = *((const u32x4*)ATT + ptid + 256 * i);
#pragma unroll
    for (int i = 0; i < 4; ++i) r[6 + i] = *((const u32x4*)KHT + ptid + 256 * i);
    if (ptid < 32) r[10] = *((const u32x4*)GDEC + ptid);
#pragma unroll
    for (int i = 0; i < 4; ++i) { const int idx = ptid + 256 * i; *(LAS u32x4*)(buf + GB_QT + (idx >> 4) * 272 + (idx & 15) * 16) = r[i]; }
#pragma unroll
    for (int i = 0; i < 2; ++i) { const int idx = ptid + 256 * i; *(LAS u32x4*)(buf + GB_ATT + (idx >> 3) * 144 + (idx & 7) * 16) = r[4 + i]; }
#pragma unroll
    for (int i = 0; i < 4; ++i) { const int idx = ptid + 256 * i; *(LAS u32x4*)(buf + GB_KHT + (idx >> 3) * 144 + (idx & 7) * 16) = r[6 + i]; }
    if (ptid < 32) *(LAS u32x4*)(buf + GB_GD + ptid * 16) = r[10];
}
__device__ __forceinline__ void gla_state(const Ctx& c, const Params& p, int bh, int slice) {
    const int b = bh >> 2, hd = bh & 3, lane = c.lane, wv = c.wave, fr = lane & 15, fq = lane >> 4, jt = slice * 4 + (wv & 3);
    const bf16_t* P = (const bf16_t*)(p.ws + OFF_P); bf16_t* O = (bf16_t*)p.out;
    unsigned char* sm = c.shm;
    f32x4 S[8];
#pragma unroll
    for (int i = 0; i < 8; ++i) S[i] = (f32x4){0.f, 0.f, 0.f, 0.f};
    bf16x8_t idf;
    { float iv[8];
#pragma unroll
      for (int e = 0; e < 8; ++e) iv[e] = (8 * fq + e == fr) ? 1.0f : 0.0f;
      idf = pack8(iv); }
    const size_t tb = (size_t)b * SEQ; const bf16_t* vcol = P + 1024 + hd * 256 + 16 * jt + 8 * fq;
    bf16x8_t vraw[4];
#pragma unroll
    for (int st = 0; st < 4; ++st) { vraw[st] = zero_frag(); if (wv < 4 && fq < 2) vraw[st] = *(const bf16x8_t*)(vcol + (tb + 16 * st + fr) * OD_IN); }
    __syncthreads();
    if (wv >= 4) gla_state_fill(p, sm, bh * 64, c.tid - 256);
    __syncthreads();
#pragma unroll 1
    for (int ck = 0; ck < 64; ++ck) {
        unsigned char* buf = sm + (ck & 1) * GB_BYTES;
        if (wv >= 4) { if (ck + 1 < 64) gla_state_fill(p, sm + ((ck + 1) & 1) * GB_BYTES, bh * 64 + ck + 1, c.tid - 256); }
        else {
            const size_t t0 = tb + ck * 64;
            const LAS bf16_t* QT = (const LAS bf16_t*)(buf + GB_QT); const LAS bf16_t* ATT = (const LAS bf16_t*)(buf + GB_ATT); const LAS bf16_t* KHT = (const LAS bf16_t*)(buf + GB_KHT); const LAS float* GD = (const LAS float*)(buf + GB_GD);
            bf16x8_t vf[2];
            { f32x4 vt[4];
#pragma unroll
              for (int st = 0; st < 4; ++st) vt[st] = __builtin_amdgcn_mfma_f32_16x16x32_bf16(vraw[st], idf, (f32x4){0.f, 0.f, 0.f, 0.f}, 0, 0, 0);
#pragma unroll
              for (int s2 = 0; s2 < 2; ++s2) { const float vv[8] = {vt[2 * s2][0], vt[2 * s2][1], vt[2 * s2][2], vt[2 * s2][3], vt[2 * s2 + 1][0], vt[2 * s2 + 1][1], vt[2 * s2 + 1][2], vt[2 * s2 + 1][3]}; vf[s2] = pack8(vv); } }
            if (ck + 1 < 64) {
#pragma unroll
                for (int st = 0; st < 4; ++st) if (fq < 2) vraw[st] = *(const bf16x8_t*)(vcol + (t0 + 64 + 16 * st + fr) * OD_IN); }
            f32x4 acc[4];
#pragma unroll
            for (int ti = 0; ti < 4; ++ti) acc[ti] = (f32x4){0.f, 0.f, 0.f, 0.f};
#pragma unroll
            for (int sg = 0; sg < 4; ++sg) { const float sv[8] = {S[2 * sg][0], S[2 * sg][1], S[2 * sg][2], S[2 * sg][3], S[2 * sg + 1][0], S[2 * sg + 1][1], S[2 * sg + 1][2], S[2 * sg + 1][3]};
                const bf16x8_t a = pack8(sv);
#pragma unroll
                for (int ti = 0; ti < 4; ++ti) acc[ti] = __builtin_amdgcn_mfma_f32_16x16x32_bf16(a, lds_frag(QT, 136, 16 * ti + fr, 32 * sg + 8 * fq), acc[ti], 0, 0, 0); }
#pragma unroll
            for (int s2 = 0; s2 < 2; ++s2)
#pragma unroll
                for (int ti = 0; ti < 4; ++ti) acc[ti] = __builtin_amdgcn_mfma_f32_16x16x32_bf16(vf[s2], lds_frag(ATT, 72, 16 * ti + fr, 32 * s2 + 8 * fq), acc[ti], 0, 0, 0);
#pragma unroll
            for (int ti = 0; ti < 4; ++ti) { u32x2 w; w.x = pk2(acc[ti][0], acc[ti][1]); w.y = pk2(acc[ti][2], acc[ti][3]);
                *(u32x2*)(O + (t0 + 16 * ti + fr) * 1024 + hd * 256 + 16 * jt + 4 * fq) = w; }
#pragma unroll
            for (int rt = 0; rt < 8; ++rt) { const f32x4 g4 = *(const LAS f32x4*)(GD + 16 * rt + 4 * fq); f32x4 s = S[rt] * g4;
#pragma unroll
                for (int s2 = 0; s2 < 2; ++s2) s = __builtin_amdgcn_mfma_f32_16x16x32_bf16(lds_frag(KHT, 72, 16 * rt + fr, 32 * s2 + 8 * fq), vf[s2], s, 0, 0, 0);
                S[rt] = s; }
        }
        __syncthreads();
    }
}
__device__ __forceinline__ void gla_finish(const Ctx& c, const Params& p) {
    const bf16_t* P = (const bf16_t*)(p.ws + OFF_P); bf16_t* O = (bf16_t*)p.out;
    const f32x4 gn = *((const f32x4*)p.od_onorm + c.lane);
    for (int r0 = c.gw; r0 < T_TOK; r0 += 2 * c.ngw) {
        u32x2 ow[2][4], gw[2][4];
#pragma unroll
        for (int q = 0; q < 2; ++q)
#pragma unroll
            for (int j = 0; j < 4; ++j) { const size_t r = (size_t)(r0 + q * c.ngw); ow[q][j] = *((const u32x2*)(O + r * 1024 + 256 * j) + c.lane); gw[q][j] = *((const u32x2*)(P + r * OD_IN + 2048 + 256 * j) + c.lane); }
#pragma unroll
        for (int q = 0; q < 2; ++q)
#pragma unroll
            for (int j = 0; j < 4; ++j) { const size_t r = (size_t)(r0 + q * c.ngw);
                const float o0 = bflo(ow[q][j].x), o1 = bfhi(ow[q][j].x), o2 = bflo(ow[q][j].y), o3 = bfhi(ow[q][j].y);
                const float ss = wave_sum(o0 * o0 + o1 * o1 + o2 * o2 + o3 * o3); const float rs = 1.0f / sqrtf(ss * (1.0f / 256.0f) + 1e-6f);
                const float g0 = bflo(gw[q][j].x), g1 = bfhi(gw[q][j].x), g2 = bflo(gw[q][j].y), g3 = bfhi(gw[q][j].y);
                u32x2 w; w.x = pk2(o0 * rs * gn.x * g0 * sigmoidf_(g0), o1 * rs * gn.y * g1 * sigmoidf_(g1)); w.y = pk2(o2 * rs * gn.z * g2 * sigmoidf_(g2), o3 * rs * gn.w * g3 * sigmoidf_(g3));
                *((u32x2*)(O + r * 1024 + 256 * j) + c.lane) = w; }
    }
}
constexpr size_t R_MG = 0, R_NT = 32 * MiB, R_QG = 64 * MiB, R_Y0 = 96 * MiB, R_Z0 = 128 * MiB, R_GAM = 160 * MiB, R_BON = 161 * MiB, R_MEMN = 164 * MiB;
constexpr size_t WSM_W2T = 0, WSM_A2T = 64 * 1024;
constexpr size_t WSM_G2T = 512 * 1024;
constexpr int XI = 64 * 72 * 2;
constexpr int X_RHS = 11 * XI, X_DIAG = X_RHS + 34816, X_TI = X_DIAG + 4352, X_RED = X_TI + 3072;

struct RxPre { u32x4 c1[2], p1[2], cr[3], pr[3]; };
__device__ __forceinline__ void rwkv_x_fetch(RxPre& f, const bf16_t* P, int b, int hd, int ck, int tid, int lane, int wv) {
    const size_t tg0 = (size_t)b * SEQ + (size_t)ck * 64; const u32x4 z = (u32x4){0u, 0u, 0u, 0u};
#pragma unroll
    for (int i = 0; i < 2; ++i) { const int task = tid + 512 * i, tt = task >> 4, q = task & 15; const bf16_t* src = P + (tg0 + tt) * EV_IN + 768 + 1536 + 8 * q;
        f.c1[i] = *(const u32x4*)src; f.p1[i] = z; if (ck * 64 + tt > 0) f.p1[i] = *(const u32x4*)(src - EV_IN); }
    const bf16_t* src = P + (tg0 + lane) * EV_IN + 768 + hd * 64 + wv * 8; const bool hp = (ck * 64 + lane > 0);
#pragma unroll
    for (int w3 = 0; w3 < 3; ++w3) { f.cr[w3] = *(const u32x4*)(src + 512 * w3); f.pr[w3] = z; if (hp) f.pr[w3] = *(const u32x4*)(src + 512 * w3 - EV_IN); }
}
__device__ __forceinline__ void rwkv_x(const Ctx& c, const Params& p, int unit, RxPre& pre, int nb, int nhd, int nck) {
    const int bh = unit >> 6, ck = unit & 63, b = bh >> 3, hd = bh & 7, tid = c.tid, lane = c.lane, wv = c.wave, fr = lane & 15, fq = lane >> 4;
    unsigned char* sm = c.shm;
    LAS bf16_t* At = (LAS bf16_t*)sm; LAS bf16_t* Bt = (LAS bf16_t*)(sm + XI); LAS bf16_t* Kt = (LAS bf16_t*)(sm + 2 * XI); LAS bf16_t* Rt = (LAS bf16_t*)(sm + 3 * XI);
    LAS bf16_t* BH = (LAS bf16_t*)(sm + 4 * XI); LAS bf16_t* KH = (LAS bf16_t*)(sm + 5 * XI); LAS bf16_t* VT = (LAS bf16_t*)(sm + 6 * XI);
    LAS bf16_t* AAB = (LAS bf16_t*)(sm + 7 * XI); LAS bf16_t* AAK = (LAS bf16_t*)(sm + 8 * XI); LAS bf16_t* ARB = (LAS bf16_t*)(sm + 9 * XI); LAS bf16_t* ARK = (LAS bf16_t*)(sm + 10 * XI);
    LAS bf16_t* XT = At;
    LAS bf16_t* YT = Kt;
    LAS float* RHS = (LAS float*)(sm + X_RHS);
    LAS float* sXW = RHS; LAS float* sXA = RHS + 64 * 68;
    LAS float* DIAG = (LAS float*)(sm + X_DIAG);
    LAS bf16_t* TI = (LAS bf16_t*)(sm + X_TI);
    LAS float* red = (LAS float*)(sm + X_RED);
    const bf16_t* P = (const bf16_t*)(p.ws + OFF_P); unsigned char* R = p.ws + OFF_R;
    const size_t tg0 = (size_t)b * SEQ + (size_t)ck * 64;
    const int t = lane, cg = wv, ch0 = hd * 64 + cg * 8;
    __syncthreads();
#pragma unroll
    for (int i = 0; i < 2; ++i) {
        const int task = tid + 512 * i, tt = task >> 4, q = task & 15;
        const int col = 1536 + 8 * q; LAS bf16_t* dst = (q < 8 ? At + tt * 72 + 8 * q : Bt + tt * 72 + 8 * (q - 8));
        const u32x4 cur = pre.c1[i], prv = pre.p1[i];
        const f32x4 m0 = *(const f32x4*)(p.ev_mu + col), m1 = *(const f32x4*)(p.ev_mu + col + 4);
        const unsigned cw[4] = {cur.x, cur.y, cur.z, cur.w}, pw[4] = {prv.x, prv.y, prv.z, prv.w}; const float mu[8] = {m0.x, m0.y, m0.z, m0.w, m1.x, m1.y, m1.z, m1.w};
        float v[8];
#pragma unroll
        for (int k = 0; k < 4; ++k) { const float c0 = bflo(cw[k]), c1 = bfhi(cw[k]), p0 = bflo(pw[k]), p1 = bfhi(pw[k]); v[2 * k] = c0 + (p0 - c0) * mu[2 * k]; v[2 * k + 1] = c1 + (p1 - c1) * mu[2 * k + 1]; }
        if (q < 8) {
#pragma unroll
            for (int k = 0; k < 8; ++k) v[k] = tanhf_(v[k]); }
        { u32x4 w; w.x = pk2(v[0], v[1]); w.y = pk2(v[2], v[3]); w.z = pk2(v[4], v[5]); w.w = pk2(v[6], v[7]); *(LAS u32x4*)dst = w; }
    }
    float rv[8], kv[8], vv[8];
    {
#pragma unroll
        for (int w3 = 0; w3 < 3; ++w3) { const u32x4 cur = pre.cr[w3], prv = pre.pr[w3];
            const f32x4 m0 = *(const f32x4*)(p.ev_mu + 512 * w3 + ch0), m1 = *(const f32x4*)(p.ev_mu + 512 * w3 + ch0 + 4);
            const unsigned cw[4] = {cur.x, cur.y, cur.z, cur.w}, pw[4] = {prv.x, prv.y, prv.z, prv.w}; const float mu[8] = {m0.x, m0.y, m0.z, m0.w, m1.x, m1.y, m1.z, m1.w};
#pragma unroll
            for (int k = 0; k < 4; ++k) { const float c0 = bflo(cw[k]), c1 = bfhi(cw[k]), p0 = bflo(pw[k]), p1 = bfhi(pw[k]);
                const float x0 = c0 + (p0 - c0) * mu[2 * k], x1 = c1 + (p1 - c1) * mu[2 * k + 1];
                if (w3 == 0) { rv[2 * k] = x0; rv[2 * k + 1] = x1; } else if (w3 == 1) { kv[2 * k] = x0; kv[2 * k + 1] = x1; } else { vv[2 * k] = x0; vv[2 * k + 1] = x1; } } }
    }
    if (nck >= 0) rwkv_x_fetch(pre, P, nb, nhd, nck, tid, lane, wv);
    __syncthreads();
    {
        const int mat = wv >> 2; const bf16_t* WT = (const bf16_t*)(p.ws + OFF_WSMALL + (mat ? WSM_A2T : WSM_W2T)); const LAS bf16_t* img = mat ? Bt : At; LAS float* dstm = mat ? sXA : sXW;
#pragma unroll
        for (int n = 0; n < 4; ++n) { const int tile = (wv & 3) * 4 + n, ct = tile >> 2, tt = tile & 3;
            f32x4 acc = (f32x4){0.f, 0.f, 0.f, 0.f};
#pragma unroll
            for (int kk = 0; kk < 2; ++kk) acc = __builtin_amdgcn_mfma_f32_16x16x32_bf16(*(const bf16x8_t*)(WT + (size_t)(hd * 64 + 16 * ct + fr) * 64 + 32 * kk + 8 * fq), lds_frag(img, 72, 16 * tt + fr, 32 * kk + 8 * fq), acc, 0, 0, 0);
            *(LAS f32x4*)(dstm + (16 * tt + fr) * 68 + 16 * ct + 4 * fq) = acc; }
    }
    __syncthreads();
    float zw[8], za[8];
    { const f32x4 a0 = *(const LAS f32x4*)(sXW + t * 68 + cg * 8), a1 = *(const LAS f32x4*)(sXW + t * 68 + cg * 8 + 4), b0 = *(const LAS f32x4*)(sXA + t * 68 + cg * 8), b1 = *(const LAS f32x4*)(sXA + t * 68 + cg * 8 + 4);
      zw[0] = a0.x; zw[1] = a0.y; zw[2] = a0.z; zw[3] = a0.w; zw[4] = a1.x; zw[5] = a1.y; zw[6] = a1.z; zw[7] = a1.w;
      za[0] = b0.x; za[1] = b0.y; za[2] = b0.z; za[3] = b0.w; za[4] = b1.x; za[5] = b1.y; za[6] = b1.z; za[7] = b1.w; }
    float lw[8], av[8], kkv[8], kp[8]; float ss = 0.f, sb = 0.f;
#pragma unroll
    for (int i = 0; i < 8; ++i) { const int ch = ch0 + i;
        const float u = -(p.ev_w0[ch] + zw[i]); const float sp = (u > 20.f) ? u : __logf(1.0f + __expf(u));
        lw[i] = -__expf(-sp - 0.5f);
        av[i] = sigmoidf_(p.ev_a0[ch] + za[i]);
        kkv[i] = kv[i] * p.ev_k_k[ch]; ss += kkv[i] * kkv[i];
        kp[i] = kv[i] * (1.0f + (av[i] - 1.0f) * p.ev_k_a[ch]);
        sb += rv[i] * kp[i] * p.ev_r_k[ch]; }
    red[t * 8 + cg] = ss; red[512 + t * 8 + cg] = sb;
    __syncthreads();
    {
        float tot = 0.f, bon = 0.f;
#pragma unroll
        for (int i = 0; i < 8; ++i) { tot += red[t * 8 + i]; bon += red[512 + t * 8 + i]; }
        if (cg == 0) ((float*)(R + R_BON))[(tg0 + t) * 8 + hd] = bon;
        const float inv = __builtin_amdgcn_rcpf(fmaxf(sqrtf(tot), 1e-12f));
        float at[8], rt_[8], bt[8], kt[8], bh_[8], kh_[8];
#pragma unroll
        for (int i = 0; i < 8; ++i) {
            const float cl = wave_scan_incl(lw[i], lane); const float cl63 = lane63(cl);
            const float e1 = __expf(cl), e0 = __expf(cl - lw[i]), en = __expf(-cl), eh = __expf(cl63 - cl);
            const float kn = kkv[i] * inv, A = -kn, Bv = kn * av[i];
            at[i] = A * e0; rt_[i] = rv[i] * e1; bt[i] = Bv * en; kt[i] = kp[i] * en; bh_[i] = Bv * eh; kh_[i] = kp[i] * eh;
            if (lane == 63) ((float*)(R + R_GAM))[(size_t)unit * 64 + cg * 8 + i] = __expf(cl63); }
        { u32x4 w; w.x = pk2(at[0], at[1]); w.y = pk2(at[2], at[3]); w.z = pk2(at[4], at[5]); w.w = pk2(at[6], at[7]); *(LAS u32x4*)(At + t * 72 + cg * 8) = w; }
        { u32x4 w; w.x = pk2(rt_[0], rt_[1]); w.y = pk2(rt_[2], rt_[3]); w.z = pk2(rt_[4], rt_[5]); w.w = pk2(rt_[6], rt_[7]); *(LAS u32x4*)(Rt + t * 72 + cg * 8) = w; }
        { u32x4 w; w.x = pk2(bt[0], bt[1]); w.y = pk2(bt[2], bt[3]); w.z = pk2(bt[4], bt[5]); w.w = pk2(bt[6], bt[7]); *(LAS u32x4*)(Bt + t * 72 + cg * 8) = w; }
        { u32x4 w; w.x = pk2(kt[0], kt[1]); w.y = pk2(kt[2], kt[3]); w.z = pk2(kt[4], kt[5]); w.w = pk2(kt[6], kt[7]); *(LAS u32x4*)(Kt + t * 72 + cg * 8) = w; }
        *(LAS f32x4*)(RHS + t * 132 + 64 + cg * 8) = (f32x4){at[0], at[1], at[2], at[3]}; *(LAS f32x4*)(RHS + t * 132 + 64 + cg * 8 + 4) = (f32x4){at[4], at[5], at[6], at[7]};
#pragma unroll
        for (int i = 0; i < 8; ++i) { BH[(cg * 8 + i) * 72 + t] = (bf16_t)f2bf(bh_[i]); KH[(cg * 8 + i) * 72 + t] = (bf16_t)f2bf(kh_[i]); VT[(cg * 8 + i) * 72 + t] = (bf16_t)f2bf(vv[i]); }
    }
    __syncthreads();
    {
        const int mat = wv >> 1;
        const LAS bf16_t* Ximg = (mat < 2) ? At : Rt; const LAS bf16_t* Yimg = (mat & 1) ? Kt : Bt;
        LAS bf16_t* Oimg = mat == 0 ? AAB : (mat == 1 ? AAK : (mat == 2 ? ARB : ARK));
#pragma unroll 4
        for (int n = 0; n < 8; ++n) { const int idx = (wv & 1) * 8 + n, si = idx >> 2, ti = idx & 3;
            f32x4 acc = (f32x4){0.f, 0.f, 0.f, 0.f};
            if (si <= ti) {
#pragma unroll
                for (int kk = 0; kk < 2; ++kk) acc = __builtin_amdgcn_mfma_f32_16x16x32_bf16(lds_frag(Yimg, 72, 16 * si + fr, 32 * kk + 8 * fq), lds_frag(Ximg, 72, 16 * ti + fr, 32 * kk + 8 * fq), acc, 0, 0, 0); }
            const int tt = 16 * ti + fr, s0 = 16 * si + 4 * fq; const int lim = (mat < 2) ? tt - 1 : tt;
            const float o0 = s0 <= lim ? acc[0] : 0.f, o1 = s0 + 1 <= lim ? acc[1] : 0.f, o2 = s0 + 2 <= lim ? acc[2] : 0.f, o3 = s0 + 3 <= lim ? acc[3] : 0.f;
            u32x2 w; w.x = pk2(o0, o1); w.y = pk2(o2, o3); *(LAS u32x2*)(Oimg + tt * 72 + s0) = w;
            if (mat == 0 && si == ti) { LAS float* d = DIAG + si * 272 + fr * 17 + 4 * fq; d[0] = o0; d[1] = o1; d[2] = o2; d[3] = o3; } }
    }
    __syncthreads();
    if (wv < 4) {
#pragma unroll
        for (int ti = 0; ti < 4; ++ti) { f32x4 acc = (f32x4){0.f, 0.f, 0.f, 0.f};
#pragma unroll
            for (int kk = 0; kk < 2; ++kk) acc = __builtin_amdgcn_mfma_f32_16x16x32_bf16(lds_frag(AAK, 72, 16 * ti + fr, 32 * kk + 8 * fq), lds_frag(VT, 72, 16 * wv + fr, 32 * kk + 8 * fq), acc, 0, 0, 0);
#pragma unroll
            for (int r = 0; r < 4; ++r) RHS[(16 * ti + 4 * fq + r) * 132 + 16 * wv + fr] = acc[r]; }
    } else if (lane < 16) { const int I = wv - 4; const LAS float* d = DIAG + I * 272; float T[16];
#pragma unroll
        for (int r = 0; r < 16; ++r) { float s = (r == lane) ? 1.f : 0.f;
#pragma unroll
            for (int q = 0; q < r; ++q) s += d[r * 17 + q] * T[q];
            T[r] = s; TI[I * 384 + r * 24 + lane] = (bf16_t)f2bf(s); } }
    __syncthreads();
#pragma unroll 1
    for (int I = 0; I < 4; ++I) {
        f32x4 acc;
#pragma unroll
        for (int r = 0; r < 4; ++r) acc[r] = RHS[(16 * I + 4 * fq + r) * 132 + 16 * wv + fr];
#pragma unroll 1
        for (int kk = 0; 32 * kk < 16 * I; ++kk) { const bool ok = (32 * kk + 8 * fq) < 16 * I;
            bf16x8_t a = zero_frag(), bq = zero_frag();
            if (ok) { a = lds_frag(AAB, 72, 16 * I + fr, 32 * kk + 8 * fq); bq = lds_frag(XT, 72, 16 * wv + fr, 32 * kk + 8 * fq); }
            acc = __builtin_amdgcn_mfma_f32_16x16x32_bf16(a, bq, acc, 0, 0, 0); }
        { u32x2 w; w.x = pk2(acc[0], acc[1]); w.y = pk2(acc[2], acc[3]); *(LAS u32x2*)(YT + (16 * wv + fr) * 24 + 4 * fq) = w; }
        LDS_WAIT();
        { bf16x8_t a = zero_frag(), bq = zero_frag();
          if (fq < 2) { a = *(const LAS bf16x8_t*)(TI + I * 384 + fr * 24 + 8 * fq); bq = *(const LAS bf16x8_t*)(YT + (16 * wv + fr) * 24 + 8 * fq); }
          f32x4 x = __builtin_amdgcn_mfma_f32_16x16x32_bf16(a, bq, (f32x4){0.f, 0.f, 0.f, 0.f}, 0, 0, 0);
          u32x2 w; w.x = pk2(x[0], x[1]); w.y = pk2(x[2], x[3]); *(LAS u32x2*)(XT + (16 * wv + fr) * 72 + 16 * I + 4 * fq) = w; }
        LDS_WAIT();
    }
    __syncthreads();
    {
        const int mat = wv >> 1;
        bf16_t* MG = (bf16_t*)(R + R_MG) + (size_t)unit * 4096; bf16_t* NT = (bf16_t*)(R + R_NT) + (size_t)unit * 4096;
        bf16_t* QG = (bf16_t*)(R + R_QG) + (size_t)unit * 4096; bf16_t* Y0G = (bf16_t*)(R + R_Y0) + (size_t)unit * 4096;
#pragma unroll 4
        for (int n = 0; n < 8; ++n) { const int idx = (wv & 1) * 8 + n, rt = idx >> 2, ct = idx & 3;
            f32x4 acc = (f32x4){0.f, 0.f, 0.f, 0.f};
            if (mat == 2) { const u32x2 r2 = *(const LAS u32x2*)(Rt + (16 * ct + fr) * 72 + 16 * rt + 4 * fq); acc = (f32x4){bflo(r2.x), bfhi(r2.x), bflo(r2.y), bfhi(r2.y)}; }
#pragma unroll
            for (int kk = 0; kk < 2; ++kk) { const int kc = 32 * kk + 8 * fq;
                if (mat == 0) acc = __builtin_amdgcn_mfma_f32_16x16x32_bf16(lds_frag(XT, 72, 64 + 16 * rt + fr, kc), lds_frag(BH, 72, 16 * ct + fr, kc), acc, 0, 0, 0);
                else if (mat == 1) { acc = __builtin_amdgcn_mfma_f32_16x16x32_bf16(lds_frag(BH, 72, 16 * rt + fr, kc), lds_frag(XT, 72, 16 * ct + fr, kc), acc, 0, 0, 0);
                                     acc = __builtin_amdgcn_mfma_f32_16x16x32_bf16(lds_frag(KH, 72, 16 * rt + fr, kc), lds_frag(VT, 72, 16 * ct + fr, kc), acc, 0, 0, 0); }
                else if (mat == 2) acc = __builtin_amdgcn_mfma_f32_16x16x32_bf16(lds_frag(XT, 72, 64 + 16 * rt + fr, kc), lds_frag(ARB, 72, 16 * ct + fr, kc), acc, 0, 0, 0);
                else { acc = __builtin_amdgcn_mfma_f32_16x16x32_bf16(lds_frag(XT, 72, 16 * rt + fr, kc), lds_frag(ARB, 72, 16 * ct + fr, kc), acc, 0, 0, 0);
                       acc = __builtin_amdgcn_mfma_f32_16x16x32_bf16(lds_frag(VT, 72, 16 * rt + fr, kc), lds_frag(ARK, 72, 16 * ct + fr, kc), acc, 0, 0, 0); } }
            u32x2 w; w.x = pk2(acc[0], acc[1]); w.y = pk2(acc[2], acc[3]);
            if (mat == 0) *(u32x2*)(MG + (16 * ct + fr) * 64 + 32 * (rt >> 1) + 8 * fq + 4 * (rt & 1)) = w;
            else if (mat == 1) *(u32x2*)(NT + (16 * ct + fr) * 64 + 16 * rt + 4 * fq) = w;
            else if (mat == 2) *(u32x2*)(QG + (16 * ct + fr) * 64 + 16 * rt + 4 * fq) = w;
            else *(u32x2*)(Y0G + (16 * ct + fr) * 64 + 16 * rt + 4 * fq) = w; }
    }
}

struct RwkvYOps { bf16x8_t m[4][2]; u32x2 n[4]; f32x4 g[4]; };
__device__ __forceinline__ void rwkv_y_load(RwkvYOps& o, const unsigned char* R, size_t unit, int jb, int fr, int fq) {
    const bf16_t* MG = (const bf16_t*)(R + R_MG) + unit * 4096; const bf16_t* NT = (const bf16_t*)(R + R_NT) + unit * 4096; const float* GAM = (const float*)(R + R_GAM) + unit * 64;
#pragma unroll
    for (int rt = 0; rt < 4; ++rt) {
#pragma unroll
        for (int sg = 0; sg < 2; ++sg) o.m[rt][sg] = *(const bf16x8_t*)(MG + (16 * rt + fr) * 64 + 32 * sg + 8 * fq);
        o.n[rt] = *(const u32x2*)(NT + (16 * jb + fr) * 64 + 16 * rt + 4 * fq); o.g[rt] = *(const f32x4*)(GAM + 16 * rt + 4 * fq); }
}
__device__ __forceinline__ void rwkv_y(const Ctx& c, const Params& p, int bh, int jb) {
    const int lane = c.lane, fr = lane & 15, fq = lane >> 4; unsigned char* R = p.ws + OFF_R;
    f32x4 Z[4];
#pragma unroll
    for (int i = 0; i < 4; ++i) Z[i] = (f32x4){0.f, 0.f, 0.f, 0.f};
    RwkvYOps cur, nxt; rwkv_y_load(cur, R, (size_t)bh * 64, jb, fr, fq);
#pragma unroll 1
    for (int ck = 0; ck < 64; ++ck) { const size_t unit = (size_t)bh * 64 + ck;
        rwkv_y_load(nxt, R, unit + (ck + 1 < 64 ? 1 : 0), jb, fr, fq);
        bf16_t* Z0 = (bf16_t*)(R + R_Z0) + unit * 4096;
        f32x4 acc[4];
#pragma unroll
        for (int rt = 0; rt < 4; ++rt) { u32x2 w; w.x = pk2(Z[rt][0], Z[rt][1]); w.y = pk2(Z[rt][2], Z[rt][3]); *(u32x2*)(Z0 + (16 * jb + fr) * 64 + 16 * rt + 4 * fq) = w;
            acc[rt] = (f32x4){bflo(cur.n[rt].x), bfhi(cur.n[rt].x), bflo(cur.n[rt].y), bfhi(cur.n[rt].y)} + cur.g[rt] * Z[rt]; }
        bf16x8_t zb[2];
#pragma unroll
        for (int sg = 0; sg < 2; ++sg) { const float zv[8] = {Z[2 * sg][0], Z[2 * sg][1], Z[2 * sg][2], Z[2 * sg][3], Z[2 * sg + 1][0], Z[2 * sg + 1][1], Z[2 * sg + 1][2], Z[2 * sg + 1][3]}; zb[sg] = pack8(zv); }
#pragma unroll
        for (int rt = 0; rt < 4; ++rt)
#pragma unroll
            for (int sg = 0; sg < 2; ++sg) acc[rt] = __builtin_amdgcn_mfma_f32_16x16x32_bf16(cur.m[rt][sg], zb[sg], acc[rt], 0, 0, 0);
#pragma unroll
        for (int rt = 0; rt < 4; ++rt) Z[rt] = acc[rt];
        cur = nxt;
    }
}

__device__ __forceinline__ void rwkv_z(const Ctx& c, const Params& p, int unit) {
    const int bh = unit >> 6, ck = unit & 63, b = bh >> 3, hd = bh & 7, lane = c.lane, fr = lane & 15, fq = lane >> 4; unsigned char* R = p.ws + OFF_R;
    const bf16_t* P = (const bf16_t*)(p.ws + OFF_P); bf16_t* MIX = (bf16_t*)p.out;
    const bf16_t* QG = (const bf16_t*)(R + R_QG) + (size_t)unit * 4096; const bf16_t* Y0G = (const bf16_t*)(R + R_Y0) + (size_t)unit * 4096; const bf16_t* Z0 = (const bf16_t*)(R + R_Z0) + (size_t)unit * 4096;
    const bf16_t* G2T = (const bf16_t*)(p.ws + OFF_WSMALL + WSM_G2T);
    const size_t tg0 = (size_t)b * SEQ + (size_t)ck * 64;
    f32x4 y[4][4], g[4][4];
#pragma unroll
    for (int jt = 0; jt < 4; ++jt)
#pragma unroll
        for (int tt = 0; tt < 4; ++tt) { const u32x2 w = *(const u32x2*)(Y0G + (16 * tt + fr) * 64 + 16 * jt + 4 * fq); y[jt][tt] = (f32x4){bflo(w.x), bfhi(w.x), bflo(w.y), bfhi(w.y)}; g[jt][tt] = (f32x4){0.f, 0.f, 0.f, 0.f}; }
#pragma unroll
    for (int sg = 0; sg < 2; ++sg) { bf16x8_t qb[4];
#pragma unroll
        for (int tt = 0; tt < 4; ++tt) qb[tt] = *(const bf16x8_t*)(QG + (16 * tt + fr) * 64 + 32 * sg + 8 * fq);
#pragma unroll
        for (int jt = 0; jt < 4; ++jt) { const bf16x8_t a = *(const bf16x8_t*)(Z0 + (16 * jt + fr) * 64 + 32 * sg + 8 * fq);
#pragma unroll
            for (int tt = 0; tt < 4; ++tt) y[jt][tt] = __builtin_amdgcn_mfma_f32_16x16x32_bf16(a, qb[tt], y[jt][tt], 0, 0, 0); } }
#pragma unroll 1
    for (int kk = 0; kk < 4; ++kk) { bf16x8_t sgf[4];
        const int col = 1664 + 32 * kk + 8 * fq; const f32x4 m0 = *(const f32x4*)(p.ev_mu + col), m1 = *(const f32x4*)(p.ev_mu + col + 4); const float mu[8] = {m0.x, m0.y, m0.z, m0.w, m1.x, m1.y, m1.z, m1.w};
#pragma unroll
        for (int tt = 0; tt < 4; ++tt) { const int tl = 16 * tt + fr; const bf16_t* src = P + (tg0 + tl) * EV_IN + 768 + col;
            const u32x4 cur = *(const u32x4*)src; u32x4 prv = (u32x4){0u, 0u, 0u, 0u}; if (ck * 64 + tl > 0) prv = *(const u32x4*)(src - EV_IN);
            const unsigned cw[4] = {cur.x, cur.y, cur.z, cur.w}, pw[4] = {prv.x, prv.y, prv.z, prv.w}; float v[8];
#pragma unroll
            for (int k = 0; k < 4; ++k) { const float c0 = bflo(cw[k]), c1 = bfhi(cw[k]), p0 = bflo(pw[k]), p1 = bfhi(pw[k]); v[2 * k] = sigmoidf_(c0 + (p0 - c0) * mu[2 * k]); v[2 * k + 1] = sigmoidf_(c1 + (p1 - c1) * mu[2 * k + 1]); }
            sgf[tt] = pack8(v); }
#pragma unroll
        for (int jt = 0; jt < 4; ++jt) { const bf16x8_t a = *(const bf16x8_t*)(G2T + (size_t)(hd * 64 + 16 * jt + fr) * 128 + 32 * kk + 8 * fq);
#pragma unroll
            for (int tt = 0; tt < 4; ++tt) g[jt][tt] = __builtin_amdgcn_mfma_f32_16x16x32_bf16(a, sgf[tt], g[jt][tt], 0, 0, 0); } }
#pragma unroll
    for (int tt = 0; tt < 4; ++tt) { const int tl = 16 * tt + fr;
        float s1 = 0.f;
#pragma unroll
        for (int jt = 0; jt < 4; ++jt) s1 += (y[jt][tt][0] + y[jt][tt][1]) + (y[jt][tt][2] + y[jt][tt][3]);
        s1 += __shfl_xor(s1, 16); s1 += __shfl_xor(s1, 32); const float mean = s1 * (1.0f / 64.0f);
        float s2 = 0.f;
#pragma unroll
        for (int jt = 0; jt < 4; ++jt)
#pragma unroll
            for (int r = 0; r < 4; ++r) { const float d = y[jt][tt][r] - mean; s2 += d * d; }
        s2 += __shfl_xor(s2, 16); s2 += __shfl_xor(s2, 32); const float rs = 1.0f / sqrtf(s2 * (1.0f / 64.0f) + 64e-5f);
        const float bon = ((const float*)(R + R_BON))[(tg0 + tl) * 8 + hd]; const bool hp = (ck * 64 + tl > 0);
#pragma unroll
        for (int jt = 0; jt < 4; ++jt) { const int ch = hd * 64 + 16 * jt + 4 * fq;
            const bf16_t* src = P + (tg0 + tl) * EV_IN + 768 + 1024 + ch; const u32x2 cur = *(const u32x2*)src; u32x2 prv; prv.x = 0u; prv.y = 0u; if (hp) prv = *(const u32x2*)(src - EV_IN);
            const f32x4 mu = *(const f32x4*)(p.ev_mu + 1024 + ch), lw4 = *(const f32x4*)(p.ev_lnx_w + ch), lb4 = *(const f32x4*)(p.ev_lnx_b + ch);
            const float c0 = bflo(cur.x), c1 = bfhi(cur.x), c2 = bflo(cur.y), c3 = bfhi(cur.y), p0 = bflo(prv.x), p1 = bfhi(prv.x), p2 = bflo(prv.y), p3 = bfhi(prv.y);
            const float v0 = c0 + (p0 - c0) * mu.x, v1 = c1 + (p1 - c1) * mu.y, v2 = c2 + (p2 - c2) * mu.z, v3 = c3 + (p3 - c3) * mu.w;
            const f32x4 yy = y[jt][tt], gg = g[jt][tt];
            const float o0 = ((yy[0] - mean) * rs * lw4.x + lb4.x + bon * v0) * gg[0], o1 = ((yy[1] - mean) * rs * lw4.y + lb4.y + bon * v1) * gg[1];
            const float o2 = ((yy[2] - mean) * rs * lw4.z + lb4.z + bon * v2) * gg[2], o3 = ((yy[3] - mean) * rs * lw4.w + lb4.w + bon * v3) * gg[3];
            u32x2 w; w.x = pk2(o0, o1); w.y = pk2(o2, o3); *(u32x2*)(MIX + (tg0 + tl) * 1024 + 512 + ch) = w; } }
}

__device__ __forceinline__ void xattn_mfma(const Ctx& c, const Params& p, int unit) {
    const int b = unit >> 5, hh = (unit >> 3) & 3, tblk = unit & 7, tid = c.tid, lane = c.lane, wv = c.wave, fr = lane & 15, fq = lane >> 4;
    LAS bf16_t* Ks = (LAS bf16_t*)c.shm;
    LAS bf16_t* VTp = (LAS bf16_t*)(c.shm + 256 * 272);
    const bf16_t* MKV = (const bf16_t*)(p.ws + OFF_MKV); const bf16_t* Q = (const bf16_t*)(p.ws + OFF_P); bf16_t* OA = (bf16_t*)(p.ws + OFF_P + 32 * MiB);
    __syncthreads();
#pragma unroll 1
    for (int i = 0; i < 16; ++i) {
        const int task = tid + 512 * i, which = task >> 12, r = (task >> 4) & 255, ck = task & 15;
        const u32x4 d = *(const u32x4*)(MKV + ((size_t)b * MEMLEN + r) * 1024 + which * 512 + hh * 128 + ck * 8);
        if (which == 0) *(LAS u32x4*)(Ks + r * 136 + ck * 8) = d;
        else { const int kc = key_perm(r); const unsigned w[4] = {d.x, d.y, d.z, d.w};
#pragma unroll
            for (int k = 0; k < 4; ++k) { VTp[(ck * 8 + 2 * k) * 264 + kc] = (bf16_t)(w[k] & 0xFFFFu); VTp[(ck * 8 + 2 * k + 1) * 264 + kc] = (bf16_t)(w[k] >> 16); } }
    }
    __syncthreads();
#pragma unroll 1
    for (int qt = 0; qt < 4; ++qt) {
        const size_t tq = (size_t)b * SEQ + tblk * 512 + wv * 64 + qt * 16 + fr;
        bf16x8_t qf[4];
#pragma unroll
        for (int kk = 0; kk < 4; ++kk) qf[kk] = *(const bf16x8_t*)(Q + tq * 512 + hh * 128 + 32 * kk + 8 * fq);
        float qsc;
        { const f32x4* sp = (const f32x4*)((const float*)(p.ws + OFF_R + R_SSP) + tq * 16); const f32x4 s0 = sp[0], s1 = sp[1], s2 = sp[2], s3 = sp[3];
          const float ssq = ((s0.x + s0.y) + (s0.z + s0.w)) + ((s1.x + s1.y) + (s1.z + s1.w)) + ((s2.x + s2.y) + (s2.z + s2.w)) + ((s3.x + s3.y) + (s3.z + s3.w));
          qsc = 0.08838834764831845f / sqrtf(ssq * (1.0f / 1024.0f) + 1e-6f); }
        f32x4 s[16];
#pragma unroll
        for (int kt = 0; kt < 16; ++kt) { s[kt] = (f32x4){0.f, 0.f, 0.f, 0.f};
#pragma unroll
            for (int kk = 0; kk < 4; ++kk) s[kt] = __builtin_amdgcn_mfma_f32_16x16x32_bf16(lds_frag(Ks, 136, 16 * kt + fr, 32 * kk + 8 * fq), qf[kk], s[kt], 0, 0, 0);
            if (kt & 1) __builtin_amdgcn_sched_barrier(0); }
        float m = s[0][0];
#pragma unroll
        for (int kt = 0; kt < 16; ++kt) m = fmaxf(fmaxf(fmaxf(m, s[kt][0]), fmaxf(s[kt][1], s[kt][2])), s[kt][3]);
        m = fmaxf(m, __shfl_xor(m, 16)); m = fmaxf(m, __shfl_xor(m, 32));
        float den = 0.f;
#pragma unroll
        for (int kt = 0; kt < 16; ++kt)
#pragma unroll
            for (int r = 0; r < 4; ++r) { const float e = __expf((s[kt][r] - m) * qsc); s[kt][r] = e; den += e; }
        den += __shfl_xor(den, 16); den += __shfl_xor(den, 32);
        f32x4 o[8];
#pragma unroll
        for (int dt = 0; dt < 8; ++dt) o[dt] = (f32x4){0.f, 0.f, 0.f, 0.f};
#pragma unroll
        for (int sg = 0; sg < 8; ++sg) { const float pv[8] = {s[2 * sg][0], s[2 * sg][1], s[2 * sg][2], s[2 * sg][3], s[2 * sg + 1][0], s[2 * sg + 1][1], s[2 * sg + 1][2], s[2 * sg + 1][3]};
            const bf16x8_t pb = pack8(pv);
#pragma unroll
            for (int dt = 0; dt < 8; ++dt) o[dt] = __builtin_amdgcn_mfma_f32_16x16x32_bf16(lds_frag(VTp, 264, 16 * dt + fr, 32 * sg + 8 * fq), pb, o[dt], 0, 0, 0);
            __builtin_amdgcn_sched_barrier(0); }
        const float inv = 1.0f / den;
#pragma unroll
        for (int dt = 0; dt < 8; ++dt) { u32x2 w; w.x = pk2(o[dt][0] * inv, o[dt][1] * inv); w.y = pk2(o[dt][2] * inv, o[dt][3] * inv); *(u32x2*)(OA + tq * 512 + hh * 128 + 16 * dt + 4 * fq) = w; }
    }
}
__device__ __forceinline__ void swa_mfma(const Ctx& c, const Params& p, int unit) {
    const int b = unit >> 6, g = (unit >> 5) & 1, n = unit & 31, tid = c.tid, lane = c.lane, wv = c.wave, fr = lane & 15, fq = lane >> 4;
    LAS bf16_t* Ks = (LAS bf16_t*)c.shm;
    LAS bf16_t* VTp = (LAS bf16_t*)(c.shm + 256 * 144);
    const bf16_t* P = (const bf16_t*)(p.ws + OFF_P); bf16_t* MIX = (bf16_t*)p.out;
    __syncthreads();
#pragma unroll 1
    for (int i = 0; i < 8; ++i) {
        const int task = tid + 512 * i, which = task >> 11, r = (task >> 3) & 255, ck = task & 7;
        const int tk = n * 128 - 128 + r;
        u32x4 d = (u32x4){0u, 0u, 0u, 0u};
        if (tk >= 0) d = *(const u32x4*)(P + ((size_t)b * SEQ + tk) * EV_IN + 512 + which * 128 + g * 64 + ck * 8);
        if (which == 0) *(LAS u32x4*)(Ks + r * 72 + ck * 8) = d;
        else { const int kc = key_perm(r); const unsigned w[4] = {d.x, d.y, d.z, d.w};
#pragma unroll
            for (int k = 0; k < 4; ++k) { VTp[(ck * 8 + 2 * k) * 264 + kc] = (bf16_t)(w[k] & 0xFFFFu); VTp[(ck * 8 + 2 * k + 1) * 264 + kc] = (bf16_t)(w[k] >> 16); } }
    }
    __syncthreads();
#pragma unroll 1
    for (int it = 0; it < 4; ++it) {
        const int tile = wv * 4 + it, hql = tile >> 3, qb = tile & 7, head = g * 4 + hql, sg0 = qb >> 1;
        const int qi = 16 * qb + fr; const size_t tq = (size_t)b * SEQ + n * 128 + qi;
        const float sink = p.ev_sinks[head];
        bf16x8_t qf[2];
#pragma unroll
        for (int kk = 0; kk < 2; ++kk) qf[kk] = *(const bf16x8_t*)(P + tq * EV_IN + head * 64 + 32 * kk + 8 * fq);
        f32x4 s[10]; float m = sink;
#pragma unroll
        for (int i = 0; i < 10; ++i) { const int kt = 2 * sg0 + i; s[i] = (f32x4){0.f, 0.f, 0.f, 0.f};
#pragma unroll
            for (int kk = 0; kk < 2; ++kk) s[i] = __builtin_amdgcn_mfma_f32_16x16x32_bf16(lds_frag(Ks, 72, 16 * kt + fr, 32 * kk + 8 * fq), qf[kk], s[i], 0, 0, 0);
#pragma unroll
            for (int r = 0; r < 4; ++r) { const int kp = 16 * kt + 4 * fq + r; const bool valid = (kp >= qi + 1) && (kp <= qi + 128) && (n > 0 || kp >= 128);
                s[i][r] = valid ? s[i][r] * 0.125f : -INFINITY; m = fmaxf(m, s[i][r]); } }
        m = fmaxf(m, __shfl_xor(m, 16)); m = fmaxf(m, __shfl_xor(m, 32));
        float den = 0.f;
#pragma unroll
        for (int i = 0; i < 10; ++i)
#pragma unroll
            for (int r = 0; r < 4; ++r) { const float e = __expf(s[i][r] - m); s[i][r] = e; den += e; }
        den += __shfl_xor(den, 16); den += __shfl_xor(den, 32); den += __expf(sink - m);
        f32x4 o[4];
#pragma unroll
        for (int dt = 0; dt < 4; ++dt) o[dt] = (f32x4){0.f, 0.f, 0.f, 0.f};
#pragma unroll
        for (int i2 = 0; i2 < 5; ++i2) { const float pv[8] = {s[2 * i2][0], s[2 * i2][1], s[2 * i2][2], s[2 * i2][3], s[2 * i2 + 1][0], s[2 * i2 + 1][1], s[2 * i2 + 1][2], s[2 * i2 + 1][3]};
            const bf16x8_t pb = pack8(pv);
#pragma unroll
            for (int dt = 0; dt < 4; ++dt) o[dt] = __builtin_amdgcn_mfma_f32_16x16x32_bf16(lds_frag(VTp, 264, 16 * dt + fr, 32 * (sg0 + i2) + 8 * fq), pb, o[dt], 0, 0, 0); }
        const float inv = 1.0f / den;
#pragma unroll
        for (int dt = 0; dt < 4; ++dt) { u32x2 w; w.x = pk2(o[dt][0] * inv, o[dt][1] * inv); w.y = pk2(o[dt][2] * inv, o[dt][3] * inv); *(u32x2*)(MIX + tq * 1024 + head * 64 + 16 * dt + 4 * fq) = w; }
    }
}

constexpr size_t WSM_RT = 640 * 1024;
constexpr size_t CTL_WGCNT = 256 * 1024;
__device__ __forceinline__ void split8(const f32x4 a, const f32x4 b, bf16x8_t& hi, bf16x8_t& lo) {
    const float x[8] = {a.x, a.y, a.z, a.w, b.x, b.y, b.z, b.w}; float h[8], l[8];
#pragma unroll
    for (int i = 0; i < 8; ++i) { h[i] = bf2f(f2bf(x[i])); l[i] = x[i] - h[i]; }
    hi = pack8(h); lo = pack8(l);
}
__device__ __forceinline__ void moe_route(const Ctx& c, const Params& p, int layer) {
    const int lane = c.lane, wv = c.wave, fr = lane & 15, fq = lane >> 4;
    LAS float* LG = (LAS float*)c.shm + wv * (16 * 48 + 16);
    LAS float* RS = LG + 16 * 48;
    LAS int* hist = (LAS int*)(c.shm + 32 * 1024);
    if (c.tid < 32) hist[c.tid] = 0;
    __syncthreads();
    const int t0 = blockIdx.x * 128 + wv * 16;
    const bf16_t* xr = (const bf16_t*)(p.ws + OFF_H) + (size_t)(t0 + fr) * 1024 + 8 * fq;
    const bf16_t* TH = (const bf16_t*)(p.ws + OFF_WSMALL + WSM_RT) + (size_t)layer * 2 * 48 * 1024; const bf16_t* TL = TH + 48 * 1024;
    f32x4 acc[3];
#pragma unroll
    for (int i = 0; i < 3; ++i) acc[i] = (f32x4){0.f, 0.f, 0.f, 0.f};
    float ss = 0.f;
#pragma unroll 4
    for (int kk = 0; kk < 32; ++kk) {
        const u32x4 xw = *(const u32x4*)(xr + 32 * kk); const bf16x8_t xh = __builtin_bit_cast(bf16x8_t, xw);
        { const float x0 = bflo(xw.x), x1 = bfhi(xw.x), x2 = bflo(xw.y), x3 = bfhi(xw.y), x4 = bflo(xw.z), x5 = bfhi(xw.z), x6 = bflo(xw.w), x7 = bfhi(xw.w);
          ss += (x0 * x0 + x1 * x1) + (x2 * x2 + x3 * x3) + (x4 * x4 + x5 * x5) + (x6 * x6 + x7 * x7); }
#pragma unroll
        for (int ct = 0; ct < 3; ++ct) { const bf16x8_t wh = *(const bf16x8_t*)(TH + (size_t)(16 * ct + fr) * 1024 + 32 * kk + 8 * fq), wl = *(const bf16x8_t*)(TL + (size_t)(16 * ct + fr) * 1024 + 32 * kk + 8 * fq);
            acc[ct] = __builtin_amdgcn_mfma_f32_16x16x32_bf16(xh, wh, acc[ct], 0, 0, 0); acc[ct] = __builtin_amdgcn_mfma_f32_16x16x32_bf16(xh, wl, acc[ct], 0, 0, 0); }
    }
    ss += __shfl_xor(ss, 16); ss += __shfl_xor(ss, 32);
    const float rstd = 1.0f / sqrtf(ss * (1.0f / 1024.0f) + 1e-6f);
    if (fq == 0) RS[fr] = rstd;
    LDS_WAIT();
#pragma unroll
    for (int ct = 0; ct < 3; ++ct)
#pragma unroll
        for (int r = 0; r < 4; ++r) LG[(4 * fq + r) * 48 + 16 * ct + fr] = acc[ct][r] * RS[4 * fq + r];
    LDS_WAIT();
    if (lane < 16) { int e0, e1; float g0, g1; route_row(LG + lane * 48, p.moe_b_group + layer * 4, p.moe_b_expert + layer * 32, e0, e1, g0, g1);
        const int t = t0 + lane; ((float*)(p.ws + OFF_ROUTE + ROUTE_RS))[t] = RS[lane]; ((int2*)(p.ws + OFF_ROUTE))[t] = make_int2(e0, e1); ((float2*)(p.ws + OFF_ROUTE + 256 * 1024))[t] = make_float2(g0, g1);
        atomicAdd((int*)&hist[e0], 1); atomicAdd((int*)&hist[e1], 1); }
    __syncthreads();
    if (c.tid < 32) ((int*)(p.ws + OFF_CTL + CTL_WGCNT))[(layer * 256 + blockIdx.x) * 32 + c.tid] = hist[c.tid];
}
__device__ __forceinline__ void moe_slots2(const Ctx& c, const Params& p, int layer) {
    LAS int* part = (LAS int*)c.shm;
    LAS int* base = part + 1024;
    LAS int* lcnt = base + 32;
    LAS int* posl = lcnt + 32;
    LAS int* pst = posl + 256;
    const int* wc = (const int*)(p.ws + OFF_CTL + CTL_WGCNT) + layer * 256 * 32; const int bid = blockIdx.x;
    __syncthreads();
    { const int e = c.tid & 31, pt = c.tid >> 5; int sa = 0, sb = 0;
      for (int w = pt * 16; w < pt * 16 + 16; ++w) { const int v = wc[w * 32 + e]; sa += v; sb += (w < bid) ? v : 0; }
      part[pt * 32 + e] = sa; part[512 + pt * 32 + e] = sb; }
    if (c.tid < 32) lcnt[c.tid] = 0;
    __syncthreads();
    if (c.tid < 32) { int sa = 0, sb = 0; for (int q = 0; q < 16; ++q) { sa += part[q * 32 + c.tid]; sb += part[512 + q * 32 + c.tid]; } part[c.tid] = sa; part[512 + c.tid] = sb; }
    __syncthreads();
    if (c.tid == 0) { int acc = 0; for (int e = 0; e < NEXP; ++e) { pst[e] = acc; acc += (part[e] + 255) / 256 * 256; } pst[32] = acc; }
    __syncthreads();
    if (c.tid < 32) base[c.tid] = pst[c.tid] + part[512 + c.tid];
    if (bid == 0 && c.tid < NEXP) { int* blk = (int*)(p.ws + OFF_CTL + CTL_BLK) + layer * 1024; const int e = c.tid, s = pst[e] / 256, en = pst[e + 1] / 256; for (int i = s; i < en; ++i) blk[1 + i] = e; if (e == 0) blk[0] = pst[32] / 256; }
    __syncthreads();
    if (c.tid < 256) { const int t = bid * 128 + (c.tid >> 1); const int2 ee = ((const int2*)(p.ws + OFF_ROUTE))[t]; const int e = (c.tid & 1) ? ee.y : ee.x;
        const int rk = atomicAdd((int*)&lcnt[e], 1); posl[c.tid] = base[e] + rk; }
    __syncthreads();
    if (c.tid < 128) ((int2*)(p.ws + OFF_ROUTE + 512 * 1024))[bid * 128 + c.tid] = make_int2(posl[2 * c.tid], posl[2 * c.tid + 1]);
    if (c.tid < 256) ((float*)(p.ws + OFF_R + R_RSS))[posl[c.tid]] = ((const float*)(p.ws + OFF_ROUTE + ROUTE_RS))[bid * 128 + (c.tid >> 1)];
    const bf16_t* H = (const bf16_t*)(p.ws + OFF_H); bf16_t* XB = (bf16_t*)(p.ws + OFF_P);
#pragma unroll
    for (int i0 = 0; i0 < 16; i0 += 8) { u32x4 ra[8], rb[8];
#pragma unroll
        for (int i = 0; i < 8; ++i) { const size_t t = (size_t)bid * 128 + c.wave * 16 + i0 + i; ra[i] = *((const u32x4*)(H + t * 1024) + c.lane); rb[i] = *((const u32x4*)(H + t * 1024) + 64 + c.lane); }
#pragma unroll
        for (int i = 0; i < 8; ++i) { const int tl = c.wave * 16 + i0 + i; const int q0 = posl[2 * tl], q1 = posl[2 * tl + 1];
            *((u32x4*)(XB + (size_t)q0 * 1024) + c.lane) = ra[i]; *((u32x4*)(XB + (size_t)q0 * 1024) + 64 + c.lane) = rb[i];
            *((u32x4*)(XB + (size_t)q1 * 1024) + c.lane) = ra[i]; *((u32x4*)(XB + (size_t)q1 * 1024) + 64 + c.lane) = rb[i]; } }
}

constexpr size_t WSM_TGD = 128 * 1024, WSM_GUT = 192 * 1024;
__device__ __forceinline__ void combine_gk(const Ctx& c, const Params& p) {
    const int lane = c.lane, wv = c.wave, fr = lane & 15, fq = lane >> 4;
    LAS float* LG = (LAS float*)c.shm + wv * (16 * 16 + 16);
    LAS float* RS = LG + 256;
    const int t0 = blockIdx.x * 128 + wv * 16; const int trow = t0 + fr;
    bf16_t* hr = (bf16_t*)(p.ws + OFF_H) + (size_t)trow * 1024 + 8 * fq;
    const int2 ps = ((const int2*)(p.ws + OFF_ROUTE + 512 * 1024))[trow]; const float2 gt = ((const float2*)(p.ws + OFF_ROUTE + 256 * 1024))[trow];
    const bf16_t* y0 = (const bf16_t*)(p.ws + OFF_P) + (size_t)ps.x * 1024 + 8 * fq; const bf16_t* y1 = (const bf16_t*)(p.ws + OFF_P) + (size_t)ps.y * 1024 + 8 * fq;
    const bf16_t* TH = (const bf16_t*)(p.ws + OFF_WSMALL + WSM_TGD); const bf16_t* TL = TH + 16 * 1024;
    f32x4 acc = (f32x4){0.f, 0.f, 0.f, 0.f}; float ss = 0.f;
#pragma unroll 4
    for (int kk = 0; kk < 32; ++kk) {
        const u32x4 xw = *(const u32x4*)(hr + 32 * kk), u0 = *(const u32x4*)(y0 + 32 * kk), u1 = *(const u32x4*)(y1 + 32 * kk);
        f32x4 a, bq;
        a.x = bflo(xw.x) + gt.x * bflo(u0.x) + gt.y * bflo(u1.x); a.y = bfhi(xw.x) + gt.x * bfhi(u0.x) + gt.y * bfhi(u1.x); a.z = bflo(xw.y) + gt.x * bflo(u0.y) + gt.y * bflo(u1.y); a.w = bfhi(xw.y) + gt.x * bfhi(u0.y) + gt.y * bfhi(u1.y);
        bq.x = bflo(xw.z) + gt.x * bflo(u0.z) + gt.y * bflo(u1.z); bq.y = bfhi(xw.z) + gt.x * bfhi(u0.z) + gt.y * bfhi(u1.z); bq.z = bflo(xw.w) + gt.x * bflo(u0.w) + gt.y * bflo(u1.w); bq.w = bfhi(xw.w) + gt.x * bfhi(u0.w) + gt.y * bfhi(u1.w);
        { u32x4 w; w.x = pk2(a.x, a.y); w.y = pk2(a.z, a.w); w.z = pk2(bq.x, bq.y); w.w = pk2(bq.z, bq.w); *(u32x4*)(hr + 32 * kk) = w; }
        ss += (a.x * a.x + a.y * a.y) + (a.z * a.z + a.w * a.w) + (bq.x * bq.x + bq.y * bq.y) + (bq.z * bq.z + bq.w * bq.w);
        bf16x8_t xh, xl; split8(a, bq, xh, xl);
        const bf16x8_t wh = *(const bf16x8_t*)(TH + (size_t)fr * 1024 + 32 * kk + 8 * fq), wl = *(const bf16x8_t*)(TL + (size_t)fr * 1024 + 32 * kk + 8 * fq);
        acc = __builtin_amdgcn_mfma_f32_16x16x32_bf16(xh, wh, acc, 0, 0, 0); acc = __builtin_amdgcn_mfma_f32_16x16x32_bf16(xh, wl, acc, 0, 0, 0); acc = __builtin_amdgcn_mfma_f32_16x16x32_bf16(xl, wh, acc, 0, 0, 0);
    }
    ss += __shfl_xor(ss, 16); ss += __shfl_xor(ss, 32);
    const float rstd = 1.0f / sqrtf(ss * (1.0f / 1024.0f) + 1e-6f);
    if (fq == 0) { RS[fr] = rstd; ((float*)(p.ws + OFF_ROUTE + ROUTE_RS))[trow] = rstd; }
    LDS_WAIT();
#pragma unroll
    for (int r = 0; r < 4; ++r) LG[(4 * fq + r) * 16 + fr] = acc[r] * RS[4 * fq + r];
    LDS_WAIT();
    bf16x8_t gh = zero_frag(), gl = zero_frag();
    if (fq < 2) { const f32x4 a = *(const LAS f32x4*)(LG + fr * 16 + 8 * fq), bq = *(const LAS f32x4*)(LG + fr * 16 + 8 * fq + 4); split8(a, bq, gh, gl); }
    const bf16_t* UH = (const bf16_t*)(p.ws + OFF_WSMALL + WSM_GUT); const bf16_t* UL = UH + 512 * 16;
    float* gk = (float*)(p.ws + OFF_R + R_GK) + (size_t)trow * 512 + 4 * fq;
#pragma unroll 4
    for (int ct = 0; ct < 32; ++ct) {
        bf16x8_t uh = zero_frag(), ul = zero_frag();
        if (fq < 2) { uh = *(const bf16x8_t*)(UH + (16 * ct + fr) * 16 + 8 * fq); ul = *(const bf16x8_t*)(UL + (16 * ct + fr) * 16 + 8 * fq); }
        f32x4 g = *(const f32x4*)(p.od_gate_b + 16 * ct + 4 * fq);
        g = __builtin_amdgcn_mfma_f32_16x16x32_bf16(uh, gh, g, 0, 0, 0); g = __builtin_amdgcn_mfma_f32_16x16x32_bf16(uh, gl, g, 0, 0, 0); g = __builtin_amdgcn_mfma_f32_16x16x32_bf16(ul, gh, g, 0, 0, 0);
#pragma unroll
        for (int r = 0; r < 4; ++r) { const float xx = g[r]; g[r] = (fminf(xx, 0.f) - __logf(1.0f + __expf(-fabsf(xx)))) * (1.0f / 16.0f); }
        *(f32x4*)(gk + 16 * ct) = g;
    }
}

constexpr int LDS_BYTES = 160 * 1024 - 64;
constexpr int N_PHASES = 25;

typedef const __attribute__((address_space(4))) Params* KParamsPtr;
__device__ __forceinline__ Params kparams() {
#if defined(__HIP_DEVICE_COMPILE__)
    KParamsPtr k = (KParamsPtr)__builtin_amdgcn_kernarg_segment_ptr(); asm volatile("" : "+s"(k)); return *k;
#else
    return Params{};
#endif
}
__device__ __forceinline__ Ctx mkctx(unsigned char* shm) {
    int tz = threadIdx.x; asm volatile("" : "+v"(tz));
    Ctx c; c.tid = tz; c.wave = __builtin_amdgcn_readfirstlane(tz >> 6); c.lane = tz & 63; c.gw = blockIdx.x * 8 + c.wave; c.ngw = 2048; c.shm = shm; return c;
}
__global__ void __launch_bounds__(512, 2) hybrid_fwd(Params p_in) {
    extern __shared__ __attribute__((aligned(16))) unsigned char shm[];
    constexpr int G = 256; const int bid = blockIdx.x;
    uint4* xbw = (uint4*)(shm + LDS_BYTES - 16);
    if (threadIdx.x == 0) *xbw = make_uint4(0u, 0u, 0u, 0u);
    __syncthreads();
    XcdBarrier bar = xcd_barrier_post((unsigned*)(kparams().ws + OFF_CTL), (volatile LAS unsigned*)xbw);
#ifndef KEEPMASK
#define KEEPMASK 0xFFFFFFFFu
#endif
#define INS(k, s) (((KEEPMASK) >> (s)) & 1u)
#ifndef REPMASK
#define REPMASK 0u
#endif
#define REP(s) ((((REPMASK) >> (s)) & 1u) ? 3 : 1)
#define SEAM(k) do { XcdBarrier b2 = bar; b2.bar = (unsigned*)(kparams().ws + OFF_CTL); xcd_barrier(b2); } while (0)
#define PHASE_BEGIN const Params p = kparams(); const Ctx c = mkctx(shm); unsigned char* const ws = p.ws; (void)c; (void)ws;
#define glds ((PG8_LAS unsigned char*)shm)
#define WD ((bf16_t*)(ws + OFF_WD))
#define H ((bf16_t*)(ws + OFF_H))
#define P ((bf16_t*)(ws + OFF_P))
#define WS_F ((float*)(ws + OFF_WSMALL))
#define RE ((int2*)(ws + OFF_ROUTE))
#define RG ((float2*)(ws + OFF_ROUTE + 256 * 1024))
#define RP ((int2*)(ws + OFF_ROUTE + 512 * 1024))

    for (int layer = 0; layer < 2; ++layer) {
        const int pb = layer * 12;
        if (layer == 0) {
            if (INS(0, 0)) for (int rep_ = 0; rep_ < REP(0); ++rep_) { PHASE_BEGIN
                tr_matrix(c, p.ev_w_in, EV_IN, 0, 1024, EV_IN, WD + WE_EV_IN, 0, 0);
                tr_matrix(c, p.ev_w_out, 1024, 0, 1024, 1024, WD + WE_EV_OUT, 0, 0);
                tr_matrix(c, p.od_w_in, OD_IN_SRC, 0, 1024, OD_IN, WD + WE_OD_IN, 0, 1, p.norm_mix + 1024);
                tr_matrix(c, p.od_w_out, 1024, 0, 1024, 1024, WD + WE_OD_OUT, 0, 0);
                tr_matrix(c, p.mem_wk, 512, 0, 1024, 512, WD + WE_MKV, 0, 0);
                tr_matrix(c, p.mem_wv, 512, 0, 1024, 512, WD + WE_MKV, 512, 0);
                for (int l = 0; l < 2; ++l) {
                    tr_matrix(c, p.xa_wq + (size_t)l * 1024 * 512, 512, 0, 1024, 512, WD + WE_WQ + (size_t)l * 512 * 1024, 0, 0, p.norm_xattn + l * 1024);
                    tr_matrix(c, p.xa_wo + (size_t)l * 512 * 1024, 1024, 0, 512, 1024, WD + WE_WO + (size_t)l * 1024 * 512, 0, 0);
                }
                for (int i = bid * 512 + c.tid; i < 16 * 1024 + 512 * 16; i += G * 512) {
                    if (i < 16 * 1024) { const int o = i >> 10, k = i & 1023; const float w = p.od_w_in[(size_t)k * OD_IN_SRC + 2048 + o] * p.norm_mix[1024 + k]; const unsigned hb = f2bf(w);
                        bf16_t* T = (bf16_t*)(ws + OFF_WSMALL + WSM_TGD); T[i] = (bf16_t)hb; T[16 * 1024 + i] = (bf16_t)f2bf(w - bf2f(hb)); }
                    else { const int r = i - 16 * 1024, ch = r >> 4, o = r & 15; const float w = p.od_gate_up[o * 512 + ch]; const unsigned hb = f2bf(w);
                        bf16_t* T = (bf16_t*)(ws + OFF_WSMALL + WSM_GUT); T[r] = (bf16_t)hb; T[512 * 16 + r] = (bf16_t)f2bf(w - bf2f(hb)); } }
                for (int i = bid * 512 + c.tid; i < 2 * 48 * 1024; i += G * 512) { const int l = i / (48 * 1024), r = i % (48 * 1024), o = r >> 10, k = r & 1023;
                    float w = 0.f; if (o < 4) w = p.moe_w_group[((size_t)l * 1024 + k) * 4 + o]; else if (o < 36) w = p.moe_w_expert[((size_t)l * 1024 + k) * 32 + (o - 4)];
                    w *= p.norm_moe[l * 1024 + k]; const unsigned hb = f2bf(w); bf16_t* T = (bf16_t*)(ws + OFF_WSMALL + WSM_RT) + (size_t)l * 2 * 48 * 1024;
                    T[r] = (bf16_t)hb; T[48 * 1024 + r] = (bf16_t)f2bf(w - bf2f(hb)); }
                for (int i = bid * 512 + c.tid; i < 2 * 512 * 64; i += G * 512) { const int wh = i >> 15, r = i & 32767, ch = r >> 6, k = r & 63;
                    ((bf16_t*)(ws + OFF_WSMALL + (wh ? WSM_A2T : WSM_W2T)))[r] = (bf16_t)f2bf((wh ? p.ev_a2 : p.ev_w2)[(size_t)k * 512 + ch]); }
                norm_plain(c, p.mem, p.mem_norm, (bf16_t*)(ws + OFF_R + R_MEMN), NB * MEMLEN);
                for (int i = bid * 512 + c.tid; i < 512 * 128; i += G * 512) { const int ch = i >> 7, m = i & 127; ((bf16_t*)(ws + OFF_WSMALL + WSM_G2T))[i] = (bf16_t)f2bf(p.ev_g2[(size_t)m * 512 + ch]); }
                norm_plain(c, p.x, p.norm_mix, H, T_TOK);
                __syncthreads();
                SEAM(0);
            }
            if (INS(1, 1)) for (int rep_ = 0; rep_ < REP(1); ++rep_) { PHASE_BEGIN
                { pg8::Gemm g{H, WD + WE_EV_IN, T_TOK, EV_IN, 1024, 0}; pg8::StaticOrder S; S.init(T_TOK, EV_IN, G, bid);
                  pg8::EpiB16 E{P, EV_IN, nullptr}; pg8::gemm_phase<pg8::EpiB16, pg8::StaticOrder, true, true>(glds, g, S, E); }
                SEAM(1);
            }
            if (INS(2, 2)) for (int rep_ = 0; rep_ < REP(2); ++rep_) { PHASE_BEGIN
#ifdef RWKV_NAIVE
                if (bid < 64) rwkv_naive(c, p, bid);
                else
#else
                {
                    RxPre pre; const int bh0 = bid >> 2, b0 = bh0 >> 3, hd0 = bh0 & 7, ck0 = (bid & 3) * 16;
                    rwkv_x_fetch(pre, (const bf16_t*)(ws + OFF_P), b0, hd0, ck0, c.tid, c.lane, c.wave);
#pragma unroll 1
                    for (int i = 0; i < 16; ++i) rwkv_x(c, p, bid * 16 + i, pre, b0, hd0, i + 1 < 16 ? ck0 + i + 1 : -1);
                }
                __syncthreads();
                SEAM(2);
            }
            if (INS(2, 16)) for (int rep_ = 0; rep_ < REP(16); ++rep_) { PHASE_BEGIN
                if (bid < 64) { if (c.wave < 4) rwkv_y(c, p, bid, c.wave); }
                else
#endif
                {
                    for (int u = bid - 64; u < 512; u += G - 64) swa_mfma(c, p, u);
                    __syncthreads();
                    if (bid >= 96) tr_moe_layer(c, p, 0, 96 * 8, 160 * 8);
                    if (bid < 96) {
                        pg8::Gemm g{(const bf16_t*)(ws + OFF_R + R_MEMN), WD + WE_MKV, NB * MEMLEN, 1024, 1024, 0}; pg8::StaticOrder S; S.init(NB * MEMLEN, 1024, 32, bid - 64);
                        pg8::EpiB16 E{(bf16_t*)(ws + OFF_MKV), 1024, nullptr}; pg8::gemm_phase<pg8::EpiB16, pg8::StaticOrder, true, true>(glds, g, S, E); }
                }
#ifndef RWKV_NAIVE
                __syncthreads();
                SEAM(2);
            }
            if (INS(2, 17)) for (int rep_ = 0; rep_ < REP(17); ++rep_) { PHASE_BEGIN
                for (int u = c.gw; u < 4096; u += c.ngw) rwkv_z(c, p, u);
#endif
                __syncthreads();
                SEAM(2);
            }
        } else {
            if (INS(12, 12)) for (int rep_ = 0; rep_ < REP(12); ++rep_) { PHASE_BEGIN
                combine_gk(c, p);
                __syncthreads();
                SEAM(12);
            }
            if (INS(13, 13)) for (int rep_ = 0; rep_ < REP(13); ++rep_) { PHASE_BEGIN
                pg8::Gemm g{H, WD + WE_OD_IN, T_TOK, OD_IN, 1024, 0}; pg8::StaticOrder S; S.init(T_TOK, OD_IN, G, bid);
                pg8::EpiB16 E{P, OD_IN, (const float*)(ws + OFF_ROUTE + ROUTE_RS)};   pg8::gemm_phase<pg8::EpiB16, pg8::StaticOrder, true, true>(glds, g, S, E);
                SEAM(13);
            }
            if (INS(14, 14)) for (int rep_ = 0; rep_ < REP(14); ++rep_) { PHASE_BEGIN
#ifdef GLA_NAIVE
                if (bid < 32) gla_naive(c, p, bid);
                __syncthreads();
                SEAM(14);
#else
                for (int u = bid; u < 2048; u += G) gla_prep(c, p, u);
                __syncthreads();
                SEAM(14);
#endif
            }
#ifndef GLA_NAIVE
            if (INS(14, 18)) for (int rep_ = 0; rep_ < REP(18); ++rep_) { PHASE_BEGIN
                if (bid < 128) gla_state(c, p, bid >> 2, bid & 3);
                else tr_moe_layer(c, p, 1, 128 * 8, 128 * 8);
                __syncthreads();
                SEAM(14);
            }
            if (INS(14, 19)) for (int rep_ = 0; rep_ < REP(19); ++rep_) { PHASE_BEGIN
                gla_finish(c, p);
                __syncthreads();
                SEAM(14);
            }
#endif
        }
        if (INS(pb + 3, 3)) for (int rep_ = 0; rep_ < REP(3); ++rep_) { PHASE_BEGIN
            pg8::Gemm g{(const bf16_t*)p.out, WD + (layer == 0 ? WE_EV_OUT : WE_OD_OUT), T_TOK, 1024, 1024, 0}; pg8::StaticOrder S; S.init(T_TOK, 1024, G, bid);
            pg8::EpiRes E{layer == 0 ? p.x : nullptr, H, 1024, (float*)(ws + OFF_R + R_SSP)};     pg8::gemm_phase<pg8::EpiRes, pg8::StaticOrder, true, true>(glds, g, S, E);
            SEAM(pb + 3);
        }
        if (INS(pb + 5, 5)) for (int rep_ = 0; rep_ < REP(5); ++rep_) { PHASE_BEGIN
            pg8::Gemm g{H, WD + WE_WQ + (size_t)layer * 512 * 1024, T_TOK, 512, 1024, 0}; pg8::StaticOrder S; S.init(T_TOK, 512, G, bid);
            pg8::EpiB16 E{P, 512, nullptr}; pg8::gemm_phase<pg8::EpiB16, pg8::StaticOrder, true, true>(glds, g, S, E);
            SEAM(pb + 5);
        }
        if (INS(pb + 6, 6)) for (int rep_ = 0; rep_ < REP(6); ++rep_) { PHASE_BEGIN for (int u = bid; u < 256; u += G) xattn_mfma(c, p, u); __syncthreads(); SEAM(pb + 6); }
        if (INS(pb + 7, 7)) for (int rep_ = 0; rep_ < REP(7); ++rep_) { PHASE_BEGIN
            pg8::Gemm g{(const bf16_t*)(ws + OFF_P + 32 * MiB), WD + WE_WO + (size_t)layer * 1024 * 512, T_TOK, 1024, 512, 0}; pg8::StaticOrder S; S.init(T_TOK, 1024, G, bid);
            pg8::EpiRes E{nullptr, H, 1024, nullptr}; pg8::gemm_phase<pg8::EpiRes, pg8::StaticOrder, true, true>(glds, g, S, E);
            SEAM(pb + 7);
        }
        if (INS(pb + 8, 8)) for (int rep_ = 0; rep_ < REP(8); ++rep_) { PHASE_BEGIN
            moe_route(c, p, layer);
            __syncthreads();
            SEAM(pb + 8);
        }
        if (INS(pb + 9, 9)) for (int rep_ = 0; rep_ < REP(9); ++rep_) { PHASE_BEGIN moe_slots2(c, p, layer); __syncthreads(); SEAM(pb + 9); }
        if (INS(pb + 10, 10)) for (int rep_ = 0; rep_ < REP(10); ++rep_) { PHASE_BEGIN
            const int* blk = (const int*)(ws + OFF_CTL + CTL_BLK) + layer * 1024; const int nblk = blk[0];
            pg8::Gemm g{P, (const bf16_t*)(ws + OFF_WMOE), nblk * 256, 1024, 1024, (size_t)1024 * 1024 * 2}; pg8::MoeOrder S{blk + 1, nblk * 4, 4, G, bid};
            pg8::EpiSwiglu E{(bf16_t*)(ws + OFF_R), 512, (const float*)(ws + OFF_R + R_RSS)}; pg8::gemm_phase<pg8::EpiSwiglu, pg8::MoeOrder, true, true>(glds, g, S, E);
            SEAM(pb + 10);
        }
        if (INS(pb + 11, 11)) for (int rep_ = 0; rep_ < REP(11); ++rep_) { PHASE_BEGIN
            const int* blk = (const int*)(ws + OFF_CTL + CTL_BLK) + layer * 1024; const int nblk = blk[0];
            pg8::Gemm g{(const bf16_t*)(ws + OFF_R), (const bf16_t*)(ws + OFF_WMOE + 64 * MiB), nblk * 256, 1024, 512, (size_t)1024 * 512 * 2}; pg8::MoeOrder S{blk + 1, nblk * 4, 4, G, bid};
            pg8::EpiB16 E{P, 1024, nullptr}; pg8::gemm_phase<pg8::EpiB16, pg8::MoeOrder, true, true>(glds, g, S, E);
            SEAM(pb + 11);
        }
    }
    if (INS(24, 15)) for (int rep_ = 0; rep_ < REP(15); ++rep_) { PHASE_BEGIN
        for (int r0 = c.gw; r0 < T_TOK; r0 += 4 * c.ngw) {
            f32x4 v[4][4]; int2 ps[4]; float2 gt[4];
#pragma unroll
            for (int q = 0; q < 4; ++q) { const int r = r0 + q * c.ngw; ps[q] = RP[r]; gt[q] = RG[r];
#pragma unroll
                for (int j = 0; j < 4; ++j) { const u32x2 w = *((const u32x2*)(H + (size_t)r * 1024) + c.lane + 64 * j); v[q][j] = (f32x4){bflo(w.x), bfhi(w.x), bflo(w.y), bfhi(w.y)}; } }
#pragma unroll
            for (int q = 0; q < 4; ++q) row_combine(v[q], P, ps[q].x, ps[q].y, gt[q].x, gt[q].y, c.lane);
#pragma unroll
            for (int q = 0; q < 4; ++q) { const int r = r0 + q * c.ngw; const float rs = row_rstd(v[q]); row_scale(v[q], rs, p.norm_final, c.lane); row_store_f32(p.out + (size_t)r * 1024, c.lane, v[q]); }
        }
    }
}

extern "C" void kernel_launch(void* const* d_in, const int* in_sizes, int n_in, void* d_out, int out_size, void* d_ws, size_t ws_size, hipStream_t stream) {
    static int ready = 0;
    if (ready == 0) {
        if (n_in != 37 || out_size != T_TOK * DM || ws_size < WS_NEED) { fprintf(stderr, "kernel_launch: unexpected problem (n_in %d, out %d, ws %zu)\n", n_in, out_size, ws_size); ready = -1; return; }
        if (hipFuncSetAttribute((const void*)hybrid_fwd, hipFuncAttributeMaxDynamicSharedMemorySize, LDS_BYTES) != hipSuccess) { fprintf(stderr, "kernel_launch: hipFuncSetAttribute failed\n"); ready = -1; return; }
        ready = 1;
    }
    if (ready < 0) return;
    hipMemsetAsync((char*)d_ws + OFF_CTL, 0, CTL_ZERO_BYTES, stream);
    Params p{};
    const float** f = (const float**)&p;
    for (int i = 0; i < 37; ++i) f[i] = (const float*)d_in[i];
    p.out = (float*)d_out; p.ws = (unsigned char*)d_ws; p.ph_lo = 0; p.ph_hi = N_PHASES;
    hipLaunchKernelGGL(hybrid_fwd, dim3(256), dim3(512), LDS_BYTES, stream, p);
}
```

```cpp
#include <hip/hip_runtime.h>
#include <cstdint>
#include <cstdio>

#define LAS __attribute__((address_space(3)))
typedef unsigned short bf16_t;
typedef float f32x4 __attribute__((ext_vector_type(4)));
typedef float f32x2 __attribute__((ext_vector_type(2)));
typedef unsigned u32x4 __attribute__((ext_vector_type(4)));
typedef unsigned u32x2 __attribute__((ext_vector_type(2)));

constexpr int T_TOK = 32768, DM = 1024, SEQ = 4096, NB = 8, MEMLEN = 256;
constexpr int EV_IN = 2560, OD_IN = 3072  , OD_IN_SRC = 3088;
constexpr int NEXP = 32, MOE_FF = 512, PMAX = 65536 + NEXP * 256;

constexpr size_t MiB = 1024 * 1024;
constexpr size_t OFF_CTL = 0;
constexpr size_t CTL_ZERO_BYTES = 64 * 1024;
constexpr size_t CTL_CNT = 16384;
constexpr size_t CTL_CUR = 16384 + 1024;
constexpr size_t CTL_BLK = 128 * 1024;
constexpr size_t OFF_ROUTE = 1 * MiB;
constexpr size_t OFF_WSMALL = 2 * MiB;
constexpr size_t OFF_MKV = 3 * MiB;
constexpr size_t OFF_WD = 7 * MiB;
constexpr size_t OFF_WMOE = 28 * MiB;
constexpr size_t OFF_H = 124 * MiB;
constexpr size_t OFF_P = 188 * MiB;
constexpr size_t OFF_R = 380 * MiB;
constexpr size_t WS_NEED = 552 * MiB;
constexpr size_t WE_EV_IN = 0, WE_EV_OUT = 2560ull * 1024, WE_OD_IN = 3584ull * 1024, WE_OD_OUT = 6656ull * 1024, WE_MKV = 7680ull * 1024, WE_WQ = 8704ull * 1024, WE_WO = 9728ull * 1024;

constexpr size_t ROUTE_RS = 768 * 1024;
constexpr size_t R_TOK = 81 * MiB;
constexpr size_t R_SSP = 0, R_RSS = 80 * MiB;
constexpr size_t P_XB1 = 64 * MiB;
struct Params {
    const float *x, *mem, *norm_mix, *norm_xattn, *norm_moe, *norm_final;
    const float *ev_w_in, *ev_sinks, *ev_mu, *ev_w0, *ev_w2, *ev_a0, *ev_a2, *ev_g2, *ev_k_k, *ev_k_a, *ev_r_k, *ev_lnx_w, *ev_lnx_b, *ev_w_out;
    const float *od_w_in, *od_gate_up, *od_gate_b, *od_onorm, *od_w_out;
    const float *mem_norm, *mem_wk, *mem_wv, *xa_wq, *xa_wo;
    const float *moe_w_group, *moe_b_group, *moe_w_expert, *moe_b_expert, *moe_w1, *moe_w3, *moe_w2;
    float* out; unsigned char* ws; int ph_lo, ph_hi;
};

#define XB_TMO      128
#define XB_XCNT(j)  (256  + 64 * (j))
#define XB_XSUB(j)  (1280 + 64 * (j))
#define XB_XGEN(j)  (2304 + 64 * (j))
#define XB_TOP      3328
#define XB_TOPGEN   3392
#define XCD_BAR_WORDS 3456
#define XB_SPIN_CAP (1u << 18)
#define LAS __attribute__((address_space(3)))

__device__ __forceinline__ unsigned xb_ld(unsigned* p)              { return __hip_atomic_load(p, __ATOMIC_RELAXED, __HIP_MEMORY_SCOPE_AGENT); }
__device__ __forceinline__ unsigned xb_add(unsigned* p, unsigned v) { return __hip_atomic_fetch_add(p, v, __ATOMIC_RELAXED, __HIP_MEMORY_SCOPE_AGENT); }
__device__ __forceinline__ unsigned xb_xcc_id() { return (unsigned)__builtin_amdgcn_s_getreg((3 << 11) | 20) & 0xFu; }
#define XB_SPIN(cond, bar) do { unsigned _sp = 0; while (cond) { __builtin_amdgcn_s_sleep(1); \
    if ((++_sp & 255u) == 0u) { if (xb_ld(&(bar)[XB_TMO])) break; if (_sp > XB_SPIN_CAP) { atomicAdd(&(bar)[XB_TMO], 1u); break; } } } } while (0)

struct XcdBarrier {
    unsigned* bar; unsigned x;
    volatile LAS unsigned* st;
};

__device__ __forceinline__ XcdBarrier xcd_barrier_post(unsigned* bar, volatile LAS unsigned* st) {
    XcdBarrier b; b.bar = bar; b.x = xb_xcc_id(); b.st = st;
    if (threadIdx.x == 0) (void)xb_add(&bar[XB_XCNT(b.x)], 1u);
    return b;
}
__device__ __forceinline__ void xcd_barrier_complete(unsigned* bar, unsigned x, unsigned& nloc, unsigned& nx) {
    const unsigned G = gridDim.x * gridDim.y * gridDim.z;
    unsigned sum, cnt, mine, sp = 0u;
    for (;;) {
        sum = 0u; cnt = 0u; mine = 0u;
#pragma unroll
        for (unsigned j = 0; j < 16; ++j) { const unsigned c = xb_ld(&bar[XB_XCNT(j)]); sum += c; cnt += (c > 0u) ? 1u : 0u; mine = (j == x) ? c : mine; }
        if (sum == G) break;
        __builtin_amdgcn_s_sleep(1);
        if ((++sp & 255u) == 0u) { if (xb_ld(&bar[XB_TMO])) break; if (sp > XB_SPIN_CAP) { atomicAdd(&bar[XB_TMO], 1u); break; } }
    }
    nloc = mine > 0u ? mine : 1u; nx = cnt > 0u ? cnt : 1u;
}

__device__ __forceinline__ void xcd_barrier(const XcdBarrier& b) {
    asm volatile("s_waitcnt vmcnt(0)" ::: "memory");
    __syncthreads();
    if (threadIdx.x == 0) {
        unsigned* bar = b.bar;
        __builtin_amdgcn_s_waitcnt(0);
        unsigned nloc = b.st[0], nx = b.st[1];
        if (nloc == 0u) { xcd_barrier_complete(bar, b.x, nloc, nx); b.st[0] = nloc; b.st[1] = nx; }
        const unsigned old = xb_add(&bar[XB_XSUB(b.x)], 1u);
        const unsigned gen = old / nloc;
        if (old + 1u == (gen + 1u) * nloc) {
            __builtin_amdgcn_fence(__ATOMIC_RELEASE, "agent");
            asm volatile("s_waitcnt vmcnt(0)" ::: "memory");
            const unsigned og = xb_add(&bar[XB_TOP], 1u);
            const unsigned tg = og / nx;
            if (og + 1u == (tg + 1u) * nx) xb_add(&bar[XB_TOPGEN], 1u);
            else XB_SPIN(xb_ld(&bar[XB_TOPGEN]) == tg, bar);
            __builtin_amdgcn_fence(__ATOMIC_ACQUIRE, "agent");
            xb_add(&bar[XB_XGEN(b.x)], 1u);
            asm volatile("s_waitcnt vmcnt(0)" ::: "memory");
        } else {
            XB_SPIN(xb_ld(&bar[XB_XGEN(b.x)]) == gen, bar);
            __builtin_amdgcn_fence(__ATOMIC_ACQUIRE, "agent");
            asm volatile("s_waitcnt vmcnt(0)" ::: "memory");
        }
    }
    __syncthreads();
}
namespace pg8 {
#define PG8_LAS __attribute__((address_space(3)))
typedef unsigned short bf16_t;
typedef short bf16x8 __attribute__((ext_vector_type(8)));
typedef float f32x4 __attribute__((ext_vector_type(4)));
typedef unsigned u32x4 __attribute__((ext_vector_type(4)));
constexpr int BM = 256, BK = 64, HALF = 128, HTB = HALF * BK * 2  , STAGE_BYTES = 8 * HTB, NXCD = 8, WGM = 8;

__host__ __device__ __forceinline__ int lds_byte(int r, int c) { const int st = (r >> 4) * 2 + (c >> 5), rr = r & 15, cc = c & 31, ob = rr * 64 + cc * 2; return st * 1024 + (ob ^ (((ob >> 9) & 1) << 5)); }
__host__ __device__ __forceinline__ void stage_rc(int b, int& R, int& C) { const int st = b / 1024, sb = b % 1024, swz = sb ^ (((sb >> 9) & 1) << 5); R = (st >> 1) * 16 + swz / 64; C = (st & 1) * 32 + (swz % 64) / 2; }
__host__ __device__ __forceinline__ int perm32(int rho) { const int n = rho >> 4, i = rho & 15; return 8 * (i >> 2) + 4 * n + (i & 3); }

struct Unit { int pm, pn, e; };
struct Gemm { const bf16_t* A; const bf16_t* Bt; int M, N, K; size_t bexp; };

struct StaticOrder {
    int nM, nN, nwg, G, c;
    __host__ __device__ void init(int M, int N, int G_, int c_) { nM = M / BM; nN = N / BM; nwg = nM * nN; G = G_; c = c_; }
    __host__ __device__ bool next(int i, Unit& u) const {
        const long L = (long)i * G + c; if (L >= nwg) return false;
        int wgid = (int)L; { const int q = nwg / NXCD, r = nwg % NXCD, xcd = wgid % NXCD, off = wgid / NXCD; wgid = (xcd < r ? xcd * (q + 1) : r * (q + 1) + (xcd - r) * q) + off; }
        const int nig = WGM * nN, gid = wgid / nig, fm = gid * WGM, gsz = (nM - fm) < WGM ? (nM - fm) : WGM;
        u.pm = fm + ((wgid % nig) % gsz); u.pn = (wgid % nig) / gsz; u.e = 0; return true;
    }
    __device__ __forceinline__ int arow(const Unit& u, int r) const { return u.pm * BM + r; }
    __device__ __forceinline__ void a_ready(const Unit&) const {}
    __device__ __forceinline__ void done(const Unit&) const {}
};
typedef __bf16 bf16x2_c __attribute__((ext_vector_type(2))); typedef float f32x2_c __attribute__((ext_vector_type(2)));
__device__ __forceinline__ unsigned cvt_pk_bf16(float lo, float hi) { const f32x2_c v = {lo, hi}; return __builtin_bit_cast(unsigned, __builtin_convertvector(v, bf16x2_c)); }

struct EpiB16 {
    static constexpr bool PERM = true, AFTER_DRAIN = false;
    bf16_t* O; int ldc; const float* rs;
    __device__ __forceinline__ void operator()(const f32x4 (&acc)[2][2][4][2], const Unit& u, int wr, int wc, int fr, int fq) const {
        const int row0 = u.pm * BM + wr * 64 + fr, col0 = u.pn * BM + wc * 32 + 8 * fq;
#pragma unroll
        for (int ai = 0; ai < 2; ++ai)
#pragma unroll
            for (int m = 0; m < 4; ++m) { bf16_t* rowp = O + (size_t)(row0 + ai * HALF + m * 16) * ldc + col0; const float r1 = rs ? rs[row0 + ai * HALF + m * 16] : 1.0f;
#pragma unroll
                for (int bj = 0; bj < 2; ++bj) { const f32x4 v0 = acc[ai][bj][m][0] * r1, v1 = acc[ai][bj][m][1] * r1;
                    u32x4 w; w.x = cvt_pk_bf16(v0[0], v0[1]); w.y = cvt_pk_bf16(v0[2], v0[3]); w.z = cvt_pk_bf16(v1[0], v1[1]); w.w = cvt_pk_bf16(v1[2], v1[3]);
                    *(u32x4*)(rowp + bj * HALF) = w; } }
    }
};
struct EpiRes {
    static constexpr bool PERM = false, AFTER_DRAIN = false;
    const float* base32; bf16_t* X; int ldc; float* ssp;
    __device__ __forceinline__ void operator()(const f32x4 (&acc)[2][2][4][2], const Unit& u, int wr, int wc, int fr, int fq) const {
        const int row0 = u.pm * BM + wr * 64 + fr, col0 = u.pn * BM + wc * 32 + 4 * fq;
        typedef unsigned u32x2v __attribute__((ext_vector_type(2)));
#pragma unroll
        for (int ai = 0; ai < 2; ++ai) {
            f32x4 bs[4][2][2];
            if (base32) {
#pragma unroll
                for (int m = 0; m < 4; ++m) { const size_t off = (size_t)(row0 + ai * HALF + m * 16) * ldc + col0;
#pragma unroll
                    for (int bj = 0; bj < 2; ++bj)
#pragma unroll
                        for (int n = 0; n < 2; ++n) bs[m][bj][n] = *(const f32x4*)(base32 + off + bj * HALF + n * 16); }
            } else {
                u32x2v rb[4][2][2];
#pragma unroll
                for (int m = 0; m < 4; ++m) { const size_t off = (size_t)(row0 + ai * HALF + m * 16) * ldc + col0;
#pragma unroll
                    for (int bj = 0; bj < 2; ++bj)
#pragma unroll
                        for (int n = 0; n < 2; ++n) rb[m][bj][n] = *(const u32x2v*)(X + off + bj * HALF + n * 16); }
#pragma unroll
                for (int m = 0; m < 4; ++m)
#pragma unroll
                    for (int bj = 0; bj < 2; ++bj)
#pragma unroll
                        for (int n = 0; n < 2; ++n) { const u32x2v w = rb[m][bj][n]; bs[m][bj][n] = (f32x4){__uint_as_float(w.x << 16), __uint_as_float(w.x & 0xFFFF0000u), __uint_as_float(w.y << 16), __uint_as_float(w.y & 0xFFFF0000u)}; }
            }
#pragma unroll
            for (int m = 0; m < 4; ++m) { const int row = row0 + ai * HALF + m * 16; const size_t off = (size_t)row * ldc + col0; float ss = 0.f;
#pragma unroll
                for (int bj = 0; bj < 2; ++bj)
#pragma unroll
                    for (int n = 0; n < 2; ++n) { const f32x4 o = bs[m][bj][n] + acc[ai][bj][m][n];
                        u32x2v w; w.x = cvt_pk_bf16(o[0], o[1]); w.y = cvt_pk_bf16(o[2], o[3]); *(u32x2v*)(X + off + bj * HALF + n * 16) = w;
                        ss += (o[0] * o[0] + o[1] * o[1]) + (o[2] * o[2] + o[3] * o[3]); }
                if (ssp) { ss += __shfl_xor(ss, 16); ss += __shfl_xor(ss, 32); if (fq == 0) ssp[(size_t)row * 16 + 4 * u.pn + wc] = ss; } }
        }
    }
};
struct EpiSwiglu {
    static constexpr bool PERM = true, AFTER_DRAIN = false;
    bf16_t* O; int ldc; const float* rs;
    __device__ __forceinline__ void operator()(const f32x4 (&acc)[2][2][4][2], const Unit& u, int wr, int wc, int fr, int fq) const {
        const int row0 = u.pm * BM + wr * 64 + fr, col0 = (u.pn * BM + wc * 32 + 8 * fq) >> 1;
        typedef unsigned u32x2v __attribute__((ext_vector_type(2)));
#pragma unroll
        for (int ai = 0; ai < 2; ++ai)
#pragma unroll
            for (int m = 0; m < 4; ++m) { bf16_t* rowp = O + (size_t)(row0 + ai * HALF + m * 16) * ldc + col0; const float r1 = rs[row0 + ai * HALF + m * 16];
#pragma unroll
                for (int bj = 0; bj < 2; ++bj) { const f32x4 a = acc[ai][bj][m][0] * r1, b = acc[ai][bj][m][1] * r1; float h[4];
#pragma unroll
                    for (int i = 0; i < 4; ++i) h[i] = a[i] * __builtin_amdgcn_rcpf(1.0f + __expf(-a[i])) * b[i];
                    u32x2v w; w.x = cvt_pk_bf16(h[0], h[1]); w.y = cvt_pk_bf16(h[2], h[3]);
                    *(u32x2v*)(rowp + bj * (HALF / 2)) = w; } }
    }
};
struct MoeOrder {
    const int* blk_e; int nunits, nN, G, c; const int* tok;
    __device__ __forceinline__ bool next(int i, Unit& u) const {
        const long L = (long)i * G + c; if (L >= nunits) return false;
        u.pm = (int)(L / nN); u.pn = (int)(L % nN); u.e = blk_e[u.pm]; return true;
    }
    __device__ __forceinline__ int arow(const Unit& u, int r) const { return tok ? tok[u.pm * BM + r] : u.pm * BM + r; }
    __device__ __forceinline__ void a_ready(const Unit&) const {}
    __device__ __forceinline__ void done(const Unit&) const {}
};
template <class Epi, class Sched, bool ALIGN_EPI = false, bool SP2 = false>
__device__ __forceinline__ void gemm_phase(PG8_LAS unsigned char* lds, const Gemm g, const Sched& S, const Epi& E) {
    static_assert(SP2, "only the two-super-phase loop is kept in this file");
    int tid_ = threadIdx.x; asm volatile("" : "+v"(tid_));
    const int tid = tid_, wid = __builtin_amdgcn_readfirstlane(tid >> 6), lane = tid & 63, wr = wid >> 2, wc = wid & 3, fr = lane & 15, fq = lane >> 4;
    const int K = g.K, nt = K / BK;
    unsigned voffB[2]; int RA[2], CA[2];
#pragma unroll
    for (int i = 0; i < 2; ++i) { int R, C; stage_rc(tid * 16 + i * 8192, R, C); const int Rb = Epi::PERM ? ((R & ~31) + perm32(R & 31)) : R;
        RA[i] = R; CA[i] = C; voffB[i] = (unsigned)(Rb * K + C) * 2u; }
    const size_t kstep = (size_t)(BK * 2);
    const size_t hstep = (size_t)HALF * K * 2;
    const size_t tstep = 2 * hstep;
    const unsigned ldsw = (unsigned)wid * 1024u;
    const int aoff = lds_byte(wr * 64 + fr, fq * 8), boff = lds_byte(wc * 32 + fr, fq * 8);
#define PG8_SA(b, h) (((b) * 2 + (h)) * HTB)
#define PG8_SB(b, h) ((4 + (b) * 2 + (h)) * HTB)
#define PG8_STAGE(bufoff, gbase, voff) do { _Pragma("unroll") for (int _i = 0; _i < 2; ++_i) \
        __builtin_amdgcn_global_load_lds((const unsigned*)((const char*)(gbase) + (voff)[_i]), (PG8_LAS unsigned*)(lds + (bufoff) + ldsw + _i * 8192), 16, 0, 0); } while (0)
#define PG8_AOFF(vo, u) do { _Pragma("unroll") for (int _h = 0; _h < 2; ++_h) _Pragma("unroll") for (int _i = 0; _i < 2; ++_i) \
        vo[_h][_i] = (unsigned)(S.arow(u, _h * HALF + RA[_i]) * K + CA[_i]) * 2u; } while (0)
#define PG8_LDA(dst, b, h) do { _Pragma("unroll") for (int m = 0; m < 4; ++m) _Pragma("unroll") for (int k = 0; k < 2; ++k) dst[m][k] = *(const PG8_LAS bf16x8*)(lds + PG8_SA(b, h) + aoff + m * 2048 + k * 1024); } while (0)
#define PG8_LDB(dst, b, h) do { _Pragma("unroll") for (int n = 0; n < 2; ++n) _Pragma("unroll") for (int k = 0; k < 2; ++k) dst[n][k] = *(const PG8_LAS bf16x8*)(lds + PG8_SB(b, h) + boff + n * 2048 + k * 1024); } while (0)
#define PG8_MMA(ai, bj, At, Bt) do { __builtin_amdgcn_s_setprio(1); _Pragma("unroll") for (int m = 0; m < 4; ++m) _Pragma("unroll") for (int n = 0; n < 2; ++n) _Pragma("unroll") for (int k = 0; k < 2; ++k) \
        acc[ai][bj][m][n] = __builtin_amdgcn_mfma_f32_16x16x32_bf16(Bt[n][k], At[m][k], acc[ai][bj][m][n], 0, 0, 0); __builtin_amdgcn_s_setprio(0); } while (0)
#define PG8_WAIT_V(n) asm volatile("s_waitcnt vmcnt(" #n ")" ::: "memory")
#define PG8_WAIT_L(n) asm volatile("s_waitcnt lgkmcnt(" #n ")" ::: "memory")
#define PG8_BAR __builtin_amdgcn_s_barrier()
#define PG8_SCHED __builtin_amdgcn_sched_barrier(0)
    Unit cur, nxt; int ui = 0;
    if (!S.next(0, cur)) return;
    f32x4 acc[2][2][4][2];
#pragma unroll
    for (int a = 0; a < 2; ++a)
#pragma unroll
        for (int b = 0; b < 2; ++b)
#pragma unroll
            for (int m = 0; m < 4; ++m)
#pragma unroll
                for (int n = 0; n < 2; ++n) acc[a][b][m][n] = (f32x4){0.f, 0.f, 0.f, 0.f};
    bf16x8 At[4][2], B0[2][2], B1[2][2];
    const char* Ab = (const char*)g.A;
    const char* cB = (const char*)g.Bt + (size_t)cur.pn * tstep + (size_t)cur.e * g.bexp;
    unsigned curA[2][2], nxtA[2][2];
    S.a_ready(cur);
    PG8_AOFF(curA, cur);
    PG8_STAGE(PG8_SB(0, 0), cB, voffB); PG8_STAGE(PG8_SB(0, 1), cB + hstep, voffB); PG8_STAGE(PG8_SA(0, 0), Ab, curA[0]); PG8_STAGE(PG8_SA(0, 1), Ab, curA[1]);
    if (wr == 1) PG8_BAR;
    PG8_WAIT_V(2); PG8_BAR;
    PG8_STAGE(PG8_SB(1, 0), cB + kstep, voffB); PG8_STAGE(PG8_SA(1, 0), Ab + kstep, curA[0]); PG8_STAGE(PG8_SB(1, 1), cB + hstep + kstep, voffB);
    PG8_WAIT_V(6); PG8_BAR;
    for (;;) {
        const bool has_next = S.next(ui + 1, nxt);
        const char* nB = has_next ? (const char*)g.Bt + (size_t)nxt.pn * tstep + (size_t)nxt.e * g.bexp : cB;
        if (has_next) { PG8_AOFF(nxtA, nxt); }
        else {
#pragma unroll
            for (int h = 0; h < 2; ++h)
#pragma unroll
                for (int i = 0; i < 2; ++i) nxtA[h][i] = curA[h][i]; }
        for (int t = 0; t < nt; t += 2) {
            const bool last = (t == nt - 2);
            const char* a1 = Ab + (size_t)(t + 1) * kstep;
            const char* a2 = last ? Ab : Ab + (size_t)(t + 2) * kstep; const char* b2 = last ? nB : cB + (size_t)(t + 2) * kstep;
            const char* a3 = a2 + kstep; const char* b3 = b2 + kstep;
            unsigned vo2[2][2];
#pragma unroll
            for (int h = 0; h < 2; ++h)
#pragma unroll
                for (int i = 0; i < 2; ++i) vo2[h][i] = last ? nxtA[h][i] : curA[h][i];
            if (last && has_next) S.a_ready(nxt);
            PG8_LDB(B0, 0, 0); PG8_LDB(B1, 0, 1); PG8_SCHED; PG8_LDA(At, 0, 0); PG8_STAGE(PG8_SA(1, 1), a1, curA[1]);
            PG8_WAIT_V(8); PG8_WAIT_L(0); PG8_BAR; PG8_MMA(0, 0, At, B0); PG8_MMA(0, 1, At, B1); PG8_BAR; PG8_SCHED;
            PG8_LDA(At, 0, 1); PG8_STAGE(PG8_SB(0, 0), b2, voffB); PG8_STAGE(PG8_SB(0, 1), b2 + hstep, voffB); PG8_STAGE(PG8_SA(0, 0), a2, vo2[0]);
            PG8_WAIT_V(8); PG8_WAIT_L(0); PG8_BAR; PG8_MMA(1, 0, At, B0); PG8_MMA(1, 1, At, B1); PG8_BAR; PG8_SCHED;
            PG8_LDB(B0, 1, 0); PG8_LDB(B1, 1, 1); PG8_SCHED; PG8_LDA(At, 1, 0); PG8_STAGE(PG8_SA(0, 1), a2, vo2[1]);
            PG8_WAIT_V(8); PG8_WAIT_L(0); PG8_BAR; PG8_MMA(0, 0, At, B0); PG8_MMA(0, 1, At, B1); PG8_BAR; PG8_SCHED;
            PG8_LDA(At, 1, 1); PG8_STAGE(PG8_SB(1, 0), b3, voffB); PG8_STAGE(PG8_SB(1, 1), b3 + hstep, voffB); PG8_STAGE(PG8_SA(1, 0), a3, vo2[0]);
            PG8_WAIT_V(8); PG8_WAIT_L(0); PG8_BAR; PG8_MMA(1, 0, At, B0); PG8_MMA(1, 1, At, B1); PG8_BAR; PG8_SCHED;
        }
        if constexpr (ALIGN_EPI) { if (wr == 0) PG8_BAR; }
        if constexpr (!Epi::AFTER_DRAIN) { E(acc, cur, wr, wc, fr, fq); S.done(cur); }
        if (!has_next) break;
#pragma unroll
        for (int a = 0; a < 2; ++a)
#pragma unroll
            for (int b = 0; b < 2; ++b)
#pragma unroll
                for (int m = 0; m < 4; ++m)
#pragma unroll
                    for (int n = 0; n < 2; ++n) acc[a][b][m][n] = (f32x4){0.f, 0.f, 0.f, 0.f};
        cur = nxt; cB = nB; ++ui;
#pragma unroll
        for (int h = 0; h < 2; ++h)
#pragma unroll
            for (int i = 0; i < 2; ++i) curA[h][i] = nxtA[h][i];
        if constexpr (ALIGN_EPI) { if (wr == 1) PG8_BAR; }
    }
    PG8_WAIT_V(0);
    if constexpr (!ALIGN_EPI) { if (wr == 0) PG8_BAR; }
    PG8_BAR;
    if constexpr (Epi::AFTER_DRAIN) { E.fused(acc, cur, wr, wc, fr, fq, lds, wid, lane); S.done(cur); }
#undef PG8_SA
#undef PG8_SB
#undef PG8_STAGE
#undef PG8_AOFF
#undef PG8_LDA
#undef PG8_LDB
#undef PG8_MMA
#undef PG8_WAIT_V
#undef PG8_WAIT_L
#undef PG8_BAR
#undef PG8_SCHED
}
}
__device__ __forceinline__ float bf2f(unsigned v) { return __uint_as_float(v << 16); }
__device__ __forceinline__ unsigned f2bf(float f) { unsigned u = __float_as_uint(f); u += 0x7FFFu + ((u >> 16) & 1u); return u >> 16; }
typedef __bf16 bf16x2_t __attribute__((ext_vector_type(2)));
__device__ __forceinline__ unsigned pk2(float lo, float hi) { const f32x2 v = {lo, hi}; return __builtin_bit_cast(unsigned, __builtin_convertvector(v, bf16x2_t)); }
__device__ __forceinline__ float bflo(unsigned w) { return __uint_as_float(w << 16); }
__device__ __forceinline__ float bfhi(unsigned w) { return __uint_as_float(w & 0xFFFF0000u); }
__device__ __forceinline__ float wave_sum(float v) {
#pragma unroll
    for (int o = 1; o < 64; o <<= 1) v += __shfl_xor(v, o);
    return v;
}
__device__ __forceinline__ float wave_max(float v) {
#pragma unroll
    for (int o = 1; o < 64; o <<= 1) v = fmaxf(v, __shfl_xor(v, o));
    return v;
}
__device__ __forceinline__ float sigmoidf_(float x) { return __builtin_amdgcn_rcpf(1.0f + __expf(-x)); }
__device__ __forceinline__ float tanhf_(float x) { return 1.0f - 2.0f * __builtin_amdgcn_rcpf(__expf(2.0f * x) + 1.0f); }
#define LDS_WAIT() asm volatile("s_waitcnt lgkmcnt(0)" ::: "memory")

struct Ctx { int tid, wave, lane, gw, ngw; unsigned char* shm; };

__device__ __forceinline__ int tr_src_col(int mode, int n, int scol0) { return mode == 1 ? (n < 2048 ? n : n + 16) : scol0 + n; }
__device__ __forceinline__ int tr_dst_row(int mode, int n, int drow0) { return mode == 2 ? 8 * (n >> 2) + (n & 3) : (mode == 3 ? 8 * (n >> 2) + 4 + (n & 3) : drow0 + n); }
struct TrD { const float* W; bf16_t* WT; const float* gain; int ldw, scol0, K, drow0, mode, item, nblk; };
__device__ __forceinline__ void tr_load(const TrD& d, int lane, f32x4 (&v)[8]) {
    const int kb = d.item / d.nblk, nb = d.item % d.nblk, k0 = 64 * kb, n0 = 32 * nb;
    const int n4 = 4 * (lane & 7), sc = tr_src_col(d.mode, n0 + n4, d.scol0);
#pragma unroll
    for (int i = 0; i < 8; ++i) v[i] = *(const f32x4*)(d.W + (size_t)(k0 + 8 * i + (lane >> 3)) * d.ldw + sc);
}
__device__ __forceinline__ void tr_finish(const TrD& d, int lane, f32x4 (&v)[8], LAS float* scr) {
    const int kb = d.item / d.nblk, nb = d.item % d.nblk, k0 = 64 * kb, n0 = 32 * nb, n4 = 4 * (lane & 7);
    if (d.gain) {
#pragma unroll
        for (int i = 0; i < 8; ++i) v[i] = v[i] * d.gain[k0 + 8 * i + (lane >> 3)]; }
#pragma unroll
    for (int i = 0; i < 8; ++i) { LAS float* q = scr + (8 * i + (lane >> 3)) * 33 + n4; q[0] = v[i].x; q[1] = v[i].y; q[2] = v[i].z; q[3] = v[i].w; }
    LDS_WAIT(); asm volatile("" ::: "memory");
    const int c = lane & 7;
#pragma unroll
    for (int j = 0; j < 4; ++j) { const int n = (lane >> 3) + 8 * j; const LAS float* s = scr + (8 * c) * 33 + n;
        u32x4 o; o.x = pk2(s[0 * 33], s[1 * 33]); o.y = pk2(s[2 * 33], s[3 * 33]); o.z = pk2(s[4 * 33], s[5 * 33]); o.w = pk2(s[6 * 33], s[7 * 33]);
        *(u32x4*)(d.WT + (size_t)tr_dst_row(d.mode, n0 + n, d.drow0) * d.K + k0 + 8 * c) = o; }
    LDS_WAIT(); asm volatile("" ::: "memory");
}
__device__ __forceinline__ void tr_pair(const TrD& d0, const TrD& d1, bool has1, int lane, LAS float* scr) {
    f32x4 va[8], vb[8];
    tr_load(d0, lane, va); if (has1) tr_load(d1, lane, vb);
    tr_finish(d0, lane, va, scr); if (has1) tr_finish(d1, lane, vb, scr + 64 * 33);
}
__device__ __forceinline__ void tr_matrix(const Ctx& c, const float* W, int ldw, int scol0, int K, int ncols, bf16_t* WT, int drow0, int mode, const float* gain = nullptr) {
    LAS float* scr = (LAS float*)(c.shm) + c.wave * (2 * 64 * 33);
    const int nblk = ncols / 32, nitems = (K / 64) * nblk;
    for (int it = c.gw; it < nitems; it += 2 * c.ngw) { TrD d0{W, WT, gain, ldw, scol0, K, drow0, mode, it, nblk}; TrD d1 = d0; d1.item = it + c.ngw; tr_pair(d0, d1, it + c.ngw < nitems, c.lane, scr); }
}
__device__ __forceinline__ TrD tr_moe_desc(const Params& p, int layer, int it) {
    bf16_t* w13t = (bf16_t*)(p.ws + OFF_WMOE); bf16_t* w2t = (bf16_t*)(p.ws + OFF_WMOE + 64 * MiB);
    const float* w1 = p.moe_w1 + (size_t)layer * NEXP * 1024 * 512; const float* w3 = p.moe_w3 + (size_t)layer * NEXP * 1024 * 512; const float* w2 = p.moe_w2 + (size_t)layer * NEXP * 512 * 1024;
    const int e = it / 768, r = it % 768;
    if (r < 256) return TrD{w1 + (size_t)e * 1024 * 512, w13t + (size_t)e * 1024 * 1024, p.norm_moe + layer * 1024, 512, 0, 1024, 0, 2, r, 16};
    if (r < 512) return TrD{w3 + (size_t)e * 1024 * 512, w13t + (size_t)e * 1024 * 1024, p.norm_moe + layer * 1024, 512, 0, 1024, 0, 3, r - 256, 16};
    return TrD{w2 + (size_t)e * 512 * 1024, w2t + (size_t)e * 1024 * 512, nullptr, 1024, 0, 512, 0, 0, r - 512, 32};
}
__device__ __forceinline__ void tr_moe_layer(const Ctx& c, const Params& p, int layer, int gw0, int ngw) {
    LAS float* scr = (LAS float*)(c.shm) + c.wave * (2 * 64 * 33);
    for (int it = c.gw - gw0; it < NEXP * 768; it += 2 * ngw) { const bool has1 = it + ngw < NEXP * 768; const TrD d0 = tr_moe_desc(p, layer, it); const TrD d1 = tr_moe_desc(p, layer, has1 ? it + ngw : it); tr_pair(d0, d1, has1, c.lane, scr); }
}

__device__ __forceinline__ void row_load(const float* row, int lane, f32x4 (&v)[4]) {
#pragma unroll
    for (int j = 0; j < 4; ++j) v[j] = *((const f32x4*)row + lane + 64 * j);
}
__device__ __forceinline__ float row_rstd(const f32x4 (&v)[4]) {
    float s = 0.f;
#pragma unroll
    for (int j = 0; j < 4; ++j) s += (v[j].x * v[j].x + v[j].y * v[j].y) + (v[j].z * v[j].z + v[j].w * v[j].w);
    return 1.0f / sqrtf(wave_sum(s) * (1.0f / 1024.0f) + 1e-6f);
}
__device__ __forceinline__ void row_scale(f32x4 (&v)[4], float rstd, const float* gain, int lane) {
#pragma unroll
    for (int j = 0; j < 4; ++j) { const f32x4 g = *((const f32x4*)gain + lane + 64 * j); v[j] = v[j] * rstd * g; }
}
__device__ __forceinline__ void row_store_bf16(bf16_t* orow, int lane, const f32x4 (&v)[4]) {
#pragma unroll
    for (int j = 0; j < 4; ++j) { u32x2 o; o.x = pk2(v[j].x, v[j].y); o.y = pk2(v[j].z, v[j].w); *((u32x2*)orow + lane + 64 * j) = o; }
}
__device__ __forceinline__ void row_store_f32(float* orow, int lane, const f32x4 (&v)[4]) {
#pragma unroll
    for (int j = 0; j < 4; ++j) *((f32x4*)orow + lane + 64 * j) = v[j];
}
__device__ __forceinline__ void row_combine(f32x4 (&v)[4], const bf16_t* yb, int p0, int p1, float g0, float g1, int lane) {
    const u32x2* r0 = (const u32x2*)(yb + (size_t)p0 * 1024); const u32x2* r1 = (const u32x2*)(yb + (size_t)p1 * 1024);
#pragma unroll
    for (int j = 0; j < 4; ++j) { const u32x2 a = r0[lane + 64 * j], b = r1[lane + 64 * j];
        v[j].x += g0 * bflo(a.x) + g1 * bflo(b.x); v[j].y += g0 * bfhi(a.x) + g1 * bfhi(b.x);
        v[j].z += g0 * bflo(a.y) + g1 * bflo(b.y); v[j].w += g0 * bfhi(a.y) + g1 * bfhi(b.y); }
}
__device__ __forceinline__ void row_logits(const f32x4 (&v)[4], const float* wT, int lane, int NL, LAS float* lg) {
#pragma unroll 1
    for (int o = 0; o < NL; ++o) { float s = 0.f;
#pragma unroll
        for (int j = 0; j < 4; ++j) { const f32x4 w = *((const f32x4*)(wT + o * 1024) + lane + 64 * j); s += (v[j].x * w.x + v[j].y * w.y) + (v[j].z * w.z + v[j].w * w.w); }
        s = wave_sum(s); if (lane == 0) lg[o] = s; }
    LDS_WAIT();
}

__device__ __forceinline__ void norm_plain(const Ctx& c, const float* src, const float* gain, bf16_t* H, int nrows) {
    for (int r0 = c.gw; r0 < nrows; r0 += 4 * c.ngw) {
        f32x4 v[4][4];
#pragma unroll
        for (int q = 0; q < 4; ++q) { const int r = r0 + q * c.ngw; if (r < nrows) row_load(src + (size_t)r * 1024, c.lane, v[q]); }
#pragma unroll
        for (int q = 0; q < 4; ++q) { const int r = r0 + q * c.ngw; if (r < nrows) { const float rs = row_rstd(v[q]); row_scale(v[q], rs, gain, c.lane); row_store_bf16(H + (size_t)r * 1024, c.lane, v[q]); } }
    }
}
__device__ __forceinline__ void route_row(const LAS float* lg, const float* bg, const float* be, int& e0, int& e1, float& g0, float& g1) {
    float gl[4]; int gt = 0; float gm;
#pragma unroll
    for (int i = 0; i < 4; ++i) gl[i] = lg[i] + bg[i];
    gm = gl[0];
#pragma unroll
    for (int i = 1; i < 4; ++i) if (gl[i] > gm) { gm = gl[i]; gt = i; }
    float gs = 0.f;
#pragma unroll
    for (int i = 0; i < 4; ++i) gs += __expf(gl[i] - gm);
    const float pg = 1.0f / gs;
    float el[8];
#pragma unroll
    for (int i = 0; i < 8; ++i) el[i] = lg[4 + 8 * gt + i] + be[8 * gt + i];
    int i0 = 0; float m0 = el[0];
#pragma unroll
    for (int i = 1; i < 8; ++i) if (el[i] > m0) { m0 = el[i]; i0 = i; }
    int i1 = -1; float m1 = -3.0e38f;
#pragma unroll
    for (int i = 0; i < 8; ++i) if (i != i0 && el[i] > m1) { m1 = el[i]; i1 = i; }
    float one = 1.0f; asm volatile("" : "+v"(one));
    const float q1 = __expf(m1 - m0); const float inv = one / (one + q1);
    e0 = gt * 8 + i0; e1 = gt * 8 + i1; g0 = pg * inv; g1 = pg * q1 * inv;
}
constexpr int RW_AS = 64 * 68;
__device__ __forceinline__ void rwkv_naive(const Ctx& c, const Params& p, int bh) {
    const int b = bh >> 3, hd = bh & 7, tid = c.tid, lane = c.lane, wv = c.wave;
    LAS float* L = (LAS float*)c.shm;
    LAS float* aR = L; LAS float* aK = L + RW_AS; LAS float* aV = L + 2 * RW_AS; LAS float* aW = L + 3 * RW_AS; LAS float* aA = L + 4 * RW_AS;
    LAS float* aB = L + 5 * RW_AS; LAS float* aG = L + 6 * RW_AS; LAS float* aY = L + 7 * RW_AS; LAS float* red = L + 8 * RW_AS;
    const bf16_t* P = (const bf16_t*)(p.ws + OFF_P); bf16_t* MIX = (bf16_t*)(p.ws + OFF_H);
    LAS f32x4* SL = (LAS f32x4*)(L + 8 * RW_AS + 1536);
    if (wv == 0) {
#pragma unroll
        for (int j4 = 0; j4 < 16; ++j4) SL[j4 * 64 + lane] = (f32x4){0.f, 0.f, 0.f, 0.f}; }
    const int t = lane, cg = wv;
    const int ch0 = hd * 64 + cg * 8;
    for (int tb = 0; tb < 64; ++tb) {
        const size_t tg0 = (size_t)b * SEQ + (size_t)tb * 64;
#pragma unroll 1
        for (int i = 0; i < 7; ++i) {
            const int task = tid + 512 * i, tt = task / 56, q = task % 56;
            int col; LAS float* dst; int kind = 0;
            if (q < 8) { col = hd * 64 + 8 * q; dst = aR + tt * 68 + 8 * q; }
            else if (q < 16) { col = 512 + hd * 64 + 8 * (q - 8); dst = aK + tt * 68 + 8 * (q - 8); }
            else if (q < 24) { col = 1024 + hd * 64 + 8 * (q - 16); dst = aV + tt * 68 + 8 * (q - 16); }
            else if (q < 32) { col = 1536 + 8 * (q - 24); dst = aW + tt * 68 + 8 * (q - 24); kind = 1; }
            else if (q < 40) { col = 1600 + 8 * (q - 32); dst = aA + tt * 68 + 8 * (q - 32); }
            else if (q < 48) { col = 1664 + 8 * (q - 40); dst = aB + tt * 68 + 8 * (q - 40); kind = 2; }
            else { col = 1664 + 8 * (q - 40); dst = aG + tt * 68 + 8 * (q - 48); kind = 2; }
            const bf16_t* src = P + (tg0 + tt) * EV_IN + 768 + col;
            const u32x4 cur = *(const u32x4*)src;
            u32x4 prv = (u32x4){0u, 0u, 0u, 0u};
            if (tb * 64 + tt > 0) prv = *(const u32x4*)(src - EV_IN);
            const f32x4 m0 = *(const f32x4*)(p.ev_mu + col), m1 = *(const f32x4*)(p.ev_mu + col + 4);
            float v[8];
            const unsigned cw[4] = {cur.x, cur.y, cur.z, cur.w}, pw[4] = {prv.x, prv.y, prv.z, prv.w};
            const float mu[8] = {m0.x, m0.y, m0.z, m0.w, m1.x, m1.y, m1.z, m1.w};
#pragma unroll
            for (int k = 0; k < 4; ++k) { const float c0 = bflo(cw[k]), c1 = bfhi(cw[k]), p0 = bflo(pw[k]), p1 = bfhi(pw[k]);
                v[2 * k] = c0 + (p0 - c0) * mu[2 * k]; v[2 * k + 1] = c1 + (p1 - c1) * mu[2 * k + 1]; }
            if (kind == 1) {
#pragma unroll
                for (int k = 0; k < 8; ++k) v[k] = tanhf(v[k]); }
            if (kind == 2) {
#pragma unroll
                for (int k = 0; k < 8; ++k) v[k] = sigmoidf_(v[k]); }
            *(LAS f32x4*)dst = (f32x4){v[0], v[1], v[2], v[3]}; *(LAS f32x4*)(dst + 4) = (f32x4){v[4], v[5], v[6], v[7]};
        }
        __syncthreads();
        float zw[8], za[8], gg[8];
#pragma unroll
        for (int i = 0; i < 8; ++i) { zw[i] = 0.f; za[i] = 0.f; gg[i] = 0.f; }
#pragma unroll 2
        for (int j4 = 0; j4 < 16; ++j4) {
            const f32x4 xw = *(const LAS f32x4*)(aW + t * 68 + 4 * j4), xa = *(const LAS f32x4*)(aA + t * 68 + 4 * j4);
            const f32x4 g0 = *(const LAS f32x4*)(aB + t * 68 + 4 * j4), g1 = *(const LAS f32x4*)(aG + t * 68 + 4 * j4);
#pragma unroll
            for (int jj = 0; jj < 4; ++jj) { const int j = 4 * j4 + jj;
                const f32x4 w2a = *(const f32x4*)(p.ev_w2 + (size_t)j * 512 + ch0), w2b = *(const f32x4*)(p.ev_w2 + (size_t)j * 512 + ch0 + 4);
                const f32x4 a2a = *(const f32x4*)(p.ev_a2 + (size_t)j * 512 + ch0), a2b = *(const f32x4*)(p.ev_a2 + (size_t)j * 512 + ch0 + 4);
                const f32x4 gla = *(const f32x4*)(p.ev_g2 + (size_t)j * 512 + ch0), glb = *(const f32x4*)(p.ev_g2 + (size_t)j * 512 + ch0 + 4);
                const f32x4 gha = *(const f32x4*)(p.ev_g2 + (size_t)(64 + j) * 512 + ch0), ghb = *(const f32x4*)(p.ev_g2 + (size_t)(64 + j) * 512 + ch0 + 4);
                const float xwv = xw[jj], xav = xa[jj], g0v = g0[jj], g1v = g1[jj];
#pragma unroll
                for (int i = 0; i < 4; ++i) { zw[i] += xwv * w2a[i]; zw[4 + i] += xwv * w2b[i]; za[i] += xav * a2a[i]; za[4 + i] += xav * a2b[i];
                    gg[i] += g0v * gla[i] + g1v * gha[i]; gg[4 + i] += g0v * glb[i] + g1v * ghb[i]; } }
        }
        float av[8], kkv[8]; float ss = 0.f;
        {
            const f32x4 kA = *(const LAS f32x4*)(aK + t * 68 + cg * 8), kB = *(const LAS f32x4*)(aK + t * 68 + cg * 8 + 4);
            const float kv[8] = {kA.x, kA.y, kA.z, kA.w, kB.x, kB.y, kB.z, kB.w};
            float dec[8], kp[8];
#pragma unroll
            for (int i = 0; i < 8; ++i) { const int ch = ch0 + i;
                const float u = -(p.ev_w0[ch] + zw[i]); const float sp = (u > 20.f) ? u : log1pf(__expf(u));
                const float w = -sp - 0.5f; dec[i] = __expf(-__expf(w));
                av[i] = sigmoidf_(p.ev_a0[ch] + za[i]);
                kkv[i] = kv[i] * p.ev_k_k[ch]; ss += kkv[i] * kkv[i];
                kp[i] = kv[i] * (1.0f + (av[i] - 1.0f) * p.ev_k_a[ch]); }
            red[t * 8 + cg] = ss;
            __syncthreads();
            *(LAS f32x4*)(aW + t * 68 + cg * 8) = (f32x4){dec[0], dec[1], dec[2], dec[3]}; *(LAS f32x4*)(aW + t * 68 + cg * 8 + 4) = (f32x4){dec[4], dec[5], dec[6], dec[7]};
            *(LAS f32x4*)(aK + t * 68 + cg * 8) = (f32x4){kp[0], kp[1], kp[2], kp[3]}; *(LAS f32x4*)(aK + t * 68 + cg * 8 + 4) = (f32x4){kp[4], kp[5], kp[6], kp[7]};
            *(LAS f32x4*)(aG + t * 68 + cg * 8) = (f32x4){gg[0], gg[1], gg[2], gg[3]}; *(LAS f32x4*)(aG + t * 68 + cg * 8 + 4) = (f32x4){gg[4], gg[5], gg[6], gg[7]};
            float tot = 0.f;
#pragma unroll
            for (int i = 0; i < 8; ++i) tot += red[t * 8 + i];
            const float inv = 1.0f / fmaxf(sqrtf(tot), 1e-12f);
            float an[8], bn[8];
#pragma unroll
            for (int i = 0; i < 8; ++i) { const float kn = kkv[i] * inv; an[i] = -kn; bn[i] = kn * av[i]; }
            *(LAS f32x4*)(aA + t * 68 + cg * 8) = (f32x4){an[0], an[1], an[2], an[3]}; *(LAS f32x4*)(aA + t * 68 + cg * 8 + 4) = (f32x4){an[4], an[5], an[6], an[7]};
            *(LAS f32x4*)(aB + t * 68 + cg * 8) = (f32x4){bn[0], bn[1], bn[2], bn[3]}; *(LAS f32x4*)(aB + t * 68 + cg * 8 + 4) = (f32x4){bn[4], bn[5], bn[6], bn[7]};
        }
        __syncthreads();
        if (wv == 0) {
            float S[64];
#pragma unroll
            for (int j4 = 0; j4 < 16; ++j4) { const f32x4 s4 = SL[j4 * 64 + lane]; S[4 * j4] = s4.x; S[4 * j4 + 1] = s4.y; S[4 * j4 + 2] = s4.z; S[4 * j4 + 3] = s4.w; }
#pragma unroll 1
            for (int tt = 0; tt < 64; ++tt) {
                const float vv = aV[tt * 68 + lane];
                float sa = 0.f;
#pragma unroll
                for (int j4 = 0; j4 < 16; ++j4) { const f32x4 a4 = *(const LAS f32x4*)(aA + tt * 68 + 4 * j4);
                    sa += S[4 * j4] * a4.x; sa += S[4 * j4 + 1] * a4.y; sa += S[4 * j4 + 2] * a4.z; sa += S[4 * j4 + 3] * a4.w; }
                float y = 0.f;
#pragma unroll
                for (int j4 = 0; j4 < 16; ++j4) {
                    const f32x4 d4 = *(const LAS f32x4*)(aW + tt * 68 + 4 * j4), b4 = *(const LAS f32x4*)(aB + tt * 68 + 4 * j4);
                    const f32x4 k4 = *(const LAS f32x4*)(aK + tt * 68 + 4 * j4), r4 = *(const LAS f32x4*)(aR + tt * 68 + 4 * j4);
#pragma unroll
                    for (int jj = 0; jj < 4; ++jj) { const int j = 4 * j4 + jj; S[j] = S[j] * d4[jj] + sa * b4[jj] + vv * k4[jj]; y += S[j] * r4[jj]; } }
                aY[tt * 68 + lane] = y;
            }
#pragma unroll
            for (int j4 = 0; j4 < 16; ++j4) SL[j4 * 64 + lane] = (f32x4){S[4 * j4], S[4 * j4 + 1], S[4 * j4 + 2], S[4 * j4 + 3]};
        }
        __syncthreads();
        {
            const f32x4 yA = *(const LAS f32x4*)(aY + t * 68 + cg * 8), yB = *(const LAS f32x4*)(aY + t * 68 + cg * 8 + 4);
            const f32x4 rA = *(const LAS f32x4*)(aR + t * 68 + cg * 8), rB = *(const LAS f32x4*)(aR + t * 68 + cg * 8 + 4);
            const f32x4 kA = *(const LAS f32x4*)(aK + t * 68 + cg * 8), kB = *(const LAS f32x4*)(aK + t * 68 + cg * 8 + 4);
            const f32x4 vA = *(const LAS f32x4*)(aV + t * 68 + cg * 8), vB = *(const LAS f32x4*)(aV + t * 68 + cg * 8 + 4);
            const f32x4 gA = *(const LAS f32x4*)(aG + t * 68 + cg * 8), gB = *(const LAS f32x4*)(aG + t * 68 + cg * 8 + 4);
            const float y[8] = {yA.x, yA.y, yA.z, yA.w, yB.x, yB.y, yB.z, yB.w}, r[8] = {rA.x, rA.y, rA.z, rA.w, rB.x, rB.y, rB.z, rB.w};
            const float k[8] = {kA.x, kA.y, kA.z, kA.w, kB.x, kB.y, kB.z, kB.w}, v[8] = {vA.x, vA.y, vA.z, vA.w, vB.x, vB.y, vB.z, vB.w};
            const float g[8] = {gA.x, gA.y, gA.z, gA.w, gB.x, gB.y, gB.z, gB.w};
            float s1 = 0.f, sb = 0.f;
#pragma unroll
            for (int i = 0; i < 8; ++i) { s1 += y[i]; sb += r[i] * k[i] * p.ev_r_k[ch0 + i]; }
            red[t * 8 + cg] = s1; red[512 + t * 8 + cg] = sb;
            __syncthreads();
            float m = 0.f, bon = 0.f;
#pragma unroll
            for (int i = 0; i < 8; ++i) { m += red[t * 8 + i]; bon += red[512 + t * 8 + i]; }
            m *= (1.0f / 64.0f);
            float s2 = 0.f;
#pragma unroll
            for (int i = 0; i < 8; ++i) s2 += (y[i] - m) * (y[i] - m);
            red[1024 + t * 8 + cg] = s2;
            __syncthreads();
            float var = 0.f;
#pragma unroll
            for (int i = 0; i < 8; ++i) var += red[1024 + t * 8 + i];
            const float rs = 1.0f / sqrtf(var * (1.0f / 64.0f) + 64e-5f);
            float o[8];
#pragma unroll
            for (int i = 0; i < 8; ++i) o[i] = ((y[i] - m) * rs * p.ev_lnx_w[ch0 + i] + p.ev_lnx_b[ch0 + i] + bon * v[i]) * g[i];
            u32x4 w; w.x = pk2(o[0], o[1]); w.y = pk2(o[2], o[3]); w.z = pk2(o[4], o[5]); w.w = pk2(o[6], o[7]);
            *(u32x4*)(MIX + (tg0 + t) * 1024 + 512 + ch0) = w;
        }
        __syncthreads();
    }
}

__device__ __forceinline__ void swa_naive(const Ctx& c, const Params& p, int unit) {
    const int b = unit >> 6, g = (unit >> 5) & 1, n = unit & 31, tid = c.tid, lane = c.lane, wv = c.wave;
    LAS bf16_t* Ks = (LAS bf16_t*)c.shm;
    LAS bf16_t* Vs = (LAS bf16_t*)(c.shm + 256 * 144);
    LAS float* qf = (LAS float*)(c.shm + 256 * 144 + 256 * 128) + wv * 320;
    LAS float* pr = qf + 64;
    const bf16_t* P = (const bf16_t*)(p.ws + OFF_P); bf16_t* MIX = (bf16_t*)(p.ws + OFF_H);
    __syncthreads();
#pragma unroll 1
    for (int i = 0; i < 8; ++i) {
        const int task = tid + 512 * i, which = task >> 11, r = (task >> 3) & 255, ck = task & 7;
        const int tk = n * 128 - 128 + r;
        u32x4 d = (u32x4){0u, 0u, 0u, 0u};
        if (tk >= 0) d = *(const u32x4*)(P + ((size_t)b * SEQ + tk) * EV_IN + 512 + which * 128 + g * 64 + ck * 8);
        if (which == 0) *(LAS u32x4*)(Ks + r * 72 + ck * 8) = d; else *(LAS u32x4*)(Vs + r * 64 + ck * 8) = d;
    }
    __syncthreads();
    const int head = g * 4 + (wv >> 1);
    const float sink = p.ev_sinks[head];
#pragma unroll 1
    for (int qq = 0; qq < 64; ++qq) {
        const int qi = (wv & 1) * 64 + qq;
        const size_t tq = (size_t)b * SEQ + n * 128 + qi;
        qf[lane] = bf2f(P[tq * EV_IN + head * 64 + lane]) * 0.125f;
        LDS_WAIT();
        float s[4];
#pragma unroll
        for (int j = 0; j < 4; ++j) { const int kp = lane + 64 * j; float a = 0.f;
#pragma unroll
            for (int ck = 0; ck < 8; ++ck) { const u32x4 kk = *(const LAS u32x4*)(Ks + kp * 72 + ck * 8);
                const f32x4 q0 = *(const LAS f32x4*)(qf + ck * 8), q1 = *(const LAS f32x4*)(qf + ck * 8 + 4);
                a += bflo(kk.x) * q0.x + bfhi(kk.x) * q0.y + bflo(kk.y) * q0.z + bfhi(kk.y) * q0.w + bflo(kk.z) * q1.x + bfhi(kk.z) * q1.y + bflo(kk.w) * q1.z + bfhi(kk.w) * q1.w; }
            const bool valid = (kp >= qi + 1) && (kp <= qi + 128) && (n > 0 || kp >= 128);
            s[j] = valid ? a : -INFINITY; }
        float m = fmaxf(fmaxf(s[0], s[1]), fmaxf(s[2], s[3])); m = fmaxf(wave_max(m), sink);
        float den = 0.f;
#pragma unroll
        for (int j = 0; j < 4; ++j) { const float e = __expf(s[j] - m); pr[lane + 64 * j] = e; den += e; }
        den = wave_sum(den) + __expf(sink - m);
        LDS_WAIT();
        float o = 0.f;
#pragma unroll 8
        for (int kp = qi + 1; kp <= qi + 128; ++kp) o += pr[kp] * bf2f(Vs[kp * 64 + lane]);
        MIX[tq * 1024 + head * 64 + lane] = (bf16_t)f2bf(o / den);
    }
}
__device__ __forceinline__ void gla_naive(const Ctx& c, const Params& p, int bh) {
    const int b = bh >> 2, hd = bh & 3, tid = c.tid, lane = c.lane, wv = c.wave;
    LAS float* qs = (LAS float*)c.shm; LAS float* ks = qs + 32 * 128; LAS float* es = ks + 32 * 128; LAS float* vs = es + 32 * 128; LAS float* os = vs + 32 * 256;
    const bf16_t* P = (const bf16_t*)(p.ws + OFF_P); const float* GK = (const float*)(p.ws + OFF_R); bf16_t* MIX = (bf16_t*)(p.ws + OFF_H);
    float S[128];
#pragma unroll
    for (int j = 0; j < 128; ++j) S[j] = 0.f;
    for (int tb = 0; tb < 128; ++tb) {
        const size_t tg0 = (size_t)b * SEQ + (size_t)tb * 32;
#pragma unroll 1
        for (int i = 0; i < 8; ++i) { const int idx = tid + 512 * i, tt = idx >> 7, j = idx & 127;
            const bf16_t* row = P + (tg0 + tt) * OD_IN;
            qs[idx] = bf2f(row[hd * 128 + j]) * 0.08838834764831845f; ks[idx] = bf2f(row[512 + hd * 128 + j]); es[idx] = __expf(GK[(tg0 + tt) * 512 + hd * 128 + j]); }
#pragma unroll 1
        for (int i = 0; i < 16; ++i) { const int idx = tid + 512 * i, tt = idx >> 8, j = idx & 255; vs[idx] = bf2f(P[(tg0 + tt) * OD_IN + 1024 + hd * 256 + j]); }
        __syncthreads();
        if (wv < 4) {
#pragma unroll 1
            for (int tt = 0; tt < 32; ++tt) {
                const float vv = vs[tt * 256 + tid]; float o = 0.f;
#pragma unroll
                for (int j4 = 0; j4 < 32; ++j4) {
                    const f32x4 e4 = *(const LAS f32x4*)(es + tt * 128 + 4 * j4), k4 = *(const LAS f32x4*)(ks + tt * 128 + 4 * j4), q4 = *(const LAS f32x4*)(qs + tt * 128 + 4 * j4);
#pragma unroll
                    for (int jj = 0; jj < 4; ++jj) { const int j = 4 * j4 + jj; S[j] = S[j] * e4[jj] + k4[jj] * vv; o += q4[jj] * S[j]; } }
                os[tt * 256 + tid] = o;
            }
        }
        __syncthreads();
#pragma unroll 1
        for (int i = 0; i < 4; ++i) { const int tt = wv + 8 * i;
            const f32x4 o4 = *(const LAS f32x4*)(os + tt * 256 + 4 * lane);
            const float ss = wave_sum(o4.x * o4.x + o4.y * o4.y + o4.z * o4.z + o4.w * o4.w);
            const float rs = 1.0f / sqrtf(ss * (1.0f / 256.0f) + 1e-6f);
            const f32x4 gn = *(const f32x4*)(p.od_onorm + 4 * lane);
            const u32x2 og = *(const u32x2*)(P + (tg0 + tt) * OD_IN + 2048 + hd * 256 + 4 * lane);
            const float g0 = bflo(og.x), g1 = bfhi(og.x), g2 = bflo(og.y), g3 = bfhi(og.y);
            u32x2 w; w.x = pk2(o4.x * rs * gn.x * g0 * sigmoidf_(g0), o4.y * rs * gn.y * g1 * sigmoidf_(g1)); w.y = pk2(o4.z * rs * gn.z * g2 * sigmoidf_(g2), o4.w * rs * gn.w * g3 * sigmoidf_(g3));
            *(u32x2*)(MIX + (tg0 + tt) * 1024 + hd * 256 + 4 * lane) = w; }
        __syncthreads();
    }
}

__device__ __forceinline__ void xattn_naive(const Ctx& c, const Params& p, int unit) {
    const int b = unit >> 5, hh = (unit >> 3) & 3, tblk = unit & 7, tid = c.tid, lane = c.lane, wv = c.wave;
    LAS bf16_t* Ks = (LAS bf16_t*)c.shm;
    LAS bf16_t* Vs = (LAS bf16_t*)(c.shm + 256 * 272);
    LAS float* qf = (LAS float*)(c.shm + 256 * 272 + 256 * 256) + wv * 384;
    LAS float* pr = qf + 128;
    const bf16_t* MKV = (const bf16_t*)(p.ws + OFF_MKV); const bf16_t* Q = (const bf16_t*)(p.ws + OFF_P); bf16_t* OA = (bf16_t*)(p.ws + OFF_P + 32 * MiB);
    __syncthreads();
#pragma unroll 1
    for (int i = 0; i < 16; ++i) {
        const int task = tid + 512 * i, which = task >> 12, r = (task >> 4) & 255, ck = task & 15;
        const u32x4 d = *(const u32x4*)(MKV + ((size_t)b * MEMLEN + r) * 1024 + which * 512 + hh * 128 + ck * 8);
        if (which == 0) *(LAS u32x4*)(Ks + r * 136 + ck * 8) = d; else *(LAS u32x4*)(Vs + r * 128 + ck * 8) = d;
    }
    __syncthreads();
#pragma unroll 1
    for (int qq = 0; qq < 64; ++qq) {
        const size_t tq = (size_t)b * SEQ + tblk * 512 + wv * 64 + qq;
        qf[lane] = bf2f(Q[tq * 512 + hh * 128 + lane]) * 0.08838834764831845f; qf[lane + 64] = bf2f(Q[tq * 512 + hh * 128 + 64 + lane]) * 0.08838834764831845f;
        LDS_WAIT();
        float s[4];
#pragma unroll
        for (int j = 0; j < 4; ++j) { const int kp = lane + 64 * j; float a = 0.f;
#pragma unroll
            for (int ck = 0; ck < 16; ++ck) { const u32x4 kk = *(const LAS u32x4*)(Ks + kp * 136 + ck * 8);
                const f32x4 q0 = *(const LAS f32x4*)(qf + ck * 8), q1 = *(const LAS f32x4*)(qf + ck * 8 + 4);
                a += bflo(kk.x) * q0.x + bfhi(kk.x) * q0.y + bflo(kk.y) * q0.z + bfhi(kk.y) * q0.w + bflo(kk.z) * q1.x + bfhi(kk.z) * q1.y + bflo(kk.w) * q1.z + bfhi(kk.w) * q1.w; }
            s[j] = a; }
        const float m = wave_max(fmaxf(fmaxf(s[0], s[1]), fmaxf(s[2], s[3])));
        float den = 0.f;
#pragma unroll
        for (int j = 0; j < 4; ++j) { const float e = __expf(s[j] - m); pr[lane + 64 * j] = e; den += e; }
        den = wave_sum(den);
        LDS_WAIT();
        float o0 = 0.f, o1 = 0.f;
#pragma unroll 4
        for (int k4 = 0; k4 < 64; ++k4) { const f32x4 p4 = *(const LAS f32x4*)(pr + 4 * k4);
#pragma unroll
            for (int kk = 0; kk < 4; ++kk) { const unsigned vv = *(const LAS unsigned*)(Vs + (4 * k4 + kk) * 128 + 2 * lane); o0 += p4[kk] * bflo(vv); o1 += p4[kk] * bfhi(vv); } }
        const float inv = 1.0f / den;
        *(unsigned*)(OA + tq * 512 + hh * 128 + 2 * lane) = pk2(o0 * inv, o1 * inv);
    }
}

__device__ __forceinline__ void moe_slots(const Ctx& c, const Params& p, int layer) {
    LAS int* sh = (LAS int*)c.shm;
    const int* cnt = (const int*)(p.ws + OFF_CTL + CTL_CNT) + layer * 32; int* cur = (int*)(p.ws + OFF_CTL + CTL_CUR) + layer * 32;
    int* blk = (int*)(p.ws + OFF_CTL + CTL_BLK) + layer * 1024;
    __syncthreads();
    if (c.tid == 0) { int acc = 0; for (int e = 0; e < NEXP; ++e) { sh[e] = acc; acc += (cnt[e] + 255) / 256 * 256; } sh[32] = acc; }
    __syncthreads();
    if (blockIdx.x == 0 && c.tid < NEXP) { const int e = c.tid, s = sh[e] / 256, en = (e == NEXP - 1 ? sh[32] : sh[e + 1]) / 256; for (int i = s; i < en; ++i) blk[1 + i] = e; if (e == 0) blk[0] = sh[32] / 256; }
    const int2* RE = (const int2*)(p.ws + OFF_ROUTE); int2* RP = (int2*)(p.ws + OFF_ROUTE + 512 * 1024);
    const bf16_t* H = (const bf16_t*)(p.ws + OFF_H); bf16_t* XB = (bf16_t*)(p.ws + OFF_P);
    for (int ck = c.gw; ck < T_TOK / 64; ck += c.ngw) {
        const int t = ck * 64 + c.lane; const int2 ee = RE[t]; int pos0 = 0, pos1 = 0;
#pragma unroll 1
        for (int e = 0; e < NEXP; ++e) {
            const unsigned long long m0 = __ballot(ee.x == e), m1 = __ballot(ee.y == e);
            const int n0 = __popcll(m0), n1 = __popcll(m1);
            if (n0 + n1 == 0) continue;
            int base = 0; if (c.lane == 0) base = atomicAdd(&cur[e], n0 + n1);
            base = __shfl(base, 0) + sh[e];
            const unsigned long long lt = (1ull << c.lane) - 1ull;
            if (ee.x == e) pos0 = base + __popcll(m0 & lt);
            if (ee.y == e) pos1 = base + n0 + __popcll(m1 & lt);
        }
        RP[t] = make_int2(pos0, pos1);
#pragma unroll 1
        for (int i = 0; i < 64; ++i) { const int ti = ck * 64 + i, q0 = __shfl(pos0, i), q1 = __shfl(pos1, i);
            const u32x4 a = *((const u32x4*)(H + (size_t)ti * 1024) + c.lane), bq = *((const u32x4*)(H + (size_t)ti * 1024) + 64 + c.lane);
            *((u32x4*)(XB + (size_t)q0 * 1024) + c.lane) = a; *((u32x4*)(XB + (size_t)q0 * 1024) + 64 + c.lane) = bq;
            *((u32x4*)(XB + (size_t)q1 * 1024) + c.lane) = a; *((u32x4*)(XB + (size_t)q1 * 1024) + 64 + c.lane) = bq; }
    }
}
typedef short bf16x8_t __attribute__((ext_vector_type(8)));
constexpr size_t R_GK = 0, R_QT = 64 * MiB, R_ATT = 96 * MiB, R_KHT = 112 * MiB, R_GDEC = 144 * MiB;
template <int CTRL, int RMASK> __device__ __forceinline__ float dpp_get0(float x) {
    return __builtin_bit_cast(float, __builtin_amdgcn_update_dpp(0, __builtin_bit_cast(int, x), CTRL, RMASK, 0xF, false)); }
__device__ __forceinline__ float wave_scan_incl(float x, int lane) {
    (void)lane;
    x += dpp_get0<0x111, 0xF>(x); x += dpp_get0<0x112, 0xF>(x); x += dpp_get0<0x114, 0xF>(x); x += dpp_get0<0x118, 0xF>(x);
    x += dpp_get0<0x142, 0xA>(x); x += dpp_get0<0x143, 0xC>(x);
    return x;
}
__device__ __forceinline__ float lane63(float x) { return __builtin_bit_cast(float, __builtin_amdgcn_readlane(__builtin_bit_cast(int, x), 63)); }
__device__ __forceinline__ int key_perm(int key) { const int kq = key & 31; return (key & ~31) + 8 * ((kq >> 2) & 3) + 4 * ((kq >> 4) & 1) + (kq & 3); }
__device__ __forceinline__ bf16x8_t zero_frag() { return (bf16x8_t){0, 0, 0, 0, 0, 0, 0, 0}; }
__device__ __forceinline__ bf16x8_t lds_frag(const LAS bf16_t* img, int pitch, int row, int col) { return *(const LAS bf16x8_t*)(img + row * pitch + col); }
__device__ __forceinline__ bf16x8_t pack8(const float (&v)[8]) {
    u32x4 w; w.x = pk2(v[0], v[1]); w.y = pk2(v[2], v[3]); w.z = pk2(v[4], v[5]); w.w = pk2(v[6], v[7]);
    return __builtin_bit_cast(bf16x8_t, w);
}
__device__ __forceinline__ void gla_prep(const Ctx& c, const Params& p, int unit) {
    const int bh = unit >> 6, ck = unit & 63, b = bh >> 2, hd = bh & 3, lane = c.lane, wv = c.wave;
    LAS bf16_t* Qs = (LAS bf16_t*)c.shm;
    LAS bf16_t* Ks = Qs + 64 * 136;
    const bf16_t* P = (const bf16_t*)(p.ws + OFF_P); unsigned char* R = p.ws + OFF_R;
    const float* GK = (const float*)(R + R_GK); bf16_t* QT = (bf16_t*)(R + R_QT) + (size_t)unit * 64 * 128; bf16_t* ATT = (bf16_t*)(R + R_ATT) + (size_t)unit * 64 * 64;
    bf16_t* KHT = (bf16_t*)(R + R_KHT) + (size_t)unit * 128 * 64; float* GDEC = (float*)(R + R_GDEC) + (size_t)unit * 128;
    const size_t tg = (size_t)b * SEQ + ck * 64 + lane; const int d0 = wv * 16;
    __syncthreads();
    {
        const bf16_t* row = P + tg * OD_IN;
        const u32x4 qa = *(const u32x4*)(row + hd * 128 + d0), qb = *(const u32x4*)(row + hd * 128 + d0 + 8);
        const u32x4 ka = *(const u32x4*)(row + 512 + hd * 128 + d0), kb = *(const u32x4*)(row + 512 + hd * 128 + d0 + 8);
        const unsigned qw[8] = {qa.x, qa.y, qa.z, qa.w, qb.x, qb.y, qb.z, qb.w}, kw[8] = {ka.x, ka.y, ka.z, ka.w, kb.x, kb.y, kb.z, kb.w};
        float qt[16], kt[16], kh[16];
#pragma unroll
        for (int i4 = 0; i4 < 4; ++i4) { const f32x4 g4 = *(const f32x4*)(GK + tg * 512 + hd * 128 + d0 + 4 * i4);
#pragma unroll
            for (int ii = 0; ii < 4; ++ii) { const int i = 4 * i4 + ii;
                const float bb = wave_scan_incl(g4[ii], lane); const float bl = lane63(bb);
                const float qv = (i & 1) ? bfhi(qw[i >> 1]) : bflo(qw[i >> 1]), kv = (i & 1) ? bfhi(kw[i >> 1]) : bflo(kw[i >> 1]);
                qt[i] = qv * 0.08838834764831845f * __expf(bb); kt[i] = kv * __expf(-bb); kh[i] = kv * __expf(bl - bb);
                if (lane == 63) GDEC[d0 + i] = __expf(bl); } }
        { u32x4 w0, w1; w0.x = pk2(qt[0], qt[1]); w0.y = pk2(qt[2], qt[3]); w0.z = pk2(qt[4], qt[5]); w0.w = pk2(qt[6], qt[7]); w1.x = pk2(qt[8], qt[9]); w1.y = pk2(qt[10], qt[11]); w1.z = pk2(qt[12], qt[13]); w1.w = pk2(qt[14], qt[15]);
          *(LAS u32x4*)(Qs + lane * 136 + d0) = w0; *(LAS u32x4*)(Qs + lane * 136 + d0 + 8) = w1; }
        { u32x4 w0, w1; w0.x = pk2(kt[0], kt[1]); w0.y = pk2(kt[2], kt[3]); w0.z = pk2(kt[4], kt[5]); w0.w = pk2(kt[6], kt[7]); w1.x = pk2(kt[8], kt[9]); w1.y = pk2(kt[10], kt[11]); w1.z = pk2(kt[12], kt[13]); w1.w = pk2(kt[14], kt[15]);
          *(LAS u32x4*)(Ks + lane * 136 + d0) = w0; *(LAS u32x4*)(Ks + lane * 136 + d0 + 8) = w1; }
        { const int sg = d0 >> 5, hb = (d0 >> 4) & 1;
#pragma unroll
          for (int x4 = 0; x4 < 4; ++x4) { u32x2 w; w.x = pk2(qt[4 * x4], qt[4 * x4 + 1]); w.y = pk2(qt[4 * x4 + 2], qt[4 * x4 + 3]);
              *(u32x2*)(QT + lane * 128 + 32 * sg + 8 * x4 + 4 * hb) = w; } }
        { const int sc = key_perm(lane);
#pragma unroll
          for (int i = 0; i < 16; ++i) KHT[(d0 + i) * 64 + sc] = (bf16_t)f2bf(kh[i]); }
    }
    __syncthreads();
    const int fr = lane & 15, fq = lane >> 4;
#pragma unroll
    for (int h2 = 0; h2 < 2; ++h2) { const int tile = 2 * wv + h2, si = tile >> 2, ti = tile & 3;
        f32x4 acc = (f32x4){0.f, 0.f, 0.f, 0.f};
        if (si <= ti) {
#pragma unroll
            for (int kk = 0; kk < 4; ++kk) { const bf16x8_t a = *(const LAS bf16x8_t*)(Ks + (16 * si + fr) * 136 + 32 * kk + 8 * fq), bq = *(const LAS bf16x8_t*)(Qs + (16 * ti + fr) * 136 + 32 * kk + 8 * fq);
                acc = __builtin_amdgcn_mfma_f32_16x16x32_bf16(a, bq, acc, 0, 0, 0); } }
        const int t = 16 * ti + fr, s0 = 16 * si + 4 * fq;
        u32x2 w; w.x = pk2(s0 <= t ? acc[0] : 0.f, s0 + 1 <= t ? acc[1] : 0.f); w.y = pk2(s0 + 2 <= t ? acc[2] : 0.f, s0 + 3 <= t ? acc[3] : 0.f);
        *(u32x2*)(ATT + t * 64 + 32 * (si >> 1) + 8 * fq + 4 * (si & 1)) = w; }
}
constexpr int GB_QT = 0, GB_ATT = 64 * 136 * 2, GB_KHT = GB_ATT + 64 * 72 * 2, GB_GD = GB_KHT + 128 * 72 * 2, GB_BYTES = GB_GD + 512;
__device__ __forceinline__ void gla_state_fill(const Params& p, unsigned char* buf, int unit, int ptid) {
    const unsigned char* R = p.ws + OFF_R;
    const bf16_t* QT = (const bf16_t*)(R + R_QT) + (size_t)unit * 64 * 128; const bf16_t* ATT = (const bf16_t*)(R + R_ATT) + (size_t)unit * 64 * 64;
    const bf16_t* KHT = (const bf16_t*)(R + R_KHT) + (size_t)unit * 128 * 64; const float* GDEC = (const float*)(R + R_GDEC) + (size_t)unit * 128;
    u32x4 r[11];
#pragma unroll
    for (int i = 0; i < 4; ++i) r[i] = *((const u32x4*)QT + ptid + 256 * i);
#pragma unroll
    for (int i = 0; i < 2; ++i) r[4 + i] = *((const u32x4*)ATT + ptid + 256 * i);
#pragma unroll
    for (int i = 0; i < 4; ++i) r[6 + i] = *((const u32x4*)KHT + ptid + 256 * i);
    if (ptid < 32) r[10] = *((const u32x4*)GDEC + ptid);
#pragma unroll
    for (int i = 0; i < 4; ++i) { const int idx = ptid + 256 * i; *(LAS u32x4*)(buf + GB_QT + (idx >> 4) * 272 + (idx & 15) * 16) = r[i]; }
#pragma unroll
    for (int i = 0; i < 2; ++i) { const int idx = ptid + 256 * i; *(LAS u32x4*)(buf + GB_ATT + (idx >> 3) * 144 + (idx & 7) * 16) = r[4 + i]; }
#pragma unroll
    for (int i = 0; i < 4; ++i) { const int idx = ptid + 256 * i; *(LAS u32x4*)(buf + GB_KHT + (idx >> 3) * 144 + (idx & 7) * 16) = r[6 + i]; }
    if (ptid < 32) *(LAS u32x4*)(buf + GB_GD + ptid * 16) = r[10];
}
__device__ __forceinline__ void gla_state(const Ctx& c, const Params& p, int bh, int slice) {
    const int b = bh >> 2, hd = bh & 3, lane = c.lane, wv = c.wave, fr = lane & 15, fq = lane >> 4, jt = slice * 4 + (wv & 3);
    const bf16_t* P = (const bf16_t*)(p.ws + OFF_P); bf16_t* O = (bf16_t*)p.out;
    unsigned char* sm = c.shm;
    f32x4 S[8];
#pragma unroll
    for (int i = 0; i < 8; ++i) S[i] = (f32x4){0.f, 0.f, 0.f, 0.f};
    bf16x8_t idf;
    { float iv[8];
#pragma unroll
      for (int e = 0; e < 8; ++e) iv[e] = (8 * fq + e == fr) ? 1.0f : 0.0f;
      idf = pack8(iv); }
    const size_t tb = (size_t)b * SEQ; const bf16_t* vcol = P + 1024 + hd * 256 + 16 * jt + 8 * fq;
    bf16x8_t vraw[4];
#pragma unroll
    for (int st = 0; st < 4; ++st) { vraw[st] = zero_frag(); if (wv < 4 && fq < 2) vraw[st] = *(const bf16x8_t*)(vcol + (tb + 16 * st + fr) * OD_IN); }
    __syncthreads();
    if (wv >= 4) gla_state_fill(p, sm, bh * 64, c.tid - 256);
    __syncthreads();
#pragma unroll 1
    for (int ck = 0; ck < 64; ++ck) {
        unsigned char* buf = sm + (ck & 1) * GB_BYTES;
        if (wv >= 4) { if (ck + 1 < 64) gla_state_fill(p, sm + ((ck + 1) & 1) * GB_BYTES, bh * 64 + ck + 1, c.tid - 256); }
        else {
            const size_t t0 = tb + ck * 64;
            const LAS bf16_t* QT = (const LAS bf16_t*)(buf + GB_QT); const LAS bf16_t* ATT = (const LAS bf16_t*)(buf + GB_ATT); const LAS bf16_t* KHT = (const LAS bf16_t*)(buf + GB_KHT); const LAS float* GD = (const LAS float*)(buf + GB_GD);
            bf16x8_t vf[2];
            { f32x4 vt[4];
#pragma unroll
              for (int st = 0; st < 4; ++st) vt[st] = __builtin_amdgcn_mfma_f32_16x16x32_bf16(vraw[st], idf, (f32x4){0.f, 0.f, 0.f, 0.f}, 0, 0, 0);
#pragma unroll
              for (int s2 = 0; s2 < 2; ++s2) { const float vv[8] = {vt[2 * s2][0], vt[2 * s2][1], vt[2 * s2][2], vt[2 * s2][3], vt[2 * s2 + 1][0], vt[2 * s2 + 1][1], vt[2 * s2 + 1][2], vt[2 * s2 + 1][3]}; vf[s2] = pack8(vv); } }
            if (ck + 1 < 64) {
#pragma unroll
                for (int st = 0; st < 4; ++st) if (fq < 2) vraw[st] = *(const bf16x8_t*)(vcol + (t0 + 64 + 16 * st + fr) * OD_IN); }
            f32x4 acc[4];
#pragma unroll
            for (int ti = 0; ti < 4; ++ti) acc[ti] = (f32x4){0.f, 0.f, 0.f, 0.f};
#pragma unroll
            for (int sg = 0; sg < 4; ++sg) { const float sv[8] = {S[2 * sg][0], S[2 * sg][1], S[2 * sg][2], S[2 * sg][3], S[2 * sg + 1][0], S[2 * sg + 1][1], S[2 * sg + 1][2], S[2 * sg + 1][3]};
                const bf16x8_t a = pack8(sv);
#pragma unroll
                for (int ti = 0; ti < 4; ++ti) acc[ti] = __builtin_amdgcn_mfma_f32_16x16x32_bf16(a, lds_frag(QT, 136, 16 * ti + fr, 32 * sg + 8 * fq), acc[ti], 0, 0, 0); }
#pragma unroll
            for (int s2 = 0; s2 < 2; ++s2)
#pragma unroll
                for (int ti = 0; ti < 4; ++ti) acc[ti] = __builtin_amdgcn_mfma_f32_16x16x32_bf16(vf[s2], lds_frag(ATT, 72, 16 * ti + fr, 32 * s2 + 8 * fq), acc[ti], 0, 0, 0);
#pragma unroll
            for (int ti = 0; ti < 4; ++ti) { u32x2 w; w.x = pk2(acc[ti][0], acc[ti][1]); w.y = pk2(acc[ti][2], acc[ti][3]);
                *(u32x2*)(O + (t0 + 16 * ti + fr) * 1024 + hd * 256 + 16 * jt + 4 * fq) = w; }
#pragma unroll
            for (int rt = 0; rt < 8; ++rt) { const f32x4 g4 = *(const LAS f32x4*)(GD + 16 * rt + 4 * fq); f32x4 s = S[rt] * g4;
#pragma unroll
                for (int s2 = 0; s2 < 2; ++s2) s = __builtin_amdgcn_mfma_f32_16x16x32_bf16(lds_frag(KHT, 72, 16 * rt + fr, 32 * s2 + 8 * fq), vf[s2], s, 0, 0, 0);
                S[rt] = s; }
        }
        __syncthreads();
    }
}
__device__ __forceinline__ void gla_finish(const Ctx& c, const Params& p) {
    const bf16_t* P = (const bf16_t*)(p.ws + OFF_P); bf16_t* O = (bf16_t*)p.out;
    const f32x4 gn = *((const f32x4*)p.od_onorm + c.lane);
    for (int r0 = c.gw; r0 < T_TOK; r0 += 2 * c.ngw) {
        u32x2 ow[2][4], gw[2][4];
#pragma unroll
        for (int q = 0; q < 2; ++q)
#pragma unroll
            for (int j = 0; j < 4; ++j) { const size_t r = (size_t)(r0 + q * c.ngw); ow[q][j] = *((const u32x2*)(O + r * 1024 + 256 * j) + c.lane); gw[q][j] = *((const u32x2*)(P + r * OD_IN + 2048 + 256 * j) + c.lane); }
#pragma unroll
        for (int q = 0; q < 2; ++q)
#pragma unroll
            for (int j = 0; j < 4; ++j) { const size_t r = (size_t)(r0 + q * c.ngw);
                const float o0 = bflo(ow[q][j].x), o1 = bfhi(ow[q][j].x), o2 = bflo(ow[q][j].y), o3 = bfhi(ow[q][j].y);
                const float ss = wave_sum(o0 * o0 + o1 * o1 + o2 * o2 + o3 * o3); const float rs = 1.0f / sqrtf(ss * (1.0f / 256.0f) + 1e-6f);
                const float g0 = bflo(gw[q][j].x), g1 = bfhi(gw[q][j].x), g2 = bflo(gw[q][j].y), g3 = bfhi(gw[q][j].y);
                u32x2 w; w.x = pk2(o0 * rs * gn.x * g0 * sigmoidf_(g0), o1 * rs * gn.y * g1 * sigmoidf_(g1)); w.y = pk2(o2 * rs * gn.z * g2 * sigmoidf_(g2), o3 * rs * gn.w * g3 * sigmoidf_(g3));
                *((u32x2*)(O + r * 1024 + 256 * j) + c.lane) = w; }
    }
}
constexpr size_t R_MG = 0, R_NT = 32 * MiB, R_QG = 64 * MiB, R_Y0 = 96 * MiB, R_Z0 = 128 * MiB, R_GAM = 160 * MiB, R_BON = 161 * MiB, R_MEMN = 164 * MiB;
constexpr size_t WSM_W2T = 0, WSM_A2T = 64 * 1024;
constexpr size_t WSM_G2T = 512 * 1024;
constexpr int XI = 64 * 72 * 2;
constexpr int X_RHS = 11 * XI, X_DIAG = X_RHS + 34816, X_TI = X_DIAG + 4352, X_RED = X_TI + 3072;

struct RxPre { u32x4 c1[2], p1[2], cr[3], pr[3]; };
__device__ __forceinline__ void rwkv_x_fetch(RxPre& f, const bf16_t* P, int b, int hd, int ck, int tid, int lane, int wv) {
    const size_t tg0 = (size_t)b * SEQ + (size_t)ck * 64; const u32x4 z = (u32x4){0u, 0u, 0u, 0u};
#pragma unroll
    for (int i = 0; i < 2; ++i) { const int task = tid + 512 * i, tt = task >> 4, q = task & 15; const bf16_t* src = P + (tg0 + tt) * EV_IN + 768 + 1536 + 8 * q;
        f.c1[i] = *(const u32x4*)src; f.p1[i] = z; if (ck * 64 + tt > 0) f.p1[i] = *(const u32x4*)(src - EV_IN); }
    const bf16_t* src = P + (tg0 + lane) * EV_IN + 768 + hd * 64 + wv * 8; const bool hp = (ck * 64 + lane > 0);
#pragma unroll
    for (int w3 = 0; w3 < 3; ++w3) { f.cr[w3] = *(const u32x4*)(src + 512 * w3); f.pr[w3] = z; if (hp) f.pr[w3] = *(const u32x4*)(src + 512 * w3 - EV_IN); }
}
__device__ __forceinline__ void rwkv_x(const Ctx& c, const Params& p, int unit, RxPre& pre, int nb, int nhd, int nck) {
    const int bh = unit >> 6, ck = unit & 63, b = bh >> 3, hd = bh & 7, tid = c.tid, lane = c.lane, wv = c.wave, fr = lane & 15, fq = lane >> 4;
    unsigned char* sm = c.shm;
    LAS bf16_t* At = (LAS bf16_t*)sm; LAS bf16_t* Bt = (LAS bf16_t*)(sm + XI); LAS bf16_t* Kt = (LAS bf16_t*)(sm + 2 * XI); LAS bf16_t* Rt = (LAS bf16_t*)(sm + 3 * XI);
    LAS bf16_t* BH = (LAS bf16_t*)(sm + 4 * XI); LAS bf16_t* KH = (LAS bf16_t*)(sm + 5 * XI); LAS bf16_t* VT = (LAS bf16_t*)(sm + 6 * XI);
    LAS bf16_t* AAB = (LAS bf16_t*)(sm + 7 * XI); LAS bf16_t* AAK = (LAS bf16_t*)(sm + 8 * XI); LAS bf16_t* ARB = (LAS bf16_t*)(sm + 9 * XI); LAS bf16_t* ARK = (LAS bf16_t*)(sm + 10 * XI);
    LAS bf16_t* XT = At;
    LAS bf16_t* YT = Kt;
    LAS float* RHS = (LAS float*)(sm + X_RHS);
    LAS float* sXW = RHS; LAS float* sXA = RHS + 64 * 68;
    LAS float* DIAG = (LAS float*)(sm + X_DIAG);
    LAS bf16_t* TI = (LAS bf16_t*)(sm + X_TI);
    LAS float* red = (LAS float*)(sm + X_RED);
    const bf16_t* P = (const bf16_t*)(p.ws + OFF_P); unsigned char* R = p.ws + OFF_R;
    const size_t tg0 = (size_t)b * SEQ + (size_t)ck * 64;
    const int t = lane, cg = wv, ch0 = hd * 64 + cg * 8;
    __syncthreads();
#pragma unroll
    for (int i = 0; i < 2; ++i) {
        const int task = tid + 512 * i, tt = task >> 4, q = task & 15;
        const int col = 1536 + 8 * q; LAS bf16_t* dst = (q < 8 ? At + tt * 72 + 8 * q : Bt + tt * 72 + 8 * (q - 8));
        const u32x4 cur = pre.c1[i], prv = pre.p1[i];
        const f32x4 m0 = *(const f32x4*)(p.ev_mu + col), m1 = *(const f32x4*)(p.ev_mu + col + 4);
        const unsigned cw[4] = {cur.x, cur.y, cur.z, cur.w}, pw[4] = {prv.x, prv.y, prv.z, prv.w}; const float mu[8] = {m0.x, m0.y, m0.z, m0.w, m1.x, m1.y, m1.z, m1.w};
        float v[8];
#pragma unroll
        for (int k = 0; k < 4; ++k) { const float c0 = bflo(cw[k]), c1 = bfhi(cw[k]), p0 = bflo(pw[k]), p1 = bfhi(pw[k]); v[2 * k] = c0 + (p0 - c0) * mu[2 * k]; v[2 * k + 1] = c1 + (p1 - c1) * mu[2 * k + 1]; }
        if (q < 8) {
#pragma unroll
            for (int k = 0; k < 8; ++k) v[k] = tanhf_(v[k]); }
        { u32x4 w; w.x = pk2(v[0], v[1]); w.y = pk2(v[2], v[3]); w.z = pk2(v[4], v[5]); w.w = pk2(v[6], v[7]); *(LAS u32x4*)dst = w; }
    }
    float rv[8], kv[8], vv[8];
    {
#pragma unroll
        for (int w3 = 0; w3 < 3; ++w3) { const u32x4 cur = pre.cr[w3], prv = pre.pr[w3];
            const f32x4 m0 = *(const f32x4*)(p.ev_mu + 512 * w3 + ch0), m1 = *(const f32x4*)(p.ev_mu + 512 * w3 + ch0 + 4);
            const unsigned cw[4] = {cur.x, cur.y, cur.z, cur.w}, pw[4] = {prv.x, prv.y, prv.z, prv.w}; const float mu[8] = {m0.x, m0.y, m0.z, m0.w, m1.x, m1.y, m1.z, m1.w};
#pragma unroll
            for (int k = 0; k < 4; ++k) { const float c0 = bflo(cw[k]), c1 = bfhi(cw[k]), p0 = bflo(pw[k]), p1 = bfhi(pw[k]);
                const float x0 = c0 + (p0 - c0) * mu[2 * k], x1 = c1 + (p1 - c1) * mu[2 * k + 1];
                if (w3 == 0) { rv[2 * k] = x0; rv[2 * k + 1] = x1; } else if (w3 == 1) { kv[2 * k] = x0; kv[2 * k + 1] = x1; } else { vv[2 * k] = x0; vv[2 * k + 1] = x1; } } }
    }
    if (nck >= 0) rwkv_x_fetch(pre, P, nb, nhd, nck, tid, lane, wv);
    __syncthreads();
    {
        const int mat = wv >> 2; const bf16_t* WT = (const bf16_t*)(p.ws + OFF_WSMALL + (mat ? WSM_A2T : WSM_W2T)); const LAS bf16_t* img = mat ? Bt : At; LAS float* dstm = mat ? sXA : sXW;
#pragma unroll
        for (int n = 0; n < 4; ++n) { const int tile = (wv & 3) * 4 + n, ct = tile >> 2, tt = tile & 3;
            f32x4 acc = (f32x4){0.f, 0.f, 0.f, 0.f};
#pragma unroll
            for (int kk = 0; kk < 2; ++kk) acc = __builtin_amdgcn_mfma_f32_16x16x32_bf16(*(const bf16x8_t*)(WT + (size_t)(hd * 64 + 16 * ct + fr) * 64 + 32 * kk + 8 * fq), lds_frag(img, 72, 16 * tt + fr, 32 * kk + 8 * fq), acc, 0, 0, 0);
            *(LAS f32x4*)(dstm + (16 * tt + fr) * 68 + 16 * ct + 4 * fq) = acc; }
    }
    __syncthreads();
    float zw[8], za[8];
    { const f32x4 a0 = *(const LAS f32x4*)(sXW + t * 68 + cg * 8), a1 = *(const LAS f32x4*)(sXW + t * 68 + cg * 8 + 4), b0 = *(const LAS f32x4*)(sXA + t * 68 + cg * 8), b1 = *(const LAS f32x4*)(sXA + t * 68 + cg * 8 + 4);
      zw[0] = a0.x; zw[1] = a0.y; zw[2] = a0.z; zw[3] = a0.w; zw[4] = a1.x; zw[5] = a1.y; zw[6] = a1.z; zw[7] = a1.w;
      za[0] = b0.x; za[1] = b0.y; za[2] = b0.z; za[3] = b0.w; za[4] = b1.x; za[5] = b1.y; za[6] = b1.z; za[7] = b1.w; }
    float lw[8], av[8], kkv[8], kp[8]; float ss = 0.f, sb = 0.f;
#pragma unroll
    for (int i = 0; i < 8; ++i) { const int ch = ch0 + i;
        const float u = -(p.ev_w0[ch] + zw[i]); const float sp = (u > 20.f) ? u : __logf(1.0f + __expf(u));
        lw[i] = -__expf(-sp - 0.5f);
        av[i] = sigmoidf_(p.ev_a0[ch] + za[i]);
        kkv[i] = kv[i] * p.ev_k_k[ch]; ss += kkv[i] * kkv[i];
        kp[i] = kv[i] * (1.0f + (av[i] - 1.0f) * p.ev_k_a[ch]);
        sb += rv[i] * kp[i] * p.ev_r_k[ch]; }
    red[t * 8 + cg] = ss; red[512 + t * 8 + cg] = sb;
    __syncthreads();
    {
        float tot = 0.f, bon = 0.f;
#pragma unroll
        for (int i = 0; i < 8; ++i) { tot += red[t * 8 + i]; bon += red[512 + t * 8 + i]; }
        if (cg == 0) ((float*)(R + R_BON))[(tg0 + t) * 8 + hd] = bon;
        const float inv = __builtin_amdgcn_rcpf(fmaxf(sqrtf(tot), 1e-12f));
        float at[8], rt_[8], bt[8], kt[8], bh_[8], kh_[8];
#pragma unroll
        for (int i = 0; i < 8; ++i) {
            const float cl = wave_scan_incl(lw[i], lane); const float cl63 = lane63(cl);
            const float e1 = __expf(cl), e0 = __expf(cl - lw[i]), en = __expf(-cl), eh = __expf(cl63 - cl);
            const float kn = kkv[i] * inv, A = -kn, Bv = kn * av[i];
            at[i] = A * e0; rt_[i] = rv[i] * e1; bt[i] = Bv * en; kt[i] = kp[i] * en; bh_[i] = Bv * eh; kh_[i] = kp[i] * eh;
            if (lane == 63) ((float*)(R + R_GAM))[(size_t)unit * 64 + cg * 8 + i] = __expf(cl63); }
        { u32x4 w; w.x = pk2(at[0], at[1]); w.y = pk2(at[2], at[3]); w.z = pk2(at[4], at[5]); w.w = pk2(at[6], at[7]); *(LAS u32x4*)(At + t * 72 + cg * 8) = w; }
        { u32x4 w; w.x = pk2(rt_[0], rt_[1]); w.y = pk2(rt_[2], rt_[3]); w.z = pk2(rt_[4], rt_[5]); w.w = pk2(rt_[6], rt_[7]); *(LAS u32x4*)(Rt + t * 72 + cg * 8) = w; }
        { u32x4 w; w.x = pk2(bt[0], bt[1]); w.y = pk2(bt[2], bt[3]); w.z = pk2(bt[4], bt[5]); w.w = pk2(bt[6], bt[7]); *(LAS u32x4*)(Bt + t * 72 + cg * 8) = w; }
        { u32x4 w; w.x = pk2(kt[0], kt[1]); w.y = pk2(kt[2], kt[3]); w.z = pk2(kt[4], kt[5]); w.w = pk2(kt[6], kt[7]); *(LAS u32x4*)(Kt + t * 72 + cg * 8) = w; }
        *(LAS f32x4*)(RHS + t * 132 + 64 + cg * 8) = (f32x4){at[0], at[1], at[2], at[3]}; *(LAS f32x4*)(RHS + t * 132 + 64 + cg * 8 + 4) = (f32x4){at[4], at[5], at[6], at[7]};
#pragma unroll
        for (int i = 0; i < 8; ++i) { BH[(cg * 8 + i) * 72 + t] = (bf16_t)f2bf(bh_[i]); KH[(cg * 8 + i) * 72 + t] = (bf16_t)f2bf(kh_[i]); VT[(cg * 8 + i) * 72 + t] = (bf16_t)f2bf(vv[i]); }
    }
    __syncthreads();
    {
        const int mat = wv >> 1;
        const LAS bf16_t* Ximg = (mat < 2) ? At : Rt; const LAS bf16_t* Yimg = (mat & 1) ? Kt : Bt;
        LAS bf16_t* Oimg = mat == 0 ? AAB : (mat == 1 ? AAK : (mat == 2 ? ARB : ARK));
#pragma unroll 4
        for (int n = 0; n < 8; ++n) { const int idx = (wv & 1) * 8 + n, si = idx >> 2, ti = idx & 3;
            f32x4 acc = (f32x4){0.f, 0.f, 0.f, 0.f};
            if (si <= ti) {
#pragma unroll
                for (int kk = 0; kk < 2; ++kk) acc = __builtin_amdgcn_mfma_f32_16x16x32_bf16(lds_frag(Yimg, 72, 16 * si + fr, 32 * kk + 8 * fq), lds_frag(Ximg, 72, 16 * ti + fr, 32 * kk + 8 * fq), acc, 0, 0, 0); }
            const int tt = 16 * ti + fr, s0 = 16 * si + 4 * fq; const int lim = (mat < 2) ? tt - 1 : tt;
            const float o0 = s0 <= lim ? acc[0] : 0.f, o1 = s0 + 1 <= lim ? acc[1] : 0.f, o2 = s0 + 2 <= lim ? acc[2] : 0.f, o3 = s0 + 3 <= lim ? acc[3] : 0.f;
            u32x2 w; w.x = pk2(o0, o1); w.y = pk2(o2, o3); *(LAS u32x2*)(Oimg + tt * 72 + s0) = w;
            if (mat == 0 && si == ti) { LAS float* d = DIAG + si * 272 + fr * 17 + 4 * fq; d[0] = o0; d[1] = o1; d[2] = o2; d[3] = o3; } }
    }
    __syncthreads();
    if (wv < 4) {
#pragma unroll
        for (int ti = 0; ti < 4; ++ti) { f32x4 acc = (f32x4){0.f, 0.f, 0.f, 0.f};
#pragma unroll
            for (int kk = 0; kk < 2; ++kk) acc = __builtin_amdgcn_mfma_f32_16x16x32_bf16(lds_frag(AAK, 72, 16 * ti + fr, 32 * kk + 8 * fq), lds_frag(VT, 72, 16 * wv + fr, 32 * kk + 8 * fq), acc, 0, 0, 0);
#pragma unroll
            for (int r = 0; r < 4; ++r) RHS[(16 * ti + 4 * fq + r) * 132 + 16 * wv + fr] = acc[r]; }
    } else if (lane < 16) { const int I = wv - 4; const LAS float* d = DIAG + I * 272; float T[16];
#pragma unroll
        for (int r = 0; r < 16; ++r) { float s = (r == lane) ? 1.f : 0.f;
#pragma unroll
            for (int q = 0; q < r; ++q) s += d[r * 17 + q] * T[q];
            T[r] = s; TI[I * 384 + r * 24 + lane] = (bf16_t)f2bf(s); } }
    __syncthreads();
#pragma unroll 1
    for (int I = 0; I < 4; ++I) {
        f32x4 acc;
#pragma unroll
        for (int r = 0; r < 4; ++r) acc[r] = RHS[(16 * I + 4 * fq + r) * 132 + 16 * wv + fr];
#pragma unroll 1
        for (int kk = 0; 32 * kk < 16 * I; ++kk) { const bool ok = (32 * kk + 8 * fq) < 16 * I;
            bf16x8_t a = zero_frag(), bq = zero_frag();
            if (ok) { a = lds_frag(AAB, 72, 16 * I + fr, 32 * kk + 8 * fq); bq = lds_frag(XT, 72, 16 * wv + fr, 32 * kk + 8 * fq); }
            acc = __builtin_amdgcn_mfma_f32_16x16x32_bf16(a, bq, acc, 0, 0, 0); }
        { u32x2 w; w.x = pk2(acc[0], acc[1]); w.y = pk2(acc[2], acc[3]); *(LAS u32x2*)(YT + (16 * wv + fr) * 24 + 4 * fq) = w; }
        LDS_WAIT();
        { bf16x8_t a = zero_frag(), bq = zero_frag();
          if (fq < 2) { a = *(const LAS bf16x8_t*)(TI + I * 384 + fr * 24 + 8 * fq); bq = *(const LAS bf16x8_t*)(YT + (16 * wv + fr) * 24 + 8 * fq); }
          f32x4 x = __builtin_amdgcn_mfma_f32_16x16x32_bf16(a, bq, (f32x4){0.f, 0.f, 0.f, 0.f}, 0, 0, 0);
          u32x2 w; w.x = pk2(x[0], x[1]); w.y = pk2(x[2], x[3]); *(LAS u32x2*)(XT + (16 * wv + fr) * 72 + 16 * I + 4 * fq) = w; }
        LDS_WAIT();
    }
    __syncthreads();
    {
        const int mat = wv >> 1;
        bf16_t* MG = (bf16_t*)(R + R_MG) + (size_t)unit * 4096; bf16_t* NT = (bf16_t*)(R + R_NT) + (size_t)unit * 4096;
        bf16_t* QG = (bf16_t*)(R + R_QG) + (size_t)unit * 4096; bf16_t* Y0G = (bf16_t*)(R + R_Y0) + (size_t)unit * 4096;
#pragma unroll 4
        for (int n = 0; n < 8; ++n) { const int idx = (wv & 1) * 8 + n, rt = idx >> 2, ct = idx & 3;
            f32x4 acc = (f32x4){0.f, 0.f, 0.f, 0.f};
            if (mat == 2) { const u32x2 r2 = *(const LAS u32x2*)(Rt + (16 * ct + fr) * 72 + 16 * rt + 4 * fq); acc = (f32x4){bflo(r2.x), bfhi(r2.x), bflo(r2.y), bfhi(r2.y)}; }
#pragma unroll
            for (int kk = 0; kk < 2; ++kk) { const int kc = 32 * kk + 8 * fq;
                if (mat == 0) acc = __builtin_amdgcn_mfma_f32_16x16x32_bf16(lds_frag(XT, 72, 64 + 16 * rt + fr, kc), lds_frag(BH, 72, 16 * ct + fr, kc), acc, 0, 0, 0);
                else if (mat == 1) { acc = __builtin_amdgcn_mfma_f32_16x16x32_bf16(lds_frag(BH, 72, 16 * rt + fr, kc), lds_frag(XT, 72, 16 * ct + fr, kc), acc, 0, 0, 0);
                                     acc = __builtin_amdgcn_mfma_f32_16x16x32_bf16(lds_frag(KH, 72, 16 * rt + fr, kc), lds_frag(VT, 72, 16 * ct + fr, kc), acc, 0, 0, 0); }
                else if (mat == 2) acc = __builtin_amdgcn_mfma_f32_16x16x32_bf16(lds_frag(XT, 72, 64 + 16 * rt + fr, kc), lds_frag(ARB, 72, 16 * ct + fr, kc), acc, 0, 0, 0);
                else { acc = __builtin_amdgcn_mfma_f32_16x16x32_bf16(lds_frag(XT, 72, 16 * rt + fr, kc), lds_frag(ARB, 72, 16 * ct + fr, kc), acc, 0, 0, 0);
                       acc = __builtin_amdgcn_mfma_f32_16x16x32_bf16(lds_frag(VT, 72, 16 * rt + fr, kc), lds_frag(ARK, 72, 16 * ct + fr, kc), acc, 0, 0, 0); } }
            u32x2 w; w.x = pk2(acc[0], acc[1]); w.y = pk2(acc[2], acc[3]);
            if (mat == 0) *(u32x2*)(MG + (16 * ct + fr) * 64 + 32 * (rt >> 1) + 8 * fq + 4 * (rt & 1)) = w;
            else if (mat == 1) *(u32x2*)(NT + (16 * ct + fr) * 64 + 16 * rt + 4 * fq) = w;
            else if (mat == 2) *(u32x2*)(QG + (16 * ct + fr) * 64 + 16 * rt + 4 * fq) = w;
            else *(u32x2*)(Y0G + (16 * ct + fr) * 64 + 16 * rt + 4 * fq) = w; }
    }
}

struct RwkvYOps { bf16x8_t m[4][2]; u32x2 n[4]; f32x4 g[4]; };
__device__ __forceinline__ void rwkv_y_load(RwkvYOps& o, const unsigned char* R, size_t unit, int jb, int fr, int fq) {
    const bf16_t* MG = (const bf16_t*)(R + R_MG) + unit * 4096; const bf16_t* NT = (const bf16_t*)(R + R_NT) + unit * 4096; const float* GAM = (const float*)(R + R_GAM) + unit * 64;
#pragma unroll
    for (int rt = 0; rt < 4; ++rt) {
#pragma unroll
        for (int sg = 0; sg < 2; ++sg) o.m[rt][sg] = *(const bf16x8_t*)(MG + (16 * rt + fr) * 64 + 32 * sg + 8 * fq);
        o.n[rt] = *(const u32x2*)(NT + (16 * jb + fr) * 64 + 16 * rt + 4 * fq); o.g[rt] = *(const f32x4*)(GAM + 16 * rt + 4 * fq); }
}
__device__ __forceinline__ void rwkv_y(const Ctx& c, const Params& p, int bh, int jb) {
    const int lane = c.lane, fr = lane & 15, fq = lane >> 4; unsigned char* R = p.ws + OFF_R;
    f32x4 Z[4];
#pragma unroll
    for (int i = 0; i < 4; ++i) Z[i] = (f32x4){0.f, 0.f, 0.f, 0.f};
    RwkvYOps cur, nxt; rwkv_y_load(cur, R, (size_t)bh * 64, jb, fr, fq);
#pragma unroll 1
    for (int ck = 0; ck < 64; ++ck) { const size_t unit = (size_t)bh * 64 + ck;
        rwkv_y_load(nxt, R, unit + (ck + 1 < 64 ? 1 : 0), jb, fr, fq);
        bf16_t* Z0 = (bf16_t*)(R + R_Z0) + unit * 4096;
        f32x4 acc[4];
#pragma unroll
        for (int rt = 0; rt < 4; ++rt) { u32x2 w; w.x = pk2(Z[rt][0], Z[rt][1]); w.y = pk2(Z[rt][2], Z[rt][3]); *(u32x2*)(Z0 + (16 * jb + fr) * 64 + 16 * rt + 4 * fq) = w;
            acc[rt] = (f32x4){bflo(cur.n[rt].x), bfhi(cur.n[rt].x), bflo(cur.n[rt].y), bfhi(cur.n[rt].y)} + cur.g[rt] * Z[rt]; }
        bf16x8_t zb[2];
#pragma unroll
        for (int sg = 0; sg < 2; ++sg) { const float zv[8] = {Z[2 * sg][0], Z[2 * sg][1], Z[2 * sg][2], Z[2 * sg][3], Z[2 * sg + 1][0], Z[2 * sg + 1][1], Z[2 * sg + 1][2], Z[2 * sg + 1][3]}; zb[sg] = pack8(zv); }
#pragma unroll
        for (int rt = 0; rt < 4; ++rt)
#pragma unroll
            for (int sg = 0; sg < 2; ++sg) acc[rt] = __builtin_amdgcn_mfma_f32_16x16x32_bf16(cur.m[rt][sg], zb[sg], acc[rt], 0, 0, 0);
#pragma unroll
        for (int rt = 0; rt < 4; ++rt) Z[rt] = acc[rt];
        cur = nxt;
    }
}

__device__ __forceinline__ void rwkv_z(const Ctx& c, const Params& p, int unit) {
    const int bh = unit >> 6, ck = unit & 63, b = bh >> 3, hd = bh & 7, lane = c.lane, fr = lane & 15, fq = lane >> 4; unsigned char* R = p.ws + OFF_R;
    const bf16_t* P = (const bf16_t*)(p.ws + OFF_P); bf16_t* MIX = (bf16_t*)p.out;
    const bf16_t* QG = (const bf16_t*)(R + R_QG) + (size_t)unit * 4096; const bf16_t* Y0G = (const bf16_t*)(R + R_Y0) + (size_t)unit * 4096; const bf16_t* Z0 = (const bf16_t*)(R + R_Z0) + (size_t)unit * 4096;
    const bf16_t* G2T = (const bf16_t*)(p.ws + OFF_WSMALL + WSM_G2T);
    const size_t tg0 = (size_t)b * SEQ + (size_t)ck * 64;
    f32x4 y[4][4], g[4][4];
#pragma unroll
    for (int jt = 0; jt < 4; ++jt)
#pragma unroll
        for (int tt = 0; tt < 4; ++tt) { const u32x2 w = *(const u32x2*)(Y0G + (16 * tt + fr) * 64 + 16 * jt + 4 * fq); y[jt][tt] = (f32x4){bflo(w.x), bfhi(w.x), bflo(w.y), bfhi(w.y)}; g[jt][tt] = (f32x4){0.f, 0.f, 0.f, 0.f}; }
#pragma unroll
    for (int sg = 0; sg < 2; ++sg) { bf16x8_t qb[4];
#pragma unroll
        for (int tt = 0; tt < 4; ++tt) qb[tt] = *(const bf16x8_t*)(QG + (16 * tt + fr) * 64 + 32 * sg + 8 * fq);
#pragma unroll
        for (int jt = 0; jt < 4; ++jt) { const bf16x8_t a = *(const bf16x8_t*)(Z0 + (16 * jt + fr) * 64 + 32 * sg + 8 * fq);
#pragma unroll
            for (int tt = 0; tt < 4; ++tt) y[jt][tt] = __builtin_amdgcn_mfma_f32_16x16x32_bf16(a, qb[tt], y[jt][tt], 0, 0, 0); } }
#pragma unroll 1
    for (int kk = 0; kk < 4; ++kk) { bf16x8_t sgf[4];
        const int col = 1664 + 32 * kk + 8 * fq; const f32x4 m0 = *(const f32x4*)(p.ev_mu + col), m1 = *(const f32x4*)(p.ev_mu + col + 4); const float mu[8] = {m0.x, m0.y, m0.z, m0.w, m1.x, m1.y, m1.z, m1.w};
#pragma unroll
        for (int tt = 0; tt < 4; ++tt) { const int tl = 16 * tt + fr; const bf16_t* src = P + (tg0 + tl) * EV_IN + 768 + col;
            const u32x4 cur = *(const u32x4*)src; u32x4 prv = (u32x4){0u, 0u, 0u, 0u}; if (ck * 64 + tl > 0) prv = *(const u32x4*)(src - EV_IN);
            const unsigned cw[4] = {cur.x, cur.y, cur.z, cur.w}, pw[4] = {prv.x, prv.y, prv.z, prv.w}; float v[8];
#pragma unroll
            for (int k = 0; k < 4; ++k) { const float c0 = bflo(cw[k]), c1 = bfhi(cw[k]), p0 = bflo(pw[k]), p1 = bfhi(pw[k]); v[2 * k] = sigmoidf_(c0 + (p0 - c0) * mu[2 * k]); v[2 * k + 1] = sigmoidf_(c1 + (p1 - c1) * mu[2 * k + 1]); }
            sgf[tt] = pack8(v); }
#pragma unroll
        for (int jt = 0; jt < 4; ++jt) { const bf16x8_t a = *(const bf16x8_t*)(G2T + (size_t)(hd * 64 + 16 * jt + fr) * 128 + 32 * kk + 8 * fq);
#pragma unroll
            for (int tt = 0; tt < 4; ++tt) g[jt][tt] = __builtin_amdgcn_mfma_f32_16x16x32_bf16(a, sgf[tt], g[jt][tt], 0, 0, 0); } }
#pragma unroll
    for (int tt = 0; tt < 4; ++tt) { const int tl = 16 * tt + fr;
        float s1 = 0.f;
#pragma unroll
        for (int jt = 0; jt < 4; ++jt) s1 += (y[jt][tt][0] + y[jt][tt][1]) + (y[jt][tt][2] + y[jt][tt][3]);
        s1 += __shfl_xor(s1, 16); s1 += __shfl_xor(s1, 32); const float mean = s1 * (1.0f / 64.0f);
        float s2 = 0.f;
#pragma unroll
        for (int jt = 0; jt < 4; ++jt)
#pragma unroll
            for (int r = 0; r < 4; ++r) { const float d = y[jt][tt][r] - mean; s2 += d * d; }
        s2 += __shfl_xor(s2, 16); s2 += __shfl_xor(s2, 32); const float rs = 1.0f / sqrtf(s2 * (1.0f / 64.0f) + 64e-5f);
        const float bon = ((const float*)(R + R_BON))[(tg0 + tl) * 8 + hd]; const bool hp = (ck * 64 + tl > 0);
#pragma unroll
        for (int jt = 0; jt < 4; ++jt) { const int ch = hd * 64 + 16 * jt + 4 * fq;
            const bf16_t* src = P + (tg0 + tl) * EV_IN + 768 + 1024 + ch; const u32x2 cur = *(const u32x2*)src; u32x2 prv; prv.x = 0u; prv.y = 0u; if (hp) prv = *(const u32x2*)(src - EV_IN);
            const f32x4 mu = *(const f32x4*)(p.ev_mu + 1024 + ch), lw4 = *(const f32x4*)(p.ev_lnx_w + ch), lb4 = *(const f32x4*)(p.ev_lnx_b + ch);
            const float c0 = bflo(cur.x), c1 = bfhi(cur.x), c2 = bflo(cur.y), c3 = bfhi(cur.y), p0 = bflo(prv.x), p1 = bfhi(prv.x), p2 = bflo(prv.y), p3 = bfhi(prv.y);
            const float v0 = c0 + (p0 - c0) * mu.x, v1 = c1 + (p1 - c1) * mu.y, v2 = c2 + (p2 - c2) * mu.z, v3 = c3 + (p3 - c3) * mu.w;
            const f32x4 yy = y[jt][tt], gg = g[jt][tt];
            const float o0 = ((yy[0] - mean) * rs * lw4.x + lb4.x + bon * v0) * gg[0], o1 = ((yy[1] - mean) * rs * lw4.y + lb4.y + bon * v1) * gg[1];
            const float o2 = ((yy[2] - mean) * rs * lw4.z + lb4.z + bon * v2) * gg[2], o3 = ((yy[3] - mean) * rs * lw4.w + lb4.w + bon * v3) * gg[3];
            u32x2 w; w.x = pk2(o0, o1); w.y = pk2(o2, o3); *(u32x2*)(MIX + (tg0 + tl) * 1024 + 512 + ch) = w; } }
}

__device__ __forceinline__ void xattn_mfma(const Ctx& c, const Params& p, int unit) {
    const int b = unit >> 5, hh = (unit >> 3) & 3, tblk = unit & 7, tid = c.tid, lane = c.lane, wv = c.wave, fr = lane & 15, fq = lane >> 4;
    LAS bf16_t* Ks = (LAS bf16_t*)c.shm;
    LAS bf16_t* VTp = (LAS bf16_t*)(c.shm + 256 * 272);
    const bf16_t* MKV = (const bf16_t*)(p.ws + OFF_MKV); const bf16_t* Q = (const bf16_t*)(p.ws + OFF_P); bf16_t* OA = (bf16_t*)(p.ws + OFF_P + 32 * MiB);
    __syncthreads();
    {
        u32x4 dd[16];
#pragma unroll
        for (int i = 0; i < 16; ++i) { const int task = tid + 512 * i, which = task >> 12, r = (task >> 4) & 255, ck = task & 15;
            dd[i] = *(const u32x4*)(MKV + ((size_t)b * MEMLEN + r) * 1024 + which * 512 + hh * 128 + ck * 8); }
#pragma unroll
        for (int i = 0; i < 16; ++i) { const int task = tid + 512 * i, which = task >> 12, r = (task >> 4) & 255, ck = task & 15; const u32x4 d = dd[i];
            if (which == 0) *(LAS u32x4*)(Ks + r * 136 + ck * 8) = d;
            else { const int kc = key_perm(r); const unsigned w[4] = {d.x, d.y, d.z, d.w};
#pragma unroll
                for (int k = 0; k < 4; ++k) { VTp[(ck * 8 + 2 * k) * 264 + kc] = (bf16_t)(w[k] & 0xFFFFu); VTp[(ck * 8 + 2 * k + 1) * 264 + kc] = (bf16_t)(w[k] >> 16); } } }
    }
    __syncthreads();
#pragma unroll 1
    for (int qt = 0; qt < 4; ++qt) {
        const size_t tq = (size_t)b * SEQ + tblk * 512 + wv * 64 + qt * 16 + fr;
        bf16x8_t qf[4];
#pragma unroll
        for (int kk = 0; kk < 4; ++kk) qf[kk] = *(const bf16x8_t*)(Q + tq * 512 + hh * 128 + 32 * kk + 8 * fq);
        float qsc;
        { const f32x4* sp = (const f32x4*)((const float*)(p.ws + OFF_R + R_SSP) + tq * 16); const f32x4 s0 = sp[0], s1 = sp[1], s2 = sp[2], s3 = sp[3];
          const float ssq = ((s0.x + s0.y) + (s0.z + s0.w)) + ((s1.x + s1.y) + (s1.z + s1.w)) + ((s2.x + s2.y) + (s2.z + s2.w)) + ((s3.x + s3.y) + (s3.z + s3.w));
          qsc = 0.08838834764831845f / sqrtf(ssq * (1.0f / 1024.0f) + 1e-6f); }
        f32x4 s[16];
#pragma unroll
        for (int kt = 0; kt < 16; ++kt) { s[kt] = (f32x4){0.f, 0.f, 0.f, 0.f};
#pragma unroll
            for (int kk = 0; kk < 4; ++kk) s[kt] = __builtin_amdgcn_mfma_f32_16x16x32_bf16(lds_frag(Ks, 136, 16 * kt + fr, 32 * kk + 8 * fq), qf[kk], s[kt], 0, 0, 0);
            if (kt & 1) __builtin_amdgcn_sched_barrier(0); }
        float m = s[0][0];
#pragma unroll
        for (int kt = 0; kt < 16; ++kt) m = fmaxf(fmaxf(fmaxf(m, s[kt][0]), fmaxf(s[kt][1], s[kt][2])), s[kt][3]);
        m = fmaxf(m, __shfl_xor(m, 16)); m = fmaxf(m, __shfl_xor(m, 32));
        float den = 0.f;
#pragma unroll
        for (int kt = 0; kt < 16; ++kt)
#pragma unroll
            for (int r = 0; r < 4; ++r) { const float e = __expf((s[kt][r] - m) * qsc); s[kt][r] = e; den += e; }
        den += __shfl_xor(den, 16); den += __shfl_xor(den, 32);
        f32x4 o[8];
#pragma unroll
        for (int dt = 0; dt < 8; ++dt) o[dt] = (f32x4){0.f, 0.f, 0.f, 0.f};
#pragma unroll
        for (int sg = 0; sg < 8; ++sg) { const float pv[8] = {s[2 * sg][0], s[2 * sg][1], s[2 * sg][2], s[2 * sg][3], s[2 * sg + 1][0], s[2 * sg + 1][1], s[2 * sg + 1][2], s[2 * sg + 1][3]};
            const bf16x8_t pb = pack8(pv);
#pragma unroll
            for (int dt = 0; dt < 8; ++dt) o[dt] = __builtin_amdgcn_mfma_f32_16x16x32_bf16(lds_frag(VTp, 264, 16 * dt + fr, 32 * sg + 8 * fq), pb, o[dt], 0, 0, 0);
            __builtin_amdgcn_sched_barrier(0); }
        const float inv = 1.0f / den;
#pragma unroll
        for (int dt = 0; dt < 8; ++dt) { u32x2 w; w.x = pk2(o[dt][0] * inv, o[dt][1] * inv); w.y = pk2(o[dt][2] * inv, o[dt][3] * inv); *(u32x2*)(OA + tq * 512 + hh * 128 + 16 * dt + 4 * fq) = w; }
    }
}
__device__ __forceinline__ void swa_mfma(const Ctx& c, const Params& p, int unit) {
    const int b = unit >> 6, g = (unit >> 5) & 1, n = unit & 31, tid = c.tid, lane = c.lane, wv = c.wave, fr = lane & 15, fq = lane >> 4;
    LAS bf16_t* Ks = (LAS bf16_t*)c.shm;
    LAS bf16_t* VTp = (LAS bf16_t*)(c.shm + 256 * 144);
    const bf16_t* P = (const bf16_t*)(p.ws + OFF_P); bf16_t* MIX = (bf16_t*)p.out;
    __syncthreads();
    {
        u32x4 dd[8];
#pragma unroll
        for (int i = 0; i < 8; ++i) { const int task = tid + 512 * i, which = task >> 11, r = (task >> 3) & 255, ck = task & 7; const int tk = n * 128 - 128 + r;
            dd[i] = (u32x4){0u, 0u, 0u, 0u}; if (tk >= 0) dd[i] = *(const u32x4*)(P + ((size_t)b * SEQ + tk) * EV_IN + 512 + which * 128 + g * 64 + ck * 8); }
#pragma unroll
        for (int i = 0; i < 8; ++i) { const int task = tid + 512 * i, which = task >> 11, r = (task >> 3) & 255, ck = task & 7; const u32x4 d = dd[i];
            if (which == 0) *(LAS u32x4*)(Ks + r * 72 + ck * 8) = d;
            else { const int kc = key_perm(r); const unsigned w[4] = {d.x, d.y, d.z, d.w};
#pragma unroll
                for (int k = 0; k < 4; ++k) { VTp[(ck * 8 + 2 * k) * 264 + kc] = (bf16_t)(w[k] & 0xFFFFu); VTp[(ck * 8 + 2 * k + 1) * 264 + kc] = (bf16_t)(w[k] >> 16); } } }
    }
    __syncthreads();
#pragma unroll 1
    for (int it = 0; it < 4; ++it) {
        const int tile = wv * 4 + it, hql = tile >> 3, qb = tile & 7, head = g * 4 + hql, sg0 = qb >> 1;
        const int qi = 16 * qb + fr; const size_t tq = (size_t)b * SEQ + n * 128 + qi;
        const float sink = p.ev_sinks[head];
        bf16x8_t qf[2];
#pragma unroll
        for (int kk = 0; kk < 2; ++kk) qf[kk] = *(const bf16x8_t*)(P + tq * EV_IN + head * 64 + 32 * kk + 8 * fq);
        f32x4 s[10]; float m = sink;
#pragma unroll
        for (int i = 0; i < 10; ++i) { const int kt = 2 * sg0 + i; s[i] = (f32x4){0.f, 0.f, 0.f, 0.f};
#pragma unroll
            for (int kk = 0; kk < 2; ++kk) s[i] = __builtin_amdgcn_mfma_f32_16x16x32_bf16(lds_frag(Ks, 72, 16 * kt + fr, 32 * kk + 8 * fq), qf[kk], s[i], 0, 0, 0);
#pragma unroll
            for (int r = 0; r < 4; ++r) { const int kp = 16 * kt + 4 * fq + r; const bool valid = (kp >= qi + 1) && (kp <= qi + 128) && (n > 0 || kp >= 128);
                s[i][r] = valid ? s[i][r] * 0.125f : -INFINITY; m = fmaxf(m, s[i][r]); } }
        m = fmaxf(m, __shfl_xor(m, 16)); m = fmaxf(m, __shfl_xor(m, 32));
        float den = 0.f;
#pragma unroll
        for (int i = 0; i < 10; ++i)
#pragma unroll
            for (int r = 0; r < 4; ++r) { const float e = __expf(s[i][r] - m); s[i][r] = e; den += e; }
        den += __shfl_xor(den, 16); den += __shfl_xor(den, 32); den += __expf(sink - m);
        f32x4 o[4];
#pragma unroll
        for (int dt = 0; dt < 4; ++dt) o[dt] = (f32x4){0.f, 0.f, 0.f, 0.f};
#pragma unroll
        for (int i2 = 0; i2 < 5; ++i2) { const float pv[8] = {s[2 * i2][0], s[2 * i2][1], s[2 * i2][2], s[2 * i2][3], s[2 * i2 + 1][0], s[2 * i2 + 1][1], s[2 * i2 + 1][2], s[2 * i2 + 1][3]};
            const bf16x8_t pb = pack8(pv);
#pragma unroll
            for (int dt = 0; dt < 4; ++dt) o[dt] = __builtin_amdgcn_mfma_f32_16x16x32_bf16(lds_frag(VTp, 264, 16 * dt + fr, 32 * (sg0 + i2) + 8 * fq), pb, o[dt], 0, 0, 0); }
        const float inv = 1.0f / den;
#pragma unroll
        for (int dt = 0; dt < 4; ++dt) { u32x2 w; w.x = pk2(o[dt][0] * inv, o[dt][1] * inv); w.y = pk2(o[dt][2] * inv, o[dt][3] * inv); *(u32x2*)(MIX + tq * 1024 + head * 64 + 16 * dt + 4 * fq) = w; }
    }
}

constexpr size_t WSM_RT = 640 * 1024;
constexpr size_t CTL_WGCNT = 256 * 1024;
__device__ __forceinline__ void split8(const f32x4 a, const f32x4 b, bf16x8_t& hi, bf16x8_t& lo) {
    const float x[8] = {a.x, a.y, a.z, a.w, b.x, b.y, b.z, b.w}; float h[8], l[8];
#pragma unroll
    for (int i = 0; i < 8; ++i) { h[i] = bf2f(f2bf(x[i])); l[i] = x[i] - h[i]; }
    hi = pack8(h); lo = pack8(l);
}
__device__ __forceinline__ void moe_route(const Ctx& c, const Params& p, int layer) {
    const int lane = c.lane, wv = c.wave, fr = lane & 15, fq = lane >> 4;
    LAS float* LG = (LAS float*)c.shm + wv * (16 * 48 + 16);
    LAS float* RS = LG + 16 * 48;
    LAS int* hist = (LAS int*)(c.shm + 32 * 1024);
    if (c.tid < 32) hist[c.tid] = 0;
    __syncthreads();
    const int t0 = blockIdx.x * 128 + wv * 16;
    const bf16_t* xr = (const bf16_t*)(p.ws + OFF_H) + (size_t)(t0 + fr) * 1024 + 8 * fq;
    const bf16_t* TH = (const bf16_t*)(p.ws + OFF_WSMALL + WSM_RT) + (size_t)layer * 2 * 48 * 1024; const bf16_t* TL = TH + 48 * 1024;
    f32x4 acc[3];
#pragma unroll
    for (int i = 0; i < 3; ++i) acc[i] = (f32x4){0.f, 0.f, 0.f, 0.f};
    float ss = 0.f;
#pragma unroll 4
    for (int kk = 0; kk < 32; ++kk) {
        const u32x4 xw = *(const u32x4*)(xr + 32 * kk); const bf16x8_t xh = __builtin_bit_cast(bf16x8_t, xw);
        { const float x0 = bflo(xw.x), x1 = bfhi(xw.x), x2 = bflo(xw.y), x3 = bfhi(xw.y), x4 = bflo(xw.z), x5 = bfhi(xw.z), x6 = bflo(xw.w), x7 = bfhi(xw.w);
          ss += (x0 * x0 + x1 * x1) + (x2 * x2 + x3 * x3) + (x4 * x4 + x5 * x5) + (x6 * x6 + x7 * x7); }
#pragma unroll
        for (int ct = 0; ct < 3; ++ct) { const bf16x8_t wh = *(const bf16x8_t*)(TH + (size_t)(16 * ct + fr) * 1024 + 32 * kk + 8 * fq), wl = *(const bf16x8_t*)(TL + (size_t)(16 * ct + fr) * 1024 + 32 * kk + 8 * fq);
            acc[ct] = __builtin_amdgcn_mfma_f32_16x16x32_bf16(xh, wh, acc[ct], 0, 0, 0); acc[ct] = __builtin_amdgcn_mfma_f32_16x16x32_bf16(xh, wl, acc[ct], 0, 0, 0); }
    }
    ss += __shfl_xor(ss, 16); ss += __shfl_xor(ss, 32);
    const float rstd = 1.0f / sqrtf(ss * (1.0f / 1024.0f) + 1e-6f);
    if (fq == 0) RS[fr] = rstd;
    LDS_WAIT();
#pragma unroll
    for (int ct = 0; ct < 3; ++ct)
#pragma unroll
        for (int r = 0; r < 4; ++r) LG[(4 * fq + r) * 48 + 16 * ct + fr] = acc[ct][r] * RS[4 * fq + r];
    LDS_WAIT();
    if (lane < 16) { int e0, e1; float g0, g1; route_row(LG + lane * 48, p.moe_b_group + layer * 4, p.moe_b_expert + layer * 32, e0, e1, g0, g1);
        const int t = t0 + lane; ((float*)(p.ws + OFF_ROUTE + ROUTE_RS))[t] = RS[lane]; ((int2*)(p.ws + OFF_ROUTE))[t] = make_int2(e0, e1); ((float2*)(p.ws + OFF_ROUTE + 256 * 1024))[t] = make_float2(g0, g1);
        atomicAdd((int*)&hist[e0], 1); atomicAdd((int*)&hist[e1], 1); }
    __syncthreads();
    if (c.tid < 32) ((int*)(p.ws + OFF_CTL + CTL_WGCNT))[(layer * 256 + blockIdx.x) * 32 + c.tid] = hist[c.tid];
}
__device__ __forceinline__ void moe_slots2(const Ctx& c, const Params& p, int layer) {
    LAS int* part = (LAS int*)c.shm;
    LAS int* base = part + 1024;
    LAS int* lcnt = base + 32;
    LAS int* posl = lcnt + 32;
    LAS int* pst = posl + 256;
    const int* wc = (const int*)(p.ws + OFF_CTL + CTL_WGCNT) + layer * 256 * 32; const int bid = blockIdx.x;
    __syncthreads();
    { const int e = c.tid & 31, pt = c.tid >> 5; int sa = 0, sb = 0;
      for (int w = pt * 16; w < pt * 16 + 16; ++w) { const int v = wc[w * 32 + e]; sa += v; sb += (w < bid) ? v : 0; }
      part[pt * 32 + e] = sa; part[512 + pt * 32 + e] = sb; }
    if (c.tid < 32) lcnt[c.tid] = 0;
    __syncthreads();
    if (c.tid < 32) { int sa = 0, sb = 0; for (int q = 0; q < 16; ++q) { sa += part[q * 32 + c.tid]; sb += part[512 + q * 32 + c.tid]; } part[c.tid] = sa; part[512 + c.tid] = sb; }
    __syncthreads();
    if (c.tid == 0) { int acc = 0; for (int e = 0; e < NEXP; ++e) { pst[e] = acc; acc += (part[e] + 255) / 256 * 256; } pst[32] = acc; }
    __syncthreads();
    if (c.tid < 32) base[c.tid] = pst[c.tid] + part[512 + c.tid];
    if (bid == 0 && c.tid < NEXP) { int* blk = (int*)(p.ws + OFF_CTL + CTL_BLK) + layer * 1024; const int e = c.tid, s = pst[e] / 256, en = pst[e + 1] / 256; for (int i = s; i < en; ++i) blk[1 + i] = e; if (e == 0) blk[0] = pst[32] / 256; }
    __syncthreads();
    if (c.tid < 256) { const int t = bid * 128 + (c.tid >> 1); const int2 ee = ((const int2*)(p.ws + OFF_ROUTE))[t]; const int e = (c.tid & 1) ? ee.y : ee.x;
        const int rk = atomicAdd((int*)&lcnt[e], 1); posl[c.tid] = base[e] + rk; }
    __syncthreads();
    if (c.tid < 128) ((int2*)(p.ws + OFF_ROUTE + 512 * 1024))[bid * 128 + c.tid] = make_int2(posl[2 * c.tid], posl[2 * c.tid + 1]);
    if (c.tid < 256) ((float*)(p.ws + OFF_R + R_RSS))[posl[c.tid]] = ((const float*)(p.ws + OFF_ROUTE + ROUTE_RS))[bid * 128 + (c.tid >> 1)];
    int* TOK = (int*)(p.ws + OFF_R + R_TOK);
    if (c.tid < 256) TOK[posl[c.tid]] = bid * 128 + (c.tid >> 1);
    if (bid == 0) { for (int e = 0; e < NEXP; ++e) { const int s = pst[e] + part[e], en = pst[e + 1]; for (int i = s + c.tid; i < en; i += 512) TOK[i] = 0; } }
}

constexpr size_t WSM_TGD = 128 * 1024, WSM_GUT = 192 * 1024;
__device__ __forceinline__ void combine_gk(const Ctx& c, const Params& p) {
    const int lane = c.lane, wv = c.wave, fr = lane & 15, fq = lane >> 4;
    LAS float* LG = (LAS float*)c.shm + wv * (16 * 16 + 16);
    LAS float* RS = LG + 256;
    const int t0 = blockIdx.x * 128 + wv * 16; const int trow = t0 + fr;
    bf16_t* hr = (bf16_t*)(p.ws + OFF_H) + (size_t)trow * 1024 + 8 * fq;
    const int2 ps = ((const int2*)(p.ws + OFF_ROUTE + 512 * 1024))[trow]; const float2 gt = ((const float2*)(p.ws + OFF_ROUTE + 256 * 1024))[trow];
    const bf16_t* y0 = (const bf16_t*)(p.ws + OFF_P) + (size_t)ps.x * 1024 + 8 * fq; const bf16_t* y1 = (const bf16_t*)(p.ws + OFF_P) + (size_t)ps.y * 1024 + 8 * fq;
    const bf16_t* TH = (const bf16_t*)(p.ws + OFF_WSMALL + WSM_TGD); const bf16_t* TL = TH + 16 * 1024;
    f32x4 acc = (f32x4){0.f, 0.f, 0.f, 0.f}; float ss = 0.f;
#pragma unroll 4
    for (int kk = 0; kk < 32; ++kk) {
        const u32x4 xw = *(const u32x4*)(hr + 32 * kk), u0 = *(const u32x4*)(y0 + 32 * kk), u1 = *(const u32x4*)(y1 + 32 * kk);
        f32x4 a, bq;
        a.x = bflo(xw.x) + gt.x * bflo(u0.x) + gt.y * bflo(u1.x); a.y = bfhi(xw.x) + gt.x * bfhi(u0.x) + gt.y * bfhi(u1.x); a.z = bflo(xw.y) + gt.x * bflo(u0.y) + gt.y * bflo(u1.y); a.w = bfhi(xw.y) + gt.x * bfhi(u0.y) + gt.y * bfhi(u1.y);
        bq.x = bflo(xw.z) + gt.x * bflo(u0.z) + gt.y * bflo(u1.z); bq.y = bfhi(xw.z) + gt.x * bfhi(u0.z) + gt.y * bfhi(u1.z); bq.z = bflo(xw.w) + gt.x * bflo(u0.w) + gt.y * bflo(u1.w); bq.w = bfhi(xw.w) + gt.x * bfhi(u0.w) + gt.y * bfhi(u1.w);
        { u32x4 w; w.x = pk2(a.x, a.y); w.y = pk2(a.z, a.w); w.z = pk2(bq.x, bq.y); w.w = pk2(bq.z, bq.w); *(u32x4*)(hr + 32 * kk) = w; }
        ss += (a.x * a.x + a.y * a.y) + (a.z * a.z + a.w * a.w) + (bq.x * bq.x + bq.y * bq.y) + (bq.z * bq.z + bq.w * bq.w);
        bf16x8_t xh, xl; split8(a, bq, xh, xl);
        const bf16x8_t wh = *(const bf16x8_t*)(TH + (size_t)fr * 1024 + 32 * kk + 8 * fq), wl = *(const bf16x8_t*)(TL + (size_t)fr * 1024 + 32 * kk + 8 * fq);
        acc = __builtin_amdgcn_mfma_f32_16x16x32_bf16(xh, wh, acc, 0, 0, 0); acc = __builtin_amdgcn_mfma_f32_16x16x32_bf16(xh, wl, acc, 0, 0, 0); acc = __builtin_amdgcn_mfma_f32_16x16x32_bf16(xl, wh, acc, 0, 0, 0);
    }
    ss += __shfl_xor(ss, 16); ss += __shfl_xor(ss, 32);
    const float rstd = 1.0f / sqrtf(ss * (1.0f / 1024.0f) + 1e-6f);
    if (fq == 0) { RS[fr] = rstd; ((float*)(p.ws + OFF_ROUTE + ROUTE_RS))[trow] = rstd; }
    LDS_WAIT();
#pragma unroll
    for (int r = 0; r < 4; ++r) LG[(4 * fq + r) * 16 + fr] = acc[r] * RS[4 * fq + r];
    LDS_WAIT();
    bf16x8_t gh = zero_frag(), gl = zero_frag();
    if (fq < 2) { const f32x4 a = *(const LAS f32x4*)(LG + fr * 16 + 8 * fq), bq = *(const LAS f32x4*)(LG + fr * 16 + 8 * fq + 4); split8(a, bq, gh, gl); }
    const bf16_t* UH = (const bf16_t*)(p.ws + OFF_WSMALL + WSM_GUT); const bf16_t* UL = UH + 512 * 16;
    float* gk = (float*)(p.ws + OFF_R + R_GK) + (size_t)trow * 512 + 4 * fq;
#pragma unroll 4
    for (int ct = 0; ct < 32; ++ct) {
        bf16x8_t uh = zero_frag(), ul = zero_frag();
        if (fq < 2) { uh = *(const bf16x8_t*)(UH + (16 * ct + fr) * 16 + 8 * fq); ul = *(const bf16x8_t*)(UL + (16 * ct + fr) * 16 + 8 * fq); }
        f32x4 g = *(const f32x4*)(p.od_gate_b + 16 * ct + 4 * fq);
        g = __builtin_amdgcn_mfma_f32_16x16x32_bf16(uh, gh, g, 0, 0, 0); g = __builtin_amdgcn_mfma_f32_16x16x32_bf16(uh, gl, g, 0, 0, 0); g = __builtin_amdgcn_mfma_f32_16x16x32_bf16(ul, gh, g, 0, 0, 0);
#pragma unroll
        for (int r = 0; r < 4; ++r) { const float xx = g[r]; g[r] = (fminf(xx, 0.f) - __logf(1.0f + __expf(-fabsf(xx)))) * (1.0f / 16.0f); }
        *(f32x4*)(gk + 16 * ct) = g;
    }
}

constexpr int LDS_BYTES = 160 * 1024 - 64;
constexpr int N_PHASES = 25;

typedef const __attribute__((address_space(4))) Params* KParamsPtr;
__device__ __forceinline__ Params kparams() {
#if defined(__HIP_DEVICE_COMPILE__)
    KParamsPtr k = (KParamsPtr)__builtin_amdgcn_kernarg_segment_ptr(); asm volatile("" : "+s"(k)); return *k;
#else
    return Params{};
#endif
}
__device__ __forceinline__ Ctx mkctx(unsigned char* shm) {
    int tz = threadIdx.x; asm volatile("" : "+v"(tz));
    Ctx c; c.tid = tz; c.wave = __builtin_amdgcn_readfirstlane(tz >> 6); c.lane = tz & 63; c.gw = blockIdx.x * 8 + c.wave; c.ngw = 2048; c.shm = shm; return c;
}
__global__ void __launch_bounds__(512, 2) hybrid_fwd(Params p_in) {
    extern __shared__ __attribute__((aligned(16))) unsigned char shm[];
    constexpr int G = 256; const int bid = blockIdx.x;
    uint4* xbw = (uint4*)(shm + LDS_BYTES - 16);
    if (threadIdx.x == 0) *xbw = make_uint4(0u, 0u, 0u, 0u);
    __syncthreads();
    XcdBarrier bar = xcd_barrier_post((unsigned*)(kparams().ws + OFF_CTL), (volatile LAS unsigned*)xbw);
#ifndef KEEPMASK
#define KEEPMASK 0xFFFFFFFFu
#endif
#define INS(k, s) (((KEEPMASK) >> (s)) & 1u)
#ifndef REPMASK
#define REPMASK 0u
#endif
#define REP(s) ((((REPMASK) >> (s)) & 1u) ? 3 : 1)
#define SEAM(k) do { XcdBarrier b2 = bar; b2.bar = (unsigned*)(kparams().ws + OFF_CTL); xcd_barrier(b2); } while (0)
#define PHASE_BEGIN const Params p = kparams(); const Ctx c = mkctx(shm); unsigned char* const ws = p.ws; (void)c; (void)ws;
#define glds ((PG8_LAS unsigned char*)shm)
#define WD ((bf16_t*)(ws + OFF_WD))
#define H ((bf16_t*)(ws + OFF_H))
#define P ((bf16_t*)(ws + OFF_P))
#define WS_F ((float*)(ws + OFF_WSMALL))
#define RE ((int2*)(ws + OFF_ROUTE))
#define RG ((float2*)(ws + OFF_ROUTE + 256 * 1024))
#define RP ((int2*)(ws + OFF_ROUTE + 512 * 1024))

    for (int layer = 0; layer < 2; ++layer) {
        const int pb = layer * 12;
        if (layer == 0) {
            if (INS(0, 0)) for (int rep_ = 0; rep_ < REP(0); ++rep_) { PHASE_BEGIN
                tr_matrix(c, p.ev_w_in, EV_IN, 0, 1024, EV_IN, WD + WE_EV_IN, 0, 0);
                tr_matrix(c, p.ev_w_out, 1024, 0, 1024, 1024, WD + WE_EV_OUT, 0, 0);
                tr_matrix(c, p.od_w_in, OD_IN_SRC, 0, 1024, OD_IN, WD + WE_OD_IN, 0, 1, p.norm_mix + 1024);
                tr_matrix(c, p.od_w_out, 1024, 0, 1024, 1024, WD + WE_OD_OUT, 0, 0);
                tr_matrix(c, p.mem_wk, 512, 0, 1024, 512, WD + WE_MKV, 0, 0);
                tr_matrix(c, p.mem_wv, 512, 0, 1024, 512, WD + WE_MKV, 512, 0);
                for (int l = 0; l < 2; ++l) {
                    tr_matrix(c, p.xa_wq + (size_t)l * 1024 * 512, 512, 0, 1024, 512, WD + WE_WQ + (size_t)l * 512 * 1024, 0, 0, p.norm_xattn + l * 1024);
                    tr_matrix(c, p.xa_wo + (size_t)l * 512 * 1024, 1024, 0, 512, 1024, WD + WE_WO + (size_t)l * 1024 * 512, 0, 0);
                }
                for (int i = bid * 512 + c.tid; i < 16 * 1024 + 512 * 16; i += G * 512) {
                    if (i < 16 * 1024) { const int o = i >> 10, k = i & 1023; const float w = p.od_w_in[(size_t)k * OD_IN_SRC + 2048 + o] * p.norm_mix[1024 + k]; const unsigned hb = f2bf(w);
                        bf16_t* T = (bf16_t*)(ws + OFF_WSMALL + WSM_TGD); T[i] = (bf16_t)hb; T[16 * 1024 + i] = (bf16_t)f2bf(w - bf2f(hb)); }
                    else { const int r = i - 16 * 1024, ch = r >> 4, o = r & 15; const float w = p.od_gate_up[o * 512 + ch]; const unsigned hb = f2bf(w);
                        bf16_t* T = (bf16_t*)(ws + OFF_WSMALL + WSM_GUT); T[r] = (bf16_t)hb; T[512 * 16 + r] = (bf16_t)f2bf(w - bf2f(hb)); } }
                for (int i = bid * 512 + c.tid; i < 2 * 48 * 1024; i += G * 512) { const int l = i / (48 * 1024), r = i % (48 * 1024), o = r >> 10, k = r & 1023;
                    float w = 0.f; if (o < 4) w = p.moe_w_group[((size_t)l * 1024 + k) * 4 + o]; else if (o < 36) w = p.moe_w_expert[((size_t)l * 1024 + k) * 32 + (o - 4)];
                    w *= p.norm_moe[l * 1024 + k]; const unsigned hb = f2bf(w); bf16_t* T = (bf16_t*)(ws + OFF_WSMALL + WSM_RT) + (size_t)l * 2 * 48 * 1024;
                    T[r] = (bf16_t)hb; T[48 * 1024 + r] = (bf16_t)f2bf(w - bf2f(hb)); }
                for (int i = bid * 512 + c.tid; i < 2 * 512 * 64; i += G * 512) { const int wh = i >> 15, r = i & 32767, ch = r >> 6, k = r & 63;
                    ((bf16_t*)(ws + OFF_WSMALL + (wh ? WSM_A2T : WSM_W2T)))[r] = (bf16_t)f2bf((wh ? p.ev_a2 : p.ev_w2)[(size_t)k * 512 + ch]); }
                norm_plain(c, p.mem, p.mem_norm, (bf16_t*)(ws + OFF_R + R_MEMN), NB * MEMLEN);
                for (int i = bid * 512 + c.tid; i < 512 * 128; i += G * 512) { const int ch = i >> 7, m = i & 127; ((bf16_t*)(ws + OFF_WSMALL + WSM_G2T))[i] = (bf16_t)f2bf(p.ev_g2[(size_t)m * 512 + ch]); }
                norm_plain(c, p.x, p.norm_mix, H, T_TOK);
                __syncthreads();
                SEAM(0);
            }
            if (INS(1, 1)) for (int rep_ = 0; rep_ < REP(1); ++rep_) { PHASE_BEGIN
                { pg8::Gemm g{H, WD + WE_EV_IN, T_TOK, EV_IN, 1024, 0}; pg8::StaticOrder S; S.init(T_TOK, EV_IN, G, bid);
                  pg8::EpiB16 E{P, EV_IN, nullptr}; pg8::gemm_phase<pg8::EpiB16, pg8::StaticOrder, true, true>(glds, g, S, E); }
                SEAM(1);
            }
            if (INS(2, 2)) for (int rep_ = 0; rep_ < REP(2); ++rep_) { PHASE_BEGIN
#ifdef RWKV_NAIVE
                if (bid < 64) rwkv_naive(c, p, bid);
                else
#else
                {
                    RxPre pre; const int bh0 = bid >> 2, b0 = bh0 >> 3, hd0 = bh0 & 7, ck0 = (bid & 3) * 16;
                    rwkv_x_fetch(pre, (const bf16_t*)(ws + OFF_P), b0, hd0, ck0, c.tid, c.lane, c.wave);
#pragma unroll 1
                    for (int i = 0; i < 16; ++i) rwkv_x(c, p, bid * 16 + i, pre, b0, hd0, i + 1 < 16 ? ck0 + i + 1 : -1);
                }
                __syncthreads();
                SEAM(2);
            }
            if (INS(2, 16)) for (int rep_ = 0; rep_ < REP(16); ++rep_) { PHASE_BEGIN
                if (bid < 64) { if (c.wave < 4) rwkv_y(c, p, bid, c.wave); }
                else
#endif
                {
                    for (int u = bid - 64; u < 512; u += G - 64) swa_mfma(c, p, u);
                    __syncthreads();
                    if (bid >= 96) tr_moe_layer(c, p, 0, 96 * 8, 160 * 8);
                    if (bid < 96) {
                        pg8::Gemm g{(const bf16_t*)(ws + OFF_R + R_MEMN), WD + WE_MKV, NB * MEMLEN, 1024, 1024, 0}; pg8::StaticOrder S; S.init(NB * MEMLEN, 1024, 32, bid - 64);
                        pg8::EpiB16 E{(bf16_t*)(ws + OFF_MKV), 1024, nullptr}; pg8::gemm_phase<pg8::EpiB16, pg8::StaticOrder, true, true>(glds, g, S, E); }
                }
#ifndef RWKV_NAIVE
                __syncthreads();
                SEAM(2);
            }
            if (INS(2, 17)) for (int rep_ = 0; rep_ < REP(17); ++rep_) { PHASE_BEGIN
                for (int u = c.gw; u < 4096; u += c.ngw) rwkv_z(c, p, u);
#endif
                __syncthreads();
                SEAM(2);
            }
        } else {
            if (INS(12, 12)) for (int rep_ = 0; rep_ < REP(12); ++rep_) { PHASE_BEGIN
                combine_gk(c, p);
                __syncthreads();
                SEAM(12);
            }
            if (INS(13, 13)) for (int rep_ = 0; rep_ < REP(13); ++rep_) { PHASE_BEGIN
                pg8::Gemm g{H, WD + WE_OD_IN, T_TOK, OD_IN, 1024, 0}; pg8::StaticOrder S; S.init(T_TOK, OD_IN, G, bid);
                pg8::EpiB16 E{P, OD_IN, (const float*)(ws + OFF_ROUTE + ROUTE_RS)};   pg8::gemm_phase<pg8::EpiB16, pg8::StaticOrder, true, true>(glds, g, S, E);
                SEAM(13);
            }
            if (INS(14, 14)) for (int rep_ = 0; rep_ < REP(14); ++rep_) { PHASE_BEGIN
#ifdef GLA_NAIVE
                if (bid < 32) gla_naive(c, p, bid);
                __syncthreads();
                SEAM(14);
#else
                for (int u = bid; u < 2048; u += G) gla_prep(c, p, u);
                __syncthreads();
                SEAM(14);
#endif
            }
#ifndef GLA_NAIVE
            if (INS(14, 18)) for (int rep_ = 0; rep_ < REP(18); ++rep_) { PHASE_BEGIN
                if (bid < 128) gla_state(c, p, bid >> 2, bid & 3);
                else tr_moe_layer(c, p, 1, 128 * 8, 128 * 8);
                __syncthreads();
                SEAM(14);
            }
            if (INS(14, 19)) for (int rep_ = 0; rep_ < REP(19); ++rep_) { PHASE_BEGIN
                gla_finish(c, p);
                __syncthreads();
                SEAM(14);
            }
#endif
        }
        if (INS(pb + 3, 3)) for (int rep_ = 0; rep_ < REP(3); ++rep_) { PHASE_BEGIN
            pg8::Gemm g{(const bf16_t*)p.out, WD + (layer == 0 ? WE_EV_OUT : WE_OD_OUT), T_TOK, 1024, 1024, 0}; pg8::StaticOrder S; S.init(T_TOK, 1024, G, bid);
            pg8::EpiRes E{layer == 0 ? p.x : nullptr, H, 1024, (float*)(ws + OFF_R + R_SSP)};     pg8::gemm_phase<pg8::EpiRes, pg8::StaticOrder, true, true>(glds, g, S, E);
            SEAM(pb + 3);
        }
        if (INS(pb + 5, 5)) for (int rep_ = 0; rep_ < REP(5); ++rep_) { PHASE_BEGIN
            pg8::Gemm g{H, WD + WE_WQ + (size_t)layer * 512 * 1024, T_TOK, 512, 1024, 0}; pg8::StaticOrder S; S.init(T_TOK, 512, G, bid);
            pg8::EpiB16 E{P, 512, nullptr}; pg8::gemm_phase<pg8::EpiB16, pg8::StaticOrder, true, true>(glds, g, S, E);
            SEAM(pb + 5);
        }
        if (INS(pb + 6, 6)) for (int rep_ = 0; rep_ < REP(6); ++rep_) { PHASE_BEGIN for (int u = bid; u < 256; u += G) xattn_mfma(c, p, u); __syncthreads(); SEAM(pb + 6); }
        if (INS(pb + 7, 7)) for (int rep_ = 0; rep_ < REP(7); ++rep_) { PHASE_BEGIN
            pg8::Gemm g{(const bf16_t*)(ws + OFF_P + 32 * MiB), WD + WE_WO + (size_t)layer * 1024 * 512, T_TOK, 1024, 512, 0}; pg8::StaticOrder S; S.init(T_TOK, 1024, G, bid);
            pg8::EpiRes E{nullptr, H, 1024, nullptr}; pg8::gemm_phase<pg8::EpiRes, pg8::StaticOrder, true, true>(glds, g, S, E);
            SEAM(pb + 7);
        }
        if (INS(pb + 8, 8)) for (int rep_ = 0; rep_ < REP(8); ++rep_) { PHASE_BEGIN
            moe_route(c, p, layer);
            __syncthreads();
            SEAM(pb + 8);
        }
        if (INS(pb + 9, 9)) for (int rep_ = 0; rep_ < REP(9); ++rep_) { PHASE_BEGIN moe_slots2(c, p, layer); __syncthreads(); SEAM(pb + 9); }
        if (INS(pb + 10, 10)) for (int rep_ = 0; rep_ < REP(10); ++rep_) { PHASE_BEGIN
            const int* blk = (const int*)(ws + OFF_CTL + CTL_BLK) + layer * 1024; const int nblk = blk[0];
            pg8::Gemm g{H, (const bf16_t*)(ws + OFF_WMOE), nblk * 256, 1024, 1024, (size_t)1024 * 1024 * 2}; pg8::MoeOrder S{blk + 1, nblk * 4, 4, G, bid, (const int*)(ws + OFF_R + R_TOK)};
            pg8::EpiSwiglu E{(bf16_t*)(ws + OFF_R), 512, (const float*)(ws + OFF_R + R_RSS)}; pg8::gemm_phase<pg8::EpiSwiglu, pg8::MoeOrder, true, true>(glds, g, S, E);
            SEAM(pb + 10);
        }
        if (INS(pb + 11, 11)) for (int rep_ = 0; rep_ < REP(11); ++rep_) { PHASE_BEGIN
            const int* blk = (const int*)(ws + OFF_CTL + CTL_BLK) + layer * 1024; const int nblk = blk[0];
            pg8::Gemm g{(const bf16_t*)(ws + OFF_R), (const bf16_t*)(ws + OFF_WMOE + 64 * MiB), nblk * 256, 1024, 512, (size_t)1024 * 512 * 2}; pg8::MoeOrder S{blk + 1, nblk * 4, 4, G, bid, nullptr};
            pg8::EpiB16 E{P, 1024, nullptr}; pg8::gemm_phase<pg8::EpiB16, pg8::MoeOrder, true, true>(glds, g, S, E);
            SEAM(pb + 11);
        }
    }
    if (INS(24, 15)) for (int rep_ = 0; rep_ < REP(15); ++rep_) { PHASE_BEGIN
        for (int r0 = c.gw; r0 < T_TOK; r0 += 4 * c.ngw) {
            f32x4 v[4][4]; int2 ps[4]; float2 gt[4];
#pragma unroll
            for (int q = 0; q < 4; ++q) { const int r = r0 + q * c.ngw; ps[q] = RP[r]; gt[q] = RG[r];
#pragma unroll
                for (int j = 0; j < 4; ++j) { const u32x2 w = *((const u32x2*)(H + (size_t)r * 1024) + c.lane + 64 * j); v[q][j] = (f32x4){bflo(w.x), bfhi(w.x), bflo(w.y), bfhi(w.y)}; } }
#pragma unroll
            for (int q = 0; q < 4; ++q) row_combine(v[q], P, ps[q].x, ps[q].y, gt[q].x, gt[q].y, c.lane);
#pragma unroll
            for (int q = 0; q < 4; ++q) { const int r = r0 + q * c.ngw; const float rs = row_rstd(v[q]); row_scale(v[q], rs, p.norm_final, c.lane); row_store_f32(p.out + (size_t)r * 1024, c.lane, v[q]); }
        }
    }
}

extern "C" void kernel_launch(void* const* d_in, const int* in_sizes, int n_in, void* d_out, int out_size, void* d_ws, size_t ws_size, hipStream_t stream) {
    static int ready = 0;
    if (ready == 0) {
        if (n_in != 37 || out_size != T_TOK * DM || ws_size < WS_NEED) { fprintf(stderr, "kernel_launch: unexpected problem (n_in %d, out %d, ws %zu)\n", n_in, out_size, ws_size); ready = -1; return; }
        if (hipFuncSetAttribute((const void*)hybrid_fwd, hipFuncAttributeMaxDynamicSharedMemorySize, LDS_BYTES) != hipSuccess) { fprintf(stderr, "kernel_launch: hipFuncSetAttribute failed\n"); ready = -1; return; }
        ready = 1;
    }
    if (ready < 0) return;
    hipMemsetAsync((char*)d_ws + OFF_CTL, 0, CTL_ZERO_BYTES, stream);
    Params p{};
    const float** f = (const float**)&p;
    for (int i = 0; i < 37; ++i) f[i] = (const float*)d_in[i];
    p.out = (float*)d_out; p.ws = (unsigned char*)d_ws; p.ph_lo = 0; p.ph_hi = N_PHASES;
    hipLaunchKernelGGL(hybrid_fwd, dim3(256), dim3(512), LDS_BYTES, stream, p);
}
```

```cpp
#include <hip/hip_runtime.h>
#include <cstdint>
#include <cstdio>

#define LAS __attribute__((address_space(3)))
typedef unsigned short bf16_t;
typedef float f32x4 __attribute__((ext_vector_type(4)));
typedef float f32x2 __attribute__((ext_vector_type(2)));
typedef unsigned u32x4 __attribute__((ext_vector_type(4)));
typedef unsigned u32x2 __attribute__((ext_vector_type(2)));

constexpr int T_TOK = 32768, DM = 1024, SEQ = 4096, NB = 8, MEMLEN = 256;
constexpr int EV_IN = 2560, OD_IN = 3072  , OD_IN_SRC = 3088;
constexpr int NEXP = 32, MOE_FF = 512, PMAX = 65536 + NEXP * 256;

constexpr size_t MiB = 1024 * 1024;
constexpr size_t OFF_CTL = 0;
constexpr size_t CTL_ZERO_BYTES = 64 * 1024;
constexpr size_t CTL_CNT = 16384;
constexpr size_t CTL_CUR = 16384 + 1024;
constexpr size_t CTL_BLK = 128 * 1024;
constexpr size_t OFF_ROUTE = 1 * MiB;
constexpr size_t OFF_WSMALL = 2 * MiB;
constexpr size_t OFF_MKV = 3 * MiB;
constexpr size_t OFF_WD = 7 * MiB;
constexpr size_t OFF_WMOE = 28 * MiB;
constexpr size_t OFF_H = 124 * MiB;
constexpr size_t OFF_P = 188 * MiB;
constexpr size_t OFF_R = 380 * MiB;
constexpr size_t WS_NEED = 552 * MiB;
constexpr size_t WE_EV_IN = 0, WE_EV_OUT = 2560ull * 1024, WE_OD_IN = 3584ull * 1024, WE_OD_OUT = 6656ull * 1024, WE_MKV = 7680ull * 1024, WE_WQ = 8704ull * 1024, WE_WO = 9728ull * 1024;

constexpr size_t ROUTE_RS = 768 * 1024;
constexpr size_t R_TOK = 81 * MiB;
constexpr size_t R_SSP = 0, R_RSS = 80 * MiB;
constexpr size_t P_XB1 = 64 * MiB;
struct Params {
    const float *x, *mem, *norm_mix, *norm_xattn, *norm_moe, *norm_final;
    const float *ev_w_in, *ev_sinks, *ev_mu, *ev_w0, *ev_w2, *ev_a0, *ev_a2, *ev_g2, *ev_k_k, *ev_k_a, *ev_r_k, *ev_lnx_w, *ev_lnx_b, *ev_w_out;
    const float *od_w_in, *od_gate_up, *od_gate_b, *od_onorm, *od_w_out;
    const float *mem_norm, *mem_wk, *mem_wv, *xa_wq, *xa_wo;
    const float *moe_w_group, *moe_b_group, *moe_w_expert, *moe_b_expert, *moe_w1, *moe_w3, *moe_w2;
    float* out; unsigned char* ws; int ph_lo, ph_hi;
};

#define XB_TMO      128
#define XB_XCNT(j)  (256  + 64 * (j))
#define XB_XSUB(j)  (1280 + 64 * (j))
#define XB_XGEN(j)  (2304 + 64 * (j))
#define XB_TOP      3328
#define XB_TOPGEN   3392
#define XCD_BAR_WORDS 3456
#define XB_SPIN_CAP (1u << 18)
#define LAS __attribute__((address_space(3)))

__device__ __forceinline__ unsigned xb_ld(unsigned* p)              { return __hip_atomic_load(p, __ATOMIC_RELAXED, __HIP_MEMORY_SCOPE_AGENT); }
__device__ __forceinline__ unsigned xb_add(unsigned* p, unsigned v) { return __hip_atomic_fetch_add(p, v, __ATOMIC_RELAXED, __HIP_MEMORY_SCOPE_AGENT); }
__device__ __forceinline__ unsigned xb_xcc_id() { return (unsigned)__builtin_amdgcn_s_getreg((3 << 11) | 20) & 0xFu; }
#define XB_SPIN(cond, bar) do { unsigned _sp = 0; while (cond) { __builtin_amdgcn_s_sleep(1); \
    if ((++_sp & 255u) == 0u) { if (xb_ld(&(bar)[XB_TMO])) break; if (_sp > XB_SPIN_CAP) { atomicAdd(&(bar)[XB_TMO], 1u); break; } } } } while (0)

struct XcdBarrier {
    unsigned* bar; unsigned x;
    volatile LAS unsigned* st;
};

__device__ __forceinline__ XcdBarrier xcd_barrier_post(unsigned* bar, volatile LAS unsigned* st) {
    XcdBarrier b; b.bar = bar; b.x = xb_xcc_id(); b.st = st;
    if (threadIdx.x == 0) (void)xb_add(&bar[XB_XCNT(b.x)], 1u);
    return b;
}
__device__ __forceinline__ void xcd_barrier_complete(unsigned* bar, unsigned x, unsigned& nloc, unsigned& nx) {
    const unsigned G = gridDim.x * gridDim.y * gridDim.z;
    unsigned sum, cnt, mine, sp = 0u;
    for (;;) {
        sum = 0u; cnt = 0u; mine = 0u;
#pragma unroll
        for (unsigned j = 0; j < 16; ++j) { const unsigned c = xb_ld(&bar[XB_XCNT(j)]); sum += c; cnt += (c > 0u) ? 1u : 0u; mine = (j == x) ? c : mine; }
        if (sum == G) break;
        __builtin_amdgcn_s_sleep(1);
        if ((++sp & 255u) == 0u) { if (xb_ld(&bar[XB_TMO])) break; if (sp > XB_SPIN_CAP) { atomicAdd(&bar[XB_TMO], 1u); break; } }
    }
    nloc = mine > 0u ? mine : 1u; nx = cnt > 0u ? cnt : 1u;
}

__device__ __forceinline__ void xcd_barrier(const XcdBarrier& b) {
    asm volatile("s_waitcnt vmcnt(0)" ::: "memory");
    __syncthreads();
    if (threadIdx.x == 0) {
        unsigned* bar = b.bar;
        __builtin_amdgcn_s_waitcnt(0);
        unsigned nloc = b.st[0], nx = b.st[1];
        if (nloc == 0u) { xcd_barrier_complete(bar, b.x, nloc, nx); b.st[0] = nloc; b.st[1] = nx; }
        const unsigned old = xb_add(&bar[XB_XSUB(b.x)], 1u);
        const unsigned gen = old / nloc;
        if (old + 1u == (gen + 1u) * nloc) {
            __builtin_amdgcn_fence(__ATOMIC_RELEASE, "agent");
            asm volatile("s_waitcnt vmcnt(0)" ::: "memory");
            const unsigned og = xb_add(&bar[XB_TOP], 1u);
            const unsigned tg = og / nx;
            if (og + 1u == (tg + 1u) * nx) xb_add(&bar[XB_TOPGEN], 1u);
            else XB_SPIN(xb_ld(&bar[XB_TOPGEN]) == tg, bar);
            __builtin_amdgcn_fence(__ATOMIC_ACQUIRE, "agent");
            xb_add(&bar[XB_XGEN(b.x)], 1u);
            asm volatile("s_waitcnt vmcnt(0)" ::: "memory");
        } else {
            XB_SPIN(xb_ld(&bar[XB_XGEN(b.x)]) == gen, bar);
            __builtin_amdgcn_fence(__ATOMIC_ACQUIRE, "agent");
            asm volatile("s_waitcnt vmcnt(0)" ::: "memory");
        }
    }
    __syncthreads();
}
namespace pg8 {
#define PG8_LAS __attribute__((address_space(3)))
typedef unsigned short bf16_t;
typedef short bf16x8 __attribute__((ext_vector_type(8)));
typedef float f32x4 __attribute__((ext_vector_type(4)));
typedef unsigned u32x4 __attribute__((ext_vector_type(4)));
constexpr int BM = 256, BK = 64, HALF = 128, HTB = HALF * BK * 2  , STAGE_BYTES = 8 * HTB, NXCD = 8, WGM = 8;

__host__ __device__ __forceinline__ int lds_byte(int r, int c) { const int st = (r >> 4) * 2 + (c >> 5), rr = r & 15, cc = c & 31, ob = rr * 64 + cc * 2; return st * 1024 + (ob ^ (((ob >> 9) & 1) << 5)); }
__host__ __device__ __forceinline__ void stage_rc(int b, int& R, int& C) { const int st = b / 1024, sb = b % 1024, swz = sb ^ (((sb >> 9) & 1) << 5); R = (st >> 1) * 16 + swz / 64; C = (st & 1) * 32 + (swz % 64) / 2; }
__host__ __device__ __forceinline__ int perm32(int rho) { const int n = rho >> 4, i = rho & 15; return 8 * (i >> 2) + 4 * n + (i & 3); }

struct Unit { int pm, pn, e; };
struct Gemm { const bf16_t* A; const bf16_t* Bt; int M, N, K; size_t bexp; };

struct StaticOrder {
    int nM, nN, nwg, G, c;
    __host__ __device__ void init(int M, int N, int G_, int c_) { nM = M / BM; nN = N / BM; nwg = nM * nN; G = G_; c = c_; }
    __host__ __device__ bool next(int i, Unit& u) const {
        const long L = (long)i * G + c; if (L >= nwg) return false;
        int wgid = (int)L; { const int q = nwg / NXCD, r = nwg % NXCD, xcd = wgid % NXCD, off = wgid / NXCD; wgid = (xcd < r ? xcd * (q + 1) : r * (q + 1) + (xcd - r) * q) + off; }
        const int nig = WGM * nN, gid = wgid / nig, fm = gid * WGM, gsz = (nM - fm) < WGM ? (nM - fm) : WGM;
        u.pm = fm + ((wgid % nig) % gsz); u.pn = (wgid % nig) / gsz; u.e = 0; return true;
    }
    __device__ __forceinline__ int arow(const Unit& u, int r) const { return u.pm * BM + r; }
    __device__ __forceinline__ void a_ready(const Unit&) const {}
    __device__ __forceinline__ void done(const Unit&) const {}
};
typedef __bf16 bf16x2_c __attribute__((ext_vector_type(2))); typedef float f32x2_c __attribute__((ext_vector_type(2)));
__device__ __forceinline__ unsigned cvt_pk_bf16(float lo, float hi) { const f32x2_c v = {lo, hi}; return __builtin_bit_cast(unsigned, __builtin_convertvector(v, bf16x2_c)); }

struct EpiB16 {
    static constexpr bool PERM = true, AFTER_DRAIN = false;
    bf16_t* O; int ldc; const float* rs;
    __device__ __forceinline__ void operator()(const f32x4 (&acc)[2][2][4][2], const Unit& u, int wr, int wc, int fr, int fq) const {
        const int row0 = u.pm * BM + wr * 64 + fr, col0 = u.pn * BM + wc * 32 + 8 * fq;
#pragma unroll
        for (int ai = 0; ai < 2; ++ai)
#pragma unroll
            for (int m = 0; m < 4; ++m) { bf16_t* rowp = O + (size_t)(row0 + ai * HALF + m * 16) * ldc + col0; const float r1 = rs ? rs[row0 + ai * HALF + m * 16] : 1.0f;
#pragma unroll
                for (int bj = 0; bj < 2; ++bj) { const f32x4 v0 = acc[ai][bj][m][0] * r1, v1 = acc[ai][bj][m][1] * r1;
                    u32x4 w; w.x = cvt_pk_bf16(v0[0], v0[1]); w.y = cvt_pk_bf16(v0[2], v0[3]); w.z = cvt_pk_bf16(v1[0], v1[1]); w.w = cvt_pk_bf16(v1[2], v1[3]);
                    *(u32x4*)(rowp + bj * HALF) = w; } }
    }
};
struct EpiRes {
    static constexpr bool PERM = false, AFTER_DRAIN = false;
    const float* base32; bf16_t* X; int ldc; float* ssp;
    __device__ __forceinline__ void operator()(const f32x4 (&acc)[2][2][4][2], const Unit& u, int wr, int wc, int fr, int fq) const {
        const int row0 = u.pm * BM + wr * 64 + fr, col0 = u.pn * BM + wc * 32 + 4 * fq;
        typedef unsigned u32x2v __attribute__((ext_vector_type(2)));
#pragma unroll
        for (int ai = 0; ai < 2; ++ai) {
            f32x4 bs[4][2][2];
            if (base32) {
#pragma unroll
                for (int m = 0; m < 4; ++m) { const size_t off = (size_t)(row0 + ai * HALF + m * 16) * ldc + col0;
#pragma unroll
                    for (int bj = 0; bj < 2; ++bj)
#pragma unroll
                        for (int n = 0; n < 2; ++n) bs[m][bj][n] = *(const f32x4*)(base32 + off + bj * HALF + n * 16); }
            } else {
                u32x2v rb[4][2][2];
#pragma unroll
                for (int m = 0; m < 4; ++m) { const size_t off = (size_t)(row0 + ai * HALF + m * 16) * ldc + col0;
#pragma unroll
                    for (int bj = 0; bj < 2; ++bj)
#pragma unroll
                        for (int n = 0; n < 2; ++n) rb[m][bj][n] = *(const u32x2v*)(X + off + bj * HALF + n * 16); }
#pragma unroll
                for (int m = 0; m < 4; ++m)
#pragma unroll
                    for (int bj = 0; bj < 2; ++bj)
#pragma unroll
                        for (int n = 0; n < 2; ++n) { const u32x2v w = rb[m][bj][n]; bs[m][bj][n] = (f32x4){__uint_as_float(w.x << 16), __uint_as_float(w.x & 0xFFFF0000u), __uint_as_float(w.y << 16), __uint_as_float(w.y & 0xFFFF0000u)}; }
            }
#pragma unroll
            for (int m = 0; m < 4; ++m) { const int row = row0 + ai * HALF + m * 16; const size_t off = (size_t)row * ldc + col0; float ss = 0.f;
#pragma unroll
                for (int bj = 0; bj < 2; ++bj)
#pragma unroll
                    for (int n = 0; n < 2; ++n) { const f32x4 o = bs[m][bj][n] + acc[ai][bj][m][n];
                        u32x2v w; w.x = cvt_pk_bf16(o[0], o[1]); w.y = cvt_pk_bf16(o[2], o[3]); *(u32x2v*)(X + off + bj * HALF + n * 16) = w;
                        ss += (o[0] * o[0] + o[1] * o[1]) + (o[2] * o[2] + o[3] * o[3]); }
                if (ssp) { ss += __shfl_xor(ss, 16); ss += __shfl_xor(ss, 32); if (fq == 0) ssp[(size_t)row * 16 + 4 * u.pn + wc] = ss; } }
        }
    }
};
struct EpiSwiglu {
    static constexpr bool PERM = true, AFTER_DRAIN = false;
    bf16_t* O; int ldc; const float* rs;
    __device__ __forceinline__ void operator()(const f32x4 (&acc)[2][2][4][2], const Unit& u, int wr, int wc, int fr, int fq) const {
        const int row0 = u.pm * BM + wr * 64 + fr, col0 = (u.pn * BM + wc * 32 + 8 * fq) >> 1;
        typedef unsigned u32x2v __attribute__((ext_vector_type(2)));
#pragma unroll
        for (int ai = 0; ai < 2; ++ai)
#pragma unroll
            for (int m = 0; m < 4; ++m) { bf16_t* rowp = O + (size_t)(row0 + ai * HALF + m * 16) * ldc + col0; const float r1 = rs[row0 + ai * HALF + m * 16];
#pragma unroll
                for (int bj = 0; bj < 2; ++bj) { const f32x4 a = acc[ai][bj][m][0] * r1, b = acc[ai][bj][m][1] * r1; float h[4];
#pragma unroll
                    for (int i = 0; i < 4; ++i) h[i] = a[i] * __builtin_amdgcn_rcpf(1.0f + __expf(-a[i])) * b[i];
                    u32x2v w; w.x = cvt_pk_bf16(h[0], h[1]); w.y = cvt_pk_bf16(h[2], h[3]);
                    *(u32x2v*)(rowp + bj * (HALF / 2)) = w; } }
    }
};
struct MoeOrder {
    const int* blk_e; int nunits, nN, G, c; const int* tok;
    __device__ __forceinline__ bool next(int i, Unit& u) const {
        const long L = (long)i * G + c; if (L >= nunits) return false;
        u.pm = (int)(L / nN); u.pn = (int)(L % nN); u.e = blk_e[u.pm]; return true;
    }
    __device__ __forceinline__ int arow(const Unit& u, int r) const { return tok ? tok[u.pm * BM + r] : u.pm * BM + r; }
    __device__ __forceinline__ void a_ready(const Unit&) const {}
    __device__ __forceinline__ void done(const Unit&) const {}
};
template <class Epi, class Sched, bool ALIGN_EPI = false, bool SP2 = false>
__device__ __forceinline__ void gemm_phase(PG8_LAS unsigned char* lds, const Gemm g, const Sched& S, const Epi& E) {
    static_assert(SP2, "only the two-super-phase loop is kept in this file");
    int tid_ = threadIdx.x; asm volatile("" : "+v"(tid_));
    const int tid = tid_, wid = __builtin_amdgcn_readfirstlane(tid >> 6), lane = tid & 63, wr = wid >> 2, wc = wid & 3, fr = lane & 15, fq = lane >> 4;
    const int K = g.K, nt = K / BK;
    unsigned voffB[2]; int RA[2], CA[2];
#pragma unroll
    for (int i = 0; i < 2; ++i) { int R, C; stage_rc(tid * 16 + i * 8192, R, C); const int Rb = Epi::PERM ? ((R & ~31) + perm32(R & 31)) : R;
        RA[i] = R; CA[i] = C; voffB[i] = (unsigned)(Rb * K + C) * 2u; }
    const size_t kstep = (size_t)(BK * 2);
    const size_t hstep = (size_t)HALF * K * 2;
    const size_t tstep = 2 * hstep;
    const unsigned ldsw = (unsigned)wid * 1024u;
    const int aoff = lds_byte(wr * 64 + fr, fq * 8), boff = lds_byte(wc * 32 + fr, fq * 8);
#define PG8_SA(b, h) (((b) * 2 + (h)) * HTB)
#define PG8_SB(b, h) ((4 + (b) * 2 + (h)) * HTB)
#define PG8_STAGE(bufoff, gbase, voff) do { _Pragma("unroll") for (int _i = 0; _i < 2; ++_i) \
        __builtin_amdgcn_global_load_lds((const unsigned*)((const char*)(gbase) + (voff)[_i]), (PG8_LAS unsigned*)(lds + (bufoff) + ldsw + _i * 8192), 16, 0, 0); } while (0)
#define PG8_AOFF(vo, u) do { _Pragma("unroll") for (int _h = 0; _h < 2; ++_h) _Pragma("unroll") for (int _i = 0; _i < 2; ++_i) \
        vo[_h][_i] = (unsigned)(S.arow(u, _h * HALF + RA[_i]) * K + CA[_i]) * 2u; } while (0)
#define PG8_LDA(dst, b, h) do { _Pragma("unroll") for (int m = 0; m < 4; ++m) _Pragma("unroll") for (int k = 0; k < 2; ++k) dst[m][k] = *(const PG8_LAS bf16x8*)(lds + PG8_SA(b, h) + aoff + m * 2048 + k * 1024); } while (0)
#define PG8_LDB(dst, b, h) do { _Pragma("unroll") for (int n = 0; n < 2; ++n) _Pragma("unroll") for (int k = 0; k < 2; ++k) dst[n][k] = *(const PG8_LAS bf16x8*)(lds + PG8_SB(b, h) + boff + n * 2048 + k * 1024); } while (0)
#define PG8_MMA(ai, bj, At, Bt) do { __builtin_amdgcn_s_setprio(1); _Pragma("unroll") for (int m = 0; m < 4; ++m) _Pragma("unroll") for (int n = 0; n < 2; ++n) _Pragma("unroll") for (int k = 0; k < 2; ++k) \
        acc[ai][bj][m][n] = __builtin_amdgcn_mfma_f32_16x16x32_bf16(Bt[n][k], At[m][k], acc[ai][bj][m][n], 0, 0, 0); __builtin_amdgcn_s_setprio(0); } while (0)
#define PG8_WAIT_V(n) asm volatile("s_waitcnt vmcnt(" #n ")" ::: "memory")
#define PG8_WAIT_L(n) asm volatile("s_waitcnt lgkmcnt(" #n ")" ::: "memory")
#define PG8_BAR __builtin_amdgcn_s_barrier()
#define PG8_SCHED __builtin_amdgcn_sched_barrier(0)
    Unit cur, nxt; int ui = 0;
    if (!S.next(0, cur)) return;
    f32x4 acc[2][2][4][2];
#pragma unroll
    for (int a = 0; a < 2; ++a)
#pragma unroll
        for (int b = 0; b < 2; ++b)
#pragma unroll
            for (int m = 0; m < 4; ++m)
#pragma unroll
                for (int n = 0; n < 2; ++n) acc[a][b][m][n] = (f32x4){0.f, 0.f, 0.f, 0.f};
    bf16x8 At[4][2], B0[2][2], B1[2][2];
    const char* Ab = (const char*)g.A;
    const char* cB = (const char*)g.Bt + (size_t)cur.pn * tstep + (size_t)cur.e * g.bexp;
    unsigned curA[2][2], nxtA[2][2];
    S.a_ready(cur);
    PG8_AOFF(curA, cur);
    PG8_STAGE(PG8_SB(0, 0), cB, voffB); PG8_STAGE(PG8_SB(0, 1), cB + hstep, voffB); PG8_STAGE(PG8_SA(0, 0), Ab, curA[0]); PG8_STAGE(PG8_SA(0, 1), Ab, curA[1]);
    if (wr == 1) PG8_BAR;
    PG8_WAIT_V(2); PG8_BAR;
    PG8_STAGE(PG8_SB(1, 0), cB + kstep, voffB); PG8_STAGE(PG8_SA(1, 0), Ab + kstep, curA[0]); PG8_STAGE(PG8_SB(1, 1), cB + hstep + kstep, voffB);
    PG8_WAIT_V(6); PG8_BAR;
    for (;;) {
        const bool has_next = S.next(ui + 1, nxt);
        const char* nB = has_next ? (const char*)g.Bt + (size_t)nxt.pn * tstep + (size_t)nxt.e * g.bexp : cB;
        if (has_next) { PG8_AOFF(nxtA, nxt); }
        else {
#pragma unroll
            for (int h = 0; h < 2; ++h)
#pragma unroll
                for (int i = 0; i < 2; ++i) nxtA[h][i] = curA[h][i]; }
        for (int t = 0; t < nt; t += 2) {
            const bool last = (t == nt - 2);
            const char* a1 = Ab + (size_t)(t + 1) * kstep;
            const char* a2 = last ? Ab : Ab + (size_t)(t + 2) * kstep; const char* b2 = last ? nB : cB + (size_t)(t + 2) * kstep;
            const char* a3 = a2 + kstep; const char* b3 = b2 + kstep;
            unsigned vo2[2][2];
#pragma unroll
            for (int h = 0; h < 2; ++h)
#pragma unroll
                for (int i = 0; i < 2; ++i) vo2[h][i] = last ? nxtA[h][i] : curA[h][i];
            if (last && has_next) S.a_ready(nxt);
            PG8_LDB(B0, 0, 0); PG8_LDB(B1, 0, 1); PG8_SCHED; PG8_LDA(At, 0, 0); PG8_STAGE(PG8_SA(1, 1), a1, curA[1]);
            PG8_WAIT_V(8); PG8_WAIT_L(0); PG8_BAR; PG8_MMA(0, 0, At, B0); PG8_MMA(0, 1, At, B1); PG8_BAR; PG8_SCHED;
            PG8_LDA(At, 0, 1); PG8_STAGE(PG8_SB(0, 0), b2, voffB); PG8_STAGE(PG8_SB(0, 1), b2 + hstep, voffB); PG8_STAGE(PG8_SA(0, 0), a2, vo2[0]);
            PG8_WAIT_V(8); PG8_WAIT_L(0); PG8_BAR; PG8_MMA(1, 0, At, B0); PG8_MMA(1, 1, At, B1); PG8_BAR; PG8_SCHED;
            PG8_LDB(B0, 1, 0); PG8_LDB(B1, 1, 1); PG8_SCHED; PG8_LDA(At, 1, 0); PG8_STAGE(PG8_SA(0, 1), a2, vo2[1]);
            PG8_WAIT_V(8); PG8_WAIT_L(0); PG8_BAR; PG8_MMA(0, 0, At, B0); PG8_MMA(0, 1, At, B1); PG8_BAR; PG8_SCHED;
            PG8_LDA(At, 1, 1); PG8_STAGE(PG8_SB(1, 0), b3, voffB); PG8_STAGE(PG8_SB(1, 1), b3 + hstep, voffB); PG8_STAGE(PG8_SA(1, 0), a3, vo2[0]);
            PG8_WAIT_V(8); PG8_WAIT_L(0); PG8_BAR; PG8_MMA(1, 0, At, B0); PG8_MMA(1, 1, At, B1); PG8_BAR; PG8_SCHED;
        }
        if constexpr (ALIGN_EPI) { if (wr == 0) PG8_BAR; }
        if constexpr (!Epi::AFTER_DRAIN) { E(acc, cur, wr, wc, fr, fq); S.done(cur); }
        if (!has_next) break;
#pragma unroll
        for (int a = 0; a < 2; ++a)
#pragma unroll
            for (int b = 0; b < 2; ++b)
#pragma unroll
                for (int m = 0; m < 4; ++m)
#pragma unroll
                    for (int n = 0; n < 2; ++n) acc[a][b][m][n] = (f32x4){0.f, 0.f, 0.f, 0.f};
        cur = nxt; cB = nB; ++ui;
#pragma unroll
        for (int h = 0; h < 2; ++h)
#pragma unroll
            for (int i = 0; i < 2; ++i) curA[h][i] = nxtA[h][i];
        if constexpr (ALIGN_EPI) { if (wr == 1) PG8_BAR; }
    }
    PG8_WAIT_V(0);
    if constexpr (!ALIGN_EPI) { if (wr == 0) PG8_BAR; }
    PG8_BAR;
    if constexpr (Epi::AFTER_DRAIN) { E.fused(acc, cur, wr, wc, fr, fq, lds, wid, lane); S.done(cur); }
#undef PG8_SA
#undef PG8_SB
#undef PG8_STAGE
#undef PG8_AOFF
#undef PG8_LDA
#undef PG8_LDB
#undef PG8_MMA
#undef PG8_WAIT_V
#undef PG8_WAIT_L
#undef PG8_BAR
#undef PG8_SCHED
}
}
__device__ __forceinline__ float bf2f(unsigned v) { return __uint_as_float(v << 16); }
__device__ __forceinline__ unsigned f2bf(float f) { unsigned u = __float_as_uint(f); u += 0x7FFFu + ((u >> 16) & 1u); return u >> 16; }
typedef __bf16 bf16x2_t __attribute__((ext_vector_type(2)));
__device__ __forceinline__ unsigned pk2(float lo, float hi) { const f32x2 v = {lo, hi}; return __builtin_bit_cast(unsigned, __builtin_convertvector(v, bf16x2_t)); }
__device__ __forceinline__ float bflo(unsigned w) { return __uint_as_float(w << 16); }
__device__ __forceinline__ float bfhi(unsigned w) { return __uint_as_float(w & 0xFFFF0000u); }
__device__ __forceinline__ float wave_sum(float v) {
#pragma unroll
    for (int o = 1; o < 64; o <<= 1) v += __shfl_xor(v, o);
    return v;
}
__device__ __forceinline__ float wave_max(float v) {
#pragma unroll
    for (int o = 1; o < 64; o <<= 1) v = fmaxf(v, __shfl_xor(v, o));
    return v;
}
__device__ __forceinline__ float sigmoidf_(float x) { return __builtin_amdgcn_rcpf(1.0f + __expf(-x)); }
__device__ __forceinline__ float tanhf_(float x) { return 1.0f - 2.0f * __builtin_amdgcn_rcpf(__expf(2.0f * x) + 1.0f); }
#define LDS_WAIT() asm volatile("s_waitcnt lgkmcnt(0)" ::: "memory")

struct Ctx { int tid, wave, lane, gw, ngw; unsigned char* shm; };

__device__ __forceinline__ int tr_src_col(int mode, int n, int scol0) { return mode == 1 ? (n < 2048 ? n : n + 16) : scol0 + n; }
__device__ __forceinline__ int tr_dst_row(int mode, int n, int drow0) { return mode == 2 ? 8 * (n >> 2) + (n & 3) : (mode == 3 ? 8 * (n >> 2) + 4 + (n & 3) : drow0 + n); }
struct TrD { const float* W; bf16_t* WT; const float* gain; int ldw, scol0, K, drow0, mode, item, nblk; };
__device__ __forceinline__ void tr_load(const TrD& d, int lane, f32x4 (&v)[8]) {
    const int kb = d.item / d.nblk, nb = d.item % d.nblk, k0 = 64 * kb, n0 = 32 * nb;
    const int n4 = 4 * (lane & 7), sc = tr_src_col(d.mode, n0 + n4, d.scol0);
#pragma unroll
    for (int i = 0; i < 8; ++i) v[i] = *(const f32x4*)(d.W + (size_t)(k0 + 8 * i + (lane >> 3)) * d.ldw + sc);
}
__device__ __forceinline__ void tr_finish(const TrD& d, int lane, f32x4 (&v)[8], LAS float* scr) {
    const int kb = d.item / d.nblk, nb = d.item % d.nblk, k0 = 64 * kb, n0 = 32 * nb, n4 = 4 * (lane & 7);
    if (d.gain) {
#pragma unroll
        for (int i = 0; i < 8; ++i) v[i] = v[i] * d.gain[k0 + 8 * i + (lane >> 3)]; }
#pragma unroll
    for (int i = 0; i < 8; ++i) { LAS float* q = scr + (8 * i + (lane >> 3)) * 33 + n4; q[0] = v[i].x; q[1] = v[i].y; q[2] = v[i].z; q[3] = v[i].w; }
    LDS_WAIT(); asm volatile("" ::: "memory");
    const int c = lane & 7;
#pragma unroll
    for (int j = 0; j < 4; ++j) { const int n = (lane >> 3) + 8 * j; const LAS float* s = scr + (8 * c) * 33 + n;
        u32x4 o; o.x = pk2(s[0 * 33], s[1 * 33]); o.y = pk2(s[2 * 33], s[3 * 33]); o.z = pk2(s[4 * 33], s[5 * 33]); o.w = pk2(s[6 * 33], s[7 * 33]);
        *(u32x4*)(d.WT + (size_t)tr_dst_row(d.mode, n0 + n, d.drow0) * d.K + k0 + 8 * c) = o; }
    LDS_WAIT(); asm volatile("" ::: "memory");
}
__device__ __forceinline__ void tr_pair(const TrD& d0, const TrD& d1, bool has1, int lane, LAS float* scr) {
    f32x4 va[8], vb[8];
    tr_load(d0, lane, va); if (has1) tr_load(d1, lane, vb);
    tr_finish(d0, lane, va, scr); if (has1) tr_finish(d1, lane, vb, scr + 64 * 33);
}
__device__ __forceinline__ void tr_matrix(const Ctx& c, const float* W, int ldw, int scol0, int K, int ncols, bf16_t* WT, int drow0, int mode, const float* gain = nullptr) {
    LAS float* scr = (LAS float*)(c.shm) + c.wave * (2 * 64 * 33);
    const int nblk = ncols / 32, nitems = (K / 64) * nblk;
    for (int it = c.gw; it < nitems; it += 2 * c.ngw) { TrD d0{W, WT, gain, ldw, scol0, K, drow0, mode, it, nblk}; TrD d1 = d0; d1.item = it + c.ngw; tr_pair(d0, d1, it + c.ngw < nitems, c.lane, scr); }
}
__device__ __forceinline__ TrD tr_moe_desc(const Params& p, int layer, int it) {
    bf16_t* w13t = (bf16_t*)(p.ws + OFF_WMOE); bf16_t* w2t = (bf16_t*)(p.ws + OFF_WMOE + 64 * MiB);
    const float* w1 = p.moe_w1 + (size_t)layer * NEXP * 1024 * 512; const float* w3 = p.moe_w3 + (size_t)layer * NEXP * 1024 * 512; const float* w2 = p.moe_w2 + (size_t)layer * NEXP * 512 * 1024;
    const int e = it / 768, r = it % 768;
    if (r < 256) return TrD{w1 + (size_t)e * 1024 * 512, w13t + (size_t)e * 1024 * 1024, p.norm_moe + layer * 1024, 512, 0, 1024, 0, 2, r, 16};
    if (r < 512) return TrD{w3 + (size_t)e * 1024 * 512, w13t + (size_t)e * 1024 * 1024, p.norm_moe + layer * 1024, 512, 0, 1024, 0, 3, r - 256, 16};
    return TrD{w2 + (size_t)e * 512 * 1024, w2t + (size_t)e * 1024 * 512, nullptr, 1024, 0, 512, 0, 0, r - 512, 32};
}
__device__ __forceinline__ void tr_moe_layer_w(const Ctx& c, const Params& p, int layer, int widx, int nw) {
    LAS float* scr = (LAS float*)(c.shm) + c.wave * (2 * 64 * 33);
    for (int it = widx; it < NEXP * 768; it += 2 * nw) { const bool has1 = it + nw < NEXP * 768; const TrD d0 = tr_moe_desc(p, layer, it); const TrD d1 = tr_moe_desc(p, layer, has1 ? it + nw : it); tr_pair(d0, d1, has1, c.lane, scr); }
}
__device__ __forceinline__ void tr_moe_layer(const Ctx& c, const Params& p, int layer, int gw0, int ngw) {
    LAS float* scr = (LAS float*)(c.shm) + c.wave * (2 * 64 * 33);
    for (int it = c.gw - gw0; it < NEXP * 768; it += 2 * ngw) { const bool has1 = it + ngw < NEXP * 768; const TrD d0 = tr_moe_desc(p, layer, it); const TrD d1 = tr_moe_desc(p, layer, has1 ? it + ngw : it); tr_pair(d0, d1, has1, c.lane, scr); }
}

__device__ __forceinline__ void row_load(const float* row, int lane, f32x4 (&v)[4]) {
#pragma unroll
    for (int j = 0; j < 4; ++j) v[j] = *((const f32x4*)row + lane + 64 * j);
}
__device__ __forceinline__ float row_rstd(const f32x4 (&v)[4]) {
    float s = 0.f;
#pragma unroll
    for (int j = 0; j < 4; ++j) s += (v[j].x * v[j].x + v[j].y * v[j].y) + (v[j].z * v[j].z + v[j].w * v[j].w);
    return 1.0f / sqrtf(wave_sum(s) * (1.0f / 1024.0f) + 1e-6f);
}
__device__ __forceinline__ void row_scale(f32x4 (&v)[4], float rstd, const float* gain, int lane) {
#pragma unroll
    for (int j = 0; j < 4; ++j) { const f32x4 g = *((const f32x4*)gain + lane + 64 * j); v[j] = v[j] * rstd * g; }
}
__device__ __forceinline__ void row_store_bf16(bf16_t* orow, int lane, const f32x4 (&v)[4]) {
#pragma unroll
    for (int j = 0; j < 4; ++j) { u32x2 o; o.x = pk2(v[j].x, v[j].y); o.y = pk2(v[j].z, v[j].w); *((u32x2*)orow + lane + 64 * j) = o; }
}
__device__ __forceinline__ void row_store_f32(float* orow, int lane, const f32x4 (&v)[4]) {
#pragma unroll
    for (int j = 0; j < 4; ++j) *((f32x4*)orow + lane + 64 * j) = v[j];
}
__device__ __forceinline__ void row_combine(f32x4 (&v)[4], const bf16_t* yb, int p0, int p1, float g0, float g1, int lane) {
    const u32x2* r0 = (const u32x2*)(yb + (size_t)p0 * 1024); const u32x2* r1 = (const u32x2*)(yb + (size_t)p1 * 1024);
#pragma unroll
    for (int j = 0; j < 4; ++j) { const u32x2 a = r0[lane + 64 * j], b = r1[lane + 64 * j];
        v[j].x += g0 * bflo(a.x) + g1 * bflo(b.x); v[j].y += g0 * bfhi(a.x) + g1 * bfhi(b.x);
        v[j].z += g0 * bflo(a.y) + g1 * bflo(b.y); v[j].w += g0 * bfhi(a.y) + g1 * bfhi(b.y); }
}
__device__ __forceinline__ void row_logits(const f32x4 (&v)[4], const float* wT, int lane, int NL, LAS float* lg) {
#pragma unroll 1
    for (int o = 0; o < NL; ++o) { float s = 0.f;
#pragma unroll
        for (int j = 0; j < 4; ++j) { const f32x4 w = *((const f32x4*)(wT + o * 1024) + lane + 64 * j); s += (v[j].x * w.x + v[j].y * w.y) + (v[j].z * w.z + v[j].w * w.w); }
        s = wave_sum(s); if (lane == 0) lg[o] = s; }
    LDS_WAIT();
}

__device__ __forceinline__ void norm_plain(const Ctx& c, const float* src, const float* gain, bf16_t* H, int nrows) {
    for (int r0 = c.gw; r0 < nrows; r0 += 4 * c.ngw) {
        f32x4 v[4][4];
#pragma unroll
        for (int q = 0; q < 4; ++q) { const int r = r0 + q * c.ngw; if (r < nrows) row_load(src + (size_t)r * 1024, c.lane, v[q]); }
#pragma unroll
        for (int q = 0; q < 4; ++q) { const int r = r0 + q * c.ngw; if (r < nrows) { const float rs = row_rstd(v[q]); row_scale(v[q], rs, gain, c.lane); row_store_bf16(H + (size_t)r * 1024, c.lane, v[q]); } }
    }
}
__device__ __forceinline__ void route_row(const LAS float* lg, const float* bg, const float* be, int& e0, int& e1, float& g0, float& g1) {
    float gl[4]; int gt = 0; float gm;
#pragma unroll
    for (int i = 0; i < 4; ++i) gl[i] = lg[i] + bg[i];
    gm = gl[0];
#pragma unroll
    for (int i = 1; i < 4; ++i) if (gl[i] > gm) { gm = gl[i]; gt = i; }
    float gs = 0.f;
#pragma unroll
    for (int i = 0; i < 4; ++i) gs += __expf(gl[i] - gm);
    const float pg = 1.0f / gs;
    float el[8];
#pragma unroll
    for (int i = 0; i < 8; ++i) el[i] = lg[4 + 8 * gt + i] + be[8 * gt + i];
    int i0 = 0; float m0 = el[0];
#pragma unroll
    for (int i = 1; i < 8; ++i) if (el[i] > m0) { m0 = el[i]; i0 = i; }
    int i1 = -1; float m1 = -3.0e38f;
#pragma unroll
    for (int i = 0; i < 8; ++i) if (i != i0 && el[i] > m1) { m1 = el[i]; i1 = i; }
    float one = 1.0f; asm volatile("" : "+v"(one));
    const float q1 = __expf(m1 - m0); const float inv = one / (one + q1);
    e0 = gt * 8 + i0; e1 = gt * 8 + i1; g0 = pg * inv; g1 = pg * q1 * inv;
}
constexpr int RW_AS = 64 * 68;
__device__ __forceinline__ void rwkv_naive(const Ctx& c, const Params& p, int bh) {
    const int b = bh >> 3, hd = bh & 7, tid = c.tid, lane = c.lane, wv = c.wave;
    LAS float* L = (LAS float*)c.shm;
    LAS float* aR = L; LAS float* aK = L + RW_AS; LAS float* aV = L + 2 * RW_AS; LAS float* aW = L + 3 * RW_AS; LAS float* aA = L + 4 * RW_AS;
    LAS float* aB = L + 5 * RW_AS; LAS float* aG = L + 6 * RW_AS; LAS float* aY = L + 7 * RW_AS; LAS float* red = L + 8 * RW_AS;
    const bf16_t* P = (const bf16_t*)(p.ws + OFF_P); bf16_t* MIX = (bf16_t*)(p.ws + OFF_H);
    LAS f32x4* SL = (LAS f32x4*)(L + 8 * RW_AS + 1536);
    if (wv == 0) {
#pragma unroll
        for (int j4 = 0; j4 < 16; ++j4) SL[j4 * 64 + lane] = (f32x4){0.f, 0.f, 0.f, 0.f}; }
    const int t = lane, cg = wv;
    const int ch0 = hd * 64 + cg * 8;
    for (int tb = 0; tb < 64; ++tb) {
        const size_t tg0 = (size_t)b * SEQ + (size_t)tb * 64;
#pragma unroll 1
        for (int i = 0; i < 7; ++i) {
            const int task = tid + 512 * i, tt = task / 56, q = task % 56;
            int col; LAS float* dst; int kind = 0;
            if (q < 8) { col = hd * 64 + 8 * q; dst = aR + tt * 68 + 8 * q; }
            else if (q < 16) { col = 512 + hd * 64 + 8 * (q - 8); dst = aK + tt * 68 + 8 * (q - 8); }
            else if (q < 24) { col = 1024 + hd * 64 + 8 * (q - 16); dst = aV + tt * 68 + 8 * (q - 16); }
            else if (q < 32) { col = 1536 + 8 * (q - 24); dst = aW + tt * 68 + 8 * (q - 24); kind = 1; }
            else if (q < 40) { col = 1600 + 8 * (q - 32); dst = aA + tt * 68 + 8 * (q - 32); }
            else if (q < 48) { col = 1664 + 8 * (q - 40); dst = aB + tt * 68 + 8 * (q - 40); kind = 2; }
            else { col = 1664 + 8 * (q - 40); dst = aG + tt * 68 + 8 * (q - 48); kind = 2; }
            const bf16_t* src = P + (tg0 + tt) * EV_IN + 768 + col;
            const u32x4 cur = *(const u32x4*)src;
            u32x4 prv = (u32x4){0u, 0u, 0u, 0u};
            if (tb * 64 + tt > 0) prv = *(const u32x4*)(src - EV_IN);
            const f32x4 m0 = *(const f32x4*)(p.ev_mu + col), m1 = *(const f32x4*)(p.ev_mu + col + 4);
            float v[8];
            const unsigned cw[4] = {cur.x, cur.y, cur.z, cur.w}, pw[4] = {prv.x, prv.y, prv.z, prv.w};
            const float mu[8] = {m0.x, m0.y, m0.z, m0.w, m1.x, m1.y, m1.z, m1.w};
#pragma unroll
            for (int k = 0; k < 4; ++k) { const float c0 = bflo(cw[k]), c1 = bfhi(cw[k]), p0 = bflo(pw[k]), p1 = bfhi(pw[k]);
                v[2 * k] = c0 + (p0 - c0) * mu[2 * k]; v[2 * k + 1] = c1 + (p1 - c1) * mu[2 * k + 1]; }
            if (kind == 1) {
#pragma unroll
                for (int k = 0; k < 8; ++k) v[k] = tanhf(v[k]); }
            if (kind == 2) {
#pragma unroll
                for (int k = 0; k < 8; ++k) v[k] = sigmoidf_(v[k]); }
            *(LAS f32x4*)dst = (f32x4){v[0], v[1], v[2], v[3]}; *(LAS f32x4*)(dst + 4) = (f32x4){v[4], v[5], v[6], v[7]};
        }
        __syncthreads();
        float zw[8], za[8], gg[8];
#pragma unroll
        for (int i = 0; i < 8; ++i) { zw[i] = 0.f; za[i] = 0.f; gg[i] = 0.f; }
#pragma unroll 2
        for (int j4 = 0; j4 < 16; ++j4) {
            const f32x4 xw = *(const LAS f32x4*)(aW + t * 68 + 4 * j4), xa = *(const LAS f32x4*)(aA + t * 68 + 4 * j4);
            const f32x4 g0 = *(const LAS f32x4*)(aB + t * 68 + 4 * j4), g1 = *(const LAS f32x4*)(aG + t * 68 + 4 * j4);
#pragma unroll
            for (int jj = 0; jj < 4; ++jj) { const int j = 4 * j4 + jj;
                const f32x4 w2a = *(const f32x4*)(p.ev_w2 + (size_t)j * 512 + ch0), w2b = *(const f32x4*)(p.ev_w2 + (size_t)j * 512 + ch0 + 4);
                const f32x4 a2a = *(const f32x4*)(p.ev_a2 + (size_t)j * 512 + ch0), a2b = *(const f32x4*)(p.ev_a2 + (size_t)j * 512 + ch0 + 4);
                const f32x4 gla = *(const f32x4*)(p.ev_g2 + (size_t)j * 512 + ch0), glb = *(const f32x4*)(p.ev_g2 + (size_t)j * 512 + ch0 + 4);
                const f32x4 gha = *(const f32x4*)(p.ev_g2 + (size_t)(64 + j) * 512 + ch0), ghb = *(const f32x4*)(p.ev_g2 + (size_t)(64 + j) * 512 + ch0 + 4);
                const float xwv = xw[jj], xav = xa[jj], g0v = g0[jj], g1v = g1[jj];
#pragma unroll
                for (int i = 0; i < 4; ++i) { zw[i] += xwv * w2a[i]; zw[4 + i] += xwv * w2b[i]; za[i] += xav * a2a[i]; za[4 + i] += xav * a2b[i];
                    gg[i] += g0v * gla[i] + g1v * gha[i]; gg[4 + i] += g0v * glb[i] + g1v * ghb[i]; } }
        }
        float av[8], kkv[8]; float ss = 0.f;
        {
            const f32x4 kA = *(const LAS f32x4*)(aK + t * 68 + cg * 8), kB = *(const LAS f32x4*)(aK + t * 68 + cg * 8 + 4);
            const float kv[8] = {kA.x, kA.y, kA.z, kA.w, kB.x, kB.y, kB.z, kB.w};
            float dec[8], kp[8];
#pragma unroll
            for (int i = 0; i < 8; ++i) { const int ch = ch0 + i;
                const float u = -(p.ev_w0[ch] + zw[i]); const float sp = (u > 20.f) ? u : log1pf(__expf(u));
                const float w = -sp - 0.5f; dec[i] = __expf(-__expf(w));
                av[i] = sigmoidf_(p.ev_a0[ch] + za[i]);
                kkv[i] = kv[i] * p.ev_k_k[ch]; ss += kkv[i] * kkv[i];
                kp[i] = kv[i] * (1.0f + (av[i] - 1.0f) * p.ev_k_a[ch]); }
            red[t * 8 + cg] = ss;
            __syncthreads();
            *(LAS f32x4*)(aW + t * 68 + cg * 8) = (f32x4){dec[0], dec[1], dec[2], dec[3]}; *(LAS f32x4*)(aW + t * 68 + cg * 8 + 4) = (f32x4){dec[4], dec[5], dec[6], dec[7]};
            *(LAS f32x4*)(aK + t * 68 + cg * 8) = (f32x4){kp[0], kp[1], kp[2], kp[3]}; *(LAS f32x4*)(aK + t * 68 + cg * 8 + 4) = (f32x4){kp[4], kp[5], kp[6], kp[7]};
            *(LAS f32x4*)(aG + t * 68 + cg * 8) = (f32x4){gg[0], gg[1], gg[2], gg[3]}; *(LAS f32x4*)(aG + t * 68 + cg * 8 + 4) = (f32x4){gg[4], gg[5], gg[6], gg[7]};
            float tot = 0.f;
#pragma unroll
            for (int i = 0; i < 8; ++i) tot += red[t * 8 + i];
            const float inv = 1.0f / fmaxf(sqrtf(tot), 1e-12f);
            float an[8], bn[8];
#pragma unroll
            for (int i = 0; i < 8; ++i) { const float kn = kkv[i] * inv; an[i] = -kn; bn[i] = kn * av[i]; }
            *(LAS f32x4*)(aA + t * 68 + cg * 8) = (f32x4){an[0], an[1], an[2], an[3]}; *(LAS f32x4*)(aA + t * 68 + cg * 8 + 4) = (f32x4){an[4], an[5], an[6], an[7]};
            *(LAS f32x4*)(aB + t * 68 + cg * 8) = (f32x4){bn[0], bn[1], bn[2], bn[3]}; *(LAS f32x4*)(aB + t * 68 + cg * 8 + 4) = (f32x4){bn[4], bn[5], bn[6], bn[7]};
        }
        __syncthreads();
        if (wv == 0) {
            float S[64];
#pragma unroll
            for (int j4 = 0; j4 < 16; ++j4) { const f32x4 s4 = SL[j4 * 64 + lane]; S[4 * j4] = s4.x; S[4 * j4 + 1] = s4.y; S[4 * j4 + 2] = s4.z; S[4 * j4 + 3] = s4.w; }
#pragma unroll 1
            for (int tt = 0; tt < 64; ++tt) {
                const float vv = aV[tt * 68 + lane];
                float sa = 0.f;
#pragma unroll
                for (int j4 = 0; j4 < 16; ++j4) { const f32x4 a4 = *(const LAS f32x4*)(aA + tt * 68 + 4 * j4);
                    sa += S[4 * j4] * a4.x; sa += S[4 * j4 + 1] * a4.y; sa += S[4 * j4 + 2] * a4.z; sa += S[4 * j4 + 3] * a4.w; }
                float y = 0.f;
#pragma unroll
                for (int j4 = 0; j4 < 16; ++j4) {
                    const f32x4 d4 = *(const LAS f32x4*)(aW + tt * 68 + 4 * j4), b4 = *(const LAS f32x4*)(aB + tt * 68 + 4 * j4);
                    const f32x4 k4 = *(const LAS f32x4*)(aK + tt * 68 + 4 * j4), r4 = *(const LAS f32x4*)(aR + tt * 68 + 4 * j4);
#pragma unroll
                    for (int jj = 0; jj < 4; ++jj) { const int j = 4 * j4 + jj; S[j] = S[j] * d4[jj] + sa * b4[jj] + vv * k4[jj]; y += S[j] * r4[jj]; } }
                aY[tt * 68 + lane] = y;
            }
#pragma unroll
            for (int j4 = 0; j4 < 16; ++j4) SL[j4 * 64 + lane] = (f32x4){S[4 * j4], S[4 * j4 + 1], S[4 * j4 + 2], S[4 * j4 + 3]};
        }
        __syncthreads();
        {
            const f32x4 yA = *(const LAS f32x4*)(aY + t * 68 + cg * 8), yB = *(const LAS f32x4*)(aY + t * 68 + cg * 8 + 4);
            const f32x4 rA = *(const LAS f32x4*)(aR + t * 68 + cg * 8), rB = *(const LAS f32x4*)(aR + t * 68 + cg * 8 + 4);
            const f32x4 kA = *(const LAS f32x4*)(aK + t * 68 + cg * 8), kB = *(const LAS f32x4*)(aK + t * 68 + cg * 8 + 4);
            const f32x4 vA = *(const LAS f32x4*)(aV + t * 68 + cg * 8), vB = *(const LAS f32x4*)(aV + t * 68 + cg * 8 + 4);
            const f32x4 gA = *(const LAS f32x4*)(aG + t * 68 + cg * 8), gB = *(const LAS f32x4*)(aG + t * 68 + cg * 8 + 4);
            const float y[8] = {yA.x, yA.y, yA.z, yA.w, yB.x, yB.y, yB.z, yB.w}, r[8] = {rA.x, rA.y, rA.z, rA.w, rB.x, rB.y, rB.z, rB.w};
            const float k[8] = {kA.x, kA.y, kA.z, kA.w, kB.x, kB.y, kB.z, kB.w}, v[8] = {vA.x, vA.y, vA.z, vA.w, vB.x, vB.y, vB.z, vB.w};
            const float g[8] = {gA.x, gA.y, gA.z, gA.w, gB.x, gB.y, gB.z, gB.w};
            float s1 = 0.f, sb = 0.f;
#pragma unroll
            for (int i = 0; i < 8; ++i) { s1 += y[i]; sb += r[i] * k[i] * p.ev_r_k[ch0 + i]; }
            red[t * 8 + cg] = s1; red[512 + t * 8 + cg] = sb;
            __syncthreads();
            float m = 0.f, bon = 0.f;
#pragma unroll
            for (int i = 0; i < 8; ++i) { m += red[t * 8 + i]; bon += red[512 + t * 8 + i]; }
            m *= (1.0f / 64.0f);
            float s2 = 0.f;
#pragma unroll
            for (int i = 0; i < 8; ++i) s2 += (y[i] - m) * (y[i] - m);
            red[1024 + t * 8 + cg] = s2;
            __syncthreads();
            float var = 0.f;
#pragma unroll
            for (int i = 0; i < 8; ++i) var += red[1024 + t * 8 + i];
            const float rs = 1.0f / sqrtf(var * (1.0f / 64.0f) + 64e-5f);
            float o[8];
#pragma unroll
            for (int i = 0; i < 8; ++i) o[i] = ((y[i] - m) * rs * p.ev_lnx_w[ch0 + i] + p.ev_lnx_b[ch0 + i] + bon * v[i]) * g[i];
            u32x4 w; w.x = pk2(o[0], o[1]); w.y = pk2(o[2], o[3]); w.z = pk2(o[4], o[5]); w.w = pk2(o[6], o[7]);
            *(u32x4*)(MIX + (tg0 + t) * 1024 + 512 + ch0) = w;
        }
        __syncthreads();
    }
}

__device__ __forceinline__ void swa_naive(const Ctx& c, const Params& p, int unit) {
    const int b = unit >> 6, g = (unit >> 5) & 1, n = unit & 31, tid = c.tid, lane = c.lane, wv = c.wave;
    LAS bf16_t* Ks = (LAS bf16_t*)c.shm;
    LAS bf16_t* Vs = (LAS bf16_t*)(c.shm + 256 * 144);
    LAS float* qf = (LAS float*)(c.shm + 256 * 144 + 256 * 128) + wv * 320;
    LAS float* pr = qf + 64;
    const bf16_t* P = (const bf16_t*)(p.ws + OFF_P); bf16_t* MIX = (bf16_t*)(p.ws + OFF_H);
    __syncthreads();
#pragma unroll 1
    for (int i = 0; i < 8; ++i) {
        const int task = tid + 512 * i, which = task >> 11, r = (task >> 3) & 255, ck = task & 7;
        const int tk = n * 128 - 128 + r;
        u32x4 d = (u32x4){0u, 0u, 0u, 0u};
        if (tk >= 0) d = *(const u32x4*)(P + ((size_t)b * SEQ + tk) * EV_IN + 512 + which * 128 + g * 64 + ck * 8);
        if (which == 0) *(LAS u32x4*)(Ks + r * 72 + ck * 8) = d; else *(LAS u32x4*)(Vs + r * 64 + ck * 8) = d;
    }
    __syncthreads();
    const int head = g * 4 + (wv >> 1);
    const float sink = p.ev_sinks[head];
#pragma unroll 1
    for (int qq = 0; qq < 64; ++qq) {
        const int qi = (wv & 1) * 64 + qq;
        const size_t tq = (size_t)b * SEQ + n * 128 + qi;
        qf[lane] = bf2f(P[tq * EV_IN + head * 64 + lane]) * 0.125f;
        LDS_WAIT();
        float s[4];
#pragma unroll
        for (int j = 0; j < 4; ++j) { const int kp = lane + 64 * j; float a = 0.f;
#pragma unroll
            for (int ck = 0; ck < 8; ++ck) { const u32x4 kk = *(const LAS u32x4*)(Ks + kp * 72 + ck * 8);
                const f32x4 q0 = *(const LAS f32x4*)(qf + ck * 8), q1 = *(const LAS f32x4*)(qf + ck * 8 + 4);
                a += bflo(kk.x) * q0.x + bfhi(kk.x) * q0.y + bflo(kk.y) * q0.z + bfhi(kk.y) * q0.w + bflo(kk.z) * q1.x + bfhi(kk.z) * q1.y + bflo(kk.w) * q1.z + bfhi(kk.w) * q1.w; }
            const bool valid = (kp >= qi + 1) && (kp <= qi + 128) && (n > 0 || kp >= 128);
            s[j] = valid ? a : -INFINITY; }
        float m = fmaxf(fmaxf(s[0], s[1]), fmaxf(s[2], s[3])); m = fmaxf(wave_max(m), sink);
        float den = 0.f;
#pragma unroll
        for (int j = 0; j < 4; ++j) { const float e = __expf(s[j] - m); pr[lane + 64 * j] = e; den += e; }
        den = wave_sum(den) + __expf(sink - m);
        LDS_WAIT();
        float o = 0.f;
#pragma unroll 8
        for (int kp = qi + 1; kp <= qi + 128; ++kp) o += pr[kp] * bf2f(Vs[kp * 64 + lane]);
        MIX[tq * 1024 + head * 64 + lane] = (bf16_t)f2bf(o / den);
    }
}
__device__ __forceinline__ void gla_naive(const Ctx& c, const Params& p, int bh) {
    const int b = bh >> 2, hd = bh & 3, tid = c.tid, lane = c.lane, wv = c.wave;
    LAS float* qs = (LAS float*)c.shm; LAS float* ks = qs + 32 * 128; LAS float* es = ks + 32 * 128; LAS float* vs = es + 32 * 128; LAS float* os = vs + 32 * 256;
    const bf16_t* P = (const bf16_t*)(p.ws + OFF_P); const float* GK = (const float*)(p.ws + OFF_R); bf16_t* MIX = (bf16_t*)(p.ws + OFF_H);
    float S[128];
#pragma unroll
    for (int j = 0; j < 128; ++j) S[j] = 0.f;
    for (int tb = 0; tb < 128; ++tb) {
        const size_t tg0 = (size_t)b * SEQ + (size_t)tb * 32;
#pragma unroll 1
        for (int i = 0; i < 8; ++i) { const int idx = tid + 512 * i, tt = idx >> 7, j = idx & 127;
            const bf16_t* row = P + (tg0 + tt) * OD_IN;
            qs[idx] = bf2f(row[hd * 128 + j]) * 0.08838834764831845f; ks[idx] = bf2f(row[512 + hd * 128 + j]); es[idx] = __expf(GK[(tg0 + tt) * 512 + hd * 128 + j]); }
#pragma unroll 1
        for (int i = 0; i < 16; ++i) { const int idx = tid + 512 * i, tt = idx >> 8, j = idx & 255; vs[idx] = bf2f(P[(tg0 + tt) * OD_IN + 1024 + hd * 256 + j]); }
        __syncthreads();
        if (wv < 4) {
#pragma unroll 1
            for (int tt = 0; tt < 32; ++tt) {
                const float vv = vs[tt * 256 + tid]; float o = 0.f;
#pragma unroll
                for (int j4 = 0; j4 < 32; ++j4) {
                    const f32x4 e4 = *(const LAS f32x4*)(es + tt * 128 + 4 * j4), k4 = *(const LAS f32x4*)(ks + tt * 128 + 4 * j4), q4 = *(const LAS f32x4*)(qs + tt * 128 + 4 * j4);
#pragma unroll
                    for (int jj = 0; jj < 4; ++jj) { const int j = 4 * j4 + jj; S[j] = S[j] * e4[jj] + k4[jj] * vv; o += q4[jj] * S[j]; } }
                os[tt * 256 + tid] = o;
            }
        }
        __syncthreads();
#pragma unroll 1
        for (int i = 0; i < 4; ++i) { const int tt = wv + 8 * i;
            const f32x4 o4 = *(const LAS f32x4*)(os + tt * 256 + 4 * lane);
            const float ss = wave_sum(o4.x * o4.x + o4.y * o4.y + o4.z * o4.z + o4.w * o4.w);
            const float rs = 1.0f / sqrtf(ss * (1.0f / 256.0f) + 1e-6f);
            const f32x4 gn = *(const f32x4*)(p.od_onorm + 4 * lane);
            const u32x2 og = *(const u32x2*)(P + (tg0 + tt) * OD_IN + 2048 + hd * 256 + 4 * lane);
            const float g0 = bflo(og.x), g1 = bfhi(og.x), g2 = bflo(og.y), g3 = bfhi(og.y);
            u32x2 w; w.x = pk2(o4.x * rs * gn.x * g0 * sigmoidf_(g0), o4.y * rs * gn.y * g1 * sigmoidf_(g1)); w.y = pk2(o4.z * rs * gn.z * g2 * sigmoidf_(g2), o4.w * rs * gn.w * g3 * sigmoidf_(g3));
            *(u32x2*)(MIX + (tg0 + tt) * 1024 + hd * 256 + 4 * lane) = w; }
        __syncthreads();
    }
}

__device__ __forceinline__ void xattn_naive(const Ctx& c, const Params& p, int unit) {
    const int b = unit >> 5, hh = (unit >> 3) & 3, tblk = unit & 7, tid = c.tid, lane = c.lane, wv = c.wave;
    LAS bf16_t* Ks = (LAS bf16_t*)c.shm;
    LAS bf16_t* Vs = (LAS bf16_t*)(c.shm + 256 * 272);
    LAS float* qf = (LAS float*)(c.shm + 256 * 272 + 256 * 256) + wv * 384;
    LAS float* pr = qf + 128;
    const bf16_t* MKV = (const bf16_t*)(p.ws + OFF_MKV); const bf16_t* Q = (const bf16_t*)(p.ws + OFF_P); bf16_t* OA = (bf16_t*)(p.ws + OFF_P + 32 * MiB);
    __syncthreads();
#pragma unroll 1
    for (int i = 0; i < 16; ++i) {
        const int task = tid + 512 * i, which = task >> 12, r = (task >> 4) & 255, ck = task & 15;
        const u32x4 d = *(const u32x4*)(MKV + ((size_t)b * MEMLEN + r) * 1024 + which * 512 + hh * 128 + ck * 8);
        if (which == 0) *(LAS u32x4*)(Ks + r * 136 + ck * 8) = d; else *(LAS u32x4*)(Vs + r * 128 + ck * 8) = d;
    }
    __syncthreads();
#pragma unroll 1
    for (int qq = 0; qq < 64; ++qq) {
        const size_t tq = (size_t)b * SEQ + tblk * 512 + wv * 64 + qq;
        qf[lane] = bf2f(Q[tq * 512 + hh * 128 + lane]) * 0.08838834764831845f; qf[lane + 64] = bf2f(Q[tq * 512 + hh * 128 + 64 + lane]) * 0.08838834764831845f;
        LDS_WAIT();
        float s[4];
#pragma unroll
        for (int j = 0; j < 4; ++j) { const int kp = lane + 64 * j; float a = 0.f;
#pragma unroll
            for (int ck = 0; ck < 16; ++ck) { const u32x4 kk = *(const LAS u32x4*)(Ks + kp * 136 + ck * 8);
                const f32x4 q0 = *(const LAS f32x4*)(qf + ck * 8), q1 = *(const LAS f32x4*)(qf + ck * 8 + 4);
                a += bflo(kk.x) * q0.x + bfhi(kk.x) * q0.y + bflo(kk.y) * q0.z + bfhi(kk.y) * q0.w + bflo(kk.z) * q1.x + bfhi(kk.z) * q1.y + bflo(kk.w) * q1.z + bfhi(kk.w) * q1.w; }
            s[j] = a; }
        const float m = wave_max(fmaxf(fmaxf(s[0], s[1]), fmaxf(s[2], s[3])));
        float den = 0.f;
#pragma unroll
        for (int j = 0; j < 4; ++j) { const float e = __expf(s[j] - m); pr[lane + 64 * j] = e; den += e; }
        den = wave_sum(den);
        LDS_WAIT();
        float o0 = 0.f, o1 = 0.f;
#pragma unroll 4
        for (int k4 = 0; k4 < 64; ++k4) { const f32x4 p4 = *(const LAS f32x4*)(pr + 4 * k4);
#pragma unroll
            for (int kk = 0; kk < 4; ++kk) { const unsigned vv = *(const LAS unsigned*)(Vs + (4 * k4 + kk) * 128 + 2 * lane); o0 += p4[kk] * bflo(vv); o1 += p4[kk] * bfhi(vv); } }
        const float inv = 1.0f / den;
        *(unsigned*)(OA + tq * 512 + hh * 128 + 2 * lane) = pk2(o0 * inv, o1 * inv);
    }
}

__device__ __forceinline__ void moe_slots(const Ctx& c, const Params& p, int layer) {
    LAS int* sh = (LAS int*)c.shm;
    const int* cnt = (const int*)(p.ws + OFF_CTL + CTL_CNT) + layer * 32; int* cur = (int*)(p.ws + OFF_CTL + CTL_CUR) + layer * 32;
    int* blk = (int*)(p.ws + OFF_CTL + CTL_BLK) + layer * 1024;
    __syncthreads();
    if (c.tid == 0) { int acc = 0; for (int e = 0; e < NEXP; ++e) { sh[e] = acc; acc += (cnt[e] + 255) / 256 * 256; } sh[32] = acc; }
    __syncthreads();
    if (blockIdx.x == 0 && c.tid < NEXP) { const int e = c.tid, s = sh[e] / 256, en = (e == NEXP - 1 ? sh[32] : sh[e + 1]) / 256; for (int i = s; i < en; ++i) blk[1 + i] = e; if (e == 0) blk[0] = sh[32] / 256; }
    const int2* RE = (const int2*)(p.ws + OFF_ROUTE); int2* RP = (int2*)(p.ws + OFF_ROUTE + 512 * 1024);
    const bf16_t* H = (const bf16_t*)(p.ws + OFF_H); bf16_t* XB = (bf16_t*)(p.ws + OFF_P);
    for (int ck = c.gw; ck < T_TOK / 64; ck += c.ngw) {
        const int t = ck * 64 + c.lane; const int2 ee = RE[t]; int pos0 = 0, pos1 = 0;
#pragma unroll 1
        for (int e = 0; e < NEXP; ++e) {
            const unsigned long long m0 = __ballot(ee.x == e), m1 = __ballot(ee.y == e);
            const int n0 = __popcll(m0), n1 = __popcll(m1);
            if (n0 + n1 == 0) continue;
            int base = 0; if (c.lane == 0) base = atomicAdd(&cur[e], n0 + n1);
            base = __shfl(base, 0) + sh[e];
            const unsigned long long lt = (1ull << c.lane) - 1ull;
            if (ee.x == e) pos0 = base + __popcll(m0 & lt);
            if (ee.y == e) pos1 = base + n0 + __popcll(m1 & lt);
        }
        RP[t] = make_int2(pos0, pos1);
#pragma unroll 1
        for (int i = 0; i < 64; ++i) { const int ti = ck * 64 + i, q0 = __shfl(pos0, i), q1 = __shfl(pos1, i);
            const u32x4 a = *((const u32x4*)(H + (size_t)ti * 1024) + c.lane), bq = *((const u32x4*)(H + (size_t)ti * 1024) + 64 + c.lane);
            *((u32x4*)(XB + (size_t)q0 * 1024) + c.lane) = a; *((u32x4*)(XB + (size_t)q0 * 1024) + 64 + c.lane) = bq;
            *((u32x4*)(XB + (size_t)q1 * 1024) + c.lane) = a; *((u32x4*)(XB + (size_t)q1 * 1024) + 64 + c.lane) = bq; }
    }
}
typedef short bf16x8_t __attribute__((ext_vector_type(8)));
constexpr size_t R_GK = 0, R_QT = 64 * MiB, R_ATT = 96 * MiB, R_KHT = 112 * MiB, R_GDEC = 144 * MiB;
template <int CTRL, int RMASK> __device__ __forceinline__ float dpp_get0(float x) {
    return __builtin_bit_cast(float, __builtin_amdgcn_update_dpp(0, __builtin_bit_cast(int, x), CTRL, RMASK, 0xF, false)); }
__device__ __forceinline__ float wave_scan_incl(float x, int lane) {
    (void)lane;
    x += dpp_get0<0x111, 0xF>(x); x += dpp_get0<0x112, 0xF>(x); x += dpp_get0<0x114, 0xF>(x); x += dpp_get0<0x118, 0xF>(x);
    x += dpp_get0<0x142, 0xA>(x); x += dpp_get0<0x143, 0xC>(x);
    return x;
}
__device__ __forceinline__ float lane63(float x) { return __builtin_bit_cast(float, __builtin_amdgcn_readlane(__builtin_bit_cast(int, x), 63)); }
__device__ __forceinline__ int key_perm(int key) { const int kq = key & 31; return (key & ~31) + 8 * ((kq >> 2) & 3) + 4 * ((kq >> 4) & 1) + (kq & 3); }
__device__ __forceinline__ bf16x8_t zero_frag() { return (bf16x8_t){0, 0, 0, 0, 0, 0, 0, 0}; }
__device__ __forceinline__ bf16x8_t lds_frag(const LAS bf16_t* img, int pitch, int row, int col) { return *(const LAS bf16x8_t*)(img + row * pitch + col); }
__device__ __forceinline__ bf16x8_t pack8(const float (&v)[8]) {
    u32x4 w; w.x = pk2(v[0], v[1]); w.y = pk2(v[2], v[3]); w.z = pk2(v[4], v[5]); w.w = pk2(v[6], v[7]);
    return __builtin_bit_cast(bf16x8_t, w);
}
__device__ __forceinline__ void gla_prep(const Ctx& c, const Params& p, int unit) {
    const int bh = unit >> 6, ck = unit & 63, b = bh >> 2, hd = bh & 3, lane = c.lane, wv = c.wave;
    LAS bf16_t* Qs = (LAS bf16_t*)c.shm;
    LAS bf16_t* Ks = Qs + 64 * 136;
    const bf16_t* P = (const bf16_t*)(p.ws + OFF_P); unsigned char* R = p.ws + OFF_R;
    const float* GK = (const float*)(R + R_GK); bf16_t* QT = (bf16_t*)(R + R_QT) + (size_t)unit * 64 * 128; bf16_t* ATT = (bf16_t*)(R + R_ATT) + (size_t)unit * 64 * 64;
    bf16_t* KHT = (bf16_t*)(R + R_KHT) + (size_t)unit * 128 * 64; float* GDEC = (float*)(R + R_GDEC) + (size_t)unit * 128;
    const size_t tg = (size_t)b * SEQ + ck * 64 + lane; const int d0 = wv * 16;
    __syncthreads();
    {
        const bf16_t* row = P + tg * OD_IN;
        const u32x4 qa = *(const u32x4*)(row + hd * 128 + d0), qb = *(const u32x4*)(row + hd * 128 + d0 + 8);
        const u32x4 ka = *(const u32x4*)(row + 512 + hd * 128 + d0), kb = *(const u32x4*)(row + 512 + hd * 128 + d0 + 8);
        const unsigned qw[8] = {qa.x, qa.y, qa.z, qa.w, qb.x, qb.y, qb.z, qb.w}, kw[8] = {ka.x, ka.y, ka.z, ka.w, kb.x, kb.y, kb.z, kb.w};
        float qt[16], kt[16], kh[16];
#pragma unroll
        for (int i4 = 0; i4 < 4; ++i4) { const f32x4 g4 = *(const f32x4*)(GK + tg * 512 + hd * 128 + d0 + 4 * i4);
#pragma unroll
            for (int ii = 0; ii < 4; ++ii) { const int i = 4 * i4 + ii;
                const float bb = wave_scan_incl(g4[ii], lane); const float bl = lane63(bb);
                const float qv = (i & 1) ? bfhi(qw[i >> 1]) : bflo(qw[i >> 1]), kv = (i & 1) ? bfhi(kw[i >> 1]) : bflo(kw[i >> 1]);
                qt[i] = qv * 0.08838834764831845f * __expf(bb); kt[i] = kv * __expf(-bb); kh[i] = kv * __expf(bl - bb);
                if (lane == 63) GDEC[d0 + i] = __expf(bl); } }
        { u32x4 w0, w1; w0.x = pk2(qt[0], qt[1]); w0.y = pk2(qt[2], qt[3]); w0.z = pk2(qt[4], qt[5]); w0.w = pk2(qt[6], qt[7]); w1.x = pk2(qt[8], qt[9]); w1.y = pk2(qt[10], qt[11]); w1.z = pk2(qt[12], qt[13]); w1.w = pk2(qt[14], qt[15]);
          *(LAS u32x4*)(Qs + lane * 136 + d0) = w0; *(LAS u32x4*)(Qs + lane * 136 + d0 + 8) = w1; }
        { u32x4 w0, w1; w0.x = pk2(kt[0], kt[1]); w0.y = pk2(kt[2], kt[3]); w0.z = pk2(kt[4], kt[5]); w0.w = pk2(kt[6], kt[7]); w1.x = pk2(kt[8], kt[9]); w1.y = pk2(kt[10], kt[11]); w1.z = pk2(kt[12], kt[13]); w1.w = pk2(kt[14], kt[15]);
          *(LAS u32x4*)(Ks + lane * 136 + d0) = w0; *(LAS u32x4*)(Ks + lane * 136 + d0 + 8) = w1; }
        { const int sg = d0 >> 5, hb = (d0 >> 4) & 1;
#pragma unroll
          for (int x4 = 0; x4 < 4; ++x4) { u32x2 w; w.x = pk2(qt[4 * x4], qt[4 * x4 + 1]); w.y = pk2(qt[4 * x4 + 2], qt[4 * x4 + 3]);
              *(u32x2*)(QT + lane * 128 + 32 * sg + 8 * x4 + 4 * hb) = w; } }
        { const int sc = key_perm(lane);
#pragma unroll
          for (int i = 0; i < 16; ++i) KHT[(d0 + i) * 64 + sc] = (bf16_t)f2bf(kh[i]); }
    }
    __syncthreads();
    const int fr = lane & 15, fq = lane >> 4;
#pragma unroll
    for (int h2 = 0; h2 < 2; ++h2) { const int tile = 2 * wv + h2, si = tile >> 2, ti = tile & 3;
        f32x4 acc = (f32x4){0.f, 0.f, 0.f, 0.f};
        if (si <= ti) {
#pragma unroll
            for (int kk = 0; kk < 4; ++kk) { const bf16x8_t a = *(const LAS bf16x8_t*)(Ks + (16 * si + fr) * 136 + 32 * kk + 8 * fq), bq = *(const LAS bf16x8_t*)(Qs + (16 * ti + fr) * 136 + 32 * kk + 8 * fq);
                acc = __builtin_amdgcn_mfma_f32_16x16x32_bf16(a, bq, acc, 0, 0, 0); } }
        const int t = 16 * ti + fr, s0 = 16 * si + 4 * fq;
        u32x2 w; w.x = pk2(s0 <= t ? acc[0] : 0.f, s0 + 1 <= t ? acc[1] : 0.f); w.y = pk2(s0 + 2 <= t ? acc[2] : 0.f, s0 + 3 <= t ? acc[3] : 0.f);
        *(u32x2*)(ATT + t * 64 + 32 * (si >> 1) + 8 * fq + 4 * (si & 1)) = w; }
}
constexpr int GB_QT = 0, GB_ATT = 64 * 136 * 2, GB_KHT = GB_ATT + 64 * 72 * 2, GB_GD = GB_KHT + 128 * 72 * 2, GB_V = GB_GD + 512, GB_BYTES = GB_V + 64 * 72 * 2;
struct GlaFill { u32x4 r[25]; };
__device__ __forceinline__ void gla_fill_load(GlaFill& f, const Params& p, int unit, int ptid, const bf16_t* vsrc) {
    const unsigned char* R = p.ws + OFF_R;
    const bf16_t* QT = (const bf16_t*)(R + R_QT) + (size_t)unit * 64 * 128; const bf16_t* ATT = (const bf16_t*)(R + R_ATT) + (size_t)unit * 64 * 64;
    const bf16_t* KHT = (const bf16_t*)(R + R_KHT) + (size_t)unit * 128 * 64; const float* GDEC = (const float*)(R + R_GDEC) + (size_t)unit * 128;
#pragma unroll
    for (int i = 0; i < 8; ++i) f.r[i] = *((const u32x4*)QT + ptid + 128 * i);
#pragma unroll
    for (int i = 0; i < 4; ++i) f.r[8 + i] = *((const u32x4*)ATT + ptid + 128 * i);
#pragma unroll
    for (int i = 0; i < 8; ++i) f.r[12 + i] = *((const u32x4*)KHT + ptid + 128 * i);
    f.r[20] = (u32x4){0u, 0u, 0u, 0u}; if (ptid < 32) f.r[20] = *((const u32x4*)GDEC + ptid);
#pragma unroll
    for (int i = 0; i < 4; ++i) { const int idx = ptid + 128 * i; f.r[21 + i] = *(const u32x4*)(vsrc + (size_t)(idx >> 3) * OD_IN + (idx & 7) * 8); }
}
__device__ __forceinline__ void gla_fill_store(const GlaFill& f, unsigned char* buf, int ptid) {
#pragma unroll
    for (int i = 0; i < 8; ++i) { const int idx = ptid + 128 * i; *(LAS u32x4*)(buf + GB_QT + (idx >> 4) * 272 + (idx & 15) * 16) = f.r[i]; }
#pragma unroll
    for (int i = 0; i < 4; ++i) { const int idx = ptid + 128 * i; *(LAS u32x4*)(buf + GB_ATT + (idx >> 3) * 144 + (idx & 7) * 16) = f.r[8 + i]; }
#pragma unroll
    for (int i = 0; i < 8; ++i) { const int idx = ptid + 128 * i; *(LAS u32x4*)(buf + GB_KHT + (idx >> 3) * 144 + (idx & 7) * 16) = f.r[12 + i]; }
    if (ptid < 32) *(LAS u32x4*)(buf + GB_GD + ptid * 16) = f.r[20];
#pragma unroll
    for (int i = 0; i < 4; ++i) { const int idx = ptid + 128 * i; *(LAS u32x4*)(buf + GB_V + (idx >> 3) * 144 + (idx & 7) * 16) = f.r[21 + i]; }
}
#define GLA_STEP_BARRIER() do { asm volatile("s_waitcnt lgkmcnt(0)" ::: "memory"); __builtin_amdgcn_s_barrier(); asm volatile("" ::: "memory"); } while (0)
__device__ __forceinline__ void gla_state(const Ctx& c, const Params& p, int bh, int slice) {
    const int b = bh >> 2, hd = bh & 3, lane = c.lane, wv = c.wave, fr = lane & 15, fq = lane >> 4, jl = wv & 3, jt = slice * 4 + jl;
    const bf16_t* P = (const bf16_t*)(p.ws + OFF_P); bf16_t* O = (bf16_t*)p.out;
    unsigned char* sm = c.shm;
    const size_t tb = (size_t)b * SEQ; const bf16_t* vbase = P + tb * OD_IN + 1024 + hd * 256 + 64 * slice;
    __syncthreads();
    if (wv >= 4) {
        const int pg = (wv - 4) >> 1, ptid = c.tid & 127;
        GlaFill fs;
        if (pg == 1) { gla_fill_load(fs, p, bh * 64, ptid, vbase); gla_fill_store(fs, sm, ptid); gla_fill_load(fs, p, bh * 64 + 2, ptid, vbase + (size_t)128 * OD_IN); } else gla_fill_load(fs, p, bh * 64 + 1, ptid, vbase + (size_t)64 * OD_IN);
        GLA_STEP_BARRIER();
#pragma unroll 1
        for (int ck = 0; ck < 64; ++ck) {
            if (((ck + 1) & 1) != pg && ck + 1 < 64) { gla_fill_store(fs, sm + ((ck + 1) & 1) * GB_BYTES, ptid); if (ck + 3 < 64) gla_fill_load(fs, p, bh * 64 + ck + 3, ptid, vbase + (size_t)(ck + 3) * 64 * OD_IN); }
            GLA_STEP_BARRIER();
        }
    } else if (wv < 2) {
        f32x4 S[2][8];
#pragma unroll
        for (int h = 0; h < 2; ++h)
#pragma unroll
            for (int i = 0; i < 8; ++i) S[h][i] = (f32x4){0.f, 0.f, 0.f, 0.f};
        bf16x8_t idf;
        { float iv[8];
#pragma unroll
          for (int e = 0; e < 8; ++e) iv[e] = (8 * fq + e == fr) ? 1.0f : 0.0f;
          idf = pack8(iv); }
        const int jt0 = slice * 4 + 2 * wv;
        GLA_STEP_BARRIER();
#pragma unroll 1
        for (int ck = 0; ck < 64; ++ck) {
            unsigned char* buf = sm + (ck & 1) * GB_BYTES; const size_t t0 = tb + ck * 64;
            const LAS bf16_t* QT = (const LAS bf16_t*)(buf + GB_QT); const LAS bf16_t* ATT = (const LAS bf16_t*)(buf + GB_ATT); const LAS bf16_t* KHT = (const LAS bf16_t*)(buf + GB_KHT); const LAS float* GD = (const LAS float*)(buf + GB_GD);
            const LAS bf16_t* VS = (const LAS bf16_t*)(buf + GB_V);
            bf16x8_t va[2][4], qf[4][4], af[2][4];
#pragma unroll
            for (int h = 0; h < 2; ++h)
#pragma unroll
                for (int st = 0; st < 4; ++st) { va[h][st] = zero_frag(); if (fq < 2) va[h][st] = lds_frag(VS, 72, 16 * st + fr, 32 * wv + 16 * h + 8 * fq); }
#pragma unroll
            for (int sg = 0; sg < 4; ++sg)
#pragma unroll
                for (int ti = 0; ti < 4; ++ti) qf[sg][ti] = lds_frag(QT, 136, 16 * ti + fr, 32 * sg + 8 * fq);
#pragma unroll
            for (int s2 = 0; s2 < 2; ++s2)
#pragma unroll
                for (int ti = 0; ti < 4; ++ti) af[s2][ti] = lds_frag(ATT, 72, 16 * ti + fr, 32 * s2 + 8 * fq);
            asm volatile("s_waitcnt lgkmcnt(0)" ::: "memory");
            bf16x8_t vf[2][2];
#pragma unroll
            for (int h = 0; h < 2; ++h) { f32x4 vt[4];
#pragma unroll
                for (int st = 0; st < 4; ++st) vt[st] = __builtin_amdgcn_mfma_f32_16x16x32_bf16(va[h][st], idf, (f32x4){0.f, 0.f, 0.f, 0.f}, 0, 0, 0);
#pragma unroll
                for (int s2 = 0; s2 < 2; ++s2) { const float vv[8] = {vt[2 * s2][0], vt[2 * s2][1], vt[2 * s2][2], vt[2 * s2][3], vt[2 * s2 + 1][0], vt[2 * s2 + 1][1], vt[2 * s2 + 1][2], vt[2 * s2 + 1][3]}; vf[h][s2] = pack8(vv); } }
            f32x4 acc[2][4];
#pragma unroll
            for (int h = 0; h < 2; ++h)
#pragma unroll
                for (int ti = 0; ti < 4; ++ti) acc[h][ti] = (f32x4){0.f, 0.f, 0.f, 0.f};
#pragma unroll
            for (int sg = 0; sg < 4; ++sg)
#pragma unroll
                for (int h = 0; h < 2; ++h) { const float sv[8] = {S[h][2 * sg][0], S[h][2 * sg][1], S[h][2 * sg][2], S[h][2 * sg][3], S[h][2 * sg + 1][0], S[h][2 * sg + 1][1], S[h][2 * sg + 1][2], S[h][2 * sg + 1][3]};
                    const bf16x8_t a = pack8(sv);
#pragma unroll
                    for (int ti = 0; ti < 4; ++ti) acc[h][ti] = __builtin_amdgcn_mfma_f32_16x16x32_bf16(a, qf[sg][ti], acc[h][ti], 0, 0, 0); }
#pragma unroll
            for (int s2 = 0; s2 < 2; ++s2)
#pragma unroll
                for (int h = 0; h < 2; ++h)
#pragma unroll
                    for (int ti = 0; ti < 4; ++ti) acc[h][ti] = __builtin_amdgcn_mfma_f32_16x16x32_bf16(vf[h][s2], af[s2][ti], acc[h][ti], 0, 0, 0);
#pragma unroll
            for (int h = 0; h < 2; ++h)
#pragma unroll
                for (int ti = 0; ti < 4; ++ti) { u32x2 w; w.x = pk2(acc[h][ti][0], acc[h][ti][1]); w.y = pk2(acc[h][ti][2], acc[h][ti][3]);
                    *(u32x2*)(O + (t0 + 16 * ti + fr) * 1024 + hd * 256 + 16 * (jt0 + h) + 4 * fq) = w; }
#pragma unroll
            for (int rt = 0; rt < 8; ++rt) { const f32x4 g4 = *(const LAS f32x4*)(GD + 16 * rt + 4 * fq);
                const bf16x8_t k0 = lds_frag(KHT, 72, 16 * rt + fr, 8 * fq), k1 = lds_frag(KHT, 72, 16 * rt + fr, 32 + 8 * fq);
#pragma unroll
                for (int h = 0; h < 2; ++h) { f32x4 s = S[h][rt] * g4; s = __builtin_amdgcn_mfma_f32_16x16x32_bf16(k0, vf[h][0], s, 0, 0, 0); s = __builtin_amdgcn_mfma_f32_16x16x32_bf16(k1, vf[h][1], s, 0, 0, 0); S[h][rt] = s; } }
            GLA_STEP_BARRIER();
        }
    } else {
        GLA_STEP_BARRIER();
#pragma unroll 1
        for (int ck = 0; ck < 64; ++ck) GLA_STEP_BARRIER();
    }
}
__device__ __forceinline__ void gla_finish(const Ctx& c, const Params& p) {
    const bf16_t* P = (const bf16_t*)(p.ws + OFF_P); bf16_t* O = (bf16_t*)p.out;
    const f32x4 gn = *((const f32x4*)p.od_onorm + c.lane);
    for (int r0 = c.gw; r0 < T_TOK; r0 += 2 * c.ngw) {
        u32x2 ow[2][4], gw[2][4];
#pragma unroll
        for (int q = 0; q < 2; ++q)
#pragma unroll
            for (int j = 0; j < 4; ++j) { const size_t r = (size_t)(r0 + q * c.ngw); ow[q][j] = *((const u32x2*)(O + r * 1024 + 256 * j) + c.lane); gw[q][j] = *((const u32x2*)(P + r * OD_IN + 2048 + 256 * j) + c.lane); }
#pragma unroll
        for (int q = 0; q < 2; ++q)
#pragma unroll
            for (int j = 0; j < 4; ++j) { const size_t r = (size_t)(r0 + q * c.ngw);
                const float o0 = bflo(ow[q][j].x), o1 = bfhi(ow[q][j].x), o2 = bflo(ow[q][j].y), o3 = bfhi(ow[q][j].y);
                const float ss = wave_sum(o0 * o0 + o1 * o1 + o2 * o2 + o3 * o3); const float rs = 1.0f / sqrtf(ss * (1.0f / 256.0f) + 1e-6f);
                const float g0 = bflo(gw[q][j].x), g1 = bfhi(gw[q][j].x), g2 = bflo(gw[q][j].y), g3 = bfhi(gw[q][j].y);
                u32x2 w; w.x = pk2(o0 * rs * gn.x * g0 * sigmoidf_(g0), o1 * rs * gn.y * g1 * sigmoidf_(g1)); w.y = pk2(o2 * rs * gn.z * g2 * sigmoidf_(g2), o3 * rs * gn.w * g3 * sigmoidf_(g3));
                *((u32x2*)(O + r * 1024 + 256 * j) + c.lane) = w; }
    }
}
constexpr size_t R_MG = 0, R_NT = 32 * MiB, R_QG = 64 * MiB, R_Y0 = 96 * MiB, R_Z0 = 128 * MiB, R_GAM = 160 * MiB, R_BON = 161 * MiB, R_MEMN = 164 * MiB;
constexpr size_t WSM_W2T = 0, WSM_A2T = 64 * 1024;
constexpr size_t WSM_G2T = 512 * 1024;
constexpr int XI = 64 * 72 * 2;
constexpr int X_RHS = 11 * XI, X_DIAG = X_RHS + 34816, X_TI = X_DIAG + 4352, X_RED = X_TI + 3072;

struct RxPre { u32x4 c1[2], p1[2], cr[3], pr[3]; };
__device__ __forceinline__ void rwkv_x_fetch(RxPre& f, const bf16_t* P, int b, int hd, int ck, int tid, int lane, int wv) {
    const size_t tg0 = (size_t)b * SEQ + (size_t)ck * 64; const u32x4 z = (u32x4){0u, 0u, 0u, 0u};
#pragma unroll
    for (int i = 0; i < 2; ++i) { const int task = tid + 512 * i, tt = task >> 4, q = task & 15; const bf16_t* src = P + (tg0 + tt) * EV_IN + 768 + 1536 + 8 * q;
        f.c1[i] = *(const u32x4*)src; f.p1[i] = z; if (ck * 64 + tt > 0) f.p1[i] = *(const u32x4*)(src - EV_IN); }
    const bf16_t* src = P + (tg0 + lane) * EV_IN + 768 + hd * 64 + wv * 8; const bool hp = (ck * 64 + lane > 0);
#pragma unroll
    for (int w3 = 0; w3 < 3; ++w3) { f.cr[w3] = *(const u32x4*)(src + 512 * w3); f.pr[w3] = z; if (hp) f.pr[w3] = *(const u32x4*)(src + 512 * w3 - EV_IN); }
}
__device__ __forceinline__ void rwkv_x(const Ctx& c, const Params& p, int unit, RxPre& pre, int nb, int nhd, int nck) {
    const int bh = unit >> 6, ck = unit & 63, b = bh >> 3, hd = bh & 7, tid = c.tid, lane = c.lane, wv = c.wave, fr = lane & 15, fq = lane >> 4;
    unsigned char* sm = c.shm;
    LAS bf16_t* At = (LAS bf16_t*)sm; LAS bf16_t* Bt = (LAS bf16_t*)(sm + XI); LAS bf16_t* Kt = (LAS bf16_t*)(sm + 2 * XI); LAS bf16_t* Rt = (LAS bf16_t*)(sm + 3 * XI);
    LAS bf16_t* BH = (LAS bf16_t*)(sm + 4 * XI); LAS bf16_t* KH = (LAS bf16_t*)(sm + 5 * XI); LAS bf16_t* VT = (LAS bf16_t*)(sm + 6 * XI);
    LAS bf16_t* AAB = (LAS bf16_t*)(sm + 7 * XI); LAS bf16_t* AAK = (LAS bf16_t*)(sm + 8 * XI); LAS bf16_t* ARB = (LAS bf16_t*)(sm + 9 * XI); LAS bf16_t* ARK = (LAS bf16_t*)(sm + 10 * XI);
    LAS bf16_t* XT = At;
    LAS bf16_t* YT = Kt;
    LAS float* RHS = (LAS float*)(sm + X_RHS);
    LAS float* sXW = RHS; LAS float* sXA = RHS + 64 * 68;
    LAS float* DIAG = (LAS float*)(sm + X_DIAG);
    LAS bf16_t* TI = (LAS bf16_t*)(sm + X_TI);
    LAS float* red = (LAS float*)(sm + X_RED);
    const bf16_t* P = (const bf16_t*)(p.ws + OFF_P); unsigned char* R = p.ws + OFF_R;
    const size_t tg0 = (size_t)b * SEQ + (size_t)ck * 64;
    const int t = lane, cg = wv, ch0 = hd * 64 + cg * 8;
    __syncthreads();
#pragma unroll
    for (int i = 0; i < 2; ++i) {
        const int task = tid + 512 * i, tt = task >> 4, q = task & 15;
        const int col = 1536 + 8 * q; LAS bf16_t* dst = (q < 8 ? At + tt * 72 + 8 * q : Bt + tt * 72 + 8 * (q - 8));
        const u32x4 cur = pre.c1[i], prv = pre.p1[i];
        const f32x4 m0 = *(const f32x4*)(p.ev_mu + col), m1 = *(const f32x4*)(p.ev_mu + col + 4);
        const unsigned cw[4] = {cur.x, cur.y, cur.z, cur.w}, pw[4] = {prv.x, prv.y, prv.z, prv.w}; const float mu[8] = {m0.x, m0.y, m0.z, m0.w, m1.x, m1.y, m1.z, m1.w};
        float v[8];
#pragma unroll
        for (int k = 0; k < 4; ++k) { const float c0 = bflo(cw[k]), c1 = bfhi(cw[k]), p0 = bflo(pw[k]), p1 = bfhi(pw[k]); v[2 * k] = c0 + (p0 - c0) * mu[2 * k]; v[2 * k + 1] = c1 + (p1 - c1) * mu[2 * k + 1]; }
        if (q < 8) {
#pragma unroll
            for (int k = 0; k < 8; ++k) v[k] = tanhf_(v[k]); }
        { u32x4 w; w.x = pk2(v[0], v[1]); w.y = pk2(v[2], v[3]); w.z = pk2(v[4], v[5]); w.w = pk2(v[6], v[7]); *(LAS u32x4*)dst = w; }
    }
    float rv[8], kv[8], vv[8];
    {
#pragma unroll
        for (int w3 = 0; w3 < 3; ++w3) { const u32x4 cur = pre.cr[w3], prv = pre.pr[w3];
            const f32x4 m0 = *(const f32x4*)(p.ev_mu + 512 * w3 + ch0), m1 = *(const f32x4*)(p.ev_mu + 512 * w3 + ch0 + 4);
            const unsigned cw[4] = {cur.x, cur.y, cur.z, cur.w}, pw[4] = {prv.x, prv.y, prv.z, prv.w}; const float mu[8] = {m0.x, m0.y, m0.z, m0.w, m1.x, m1.y, m1.z, m1.w};
#pragma unroll
            for (int k = 0; k < 4; ++k) { const float c0 = bflo(cw[k]), c1 = bfhi(cw[k]), p0 = bflo(pw[k]), p1 = bfhi(pw[k]);
                const float x0 = c0 + (p0 - c0) * mu[2 * k], x1 = c1 + (p1 - c1) * mu[2 * k + 1];
                if (w3 == 0) { rv[2 * k] = x0; rv[2 * k + 1] = x1; } else if (w3 == 1) { kv[2 * k] = x0; kv[2 * k + 1] = x1; } else { vv[2 * k] = x0; vv[2 * k + 1] = x1; } } }
    }
    if (nck >= 0) rwkv_x_fetch(pre, P, nb, nhd, nck, tid, lane, wv);
    __syncthreads();
    {
        const int mat = wv >> 2; const bf16_t* WT = (const bf16_t*)(p.ws + OFF_WSMALL + (mat ? WSM_A2T : WSM_W2T)); const LAS bf16_t* img = mat ? Bt : At; LAS float* dstm = mat ? sXA : sXW;
#pragma unroll
        for (int n = 0; n < 4; ++n) { const int tile = (wv & 3) * 4 + n, ct = tile >> 2, tt = tile & 3;
            f32x4 acc = (f32x4){0.f, 0.f, 0.f, 0.f};
#pragma unroll
            for (int kk = 0; kk < 2; ++kk) acc = __builtin_amdgcn_mfma_f32_16x16x32_bf16(*(const bf16x8_t*)(WT + (size_t)(hd * 64 + 16 * ct + fr) * 64 + 32 * kk + 8 * fq), lds_frag(img, 72, 16 * tt + fr, 32 * kk + 8 * fq), acc, 0, 0, 0);
            *(LAS f32x4*)(dstm + (16 * tt + fr) * 68 + 16 * ct + 4 * fq) = acc; }
    }
    __syncthreads();
    float zw[8], za[8];
    { const f32x4 a0 = *(const LAS f32x4*)(sXW + t * 68 + cg * 8), a1 = *(const LAS f32x4*)(sXW + t * 68 + cg * 8 + 4), b0 = *(const LAS f32x4*)(sXA + t * 68 + cg * 8), b1 = *(const LAS f32x4*)(sXA + t * 68 + cg * 8 + 4);
      zw[0] = a0.x; zw[1] = a0.y; zw[2] = a0.z; zw[3] = a0.w; zw[4] = a1.x; zw[5] = a1.y; zw[6] = a1.z; zw[7] = a1.w;
      za[0] = b0.x; za[1] = b0.y; za[2] = b0.z; za[3] = b0.w; za[4] = b1.x; za[5] = b1.y; za[6] = b1.z; za[7] = b1.w; }
    float lw[8], av[8], kkv[8], kp[8]; float ss = 0.f, sb = 0.f;
#pragma unroll
    for (int i = 0; i < 8; ++i) { const int ch = ch0 + i;
        const float u = -(p.ev_w0[ch] + zw[i]); const float sp = (u > 20.f) ? u : __logf(1.0f + __expf(u));
        lw[i] = -__expf(-sp - 0.5f);
        av[i] = sigmoidf_(p.ev_a0[ch] + za[i]);
        kkv[i] = kv[i] * p.ev_k_k[ch]; ss += kkv[i] * kkv[i];
        kp[i] = kv[i] * (1.0f + (av[i] - 1.0f) * p.ev_k_a[ch]);
        sb += rv[i] * kp[i] * p.ev_r_k[ch]; }
    red[t * 8 + cg] = ss; red[512 + t * 8 + cg] = sb;
    __syncthreads();
    {
        float tot = 0.f, bon = 0.f;
#pragma unroll
        for (int i = 0; i < 8; ++i) { tot += red[t * 8 + i]; bon += red[512 + t * 8 + i]; }
        if (cg == 0) ((float*)(R + R_BON))[(tg0 + t) * 8 + hd] = bon;
        const float inv = __builtin_amdgcn_rcpf(fmaxf(sqrtf(tot), 1e-12f));
        float at[8], rt_[8], bt[8], kt[8], bh_[8], kh_[8];
#pragma unroll
        for (int i = 0; i < 8; ++i) {
            const float cl = wave_scan_incl(lw[i], lane); const float cl63 = lane63(cl);
            const float e1 = __expf(cl), e0 = __expf(cl - lw[i]), en = __expf(-cl), eh = __expf(cl63 - cl);
            const float kn = kkv[i] * inv, A = -kn, Bv = kn * av[i];
            at[i] = A * e0; rt_[i] = rv[i] * e1; bt[i] = Bv * en; kt[i] = kp[i] * en; bh_[i] = Bv * eh; kh_[i] = kp[i] * eh;
            if (lane == 63) ((float*)(R + R_GAM))[(size_t)unit * 64 + cg * 8 + i] = __expf(cl63); }
        { u32x4 w; w.x = pk2(at[0], at[1]); w.y = pk2(at[2], at[3]); w.z = pk2(at[4], at[5]); w.w = pk2(at[6], at[7]); *(LAS u32x4*)(At + t * 72 + cg * 8) = w; }
        { u32x4 w; w.x = pk2(rt_[0], rt_[1]); w.y = pk2(rt_[2], rt_[3]); w.z = pk2(rt_[4], rt_[5]); w.w = pk2(rt_[6], rt_[7]); *(LAS u32x4*)(Rt + t * 72 + cg * 8) = w; }
        { u32x4 w; w.x = pk2(bt[0], bt[1]); w.y = pk2(bt[2], bt[3]); w.z = pk2(bt[4], bt[5]); w.w = pk2(bt[6], bt[7]); *(LAS u32x4*)(Bt + t * 72 + cg * 8) = w; }
        { u32x4 w; w.x = pk2(kt[0], kt[1]); w.y = pk2(kt[2], kt[3]); w.z = pk2(kt[4], kt[5]); w.w = pk2(kt[6], kt[7]); *(LAS u32x4*)(Kt + t * 72 + cg * 8) = w; }
        *(LAS f32x4*)(RHS + t * 132 + 64 + cg * 8) = (f32x4){at[0], at[1], at[2], at[3]}; *(LAS f32x4*)(RHS + t * 132 + 64 + cg * 8 + 4) = (f32x4){at[4], at[5], at[6], at[7]};
#pragma unroll
        for (int i = 0; i < 8; ++i) { BH[(cg * 8 + i) * 72 + t] = (bf16_t)f2bf(bh_[i]); KH[(cg * 8 + i) * 72 + t] = (bf16_t)f2bf(kh_[i]); VT[(cg * 8 + i) * 72 + t] = (bf16_t)f2bf(vv[i]); }
    }
    __syncthreads();
    {
        const int mat = wv >> 1;
        const LAS bf16_t* Ximg = (mat < 2) ? At : Rt; const LAS bf16_t* Yimg = (mat & 1) ? Kt : Bt;
        LAS bf16_t* Oimg = mat == 0 ? AAB : (mat == 1 ? AAK : (mat == 2 ? ARB : ARK));
#pragma unroll 4
        for (int n = 0; n < 8; ++n) { const int idx = (wv & 1) * 8 + n, si = idx >> 2, ti = idx & 3;
            f32x4 acc = (f32x4){0.f, 0.f, 0.f, 0.f};
            if (si <= ti) {
#pragma unroll
                for (int kk = 0; kk < 2; ++kk) acc = __builtin_amdgcn_mfma_f32_16x16x32_bf16(lds_frag(Yimg, 72, 16 * si + fr, 32 * kk + 8 * fq), lds_frag(Ximg, 72, 16 * ti + fr, 32 * kk + 8 * fq), acc, 0, 0, 0); }
            const int tt = 16 * ti + fr, s0 = 16 * si + 4 * fq; const int lim = (mat < 2) ? tt - 1 : tt;
            const float o0 = s0 <= lim ? acc[0] : 0.f, o1 = s0 + 1 <= lim ? acc[1] : 0.f, o2 = s0 + 2 <= lim ? acc[2] : 0.f, o3 = s0 + 3 <= lim ? acc[3] : 0.f;
            u32x2 w; w.x = pk2(o0, o1); w.y = pk2(o2, o3); *(LAS u32x2*)(Oimg + tt * 72 + s0) = w;
            if (mat == 0 && si == ti) { LAS float* d = DIAG + si * 272 + fr * 17 + 4 * fq; d[0] = o0; d[1] = o1; d[2] = o2; d[3] = o3; } }
    }
    __syncthreads();
    if (wv < 4) {
#pragma unroll
        for (int ti = 0; ti < 4; ++ti) { f32x4 acc = (f32x4){0.f, 0.f, 0.f, 0.f};
#pragma unroll
            for (int kk = 0; kk < 2; ++kk) acc = __builtin_amdgcn_mfma_f32_16x16x32_bf16(lds_frag(AAK, 72, 16 * ti + fr, 32 * kk + 8 * fq), lds_frag(VT, 72, 16 * wv + fr, 32 * kk + 8 * fq), acc, 0, 0, 0);
#pragma unroll
            for (int r = 0; r < 4; ++r) RHS[(16 * ti + 4 * fq + r) * 132 + 16 * wv + fr] = acc[r]; }
    } else if (lane < 16) { const int I = wv - 4; const LAS float* d = DIAG + I * 272; float T[16];
#pragma unroll
        for (int r = 0; r < 16; ++r) { float s = (r == lane) ? 1.f : 0.f;
#pragma unroll
            for (int q = 0; q < r; ++q) s += d[r * 17 + q] * T[q];
            T[r] = s; TI[I * 384 + r * 24 + lane] = (bf16_t)f2bf(s); } }
    __syncthreads();
#pragma unroll 1
    for (int I = 0; I < 4; ++I) {
        f32x4 acc;
#pragma unroll
        for (int r = 0; r < 4; ++r) acc[r] = RHS[(16 * I + 4 * fq + r) * 132 + 16 * wv + fr];
#pragma unroll 1
        for (int kk = 0; 32 * kk < 16 * I; ++kk) { const bool ok = (32 * kk + 8 * fq) < 16 * I;
            bf16x8_t a = zero_frag(), bq = zero_frag();
            if (ok) { a = lds_frag(AAB, 72, 16 * I + fr, 32 * kk + 8 * fq); bq = lds_frag(XT, 72, 16 * wv + fr, 32 * kk + 8 * fq); }
            acc = __builtin_amdgcn_mfma_f32_16x16x32_bf16(a, bq, acc, 0, 0, 0); }
        { u32x2 w; w.x = pk2(acc[0], acc[1]); w.y = pk2(acc[2], acc[3]); *(LAS u32x2*)(YT + (16 * wv + fr) * 24 + 4 * fq) = w; }
        LDS_WAIT();
        { bf16x8_t a = zero_frag(), bq = zero_frag();
          if (fq < 2) { a = *(const LAS bf16x8_t*)(TI + I * 384 + fr * 24 + 8 * fq); bq = *(const LAS bf16x8_t*)(YT + (16 * wv + fr) * 24 + 8 * fq); }
          f32x4 x = __builtin_amdgcn_mfma_f32_16x16x32_bf16(a, bq, (f32x4){0.f, 0.f, 0.f, 0.f}, 0, 0, 0);
          u32x2 w; w.x = pk2(x[0], x[1]); w.y = pk2(x[2], x[3]); *(LAS u32x2*)(XT + (16 * wv + fr) * 72 + 16 * I + 4 * fq) = w; }
        LDS_WAIT();
    }
    __syncthreads();
    {
        const int mat = wv >> 1;
        bf16_t* MG = (bf16_t*)(R + R_MG) + (size_t)unit * 4096; bf16_t* NT = (bf16_t*)(R + R_NT) + (size_t)unit * 4096;
        bf16_t* QG = (bf16_t*)(R + R_QG) + (size_t)unit * 4096; bf16_t* Y0G = (bf16_t*)(R + R_Y0) + (size_t)unit * 4096;
#pragma unroll 4
        for (int n = 0; n < 8; ++n) { const int idx = (wv & 1) * 8 + n, rt = idx >> 2, ct = idx & 3;
            f32x4 acc = (f32x4){0.f, 0.f, 0.f, 0.f};
            if (mat == 2) { const u32x2 r2 = *(const LAS u32x2*)(Rt + (16 * ct + fr) * 72 + 16 * rt + 4 * fq); acc = (f32x4){bflo(r2.x), bfhi(r2.x), bflo(r2.y), bfhi(r2.y)}; }
#pragma unroll
            for (int kk = 0; kk < 2; ++kk) { const int kc = 32 * kk + 8 * fq;
                if (mat == 0) acc = __builtin_amdgcn_mfma_f32_16x16x32_bf16(lds_frag(XT, 72, 64 + 16 * rt + fr, kc), lds_frag(BH, 72, 16 * ct + fr, kc), acc, 0, 0, 0);
                else if (mat == 1) { acc = __builtin_amdgcn_mfma_f32_16x16x32_bf16(lds_frag(BH, 72, 16 * rt + fr, kc), lds_frag(XT, 72, 16 * ct + fr, kc), acc, 0, 0, 0);
                                     acc = __builtin_amdgcn_mfma_f32_16x16x32_bf16(lds_frag(KH, 72, 16 * rt + fr, kc), lds_frag(VT, 72, 16 * ct + fr, kc), acc, 0, 0, 0); }
                else if (mat == 2) acc = __builtin_amdgcn_mfma_f32_16x16x32_bf16(lds_frag(XT, 72, 64 + 16 * rt + fr, kc), lds_frag(ARB, 72, 16 * ct + fr, kc), acc, 0, 0, 0);
                else { acc = __builtin_amdgcn_mfma_f32_16x16x32_bf16(lds_frag(XT, 72, 16 * rt + fr, kc), lds_frag(ARB, 72, 16 * ct + fr, kc), acc, 0, 0, 0);
                       acc = __builtin_amdgcn_mfma_f32_16x16x32_bf16(lds_frag(VT, 72, 16 * rt + fr, kc), lds_frag(ARK, 72, 16 * ct + fr, kc), acc, 0, 0, 0); } }
            u32x2 w; w.x = pk2(acc[0], acc[1]); w.y = pk2(acc[2], acc[3]);
            if (mat == 0) *(u32x2*)(MG + (16 * ct + fr) * 64 + 32 * (rt >> 1) + 8 * fq + 4 * (rt & 1)) = w;
            else if (mat == 1) *(u32x2*)(NT + (16 * ct + fr) * 64 + 16 * rt + 4 * fq) = w;
            else if (mat == 2) *(u32x2*)(QG + (16 * ct + fr) * 64 + 16 * rt + 4 * fq) = w;
            else *(u32x2*)(Y0G + (16 * ct + fr) * 64 + 16 * rt + 4 * fq) = w; }
    }
}

constexpr int RY_SLOT = 2 * 64 * 72 * 2 + 256;
struct RyFill { u32x4 m[8], n[8], g; };
__device__ __forceinline__ void rwkv_y_fetch(RyFill& f, const unsigned char* R, size_t unit, int lane) {
    const u32x4* MG = (const u32x4*)((const bf16_t*)(R + R_MG) + unit * 4096); const u32x4* NT = (const u32x4*)((const bf16_t*)(R + R_NT) + unit * 4096); const u32x4* GAM = (const u32x4*)((const float*)(R + R_GAM) + unit * 64);
#pragma unroll
    for (int i = 0; i < 8; ++i) { f.m[i] = MG[lane + 64 * i]; f.n[i] = NT[lane + 64 * i]; }
    f.g = (u32x4){0u, 0u, 0u, 0u}; if (lane < 16) f.g = GAM[lane];
}
__device__ __forceinline__ void rwkv_y_put(const RyFill& f, unsigned char* slot, int lane) {
#pragma unroll
    for (int i = 0; i < 8; ++i) { const int idx = lane + 64 * i; *(LAS u32x4*)(slot + (idx >> 3) * 144 + (idx & 7) * 16) = f.m[i]; *(LAS u32x4*)(slot + 9216 + (idx >> 3) * 144 + (idx & 7) * 16) = f.n[i]; }
    if (lane < 16) *(LAS u32x4*)(slot + 18432 + lane * 16) = f.g;
}
__device__ __forceinline__ void rwkv_y(const Ctx& c, const Params& p, int bh) {
    const int lane = c.lane, wv = c.wave, fr = lane & 15, fq = lane >> 4, jb = wv & 3, g = wv - 4; unsigned char* R = p.ws + OFF_R; unsigned char* sm = c.shm;
    f32x4 Z[4];
#pragma unroll
    for (int i = 0; i < 4; ++i) Z[i] = (f32x4){0.f, 0.f, 0.f, 0.f};
    RyFill fs;
    __syncthreads();
    if (wv >= 4) {
        if (g == 0) { rwkv_y_fetch(fs, R, (size_t)bh * 64, lane); rwkv_y_put(fs, sm, lane); rwkv_y_fetch(fs, R, (size_t)bh * 64 + 4, lane); }
        else rwkv_y_fetch(fs, R, (size_t)bh * 64 + g, lane);
    }
    __syncthreads();
#pragma unroll 1
    for (int ck = 0; ck < 64; ++ck) {
        if (wv >= 4) {
            if (((ck + 1) & 3) == g && ck + 1 < 64) { rwkv_y_put(fs, sm + ((ck + 1) & 7) * RY_SLOT, lane); if (ck + 5 < 64) rwkv_y_fetch(fs, R, (size_t)bh * 64 + ck + 5, lane); }
        } else {
            const size_t unit = (size_t)bh * 64 + ck; const unsigned char* slot = sm + (ck & 7) * RY_SLOT;
            const LAS bf16_t* MGs = (const LAS bf16_t*)slot; const LAS bf16_t* NTs = (const LAS bf16_t*)(slot + 9216); const LAS float* GMs = (const LAS float*)(slot + 18432);
            bf16x8_t mf[4][2]; u32x2 nn[4]; f32x4 gg[4];
#pragma unroll
            for (int rt = 0; rt < 4; ++rt) {
#pragma unroll
                for (int sg = 0; sg < 2; ++sg) mf[rt][sg] = lds_frag(MGs, 72, 16 * rt + fr, 32 * sg + 8 * fq);
                nn[rt] = *(const LAS u32x2*)(NTs + (16 * jb + fr) * 72 + 16 * rt + 4 * fq); gg[rt] = *(const LAS f32x4*)(GMs + 16 * rt + 4 * fq); }
            bf16_t* Z0 = (bf16_t*)(R + R_Z0) + unit * 4096;
            bf16x8_t zb[2];
#pragma unroll
            for (int sg = 0; sg < 2; ++sg) { const float zv[8] = {Z[2 * sg][0], Z[2 * sg][1], Z[2 * sg][2], Z[2 * sg][3], Z[2 * sg + 1][0], Z[2 * sg + 1][1], Z[2 * sg + 1][2], Z[2 * sg + 1][3]}; zb[sg] = pack8(zv); }
#pragma unroll
            for (int rt = 0; rt < 4; ++rt) { u32x2 w; w.x = pk2(Z[rt][0], Z[rt][1]); w.y = pk2(Z[rt][2], Z[rt][3]); *(u32x2*)(Z0 + (16 * jb + fr) * 64 + 16 * rt + 4 * fq) = w; }
            asm volatile("s_waitcnt lgkmcnt(0)" ::: "memory");
            f32x4 acc[4];
#pragma unroll
            for (int rt = 0; rt < 4; ++rt) { acc[rt] = (f32x4){bflo(nn[rt].x), bfhi(nn[rt].x), bflo(nn[rt].y), bfhi(nn[rt].y)} + gg[rt] * Z[rt];
#pragma unroll
                for (int sg = 0; sg < 2; ++sg) acc[rt] = __builtin_amdgcn_mfma_f32_16x16x32_bf16(mf[rt][sg], zb[sg], acc[rt], 0, 0, 0); }
#pragma unroll
            for (int rt = 0; rt < 4; ++rt) Z[rt] = acc[rt];
        }
        asm volatile("s_waitcnt lgkmcnt(0)" ::: "memory"); __builtin_amdgcn_s_barrier(); asm volatile("" ::: "memory");
    }
}

__device__ __forceinline__ void rwkv_z(const Ctx& c, const Params& p, int unit) {
    const int bh = unit >> 6, ck = unit & 63, b = bh >> 3, hd = bh & 7, lane = c.lane, fr = lane & 15, fq = lane >> 4; unsigned char* R = p.ws + OFF_R;
    const bf16_t* P = (const bf16_t*)(p.ws + OFF_P); bf16_t* MIX = (bf16_t*)p.out;
    const bf16_t* QG = (const bf16_t*)(R + R_QG) + (size_t)unit * 4096; const bf16_t* Y0G = (const bf16_t*)(R + R_Y0) + (size_t)unit * 4096; const bf16_t* Z0 = (const bf16_t*)(R + R_Z0) + (size_t)unit * 4096;
    const bf16_t* G2T = (const bf16_t*)(p.ws + OFF_WSMALL + WSM_G2T);
    const size_t tg0 = (size_t)b * SEQ + (size_t)ck * 64;
    f32x4 y[4][4], g[4][4];
#pragma unroll
    for (int jt = 0; jt < 4; ++jt)
#pragma unroll
        for (int tt = 0; tt < 4; ++tt) { const u32x2 w = *(const u32x2*)(Y0G + (16 * tt + fr) * 64 + 16 * jt + 4 * fq); y[jt][tt] = (f32x4){bflo(w.x), bfhi(w.x), bflo(w.y), bfhi(w.y)}; g[jt][tt] = (f32x4){0.f, 0.f, 0.f, 0.f}; }
#pragma unroll
    for (int sg = 0; sg < 2; ++sg) { bf16x8_t qb[4];
#pragma unroll
        for (int tt = 0; tt < 4; ++tt) qb[tt] = *(const bf16x8_t*)(QG + (16 * tt + fr) * 64 + 32 * sg + 8 * fq);
#pragma unroll
        for (int jt = 0; jt < 4; ++jt) { const bf16x8_t a = *(const bf16x8_t*)(Z0 + (16 * jt + fr) * 64 + 32 * sg + 8 * fq);
#pragma unroll
            for (int tt = 0; tt < 4; ++tt) y[jt][tt] = __builtin_amdgcn_mfma_f32_16x16x32_bf16(a, qb[tt], y[jt][tt], 0, 0, 0); } }
#pragma unroll 1
    for (int kk = 0; kk < 4; ++kk) { bf16x8_t sgf[4];
        const int col = 1664 + 32 * kk + 8 * fq; const f32x4 m0 = *(const f32x4*)(p.ev_mu + col), m1 = *(const f32x4*)(p.ev_mu + col + 4); const float mu[8] = {m0.x, m0.y, m0.z, m0.w, m1.x, m1.y, m1.z, m1.w};
#pragma unroll
        for (int tt = 0; tt < 4; ++tt) { const int tl = 16 * tt + fr; const bf16_t* src = P + (tg0 + tl) * EV_IN + 768 + col;
            const u32x4 cur = *(const u32x4*)src; u32x4 prv = (u32x4){0u, 0u, 0u, 0u}; if (ck * 64 + tl > 0) prv = *(const u32x4*)(src - EV_IN);
            const unsigned cw[4] = {cur.x, cur.y, cur.z, cur.w}, pw[4] = {prv.x, prv.y, prv.z, prv.w}; float v[8];
#pragma unroll
            for (int k = 0; k < 4; ++k) { const float c0 = bflo(cw[k]), c1 = bfhi(cw[k]), p0 = bflo(pw[k]), p1 = bfhi(pw[k]); v[2 * k] = sigmoidf_(c0 + (p0 - c0) * mu[2 * k]); v[2 * k + 1] = sigmoidf_(c1 + (p1 - c1) * mu[2 * k + 1]); }
            sgf[tt] = pack8(v); }
#pragma unroll
        for (int jt = 0; jt < 4; ++jt) { const bf16x8_t a = *(const bf16x8_t*)(G2T + (size_t)(hd * 64 + 16 * jt + fr) * 128 + 32 * kk + 8 * fq);
#pragma unroll
            for (int tt = 0; tt < 4; ++tt) g[jt][tt] = __builtin_amdgcn_mfma_f32_16x16x32_bf16(a, sgf[tt], g[jt][tt], 0, 0, 0); } }
#pragma unroll
    for (int tt = 0; tt < 4; ++tt) { const int tl = 16 * tt + fr;
        float s1 = 0.f;
#pragma unroll
        for (int jt = 0; jt < 4; ++jt) s1 += (y[jt][tt][0] + y[jt][tt][1]) + (y[jt][tt][2] + y[jt][tt][3]);
        s1 += __shfl_xor(s1, 16); s1 += __shfl_xor(s1, 32); const float mean = s1 * (1.0f / 64.0f);
        float s2 = 0.f;
#pragma unroll
        for (int jt = 0; jt < 4; ++jt)
#pragma unroll
            for (int r = 0; r < 4; ++r) { const float d = y[jt][tt][r] - mean; s2 += d * d; }
        s2 += __shfl_xor(s2, 16); s2 += __shfl_xor(s2, 32); const float rs = 1.0f / sqrtf(s2 * (1.0f / 64.0f) + 64e-5f);
        const float bon = ((const float*)(R + R_BON))[(tg0 + tl) * 8 + hd]; const bool hp = (ck * 64 + tl > 0);
#pragma unroll
        for (int jt = 0; jt < 4; ++jt) { const int ch = hd * 64 + 16 * jt + 4 * fq;
            const bf16_t* src = P + (tg0 + tl) * EV_IN + 768 + 1024 + ch; const u32x2 cur = *(const u32x2*)src; u32x2 prv; prv.x = 0u; prv.y = 0u; if (hp) prv = *(const u32x2*)(src - EV_IN);
            const f32x4 mu = *(const f32x4*)(p.ev_mu + 1024 + ch), lw4 = *(const f32x4*)(p.ev_lnx_w + ch), lb4 = *(const f32x4*)(p.ev_lnx_b + ch);
            const float c0 = bflo(cur.x), c1 = bfhi(cur.x), c2 = bflo(cur.y), c3 = bfhi(cur.y), p0 = bflo(prv.x), p1 = bfhi(prv.x), p2 = bflo(prv.y), p3 = bfhi(prv.y);
            const float v0 = c0 + (p0 - c0) * mu.x, v1 = c1 + (p1 - c1) * mu.y, v2 = c2 + (p2 - c2) * mu.z, v3 = c3 + (p3 - c3) * mu.w;
            const f32x4 yy = y[jt][tt], gg = g[jt][tt];
            const float o0 = ((yy[0] - mean) * rs * lw4.x + lb4.x + bon * v0) * gg[0], o1 = ((yy[1] - mean) * rs * lw4.y + lb4.y + bon * v1) * gg[1];
            const float o2 = ((yy[2] - mean) * rs * lw4.z + lb4.z + bon * v2) * gg[2], o3 = ((yy[3] - mean) * rs * lw4.w + lb4.w + bon * v3) * gg[3];
            u32x2 w; w.x = pk2(o0, o1); w.y = pk2(o2, o3); *(u32x2*)(MIX + (tg0 + tl) * 1024 + 512 + ch) = w; } }
}

__device__ __forceinline__ void xattn_mfma(const Ctx& c, const Params& p, int unit) {
    const int b = unit >> 5, hh = (unit >> 3) & 3, tblk = unit & 7, tid = c.tid, lane = c.lane, wv = c.wave, fr = lane & 15, fq = lane >> 4;
    LAS bf16_t* Ks = (LAS bf16_t*)c.shm;
    LAS bf16_t* VTp = (LAS bf16_t*)(c.shm + 256 * 272);
    const bf16_t* MKV = (const bf16_t*)(p.ws + OFF_MKV); const bf16_t* Q = (const bf16_t*)(p.ws + OFF_P); bf16_t* OA = (bf16_t*)(p.ws + OFF_P + 32 * MiB);
    __syncthreads();
    {
        u32x4 dd[16];
#pragma unroll
        for (int i = 0; i < 16; ++i) { const int task = tid + 512 * i, which = task >> 12, r = (task >> 4) & 255, ck = task & 15;
            dd[i] = *(const u32x4*)(MKV + ((size_t)b * MEMLEN + r) * 1024 + which * 512 + hh * 128 + ck * 8); }
#pragma unroll
        for (int i = 0; i < 16; ++i) { const int task = tid + 512 * i, which = task >> 12, r = (task >> 4) & 255, ck = task & 15; const u32x4 d = dd[i];
            if (which == 0) *(LAS u32x4*)(Ks + r * 136 + ck * 8) = d;
            else { const int kc = key_perm(r); const unsigned w[4] = {d.x, d.y, d.z, d.w};
#pragma unroll
                for (int k = 0; k < 4; ++k) { VTp[(ck * 8 + 2 * k) * 264 + kc] = (bf16_t)(w[k] & 0xFFFFu); VTp[(ck * 8 + 2 * k + 1) * 264 + kc] = (bf16_t)(w[k] >> 16); } } }
    }
    __syncthreads();
#pragma unroll 1
    for (int qt = 0; qt < 4; ++qt) {
        const size_t tq = (size_t)b * SEQ + tblk * 512 + wv * 64 + qt * 16 + fr;
        bf16x8_t qf[4];
#pragma unroll
        for (int kk = 0; kk < 4; ++kk) qf[kk] = *(const bf16x8_t*)(Q + tq * 512 + hh * 128 + 32 * kk + 8 * fq);
        float qsc;
        { const f32x4* sp = (const f32x4*)((const float*)(p.ws + OFF_R + R_SSP) + tq * 16); const f32x4 s0 = sp[0], s1 = sp[1], s2 = sp[2], s3 = sp[3];
          const float ssq = ((s0.x + s0.y) + (s0.z + s0.w)) + ((s1.x + s1.y) + (s1.z + s1.w)) + ((s2.x + s2.y) + (s2.z + s2.w)) + ((s3.x + s3.y) + (s3.z + s3.w));
          qsc = 0.08838834764831845f / sqrtf(ssq * (1.0f / 1024.0f) + 1e-6f); }
        f32x4 s[16];
#pragma unroll
        for (int kt = 0; kt < 16; ++kt) { s[kt] = (f32x4){0.f, 0.f, 0.f, 0.f};
#pragma unroll
            for (int kk = 0; kk < 4; ++kk) s[kt] = __builtin_amdgcn_mfma_f32_16x16x32_bf16(lds_frag(Ks, 136, 16 * kt + fr, 32 * kk + 8 * fq), qf[kk], s[kt], 0, 0, 0);
            if (kt & 1) __builtin_amdgcn_sched_barrier(0); }
        float m = s[0][0];
#pragma unroll
        for (int kt = 0; kt < 16; ++kt) m = fmaxf(fmaxf(fmaxf(m, s[kt][0]), fmaxf(s[kt][1], s[kt][2])), s[kt][3]);
        m = fmaxf(m, __shfl_xor(m, 16)); m = fmaxf(m, __shfl_xor(m, 32));
        float den = 0.f;
#pragma unroll
        for (int kt = 0; kt < 16; ++kt)
#pragma unroll
            for (int r = 0; r < 4; ++r) { const float e = __expf((s[kt][r] - m) * qsc); s[kt][r] = e; den += e; }
        den += __shfl_xor(den, 16); den += __shfl_xor(den, 32);
        f32x4 o[8];
#pragma unroll
        for (int dt = 0; dt < 8; ++dt) o[dt] = (f32x4){0.f, 0.f, 0.f, 0.f};
#pragma unroll
        for (int sg = 0; sg < 8; ++sg) { const float pv[8] = {s[2 * sg][0], s[2 * sg][1], s[2 * sg][2], s[2 * sg][3], s[2 * sg + 1][0], s[2 * sg + 1][1], s[2 * sg + 1][2], s[2 * sg + 1][3]};
            const bf16x8_t pb = pack8(pv);
#pragma unroll
            for (int dt = 0; dt < 8; ++dt) o[dt] = __builtin_amdgcn_mfma_f32_16x16x32_bf16(lds_frag(VTp, 264, 16 * dt + fr, 32 * sg + 8 * fq), pb, o[dt], 0, 0, 0);
            __builtin_amdgcn_sched_barrier(0); }
        const float inv = 1.0f / den;
#pragma unroll
        for (int dt = 0; dt < 8; ++dt) { u32x2 w; w.x = pk2(o[dt][0] * inv, o[dt][1] * inv); w.y = pk2(o[dt][2] * inv, o[dt][3] * inv); *(u32x2*)(OA + tq * 512 + hh * 128 + 16 * dt + 4 * fq) = w; }
    }
}
__device__ __forceinline__ void swa_mfma(const Ctx& c, const Params& p, int unit) {
    const int b = unit >> 6, g = (unit >> 5) & 1, n = unit & 31, tid = c.tid, lane = c.lane, wv = c.wave, fr = lane & 15, fq = lane >> 4;
    LAS bf16_t* Ks = (LAS bf16_t*)c.shm;
    LAS bf16_t* VTp = (LAS bf16_t*)(c.shm + 256 * 144);
    const bf16_t* P = (const bf16_t*)(p.ws + OFF_P); bf16_t* MIX = (bf16_t*)p.out;
    __syncthreads();
    {
        u32x4 dd[8];
#pragma unroll
        for (int i = 0; i < 8; ++i) { const int task = tid + 512 * i, which = task >> 11, r = (task >> 3) & 255, ck = task & 7; const int tk = n * 128 - 128 + r;
            dd[i] = (u32x4){0u, 0u, 0u, 0u}; if (tk >= 0) dd[i] = *(const u32x4*)(P + ((size_t)b * SEQ + tk) * EV_IN + 512 + which * 128 + g * 64 + ck * 8); }
#pragma unroll
        for (int i = 0; i < 8; ++i) { const int task = tid + 512 * i, which = task >> 11, r = (task >> 3) & 255, ck = task & 7; const u32x4 d = dd[i];
            if (which == 0) *(LAS u32x4*)(Ks + r * 72 + ck * 8) = d;
            else { const int kc = key_perm(r); const unsigned w[4] = {d.x, d.y, d.z, d.w};
#pragma unroll
                for (int k = 0; k < 4; ++k) { VTp[(ck * 8 + 2 * k) * 264 + kc] = (bf16_t)(w[k] & 0xFFFFu); VTp[(ck * 8 + 2 * k + 1) * 264 + kc] = (bf16_t)(w[k] >> 16); } } }
    }
    __syncthreads();
#pragma unroll 1
    for (int it = 0; it < 4; ++it) {
        const int tile = wv * 4 + it, hql = tile >> 3, qb = tile & 7, head = g * 4 + hql, sg0 = qb >> 1;
        const int qi = 16 * qb + fr; const size_t tq = (size_t)b * SEQ + n * 128 + qi;
        const float sink = p.ev_sinks[head];
        bf16x8_t qf[2];
#pragma unroll
        for (int kk = 0; kk < 2; ++kk) qf[kk] = *(const bf16x8_t*)(P + tq * EV_IN + head * 64 + 32 * kk + 8 * fq);
        f32x4 s[10]; float m = sink;
#pragma unroll
        for (int i = 0; i < 10; ++i) { const int kt = 2 * sg0 + i; s[i] = (f32x4){0.f, 0.f, 0.f, 0.f};
#pragma unroll
            for (int kk = 0; kk < 2; ++kk) s[i] = __builtin_amdgcn_mfma_f32_16x16x32_bf16(lds_frag(Ks, 72, 16 * kt + fr, 32 * kk + 8 * fq), qf[kk], s[i], 0, 0, 0);
#pragma unroll
            for (int r = 0; r < 4; ++r) { const int kp = 16 * kt + 4 * fq + r; const bool valid = (kp >= qi + 1) && (kp <= qi + 128) && (n > 0 || kp >= 128);
                s[i][r] = valid ? s[i][r] * 0.125f : -INFINITY; m = fmaxf(m, s[i][r]); } }
        m = fmaxf(m, __shfl_xor(m, 16)); m = fmaxf(m, __shfl_xor(m, 32));
        float den = 0.f;
#pragma unroll
        for (int i = 0; i < 10; ++i)
#pragma unroll
            for (int r = 0; r < 4; ++r) { const float e = __expf(s[i][r] - m); s[i][r] = e; den += e; }
        den += __shfl_xor(den, 16); den += __shfl_xor(den, 32); den += __expf(sink - m);
        f32x4 o[4];
#pragma unroll
        for (int dt = 0; dt < 4; ++dt) o[dt] = (f32x4){0.f, 0.f, 0.f, 0.f};
#pragma unroll
        for (int i2 = 0; i2 < 5; ++i2) { const float pv[8] = {s[2 * i2][0], s[2 * i2][1], s[2 * i2][2], s[2 * i2][3], s[2 * i2 + 1][0], s[2 * i2 + 1][1], s[2 * i2 + 1][2], s[2 * i2 + 1][3]};
            const bf16x8_t pb = pack8(pv);
#pragma unroll
            for (int dt = 0; dt < 4; ++dt) o[dt] = __builtin_amdgcn_mfma_f32_16x16x32_bf16(lds_frag(VTp, 264, 16 * dt + fr, 32 * (sg0 + i2) + 8 * fq), pb, o[dt], 0, 0, 0); }
        const float inv = 1.0f / den;
#pragma unroll
        for (int dt = 0; dt < 4; ++dt) { u32x2 w; w.x = pk2(o[dt][0] * inv, o[dt][1] * inv); w.y = pk2(o[dt][2] * inv, o[dt][3] * inv); *(u32x2*)(MIX + tq * 1024 + head * 64 + 16 * dt + 4 * fq) = w; }
    }
}

constexpr size_t WSM_RT = 640 * 1024;
constexpr size_t CTL_WGCNT = 256 * 1024;
__device__ __forceinline__ void split8(const f32x4 a, const f32x4 b, bf16x8_t& hi, bf16x8_t& lo) {
    const float x[8] = {a.x, a.y, a.z, a.w, b.x, b.y, b.z, b.w}; float h[8], l[8];
#pragma unroll
    for (int i = 0; i < 8; ++i) { h[i] = bf2f(f2bf(x[i])); l[i] = x[i] - h[i]; }
    hi = pack8(h); lo = pack8(l);
}
__device__ __forceinline__ void moe_route(const Ctx& c, const Params& p, int layer) {
    const int lane = c.lane, wv = c.wave, fr = lane & 15, fq = lane >> 4;
    LAS float* LG = (LAS float*)c.shm + wv * (16 * 48 + 16);
    LAS float* RS = LG + 16 * 48;
    LAS int* hist = (LAS int*)(c.shm + 32 * 1024);
    if (c.tid < 32) hist[c.tid] = 0;
    __syncthreads();
    const int t0 = blockIdx.x * 128 + wv * 16;
    const bf16_t* xr = (const bf16_t*)(p.ws + OFF_H) + (size_t)(t0 + fr) * 1024 + 8 * fq;
    const bf16_t* TH = (const bf16_t*)(p.ws + OFF_WSMALL + WSM_RT) + (size_t)layer * 2 * 48 * 1024; const bf16_t* TL = TH + 48 * 1024;
    f32x4 acc[3];
#pragma unroll
    for (int i = 0; i < 3; ++i) acc[i] = (f32x4){0.f, 0.f, 0.f, 0.f};
    float ss = 0.f;
#pragma unroll 4
    for (int kk = 0; kk < 32; ++kk) {
        const u32x4 xw = *(const u32x4*)(xr + 32 * kk); const bf16x8_t xh = __builtin_bit_cast(bf16x8_t, xw);
        { const float x0 = bflo(xw.x), x1 = bfhi(xw.x), x2 = bflo(xw.y), x3 = bfhi(xw.y), x4 = bflo(xw.z), x5 = bfhi(xw.z), x6 = bflo(xw.w), x7 = bfhi(xw.w);
          ss += (x0 * x0 + x1 * x1) + (x2 * x2 + x3 * x3) + (x4 * x4 + x5 * x5) + (x6 * x6 + x7 * x7); }
#pragma unroll
        for (int ct = 0; ct < 3; ++ct) { const bf16x8_t wh = *(const bf16x8_t*)(TH + (size_t)(16 * ct + fr) * 1024 + 32 * kk + 8 * fq), wl = *(const bf16x8_t*)(TL + (size_t)(16 * ct + fr) * 1024 + 32 * kk + 8 * fq);
            acc[ct] = __builtin_amdgcn_mfma_f32_16x16x32_bf16(xh, wh, acc[ct], 0, 0, 0); acc[ct] = __builtin_amdgcn_mfma_f32_16x16x32_bf16(xh, wl, acc[ct], 0, 0, 0); }
    }
    ss += __shfl_xor(ss, 16); ss += __shfl_xor(ss, 32);
    const float rstd = 1.0f / sqrtf(ss * (1.0f / 1024.0f) + 1e-6f);
    if (fq == 0) RS[fr] = rstd;
    LDS_WAIT();
#pragma unroll
    for (int ct = 0; ct < 3; ++ct)
#pragma unroll
        for (int r = 0; r < 4; ++r) LG[(4 * fq + r) * 48 + 16 * ct + fr] = acc[ct][r] * RS[4 * fq + r];
    LDS_WAIT();
    if (lane < 16) { int e0, e1; float g0, g1; route_row(LG + lane * 48, p.moe_b_group + layer * 4, p.moe_b_expert + layer * 32, e0, e1, g0, g1);
        const int t = t0 + lane; ((float*)(p.ws + OFF_ROUTE + ROUTE_RS))[t] = RS[lane]; ((int2*)(p.ws + OFF_ROUTE))[t] = make_int2(e0, e1); ((float2*)(p.ws + OFF_ROUTE + 256 * 1024))[t] = make_float2(g0, g1);
        atomicAdd((int*)&hist[e0], 1); atomicAdd((int*)&hist[e1], 1); }
    __syncthreads();
    if (c.tid < 32) ((int*)(p.ws + OFF_CTL + CTL_WGCNT))[(layer * 256 + blockIdx.x) * 32 + c.tid] = hist[c.tid];
}
__device__ __forceinline__ void moe_slots2(const Ctx& c, const Params& p, int layer) {
    LAS int* part = (LAS int*)c.shm;
    LAS int* base = part + 1024;
    LAS int* lcnt = base + 32;
    LAS int* posl = lcnt + 32;
    LAS int* pst = posl + 256;
    const int* wc = (const int*)(p.ws + OFF_CTL + CTL_WGCNT) + layer * 256 * 32; const int bid = blockIdx.x;
    __syncthreads();
    { const int e = c.tid & 31, pt = c.tid >> 5; int sa = 0, sb = 0;
      for (int w = pt * 16; w < pt * 16 + 16; ++w) { const int v = wc[w * 32 + e]; sa += v; sb += (w < bid) ? v : 0; }
      part[pt * 32 + e] = sa; part[512 + pt * 32 + e] = sb; }
    if (c.tid < 32) lcnt[c.tid] = 0;
    __syncthreads();
    if (c.tid < 32) { int sa = 0, sb = 0; for (int q = 0; q < 16; ++q) { sa += part[q * 32 + c.tid]; sb += part[512 + q * 32 + c.tid]; } part[c.tid] = sa; part[512 + c.tid] = sb; }
    __syncthreads();
    if (c.tid == 0) { int acc = 0; for (int e = 0; e < NEXP; ++e) { pst[e] = acc; acc += (part[e] + 255) / 256 * 256; } pst[32] = acc; }
    __syncthreads();
    if (c.tid < 32) base[c.tid] = pst[c.tid] + part[512 + c.tid];
    if (bid == 0 && c.tid < NEXP) { int* blk = (int*)(p.ws + OFF_CTL + CTL_BLK) + layer * 1024; const int e = c.tid, s = pst[e] / 256, en = pst[e + 1] / 256; for (int i = s; i < en; ++i) blk[1 + i] = e; if (e == 0) blk[0] = pst[32] / 256; }
    __syncthreads();
    if (c.tid < 256) { const int t = bid * 128 + (c.tid >> 1); const int2 ee = ((const int2*)(p.ws + OFF_ROUTE))[t]; const int e = (c.tid & 1) ? ee.y : ee.x;
        const int rk = atomicAdd((int*)&lcnt[e], 1); posl[c.tid] = base[e] + rk; }
    __syncthreads();
    if (c.tid < 128) ((int2*)(p.ws + OFF_ROUTE + 512 * 1024))[bid * 128 + c.tid] = make_int2(posl[2 * c.tid], posl[2 * c.tid + 1]);
    if (c.tid < 256) ((float*)(p.ws + OFF_R + R_RSS))[posl[c.tid]] = ((const float*)(p.ws + OFF_ROUTE + ROUTE_RS))[bid * 128 + (c.tid >> 1)];
    int* TOK = (int*)(p.ws + OFF_R + R_TOK);
    if (c.tid < 256) TOK[posl[c.tid]] = bid * 128 + (c.tid >> 1);
    if (bid == 0) { for (int e = 0; e < NEXP; ++e) { const int s = pst[e] + part[e], en = pst[e + 1]; for (int i = s + c.tid; i < en; i += 512) TOK[i] = 0; } }
}

constexpr size_t WSM_TGD = 128 * 1024, WSM_GUT = 192 * 1024;
__device__ __forceinline__ void combine_gk(const Ctx& c, const Params& p) {
    const int lane = c.lane, wv = c.wave, fr = lane & 15, fq = lane >> 4;
    LAS float* LG = (LAS float*)c.shm + wv * (16 * 16 + 16);
    LAS float* RS = LG + 256;
    const int t0 = blockIdx.x * 128 + wv * 16; const int trow = t0 + fr;
    bf16_t* hr = (bf16_t*)(p.ws + OFF_H) + (size_t)trow * 1024 + 8 * fq;
    const int2 ps = ((const int2*)(p.ws + OFF_ROUTE + 512 * 1024))[trow]; const float2 gt = ((const float2*)(p.ws + OFF_ROUTE + 256 * 1024))[trow];
    const bf16_t* y0 = (const bf16_t*)(p.ws + OFF_P) + (size_t)ps.x * 1024 + 8 * fq; const bf16_t* y1 = (const bf16_t*)(p.ws + OFF_P) + (size_t)ps.y * 1024 + 8 * fq;
    const bf16_t* TH = (const bf16_t*)(p.ws + OFF_WSMALL + WSM_TGD); const bf16_t* TL = TH + 16 * 1024;
    f32x4 acc = (f32x4){0.f, 0.f, 0.f, 0.f}; float ss = 0.f;
#pragma unroll 4
    for (int kk = 0; kk < 32; ++kk) {
        const u32x4 xw = *(const u32x4*)(hr + 32 * kk), u0 = *(const u32x4*)(y0 + 32 * kk), u1 = *(const u32x4*)(y1 + 32 * kk);
        f32x4 a, bq;
        a.x = bflo(xw.x) + gt.x * bflo(u0.x) + gt.y * bflo(u1.x); a.y = bfhi(xw.x) + gt.x * bfhi(u0.x) + gt.y * bfhi(u1.x); a.z = bflo(xw.y) + gt.x * bflo(u0.y) + gt.y * bflo(u1.y); a.w = bfhi(xw.y) + gt.x * bfhi(u0.y) + gt.y * bfhi(u1.y);
        bq.x = bflo(xw.z) + gt.x * bflo(u0.z) + gt.y * bflo(u1.z); bq.y = bfhi(xw.z) + gt.x * bfhi(u0.z) + gt.y * bfhi(u1.z); bq.z = bflo(xw.w) + gt.x * bflo(u0.w) + gt.y * bflo(u1.w); bq.w = bfhi(xw.w) + gt.x * bfhi(u0.w) + gt.y * bfhi(u1.w);
        { u32x4 w; w.x = pk2(a.x, a.y); w.y = pk2(a.z, a.w); w.z = pk2(bq.x, bq.y); w.w = pk2(bq.z, bq.w); *(u32x4*)(hr + 32 * kk) = w; }
        ss += (a.x * a.x + a.y * a.y) + (a.z * a.z + a.w * a.w) + (bq.x * bq.x + bq.y * bq.y) + (bq.z * bq.z + bq.w * bq.w);
        bf16x8_t xh, xl; split8(a, bq, xh, xl);
        const bf16x8_t wh = *(const bf16x8_t*)(TH + (size_t)fr * 1024 + 32 * kk + 8 * fq), wl = *(const bf16x8_t*)(TL + (size_t)fr * 1024 + 32 * kk + 8 * fq);
        acc = __builtin_amdgcn_mfma_f32_16x16x32_bf16(xh, wh, acc, 0, 0, 0); acc = __builtin_amdgcn_mfma_f32_16x16x32_bf16(xh, wl, acc, 0, 0, 0); acc = __builtin_amdgcn_mfma_f32_16x16x32_bf16(xl, wh, acc, 0, 0, 0);
    }
    ss += __shfl_xor(ss, 16); ss += __shfl_xor(ss, 32);
    const float rstd = 1.0f / sqrtf(ss * (1.0f / 1024.0f) + 1e-6f);
    if (fq == 0) { RS[fr] = rstd; ((float*)(p.ws + OFF_ROUTE + ROUTE_RS))[trow] = rstd; }
    LDS_WAIT();
#pragma unroll
    for (int r = 0; r < 4; ++r) LG[(4 * fq + r) * 16 + fr] = acc[r] * RS[4 * fq + r];
    LDS_WAIT();
    bf16x8_t gh = zero_frag(), gl = zero_frag();
    if (fq < 2) { const f32x4 a = *(const LAS f32x4*)(LG + fr * 16 + 8 * fq), bq = *(const LAS f32x4*)(LG + fr * 16 + 8 * fq + 4); split8(a, bq, gh, gl); }
    const bf16_t* UH = (const bf16_t*)(p.ws + OFF_WSMALL + WSM_GUT); const bf16_t* UL = UH + 512 * 16;
    float* gk = (float*)(p.ws + OFF_R + R_GK) + (size_t)trow * 512 + 4 * fq;
#pragma unroll 4
    for (int ct = 0; ct < 32; ++ct) {
        bf16x8_t uh = zero_frag(), ul = zero_frag();
        if (fq < 2) { uh = *(const bf16x8_t*)(UH + (16 * ct + fr) * 16 + 8 * fq); ul = *(const bf16x8_t*)(UL + (16 * ct + fr) * 16 + 8 * fq); }
        f32x4 g = *(const f32x4*)(p.od_gate_b + 16 * ct + 4 * fq);
        g = __builtin_amdgcn_mfma_f32_16x16x32_bf16(uh, gh, g, 0, 0, 0); g = __builtin_amdgcn_mfma_f32_16x16x32_bf16(uh, gl, g, 0, 0, 0); g = __builtin_amdgcn_mfma_f32_16x16x32_bf16(ul, gh, g, 0, 0, 0);
#pragma unroll
        for (int r = 0; r < 4; ++r) { const float xx = g[r]; g[r] = (fminf(xx, 0.f) - __logf(1.0f + __expf(-fabsf(xx)))) * (1.0f / 16.0f); }
        *(f32x4*)(gk + 16 * ct) = g;
    }
}

constexpr int LDS_BYTES = 160 * 1024 - 64;
constexpr int N_PHASES = 25;

typedef const __attribute__((address_space(4))) Params* KParamsPtr;
__device__ __forceinline__ Params kparams() {
#if defined(__HIP_DEVICE_COMPILE__)
    KParamsPtr k = (KParamsPtr)__builtin_amdgcn_kernarg_segment_ptr(); asm volatile("" : "+s"(k)); return *k;
#else
    return Params{};
#endif
}
__device__ __forceinline__ Ctx mkctx(unsigned char* shm) {
    int tz = threadIdx.x; asm volatile("" : "+v"(tz));
    Ctx c; c.tid = tz; c.wave = __builtin_amdgcn_readfirstlane(tz >> 6); c.lane = tz & 63; c.gw = blockIdx.x * 8 + c.wave; c.ngw = 2048; c.shm = shm; return c;
}
__global__ void __launch_bounds__(512, 2) hybrid_fwd(Params p_in) {
    extern __shared__ __attribute__((aligned(16))) unsigned char shm[];
    constexpr int G = 256; const int bid = blockIdx.x;
    uint4* xbw = (uint4*)(shm + LDS_BYTES - 16);
    if (threadIdx.x == 0) *xbw = make_uint4(0u, 0u, 0u, 0u);
    __syncthreads();
    XcdBarrier bar = xcd_barrier_post((unsigned*)(kparams().ws + OFF_CTL), (volatile LAS unsigned*)xbw);
#ifndef KEEPMASK
#define KEEPMASK 0xFFFFFFFFu
#endif
#define INS(k, s) (((KEEPMASK) >> (s)) & 1u)
#ifndef REPMASK
#define REPMASK 0u
#endif
#define REP(s) ((((REPMASK) >> (s)) & 1u) ? 3 : 1)
#define SEAM(k) do { XcdBarrier b2 = bar; b2.bar = (unsigned*)(kparams().ws + OFF_CTL); xcd_barrier(b2); } while (0)
#define PHASE_BEGIN const Params p = kparams(); const Ctx c = mkctx(shm); unsigned char* const ws = p.ws; (void)c; (void)ws;
#define glds ((PG8_LAS unsigned char*)shm)
#define WD ((bf16_t*)(ws + OFF_WD))
#define H ((bf16_t*)(ws + OFF_H))
#define P ((bf16_t*)(ws + OFF_P))
#define WS_F ((float*)(ws + OFF_WSMALL))
#define RE ((int2*)(ws + OFF_ROUTE))
#define RG ((float2*)(ws + OFF_ROUTE + 256 * 1024))
#define RP ((int2*)(ws + OFF_ROUTE + 512 * 1024))

    for (int layer = 0; layer < 2; ++layer) {
        const int pb = layer * 12;
        if (layer == 0) {
            if (INS(0, 0)) for (int rep_ = 0; rep_ < REP(0); ++rep_) { PHASE_BEGIN
                tr_matrix(c, p.ev_w_in, EV_IN, 0, 1024, EV_IN, WD + WE_EV_IN, 0, 0);
                tr_matrix(c, p.ev_w_out, 1024, 0, 1024, 1024, WD + WE_EV_OUT, 0, 0);
                tr_matrix(c, p.od_w_in, OD_IN_SRC, 0, 1024, OD_IN, WD + WE_OD_IN, 0, 1, p.norm_mix + 1024);
                tr_matrix(c, p.od_w_out, 1024, 0, 1024, 1024, WD + WE_OD_OUT, 0, 0);
                tr_matrix(c, p.mem_wk, 512, 0, 1024, 512, WD + WE_MKV, 0, 0);
                tr_matrix(c, p.mem_wv, 512, 0, 1024, 512, WD + WE_MKV, 512, 0);
                for (int l = 0; l < 2; ++l) {
                    tr_matrix(c, p.xa_wq + (size_t)l * 1024 * 512, 512, 0, 1024, 512, WD + WE_WQ + (size_t)l * 512 * 1024, 0, 0, p.norm_xattn + l * 1024);
                    tr_matrix(c, p.xa_wo + (size_t)l * 512 * 1024, 1024, 0, 512, 1024, WD + WE_WO + (size_t)l * 1024 * 512, 0, 0);
                }
                for (int i = bid * 512 + c.tid; i < 16 * 1024 + 512 * 16; i += G * 512) {
                    if (i < 16 * 1024) { const int o = i >> 10, k = i & 1023; const float w = p.od_w_in[(size_t)k * OD_IN_SRC + 2048 + o] * p.norm_mix[1024 + k]; const unsigned hb = f2bf(w);
                        bf16_t* T = (bf16_t*)(ws + OFF_WSMALL + WSM_TGD); T[i] = (bf16_t)hb; T[16 * 1024 + i] = (bf16_t)f2bf(w - bf2f(hb)); }
                    else { const int r = i - 16 * 1024, ch = r >> 4, o = r & 15; const float w = p.od_gate_up[o * 512 + ch]; const unsigned hb = f2bf(w);
                        bf16_t* T = (bf16_t*)(ws + OFF_WSMALL + WSM_GUT); T[r] = (bf16_t)hb; T[512 * 16 + r] = (bf16_t)f2bf(w - bf2f(hb)); } }
                for (int i = bid * 512 + c.tid; i < 2 * 48 * 1024; i += G * 512) { const int l = i / (48 * 1024), r = i % (48 * 1024), o = r >> 10, k = r & 1023;
                    float w = 0.f; if (o < 4) w = p.moe_w_group[((size_t)l * 1024 + k) * 4 + o]; else if (o < 36) w = p.moe_w_expert[((size_t)l * 1024 + k) * 32 + (o - 4)];
                    w *= p.norm_moe[l * 1024 + k]; const unsigned hb = f2bf(w); bf16_t* T = (bf16_t*)(ws + OFF_WSMALL + WSM_RT) + (size_t)l * 2 * 48 * 1024;
                    T[r] = (bf16_t)hb; T[48 * 1024 + r] = (bf16_t)f2bf(w - bf2f(hb)); }
                for (int i = bid * 512 + c.tid; i < 2 * 512 * 64; i += G * 512) { const int wh = i >> 15, r = i & 32767, ch = r >> 6, k = r & 63;
                    ((bf16_t*)(ws + OFF_WSMALL + (wh ? WSM_A2T : WSM_W2T)))[r] = (bf16_t)f2bf((wh ? p.ev_a2 : p.ev_w2)[(size_t)k * 512 + ch]); }
                norm_plain(c, p.mem, p.mem_norm, (bf16_t*)(ws + OFF_R + R_MEMN), NB * MEMLEN);
                for (int i = bid * 512 + c.tid; i < 512 * 128; i += G * 512) { const int ch = i >> 7, m = i & 127; ((bf16_t*)(ws + OFF_WSMALL + WSM_G2T))[i] = (bf16_t)f2bf(p.ev_g2[(size_t)m * 512 + ch]); }
                norm_plain(c, p.x, p.norm_mix, H, T_TOK);
                __syncthreads();
                SEAM(0);
            }
            if (INS(1, 1)) for (int rep_ = 0; rep_ < REP(1); ++rep_) { PHASE_BEGIN
                { pg8::Gemm g{H, WD + WE_EV_IN, T_TOK, EV_IN, 1024, 0}; pg8::StaticOrder S; S.init(T_TOK, EV_IN, G, bid);
                  pg8::EpiB16 E{P, EV_IN, nullptr}; pg8::gemm_phase<pg8::EpiB16, pg8::StaticOrder, true, true>(glds, g, S, E); }
                SEAM(1);
            }
            if (INS(2, 2)) for (int rep_ = 0; rep_ < REP(2); ++rep_) { PHASE_BEGIN
#ifdef RWKV_NAIVE
                if (bid < 64) rwkv_naive(c, p, bid);
                else
#else
                {
                    RxPre pre; const int bh0 = bid >> 2, b0 = bh0 >> 3, hd0 = bh0 & 7, ck0 = (bid & 3) * 16;
                    rwkv_x_fetch(pre, (const bf16_t*)(ws + OFF_P), b0, hd0, ck0, c.tid, c.lane, c.wave);
#pragma unroll 1
                    for (int i = 0; i < 16; ++i) rwkv_x(c, p, bid * 16 + i, pre, b0, hd0, i + 1 < 16 ? ck0 + i + 1 : -1);
                }
                __syncthreads();
                SEAM(2);
            }
            if (INS(2, 16)) for (int rep_ = 0; rep_ < REP(16); ++rep_) { PHASE_BEGIN
                if (bid < 64) { rwkv_y(c, p, bid); __syncthreads(); tr_moe_layer_w(c, p, 0, 1280 + bid * 8 + c.wave, 1792); }
                else
#endif
                {
                    for (int u = bid - 64; u < 512; u += G - 64) swa_mfma(c, p, u);
                    __syncthreads();
                    if (bid >= 96) tr_moe_layer_w(c, p, 0, (bid - 96) * 8 + c.wave, 1792);
                    if (bid < 96) {
                        pg8::Gemm g{(const bf16_t*)(ws + OFF_R + R_MEMN), WD + WE_MKV, NB * MEMLEN, 1024, 1024, 0}; pg8::StaticOrder S; S.init(NB * MEMLEN, 1024, 32, bid - 64);
                        pg8::EpiB16 E{(bf16_t*)(ws + OFF_MKV), 1024, nullptr}; pg8::gemm_phase<pg8::EpiB16, pg8::StaticOrder, true, true>(glds, g, S, E); }
                }
#ifndef RWKV_NAIVE
                __syncthreads();
                SEAM(2);
            }
            if (INS(2, 17)) for (int rep_ = 0; rep_ < REP(17); ++rep_) { PHASE_BEGIN
                for (int u = c.gw; u < 4096; u += c.ngw) rwkv_z(c, p, u);
#endif
                __syncthreads();
                SEAM(2);
            }
        } else {
            if (INS(12, 12)) for (int rep_ = 0; rep_ < REP(12); ++rep_) { PHASE_BEGIN
                combine_gk(c, p);
                __syncthreads();
                SEAM(12);
            }
            if (INS(13, 13)) for (int rep_ = 0; rep_ < REP(13); ++rep_) { PHASE_BEGIN
                pg8::Gemm g{H, WD + WE_OD_IN, T_TOK, OD_IN, 1024, 0}; pg8::StaticOrder S; S.init(T_TOK, OD_IN, G, bid);
                pg8::EpiB16 E{P, OD_IN, (const float*)(ws + OFF_ROUTE + ROUTE_RS)};   pg8::gemm_phase<pg8::EpiB16, pg8::StaticOrder, true, true>(glds, g, S, E);
                SEAM(13);
            }
            if (INS(14, 14)) for (int rep_ = 0; rep_ < REP(14); ++rep_) { PHASE_BEGIN
#ifdef GLA_NAIVE
                if (bid < 32) gla_naive(c, p, bid);
                __syncthreads();
                SEAM(14);
#else
                for (int u = bid; u < 2048; u += G) gla_prep(c, p, u);
                __syncthreads();
                SEAM(14);
#endif
            }
#ifndef GLA_NAIVE
            if (INS(14, 18)) for (int rep_ = 0; rep_ < REP(18); ++rep_) { PHASE_BEGIN
                if (bid < 128) gla_state(c, p, bid >> 2, bid & 3);
                else tr_moe_layer(c, p, 1, 128 * 8, 128 * 8);
                __syncthreads();
                SEAM(14);
            }
            if (INS(14, 19)) for (int rep_ = 0; rep_ < REP(19); ++rep_) { PHASE_BEGIN
                gla_finish(c, p);
                __syncthreads();
                SEAM(14);
            }
#endif
        }
        if (INS(pb + 3, 3)) for (int rep_ = 0; rep_ < REP(3); ++rep_) { PHASE_BEGIN
            pg8::Gemm g{(const bf16_t*)p.out, WD + (layer == 0 ? WE_EV_OUT : WE_OD_OUT), T_TOK, 1024, 1024, 0}; pg8::StaticOrder S; S.init(T_TOK, 1024, G, bid);
            pg8::EpiRes E{layer == 0 ? p.x : nullptr, H, 1024, (float*)(ws + OFF_R + R_SSP)};     pg8::gemm_phase<pg8::EpiRes, pg8::StaticOrder, true, true>(glds, g, S, E);
            SEAM(pb + 3);
        }
        if (INS(pb + 5, 5)) for (int rep_ = 0; rep_ < REP(5); ++rep_) { PHASE_BEGIN
            pg8::Gemm g{H, WD + WE_WQ + (size_t)layer * 512 * 1024, T_TOK, 512, 1024, 0}; pg8::StaticOrder S; S.init(T_TOK, 512, G, bid);
            pg8::EpiB16 E{P, 512, nullptr}; pg8::gemm_phase<pg8::EpiB16, pg8::StaticOrder, true, true>(glds, g, S, E);
            SEAM(pb + 5);
        }
        if (INS(pb + 6, 6)) for (int rep_ = 0; rep_ < REP(6); ++rep_) { PHASE_BEGIN for (int u = bid; u < 256; u += G) xattn_mfma(c, p, u); __syncthreads(); SEAM(pb + 6); }
        if (INS(pb + 7, 7)) for (int rep_ = 0; rep_ < REP(7); ++rep_) { PHASE_BEGIN
            pg8::Gemm g{(const bf16_t*)(ws + OFF_P + 32 * MiB), WD + WE_WO + (size_t)layer * 1024 * 512, T_TOK, 1024, 512, 0}; pg8::StaticOrder S; S.init(T_TOK, 1024, G, bid);
            pg8::EpiRes E{nullptr, H, 1024, nullptr}; pg8::gemm_phase<pg8::EpiRes, pg8::StaticOrder, true, true>(glds, g, S, E);
            SEAM(pb + 7);
        }
        if (INS(pb + 8, 8)) for (int rep_ = 0; rep_ < REP(8); ++rep_) { PHASE_BEGIN
            moe_route(c, p, layer);
            __syncthreads();
            SEAM(pb + 8);
        }
        if (INS(pb + 9, 9)) for (int rep_ = 0; rep_ < REP(9); ++rep_) { PHASE_BEGIN moe_slots2(c, p, layer); __syncthreads(); SEAM(pb + 9); }
        if (INS(pb + 10, 10)) for (int rep_ = 0; rep_ < REP(10); ++rep_) { PHASE_BEGIN
            const int* blk = (const int*)(ws + OFF_CTL + CTL_BLK) + layer * 1024; const int nblk = blk[0];
            pg8::Gemm g{H, (const bf16_t*)(ws + OFF_WMOE), nblk * 256, 1024, 1024, (size_t)1024 * 1024 * 2}; pg8::MoeOrder S{blk + 1, nblk * 4, 4, G, bid, (const int*)(ws + OFF_R + R_TOK)};
            pg8::EpiSwiglu E{(bf16_t*)(ws + OFF_R), 512, (const float*)(ws + OFF_R + R_RSS)}; pg8::gemm_phase<pg8::EpiSwiglu, pg8::MoeOrder, true, true>(glds, g, S, E);
            SEAM(pb + 10);
        }
        if (INS(pb + 11, 11)) for (int rep_ = 0; rep_ < REP(11); ++rep_) { PHASE_BEGIN
            const int* blk = (const int*)(ws + OFF_CTL + CTL_BLK) + layer * 1024; const int nblk = blk[0];
            pg8::Gemm g{(const bf16_t*)(ws + OFF_R), (const bf16_t*)(ws + OFF_WMOE + 64 * MiB), nblk * 256, 1024, 512, (size_t)1024 * 512 * 2}; pg8::MoeOrder S{blk + 1, nblk * 4, 4, G, bid, nullptr};
            pg8::EpiB16 E{P, 1024, nullptr}; pg8::gemm_phase<pg8::EpiB16, pg8::MoeOrder, true, true>(glds, g, S, E);
            SEAM(pb + 11);
        }
    }
    if (INS(24, 15)) for (int rep_ = 0; rep_ < REP(15); ++rep_) { PHASE_BEGIN
        for (int r0 = c.gw; r0 < T_TOK; r0 += 4 * c.ngw) {
            f32x4 v[4][4]; int2 ps[4]; float2 gt[4];
#pragma unroll
            for (int q = 0; q < 4; ++q) { const int r = r0 + q * c.ngw; ps[q] = RP[r]; gt[q] = RG[r];
#pragma unroll
                for (int j = 0; j < 4; ++j) { const u32x2 w = *((const u32x2*)(H + (size_t)r * 1024) + c.lane + 64 * j); v[q][j] = (f32x4){bflo(w.x), bfhi(w.x), bflo(w.y), bfhi(w.y)}; } }
#pragma unroll
            for (int q = 0; q < 4; ++q) row_combine(v[q], P, ps[q].x, ps[q].y, gt[q].x, gt[q].y, c.lane);
#pragma unroll
            for (int q = 0; q < 4; ++q) { const int r = r0 + q * c.ngw; const float rs = row_rstd(v[q]); row_scale(v[q], rs, p.norm_final, c.lane); row_store_f32(p.out + (size_t)r * 1024, c.lane, v[q]); }
        }
    }
}

extern "C" void kernel_launch(void* const* d_in, const int* in_sizes, int n_in, void* d_out, int out_size, void* d_ws, size_t ws_size, hipStream_t stream) {
    static int ready = 0;
    if (ready == 0) {
        if (n_in != 37 || out_size != T_TOK * DM || ws_size < WS_NEED) { fprintf(stderr, "kernel_launch: unexpected problem (n_in %d, out %d, ws %zu)\n", n_in, out_size, ws_size); ready = -1; return; }
        if (hipFuncSetAttribute((const void*)hybrid_fwd, hipFuncAttributeMaxDynamicSharedMemorySize, LDS_BYTES) != hipSuccess) { fprintf(stderr, "kernel_launch: hipFuncSetAttribute failed\n"); ready = -1; return; }
        ready = 1;
    }
    if (ready < 0) return;
    hipMemsetAsync((char*)d_ws + OFF_CTL, 0, CTL_ZERO_BYTES, stream);
    Params p{};
    const float** f = (const float**)&p;
    for (int i = 0; i < 37; ++i) f[i] = (const float*)d_in[i];
    p.out = (float*)d_out; p.ws = (unsigned char*)d_ws; p.ph_lo = 0; p.ph_hi = N_PHASES;
    hipLaunchKernelGGL(hybrid_fwd, dim3(256), dim3(512), LDS_BYTES, stream, p);
}
```

```cpp
#include <hip/hip_runtime.h>
#include <cstdint>
#include <cstdio>

#define LAS __attribute__((address_space(3)))
typedef unsigned short bf16_t;
typedef float f32x4 __attribute__((ext_vector_type(4)));
typedef float f32x2 __attribute__((ext_vector_type(2)));
typedef unsigned u32x4 __attribute__((ext_vector_type(4)));
typedef unsigned u32x2 __attribute__((ext_vector_type(2)));

constexpr int T_TOK = 32768, DM = 1024, SEQ = 4096, NB = 8, MEMLEN = 256;
constexpr int EV_IN = 2560, OD_IN = 3072  , OD_IN_SRC = 3088;
constexpr int NEXP = 32, MOE_FF = 512, PMAX = 65536 + NEXP * 256;

constexpr size_t MiB = 1024 * 1024;
constexpr size_t OFF_CTL = 0;
constexpr size_t CTL_ZERO_BYTES = 64 * 1024;
constexpr size_t CTL_CNT = 16384;
constexpr size_t CTL_CUR = 16384 + 1024;
constexpr size_t CTL_BLK = 128 * 1024;
constexpr size_t OFF_ROUTE = 1 * MiB;
constexpr size_t OFF_WSMALL = 2 * MiB;
constexpr size_t OFF_MKV = 3 * MiB;
constexpr size_t OFF_WD = 7 * MiB;
constexpr size_t OFF_WMOE = 28 * MiB;
constexpr size_t OFF_H = 124 * MiB;
constexpr size_t OFF_P = 188 * MiB;
constexpr size_t OFF_R = 380 * MiB;
constexpr size_t WS_NEED = 552 * MiB;
constexpr size_t WE_EV_IN = 0, WE_EV_OUT = 2560ull * 1024, WE_OD_IN = 3584ull * 1024, WE_OD_OUT = 6656ull * 1024, WE_MKV = 7680ull * 1024, WE_WQ = 8704ull * 1024, WE_WO = 9728ull * 1024;

constexpr size_t ROUTE_RS = 768 * 1024;
constexpr size_t R_TOK = 81 * MiB;
constexpr size_t R_SSP = 0, R_RSS = 80 * MiB;
constexpr size_t P_XB1 = 64 * MiB;
struct Params {
    const float *x, *mem, *norm_mix, *norm_xattn, *norm_moe, *norm_final;
    const float *ev_w_in, *ev_sinks, *ev_mu, *ev_w0, *ev_w2, *ev_a0, *ev_a2, *ev_g2, *ev_k_k, *ev_k_a, *ev_r_k, *ev_lnx_w, *ev_lnx_b, *ev_w_out;
    const float *od_w_in, *od_gate_up, *od_gate_b, *od_onorm, *od_w_out;
    const float *mem_norm, *mem_wk, *mem_wv, *xa_wq, *xa_wo;
    const float *moe_w_group, *moe_b_group, *moe_w_expert, *moe_b_expert, *moe_w1, *moe_w3, *moe_w2;
    float* out; unsigned char* ws; int ph_lo, ph_hi;
};

#define XB_TMO      128
#define XB_XCNT(j)  (256  + 64 * (j))
#define XB_XSUB(j)  (1280 + 64 * (j))
#define XB_XGEN(j)  (2304 + 64 * (j))
#define XB_TOP      3328
#define XB_TOPGEN   3392
#define XCD_BAR_WORDS 3456
#define XB_SPIN_CAP (1u << 18)
#define LAS __attribute__((address_space(3)))

__device__ __forceinline__ unsigned xb_ld(unsigned* p)              { return __hip_atomic_load(p, __ATOMIC_RELAXED, __HIP_MEMORY_SCOPE_AGENT); }
__device__ __forceinline__ unsigned xb_add(unsigned* p, unsigned v) { return __hip_atomic_fetch_add(p, v, __ATOMIC_RELAXED, __HIP_MEMORY_SCOPE_AGENT); }
__device__ __forceinline__ unsigned xb_xcc_id() { return (unsigned)__builtin_amdgcn_s_getreg((3 << 11) | 20) & 0xFu; }
#define XB_SPIN(cond, bar) do { unsigned _sp = 0; while (cond) { __builtin_amdgcn_s_sleep(1); \
    if ((++_sp & 255u) == 0u) { if (xb_ld(&(bar)[XB_TMO])) break; if (_sp > XB_SPIN_CAP) { atomicAdd(&(bar)[XB_TMO], 1u); break; } } } } while (0)

struct XcdBarrier {
    unsigned* bar; unsigned x;
    volatile LAS unsigned* st;
};

__device__ __forceinline__ XcdBarrier xcd_barrier_post(unsigned* bar, volatile LAS unsigned* st) {
    XcdBarrier b; b.bar = bar; b.x = xb_xcc_id(); b.st = st;
    if (threadIdx.x == 0) (void)xb_add(&bar[XB_XCNT(b.x)], 1u);
    return b;
}
__device__ __forceinline__ void xcd_barrier_complete(unsigned* bar, unsigned x, unsigned& nloc, unsigned& nx) {
    const unsigned G = gridDim.x * gridDim.y * gridDim.z;
    unsigned sum, cnt, mine, sp = 0u;
    for (;;) {
        sum = 0u; cnt = 0u; mine = 0u;
#pragma unroll
        for (unsigned j = 0; j < 16; ++j) { const unsigned c = xb_ld(&bar[XB_XCNT(j)]); sum += c; cnt += (c > 0u) ? 1u : 0u; mine = (j == x) ? c : mine; }
        if (sum == G) break;
        __builtin_amdgcn_s_sleep(1);
        if ((++sp & 255u) == 0u) { if (xb_ld(&bar[XB_TMO])) break; if (sp > XB_SPIN_CAP) { atomicAdd(&bar[XB_TMO], 1u); break; } }
    }
    nloc = mine > 0u ? mine : 1u; nx = cnt > 0u ? cnt : 1u;
}

__device__ __forceinline__ void xcd_barrier(const XcdBarrier& b) {
    asm volatile("s_waitcnt vmcnt(0)" ::: "memory");
    __syncthreads();
    if (threadIdx.x == 0) {
        unsigned* bar = b.bar;
        __builtin_amdgcn_s_waitcnt(0);
        unsigned nloc = b.st[0], nx = b.st[1];
        if (nloc == 0u) { xcd_barrier_complete(bar, b.x, nloc, nx); b.st[0] = nloc; b.st[1] = nx; }
        const unsigned old = xb_add(&bar[XB_XSUB(b.x)], 1u);
        const unsigned gen = old / nloc;
        if (old + 1u == (gen + 1u) * nloc) {
            __builtin_amdgcn_fence(__ATOMIC_RELEASE, "agent");
            asm volatile("s_waitcnt vmcnt(0)" ::: "memory");
            const unsigned og = xb_add(&bar[XB_TOP], 1u);
            const unsigned tg = og / nx;
            if (og + 1u == (tg + 1u) * nx) xb_add(&bar[XB_TOPGEN], 1u);
            else XB_SPIN(xb_ld(&bar[XB_TOPGEN]) == tg, bar);
            __builtin_amdgcn_fence(__ATOMIC_ACQUIRE, "agent");
            xb_add(&bar[XB_XGEN(b.x)], 1u);
            asm volatile("s_waitcnt vmcnt(0)" ::: "memory");
        } else {
            XB_SPIN(xb_ld(&bar[XB_XGEN(b.x)]) == gen, bar);
            __builtin_amdgcn_fence(__ATOMIC_ACQUIRE, "agent");
            asm volatile("s_waitcnt vmcnt(0)" ::: "memory");
        }
    }
    __syncthreads();
}
namespace pg8 {
#define PG8_LAS __attribute__((address_space(3)))
typedef unsigned short bf16_t;
typedef short bf16x8 __attribute__((ext_vector_type(8)));
typedef float f32x4 __attribute__((ext_vector_type(4)));
typedef unsigned u32x4 __attribute__((ext_vector_type(4)));
constexpr int BM = 256, BK = 64, HALF = 128, HTB = HALF * BK * 2  , STAGE_BYTES = 8 * HTB, NXCD = 8, WGM = 8;

__host__ __device__ __forceinline__ int lds_byte(int r, int c) { const int st = (r >> 4) * 2 + (c >> 5), rr = r & 15, cc = c & 31, ob = rr * 64 + cc * 2; return st * 1024 + (ob ^ (((ob >> 9) & 1) << 5)); }
__host__ __device__ __forceinline__ void stage_rc(int b, int& R, int& C) { const int st = b / 1024, sb = b % 1024, swz = sb ^ (((sb >> 9) & 1) << 5); R = (st >> 1) * 16 + swz / 64; C = (st & 1) * 32 + (swz % 64) / 2; }
__host__ __device__ __forceinline__ int perm32(int rho) { const int n = rho >> 4, i = rho & 15; return 8 * (i >> 2) + 4 * n + (i & 3); }

struct Unit { int pm, pn, e; };
struct Gemm { const bf16_t* A; const bf16_t* Bt; int M, N, K; size_t bexp; };

struct StaticOrder {
    int nM, nN, nwg, G, c;
    __host__ __device__ void init(int M, int N, int G_, int c_) { nM = M / BM; nN = N / BM; nwg = nM * nN; G = G_; c = c_; }
    __host__ __device__ bool next(int i, Unit& u) const {
        const long L = (long)i * G + c; if (L >= nwg) return false;
        int wgid = (int)L; { const int q = nwg / NXCD, r = nwg % NXCD, xcd = wgid % NXCD, off = wgid / NXCD; wgid = (xcd < r ? xcd * (q + 1) : r * (q + 1) + (xcd - r) * q) + off; }
        const int nig = WGM * nN, gid = wgid / nig, fm = gid * WGM, gsz = (nM - fm) < WGM ? (nM - fm) : WGM;
        u.pm = fm + ((wgid % nig) % gsz); u.pn = (wgid % nig) / gsz; u.e = 0; return true;
    }
    __device__ __forceinline__ int arow(const Unit& u, int r) const { return u.pm * BM + r; }
    __device__ __forceinline__ void a_ready(const Unit&) const {}
    __device__ __forceinline__ void done(const Unit&) const {}
};
typedef __bf16 bf16x2_c __attribute__((ext_vector_type(2))); typedef float f32x2_c __attribute__((ext_vector_type(2)));
__device__ __forceinline__ unsigned cvt_pk_bf16(float lo, float hi) { const f32x2_c v = {lo, hi}; return __builtin_bit_cast(unsigned, __builtin_convertvector(v, bf16x2_c)); }

struct EpiB16 {
    static constexpr bool PERM = true, AFTER_DRAIN = false;
    bf16_t* O; int ldc; const float* rs;
    __device__ __forceinline__ void operator()(const f32x4 (&acc)[2][2][4][2], const Unit& u, int wr, int wc, int fr, int fq) const {
        const int row0 = u.pm * BM + wr * 64 + fr, col0 = u.pn * BM + wc * 32 + 8 * fq;
#pragma unroll
        for (int ai = 0; ai < 2; ++ai)
#pragma unroll
            for (int m = 0; m < 4; ++m) { bf16_t* rowp = O + (size_t)(row0 + ai * HALF + m * 16) * ldc + col0; const float r1 = rs ? rs[row0 + ai * HALF + m * 16] : 1.0f;
#pragma unroll
                for (int bj = 0; bj < 2; ++bj) { const f32x4 v0 = acc[ai][bj][m][0] * r1, v1 = acc[ai][bj][m][1] * r1;
                    u32x4 w; w.x = cvt_pk_bf16(v0[0], v0[1]); w.y = cvt_pk_bf16(v0[2], v0[3]); w.z = cvt_pk_bf16(v1[0], v1[1]); w.w = cvt_pk_bf16(v1[2], v1[3]);
                    *(u32x4*)(rowp + bj * HALF) = w; } }
    }
};
struct EpiRes {
    static constexpr bool PERM = false, AFTER_DRAIN = false;
    const float* base32; bf16_t* X; int ldc; float* ssp;
    __device__ __forceinline__ void operator()(const f32x4 (&acc)[2][2][4][2], const Unit& u, int wr, int wc, int fr, int fq) const {
        const int row0 = u.pm * BM + wr * 64 + fr, col0 = u.pn * BM + wc * 32 + 4 * fq;
        typedef unsigned u32x2v __attribute__((ext_vector_type(2)));
#pragma unroll
        for (int ai = 0; ai < 2; ++ai) {
            f32x4 bs[4][2][2];
            if (base32) {
#pragma unroll
                for (int m = 0; m < 4; ++m) { const size_t off = (size_t)(row0 + ai * HALF + m * 16) * ldc + col0;
#pragma unroll
                    for (int bj = 0; bj < 2; ++bj)
#pragma unroll
                        for (int n = 0; n < 2; ++n) bs[m][bj][n] = *(const f32x4*)(base32 + off + bj * HALF + n * 16); }
            } else {
                u32x2v rb[4][2][2];
#pragma unroll
                for (int m = 0; m < 4; ++m) { const size_t off = (size_t)(row0 + ai * HALF + m * 16) * ldc + col0;
#pragma unroll
                    for (int bj = 0; bj < 2; ++bj)
#pragma unroll
                        for (int n = 0; n < 2; ++n) rb[m][bj][n] = *(const u32x2v*)(X + off + bj * HALF + n * 16); }
#pragma unroll
                for (int m = 0; m < 4; ++m)
#pragma unroll
                    for (int bj = 0; bj < 2; ++bj)
#pragma unroll
                        for (int n = 0; n < 2; ++n) { const u32x2v w = rb[m][bj][n]; bs[m][bj][n] = (f32x4){__uint_as_float(w.x << 16), __uint_as_float(w.x & 0xFFFF0000u), __uint_as_float(w.y << 16), __uint_as_float(w.y & 0xFFFF0000u)}; }
            }
#pragma unroll
            for (int m = 0; m < 4; ++m) { const int row = row0 + ai * HALF + m * 16; const size_t off = (size_t)row * ldc + col0; float ss = 0.f;
#pragma unroll
                for (int bj = 0; bj < 2; ++bj)
#pragma unroll
                    for (int n = 0; n < 2; ++n) { const f32x4 o = bs[m][bj][n] + acc[ai][bj][m][n];
                        u32x2v w; w.x = cvt_pk_bf16(o[0], o[1]); w.y = cvt_pk_bf16(o[2], o[3]); *(u32x2v*)(X + off + bj * HALF + n * 16) = w;
                        ss += (o[0] * o[0] + o[1] * o[1]) + (o[2] * o[2] + o[3] * o[3]); }
                if (ssp) { ss += __shfl_xor(ss, 16); ss += __shfl_xor(ss, 32); if (fq == 0) ssp[(size_t)row * 16 + 4 * u.pn + wc] = ss; } }
        }
    }
};
struct EpiSwiglu {
    static constexpr bool PERM = true, AFTER_DRAIN = false;
    bf16_t* O; int ldc; const float* rs;
    __device__ __forceinline__ void operator()(const f32x4 (&acc)[2][2][4][2], const Unit& u, int wr, int wc, int fr, int fq) const {
        const int row0 = u.pm * BM + wr * 64 + fr, col0 = (u.pn * BM + wc * 32 + 8 * fq) >> 1;
        typedef unsigned u32x2v __attribute__((ext_vector_type(2)));
#pragma unroll
        for (int ai = 0; ai < 2; ++ai)
#pragma unroll
            for (int m = 0; m < 4; ++m) { bf16_t* rowp = O + (size_t)(row0 + ai * HALF + m * 16) * ldc + col0; const float r1 = rs[row0 + ai * HALF + m * 16];
#pragma unroll
                for (int bj = 0; bj < 2; ++bj) { const f32x4 a = acc[ai][bj][m][0] * r1, b = acc[ai][bj][m][1] * r1; float h[4];
#pragma unroll
                    for (int i = 0; i < 4; ++i) h[i] = a[i] * __builtin_amdgcn_rcpf(1.0f + __expf(-a[i])) * b[i];
                    u32x2v w; w.x = cvt_pk_bf16(h[0], h[1]); w.y = cvt_pk_bf16(h[2], h[3]);
                    *(u32x2v*)(rowp + bj * (HALF / 2)) = w; } }
    }
};
struct MoeOrder {
    const int* blk_e; int nunits, nN, G, c; const int* tok;
    __device__ __forceinline__ bool next(int i, Unit& u) const {
        const long L = (long)i * G + c; if (L >= nunits) return false;
        u.pm = (int)(L / nN); u.pn = (int)(L % nN); u.e = blk_e[u.pm]; return true;
    }
    __device__ __forceinline__ int arow(const Unit& u, int r) const { return tok ? tok[u.pm * BM + r] : u.pm * BM + r; }
    __device__ __forceinline__ void a_ready(const Unit&) const {}
    __device__ __forceinline__ void done(const Unit&) const {}
};
template <class Epi, class Sched, bool ALIGN_EPI = false, bool SP2 = false>
__device__ __forceinline__ void gemm_phase(PG8_LAS unsigned char* lds, const Gemm g, const Sched& S, const Epi& E) {
    static_assert(SP2, "only the two-super-phase loop is kept in this file");
    int tid_ = threadIdx.x; asm volatile("" : "+v"(tid_));
    const int tid = tid_, wid = __builtin_amdgcn_readfirstlane(tid >> 6), lane = tid & 63, wr = wid >> 2, wc = wid & 3, fr = lane & 15, fq = lane >> 4;
    const int K = g.K, nt = K / BK;
    unsigned voffB[2]; int RA[2], CA[2];
#pragma unroll
    for (int i = 0; i < 2; ++i) { int R, C; stage_rc(tid * 16 + i * 8192, R, C); const int Rb = Epi::PERM ? ((R & ~31) + perm32(R & 31)) : R;
        RA[i] = R; CA[i] = C; voffB[i] = (unsigned)(Rb * K + C) * 2u; }
    const size_t kstep = (size_t)(BK * 2);
    const size_t hstep = (size_t)HALF * K * 2;
    const size_t tstep = 2 * hstep;
    const unsigned ldsw = (unsigned)wid * 1024u;
    const int aoff = lds_byte(wr * 64 + fr, fq * 8), boff = lds_byte(wc * 32 + fr, fq * 8);
#define PG8_SA(b, h) (((b) * 2 + (h)) * HTB)
#define PG8_SB(b, h) ((4 + (b) * 2 + (h)) * HTB)
#define PG8_STAGE(bufoff, gbase, voff) do { _Pragma("unroll") for (int _i = 0; _i < 2; ++_i) \
        __builtin_amdgcn_global_load_lds((const unsigned*)((const char*)(gbase) + (voff)[_i]), (PG8_LAS unsigned*)(lds + (bufoff) + ldsw + _i * 8192), 16, 0, 0); } while (0)
#define PG8_AOFF(vo, u) do { _Pragma("unroll") for (int _h = 0; _h < 2; ++_h) _Pragma("unroll") for (int _i = 0; _i < 2; ++_i) \
        vo[_h][_i] = (unsigned)(S.arow(u, _h * HALF + RA[_i]) * K + CA[_i]) * 2u; } while (0)
#define PG8_LDA(dst, b, h) do { _Pragma("unroll") for (int m = 0; m < 4; ++m) _Pragma("unroll") for (int k = 0; k < 2; ++k) dst[m][k] = *(const PG8_LAS bf16x8*)(lds + PG8_SA(b, h) + aoff + m * 2048 + k * 1024); } while (0)
#define PG8_LDB(dst, b, h) do { _Pragma("unroll") for (int n = 0; n < 2; ++n) _Pragma("unroll") for (int k = 0; k < 2; ++k) dst[n][k] = *(const PG8_LAS bf16x8*)(lds + PG8_SB(b, h) + boff + n * 2048 + k * 1024); } while (0)
#define PG8_MMA(ai, bj, At, Bt) do { __builtin_amdgcn_s_setprio(1); _Pragma("unroll") for (int m = 0; m < 4; ++m) _Pragma("unroll") for (int n = 0; n < 2; ++n) _Pragma("unroll") for (int k = 0; k < 2; ++k) \
        acc[ai][bj][m][n] = __builtin_amdgcn_mfma_f32_16x16x32_bf16(Bt[n][k], At[m][k], acc[ai][bj][m][n], 0, 0, 0); __builtin_amdgcn_s_setprio(0); } while (0)
#define PG8_WAIT_V(n) asm volatile("s_waitcnt vmcnt(" #n ")" ::: "memory")
#define PG8_WAIT_L(n) asm volatile("s_waitcnt lgkmcnt(" #n ")" ::: "memory")
#define PG8_BAR __builtin_amdgcn_s_barrier()
#define PG8_SCHED __builtin_amdgcn_sched_barrier(0)
    Unit cur, nxt; int ui = 0;
    if (!S.next(0, cur)) return;
    f32x4 acc[2][2][4][2];
#pragma unroll
    for (int a = 0; a < 2; ++a)
#pragma unroll
        for (int b = 0; b < 2; ++b)
#pragma unroll
            for (int m = 0; m < 4; ++m)
#pragma unroll
                for (int n = 0; n < 2; ++n) acc[a][b][m][n] = (f32x4){0.f, 0.f, 0.f, 0.f};
    bf16x8 At[4][2], B0[2][2], B1[2][2];
    const char* Ab = (const char*)g.A;
    const char* cB = (const char*)g.Bt + (size_t)cur.pn * tstep + (size_t)cur.e * g.bexp;
    unsigned curA[2][2], nxtA[2][2];
    S.a_ready(cur);
    PG8_AOFF(curA, cur);
    PG8_STAGE(PG8_SB(0, 0), cB, voffB); PG8_STAGE(PG8_SB(0, 1), cB + hstep, voffB); PG8_STAGE(PG8_SA(0, 0), Ab, curA[0]); PG8_STAGE(PG8_SA(0, 1), Ab, curA[1]);
    if (wr == 1) PG8_BAR;
    PG8_WAIT_V(2); PG8_BAR;
    PG8_STAGE(PG8_SB(1, 0), cB + kstep, voffB); PG8_STAGE(PG8_SA(1, 0), Ab + kstep, curA[0]); PG8_STAGE(PG8_SB(1, 1), cB + hstep + kstep, voffB);
    PG8_WAIT_V(6); PG8_BAR;
    for (;;) {
        const bool has_next = S.next(ui + 1, nxt);
        const char* nB = has_next ? (const char*)g.Bt + (size_t)nxt.pn * tstep + (size_t)nxt.e * g.bexp : cB;
        if (has_next) { PG8_AOFF(nxtA, nxt); }
        else {
#pragma unroll
            for (int h = 0; h < 2; ++h)
#pragma unroll
                for (int i = 0; i < 2; ++i) nxtA[h][i] = curA[h][i]; }
        for (int t = 0; t < nt; t += 2) {
            const bool last = (t == nt - 2);
            const char* a1 = Ab + (size_t)(t + 1) * kstep;
            const char* a2 = last ? Ab : Ab + (size_t)(t + 2) * kstep; const char* b2 = last ? nB : cB + (size_t)(t + 2) * kstep;
            const char* a3 = a2 + kstep; const char* b3 = b2 + kstep;
            unsigned vo2[2][2];
#pragma unroll
            for (int h = 0; h < 2; ++h)
#pragma unroll
                for (int i = 0; i < 2; ++i) vo2[h][i] = last ? nxtA[h][i] : curA[h][i];
            if (last && has_next) S.a_ready(nxt);
            PG8_LDB(B0, 0, 0); PG8_LDB(B1, 0, 1); PG8_SCHED; PG8_LDA(At, 0, 0); PG8_STAGE(PG8_SA(1, 1), a1, curA[1]);
            PG8_WAIT_V(8); PG8_WAIT_L(0); PG8_BAR; PG8_MMA(0, 0, At, B0); PG8_MMA(0, 1, At, B1); PG8_BAR; PG8_SCHED;
            PG8_LDA(At, 0, 1); PG8_STAGE(PG8_SB(0, 0), b2, voffB); PG8_STAGE(PG8_SB(0, 1), b2 + hstep, voffB); PG8_STAGE(PG8_SA(0, 0), a2, vo2[0]);
            PG8_WAIT_V(8); PG8_WAIT_L(0); PG8_BAR; PG8_MMA(1, 0, At, B0); PG8_MMA(1, 1, At, B1); PG8_BAR; PG8_SCHED;
            PG8_LDB(B0, 1, 0); PG8_LDB(B1, 1, 1); PG8_SCHED; PG8_LDA(At, 1, 0); PG8_STAGE(PG8_SA(0, 1), a2, vo2[1]);
            PG8_WAIT_V(8); PG8_WAIT_L(0); PG8_BAR; PG8_MMA(0, 0, At, B0); PG8_MMA(0, 1, At, B1); PG8_BAR; PG8_SCHED;
            PG8_LDA(At, 1, 1); PG8_STAGE(PG8_SB(1, 0), b3, voffB); PG8_STAGE(PG8_SB(1, 1), b3 + hstep, voffB); PG8_STAGE(PG8_SA(1, 0), a3, vo2[0]);
            PG8_WAIT_V(8); PG8_WAIT_L(0); PG8_BAR; PG8_MMA(1, 0, At, B0); PG8_MMA(1, 1, At, B1); PG8_BAR; PG8_SCHED;
        }
        if constexpr (ALIGN_EPI) { if (wr == 0) PG8_BAR; }
        if constexpr (!Epi::AFTER_DRAIN) { E(acc, cur, wr, wc, fr, fq); S.done(cur); }
        if (!has_next) break;
#pragma unroll
        for (int a = 0; a < 2; ++a)
#pragma unroll
            for (int b = 0; b < 2; ++b)
#pragma unroll
                for (int m = 0; m < 4; ++m)
#pragma unroll
                    for (int n = 0; n < 2; ++n) acc[a][b][m][n] = (f32x4){0.f, 0.f, 0.f, 0.f};
        cur = nxt; cB = nB; ++ui;
#pragma unroll
        for (int h = 0; h < 2; ++h)
#pragma unroll
            for (int i = 0; i < 2; ++i) curA[h][i] = nxtA[h][i];
        if constexpr (ALIGN_EPI) { if (wr == 1) PG8_BAR; }
    }
    PG8_WAIT_V(0);
    if constexpr (!ALIGN_EPI) { if (wr == 0) PG8_BAR; }
    PG8_BAR;
    if constexpr (Epi::AFTER_DRAIN) { E.fused(acc, cur, wr, wc, fr, fq, lds, wid, lane); S.done(cur); }
#undef PG8_SA
#undef PG8_SB
#undef PG8_STAGE
#undef PG8_AOFF
#undef PG8_LDA
#undef PG8_LDB
#undef PG8_MMA
#undef PG8_WAIT_V
#undef PG8_WAIT_L
#undef PG8_BAR
#undef PG8_SCHED
}
}
__device__ __forceinline__ float bf2f(unsigned v) { return __uint_as_float(v << 16); }
__device__ __forceinline__ unsigned f2bf(float f) { unsigned u = __float_as_uint(f); u += 0x7FFFu + ((u >> 16) & 1u); return u >> 16; }
typedef __bf16 bf16x2_t __attribute__((ext_vector_type(2)));
__device__ __forceinline__ unsigned pk2(float lo, float hi) { const f32x2 v = {lo, hi}; return __builtin_bit_cast(unsigned, __builtin_convertvector(v, bf16x2_t)); }
__device__ __forceinline__ float bflo(unsigned w) { return __uint_as_float(w << 16); }
__device__ __forceinline__ float bfhi(unsigned w) { return __uint_as_float(w & 0xFFFF0000u); }
__device__ __forceinline__ float wave_sum(float v) {
#pragma unroll
    for (int o = 1; o < 64; o <<= 1) v += __shfl_xor(v, o);
    return v;
}
__device__ __forceinline__ float wave_max(float v) {
#pragma unroll
    for (int o = 1; o < 64; o <<= 1) v = fmaxf(v, __shfl_xor(v, o));
    return v;
}
__device__ __forceinline__ float sigmoidf_(float x) { return __builtin_amdgcn_rcpf(1.0f + __expf(-x)); }
__device__ __forceinline__ float tanhf_(float x) { return 1.0f - 2.0f * __builtin_amdgcn_rcpf(__expf(2.0f * x) + 1.0f); }
#define LDS_WAIT() asm volatile("s_waitcnt lgkmcnt(0)" ::: "memory")

struct Ctx { int tid, wave, lane, gw, ngw; unsigned char* shm; };

__device__ __forceinline__ int tr_src_col(int mode, int n, int scol0) { return mode == 1 ? (n < 2048 ? n : n + 16) : scol0 + n; }
__device__ __forceinline__ int tr_dst_row(int mode, int n, int drow0) { return mode == 2 ? 8 * (n >> 2) + (n & 3) : (mode == 3 ? 8 * (n >> 2) + 4 + (n & 3) : drow0 + n); }
struct TrD { const float* W; bf16_t* WT; const float* gain; int ldw, scol0, K, drow0, mode, item, nblk; };
__device__ __forceinline__ void tr_load(const TrD& d, int lane, f32x4 (&v)[8]) {
    const int kb = d.item / d.nblk, nb = d.item % d.nblk, k0 = 64 * kb, n0 = 32 * nb;
    const int n4 = 4 * (lane & 7), sc = tr_src_col(d.mode, n0 + n4, d.scol0);
#pragma unroll
    for (int i = 0; i < 8; ++i) v[i] = *(const f32x4*)(d.W + (size_t)(k0 + 8 * i + (lane >> 3)) * d.ldw + sc);
}
__device__ __forceinline__ void tr_finish(const TrD& d, int lane, f32x4 (&v)[8], LAS float* scr) {
    const int kb = d.item / d.nblk, nb = d.item % d.nblk, k0 = 64 * kb, n0 = 32 * nb, n4 = 4 * (lane & 7);
    if (d.gain) {
#pragma unroll
        for (int i = 0; i < 8; ++i) v[i] = v[i] * d.gain[k0 + 8 * i + (lane >> 3)]; }
#pragma unroll
    for (int i = 0; i < 8; ++i) { LAS float* q = scr + (8 * i + (lane >> 3)) * 33 + n4; q[0] = v[i].x; q[1] = v[i].y; q[2] = v[i].z; q[3] = v[i].w; }
    LDS_WAIT(); asm volatile("" ::: "memory");
    const int c = lane & 7;
#pragma unroll
    for (int j = 0; j < 4; ++j) { const int n = (lane >> 3) + 8 * j; const LAS float* s = scr + (8 * c) * 33 + n;
        u32x4 o; o.x = pk2(s[0 * 33], s[1 * 33]); o.y = pk2(s[2 * 33], s[3 * 33]); o.z = pk2(s[4 * 33], s[5 * 33]); o.w = pk2(s[6 * 33], s[7 * 33]);
        *(u32x4*)(d.WT + (size_t)tr_dst_row(d.mode, n0 + n, d.drow0) * d.K + k0 + 8 * c) = o; }
    LDS_WAIT(); asm volatile("" ::: "memory");
}
__device__ __forceinline__ void tr_pair(const TrD& d0, const TrD& d1, bool has1, int lane, LAS float* scr) {
    f32x4 va[8], vb[8];
    tr_load(d0, lane, va); if (has1) tr_load(d1, lane, vb);
    tr_finish(d0, lane, va, scr); if (has1) tr_finish(d1, lane, vb, scr + 64 * 33);
}
__device__ __forceinline__ void tr_matrix(const Ctx& c, const float* W, int ldw, int scol0, int K, int ncols, bf16_t* WT, int drow0, int mode, const float* gain = nullptr) {
    LAS float* scr = (LAS float*)(c.shm) + c.wave * (2 * 64 * 33);
    const int nblk = ncols / 32, nitems = (K / 64) * nblk;
    for (int it = c.gw; it < nitems; it += 2 * c.ngw) { TrD d0{W, WT, gain, ldw, scol0, K, drow0, mode, it, nblk}; TrD d1 = d0; d1.item = it + c.ngw; tr_pair(d0, d1, it + c.ngw < nitems, c.lane, scr); }
}
__device__ __forceinline__ TrD tr_moe_desc(const Params& p, int layer, int it) {
    bf16_t* w13t = (bf16_t*)(p.ws + OFF_WMOE); bf16_t* w2t = (bf16_t*)(p.ws + OFF_WMOE + 64 * MiB);
    const float* w1 = p.moe_w1 + (size_t)layer * NEXP * 1024 * 512; const float* w3 = p.moe_w3 + (size_t)layer * NEXP * 1024 * 512; const float* w2 = p.moe_w2 + (size_t)layer * NEXP * 512 * 1024;
    const int e = it / 768, r = it % 768;
    if (r < 256) return TrD{w1 + (size_t)e * 1024 * 512, w13t + (size_t)e * 1024 * 1024, p.norm_moe + layer * 1024, 512, 0, 1024, 0, 2, r, 16};
    if (r < 512) return TrD{w3 + (size_t)e * 1024 * 512, w13t + (size_t)e * 1024 * 1024, p.norm_moe + layer * 1024, 512, 0, 1024, 0, 3, r - 256, 16};
    return TrD{w2 + (size_t)e * 512 * 1024, w2t + (size_t)e * 1024 * 512, nullptr, 1024, 0, 512, 0, 0, r - 512, 32};
}
__device__ __forceinline__ void tr_moe_layer_w(const Ctx& c, const Params& p, int layer, int widx, int nw) {
    LAS float* scr = (LAS float*)(c.shm) + c.wave * (2 * 64 * 33);
    for (int it = widx; it < NEXP * 768; it += 2 * nw) { const bool has1 = it + nw < NEXP * 768; const TrD d0 = tr_moe_desc(p, layer, it); const TrD d1 = tr_moe_desc(p, layer, has1 ? it + nw : it); tr_pair(d0, d1, has1, c.lane, scr); }
}
__device__ __forceinline__ void tr_moe_layer(const Ctx& c, const Params& p, int layer, int gw0, int ngw) {
    LAS float* scr = (LAS float*)(c.shm) + c.wave * (2 * 64 * 33);
    for (int it = c.gw - gw0; it < NEXP * 768; it += 2 * ngw) { const bool has1 = it + ngw < NEXP * 768; const TrD d0 = tr_moe_desc(p, layer, it); const TrD d1 = tr_moe_desc(p, layer, has1 ? it + ngw : it); tr_pair(d0, d1, has1, c.lane, scr); }
}

__device__ __forceinline__ void row_load(const float* row, int lane, f32x4 (&v)[4]) {
#pragma unroll
    for (int j = 0; j < 4; ++j) v[j] = *((const f32x4*)row + lane + 64 * j);
}
__device__ __forceinline__ float row_rstd(const f32x4 (&v)[4]) {
    float s = 0.f;
#pragma unroll
    for (int j = 0; j < 4; ++j) s += (v[j].x * v[j].x + v[j].y * v[j].y) + (v[j].z * v[j].z + v[j].w * v[j].w);
    return 1.0f / sqrtf(wave_sum(s) * (1.0f / 1024.0f) + 1e-6f);
}
__device__ __forceinline__ void row_scale(f32x4 (&v)[4], float rstd, const float* gain, int lane) {
#pragma unroll
    for (int j = 0; j < 4; ++j) { const f32x4 g = *((const f32x4*)gain + lane + 64 * j); v[j] = v[j] * rstd * g; }
}
__device__ __forceinline__ void row_store_bf16(bf16_t* orow, int lane, const f32x4 (&v)[4]) {
#pragma unroll
    for (int j = 0; j < 4; ++j) { u32x2 o; o.x = pk2(v[j].x, v[j].y); o.y = pk2(v[j].z, v[j].w); *((u32x2*)orow + lane + 64 * j) = o; }
}
__device__ __forceinline__ void row_store_f32(float* orow, int lane, const f32x4 (&v)[4]) {
#pragma unroll
    for (int j = 0; j < 4; ++j) *((f32x4*)orow + lane + 64 * j) = v[j];
}
__device__ __forceinline__ void row_combine(f32x4 (&v)[4], const bf16_t* yb, int p0, int p1, float g0, float g1, int lane) {
    const u32x2* r0 = (const u32x2*)(yb + (size_t)p0 * 1024); const u32x2* r1 = (const u32x2*)(yb + (size_t)p1 * 1024);
#pragma unroll
    for (int j = 0; j < 4; ++j) { const u32x2 a = r0[lane + 64 * j], b = r1[lane + 64 * j];
        v[j].x += g0 * bflo(a.x) + g1 * bflo(b.x); v[j].y += g0 * bfhi(a.x) + g1 * bfhi(b.x);
        v[j].z += g0 * bflo(a.y) + g1 * bflo(b.y); v[j].w += g0 * bfhi(a.y) + g1 * bfhi(b.y); }
}
__device__ __forceinline__ void row_logits(const f32x4 (&v)[4], const float* wT, int lane, int NL, LAS float* lg) {
#pragma unroll 1
    for (int o = 0; o < NL; ++o) { float s = 0.f;
#pragma unroll
        for (int j = 0; j < 4; ++j) { const f32x4 w = *((const f32x4*)(wT + o * 1024) + lane + 64 * j); s += (v[j].x * w.x + v[j].y * w.y) + (v[j].z * w.z + v[j].w * w.w); }
        s = wave_sum(s); if (lane == 0) lg[o] = s; }
    LDS_WAIT();
}

__device__ __forceinline__ void norm_plain(const Ctx& c, const float* src, const float* gain, bf16_t* H, int nrows) {
    for (int r0 = c.gw; r0 < nrows; r0 += 4 * c.ngw) {
        f32x4 v[4][4];
#pragma unroll
        for (int q = 0; q < 4; ++q) { const int r = r0 + q * c.ngw; if (r < nrows) row_load(src + (size_t)r * 1024, c.lane, v[q]); }
#pragma unroll
        for (int q = 0; q < 4; ++q) { const int r = r0 + q * c.ngw; if (r < nrows) { const float rs = row_rstd(v[q]); row_scale(v[q], rs, gain, c.lane); row_store_bf16(H + (size_t)r * 1024, c.lane, v[q]); } }
    }
}
__device__ __forceinline__ void route_row(const LAS float* lg, const float* bg, const float* be, int& e0, int& e1, float& g0, float& g1) {
    float gl[4]; int gt = 0; float gm;
#pragma unroll
    for (int i = 0; i < 4; ++i) gl[i] = lg[i] + bg[i];
    gm = gl[0];
#pragma unroll
    for (int i = 1; i < 4; ++i) if (gl[i] > gm) { gm = gl[i]; gt = i; }
    float gs = 0.f;
#pragma unroll
    for (int i = 0; i < 4; ++i) gs += __expf(gl[i] - gm);
    const float pg = 1.0f / gs;
    float el[8];
#pragma unroll
    for (int i = 0; i < 8; ++i) el[i] = lg[4 + 8 * gt + i] + be[8 * gt + i];
    int i0 = 0; float m0 = el[0];
#pragma unroll
    for (int i = 1; i < 8; ++i) if (el[i] > m0) { m0 = el[i]; i0 = i; }
    int i1 = -1; float m1 = -3.0e38f;
#pragma unroll
    for (int i = 0; i < 8; ++i) if (i != i0 && el[i] > m1) { m1 = el[i]; i1 = i; }
    float one = 1.0f; asm volatile("" : "+v"(one));
    const float q1 = __expf(m1 - m0); const float inv = one / (one + q1);
    e0 = gt * 8 + i0; e1 = gt * 8 + i1; g0 = pg * inv; g1 = pg * q1 * inv;
}
constexpr int RW_AS = 64 * 68;
__device__ __forceinline__ void rwkv_naive(const Ctx& c, const Params& p, int bh) {
    const int b = bh >> 3, hd = bh & 7, tid = c.tid, lane = c.lane, wv = c.wave;
    LAS float* L = (LAS float*)c.shm;
    LAS float* aR = L; LAS float* aK = L + RW_AS; LAS float* aV = L + 2 * RW_AS; LAS float* aW = L + 3 * RW_AS; LAS float* aA = L + 4 * RW_AS;
    LAS float* aB = L + 5 * RW_AS; LAS float* aG = L + 6 * RW_AS; LAS float* aY = L + 7 * RW_AS; LAS float* red = L + 8 * RW_AS;
    const bf16_t* P = (const bf16_t*)(p.ws + OFF_P); bf16_t* MIX = (bf16_t*)(p.ws + OFF_H);
    LAS f32x4* SL = (LAS f32x4*)(L + 8 * RW_AS + 1536);
    if (wv == 0) {
#pragma unroll
        for (int j4 = 0; j4 < 16; ++j4) SL[j4 * 64 + lane] = (f32x4){0.f, 0.f, 0.f, 0.f}; }
    const int t = lane, cg = wv;
    const int ch0 = hd * 64 + cg * 8;
    for (int tb = 0; tb < 64; ++tb) {
        const size_t tg0 = (size_t)b * SEQ + (size_t)tb * 64;
#pragma unroll 1
        for (int i = 0; i < 7; ++i) {
            const int task = tid + 512 * i, tt = task / 56, q = task % 56;
            int col; LAS float* dst; int kind = 0;
            if (q < 8) { col = hd * 64 + 8 * q; dst = aR + tt * 68 + 8 * q; }
            else if (q < 16) { col = 512 + hd * 64 + 8 * (q - 8); dst = aK + tt * 68 + 8 * (q - 8); }
            else if (q < 24) { col = 1024 + hd * 64 + 8 * (q - 16); dst = aV + tt * 68 + 8 * (q - 16); }
            else if (q < 32) { col = 1536 + 8 * (q - 24); dst = aW + tt * 68 + 8 * (q - 24); kind = 1; }
            else if (q < 40) { col = 1600 + 8 * (q - 32); dst = aA + tt * 68 + 8 * (q - 32); }
            else if (q < 48) { col = 1664 + 8 * (q - 40); dst = aB + tt * 68 + 8 * (q - 40); kind = 2; }
            else { col = 1664 + 8 * (q - 40); dst = aG + tt * 68 + 8 * (q - 48); kind = 2; }
            const bf16_t* src = P + (tg0 + tt) * EV_IN + 768 + col;
            const u32x4 cur = *(const u32x4*)src;
            u32x4 prv = (u32x4){0u, 0u, 0u, 0u};
            if (tb * 64 + tt > 0) prv = *(const u32x4*)(src - EV_IN);
            const f32x4 m0 = *(const f32x4*)(p.ev_mu + col), m1 = *(const f32x4*)(p.ev_mu + col + 4);
            float v[8];
            const unsigned cw[4] = {cur.x, cur.y, cur.z, cur.w}, pw[4] = {prv.x, prv.y, prv.z, prv.w};
            const float mu[8] = {m0.x, m0.y, m0.z, m0.w, m1.x, m1.y, m1.z, m1.w};
#pragma unroll
            for (int k = 0; k < 4; ++k) { const float c0 = bflo(cw[k]), c1 = bfhi(cw[k]), p0 = bflo(pw[k]), p1 = bfhi(pw[k]);
                v[2 * k] = c0 + (p0 - c0) * mu[2 * k]; v[2 * k + 1] = c1 + (p1 - c1) * mu[2 * k + 1]; }
            if (kind == 1) {
#pragma unroll
                for (int k = 0; k < 8; ++k) v[k] = tanhf(v[k]); }
            if (kind == 2) {
#pragma unroll
                for (int k = 0; k < 8; ++k) v[k] = sigmoidf_(v[k]); }
            *(LAS f32x4*)dst = (f32x4){v[0], v[1], v[2], v[3]}; *(LAS f32x4*)(dst + 4) = (f32x4){v[4], v[5], v[6], v[7]};
        }
        __syncthreads();
        float zw[8], za[8], gg[8];
#pragma unroll
        for (int i = 0; i < 8; ++i) { zw[i] = 0.f; za[i] = 0.f; gg[i] = 0.f; }
#pragma unroll 2
        for (int j4 = 0; j4 < 16; ++j4) {
            const f32x4 xw = *(const LAS f32x4*)(aW + t * 68 + 4 * j4), xa = *(const LAS f32x4*)(aA + t * 68 + 4 * j4);
            const f32x4 g0 = *(const LAS f32x4*)(aB + t * 68 + 4 * j4), g1 = *(const LAS f32x4*)(aG + t * 68 + 4 * j4);
#pragma unroll
            for (int jj = 0; jj < 4; ++jj) { const int j = 4 * j4 + jj;
                const f32x4 w2a = *(const f32x4*)(p.ev_w2 + (size_t)j * 512 + ch0), w2b = *(const f32x4*)(p.ev_w2 + (size_t)j * 512 + ch0 + 4);
                const f32x4 a2a = *(const f32x4*)(p.ev_a2 + (size_t)j * 512 + ch0), a2b = *(const f32x4*)(p.ev_a2 + (size_t)j * 512 + ch0 + 4);
                const f32x4 gla = *(const f32x4*)(p.ev_g2 + (size_t)j * 512 + ch0), glb = *(const f32x4*)(p.ev_g2 + (size_t)j * 512 + ch0 + 4);
                const f32x4 gha = *(const f32x4*)(p.ev_g2 + (size_t)(64 + j) * 512 + ch0), ghb = *(const f32x4*)(p.ev_g2 + (size_t)(64 + j) * 512 + ch0 + 4);
                const float xwv = xw[jj], xav = xa[jj], g0v = g0[jj], g1v = g1[jj];
#pragma unroll
                for (int i = 0; i < 4; ++i) { zw[i] += xwv * w2a[i]; zw[4 + i] += xwv * w2b[i]; za[i] += xav * a2a[i]; za[4 + i] += xav * a2b[i];
                    gg[i] += g0v * gla[i] + g1v * gha[i]; gg[4 + i] += g0v * glb[i] + g1v * ghb[i]; } }
        }
        float av[8], kkv[8]; float ss = 0.f;
        {
            const f32x4 kA = *(const LAS f32x4*)(aK + t * 68 + cg * 8), kB = *(const LAS f32x4*)(aK + t * 68 + cg * 8 + 4);
            const float kv[8] = {kA.x, kA.y, kA.z, kA.w, kB.x, kB.y, kB.z, kB.w};
            float dec[8], kp[8];
#pragma unroll
            for (int i = 0; i < 8; ++i) { const int ch = ch0 + i;
                const float u = -(p.ev_w0[ch] + zw[i]); const float sp = (u > 20.f) ? u : log1pf(__expf(u));
                const float w = -sp - 0.5f; dec[i] = __expf(-__expf(w));
                av[i] = sigmoidf_(p.ev_a0[ch] + za[i]);
                kkv[i] = kv[i] * p.ev_k_k[ch]; ss += kkv[i] * kkv[i];
                kp[i] = kv[i] * (1.0f + (av[i] - 1.0f) * p.ev_k_a[ch]); }
            red[t * 8 + cg] = ss;
            __syncthreads();
            *(LAS f32x4*)(aW + t * 68 + cg * 8) = (f32x4){dec[0], dec[1], dec[2], dec[3]}; *(LAS f32x4*)(aW + t * 68 + cg * 8 + 4) = (f32x4){dec[4], dec[5], dec[6], dec[7]};
            *(LAS f32x4*)(aK + t * 68 + cg * 8) = (f32x4){kp[0], kp[1], kp[2], kp[3]}; *(LAS f32x4*)(aK + t * 68 + cg * 8 + 4) = (f32x4){kp[4], kp[5], kp[6], kp[7]};
            *(LAS f32x4*)(aG + t * 68 + cg * 8) = (f32x4){gg[0], gg[1], gg[2], gg[3]}; *(LAS f32x4*)(aG + t * 68 + cg * 8 + 4) = (f32x4){gg[4], gg[5], gg[6], gg[7]};
            float tot = 0.f;
#pragma unroll
            for (int i = 0; i < 8; ++i) tot += red[t * 8 + i];
            const float inv = 1.0f / fmaxf(sqrtf(tot), 1e-12f);
            float an[8], bn[8];
#pragma unroll
            for (int i = 0; i < 8; ++i) { const float kn = kkv[i] * inv; an[i] = -kn; bn[i] = kn * av[i]; }
            *(LAS f32x4*)(aA + t * 68 + cg * 8) = (f32x4){an[0], an[1], an[2], an[3]}; *(LAS f32x4*)(aA + t * 68 + cg * 8 + 4) = (f32x4){an[4], an[5], an[6], an[7]};
            *(LAS f32x4*)(aB + t * 68 + cg * 8) = (f32x4){bn[0], bn[1], bn[2], bn[3]}; *(LAS f32x4*)(aB + t * 68 + cg * 8 + 4) = (f32x4){bn[4], bn[5], bn[6], bn[7]};
        }
        __syncthreads();
        if (wv == 0) {
            float S[64];
#pragma unroll
            for (int j4 = 0; j4 < 16; ++j4) { const f32x4 s4 = SL[j4 * 64 + lane]; S[4 * j4] = s4.x; S[4 * j4 + 1] = s4.y; S[4 * j4 + 2] = s4.z; S[4 * j4 + 3] = s4.w; }
#pragma unroll 1
            for (int tt = 0; tt < 64; ++tt) {
                const float vv = aV[tt * 68 + lane];
                float sa = 0.f;
#pragma unroll
                for (int j4 = 0; j4 < 16; ++j4) { const f32x4 a4 = *(const LAS f32x4*)(aA + tt * 68 + 4 * j4);
                    sa += S[4 * j4] * a4.x; sa += S[4 * j4 + 1] * a4.y; sa += S[4 * j4 + 2] * a4.z; sa += S[4 * j4 + 3] * a4.w; }
                float y = 0.f;
#pragma unroll
                for (int j4 = 0; j4 < 16; ++j4) {
                    const f32x4 d4 = *(const LAS f32x4*)(aW + tt * 68 + 4 * j4), b4 = *(const LAS f32x4*)(aB + tt * 68 + 4 * j4);
                    const f32x4 k4 = *(const LAS f32x4*)(aK + tt * 68 + 4 * j4), r4 = *(const LAS f32x4*)(aR + tt * 68 + 4 * j4);
#pragma unroll
                    for (int jj = 0; jj < 4; ++jj) { const int j = 4 * j4 + jj; S[j] = S[j] * d4[jj] + sa * b4[jj] + vv * k4[jj]; y += S[j] * r4[jj]; } }
                aY[tt * 68 + lane] = y;
            }
#pragma unroll
            for (int j4 = 0; j4 < 16; ++j4) SL[j4 * 64 + lane] = (f32x4){S[4 * j4], S[4 * j4 + 1], S[4 * j4 + 2], S[4 * j4 + 3]};
        }
        __syncthreads();
        {
            const f32x4 yA = *(const LAS f32x4*)(aY + t * 68 + cg * 8), yB = *(const LAS f32x4*)(aY + t * 68 + cg * 8 + 4);
            const f32x4 rA = *(const LAS f32x4*)(aR + t * 68 + cg * 8), rB = *(const LAS f32x4*)(aR + t * 68 + cg * 8 + 4);
            const f32x4 kA = *(const LAS f32x4*)(aK + t * 68 + cg * 8), kB = *(const LAS f32x4*)(aK + t * 68 + cg * 8 + 4);
            const f32x4 vA = *(const LAS f32x4*)(aV + t * 68 + cg * 8), vB = *(const LAS f32x4*)(aV + t * 68 + cg * 8 + 4);
            const f32x4 gA = *(const LAS f32x4*)(aG + t * 68 + cg * 8), gB = *(const LAS f32x4*)(aG + t * 68 + cg * 8 + 4);
            const float y[8] = {yA.x, yA.y, yA.z, yA.w, yB.x, yB.y, yB.z, yB.w}, r[8] = {rA.x, rA.y, rA.z, rA.w, rB.x, rB.y, rB.z, rB.w};
            const float k[8] = {kA.x, kA.y, kA.z, kA.w, kB.x, kB.y, kB.z, kB.w}, v[8] = {vA.x, vA.y, vA.z, vA.w, vB.x, vB.y, vB.z, vB.w};
            const float g[8] = {gA.x, gA.y, gA.z, gA.w, gB.x, gB.y, gB.z, gB.w};
            float s1 = 0.f, sb = 0.f;
#pragma unroll
            for (int i = 0; i < 8; ++i) { s1 += y[i]; sb += r[i] * k[i] * p.ev_r_k[ch0 + i]; }
            red[t * 8 + cg] = s1; red[512 + t * 8 + cg] = sb;
            __syncthreads();
            float m = 0.f, bon = 0.f;
#pragma unroll
            for (int i = 0; i < 8; ++i) { m += red[t * 8 + i]; bon += red[512 + t * 8 + i]; }
            m *= (1.0f / 64.0f);
            float s2 = 0.f;
#pragma unroll
            for (int i = 0; i < 8; ++i) s2 += (y[i] - m) * (y[i] - m);
            red[1024 + t * 8 + cg] = s2;
            __syncthreads();
            float var = 0.f;
#pragma unroll
            for (int i = 0; i < 8; ++i) var += red[1024 + t * 8 + i];
            const float rs = 1.0f / sqrtf(var * (1.0f / 64.0f) + 64e-5f);
            float o[8];
#pragma unroll
            for (int i = 0; i < 8; ++i) o[i] = ((y[i] - m) * rs * p.ev_lnx_w[ch0 + i] + p.ev_lnx_b[ch0 + i] + bon * v[i]) * g[i];
            u32x4 w; w.x = pk2(o[0], o[1]); w.y = pk2(o[2], o[3]); w.z = pk2(o[4], o[5]); w.w = pk2(o[6], o[7]);
            *(u32x4*)(MIX + (tg0 + t) * 1024 + 512 + ch0) = w;
        }
        __syncthreads();
    }
}

__device__ __forceinline__ void swa_naive(const Ctx& c, const Params& p, int unit) {
    const int b = unit >> 6, g = (unit >> 5) & 1, n = unit & 31, tid = c.tid, lane = c.lane, wv = c.wave;
    LAS bf16_t* Ks = (LAS bf16_t*)c.shm;
    LAS bf16_t* Vs = (LAS bf16_t*)(c.shm + 256 * 144);
    LAS float* qf = (LAS float*)(c.shm + 256 * 144 + 256 * 128) + wv * 320;
    LAS float* pr = qf + 64;
    const bf16_t* P = (const bf16_t*)(p.ws + OFF_P); bf16_t* MIX = (bf16_t*)(p.ws + OFF_H);
    __syncthreads();
#pragma unroll 1
    for (int i = 0; i < 8; ++i) {
        const int task = tid + 512 * i, which = task >> 11, r = (task >> 3) & 255, ck = task & 7;
        const int tk = n * 128 - 128 + r;
        u32x4 d = (u32x4){0u, 0u, 0u, 0u};
        if (tk >= 0) d = *(const u32x4*)(P + ((size_t)b * SEQ + tk) * EV_IN + 512 + which * 128 + g * 64 + ck * 8);
        if (which == 0) *(LAS u32x4*)(Ks + r * 72 + ck * 8) = d; else *(LAS u32x4*)(Vs + r * 64 + ck * 8) = d;
    }
    __syncthreads();
    const int head = g * 4 + (wv >> 1);
    const float sink = p.ev_sinks[head];
#pragma unroll 1
    for (int qq = 0; qq < 64; ++qq) {
        const int qi = (wv & 1) * 64 + qq;
        const size_t tq = (size_t)b * SEQ + n * 128 + qi;
        qf[lane] = bf2f(P[tq * EV_IN + head * 64 + lane]) * 0.125f;
        LDS_WAIT();
        float s[4];
#pragma unroll
        for (int j = 0; j < 4; ++j) { const int kp = lane + 64 * j; float a = 0.f;
#pragma unroll
            for (int ck = 0; ck < 8; ++ck) { const u32x4 kk = *(const LAS u32x4*)(Ks + kp * 72 + ck * 8);
                const f32x4 q0 = *(const LAS f32x4*)(qf + ck * 8), q1 = *(const LAS f32x4*)(qf + ck * 8 + 4);
                a += bflo(kk.x) * q0.x + bfhi(kk.x) * q0.y + bflo(kk.y) * q0.z + bfhi(kk.y) * q0.w + bflo(kk.z) * q1.x + bfhi(kk.z) * q1.y + bflo(kk.w) * q1.z + bfhi(kk.w) * q1.w; }
            const bool valid = (kp >= qi + 1) && (kp <= qi + 128) && (n > 0 || kp >= 128);
            s[j] = valid ? a : -INFINITY; }
        float m = fmaxf(fmaxf(s[0], s[1]), fmaxf(s[2], s[3])); m = fmaxf(wave_max(m), sink);
        float den = 0.f;
#pragma unroll
        for (int j = 0; j < 4; ++j) { const float e = __expf(s[j] - m); pr[lane + 64 * j] = e; den += e; }
        den = wave_sum(den) + __expf(sink - m);
        LDS_WAIT();
        float o = 0.f;
#pragma unroll 8
        for (int kp = qi + 1; kp <= qi + 128; ++kp) o += pr[kp] * bf2f(Vs[kp * 64 + lane]);
        MIX[tq * 1024 + head * 64 + lane] = (bf16_t)f2bf(o / den);
    }
}
__device__ __forceinline__ void gla_naive(const Ctx& c, const Params& p, int bh) {
    const int b = bh >> 2, hd = bh & 3, tid = c.tid, lane = c.lane, wv = c.wave;
    LAS float* qs = (LAS float*)c.shm; LAS float* ks = qs + 32 * 128; LAS float* es = ks + 32 * 128; LAS float* vs = es + 32 * 128; LAS float* os = vs + 32 * 256;
    const bf16_t* P = (const bf16_t*)(p.ws + OFF_P); const float* GK = (const float*)(p.ws + OFF_R); bf16_t* MIX = (bf16_t*)(p.ws + OFF_H);
    float S[128];
#pragma unroll
    for (int j = 0; j < 128; ++j) S[j] = 0.f;
    for (int tb = 0; tb < 128; ++tb) {
        const size_t tg0 = (size_t)b * SEQ + (size_t)tb * 32;
#pragma unroll 1
        for (int i = 0; i < 8; ++i) { const int idx = tid + 512 * i, tt = idx >> 7, j = idx & 127;
            const bf16_t* row = P + (tg0 + tt) * OD_IN;
            qs[idx] = bf2f(row[hd * 128 + j]) * 0.08838834764831845f; ks[idx] = bf2f(row[512 + hd * 128 + j]); es[idx] = __expf(GK[(tg0 + tt) * 512 + hd * 128 + j]); }
#pragma unroll 1
        for (int i = 0; i < 16; ++i) { const int idx = tid + 512 * i, tt = idx >> 8, j = idx & 255; vs[idx] = bf2f(P[(tg0 + tt) * OD_IN + 1024 + hd * 256 + j]); }
        __syncthreads();
        if (wv < 4) {
#pragma unroll 1
            for (int tt = 0; tt < 32; ++tt) {
                const float vv = vs[tt * 256 + tid]; float o = 0.f;
#pragma unroll
                for (int j4 = 0; j4 < 32; ++j4) {
                    const f32x4 e4 = *(const LAS f32x4*)(es + tt * 128 + 4 * j4), k4 = *(const LAS f32x4*)(ks + tt * 128 + 4 * j4), q4 = *(const LAS f32x4*)(qs + tt * 128 + 4 * j4);
#pragma unroll
                    for (int jj = 0; jj < 4; ++jj) { const int j = 4 * j4 + jj; S[j] = S[j] * e4[jj] + k4[jj] * vv; o += q4[jj] * S[j]; } }
                os[tt * 256 + tid] = o;
            }
        }
        __syncthreads();
#pragma unroll 1
        for (int i = 0; i < 4; ++i) { const int tt = wv + 8 * i;
            const f32x4 o4 = *(const LAS f32x4*)(os + tt * 256 + 4 * lane);
            const float ss = wave_sum(o4.x * o4.x + o4.y * o4.y + o4.z * o4.z + o4.w * o4.w);
            const float rs = 1.0f / sqrtf(ss * (1.0f / 256.0f) + 1e-6f);
            const f32x4 gn = *(const f32x4*)(p.od_onorm + 4 * lane);
            const u32x2 og = *(const u32x2*)(P + (tg0 + tt) * OD_IN + 2048 + hd * 256 + 4 * lane);
            const float g0 = bflo(og.x), g1 = bfhi(og.x), g2 = bflo(og.y), g3 = bfhi(og.y);
            u32x2 w; w.x = pk2(o4.x * rs * gn.x * g0 * sigmoidf_(g0), o4.y * rs * gn.y * g1 * sigmoidf_(g1)); w.y = pk2(o4.z * rs * gn.z * g2 * sigmoidf_(g2), o4.w * rs * gn.w * g3 * sigmoidf_(g3));
            *(u32x2*)(MIX + (tg0 + tt) * 1024 + hd * 256 + 4 * lane) = w; }
        __syncthreads();
    }
}

__device__ __forceinline__ void xattn_naive(const Ctx& c, const Params& p, int unit) {
    const int b = unit >> 5, hh = (unit >> 3) & 3, tblk = unit & 7, tid = c.tid, lane = c.lane, wv = c.wave;
    LAS bf16_t* Ks = (LAS bf16_t*)c.shm;
    LAS bf16_t* Vs = (LAS bf16_t*)(c.shm + 256 * 272);
    LAS float* qf = (LAS float*)(c.shm + 256 * 272 + 256 * 256) + wv * 384;
    LAS float* pr = qf + 128;
    const bf16_t* MKV = (const bf16_t*)(p.ws + OFF_MKV); const bf16_t* Q = (const bf16_t*)(p.ws + OFF_P); bf16_t* OA = (bf16_t*)(p.ws + OFF_P + 32 * MiB);
    __syncthreads();
#pragma unroll 1
    for (int i = 0; i < 16; ++i) {
        const int task = tid + 512 * i, which = task >> 12, r = (task >> 4) & 255, ck = task & 15;
        const u32x4 d = *(const u32x4*)(MKV + ((size_t)b * MEMLEN + r) * 1024 + which * 512 + hh * 128 + ck * 8);
        if (which == 0) *(LAS u32x4*)(Ks + r * 136 + ck * 8) = d; else *(LAS u32x4*)(Vs + r * 128 + ck * 8) = d;
    }
    __syncthreads();
#pragma unroll 1
    for (int qq = 0; qq < 64; ++qq) {
        const size_t tq = (size_t)b * SEQ + tblk * 512 + wv * 64 + qq;
        qf[lane] = bf2f(Q[tq * 512 + hh * 128 + lane]) * 0.08838834764831845f; qf[lane + 64] = bf2f(Q[tq * 512 + hh * 128 + 64 + lane]) * 0.08838834764831845f;
        LDS_WAIT();
        float s[4];
#pragma unroll
        for (int j = 0; j < 4; ++j) { const int kp = lane + 64 * j; float a = 0.f;
#pragma unroll
            for (int ck = 0; ck < 16; ++ck) { const u32x4 kk = *(const LAS u32x4*)(Ks + kp * 136 + ck * 8);
                const f32x4 q0 = *(const LAS f32x4*)(qf + ck * 8), q1 = *(const LAS f32x4*)(qf + ck * 8 + 4);
                a += bflo(kk.x) * q0.x + bfhi(kk.x) * q0.y + bflo(kk.y) * q0.z + bfhi(kk.y) * q0.w + bflo(kk.z) * q1.x + bfhi(kk.z) * q1.y + bflo(kk.w) * q1.z + bfhi(kk.w) * q1.w; }
            s[j] = a; }
        const float m = wave_max(fmaxf(fmaxf(s[0], s[1]), fmaxf(s[2], s[3])));
        float den = 0.f;
#pragma unroll
        for (int j = 0; j < 4; ++j) { const float e = __expf(s[j] - m); pr[lane + 64 * j] = e; den += e; }
        den = wave_sum(den);
        LDS_WAIT();
        float o0 = 0.f, o1 = 0.f;
#pragma unroll 4
        for (int k4 = 0; k4 < 64; ++k4) { const f32x4 p4 = *(const LAS f32x4*)(pr + 4 * k4);
#pragma unroll
            for (int kk = 0; kk < 4; ++kk) { const unsigned vv = *(const LAS unsigned*)(Vs + (4 * k4 + kk) * 128 + 2 * lane); o0 += p4[kk] * bflo(vv); o1 += p4[kk] * bfhi(vv); } }
        const float inv = 1.0f / den;
        *(unsigned*)(OA + tq * 512 + hh * 128 + 2 * lane) = pk2(o0 * inv, o1 * inv);
    }
}

__device__ __forceinline__ void moe_slots(const Ctx& c, const Params& p, int layer) {
    LAS int* sh = (LAS int*)c.shm;
    const int* cnt = (const int*)(p.ws + OFF_CTL + CTL_CNT) + layer * 32; int* cur = (int*)(p.ws + OFF_CTL + CTL_CUR) + layer * 32;
    int* blk = (int*)(p.ws + OFF_CTL + CTL_BLK) + layer * 1024;
    __syncthreads();
    if (c.tid == 0) { int acc = 0; for (int e = 0; e < NEXP; ++e) { sh[e] = acc; acc += (cnt[e] + 255) / 256 * 256; } sh[32] = acc; }
    __syncthreads();
    if (blockIdx.x == 0 && c.tid < NEXP) { const int e = c.tid, s = sh[e] / 256, en = (e == NEXP - 1 ? sh[32] : sh[e + 1]) / 256; for (int i = s; i < en; ++i) blk[1 + i] = e; if (e == 0) blk[0] = sh[32] / 256; }
    const int2* RE = (const int2*)(p.ws + OFF_ROUTE); int2* RP = (int2*)(p.ws + OFF_ROUTE + 512 * 1024);
    const bf16_t* H = (const bf16_t*)(p.ws + OFF_H); bf16_t* XB = (bf16_t*)(p.ws + OFF_P);
    for (int ck = c.gw; ck < T_TOK / 64; ck += c.ngw) {
        const int t = ck * 64 + c.lane; const int2 ee = RE[t]; int pos0 = 0, pos1 = 0;
#pragma unroll 1
        for (int e = 0; e < NEXP; ++e) {
            const unsigned long long m0 = __ballot(ee.x == e), m1 = __ballot(ee.y == e);
            const int n0 = __popcll(m0), n1 = __popcll(m1);
            if (n0 + n1 == 0) continue;
            int base = 0; if (c.lane == 0) base = atomicAdd(&cur[e], n0 + n1);
            base = __shfl(base, 0) + sh[e];
            const unsigned long long lt = (1ull << c.lane) - 1ull;
            if (ee.x == e) pos0 = base + __popcll(m0 & lt);
            if (ee.y == e) pos1 = base + n0 + __popcll(m1 & lt);
        }
        RP[t] = make_int2(pos0, pos1);
#pragma unroll 1
        for (int i = 0; i < 64; ++i) { const int ti = ck * 64 + i, q0 = __shfl(pos0, i), q1 = __shfl(pos1, i);
            const u32x4 a = *((const u32x4*)(H + (size_t)ti * 1024) + c.lane), bq = *((const u32x4*)(H + (size_t)ti * 1024) + 64 + c.lane);
            *((u32x4*)(XB + (size_t)q0 * 1024) + c.lane) = a; *((u32x4*)(XB + (size_t)q0 * 1024) + 64 + c.lane) = bq;
            *((u32x4*)(XB + (size_t)q1 * 1024) + c.lane) = a; *((u32x4*)(XB + (size_t)q1 * 1024) + 64 + c.lane) = bq; }
    }
}
typedef short bf16x8_t __attribute__((ext_vector_type(8)));
constexpr size_t R_GK = 0, R_QT = 64 * MiB, R_ATT = 96 * MiB, R_KHT = 112 * MiB, R_GDEC = 144 * MiB;
template <int CTRL, int RMASK> __device__ __forceinline__ float dpp_get0(float x) {
    return __builtin_bit_cast(float, __builtin_amdgcn_update_dpp(0, __builtin_bit_cast(int, x), CTRL, RMASK, 0xF, false)); }
__device__ __forceinline__ float wave_scan_incl(float x, int lane) {
    (void)lane;
    x += dpp_get0<0x111, 0xF>(x); x += dpp_get0<0x112, 0xF>(x); x += dpp_get0<0x114, 0xF>(x); x += dpp_get0<0x118, 0xF>(x);
    x += dpp_get0<0x142, 0xA>(x); x += dpp_get0<0x143, 0xC>(x);
    return x;
}
__device__ __forceinline__ float lane63(float x) { return __builtin_bit_cast(float, __builtin_amdgcn_readlane(__builtin_bit_cast(int, x), 63)); }
__device__ __forceinline__ int key_perm(int key) { const int kq = key & 31; return (key & ~31) + 8 * ((kq >> 2) & 3) + 4 * ((kq >> 4) & 1) + (kq & 3); }
__device__ __forceinline__ bf16x8_t zero_frag() { return (bf16x8_t){0, 0, 0, 0, 0, 0, 0, 0}; }
__device__ __forceinline__ bf16x8_t lds_frag(const LAS bf16_t* img, int pitch, int row, int col) { return *(const LAS bf16x8_t*)(img + row * pitch + col); }
__device__ __forceinline__ bf16x8_t pack8(const float (&v)[8]) {
    u32x4 w; w.x = pk2(v[0], v[1]); w.y = pk2(v[2], v[3]); w.z = pk2(v[4], v[5]); w.w = pk2(v[6], v[7]);
    return __builtin_bit_cast(bf16x8_t, w);
}
__device__ __forceinline__ void gla_prep(const Ctx& c, const Params& p, int unit) {
    const int bh = unit >> 6, ck = unit & 63, b = bh >> 2, hd = bh & 3, lane = c.lane, wv = c.wave;
    LAS bf16_t* Qs = (LAS bf16_t*)c.shm;
    LAS bf16_t* Ks = Qs + 64 * 136;
    const bf16_t* P = (const bf16_t*)(p.ws + OFF_P); unsigned char* R = p.ws + OFF_R;
    const float* GK = (const float*)(R + R_GK); bf16_t* QT = (bf16_t*)(R + R_QT) + (size_t)unit * 64 * 128; bf16_t* ATT = (bf16_t*)(R + R_ATT) + (size_t)unit * 64 * 64;
    bf16_t* KHT = (bf16_t*)(R + R_KHT) + (size_t)unit * 128 * 64; float* GDEC = (float*)(R + R_GDEC) + (size_t)unit * 128;
    const size_t tg = (size_t)b * SEQ + ck * 64 + lane; const int d0 = wv * 16;
    __syncthreads();
    {
        const bf16_t* row = P + tg * OD_IN;
        const u32x4 qa = *(const u32x4*)(row + hd * 128 + d0), qb = *(const u32x4*)(row + hd * 128 + d0 + 8);
        const u32x4 ka = *(const u32x4*)(row + 512 + hd * 128 + d0), kb = *(const u32x4*)(row + 512 + hd * 128 + d0 + 8);
        const unsigned qw[8] = {qa.x, qa.y, qa.z, qa.w, qb.x, qb.y, qb.z, qb.w}, kw[8] = {ka.x, ka.y, ka.z, ka.w, kb.x, kb.y, kb.z, kb.w};
        float qt[16], kt[16], kh[16];
#pragma unroll
        for (int i4 = 0; i4 < 4; ++i4) { const f32x4 g4 = *(const f32x4*)(GK + tg * 512 + hd * 128 + d0 + 4 * i4);
#pragma unroll
            for (int ii = 0; ii < 4; ++ii) { const int i = 4 * i4 + ii;
                const float bb = wave_scan_incl(g4[ii], lane); const float bl = lane63(bb);
                const float qv = (i & 1) ? bfhi(qw[i >> 1]) : bflo(qw[i >> 1]), kv = (i & 1) ? bfhi(kw[i >> 1]) : bflo(kw[i >> 1]);
                qt[i] = qv * 0.08838834764831845f * __expf(bb); kt[i] = kv * __expf(-bb); kh[i] = kv * __expf(bl - bb);
                if (lane == 63) GDEC[d0 + i] = __expf(bl); } }
        { u32x4 w0, w1; w0.x = pk2(qt[0], qt[1]); w0.y = pk2(qt[2], qt[3]); w0.z = pk2(qt[4], qt[5]); w0.w = pk2(qt[6], qt[7]); w1.x = pk2(qt[8], qt[9]); w1.y = pk2(qt[10], qt[11]); w1.z = pk2(qt[12], qt[13]); w1.w = pk2(qt[14], qt[15]);
          *(LAS u32x4*)(Qs + lane * 136 + d0) = w0; *(LAS u32x4*)(Qs + lane * 136 + d0 + 8) = w1; }
        { u32x4 w0, w1; w0.x = pk2(kt[0], kt[1]); w0.y = pk2(kt[2], kt[3]); w0.z = pk2(kt[4], kt[5]); w0.w = pk2(kt[6], kt[7]); w1.x = pk2(kt[8], kt[9]); w1.y = pk2(kt[10], kt[11]); w1.z = pk2(kt[12], kt[13]); w1.w = pk2(kt[14], kt[15]);
          *(LAS u32x4*)(Ks + lane * 136 + d0) = w0; *(LAS u32x4*)(Ks + lane * 136 + d0 + 8) = w1; }
        { const int sg = d0 >> 5, hb = (d0 >> 4) & 1;
#pragma unroll
          for (int x4 = 0; x4 < 4; ++x4) { u32x2 w; w.x = pk2(qt[4 * x4], qt[4 * x4 + 1]); w.y = pk2(qt[4 * x4 + 2], qt[4 * x4 + 3]);
              *(u32x2*)(QT + lane * 128 + 32 * sg + 8 * x4 + 4 * hb) = w; } }
        { const int sc = key_perm(lane);
#pragma unroll
          for (int i = 0; i < 16; ++i) KHT[(d0 + i) * 64 + sc] = (bf16_t)f2bf(kh[i]); }
    }
    __syncthreads();
    const int fr = lane & 15, fq = lane >> 4;
#pragma unroll
    for (int h2 = 0; h2 < 2; ++h2) { const int tile = 2 * wv + h2, si = tile >> 2, ti = tile & 3;
        f32x4 acc = (f32x4){0.f, 0.f, 0.f, 0.f};
        if (si <= ti) {
#pragma unroll
            for (int kk = 0; kk < 4; ++kk) { const bf16x8_t a = *(const LAS bf16x8_t*)(Ks + (16 * si + fr) * 136 + 32 * kk + 8 * fq), bq = *(const LAS bf16x8_t*)(Qs + (16 * ti + fr) * 136 + 32 * kk + 8 * fq);
                acc = __builtin_amdgcn_mfma_f32_16x16x32_bf16(a, bq, acc, 0, 0, 0); } }
        const int t = 16 * ti + fr, s0 = 16 * si + 4 * fq;
        u32x2 w; w.x = pk2(s0 <= t ? acc[0] : 0.f, s0 + 1 <= t ? acc[1] : 0.f); w.y = pk2(s0 + 2 <= t ? acc[2] : 0.f, s0 + 3 <= t ? acc[3] : 0.f);
        *(u32x2*)(ATT + t * 64 + 32 * (si >> 1) + 8 * fq + 4 * (si & 1)) = w; }
}
constexpr int GB_QT = 0, GB_ATT = 64 * 136 * 2, GB_KHT = GB_ATT + 64 * 72 * 2, GB_GD = GB_KHT + 128 * 72 * 2, GB_V = GB_GD + 512, GB_BYTES = GB_V + 64 * 72 * 2;
struct GlaFill { u32x4 r[25]; };
__device__ __forceinline__ void gla_fill_load(GlaFill& f, const Params& p, int unit, int ptid, const bf16_t* vsrc) {
    const unsigned char* R = p.ws + OFF_R;
    const bf16_t* QT = (const bf16_t*)(R + R_QT) + (size_t)unit * 64 * 128; const bf16_t* ATT = (const bf16_t*)(R + R_ATT) + (size_t)unit * 64 * 64;
    const bf16_t* KHT = (const bf16_t*)(R + R_KHT) + (size_t)unit * 128 * 64; const float* GDEC = (const float*)(R + R_GDEC) + (size_t)unit * 128;
#pragma unroll
    for (int i = 0; i < 8; ++i) f.r[i] = *((const u32x4*)QT + ptid + 128 * i);
#pragma unroll
    for (int i = 0; i < 4; ++i) f.r[8 + i] = *((const u32x4*)ATT + ptid + 128 * i);
#pragma unroll
    for (int i = 0; i < 8; ++i) f.r[12 + i] = *((const u32x4*)KHT + ptid + 128 * i);
    f.r[20] = (u32x4){0u, 0u, 0u, 0u}; if (ptid < 32) f.r[20] = *((const u32x4*)GDEC + ptid);
#pragma unroll
    for (int i = 0; i < 4; ++i) { const int idx = ptid + 128 * i; f.r[21 + i] = *(const u32x4*)(vsrc + (size_t)(idx >> 3) * OD_IN + (idx & 7) * 8); }
}
__device__ __forceinline__ void gla_fill_store(const GlaFill& f, unsigned char* buf, int ptid) {
#pragma unroll
    for (int i = 0; i < 8; ++i) { const int idx = ptid + 128 * i; *(LAS u32x4*)(buf + GB_QT + (idx >> 4) * 272 + (idx & 15) * 16) = f.r[i]; }
#pragma unroll
    for (int i = 0; i < 4; ++i) { const int idx = ptid + 128 * i; *(LAS u32x4*)(buf + GB_ATT + (idx >> 3) * 144 + (idx & 7) * 16) = f.r[8 + i]; }
#pragma unroll
    for (int i = 0; i < 8; ++i) { const int idx = ptid + 128 * i; *(LAS u32x4*)(buf + GB_KHT + (idx >> 3) * 144 + (idx & 7) * 16) = f.r[12 + i]; }
    if (ptid < 32) *(LAS u32x4*)(buf + GB_GD + ptid * 16) = f.r[20];
#pragma unroll
    for (int i = 0; i < 4; ++i) { const int idx = ptid + 128 * i; *(LAS u32x4*)(buf + GB_V + (idx >> 3) * 144 + (idx & 7) * 16) = f.r[21 + i]; }
}
#define GLA_STEP_BARRIER() do { asm volatile("s_waitcnt lgkmcnt(0)" ::: "memory"); __builtin_amdgcn_s_barrier(); asm volatile("" ::: "memory"); } while (0)
__device__ __forceinline__ void gla_state(const Ctx& c, const Params& p, int bh, int slice) {
    const int b = bh >> 2, hd = bh & 3, lane = c.lane, wv = c.wave, fr = lane & 15, fq = lane >> 4, jl = wv & 3, jt = slice * 4 + jl;
    const bf16_t* P = (const bf16_t*)(p.ws + OFF_P); bf16_t* O = (bf16_t*)p.out;
    unsigned char* sm = c.shm;
    const size_t tb = (size_t)b * SEQ; const bf16_t* vbase = P + tb * OD_IN + 1024 + hd * 256 + 64 * slice;
    __syncthreads();
    if (wv >= 4) {
        const int pg = (wv - 4) >> 1, ptid = c.tid & 127;
        GlaFill fs;
        if (pg == 1) { gla_fill_load(fs, p, bh * 64, ptid, vbase); gla_fill_store(fs, sm, ptid); gla_fill_load(fs, p, bh * 64 + 2, ptid, vbase + (size_t)128 * OD_IN); } else gla_fill_load(fs, p, bh * 64 + 1, ptid, vbase + (size_t)64 * OD_IN);
        GLA_STEP_BARRIER();
#pragma unroll 1
        for (int ck = 0; ck < 64; ++ck) {
            if (((ck + 1) & 1) != pg && ck + 1 < 64) { gla_fill_store(fs, sm + ((ck + 1) & 1) * GB_BYTES, ptid); if (ck + 3 < 64) gla_fill_load(fs, p, bh * 64 + ck + 3, ptid, vbase + (size_t)(ck + 3) * 64 * OD_IN); }
            GLA_STEP_BARRIER();
        }
    } else if (wv < 2) {
        f32x4 S[2][8];
#pragma unroll
        for (int h = 0; h < 2; ++h)
#pragma unroll
            for (int i = 0; i < 8; ++i) S[h][i] = (f32x4){0.f, 0.f, 0.f, 0.f};
        bf16x8_t idf;
        { float iv[8];
#pragma unroll
          for (int e = 0; e < 8; ++e) iv[e] = (8 * fq + e == fr) ? 1.0f : 0.0f;
          idf = pack8(iv); }
        const int jt0 = slice * 4 + 2 * wv;
        GLA_STEP_BARRIER();
#pragma unroll 1
        for (int ck = 0; ck < 64; ++ck) {
            unsigned char* buf = sm + (ck & 1) * GB_BYTES; const size_t t0 = tb + ck * 64;
            const LAS bf16_t* QT = (const LAS bf16_t*)(buf + GB_QT); const LAS bf16_t* ATT = (const LAS bf16_t*)(buf + GB_ATT); const LAS bf16_t* KHT = (const LAS bf16_t*)(buf + GB_KHT); const LAS float* GD = (const LAS float*)(buf + GB_GD);
            const LAS bf16_t* VS = (const LAS bf16_t*)(buf + GB_V);
            bf16x8_t va[2][4], qf[4][4], af[2][4];
#pragma unroll
            for (int h = 0; h < 2; ++h)
#pragma unroll
                for (int st = 0; st < 4; ++st) { va[h][st] = zero_frag(); if (fq < 2) va[h][st] = lds_frag(VS, 72, 16 * st + fr, 32 * wv + 16 * h + 8 * fq); }
#pragma unroll
            for (int sg = 0; sg < 4; ++sg)
#pragma unroll
                for (int ti = 0; ti < 4; ++ti) qf[sg][ti] = lds_frag(QT, 136, 16 * ti + fr, 32 * sg + 8 * fq);
#pragma unroll
            for (int s2 = 0; s2 < 2; ++s2)
#pragma unroll
                for (int ti = 0; ti < 4; ++ti) af[s2][ti] = lds_frag(ATT, 72, 16 * ti + fr, 32 * s2 + 8 * fq);
            asm volatile("s_waitcnt lgkmcnt(0)" ::: "memory");
            bf16x8_t vf[2][2];
#pragma unroll
            for (int h = 0; h < 2; ++h) { f32x4 vt[4];
#pragma unroll
                for (int st = 0; st < 4; ++st) vt[st] = __builtin_amdgcn_mfma_f32_16x16x32_bf16(va[h][st], idf, (f32x4){0.f, 0.f, 0.f, 0.f}, 0, 0, 0);
#pragma unroll
                for (int s2 = 0; s2 < 2; ++s2) { const float vv[8] = {vt[2 * s2][0], vt[2 * s2][1], vt[2 * s2][2], vt[2 * s2][3], vt[2 * s2 + 1][0], vt[2 * s2 + 1][1], vt[2 * s2 + 1][2], vt[2 * s2 + 1][3]}; vf[h][s2] = pack8(vv); } }
            f32x4 acc[2][4];
#pragma unroll
            for (int h = 0; h < 2; ++h)
#pragma unroll
                for (int ti = 0; ti < 4; ++ti) acc[h][ti] = (f32x4){0.f, 0.f, 0.f, 0.f};
#pragma unroll
            for (int sg = 0; sg < 4; ++sg)
#pragma unroll
                for (int h = 0; h < 2; ++h) { const float sv[8] = {S[h][2 * sg][0], S[h][2 * sg][1], S[h][2 * sg][2], S[h][2 * sg][3], S[h][2 * sg + 1][0], S[h][2 * sg + 1][1], S[h][2 * sg + 1][2], S[h][2 * sg + 1][3]};
                    const bf16x8_t a = pack8(sv);
#pragma unroll
                    for (int ti = 0; ti < 4; ++ti) acc[h][ti] = __builtin_amdgcn_mfma_f32_16x16x32_bf16(a, qf[sg][ti], acc[h][ti], 0, 0, 0); }
#pragma unroll
            for (int s2 = 0; s2 < 2; ++s2)
#pragma unroll
                for (int h = 0; h < 2; ++h)
#pragma unroll
                    for (int ti = 0; ti < 4; ++ti) acc[h][ti] = __builtin_amdgcn_mfma_f32_16x16x32_bf16(vf[h][s2], af[s2][ti], acc[h][ti], 0, 0, 0);
#pragma unroll
            for (int h = 0; h < 2; ++h)
#pragma unroll
                for (int ti = 0; ti < 4; ++ti) { u32x2 w; w.x = pk2(acc[h][ti][0], acc[h][ti][1]); w.y = pk2(acc[h][ti][2], acc[h][ti][3]);
                    *(u32x2*)(O + (t0 + 16 * ti + fr) * 1024 + hd * 256 + 16 * (jt0 + h) + 4 * fq) = w; }
#pragma unroll
            for (int rt = 0; rt < 8; ++rt) { const f32x4 g4 = *(const LAS f32x4*)(GD + 16 * rt + 4 * fq);
                const bf16x8_t k0 = lds_frag(KHT, 72, 16 * rt + fr, 8 * fq), k1 = lds_frag(KHT, 72, 16 * rt + fr, 32 + 8 * fq);
#pragma unroll
                for (int h = 0; h < 2; ++h) { f32x4 s = S[h][rt] * g4; s = __builtin_amdgcn_mfma_f32_16x16x32_bf16(k0, vf[h][0], s, 0, 0, 0); s = __builtin_amdgcn_mfma_f32_16x16x32_bf16(k1, vf[h][1], s, 0, 0, 0); S[h][rt] = s; } }
            GLA_STEP_BARRIER();
        }
    } else {
        GLA_STEP_BARRIER();
#pragma unroll 1
        for (int ck = 0; ck < 64; ++ck) GLA_STEP_BARRIER();
    }
}
__device__ __forceinline__ void gla_finish(const Ctx& c, const Params& p) {
    const bf16_t* P = (const bf16_t*)(p.ws + OFF_P); bf16_t* O = (bf16_t*)p.out;
    const f32x4 gn = *((const f32x4*)p.od_onorm + c.lane);
    for (int r0 = c.gw; r0 < T_TOK; r0 += 2 * c.ngw) {
        u32x2 ow[2][4], gw[2][4];
#pragma unroll
        for (int q = 0; q < 2; ++q)
#pragma unroll
            for (int j = 0; j < 4; ++j) { const size_t r = (size_t)(r0 + q * c.ngw); ow[q][j] = *((const u32x2*)(O + r * 1024 + 256 * j) + c.lane); gw[q][j] = *((const u32x2*)(P + r * OD_IN + 2048 + 256 * j) + c.lane); }
#pragma unroll
        for (int q = 0; q < 2; ++q)
#pragma unroll
            for (int j = 0; j < 4; ++j) { const size_t r = (size_t)(r0 + q * c.ngw);
                const float o0 = bflo(ow[q][j].x), o1 = bfhi(ow[q][j].x), o2 = bflo(ow[q][j].y), o3 = bfhi(ow[q][j].y);
                const float ss = wave_sum(o0 * o0 + o1 * o1 + o2 * o2 + o3 * o3); const float rs = 1.0f / sqrtf(ss * (1.0f / 256.0f) + 1e-6f);
                const float g0 = bflo(gw[q][j].x), g1 = bfhi(gw[q][j].x), g2 = bflo(gw[q][j].y), g3 = bfhi(gw[q][j].y);
                u32x2 w; w.x = pk2(o0 * rs * gn.x * g0 * sigmoidf_(g0), o1 * rs * gn.y * g1 * sigmoidf_(g1)); w.y = pk2(o2 * rs * gn.z * g2 * sigmoidf_(g2), o3 * rs * gn.w * g3 * sigmoidf_(g3));
                *((u32x2*)(O + r * 1024 + 256 * j) + c.lane) = w; }
    }
}
constexpr size_t R_MG = 0, R_NT = 32 * MiB, R_QG = 64 * MiB, R_Y0 = 96 * MiB, R_Z0 = 128 * MiB, R_GAM = 160 * MiB, R_BON = 161 * MiB, R_MEMN = 164 * MiB;
constexpr size_t WSM_W2T = 0, WSM_A2T = 64 * 1024;
constexpr size_t WSM_G2T = 512 * 1024;
constexpr int XI = 64 * 72 * 2;
constexpr int X_RHS = 11 * XI, X_DIAG = X_RHS + 34816, X_TI = X_DIAG + 4352, X_RED = X_TI + 3072;

struct RxPre { u32x4 c1[2], p1[2], cr[3], pr[3]; };
__device__ __forceinline__ void rwkv_x_fetch(RxPre& f, const bf16_t* P, int b, int hd, int ck, int tid, int lane, int wv) {
    const size_t tg0 = (size_t)b * SEQ + (size_t)ck * 64; const u32x4 z = (u32x4){0u, 0u, 0u, 0u};
#pragma unroll
    for (int i = 0; i < 2; ++i) { const int task = tid + 512 * i, tt = task >> 4, q = task & 15; const bf16_t* src = P + (tg0 + tt) * EV_IN + 768 + 1536 + 8 * q;
        f.c1[i] = *(const u32x4*)src; f.p1[i] = z; if (ck * 64 + tt > 0) f.p1[i] = *(const u32x4*)(src - EV_IN); }
    const bf16_t* src = P + (tg0 + lane) * EV_IN + 768 + hd * 64 + wv * 8; const bool hp = (ck * 64 + lane > 0);
#pragma unroll
    for (int w3 = 0; w3 < 3; ++w3) { f.cr[w3] = *(const u32x4*)(src + 512 * w3); f.pr[w3] = z; if (hp) f.pr[w3] = *(const u32x4*)(src + 512 * w3 - EV_IN); }
}
__device__ __forceinline__ void rwkv_x(const Ctx& c, const Params& p, int unit, RxPre& pre, int nb, int nhd, int nck) {
    const int bh = unit >> 6, ck = unit & 63, b = bh >> 3, hd = bh & 7, tid = c.tid, lane = c.lane, wv = c.wave, fr = lane & 15, fq = lane >> 4;
    unsigned char* sm = c.shm;
    LAS bf16_t* At = (LAS bf16_t*)sm; LAS bf16_t* Bt = (LAS bf16_t*)(sm + XI); LAS bf16_t* Kt = (LAS bf16_t*)(sm + 2 * XI); LAS bf16_t* Rt = (LAS bf16_t*)(sm + 3 * XI);
    LAS bf16_t* BH = (LAS bf16_t*)(sm + 4 * XI); LAS bf16_t* KH = (LAS bf16_t*)(sm + 5 * XI); LAS bf16_t* VT = (LAS bf16_t*)(sm + 6 * XI);
    LAS bf16_t* AAB = (LAS bf16_t*)(sm + 7 * XI); LAS bf16_t* AAK = (LAS bf16_t*)(sm + 8 * XI); LAS bf16_t* ARB = (LAS bf16_t*)(sm + 9 * XI); LAS bf16_t* ARK = (LAS bf16_t*)(sm + 10 * XI);
    LAS bf16_t* XT = At;
    LAS bf16_t* YT = Kt;
    LAS float* RHS = (LAS float*)(sm + X_RHS);
    LAS float* sXW = RHS; LAS float* sXA = RHS + 64 * 68;
    LAS float* DIAG = (LAS float*)(sm + X_DIAG);
    LAS bf16_t* TI = (LAS bf16_t*)(sm + X_TI);
    LAS float* red = (LAS float*)(sm + X_RED);
    const bf16_t* P = (const bf16_t*)(p.ws + OFF_P); unsigned char* R = p.ws + OFF_R;
    const size_t tg0 = (size_t)b * SEQ + (size_t)ck * 64;
    const int t = lane, cg = wv, ch0 = hd * 64 + cg * 8;
    __syncthreads();
#pragma unroll
    for (int i = 0; i < 2; ++i) {
        const int task = tid + 512 * i, tt = task >> 4, q = task & 15;
        const int col = 1536 + 8 * q; LAS bf16_t* dst = (q < 8 ? At + tt * 72 + 8 * q : Bt + tt * 72 + 8 * (q - 8));
        const u32x4 cur = pre.c1[i], prv = pre.p1[i];
        const f32x4 m0 = *(const f32x4*)(p.ev_mu + col), m1 = *(const f32x4*)(p.ev_mu + col + 4);
        const unsigned cw[4] = {cur.x, cur.y, cur.z, cur.w}, pw[4] = {prv.x, prv.y, prv.z, prv.w}; const float mu[8] = {m0.x, m0.y, m0.z, m0.w, m1.x, m1.y, m1.z, m1.w};
        float v[8];
#pragma unroll
        for (int k = 0; k < 4; ++k) { const float c0 = bflo(cw[k]), c1 = bfhi(cw[k]), p0 = bflo(pw[k]), p1 = bfhi(pw[k]); v[2 * k] = c0 + (p0 - c0) * mu[2 * k]; v[2 * k + 1] = c1 + (p1 - c1) * mu[2 * k + 1]; }
        if (q < 8) {
#pragma unroll
            for (int k = 0; k < 8; ++k) v[k] = tanhf_(v[k]); }
        { u32x4 w; w.x = pk2(v[0], v[1]); w.y = pk2(v[2], v[3]); w.z = pk2(v[4], v[5]); w.w = pk2(v[6], v[7]); *(LAS u32x4*)dst = w; }
    }
    float rv[8], kv[8], vv[8];
    {
#pragma unroll
        for (int w3 = 0; w3 < 3; ++w3) { const u32x4 cur = pre.cr[w3], prv = pre.pr[w3];
            const f32x4 m0 = *(const f32x4*)(p.ev_mu + 512 * w3 + ch0), m1 = *(const f32x4*)(p.ev_mu + 512 * w3 + ch0 + 4);
            const unsigned cw[4] = {cur.x, cur.y, cur.z, cur.w}, pw[4] = {prv.x, prv.y, prv.z, prv.w}; const float mu[8] = {m0.x, m0.y, m0.z, m0.w, m1.x, m1.y, m1.z, m1.w};
#pragma unroll
            for (int k = 0; k < 4; ++k) { const float c0 = bflo(cw[k]), c1 = bfhi(cw[k]), p0 = bflo(pw[k]), p1 = bfhi(pw[k]);
                const float x0 = c0 + (p0 - c0) * mu[2 * k], x1 = c1 + (p1 - c1) * mu[2 * k + 1];
                if (w3 == 0) { rv[2 * k] = x0; rv[2 * k + 1] = x1; } else if (w3 == 1) { kv[2 * k] = x0; kv[2 * k + 1] = x1; } else { vv[2 * k] = x0; vv[2 * k + 1] = x1; } } }
    }
    if (nck >= 0) rwkv_x_fetch(pre, P, nb, nhd, nck, tid, lane, wv);
    __syncthreads();
    {
        const int mat = wv >> 2; const bf16_t* WT = (const bf16_t*)(p.ws + OFF_WSMALL + (mat ? WSM_A2T : WSM_W2T)); const LAS bf16_t* img = mat ? Bt : At; LAS float* dstm = mat ? sXA : sXW;
#pragma unroll
        for (int n = 0; n < 4; ++n) { const int tile = (wv & 3) * 4 + n, ct = tile >> 2, tt = tile & 3;
            f32x4 acc = (f32x4){0.f, 0.f, 0.f, 0.f};
#pragma unroll
            for (int kk = 0; kk < 2; ++kk) acc = __builtin_amdgcn_mfma_f32_16x16x32_bf16(*(const bf16x8_t*)(WT + (size_t)(hd * 64 + 16 * ct + fr) * 64 + 32 * kk + 8 * fq), lds_frag(img, 72, 16 * tt + fr, 32 * kk + 8 * fq), acc, 0, 0, 0);
            *(LAS f32x4*)(dstm + (16 * tt + fr) * 68 + 16 * ct + 4 * fq) = acc; }
    }
    __syncthreads();
    float zw[8], za[8];
    { const f32x4 a0 = *(const LAS f32x4*)(sXW + t * 68 + cg * 8), a1 = *(const LAS f32x4*)(sXW + t * 68 + cg * 8 + 4), b0 = *(const LAS f32x4*)(sXA + t * 68 + cg * 8), b1 = *(const LAS f32x4*)(sXA + t * 68 + cg * 8 + 4);
      zw[0] = a0.x; zw[1] = a0.y; zw[2] = a0.z; zw[3] = a0.w; zw[4] = a1.x; zw[5] = a1.y; zw[6] = a1.z; zw[7] = a1.w;
      za[0] = b0.x; za[1] = b0.y; za[2] = b0.z; za[3] = b0.w; za[4] = b1.x; za[5] = b1.y; za[6] = b1.z; za[7] = b1.w; }
    float lw[8], av[8], kkv[8], kp[8]; float ss = 0.f, sb = 0.f;
#pragma unroll
    for (int i = 0; i < 8; ++i) { const int ch = ch0 + i;
        const float u = -(p.ev_w0[ch] + zw[i]); const float sp = (u > 20.f) ? u : __logf(1.0f + __expf(u));
        lw[i] = -__expf(-sp - 0.5f);
        av[i] = sigmoidf_(p.ev_a0[ch] + za[i]);
        kkv[i] = kv[i] * p.ev_k_k[ch]; ss += kkv[i] * kkv[i];
        kp[i] = kv[i] * (1.0f + (av[i] - 1.0f) * p.ev_k_a[ch]);
        sb += rv[i] * kp[i] * p.ev_r_k[ch]; }
    red[t * 8 + cg] = ss; red[512 + t * 8 + cg] = sb;
    __syncthreads();
    {
        float tot = 0.f, bon = 0.f;
#pragma unroll
        for (int i = 0; i < 8; ++i) { tot += red[t * 8 + i]; bon += red[512 + t * 8 + i]; }
        if (cg == 0) ((float*)(R + R_BON))[(tg0 + t) * 8 + hd] = bon;
        const float inv = __builtin_amdgcn_rcpf(fmaxf(sqrtf(tot), 1e-12f));
        float at[8], rt_[8], bt[8], kt[8], bh_[8], kh_[8];
#pragma unroll
        for (int i = 0; i < 8; ++i) {
            const float cl = wave_scan_incl(lw[i], lane); const float cl63 = lane63(cl);
            const float e1 = __expf(cl), e0 = __expf(cl - lw[i]), en = __expf(-cl), eh = __expf(cl63 - cl);
            const float kn = kkv[i] * inv, A = -kn, Bv = kn * av[i];
            at[i] = A * e0; rt_[i] = rv[i] * e1; bt[i] = Bv * en; kt[i] = kp[i] * en; bh_[i] = Bv * eh; kh_[i] = kp[i] * eh;
            if (lane == 63) ((float*)(R + R_GAM))[(size_t)unit * 64 + cg * 8 + i] = __expf(cl63); }
        { u32x4 w; w.x = pk2(at[0], at[1]); w.y = pk2(at[2], at[3]); w.z = pk2(at[4], at[5]); w.w = pk2(at[6], at[7]); *(LAS u32x4*)(At + t * 72 + cg * 8) = w; }
        { u32x4 w; w.x = pk2(rt_[0], rt_[1]); w.y = pk2(rt_[2], rt_[3]); w.z = pk2(rt_[4], rt_[5]); w.w = pk2(rt_[6], rt_[7]); *(LAS u32x4*)(Rt + t * 72 + cg * 8) = w; }
        { u32x4 w; w.x = pk2(bt[0], bt[1]); w.y = pk2(bt[2], bt[3]); w.z = pk2(bt[4], bt[5]); w.w = pk2(bt[6], bt[7]); *(LAS u32x4*)(Bt + t * 72 + cg * 8) = w; }
        { u32x4 w; w.x = pk2(kt[0], kt[1]); w.y = pk2(kt[2], kt[3]); w.z = pk2(kt[4], kt[5]); w.w = pk2(kt[6], kt[7]); *(LAS u32x4*)(Kt + t * 72 + cg * 8) = w; }
        *(LAS f32x4*)(RHS + t * 132 + 64 + cg * 8) = (f32x4){at[0], at[1], at[2], at[3]}; *(LAS f32x4*)(RHS + t * 132 + 64 + cg * 8 + 4) = (f32x4){at[4], at[5], at[6], at[7]};
#pragma unroll
        for (int i = 0; i < 8; ++i) { BH[(cg * 8 + i) * 72 + t] = (bf16_t)f2bf(bh_[i]); KH[(cg * 8 + i) * 72 + t] = (bf16_t)f2bf(kh_[i]); VT[(cg * 8 + i) * 72 + t] = (bf16_t)f2bf(vv[i]); }
    }
    __syncthreads();
    {
        const int mat = wv >> 1;
        const LAS bf16_t* Ximg = (mat < 2) ? At : Rt; const LAS bf16_t* Yimg = (mat & 1) ? Kt : Bt;
        LAS bf16_t* Oimg = mat == 0 ? AAB : (mat == 1 ? AAK : (mat == 2 ? ARB : ARK));
#pragma unroll 4
        for (int n = 0; n < 8; ++n) { const int idx = (wv & 1) * 8 + n, si = idx >> 2, ti = idx & 3;
            f32x4 acc = (f32x4){0.f, 0.f, 0.f, 0.f};
            if (si <= ti) {
#pragma unroll
                for (int kk = 0; kk < 2; ++kk) acc = __builtin_amdgcn_mfma_f32_16x16x32_bf16(lds_frag(Yimg, 72, 16 * si + fr, 32 * kk + 8 * fq), lds_frag(Ximg, 72, 16 * ti + fr, 32 * kk + 8 * fq), acc, 0, 0, 0); }
            const int tt = 16 * ti + fr, s0 = 16 * si + 4 * fq; const int lim = (mat < 2) ? tt - 1 : tt;
            const float o0 = s0 <= lim ? acc[0] : 0.f, o1 = s0 + 1 <= lim ? acc[1] : 0.f, o2 = s0 + 2 <= lim ? acc[2] : 0.f, o3 = s0 + 3 <= lim ? acc[3] : 0.f;
            u32x2 w; w.x = pk2(o0, o1); w.y = pk2(o2, o3); *(LAS u32x2*)(Oimg + tt * 72 + s0) = w;
            if (mat == 0 && si == ti) { LAS float* d = DIAG + si * 272 + fr * 17 + 4 * fq; d[0] = o0; d[1] = o1; d[2] = o2; d[3] = o3; } }
    }
    __syncthreads();
    if (wv < 4) {
#pragma unroll
        for (int ti = 0; ti < 4; ++ti) { f32x4 acc = (f32x4){0.f, 0.f, 0.f, 0.f};
#pragma unroll
            for (int kk = 0; kk < 2; ++kk) acc = __builtin_amdgcn_mfma_f32_16x16x32_bf16(lds_frag(AAK, 72, 16 * ti + fr, 32 * kk + 8 * fq), lds_frag(VT, 72, 16 * wv + fr, 32 * kk + 8 * fq), acc, 0, 0, 0);
#pragma unroll
            for (int r = 0; r < 4; ++r) RHS[(16 * ti + 4 * fq + r) * 132 + 16 * wv + fr] = acc[r]; }
    } else if (lane < 16) { const int I = wv - 4; const LAS float* d = DIAG + I * 272; float T[16];
#pragma unroll
        for (int r = 0; r < 16; ++r) { float s = (r == lane) ? 1.f : 0.f;
#pragma unroll
            for (int q = 0; q < r; ++q) s += d[r * 17 + q] * T[q];
            T[r] = s; TI[I * 384 + r * 24 + lane] = (bf16_t)f2bf(s); } }
    __syncthreads();
#pragma unroll 1
    for (int I = 0; I < 4; ++I) {
        f32x4 acc;
#pragma unroll
        for (int r = 0; r < 4; ++r) acc[r] = RHS[(16 * I + 4 * fq + r) * 132 + 16 * wv + fr];
#pragma unroll 1
        for (int kk = 0; 32 * kk < 16 * I; ++kk) { const bool ok = (32 * kk + 8 * fq) < 16 * I;
            bf16x8_t a = zero_frag(), bq = zero_frag();
            if (ok) { a = lds_frag(AAB, 72, 16 * I + fr, 32 * kk + 8 * fq); bq = lds_frag(XT, 72, 16 * wv + fr, 32 * kk + 8 * fq); }
            acc = __builtin_amdgcn_mfma_f32_16x16x32_bf16(a, bq, acc, 0, 0, 0); }
        { u32x2 w; w.x = pk2(acc[0], acc[1]); w.y = pk2(acc[2], acc[3]); *(LAS u32x2*)(YT + (16 * wv + fr) * 24 + 4 * fq) = w; }
        LDS_WAIT();
        { bf16x8_t a = zero_frag(), bq = zero_frag();
          if (fq < 2) { a = *(const LAS bf16x8_t*)(TI + I * 384 + fr * 24 + 8 * fq); bq = *(const LAS bf16x8_t*)(YT + (16 * wv + fr) * 24 + 8 * fq); }
          f32x4 x = __builtin_amdgcn_mfma_f32_16x16x32_bf16(a, bq, (f32x4){0.f, 0.f, 0.f, 0.f}, 0, 0, 0);
          u32x2 w; w.x = pk2(x[0], x[1]); w.y = pk2(x[2], x[3]); *(LAS u32x2*)(XT + (16 * wv + fr) * 72 + 16 * I + 4 * fq) = w; }
        LDS_WAIT();
    }
    __syncthreads();
    {
        const int mat = wv >> 1;
        bf16_t* MG = (bf16_t*)(R + R_MG) + (size_t)unit * 4096; bf16_t* NT = (bf16_t*)(R + R_NT) + (size_t)unit * 4096;
        bf16_t* QG = (bf16_t*)(R + R_QG) + (size_t)unit * 4096; bf16_t* Y0G = (bf16_t*)(R + R_Y0) + (size_t)unit * 4096;
#pragma unroll 4
        for (int n = 0; n < 8; ++n) { const int idx = (wv & 1) * 8 + n, rt = idx >> 2, ct = idx & 3;
            f32x4 acc = (f32x4){0.f, 0.f, 0.f, 0.f};
            if (mat == 2) { const u32x2 r2 = *(const LAS u32x2*)(Rt + (16 * ct + fr) * 72 + 16 * rt + 4 * fq); acc = (f32x4){bflo(r2.x), bfhi(r2.x), bflo(r2.y), bfhi(r2.y)}; }
#pragma unroll
            for (int kk = 0; kk < 2; ++kk) { const int kc = 32 * kk + 8 * fq;
                if (mat == 0) acc = __builtin_amdgcn_mfma_f32_16x16x32_bf16(lds_frag(XT, 72, 64 + 16 * rt + fr, kc), lds_frag(BH, 72, 16 * ct + fr, kc), acc, 0, 0, 0);
                else if (mat == 1) { acc = __builtin_amdgcn_mfma_f32_16x16x32_bf16(lds_frag(BH, 72, 16 * rt + fr, kc), lds_frag(XT, 72, 16 * ct + fr, kc), acc, 0, 0, 0);
                                     acc = __builtin_amdgcn_mfma_f32_16x16x32_bf16(lds_frag(KH, 72, 16 * rt + fr, kc), lds_frag(VT, 72, 16 * ct + fr, kc), acc, 0, 0, 0); }
                else if (mat == 2) acc = __builtin_amdgcn_mfma_f32_16x16x32_bf16(lds_frag(XT, 72, 64 + 16 * rt + fr, kc), lds_frag(ARB, 72, 16 * ct + fr, kc), acc, 0, 0, 0);
                else { acc = __builtin_amdgcn_mfma_f32_16x16x32_bf16(lds_frag(XT, 72, 16 * rt + fr, kc), lds_frag(ARB, 72, 16 * ct + fr, kc), acc, 0, 0, 0);
                       acc = __builtin_amdgcn_mfma_f32_16x16x32_bf16(lds_frag(VT, 72, 16 * rt + fr, kc), lds_frag(ARK, 72, 16 * ct + fr, kc), acc, 0, 0, 0); } }
            u32x2 w; w.x = pk2(acc[0], acc[1]); w.y = pk2(acc[2], acc[3]);
            if (mat == 0) *(u32x2*)(MG + (16 * ct + fr) * 64 + 32 * (rt >> 1) + 8 * fq + 4 * (rt & 1)) = w;
            else if (mat == 1) *(u32x2*)(NT + (16 * ct + fr) * 64 + 16 * rt + 4 * fq) = w;
            else if (mat == 2) *(u32x2*)(QG + (16 * ct + fr) * 64 + 16 * rt + 4 * fq) = w;
            else *(u32x2*)(Y0G + (16 * ct + fr) * 64 + 16 * rt + 4 * fq) = w; }
    }
}

constexpr int RY_SLOT = 2 * 64 * 72 * 2 + 256;
struct RyFill { u32x4 m[8], n[8], g; };
__device__ __forceinline__ void rwkv_y_fetch(RyFill& f, const unsigned char* R, size_t unit, int lane) {
    const u32x4* MG = (const u32x4*)((const bf16_t*)(R + R_MG) + unit * 4096); const u32x4* NT = (const u32x4*)((const bf16_t*)(R + R_NT) + unit * 4096); const u32x4* GAM = (const u32x4*)((const float*)(R + R_GAM) + unit * 64);
#pragma unroll
    for (int i = 0; i < 8; ++i) { f.m[i] = MG[lane + 64 * i]; f.n[i] = NT[lane + 64 * i]; }
    f.g = (u32x4){0u, 0u, 0u, 0u}; if (lane < 16) f.g = GAM[lane];
}
__device__ __forceinline__ void rwkv_y_put(const RyFill& f, unsigned char* slot, int lane) {
#pragma unroll
    for (int i = 0; i < 8; ++i) { const int idx = lane + 64 * i; *(LAS u32x4*)(slot + (idx >> 3) * 144 + (idx & 7) * 16) = f.m[i]; *(LAS u32x4*)(slot + 9216 + (idx >> 3) * 144 + (idx & 7) * 16) = f.n[i]; }
    if (lane < 16) *(LAS u32x4*)(slot + 18432 + lane * 16) = f.g;
}
__device__ __forceinline__ void rwkv_y(const Ctx& c, const Params& p, int bh) {
    const int lane = c.lane, wv = c.wave, fr = lane & 15, fq = lane >> 4, jb = wv & 3, g = wv - 4; unsigned char* R = p.ws + OFF_R; unsigned char* sm = c.shm;
    f32x4 Z[4];
#pragma unroll
    for (int i = 0; i < 4; ++i) Z[i] = (f32x4){0.f, 0.f, 0.f, 0.f};
    RyFill fs;
    __syncthreads();
    if (wv >= 4) {
        if (g == 0) { rwkv_y_fetch(fs, R, (size_t)bh * 64, lane); rwkv_y_put(fs, sm, lane); rwkv_y_fetch(fs, R, (size_t)bh * 64 + 4, lane); }
        else rwkv_y_fetch(fs, R, (size_t)bh * 64 + g, lane);
    }
    __syncthreads();
#pragma unroll 1
    for (int ck = 0; ck < 64; ++ck) {
        if (wv >= 4) {
            if (((ck + 1) & 3) == g && ck + 1 < 64) { rwkv_y_put(fs, sm + ((ck + 1) & 7) * RY_SLOT, lane); if (ck + 5 < 64) rwkv_y_fetch(fs, R, (size_t)bh * 64 + ck + 5, lane); }
        } else {
            const size_t unit = (size_t)bh * 64 + ck; const unsigned char* slot = sm + (ck & 7) * RY_SLOT;
            const LAS bf16_t* MGs = (const LAS bf16_t*)slot; const LAS bf16_t* NTs = (const LAS bf16_t*)(slot + 9216); const LAS float* GMs = (const LAS float*)(slot + 18432);
            bf16x8_t mf[4][2]; u32x2 nn[4]; f32x4 gg[4];
#pragma unroll
            for (int rt = 0; rt < 4; ++rt) {
#pragma unroll
                for (int sg = 0; sg < 2; ++sg) mf[rt][sg] = lds_frag(MGs, 72, 16 * rt + fr, 32 * sg + 8 * fq);
                nn[rt] = *(const LAS u32x2*)(NTs + (16 * jb + fr) * 72 + 16 * rt + 4 * fq); gg[rt] = *(const LAS f32x4*)(GMs + 16 * rt + 4 * fq); }
            bf16_t* Z0 = (bf16_t*)(R + R_Z0) + unit * 4096;
            bf16x8_t zb[2];
#pragma unroll
            for (int sg = 0; sg < 2; ++sg) { const float zv[8] = {Z[2 * sg][0], Z[2 * sg][1], Z[2 * sg][2], Z[2 * sg][3], Z[2 * sg + 1][0], Z[2 * sg + 1][1], Z[2 * sg + 1][2], Z[2 * sg + 1][3]}; zb[sg] = pack8(zv); }
#pragma unroll
            for (int rt = 0; rt < 4; ++rt) { u32x2 w; w.x = pk2(Z[rt][0], Z[rt][1]); w.y = pk2(Z[rt][2], Z[rt][3]); *(u32x2*)(Z0 + (16 * jb + fr) * 64 + 16 * rt + 4 * fq) = w; }
            asm volatile("s_waitcnt lgkmcnt(0)" ::: "memory");
            f32x4 acc[4];
#pragma unroll
            for (int rt = 0; rt < 4; ++rt) { acc[rt] = (f32x4){bflo(nn[rt].x), bfhi(nn[rt].x), bflo(nn[rt].y), bfhi(nn[rt].y)} + gg[rt] * Z[rt];
#pragma unroll
                for (int sg = 0; sg < 2; ++sg) acc[rt] = __builtin_amdgcn_mfma_f32_16x16x32_bf16(mf[rt][sg], zb[sg], acc[rt], 0, 0, 0); }
#pragma unroll
            for (int rt = 0; rt < 4; ++rt) Z[rt] = acc[rt];
        }
        asm volatile("s_waitcnt lgkmcnt(0)" ::: "memory"); __builtin_amdgcn_s_barrier(); asm volatile("" ::: "memory");
    }
}

__device__ __forceinline__ void rwkv_z(const Ctx& c, const Params& p, int unit) {
    const int bh = unit >> 6, ck = unit & 63, b = bh >> 3, hd = bh & 7, lane = c.lane, fr = lane & 15, fq = lane >> 4; unsigned char* R = p.ws + OFF_R;
    const bf16_t* P = (const bf16_t*)(p.ws + OFF_P); bf16_t* MIX = (bf16_t*)p.out;
    const bf16_t* QG = (const bf16_t*)(R + R_QG) + (size_t)unit * 4096; const bf16_t* Y0G = (const bf16_t*)(R + R_Y0) + (size_t)unit * 4096; const bf16_t* Z0 = (const bf16_t*)(R + R_Z0) + (size_t)unit * 4096;
    const bf16_t* G2T = (const bf16_t*)(p.ws + OFF_WSMALL + WSM_G2T);
    const size_t tg0 = (size_t)b * SEQ + (size_t)ck * 64;
    f32x4 y[4][4], g[4][4];
#pragma unroll
    for (int jt = 0; jt < 4; ++jt)
#pragma unroll
        for (int tt = 0; tt < 4; ++tt) { const u32x2 w = *(const u32x2*)(Y0G + (16 * tt + fr) * 64 + 16 * jt + 4 * fq); y[jt][tt] = (f32x4){bflo(w.x), bfhi(w.x), bflo(w.y), bfhi(w.y)}; g[jt][tt] = (f32x4){0.f, 0.f, 0.f, 0.f}; }
#pragma unroll
    for (int sg = 0; sg < 2; ++sg) { bf16x8_t qb[4];
#pragma unroll
        for (int tt = 0; tt < 4; ++tt) qb[tt] = *(const bf16x8_t*)(QG + (16 * tt + fr) * 64 + 32 * sg + 8 * fq);
#pragma unroll
        for (int jt = 0; jt < 4; ++jt) { const bf16x8_t a = *(const bf16x8_t*)(Z0 + (16 * jt + fr) * 64 + 32 * sg + 8 * fq);
#pragma unroll
            for (int tt = 0; tt < 4; ++tt) y[jt][tt] = __builtin_amdgcn_mfma_f32_16x16x32_bf16(a, qb[tt], y[jt][tt], 0, 0, 0); } }
#pragma unroll 1
    for (int kk = 0; kk < 4; ++kk) { bf16x8_t sgf[4];
        const int col = 1664 + 32 * kk + 8 * fq; const f32x4 m0 = *(const f32x4*)(p.ev_mu + col), m1 = *(const f32x4*)(p.ev_mu + col + 4); const float mu[8] = {m0.x, m0.y, m0.z, m0.w, m1.x, m1.y, m1.z, m1.w};
#pragma unroll
        for (int tt = 0; tt < 4; ++tt) { const int tl = 16 * tt + fr; const bf16_t* src = P + (tg0 + tl) * EV_IN + 768 + col;
            const u32x4 cur = *(const u32x4*)src; u32x4 prv = (u32x4){0u, 0u, 0u, 0u}; if (ck * 64 + tl > 0) prv = *(const u32x4*)(src - EV_IN);
            const unsigned cw[4] = {cur.x, cur.y, cur.z, cur.w}, pw[4] = {prv.x, prv.y, prv.z, prv.w}; float v[8];
#pragma unroll
            for (int k = 0; k < 4; ++k) { const float c0 = bflo(cw[k]), c1 = bfhi(cw[k]), p0 = bflo(pw[k]), p1 = bfhi(pw[k]); v[2 * k] = sigmoidf_(c0 + (p0 - c0) * mu[2 * k]); v[2 * k + 1] = sigmoidf_(c1 + (p1 - c1) * mu[2 * k + 1]); }
            sgf[tt] = pack8(v); }
#pragma unroll
        for (int jt = 0; jt < 4; ++jt) { const bf16x8_t a = *(const bf16x8_t*)(G2T + (size_t)(hd * 64 + 16 * jt + fr) * 128 + 32 * kk + 8 * fq);
#pragma unroll
            for (int tt = 0; tt < 4; ++tt) g[jt][tt] = __builtin_amdgcn_mfma_f32_16x16x32_bf16(a, sgf[tt], g[jt][tt], 0, 0, 0); } }
#pragma unroll
    for (int tt = 0; tt < 4; ++tt) { const int tl = 16 * tt + fr;
        float s1 = 0.f;
#pragma unroll
        for (int jt = 0; jt < 4; ++jt) s1 += (y[jt][tt][0] + y[jt][tt][1]) + (y[jt][tt][2] + y[jt][tt][3]);
        s1 += __shfl_xor(s1, 16); s1 += __shfl_xor(s1, 32); const float mean = s1 * (1.0f / 64.0f);
        float s2 = 0.f;
#pragma unroll
        for (int jt = 0; jt < 4; ++jt)
#pragma unroll
            for (int r = 0; r < 4; ++r) { const float d = y[jt][tt][r] - mean; s2 += d * d; }
        s2 += __shfl_xor(s2, 16); s2 += __shfl_xor(s2, 32); const float rs = 1.0f / sqrtf(s2 * (1.0f / 64.0f) + 64e-5f);
        const float bon = ((const float*)(R + R_BON))[(tg0 + tl) * 8 + hd]; const bool hp = (ck * 64 + tl > 0);
#pragma unroll
        for (int jt = 0; jt < 4; ++jt) { const int ch = hd * 64 + 16 * jt + 4 * fq;
            const bf16_t* src = P + (tg0 + tl) * EV_IN + 768 + 1024 + ch; const u32x2 cur = *(const u32x2*)src; u32x2 prv; prv.x = 0u; prv.y = 0u; if (hp) prv = *(const u32x2*)(src - EV_IN);
            const f32x4 mu = *(const f32x4*)(p.ev_mu + 1024 + ch), lw4 = *(const f32x4*)(p.ev_lnx_w + ch), lb4 = *(const f32x4*)(p.ev_lnx_b + ch);
            const float c0 = bflo(cur.x), c1 = bfhi(cur.x), c2 = bflo(cur.y), c3 = bfhi(cur.y), p0 = bflo(prv.x), p1 = bfhi(prv.x), p2 = bflo(prv.y), p3 = bfhi(prv.y);
            const float v0 = c0 + (p0 - c0) * mu.x, v1 = c1 + (p1 - c1) * mu.y, v2 = c2 + (p2 - c2) * mu.z, v3 = c3 + (p3 - c3) * mu.w;
            const f32x4 yy = y[jt][tt], gg = g[jt][tt];
            const float o0 = ((yy[0] - mean) * rs * lw4.x + lb4.x + bon * v0) * gg[0], o1 = ((yy[1] - mean) * rs * lw4.y + lb4.y + bon * v1) * gg[1];
            const float o2 = ((yy[2] - mean) * rs * lw4.z + lb4.z + bon * v2) * gg[2], o3 = ((yy[3] - mean) * rs * lw4.w + lb4.w + bon * v3) * gg[3];
            u32x2 w; w.x = pk2(o0, o1); w.y = pk2(o2, o3); *(u32x2*)(MIX + (tg0 + tl) * 1024 + 512 + ch) = w; } }
}

__device__ __forceinline__ void xattn_mfma(const Ctx& c, const Params& p, int unit) {
    const int b = unit >> 5, hh = (unit >> 3) & 3, tblk = unit & 7, tid = c.tid, lane = c.lane, wv = c.wave, fr = lane & 15, fq = lane >> 4;
    LAS bf16_t* Ks = (LAS bf16_t*)c.shm;
    LAS bf16_t* VTp = (LAS bf16_t*)(c.shm + 256 * 272);
    const bf16_t* MKV = (const bf16_t*)(p.ws + OFF_MKV); const bf16_t* Q = (const bf16_t*)(p.ws + OFF_P); bf16_t* OA = (bf16_t*)(p.ws + OFF_P + 32 * MiB);
    __syncthreads();
    {
        u32x4 dd[16];
#pragma unroll
        for (int i = 0; i < 16; ++i) { const int task = tid + 512 * i, which = task >> 12, r = (task >> 4) & 255, ck = task & 15;
            dd[i] = *(const u32x4*)(MKV + ((size_t)b * MEMLEN + r) * 1024 + which * 512 + hh * 128 + ck * 8); }
#pragma unroll
        for (int i = 0; i < 16; ++i) { const int task = tid + 512 * i, which = task >> 12, r = (task >> 4) & 255, ck = task & 15; const u32x4 d = dd[i];
            if (which == 0) *(LAS u32x4*)(Ks + r * 136 + ck * 8) = d;
            else { const int kc = key_perm(r); const unsigned w[4] = {d.x, d.y, d.z, d.w};
#pragma unroll
                for (int k = 0; k < 4; ++k) { VTp[(ck * 8 + 2 * k) * 264 + kc] = (bf16_t)(w[k] & 0xFFFFu); VTp[(ck * 8 + 2 * k + 1) * 264 + kc] = (bf16_t)(w[k] >> 16); } } }
    }
    __syncthreads();
#pragma unroll 1
    for (int qt = 0; qt < 4; ++qt) {
        const size_t tq = (size_t)b * SEQ + tblk * 512 + wv * 64 + qt * 16 + fr;
        bf16x8_t qf[4];
#pragma unroll
        for (int kk = 0; kk < 4; ++kk) qf[kk] = *(const bf16x8_t*)(Q + tq * 512 + hh * 128 + 32 * kk + 8 * fq);
        float qsc;
        { const f32x4* sp = (const f32x4*)((const float*)(p.ws + OFF_R + R_SSP) + tq * 16); const f32x4 s0 = sp[0], s1 = sp[1], s2 = sp[2], s3 = sp[3];
          const float ssq = ((s0.x + s0.y) + (s0.z + s0.w)) + ((s1.x + s1.y) + (s1.z + s1.w)) + ((s2.x + s2.y) + (s2.z + s2.w)) + ((s3.x + s3.y) + (s3.z + s3.w));
          qsc = 0.08838834764831845f / sqrtf(ssq * (1.0f / 1024.0f) + 1e-6f); }
        f32x4 s[16];
#pragma unroll
        for (int kt = 0; kt < 16; ++kt) { s[kt] = (f32x4){0.f, 0.f, 0.f, 0.f};
#pragma unroll
            for (int kk = 0; kk < 4; ++kk) s[kt] = __builtin_amdgcn_mfma_f32_16x16x32_bf16(lds_frag(Ks, 136, 16 * kt + fr, 32 * kk + 8 * fq), qf[kk], s[kt], 0, 0, 0);
            if (kt & 1) __builtin_amdgcn_sched_barrier(0); }
        float m = s[0][0];
#pragma unroll
        for (int kt = 0; kt < 16; ++kt) m = fmaxf(fmaxf(fmaxf(m, s[kt][0]), fmaxf(s[kt][1], s[kt][2])), s[kt][3]);
        m = fmaxf(m, __shfl_xor(m, 16)); m = fmaxf(m, __shfl_xor(m, 32));
        float den = 0.f;
#pragma unroll
        for (int kt = 0; kt < 16; ++kt)
#pragma unroll
            for (int r = 0; r < 4; ++r) { const float e = __expf((s[kt][r] - m) * qsc); s[kt][r] = e; den += e; }
        den += __shfl_xor(den, 16); den += __shfl_xor(den, 32);
        f32x4 o[8];
#pragma unroll
        for (int dt = 0; dt < 8; ++dt) o[dt] = (f32x4){0.f, 0.f, 0.f, 0.f};
#pragma unroll
        for (int sg = 0; sg < 8; ++sg) { const float pv[8] = {s[2 * sg][0], s[2 * sg][1], s[2 * sg][2], s[2 * sg][3], s[2 * sg + 1][0], s[2 * sg + 1][1], s[2 * sg + 1][2], s[2 * sg + 1][3]};
            const bf16x8_t pb = pack8(pv);
#pragma unroll
            for (int dt = 0; dt < 8; ++dt) o[dt] = __builtin_amdgcn_mfma_f32_16x16x32_bf16(lds_frag(VTp, 264, 16 * dt + fr, 32 * sg + 8 * fq), pb, o[dt], 0, 0, 0);
            __builtin_amdgcn_sched_barrier(0); }
        const float inv = 1.0f / den;
#pragma unroll
        for (int dt = 0; dt < 8; ++dt) { u32x2 w; w.x = pk2(o[dt][0] * inv, o[dt][1] * inv); w.y = pk2(o[dt][2] * inv, o[dt][3] * inv); *(u32x2*)(OA + tq * 512 + hh * 128 + 16 * dt + 4 * fq) = w; }
    }
}
__device__ __forceinline__ void swa_mfma(const Ctx& c, const Params& p, int unit) {
    const int b = unit >> 6, g = (unit >> 5) & 1, n = unit & 31, tid = c.tid, lane = c.lane, wv = c.wave, fr = lane & 15, fq = lane >> 4;
    LAS bf16_t* Ks = (LAS bf16_t*)c.shm;
    LAS bf16_t* VTp = (LAS bf16_t*)(c.shm + 256 * 144);
    const bf16_t* P = (const bf16_t*)(p.ws + OFF_P); bf16_t* MIX = (bf16_t*)p.out;
    __syncthreads();
    {
        u32x4 dd[8];
#pragma unroll
        for (int i = 0; i < 8; ++i) { const int task = tid + 512 * i, which = task >> 11, r = (task >> 3) & 255, ck = task & 7; const int tk = n * 128 - 128 + r;
            dd[i] = (u32x4){0u, 0u, 0u, 0u}; if (tk >= 0) dd[i] = *(const u32x4*)(P + ((size_t)b * SEQ + tk) * EV_IN + 512 + which * 128 + g * 64 + ck * 8); }
#pragma unroll
        for (int i = 0; i < 8; ++i) { const int task = tid + 512 * i, which = task >> 11, r = (task >> 3) & 255, ck = task & 7; const u32x4 d = dd[i];
            if (which == 0) *(LAS u32x4*)(Ks + r * 72 + ck * 8) = d;
            else { const int kc = key_perm(r); const unsigned w[4] = {d.x, d.y, d.z, d.w};
#pragma unroll
                for (int k = 0; k < 4; ++k) { VTp[(ck * 8 + 2 * k) * 264 + kc] = (bf16_t)(w[k] & 0xFFFFu); VTp[(ck * 8 + 2 * k + 1) * 264 + kc] = (bf16_t)(w[k] >> 16); } } }
    }
    __syncthreads();
#pragma unroll 1
    for (int it = 0; it < 4; ++it) {
        const int tile = wv * 4 + it, hql = tile >> 3, qb = tile & 7, head = g * 4 + hql, sg0 = qb >> 1;
        const int qi = 16 * qb + fr; const size_t tq = (size_t)b * SEQ + n * 128 + qi;
        const float sink = p.ev_sinks[head];
        bf16x8_t qf[2];
#pragma unroll
        for (int kk = 0; kk < 2; ++kk) qf[kk] = *(const bf16x8_t*)(P + tq * EV_IN + head * 64 + 32 * kk + 8 * fq);
        f32x4 s[10]; float m = sink;
#pragma unroll
        for (int i = 0; i < 10; ++i) { const int kt = 2 * sg0 + i; s[i] = (f32x4){0.f, 0.f, 0.f, 0.f};
#pragma unroll
            for (int kk = 0; kk < 2; ++kk) s[i] = __builtin_amdgcn_mfma_f32_16x16x32_bf16(lds_frag(Ks, 72, 16 * kt + fr, 32 * kk + 8 * fq), qf[kk], s[i], 0, 0, 0);
#pragma unroll
            for (int r = 0; r < 4; ++r) { const int kp = 16 * kt + 4 * fq + r; const bool valid = (kp >= qi + 1) && (kp <= qi + 128) && (n > 0 || kp >= 128);
                s[i][r] = valid ? s[i][r] * 0.125f : -INFINITY; m = fmaxf(m, s[i][r]); } }
        m = fmaxf(m, __shfl_xor(m, 16)); m = fmaxf(m, __shfl_xor(m, 32));
        float den = 0.f;
#pragma unroll
        for (int i = 0; i < 10; ++i)
#pragma unroll
            for (int r = 0; r < 4; ++r) { const float e = __expf(s[i][r] - m); s[i][r] = e; den += e; }
        den += __shfl_xor(den, 16); den += __shfl_xor(den, 32); den += __expf(sink - m);
        f32x4 o[4];
#pragma unroll
        for (int dt = 0; dt < 4; ++dt) o[dt] = (f32x4){0.f, 0.f, 0.f, 0.f};
#pragma unroll
        for (int i2 = 0; i2 < 5; ++i2) { const float pv[8] = {s[2 * i2][0], s[2 * i2][1], s[2 * i2][2], s[2 * i2][3], s[2 * i2 + 1][0], s[2 * i2 + 1][1], s[2 * i2 + 1][2], s[2 * i2 + 1][3]};
            const bf16x8_t pb = pack8(pv);
#pragma unroll
            for (int dt = 0; dt < 4; ++dt) o[dt] = __builtin_amdgcn_mfma_f32_16x16x32_bf16(lds_frag(VTp, 264, 16 * dt + fr, 32 * (sg0 + i2) + 8 * fq), pb, o[dt], 0, 0, 0); }
        const float inv = 1.0f / den;
#pragma unroll
        for (int dt = 0; dt < 4; ++dt) { u32x2 w; w.x = pk2(o[dt][0] * inv, o[dt][1] * inv); w.y = pk2(o[dt][2] * inv, o[dt][3] * inv); *(u32x2*)(MIX + tq * 1024 + head * 64 + 16 * dt + 4 * fq) = w; }
    }
}

constexpr size_t WSM_RT = 640 * 1024;
constexpr size_t CTL_WGCNT = 256 * 1024;
__device__ __forceinline__ void split8(const f32x4 a, const f32x4 b, bf16x8_t& hi, bf16x8_t& lo) {
    const float x[8] = {a.x, a.y, a.z, a.w, b.x, b.y, b.z, b.w}; float h[8], l[8];
#pragma unroll
    for (int i = 0; i < 8; ++i) { h[i] = bf2f(f2bf(x[i])); l[i] = x[i] - h[i]; }
    hi = pack8(h); lo = pack8(l);
}
__device__ __forceinline__ void moe_route(const Ctx& c, const Params& p, int layer) {
    const int lane = c.lane, wv = c.wave, fr = lane & 15, fq = lane >> 4;
    LAS float* LG = (LAS float*)c.shm + wv * (16 * 48 + 16);
    LAS float* RS = LG + 16 * 48;
    LAS int* hist = (LAS int*)(c.shm + 32 * 1024);
    if (c.tid < 32) hist[c.tid] = 0;
    __syncthreads();
    const int t0 = blockIdx.x * 128 + wv * 16;
    const bf16_t* xr = (const bf16_t*)(p.ws + OFF_H) + (size_t)(t0 + fr) * 1024 + 8 * fq;
    const bf16_t* TH = (const bf16_t*)(p.ws + OFF_WSMALL + WSM_RT) + (size_t)layer * 2 * 48 * 1024; const bf16_t* TL = TH + 48 * 1024;
    f32x4 acc[3];
#pragma unroll
    for (int i = 0; i < 3; ++i) acc[i] = (f32x4){0.f, 0.f, 0.f, 0.f};
    float ss = 0.f;
#pragma unroll 4
    for (int kk = 0; kk < 32; ++kk) {
        const u32x4 xw = *(const u32x4*)(xr + 32 * kk); const bf16x8_t xh = __builtin_bit_cast(bf16x8_t, xw);
        { const float x0 = bflo(xw.x), x1 = bfhi(xw.x), x2 = bflo(xw.y), x3 = bfhi(xw.y), x4 = bflo(xw.z), x5 = bfhi(xw.z), x6 = bflo(xw.w), x7 = bfhi(xw.w);
          ss += (x0 * x0 + x1 * x1) + (x2 * x2 + x3 * x3) + (x4 * x4 + x5 * x5) + (x6 * x6 + x7 * x7); }
#pragma unroll
        for (int ct = 0; ct < 3; ++ct) { const bf16x8_t wh = *(const bf16x8_t*)(TH + (size_t)(16 * ct + fr) * 1024 + 32 * kk + 8 * fq), wl = *(const bf16x8_t*)(TL + (size_t)(16 * ct + fr) * 1024 + 32 * kk + 8 * fq);
            acc[ct] = __builtin_amdgcn_mfma_f32_16x16x32_bf16(xh, wh, acc[ct], 0, 0, 0); acc[ct] = __builtin_amdgcn_mfma_f32_16x16x32_bf16(xh, wl, acc[ct], 0, 0, 0); }
    }
    ss += __shfl_xor(ss, 16); ss += __shfl_xor(ss, 32);
    const float rstd = 1.0f / sqrtf(ss * (1.0f / 1024.0f) + 1e-6f);
    if (fq == 0) RS[fr] = rstd;
    LDS_WAIT();
#pragma unroll
    for (int ct = 0; ct < 3; ++ct)
#pragma unroll
        for (int r = 0; r < 4; ++r) LG[(4 * fq + r) * 48 + 16 * ct + fr] = acc[ct][r] * RS[4 * fq + r];
    LDS_WAIT();
    if (lane < 16) { int e0, e1; float g0, g1; route_row(LG + lane * 48, p.moe_b_group + layer * 4, p.moe_b_expert + layer * 32, e0, e1, g0, g1);
        const int t = t0 + lane; ((float*)(p.ws + OFF_ROUTE + ROUTE_RS))[t] = RS[lane]; ((int2*)(p.ws + OFF_ROUTE))[t] = make_int2(e0, e1); ((float2*)(p.ws + OFF_ROUTE + 256 * 1024))[t] = make_float2(g0, g1);
        atomicAdd((int*)&hist[e0], 1); atomicAdd((int*)&hist[e1], 1); }
    __syncthreads();
    if (c.tid < 32) ((int*)(p.ws + OFF_CTL + CTL_WGCNT))[(layer * 256 + blockIdx.x) * 32 + c.tid] = hist[c.tid];
}
__device__ __forceinline__ void moe_slots2(const Ctx& c, const Params& p, int layer) {
    LAS int* part = (LAS int*)c.shm;
    LAS int* base = part + 1024;
    LAS int* lcnt = base + 32;
    LAS int* posl = lcnt + 32;
    LAS int* pst = posl + 256;
    const int* wc = (const int*)(p.ws + OFF_CTL + CTL_WGCNT) + layer * 256 * 32; const int bid = blockIdx.x;
    __syncthreads();
    { const int e = c.tid & 31, pt = c.tid >> 5; int sa = 0, sb = 0;
      for (int w = pt * 16; w < pt * 16 + 16; ++w) { const int v = wc[w * 32 + e]; sa += v; sb += (w < bid) ? v : 0; }
      part[pt * 32 + e] = sa; part[512 + pt * 32 + e] = sb; }
    if (c.tid < 32) lcnt[c.tid] = 0;
    __syncthreads();
    if (c.tid < 32) { int sa = 0, sb = 0; for (int q = 0; q < 16; ++q) { sa += part[q * 32 + c.tid]; sb += part[512 + q * 32 + c.tid]; } part[c.tid] = sa; part[512 + c.tid] = sb; }
    __syncthreads();
    if (c.tid == 0) { int acc = 0; for (int e = 0; e < NEXP; ++e) { pst[e] = acc; acc += (part[e] + 255) / 256 * 256; } pst[32] = acc; }
    __syncthreads();
    if (c.tid < 32) base[c.tid] = pst[c.tid] + part[512 + c.tid];
    if (bid == 0 && c.tid < NEXP) { int* blk = (int*)(p.ws + OFF_CTL + CTL_BLK) + layer * 1024; const int e = c.tid, s = pst[e] / 256, en = pst[e + 1] / 256; for (int i = s; i < en; ++i) blk[1 + i] = e; if (e == 0) blk[0] = pst[32] / 256; }
    __syncthreads();
    if (c.tid < 256) { const int t = bid * 128 + (c.tid >> 1); const int2 ee = ((const int2*)(p.ws + OFF_ROUTE))[t]; const int e = (c.tid & 1) ? ee.y : ee.x;
        const int rk = atomicAdd((int*)&lcnt[e], 1); posl[c.tid] = base[e] + rk; }
    __syncthreads();
    if (c.tid < 128) ((int2*)(p.ws + OFF_ROUTE + 512 * 1024))[bid * 128 + c.tid] = make_int2(posl[2 * c.tid], posl[2 * c.tid + 1]);
    if (c.tid < 256) ((float*)(p.ws + OFF_R + R_RSS))[posl[c.tid]] = ((const float*)(p.ws + OFF_ROUTE + ROUTE_RS))[bid * 128 + (c.tid >> 1)];
    int* TOK = (int*)(p.ws + OFF_R + R_TOK);
    if (c.tid < 256) TOK[posl[c.tid]] = bid * 128 + (c.tid >> 1);
    if (bid == 0) { for (int e = 0; e < NEXP; ++e) { const int s = pst[e] + part[e], en = pst[e + 1]; for (int i = s + c.tid; i < en; i += 512) TOK[i] = 0; } }
}

constexpr size_t WSM_TGD = 128 * 1024, WSM_GUT = 192 * 1024;
__device__ __forceinline__ void combine_gk(const Ctx& c, const Params& p) {
    const int lane = c.lane, wv = c.wave, fr = lane & 15, fq = lane >> 4;
    LAS float* LG = (LAS float*)c.shm + wv * (16 * 16 + 16);
    LAS float* RS = LG + 256;
    const int t0 = blockIdx.x * 128 + wv * 16; const int trow = t0 + fr;
    bf16_t* hr = (bf16_t*)(p.ws + OFF_H) + (size_t)trow * 1024 + 8 * fq;
    const int2 ps = ((const int2*)(p.ws + OFF_ROUTE + 512 * 1024))[trow]; const float2 gt = ((const float2*)(p.ws + OFF_ROUTE + 256 * 1024))[trow];
    const bf16_t* y0 = (const bf16_t*)(p.ws + OFF_P) + (size_t)ps.x * 1024 + 8 * fq; const bf16_t* y1 = (const bf16_t*)(p.ws + OFF_P) + (size_t)ps.y * 1024 + 8 * fq;
    const bf16_t* TH = (const bf16_t*)(p.ws + OFF_WSMALL + WSM_TGD); const bf16_t* TL = TH + 16 * 1024;
    f32x4 acc = (f32x4){0.f, 0.f, 0.f, 0.f}; float ss = 0.f;
#pragma unroll 4
    for (int kk = 0; kk < 32; ++kk) {
        const u32x4 xw = *(const u32x4*)(hr + 32 * kk), u0 = *(const u32x4*)(y0 + 32 * kk), u1 = *(const u32x4*)(y1 + 32 * kk);
        f32x4 a, bq;
        a.x = bflo(xw.x) + gt.x * bflo(u0.x) + gt.y * bflo(u1.x); a.y = bfhi(xw.x) + gt.x * bfhi(u0.x) + gt.y * bfhi(u1.x); a.z = bflo(xw.y) + gt.x * bflo(u0.y) + gt.y * bflo(u1.y); a.w = bfhi(xw.y) + gt.x * bfhi(u0.y) + gt.y * bfhi(u1.y);
        bq.x = bflo(xw.z) + gt.x * bflo(u0.z) + gt.y * bflo(u1.z); bq.y = bfhi(xw.z) + gt.x * bfhi(u0.z) + gt.y * bfhi(u1.z); bq.z = bflo(xw.w) + gt.x * bflo(u0.w) + gt.y * bflo(u1.w); bq.w = bfhi(xw.w) + gt.x * bfhi(u0.w) + gt.y * bfhi(u1.w);
        { u32x4 w; w.x = pk2(a.x, a.y); w.y = pk2(a.z, a.w); w.z = pk2(bq.x, bq.y); w.w = pk2(bq.z, bq.w); *(u32x4*)(hr + 32 * kk) = w; }
        ss += (a.x * a.x + a.y * a.y) + (a.z * a.z + a.w * a.w) + (bq.x * bq.x + bq.y * bq.y) + (bq.z * bq.z + bq.w * bq.w);
        bf16x8_t xh, xl; split8(a, bq, xh, xl);
        const bf16x8_t wh = *(const bf16x8_t*)(TH + (size_t)fr * 1024 + 32 * kk + 8 * fq), wl = *(const bf16x8_t*)(TL + (size_t)fr * 1024 + 32 * kk + 8 * fq);
        acc = __builtin_amdgcn_mfma_f32_16x16x32_bf16(xh, wh, acc, 0, 0, 0); acc = __builtin_amdgcn_mfma_f32_16x16x32_bf16(xh, wl, acc, 0, 0, 0); acc = __builtin_amdgcn_mfma_f32_16x16x32_bf16(xl, wh, acc, 0, 0, 0);
    }
    ss += __shfl_xor(ss, 16); ss += __shfl_xor(ss, 32);
    const float rstd = 1.0f / sqrtf(ss * (1.0f / 1024.0f) + 1e-6f);
    if (fq == 0) { RS[fr] = rstd; ((float*)(p.ws + OFF_ROUTE + ROUTE_RS))[trow] = rstd; }
    LDS_WAIT();
#pragma unroll
    for (int r = 0; r < 4; ++r) LG[(4 * fq + r) * 16 + fr] = acc[r] * RS[4 * fq + r];
    LDS_WAIT();
    bf16x8_t gh = zero_frag(), gl = zero_frag();
    if (fq < 2) { const f32x4 a = *(const LAS f32x4*)(LG + fr * 16 + 8 * fq), bq = *(const LAS f32x4*)(LG + fr * 16 + 8 * fq + 4); split8(a, bq, gh, gl); }
    const bf16_t* UH = (const bf16_t*)(p.ws + OFF_WSMALL + WSM_GUT); const bf16_t* UL = UH + 512 * 16;
    float* gk = (float*)(p.ws + OFF_R + R_GK) + (size_t)trow * 512 + 4 * fq;
#pragma unroll 4
    for (int ct = 0; ct < 32; ++ct) {
        bf16x8_t uh = zero_frag(), ul = zero_frag();
        if (fq < 2) { uh = *(const bf16x8_t*)(UH + (16 * ct + fr) * 16 + 8 * fq); ul = *(const bf16x8_t*)(UL + (16 * ct + fr) * 16 + 8 * fq); }
        f32x4 g = *(const f32x4*)(p.od_gate_b + 16 * ct + 4 * fq);
        g = __builtin_amdgcn_mfma_f32_16x16x32_bf16(uh, gh, g, 0, 0, 0); g = __builtin_amdgcn_mfma_f32_16x16x32_bf16(uh, gl, g, 0, 0, 0); g = __builtin_amdgcn_mfma_f32_16x16x32_bf16(ul, gh, g, 0, 0, 0);
#pragma unroll
        for (int r = 0; r < 4; ++r) { const float xx = g[r]; g[r] = (fminf(xx, 0.f) - __logf(1.0f + __expf(-fabsf(xx)))) * (1.0f / 16.0f); }
        *(f32x4*)(gk + 16 * ct) = g;
    }
}

constexpr int LDS_BYTES = 160 * 1024 - 64;
constexpr int N_PHASES = 25;

typedef const __attribute__((address_space(4))) Params* KParamsPtr;
__device__ __forceinline__ Params kparams() {
#if defined(__HIP_DEVICE_COMPILE__)
    KParamsPtr k = (KParamsPtr)__builtin_amdgcn_kernarg_segment_ptr(); asm volatile("" : "+s"(k)); return *k;
#else
    return Params{};
#endif
}
__device__ __forceinline__ Ctx mkctx(unsigned char* shm) {
    int tz = threadIdx.x; asm volatile("" : "+v"(tz));
    Ctx c; c.tid = tz; c.wave = __builtin_amdgcn_readfirstlane(tz >> 6); c.lane = tz & 63; c.gw = blockIdx.x * 8 + c.wave; c.ngw = 2048; c.shm = shm; return c;
}
__global__ void __launch_bounds__(512, 2) hybrid_fwd(Params p_in) {
    extern __shared__ __attribute__((aligned(16))) unsigned char shm[];
    constexpr int G = 256; const int bid = blockIdx.x;
    uint4* xbw = (uint4*)(shm + LDS_BYTES - 16);
    if (threadIdx.x == 0) *xbw = make_uint4(0u, 0u, 0u, 0u);
    __syncthreads();
    XcdBarrier bar = xcd_barrier_post((unsigned*)(kparams().ws + OFF_CTL), (volatile LAS unsigned*)xbw);
#ifndef KEEPMASK
#define KEEPMASK 0xFFFFFFFFu
#endif
#define INS(k, s) (((KEEPMASK) >> (s)) & 1u)
#ifndef REPMASK
#define REPMASK 0u
#endif
#define REP(s) ((((REPMASK) >> (s)) & 1u) ? 3 : 1)
#define SEAM(k) do { XcdBarrier b2 = bar; b2.bar = (unsigned*)(kparams().ws + OFF_CTL); xcd_barrier(b2); } while (0)
#define PHASE_BEGIN const Params p = kparams(); const Ctx c = mkctx(shm); unsigned char* const ws = p.ws; (void)c; (void)ws;
#define glds ((PG8_LAS unsigned char*)shm)
#define WD ((bf16_t*)(ws + OFF_WD))
#define H ((bf16_t*)(ws + OFF_H))
#define P ((bf16_t*)(ws + OFF_P))
#define WS_F ((float*)(ws + OFF_WSMALL))
#define RE ((int2*)(ws + OFF_ROUTE))
#define RG ((float2*)(ws + OFF_ROUTE + 256 * 1024))
#define RP ((int2*)(ws + OFF_ROUTE + 512 * 1024))

    for (int layer = 0; layer < 2; ++layer) {
        const int pb = layer * 12;
        if (layer == 0) {
            if (INS(0, 0)) for (int rep_ = 0; rep_ < REP(0); ++rep_) { PHASE_BEGIN
                if (bid < 160) { Ctx c2 = c; c2.ngw = 160 * 8; norm_plain(c2, p.x, p.norm_mix, H, T_TOK); }
                else {
                Ctx c2 = c; c2.gw = (bid - 160) * 8 + c.wave; c2.ngw = 96 * 8; const int bid2 = bid - 160; constexpr int G2 = 96;
                tr_matrix(c2, p.ev_w_in, EV_IN, 0, 1024, EV_IN, WD + WE_EV_IN, 0, 0);
                tr_matrix(c2, p.ev_w_out, 1024, 0, 1024, 1024, WD + WE_EV_OUT, 0, 0);
                tr_matrix(c2, p.od_w_in, OD_IN_SRC, 0, 1024, OD_IN, WD + WE_OD_IN, 0, 1, p.norm_mix + 1024);
                tr_matrix(c2, p.od_w_out, 1024, 0, 1024, 1024, WD + WE_OD_OUT, 0, 0);
                tr_matrix(c2, p.mem_wk, 512, 0, 1024, 512, WD + WE_MKV, 0, 0);
                tr_matrix(c2, p.mem_wv, 512, 0, 1024, 512, WD + WE_MKV, 512, 0);
                for (int l = 0; l < 2; ++l) {
                    tr_matrix(c2, p.xa_wq + (size_t)l * 1024 * 512, 512, 0, 1024, 512, WD + WE_WQ + (size_t)l * 512 * 1024, 0, 0, p.norm_xattn + l * 1024);
                    tr_matrix(c2, p.xa_wo + (size_t)l * 512 * 1024, 1024, 0, 512, 1024, WD + WE_WO + (size_t)l * 1024 * 512, 0, 0);
                }
                for (int i = bid2 * 512 + c.tid; i < 16 * 1024 + 512 * 16; i += G2 * 512) {
                    if (i < 16 * 1024) { const int o = i >> 10, k = i & 1023; const float w = p.od_w_in[(size_t)k * OD_IN_SRC + 2048 + o] * p.norm_mix[1024 + k]; const unsigned hb = f2bf(w);
                        bf16_t* T = (bf16_t*)(ws + OFF_WSMALL + WSM_TGD); T[i] = (bf16_t)hb; T[16 * 1024 + i] = (bf16_t)f2bf(w - bf2f(hb)); }
                    else { const int r = i - 16 * 1024, ch = r >> 4, o = r & 15; const float w = p.od_gate_up[o * 512 + ch]; const unsigned hb = f2bf(w);
                        bf16_t* T = (bf16_t*)(ws + OFF_WSMALL + WSM_GUT); T[r] = (bf16_t)hb; T[512 * 16 + r] = (bf16_t)f2bf(w - bf2f(hb)); } }
                for (int i = bid2 * 512 + c.tid; i < 2 * 48 * 1024; i += G2 * 512) { const int l = i / (48 * 1024), r = i % (48 * 1024), o = r >> 10, k = r & 1023;
                    float w = 0.f; if (o < 4) w = p.moe_w_group[((size_t)l * 1024 + k) * 4 + o]; else if (o < 36) w = p.moe_w_expert[((size_t)l * 1024 + k) * 32 + (o - 4)];
                    w *= p.norm_moe[l * 1024 + k]; const unsigned hb = f2bf(w); bf16_t* T = (bf16_t*)(ws + OFF_WSMALL + WSM_RT) + (size_t)l * 2 * 48 * 1024;
                    T[r] = (bf16_t)hb; T[48 * 1024 + r] = (bf16_t)f2bf(w - bf2f(hb)); }
                for (int i = bid2 * 512 + c.tid; i < 2 * 512 * 64; i += G2 * 512) { const int wh = i >> 15, r = i & 32767, ch = r >> 6, k = r & 63;
                    ((bf16_t*)(ws + OFF_WSMALL + (wh ? WSM_A2T : WSM_W2T)))[r] = (bf16_t)f2bf((wh ? p.ev_a2 : p.ev_w2)[(size_t)k * 512 + ch]); }
                norm_plain(c2, p.mem, p.mem_norm, (bf16_t*)(ws + OFF_R + R_MEMN), NB * MEMLEN);
                for (int i = bid2 * 512 + c.tid; i < 512 * 128; i += G2 * 512) { const int ch = i >> 7, m = i & 127; ((bf16_t*)(ws + OFF_WSMALL + WSM_G2T))[i] = (bf16_t)f2bf(p.ev_g2[(size_t)m * 512 + ch]); }
                }
                __syncthreads();
                SEAM(0);
            }
            if (INS(1, 1)) for (int rep_ = 0; rep_ < REP(1); ++rep_) { PHASE_BEGIN
                { pg8::Gemm g{H, WD + WE_EV_IN, T_TOK, EV_IN, 1024, 0}; pg8::StaticOrder S; S.init(T_TOK, EV_IN, G, bid);
                  pg8::EpiB16 E{P, EV_IN, nullptr}; pg8::gemm_phase<pg8::EpiB16, pg8::StaticOrder, true, true>(glds, g, S, E); }
                SEAM(1);
            }
            if (INS(2, 2)) for (int rep_ = 0; rep_ < REP(2); ++rep_) { PHASE_BEGIN
#ifdef RWKV_NAIVE
                if (bid < 64) rwkv_naive(c, p, bid);
                else
#else
                {
                    RxPre pre; const int bh0 = bid >> 2, b0 = bh0 >> 3, hd0 = bh0 & 7, ck0 = (bid & 3) * 16;
                    rwkv_x_fetch(pre, (const bf16_t*)(ws + OFF_P), b0, hd0, ck0, c.tid, c.lane, c.wave);
#pragma unroll 1
                    for (int i = 0; i < 16; ++i) rwkv_x(c, p, bid * 16 + i, pre, b0, hd0, i + 1 < 16 ? ck0 + i + 1 : -1);
                }
                __syncthreads();
                SEAM(2);
            }
            if (INS(2, 16)) for (int rep_ = 0; rep_ < REP(16); ++rep_) { PHASE_BEGIN
                if (bid < 64) { rwkv_y(c, p, bid); __syncthreads(); tr_moe_layer_w(c, p, 0, 1280 + bid * 8 + c.wave, 1792); }
                else
#endif
                {
                    for (int u = bid - 64; u < 512; u += G - 64) swa_mfma(c, p, u);
                    __syncthreads();
                    if (bid >= 96) tr_moe_layer_w(c, p, 0, (bid - 96) * 8 + c.wave, 1792);
                    if (bid < 96) {
                        pg8::Gemm g{(const bf16_t*)(ws + OFF_R + R_MEMN), WD + WE_MKV, NB * MEMLEN, 1024, 1024, 0}; pg8::StaticOrder S; S.init(NB * MEMLEN, 1024, 32, bid - 64);
                        pg8::EpiB16 E{(bf16_t*)(ws + OFF_MKV), 1024, nullptr}; pg8::gemm_phase<pg8::EpiB16, pg8::StaticOrder, true, true>(glds, g, S, E); }
                }
#ifndef RWKV_NAIVE
                __syncthreads();
                SEAM(2);
            }
            if (INS(2, 17)) for (int rep_ = 0; rep_ < REP(17); ++rep_) { PHASE_BEGIN
                for (int u = c.gw; u < 4096; u += c.ngw) rwkv_z(c, p, u);
#endif
                __syncthreads();
                SEAM(2);
            }
        } else {
            if (INS(12, 12)) for (int rep_ = 0; rep_ < REP(12); ++rep_) { PHASE_BEGIN
                combine_gk(c, p);
                __syncthreads();
                SEAM(12);
            }
            if (INS(13, 13)) for (int rep_ = 0; rep_ < REP(13); ++rep_) { PHASE_BEGIN
                pg8::Gemm g{H, WD + WE_OD_IN, T_TOK, OD_IN, 1024, 0}; pg8::StaticOrder S; S.init(T_TOK, OD_IN, G, bid);
                pg8::EpiB16 E{P, OD_IN, (const float*)(ws + OFF_ROUTE + ROUTE_RS)};   pg8::gemm_phase<pg8::EpiB16, pg8::StaticOrder, true, true>(glds, g, S, E);
                SEAM(13);
            }
            if (INS(14, 14)) for (int rep_ = 0; rep_ < REP(14); ++rep_) { PHASE_BEGIN
#ifdef GLA_NAIVE
                if (bid < 32) gla_naive(c, p, bid);
                __syncthreads();
                SEAM(14);
#else
                for (int u = bid; u < 2048; u += G) gla_prep(c, p, u);
                __syncthreads();
                SEAM(14);
#endif
            }
#ifndef GLA_NAIVE
            if (INS(14, 18)) for (int rep_ = 0; rep_ < REP(18); ++rep_) { PHASE_BEGIN
                if (bid < 128) gla_state(c, p, bid >> 2, bid & 3);
                else tr_moe_layer(c, p, 1, 128 * 8, 128 * 8);
                __syncthreads();
                SEAM(14);
            }
            if (INS(14, 19)) for (int rep_ = 0; rep_ < REP(19); ++rep_) { PHASE_BEGIN
                gla_finish(c, p);
                __syncthreads();
                SEAM(14);
            }
#endif
        }
        if (INS(pb + 3, 3)) for (int rep_ = 0; rep_ < REP(3); ++rep_) { PHASE_BEGIN
            pg8::Gemm g{(const bf16_t*)p.out, WD + (layer == 0 ? WE_EV_OUT : WE_OD_OUT), T_TOK, 1024, 1024, 0}; pg8::StaticOrder S; S.init(T_TOK, 1024, G, bid);
            pg8::EpiRes E{layer == 0 ? p.x : nullptr, H, 1024, (float*)(ws + OFF_R + R_SSP)};     pg8::gemm_phase<pg8::EpiRes, pg8::StaticOrder, true, true>(glds, g, S, E);
            SEAM(pb + 3);
        }
        if (INS(pb + 5, 5)) for (int rep_ = 0; rep_ < REP(5); ++rep_) { PHASE_BEGIN
            pg8::Gemm g{H, WD + WE_WQ + (size_t)layer * 512 * 1024, T_TOK, 512, 1024, 0}; pg8::StaticOrder S; S.init(T_TOK, 512, G, bid);
            pg8::EpiB16 E{P, 512, nullptr}; pg8::gemm_phase<pg8::EpiB16, pg8::StaticOrder, true, true>(glds, g, S, E);
            SEAM(pb + 5);
        }
        if (INS(pb + 6, 6)) for (int rep_ = 0; rep_ < REP(6); ++rep_) { PHASE_BEGIN for (int u = bid; u < 256; u += G) xattn_mfma(c, p, u); __syncthreads(); SEAM(pb + 6); }
        if (INS(pb + 7, 7)) for (int rep_ = 0; rep_ < REP(7); ++rep_) { PHASE_BEGIN
            pg8::Gemm g{(const bf16_t*)(ws + OFF_P + 32 * MiB), WD + WE_WO + (size_t)layer * 1024 * 512, T_TOK, 1024, 512, 0}; pg8::StaticOrder S; S.init(T_TOK, 1024, G, bid);
            pg8::EpiRes E{nullptr, H, 1024, nullptr}; pg8::gemm_phase<pg8::EpiRes, pg8::StaticOrder, true, true>(glds, g, S, E);
            SEAM(pb + 7);
        }
        if (INS(pb + 8, 8)) for (int rep_ = 0; rep_ < REP(8); ++rep_) { PHASE_BEGIN
            moe_route(c, p, layer);
            __syncthreads();
            SEAM(pb + 8);
        }
        if (INS(pb + 9, 9)) for (int rep_ = 0; rep_ < REP(9); ++rep_) { PHASE_BEGIN moe_slots2(c, p, layer); __syncthreads(); SEAM(pb + 9); }
        if (INS(pb + 10, 10)) for (int rep_ = 0; rep_ < REP(10); ++rep_) { PHASE_BEGIN
            const int* blk = (const int*)(ws + OFF_CTL + CTL_BLK) + layer * 1024; const int nblk = blk[0];
            pg8::Gemm g{H, (const bf16_t*)(ws + OFF_WMOE), nblk * 256, 1024, 1024, (size_t)1024 * 1024 * 2}; pg8::MoeOrder S{blk + 1, nblk * 4, 4, G, bid, (const int*)(ws + OFF_R + R_TOK)};
            pg8::EpiSwiglu E{(bf16_t*)(ws + OFF_R), 512, (const float*)(ws + OFF_R + R_RSS)}; pg8::gemm_phase<pg8::EpiSwiglu, pg8::MoeOrder, true, true>(glds, g, S, E);
            SEAM(pb + 10);
        }
        if (INS(pb + 11, 11)) for (int rep_ = 0; rep_ < REP(11); ++rep_) { PHASE_BEGIN
            const int* blk = (const int*)(ws + OFF_CTL + CTL_BLK) + layer * 1024; const int nblk = blk[0];
            pg8::Gemm g{(const bf16_t*)(ws + OFF_R), (const bf16_t*)(ws + OFF_WMOE + 64 * MiB), nblk * 256, 1024, 512, (size_t)1024 * 512 * 2}; pg8::MoeOrder S{blk + 1, nblk * 4, 4, G, bid, nullptr};
            pg8::EpiB16 E{P, 1024, nullptr}; pg8::gemm_phase<pg8::EpiB16, pg8::MoeOrder, true, true>(glds, g, S, E);
            SEAM(pb + 11);
        }
    }
    if (INS(24, 15)) for (int rep_ = 0; rep_ < REP(15); ++rep_) { PHASE_BEGIN
        for (int r0 = c.gw; r0 < T_TOK; r0 += 4 * c.ngw) {
            f32x4 v[4][4]; int2 ps[4]; float2 gt[4];
#pragma unroll
            for (int q = 0; q < 4; ++q) { const int r = r0 + q * c.ngw; ps[q] = RP[r]; gt[q] = RG[r];
#pragma unroll
                for (int j = 0; j < 4; ++j) { const u32x2 w = *((const u32x2*)(H + (size_t)r * 1024) + c.lane + 64 * j); v[q][j] = (f32x4){bflo(w.x), bfhi(w.x), bflo(w.y), bfhi(w.y)}; } }
#pragma unroll
            for (int q = 0; q < 4; ++q) row_combine(v[q], P, ps[q].x, ps[q].y, gt[q].x, gt[q].y, c.lane);
#pragma unroll
            for (int q = 0; q < 4; ++q) { const int r = r0 + q * c.ngw; const float rs = row_rstd(v[q]); row_scale(v[q], rs, p.norm_final, c.lane); row_store_f32(p.out + (size_t)r * 1024, c.lane, v[q]); }
        }
    }
}

extern "C" void kernel_launch(void* const* d_in, const int* in_sizes, int n_in, void* d_out, int out_size, void* d_ws, size_t ws_size, hipStream_t stream) {
    static int ready = 0;
    if (ready == 0) {
        if (n_in != 37 || out_size != T_TOK * DM || ws_size < WS_NEED) { fprintf(stderr, "kernel_launch: unexpected problem (n_in %d, out %d, ws %zu)\n", n_in, out_size, ws_size); ready = -1; return; }
        if (hipFuncSetAttribute((const void*)hybrid_fwd, hipFuncAttributeMaxDynamicSharedMemorySize, LDS_BYTES) != hipSuccess) { fprintf(stderr, "kernel_launch: hipFuncSetAttribute failed\n"); ready = -1; return; }
        ready = 1;
    }
    if (ready < 0) return;
    hipMemsetAsync((char*)d_ws + OFF_CTL, 0, CTL_ZERO_BYTES, stream);
    Params p{};
    const float** f = (const float**)&p;
    for (int i = 0; i < 37; ++i) f[i] = (const float*)d_in[i];
    p.out = (float*)d_out; p.ws = (unsigned char*)d_ws; p.ph_lo = 0; p.ph_hi = N_PHASES;
    hipLaunchKernelGGL(hybrid_fwd, dim3(256), dim3(512), LDS_BYTES, stream, p);
}
```

```cpp
#include <hip/hip_runtime.h>
#include <cstdint>
#include <cstdio>

#define LAS __attribute__((address_space(3)))
typedef unsigned short bf16_t;
typedef float f32x4 __attribute__((ext_vector_type(4)));
typedef float f32x2 __attribute__((ext_vector_type(2)));
typedef unsigned u32x4 __attribute__((ext_vector_type(4)));
typedef unsigned u32x2 __attribute__((ext_vector_type(2)));

constexpr int T_TOK = 32768, DM = 1024, SEQ = 4096, NB = 8, MEMLEN = 256;
constexpr int EV_IN = 2560, OD_IN = 3072  , OD_IN_SRC = 3088;
constexpr int NEXP = 32, MOE_FF = 512, PMAX = 65536 + NEXP * 256;

constexpr size_t MiB = 1024 * 1024;
constexpr size_t OFF_CTL = 0;
constexpr size_t CTL_ZERO_BYTES = 64 * 1024;
constexpr size_t CTL_CNT = 16384;
constexpr size_t CTL_CUR = 16384 + 1024;
constexpr size_t CTL_BLK = 128 * 1024;
constexpr size_t OFF_ROUTE = 1 * MiB;
constexpr size_t OFF_WSMALL = 2 * MiB;
constexpr size_t OFF_MKV = 3 * MiB;
constexpr size_t OFF_WD = 7 * MiB;
constexpr size_t OFF_WMOE = 28 * MiB;
constexpr size_t OFF_H = 124 * MiB;
constexpr size_t OFF_P = 188 * MiB;
constexpr size_t OFF_R = 380 * MiB;
constexpr size_t WS_NEED = 552 * MiB;
constexpr size_t WE_EV_IN = 0, WE_EV_OUT = 2560ull * 1024, WE_OD_IN = 3584ull * 1024, WE_OD_OUT = 6656ull * 1024, WE_MKV = 7680ull * 1024, WE_WQ = 8704ull * 1024, WE_WO = 9728ull * 1024;

constexpr size_t ROUTE_RS = 768 * 1024;
constexpr size_t R_TOK = 81 * MiB;
constexpr size_t R_SSP = 0, R_RSS = 80 * MiB;
constexpr size_t P_XB1 = 64 * MiB;
struct Params {
    const float *x, *mem, *norm_mix, *norm_xattn, *norm_moe, *norm_final;
    const float *ev_w_in, *ev_sinks, *ev_mu, *ev_w0, *ev_w2, *ev_a0, *ev_a2, *ev_g2, *ev_k_k, *ev_k_a, *ev_r_k, *ev_lnx_w, *ev_lnx_b, *ev_w_out;
    const float *od_w_in, *od_gate_up, *od_gate_b, *od_onorm, *od_w_out;
    const float *mem_norm, *mem_wk, *mem_wv, *xa_wq, *xa_wo;
    const float *moe_w_group, *moe_b_group, *moe_w_expert, *moe_b_expert, *moe_w1, *moe_w3, *moe_w2;
    float* out; unsigned char* ws; int ph_lo, ph_hi;
};

#define XB_TMO      128
#define XB_XCNT(j)  (256  + 64 * (j))
#define XB_XSUB(j)  (1280 + 64 * (j))
#define XB_XGEN(j)  (2304 + 64 * (j))
#define XB_TOP      3328
#define XB_TOPGEN   3392
#define XCD_BAR_WORDS 3456
#define XB_SPIN_CAP (1u << 18)
#define LAS __attribute__((address_space(3)))

__device__ __forceinline__ unsigned xb_ld(unsigned* p)              { return __hip_atomic_load(p, __ATOMIC_RELAXED, __HIP_MEMORY_SCOPE_AGENT); }
__device__ __forceinline__ unsigned xb_add(unsigned* p, unsigned v) { return __hip_atomic_fetch_add(p, v, __ATOMIC_RELAXED, __HIP_MEMORY_SCOPE_AGENT); }
__device__ __forceinline__ unsigned xb_xcc_id() { return (unsigned)__builtin_amdgcn_s_getreg((3 << 11) | 20) & 0xFu; }
#define XB_SPIN(cond, bar) do { unsigned _sp = 0; while (cond) { __builtin_amdgcn_s_sleep(1); \
    if ((++_sp & 255u) == 0u) { if (xb_ld(&(bar)[XB_TMO])) break; if (_sp > XB_SPIN_CAP) { atomicAdd(&(bar)[XB_TMO], 1u); break; } } } } while (0)

struct XcdBarrier {
    unsigned* bar; unsigned x;
    volatile LAS unsigned* st;
};

__device__ __forceinline__ XcdBarrier xcd_barrier_post(unsigned* bar, volatile LAS unsigned* st) {
    XcdBarrier b; b.bar = bar; b.x = xb_xcc_id(); b.st = st;
    if (threadIdx.x == 0) (void)xb_add(&bar[XB_XCNT(b.x)], 1u);
    return b;
}
__device__ __forceinline__ void xcd_barrier_complete(unsigned* bar, unsigned x, unsigned& nloc, unsigned& nx) {
    const unsigned G = gridDim.x * gridDim.y * gridDim.z;
    unsigned sum, cnt, mine, sp = 0u;
    for (;;) {
        sum = 0u; cnt = 0u; mine = 0u;
#pragma unroll
        for (unsigned j = 0; j < 16; ++j) { const unsigned c = xb_ld(&bar[XB_XCNT(j)]); sum += c; cnt += (c > 0u) ? 1u : 0u; mine = (j == x) ? c : mine; }
        if (sum == G) break;
        __builtin_amdgcn_s_sleep(1);
        if ((++sp & 255u) == 0u) { if (xb_ld(&bar[XB_TMO])) break; if (sp > XB_SPIN_CAP) { atomicAdd(&bar[XB_TMO], 1u); break; } }
    }
    nloc = mine > 0u ? mine : 1u; nx = cnt > 0u ? cnt : 1u;
}

__device__ __forceinline__ void xcd_barrier(const XcdBarrier& b) {
    asm volatile("s_waitcnt vmcnt(0)" ::: "memory");
    __syncthreads();
    if (threadIdx.x == 0) {
        unsigned* bar = b.bar;
        __builtin_amdgcn_s_waitcnt(0);
        unsigned nloc = b.st[0], nx = b.st[1];
        if (nloc == 0u) { xcd_barrier_complete(bar, b.x, nloc, nx); b.st[0] = nloc; b.st[1] = nx; }
        const unsigned old = xb_add(&bar[XB_XSUB(b.x)], 1u);
        const unsigned gen = old / nloc;
        if (old + 1u == (gen + 1u) * nloc) {
            __builtin_amdgcn_fence(__ATOMIC_RELEASE, "agent");
            asm volatile("s_waitcnt vmcnt(0)" ::: "memory");
            const unsigned og = xb_add(&bar[XB_TOP], 1u);
            const unsigned tg = og / nx;
            if (og + 1u == (tg + 1u) * nx) xb_add(&bar[XB_TOPGEN], 1u);
            else XB_SPIN(xb_ld(&bar[XB_TOPGEN]) == tg, bar);
            __builtin_amdgcn_fence(__ATOMIC_ACQUIRE, "agent");
            xb_add(&bar[XB_XGEN(b.x)], 1u);
            asm volatile("s_waitcnt vmcnt(0)" ::: "memory");
        } else {
            XB_SPIN(xb_ld(&bar[XB_XGEN(b.x)]) == gen, bar);
            __builtin_amdgcn_fence(__ATOMIC_ACQUIRE, "agent");
            asm volatile("s_waitcnt vmcnt(0)" ::: "memory");
        }
    }
    __syncthreads();
}
namespace pg8 {
#define PG8_LAS __attribute__((address_space(3)))
typedef unsigned short bf16_t;
typedef short bf16x8 __attribute__((ext_vector_type(8)));
typedef float f32x4 __attribute__((ext_vector_type(4)));
typedef unsigned u32x4 __attribute__((ext_vector_type(4)));
constexpr int BM = 256, BK = 64, HALF = 128, HTB = HALF * BK * 2  , STAGE_BYTES = 8 * HTB, NXCD = 8, WGM = 8;

__host__ __device__ __forceinline__ int lds_byte(int r, int c) { const int st = (r >> 4) * 2 + (c >> 5), rr = r & 15, cc = c & 31, ob = rr * 64 + cc * 2; return st * 1024 + (ob ^ (((ob >> 9) & 1) << 5)); }
__host__ __device__ __forceinline__ void stage_rc(int b, int& R, int& C) { const int st = b / 1024, sb = b % 1024, swz = sb ^ (((sb >> 9) & 1) << 5); R = (st >> 1) * 16 + swz / 64; C = (st & 1) * 32 + (swz % 64) / 2; }
__host__ __device__ __forceinline__ int perm32(int rho) { const int n = rho >> 4, i = rho & 15; return 8 * (i >> 2) + 4 * n + (i & 3); }

struct Unit { int pm, pn, e; };
struct Gemm { const bf16_t* A; const bf16_t* Bt; int M, N, K; size_t bexp; };

struct StaticOrder {
    int nM, nN, nwg, G, c;
    __host__ __device__ void init(int M, int N, int G_, int c_) { nM = M / BM; nN = N / BM; nwg = nM * nN; G = G_; c = c_; }
    __host__ __device__ bool next(int i, Unit& u) const {
        const long L = (long)i * G + c; if (L >= nwg) return false;
        int wgid = (int)L; { const int q = nwg / NXCD, r = nwg % NXCD, xcd = wgid % NXCD, off = wgid / NXCD; wgid = (xcd < r ? xcd * (q + 1) : r * (q + 1) + (xcd - r) * q) + off; }
        const int nig = WGM * nN, gid = wgid / nig, fm = gid * WGM, gsz = (nM - fm) < WGM ? (nM - fm) : WGM;
        u.pm = fm + ((wgid % nig) % gsz); u.pn = (wgid % nig) / gsz; u.e = 0; return true;
    }
    __device__ __forceinline__ int arow(const Unit& u, int r) const { return u.pm * BM + r; }
    __device__ __forceinline__ void a_ready(const Unit&) const {}
    __device__ __forceinline__ void done(const Unit&) const {}
};
typedef __bf16 bf16x2_c __attribute__((ext_vector_type(2))); typedef float f32x2_c __attribute__((ext_vector_type(2)));
__device__ __forceinline__ unsigned cvt_pk_bf16(float lo, float hi) { const f32x2_c v = {lo, hi}; return __builtin_bit_cast(unsigned, __builtin_convertvector(v, bf16x2_c)); }

struct EpiB16 {
    static constexpr bool PERM = true, AFTER_DRAIN = false;
    bf16_t* O; int ldc; const float* rs;
    __device__ __forceinline__ void operator()(const f32x4 (&acc)[2][2][4][2], const Unit& u, int wr, int wc, int fr, int fq) const {
        const int row0 = u.pm * BM + wr * 64 + fr, col0 = u.pn * BM + wc * 32 + 8 * fq;
#pragma unroll
        for (int ai = 0; ai < 2; ++ai)
#pragma unroll
            for (int m = 0; m < 4; ++m) { bf16_t* rowp = O + (size_t)(row0 + ai * HALF + m * 16) * ldc + col0; const float r1 = rs ? rs[row0 + ai * HALF + m * 16] : 1.0f;
#pragma unroll
                for (int bj = 0; bj < 2; ++bj) { const f32x4 v0 = acc[ai][bj][m][0] * r1, v1 = acc[ai][bj][m][1] * r1;
                    u32x4 w; w.x = cvt_pk_bf16(v0[0], v0[1]); w.y = cvt_pk_bf16(v0[2], v0[3]); w.z = cvt_pk_bf16(v1[0], v1[1]); w.w = cvt_pk_bf16(v1[2], v1[3]);
                    *(u32x4*)(rowp + bj * HALF) = w; } }
    }
};
struct EpiRes {
    static constexpr bool PERM = true, AFTER_DRAIN = false;
    const float* base32; bf16_t* X; int ldc; float* ssp;
    __device__ __forceinline__ void operator()(const f32x4 (&acc)[2][2][4][2], const Unit& u, int wr, int wc, int fr, int fq) const {
        const int row0 = u.pm * BM + wr * 64 + fr, col0 = u.pn * BM + wc * 32 + 8 * fq;
#pragma unroll
        for (int ai = 0; ai < 2; ++ai) {
            f32x4 bs[4][2][2];
            if (base32) {
#pragma unroll
                for (int m = 0; m < 4; ++m) { const size_t off = (size_t)(row0 + ai * HALF + m * 16) * ldc + col0;
#pragma unroll
                    for (int bj = 0; bj < 2; ++bj)
#pragma unroll
                        for (int n = 0; n < 2; ++n) bs[m][bj][n] = *(const f32x4*)(base32 + off + bj * HALF + 4 * n); }
            } else {
                u32x4 rb[4][2];
#pragma unroll
                for (int m = 0; m < 4; ++m) { const size_t off = (size_t)(row0 + ai * HALF + m * 16) * ldc + col0;
#pragma unroll
                    for (int bj = 0; bj < 2; ++bj) rb[m][bj] = *(const u32x4*)(X + off + bj * HALF); }
#pragma unroll
                for (int m = 0; m < 4; ++m)
#pragma unroll
                    for (int bj = 0; bj < 2; ++bj) { const u32x4 w = rb[m][bj];
                        bs[m][bj][0] = (f32x4){__uint_as_float(w.x << 16), __uint_as_float(w.x & 0xFFFF0000u), __uint_as_float(w.y << 16), __uint_as_float(w.y & 0xFFFF0000u)};
                        bs[m][bj][1] = (f32x4){__uint_as_float(w.z << 16), __uint_as_float(w.z & 0xFFFF0000u), __uint_as_float(w.w << 16), __uint_as_float(w.w & 0xFFFF0000u)}; }
            }
#pragma unroll
            for (int m = 0; m < 4; ++m) { const int row = row0 + ai * HALF + m * 16; const size_t off = (size_t)row * ldc + col0; float ss = 0.f;
#pragma unroll
                for (int bj = 0; bj < 2; ++bj) { const f32x4 o0 = bs[m][bj][0] + acc[ai][bj][m][0], o1 = bs[m][bj][1] + acc[ai][bj][m][1];
                    u32x4 w; w.x = cvt_pk_bf16(o0[0], o0[1]); w.y = cvt_pk_bf16(o0[2], o0[3]); w.z = cvt_pk_bf16(o1[0], o1[1]); w.w = cvt_pk_bf16(o1[2], o1[3]);
                    *(u32x4*)(X + off + bj * HALF) = w;
                    ss += ((o0[0] * o0[0] + o0[1] * o0[1]) + (o0[2] * o0[2] + o0[3] * o0[3])) + ((o1[0] * o1[0] + o1[1] * o1[1]) + (o1[2] * o1[2] + o1[3] * o1[3])); }
                if (ssp) { ss += __shfl_xor(ss, 16); ss += __shfl_xor(ss, 32); if (fq == 0) ssp[(size_t)row * 16 + 4 * u.pn + wc] = ss; } }
        }
    }
};
struct EpiSwiglu {
    static constexpr bool PERM = true, AFTER_DRAIN = false;
    bf16_t* O; int ldc; const float* rs;
    __device__ __forceinline__ void operator()(const f32x4 (&acc)[2][2][4][2], const Unit& u, int wr, int wc, int fr, int fq) const {
        const int row0 = u.pm * BM + wr * 64 + fr, col0 = (u.pn * BM + wc * 32 + 8 * fq) >> 1;
        typedef unsigned u32x2v __attribute__((ext_vector_type(2)));
#pragma unroll
        for (int ai = 0; ai < 2; ++ai)
#pragma unroll
            for (int m = 0; m < 4; ++m) { bf16_t* rowp = O + (size_t)(row0 + ai * HALF + m * 16) * ldc + col0; const float r1 = rs[row0 + ai * HALF + m * 16];
#pragma unroll
                for (int bj = 0; bj < 2; ++bj) { const f32x4 a = acc[ai][bj][m][0] * r1, b = acc[ai][bj][m][1] * r1; float h[4];
#pragma unroll
                    for (int i = 0; i < 4; ++i) h[i] = a[i] * __builtin_amdgcn_rcpf(1.0f + __expf(-a[i])) * b[i];
                    u32x2v w; w.x = cvt_pk_bf16(h[0], h[1]); w.y = cvt_pk_bf16(h[2], h[3]);
                    *(u32x2v*)(rowp + bj * (HALF / 2)) = w; } }
    }
};
struct MoeOrder {
    const int* blk_e; int nunits, nN, G, c; const int* tok;
    __device__ __forceinline__ bool next(int i, Unit& u) const {
        const long L = (long)i * G + c; if (L >= nunits) return false;
        u.pm = (int)(L / nN); u.pn = (int)(L % nN); u.e = blk_e[u.pm]; return true;
    }
    __device__ __forceinline__ int arow(const Unit& u, int r) const { return tok ? tok[u.pm * BM + r] : u.pm * BM + r; }
    __device__ __forceinline__ void a_ready(const Unit&) const {}
    __device__ __forceinline__ void done(const Unit&) const {}
};
template <class Epi, class Sched, bool ALIGN_EPI = false, bool SP2 = false>
__device__ __forceinline__ void gemm_phase(PG8_LAS unsigned char* lds, const Gemm g, const Sched& S, const Epi& E) {
    static_assert(SP2, "only the two-super-phase loop is kept in this file");
    int tid_ = threadIdx.x; asm volatile("" : "+v"(tid_));
    const int tid = tid_, wid = __builtin_amdgcn_readfirstlane(tid >> 6), lane = tid & 63, wr = wid >> 2, wc = wid & 3, fr = lane & 15, fq = lane >> 4;
    const int K = g.K, nt = K / BK;
    unsigned voffB[2]; int RA[2], CA[2];
#pragma unroll
    for (int i = 0; i < 2; ++i) { int R, C; stage_rc(tid * 16 + i * 8192, R, C); const int Rb = Epi::PERM ? ((R & ~31) + perm32(R & 31)) : R;
        RA[i] = R; CA[i] = C; voffB[i] = (unsigned)(Rb * K + C) * 2u; }
    const size_t kstep = (size_t)(BK * 2);
    const size_t hstep = (size_t)HALF * K * 2;
    const size_t tstep = 2 * hstep;
    const unsigned ldsw = (unsigned)wid * 1024u;
    const int aoff = lds_byte(wr * 64 + fr, fq * 8), boff = lds_byte(wc * 32 + fr, fq * 8);
#define PG8_SA(b, h) (((b) * 2 + (h)) * HTB)
#define PG8_SB(b, h) ((4 + (b) * 2 + (h)) * HTB)
#define PG8_STAGE(bufoff, gbase, voff) do { _Pragma("unroll") for (int _i = 0; _i < 2; ++_i) \
        __builtin_amdgcn_global_load_lds((const unsigned*)((const char*)(gbase) + (voff)[_i]), (PG8_LAS unsigned*)(lds + (bufoff) + ldsw + _i * 8192), 16, 0, 0); } while (0)
#define PG8_AOFF(vo, u) do { _Pragma("unroll") for (int _h = 0; _h < 2; ++_h) _Pragma("unroll") for (int _i = 0; _i < 2; ++_i) \
        vo[_h][_i] = (unsigned)(S.arow(u, _h * HALF + RA[_i]) * K + CA[_i]) * 2u; } while (0)
#define PG8_LDA(dst, b, h) do { _Pragma("unroll") for (int m = 0; m < 4; ++m) _Pragma("unroll") for (int k = 0; k < 2; ++k) dst[m][k] = *(const PG8_LAS bf16x8*)(lds + PG8_SA(b, h) + aoff + m * 2048 + k * 1024); } while (0)
#define PG8_LDB(dst, b, h) do { _Pragma("unroll") for (int n = 0; n < 2; ++n) _Pragma("unroll") for (int k = 0; k < 2; ++k) dst[n][k] = *(const PG8_LAS bf16x8*)(lds + PG8_SB(b, h) + boff + n * 2048 + k * 1024); } while (0)
#define PG8_MMA(ai, bj, At, Bt) do { __builtin_amdgcn_s_setprio(1); _Pragma("unroll") for (int m = 0; m < 4; ++m) _Pragma("unroll") for (int n = 0; n < 2; ++n) _Pragma("unroll") for (int k = 0; k < 2; ++k) \
        acc[ai][bj][m][n] = __builtin_amdgcn_mfma_f32_16x16x32_bf16(Bt[n][k], At[m][k], acc[ai][bj][m][n], 0, 0, 0); __builtin_amdgcn_s_setprio(0); } while (0)
#define PG8_WAIT_V(n) asm volatile("s_waitcnt vmcnt(" #n ")" ::: "memory")
#define PG8_WAIT_L(n) asm volatile("s_waitcnt lgkmcnt(" #n ")" ::: "memory")
#define PG8_BAR __builtin_amdgcn_s_barrier()
#define PG8_SCHED __builtin_amdgcn_sched_barrier(0)
    Unit cur, nxt; int ui = 0;
    if (!S.next(0, cur)) return;
    f32x4 acc[2][2][4][2];
#pragma unroll
    for (int a = 0; a < 2; ++a)
#pragma unroll
        for (int b = 0; b < 2; ++b)
#pragma unroll
            for (int m = 0; m < 4; ++m)
#pragma unroll
                for (int n = 0; n < 2; ++n) acc[a][b][m][n] = (f32x4){0.f, 0.f, 0.f, 0.f};
    bf16x8 At[4][2], B0[2][2], B1[2][2];
    const char* Ab = (const char*)g.A;
    const char* cB = (const char*)g.Bt + (size_t)cur.pn * tstep + (size_t)cur.e * g.bexp;
    unsigned curA[2][2], nxtA[2][2];
    S.a_ready(cur);
    PG8_AOFF(curA, cur);
    PG8_STAGE(PG8_SB(0, 0), cB, voffB); PG8_STAGE(PG8_SB(0, 1), cB + hstep, voffB); PG8_STAGE(PG8_SA(0, 0), Ab, curA[0]); PG8_STAGE(PG8_SA(0, 1), Ab, curA[1]);
    if (wr == 1) PG8_BAR;
    PG8_WAIT_V(2); PG8_BAR;
    PG8_STAGE(PG8_SB(1, 0), cB + kstep, voffB); PG8_STAGE(PG8_SA(1, 0), Ab + kstep, curA[0]); PG8_STAGE(PG8_SB(1, 1), cB + hstep + kstep, voffB);
    PG8_WAIT_V(6); PG8_BAR;
    for (;;) {
        const bool has_next = S.next(ui + 1, nxt);
        const char* nB = has_next ? (const char*)g.Bt + (size_t)nxt.pn * tstep + (size_t)nxt.e * g.bexp : cB;
        if (has_next) { PG8_AOFF(nxtA, nxt); }
        else {
#pragma unroll
            for (int h = 0; h < 2; ++h)
#pragma unroll
                for (int i = 0; i < 2; ++i) nxtA[h][i] = curA[h][i]; }
        for (int t = 0; t < nt; t += 2) {
            const bool last = (t == nt - 2);
            const char* a1 = Ab + (size_t)(t + 1) * kstep;
            const char* a2 = last ? Ab : Ab + (size_t)(t + 2) * kstep; const char* b2 = last ? nB : cB + (size_t)(t + 2) * kstep;
            const char* a3 = a2 + kstep; const char* b3 = b2 + kstep;
            unsigned vo2[2][2];
#pragma unroll
            for (int h = 0; h < 2; ++h)
#pragma unroll
                for (int i = 0; i < 2; ++i) vo2[h][i] = last ? nxtA[h][i] : curA[h][i];
            if (last && has_next) S.a_ready(nxt);
            PG8_LDB(B0, 0, 0); PG8_LDB(B1, 0, 1); PG8_SCHED; PG8_LDA(At, 0, 0); PG8_STAGE(PG8_SA(1, 1), a1, curA[1]);
            PG8_WAIT_V(8); PG8_WAIT_L(0); PG8_BAR; PG8_MMA(0, 0, At, B0); PG8_MMA(0, 1, At, B1); PG8_BAR; PG8_SCHED;
            PG8_LDA(At, 0, 1); PG8_STAGE(PG8_SB(0, 0), b2, voffB); PG8_STAGE(PG8_SB(0, 1), b2 + hstep, voffB); PG8_STAGE(PG8_SA(0, 0), a2, vo2[0]);
            PG8_WAIT_V(8); PG8_WAIT_L(0); PG8_BAR; PG8_MMA(1, 0, At, B0); PG8_MMA(1, 1, At, B1); PG8_BAR; PG8_SCHED;
            PG8_LDB(B0, 1, 0); PG8_LDB(B1, 1, 1); PG8_SCHED; PG8_LDA(At, 1, 0); PG8_STAGE(PG8_SA(0, 1), a2, vo2[1]);
            PG8_WAIT_V(8); PG8_WAIT_L(0); PG8_BAR; PG8_MMA(0, 0, At, B0); PG8_MMA(0, 1, At, B1); PG8_BAR; PG8_SCHED;
            PG8_LDA(At, 1, 1); PG8_STAGE(PG8_SB(1, 0), b3, voffB); PG8_STAGE(PG8_SB(1, 1), b3 + hstep, voffB); PG8_STAGE(PG8_SA(1, 0), a3, vo2[0]);
            PG8_WAIT_V(8); PG8_WAIT_L(0); PG8_BAR; PG8_MMA(1, 0, At, B0); PG8_MMA(1, 1, At, B1); PG8_BAR; PG8_SCHED;
        }
        if constexpr (ALIGN_EPI) { if (wr == 0) PG8_BAR; }
        if constexpr (!Epi::AFTER_DRAIN) { E(acc, cur, wr, wc, fr, fq); S.done(cur); }
        if (!has_next) break;
#pragma unroll
        for (int a = 0; a < 2; ++a)
#pragma unroll
            for (int b = 0; b < 2; ++b)
#pragma unroll
                for (int m = 0; m < 4; ++m)
#pragma unroll
                    for (int n = 0; n < 2; ++n) acc[a][b][m][n] = (f32x4){0.f, 0.f, 0.f, 0.f};
        cur = nxt; cB = nB; ++ui;
#pragma unroll
        for (int h = 0; h < 2; ++h)
#pragma unroll
            for (int i = 0; i < 2; ++i) curA[h][i] = nxtA[h][i];
        if constexpr (ALIGN_EPI) { if (wr == 1) PG8_BAR; }
    }
    PG8_WAIT_V(0);
    if constexpr (!ALIGN_EPI) { if (wr == 0) PG8_BAR; }
    PG8_BAR;
    if constexpr (Epi::AFTER_DRAIN) { E.fused(acc, cur, wr, wc, fr, fq, lds, wid, lane); S.done(cur); }
#undef PG8_SA
#undef PG8_SB
#undef PG8_STAGE
#undef PG8_AOFF
#undef PG8_LDA
#undef PG8_LDB
#undef PG8_MMA
#undef PG8_WAIT_V
#undef PG8_WAIT_L
#undef PG8_BAR
#undef PG8_SCHED
}
}
__device__ __forceinline__ float bf2f(unsigned v) { return __uint_as_float(v << 16); }
__device__ __forceinline__ unsigned f2bf(float f) { unsigned u = __float_as_uint(f); u += 0x7FFFu + ((u >> 16) & 1u); return u >> 16; }
typedef __bf16 bf16x2_t __attribute__((ext_vector_type(2)));
__device__ __forceinline__ unsigned pk2(float lo, float hi) { const f32x2 v = {lo, hi}; return __builtin_bit_cast(unsigned, __builtin_convertvector(v, bf16x2_t)); }
__device__ __forceinline__ float bflo(unsigned w) { return __uint_as_float(w << 16); }
__device__ __forceinline__ float bfhi(unsigned w) { return __uint_as_float(w & 0xFFFF0000u); }
__device__ __forceinline__ float wave_sum(float v) {
#pragma unroll
    for (int o = 1; o < 64; o <<= 1) v += __shfl_xor(v, o);
    return v;
}
__device__ __forceinline__ float wave_max(float v) {
#pragma unroll
    for (int o = 1; o < 64; o <<= 1) v = fmaxf(v, __shfl_xor(v, o));
    return v;
}
__device__ __forceinline__ float sigmoidf_(float x) { return __builtin_amdgcn_rcpf(1.0f + __expf(-x)); }
__device__ __forceinline__ float tanhf_(float x) { return 1.0f - 2.0f * __builtin_amdgcn_rcpf(__expf(2.0f * x) + 1.0f); }
#define LDS_WAIT() asm volatile("s_waitcnt lgkmcnt(0)" ::: "memory")

struct Ctx { int tid, wave, lane, gw, ngw; unsigned char* shm; };

__device__ __forceinline__ int tr_src_col(int mode, int n, int scol0) { return mode == 1 ? (n < 2048 ? n : n + 16) : scol0 + n; }
__device__ __forceinline__ int tr_dst_row(int mode, int n, int drow0) { return mode == 2 ? 8 * (n >> 2) + (n & 3) : (mode == 3 ? 8 * (n >> 2) + 4 + (n & 3) : drow0 + n); }
struct TrD { const float* W; bf16_t* WT; const float* gain; int ldw, scol0, K, drow0, mode, item, nblk; };
__device__ __forceinline__ void tr_load(const TrD& d, int lane, f32x4 (&v)[8]) {
    const int kb = d.item / d.nblk, nb = d.item % d.nblk, k0 = 64 * kb, n0 = 32 * nb;
    const int n4 = 4 * (lane & 7), sc = tr_src_col(d.mode, n0 + n4, d.scol0);
#pragma unroll
    for (int i = 0; i < 8; ++i) v[i] = *(const f32x4*)(d.W + (size_t)(k0 + 8 * i + (lane >> 3)) * d.ldw + sc);
}
__device__ __forceinline__ void tr_finish(const TrD& d, int lane, f32x4 (&v)[8], LAS float* scr) {
    const int kb = d.item / d.nblk, nb = d.item % d.nblk, k0 = 64 * kb, n0 = 32 * nb, n4 = 4 * (lane & 7);
    if (d.gain) {
#pragma unroll
        for (int i = 0; i < 8; ++i) v[i] = v[i] * d.gain[k0 + 8 * i + (lane >> 3)]; }
#pragma unroll
    for (int i = 0; i < 8; ++i) { LAS float* q = scr + (8 * i + (lane >> 3)) * 33 + n4; q[0] = v[i].x; q[1] = v[i].y; q[2] = v[i].z; q[3] = v[i].w; }
    LDS_WAIT(); asm volatile("" ::: "memory");
    const int c = lane & 7;
#pragma unroll
    for (int j = 0; j < 4; ++j) { const int n = (lane >> 3) + 8 * j; const LAS float* s = scr + (8 * c) * 33 + n;
        u32x4 o; o.x = pk2(s[0 * 33], s[1 * 33]); o.y = pk2(s[2 * 33], s[3 * 33]); o.z = pk2(s[4 * 33], s[5 * 33]); o.w = pk2(s[6 * 33], s[7 * 33]);
        *(u32x4*)(d.WT + (size_t)tr_dst_row(d.mode, n0 + n, d.drow0) * d.K + k0 + 8 * c) = o; }
    LDS_WAIT(); asm volatile("" ::: "memory");
}
__device__ __forceinline__ void tr_pair(const TrD& d0, const TrD& d1, bool has1, int lane, LAS float* scr) {
    f32x4 va[8], vb[8];
    tr_load(d0, lane, va); if (has1) tr_load(d1, lane, vb);
    tr_finish(d0, lane, va, scr); if (has1) tr_finish(d1, lane, vb, scr + 64 * 33);
}
__device__ __forceinline__ void tr_matrix(const Ctx& c, const float* W, int ldw, int scol0, int K, int ncols, bf16_t* WT, int drow0, int mode, const float* gain = nullptr) {
    LAS float* scr = (LAS float*)(c.shm) + c.wave * (2 * 64 * 33);
    const int nblk = ncols / 32, nitems = (K / 64) * nblk;
    for (int it = c.gw; it < nitems; it += 2 * c.ngw) { TrD d0{W, WT, gain, ldw, scol0, K, drow0, mode, it, nblk}; TrD d1 = d0; d1.item = it + c.ngw; tr_pair(d0, d1, it + c.ngw < nitems, c.lane, scr); }
}
__device__ __forceinline__ TrD tr_moe_desc(const Params& p, int layer, int it) {
    bf16_t* w13t = (bf16_t*)(p.ws + OFF_WMOE); bf16_t* w2t = (bf16_t*)(p.ws + OFF_WMOE + 64 * MiB);
    const float* w1 = p.moe_w1 + (size_t)layer * NEXP * 1024 * 512; const float* w3 = p.moe_w3 + (size_t)layer * NEXP * 1024 * 512; const float* w2 = p.moe_w2 + (size_t)layer * NEXP * 512 * 1024;
    const int e = it / 768, r = it % 768;
    if (r < 256) return TrD{w1 + (size_t)e * 1024 * 512, w13t + (size_t)e * 1024 * 1024, p.norm_moe + layer * 1024, 512, 0, 1024, 0, 2, r, 16};
    if (r < 512) return TrD{w3 + (size_t)e * 1024 * 512, w13t + (size_t)e * 1024 * 1024, p.norm_moe + layer * 1024, 512, 0, 1024, 0, 3, r - 256, 16};
    return TrD{w2 + (size_t)e * 512 * 1024, w2t + (size_t)e * 1024 * 512, nullptr, 1024, 0, 512, 0, 0, r - 512, 32};
}
__device__ __forceinline__ void tr_moe_layer_w(const Ctx& c, const Params& p, int layer, int widx, int nw) {
    LAS float* scr = (LAS float*)(c.shm) + c.wave * (2 * 64 * 33);
    for (int it = widx; it < NEXP * 768; it += 2 * nw) { const bool has1 = it + nw < NEXP * 768; const TrD d0 = tr_moe_desc(p, layer, it); const TrD d1 = tr_moe_desc(p, layer, has1 ? it + nw : it); tr_pair(d0, d1, has1, c.lane, scr); }
}
__device__ __forceinline__ void tr_moe_layer(const Ctx& c, const Params& p, int layer, int gw0, int ngw) {
    LAS float* scr = (LAS float*)(c.shm) + c.wave * (2 * 64 * 33);
    for (int it = c.gw - gw0; it < NEXP * 768; it += 2 * ngw) { const bool has1 = it + ngw < NEXP * 768; const TrD d0 = tr_moe_desc(p, layer, it); const TrD d1 = tr_moe_desc(p, layer, has1 ? it + ngw : it); tr_pair(d0, d1, has1, c.lane, scr); }
}

__device__ __forceinline__ void row_load(const float* row, int lane, f32x4 (&v)[4]) {
#pragma unroll
    for (int j = 0; j < 4; ++j) v[j] = *((const f32x4*)row + lane + 64 * j);
}
__device__ __forceinline__ float row_rstd(const f32x4 (&v)[4]) {
    float s = 0.f;
#pragma unroll
    for (int j = 0; j < 4; ++j) s += (v[j].x * v[j].x + v[j].y * v[j].y) + (v[j].z * v[j].z + v[j].w * v[j].w);
    return 1.0f / sqrtf(wave_sum(s) * (1.0f / 1024.0f) + 1e-6f);
}
__device__ __forceinline__ void row_scale(f32x4 (&v)[4], float rstd, const float* gain, int lane) {
#pragma unroll
    for (int j = 0; j < 4; ++j) { const f32x4 g = *((const f32x4*)gain + lane + 64 * j); v[j] = v[j] * rstd * g; }
}
__device__ __forceinline__ void row_store_bf16(bf16_t* orow, int lane, const f32x4 (&v)[4]) {
#pragma unroll
    for (int j = 0; j < 4; ++j) { u32x2 o; o.x = pk2(v[j].x, v[j].y); o.y = pk2(v[j].z, v[j].w); *((u32x2*)orow + lane + 64 * j) = o; }
}
__device__ __forceinline__ void row_store_f32(float* orow, int lane, const f32x4 (&v)[4]) {
#pragma unroll
    for (int j = 0; j < 4; ++j) *((f32x4*)orow + lane + 64 * j) = v[j];
}
__device__ __forceinline__ void row_combine(f32x4 (&v)[4], const bf16_t* yb, int p0, int p1, float g0, float g1, int lane) {
    const u32x2* r0 = (const u32x2*)(yb + (size_t)p0 * 1024); const u32x2* r1 = (const u32x2*)(yb + (size_t)p1 * 1024);
#pragma unroll
    for (int j = 0; j < 4; ++j) { const u32x2 a = r0[lane + 64 * j], b = r1[lane + 64 * j];
        v[j].x += g0 * bflo(a.x) + g1 * bflo(b.x); v[j].y += g0 * bfhi(a.x) + g1 * bfhi(b.x);
        v[j].z += g0 * bflo(a.y) + g1 * bflo(b.y); v[j].w += g0 * bfhi(a.y) + g1 * bfhi(b.y); }
}
__device__ __forceinline__ void row_logits(const f32x4 (&v)[4], const float* wT, int lane, int NL, LAS float* lg) {
#pragma unroll 1
    for (int o = 0; o < NL; ++o) { float s = 0.f;
#pragma unroll
        for (int j = 0; j < 4; ++j) { const f32x4 w = *((const f32x4*)(wT + o * 1024) + lane + 64 * j); s += (v[j].x * w.x + v[j].y * w.y) + (v[j].z * w.z + v[j].w * w.w); }
        s = wave_sum(s); if (lane == 0) lg[o] = s; }
    LDS_WAIT();
}

__device__ __forceinline__ void norm_plain(const Ctx& c, const float* src, const float* gain, bf16_t* H, int nrows) {
    for (int r0 = c.gw; r0 < nrows; r0 += 4 * c.ngw) {
        f32x4 v[4][4];
#pragma unroll
        for (int q = 0; q < 4; ++q) { const int r = r0 + q * c.ngw; if (r < nrows) row_load(src + (size_t)r * 1024, c.lane, v[q]); }
#pragma unroll
        for (int q = 0; q < 4; ++q) { const int r = r0 + q * c.ngw; if (r < nrows) { const float rs = row_rstd(v[q]); row_scale(v[q], rs, gain, c.lane); row_store_bf16(H + (size_t)r * 1024, c.lane, v[q]); } }
    }
}
__device__ __forceinline__ void route_row(const LAS float* lg, const float* bg, const float* be, int& e0, int& e1, float& g0, float& g1) {
    float gl[4]; int gt = 0; float gm;
#pragma unroll
    for (int i = 0; i < 4; ++i) gl[i] = lg[i] + bg[i];
    gm = gl[0];
#pragma unroll
    for (int i = 1; i < 4; ++i) if (gl[i] > gm) { gm = gl[i]; gt = i; }
    float gs = 0.f;
#pragma unroll
    for (int i = 0; i < 4; ++i) gs += __expf(gl[i] - gm);
    const float pg = 1.0f / gs;
    float el[8];
#pragma unroll
    for (int i = 0; i < 8; ++i) el[i] = lg[4 + 8 * gt + i] + be[8 * gt + i];
    int i0 = 0; float m0 = el[0];
#pragma unroll
    for (int i = 1; i < 8; ++i) if (el[i] > m0) { m0 = el[i]; i0 = i; }
    int i1 = -1; float m1 = -3.0e38f;
#pragma unroll
    for (int i = 0; i < 8; ++i) if (i != i0 && el[i] > m1) { m1 = el[i]; i1 = i; }
    float one = 1.0f; asm volatile("" : "+v"(one));
    const float q1 = __expf(m1 - m0); const float inv = one / (one + q1);
    e0 = gt * 8 + i0; e1 = gt * 8 + i1; g0 = pg * inv; g1 = pg * q1 * inv;
}
constexpr int RW_AS = 64 * 68;
__device__ __forceinline__ void rwkv_naive(const Ctx& c, const Params& p, int bh) {
    const int b = bh >> 3, hd = bh & 7, tid = c.tid, lane = c.lane, wv = c.wave;
    LAS float* L = (LAS float*)c.shm;
    LAS float* aR = L; LAS float* aK = L + RW_AS; LAS float* aV = L + 2 * RW_AS; LAS float* aW = L + 3 * RW_AS; LAS float* aA = L + 4 * RW_AS;
    LAS float* aB = L + 5 * RW_AS; LAS float* aG = L + 6 * RW_AS; LAS float* aY = L + 7 * RW_AS; LAS float* red = L + 8 * RW_AS;
    const bf16_t* P = (const bf16_t*)(p.ws + OFF_P); bf16_t* MIX = (bf16_t*)(p.ws + OFF_H);
    LAS f32x4* SL = (LAS f32x4*)(L + 8 * RW_AS + 1536);
    if (wv == 0) {
#pragma unroll
        for (int j4 = 0; j4 < 16; ++j4) SL[j4 * 64 + lane] = (f32x4){0.f, 0.f, 0.f, 0.f}; }
    const int t = lane, cg = wv;
    const int ch0 = hd * 64 + cg * 8;
    for (int tb = 0; tb < 64; ++tb) {
        const size_t tg0 = (size_t)b * SEQ + (size_t)tb * 64;
#pragma unroll 1
        for (int i = 0; i < 7; ++i) {
            const int task = tid + 512 * i, tt = task / 56, q = task % 56;
            int col; LAS float* dst; int kind = 0;
            if (q < 8) { col = hd * 64 + 8 * q; dst = aR + tt * 68 + 8 * q; }
            else if (q < 16) { col = 512 + hd * 64 + 8 * (q - 8); dst = aK + tt * 68 + 8 * (q - 8); }
            else if (q < 24) { col = 1024 + hd * 64 + 8 * (q - 16); dst = aV + tt * 68 + 8 * (q - 16); }
            else if (q < 32) { col = 1536 + 8 * (q - 24); dst = aW + tt * 68 + 8 * (q - 24); kind = 1; }
            else if (q < 40) { col = 1600 + 8 * (q - 32); dst = aA + tt * 68 + 8 * (q - 32); }
            else if (q < 48) { col = 1664 + 8 * (q - 40); dst = aB + tt * 68 + 8 * (q - 40); kind = 2; }
            else { col = 1664 + 8 * (q - 40); dst = aG + tt * 68 + 8 * (q - 48); kind = 2; }
            const bf16_t* src = P + (tg0 + tt) * EV_IN + 768 + col;
            const u32x4 cur = *(const u32x4*)src;
            u32x4 prv = (u32x4){0u, 0u, 0u, 0u};
            if (tb * 64 + tt > 0) prv = *(const u32x4*)(src - EV_IN);
            const f32x4 m0 = *(const f32x4*)(p.ev_mu + col), m1 = *(const f32x4*)(p.ev_mu + col + 4);
            float v[8];
            const unsigned cw[4] = {cur.x, cur.y, cur.z, cur.w}, pw[4] = {prv.x, prv.y, prv.z, prv.w};
            const float mu[8] = {m0.x, m0.y, m0.z, m0.w, m1.x, m1.y, m1.z, m1.w};
#pragma unroll
            for (int k = 0; k < 4; ++k) { const float c0 = bflo(cw[k]), c1 = bfhi(cw[k]), p0 = bflo(pw[k]), p1 = bfhi(pw[k]);
                v[2 * k] = c0 + (p0 - c0) * mu[2 * k]; v[2 * k + 1] = c1 + (p1 - c1) * mu[2 * k + 1]; }
            if (kind == 1) {
#pragma unroll
                for (int k = 0; k < 8; ++k) v[k] = tanhf(v[k]); }
            if (kind == 2) {
#pragma unroll
                for (int k = 0; k < 8; ++k) v[k] = sigmoidf_(v[k]); }
            *(LAS f32x4*)dst = (f32x4){v[0], v[1], v[2], v[3]}; *(LAS f32x4*)(dst + 4) = (f32x4){v[4], v[5], v[6], v[7]};
        }
        __syncthreads();
        float zw[8], za[8], gg[8];
#pragma unroll
        for (int i = 0; i < 8; ++i) { zw[i] = 0.f; za[i] = 0.f; gg[i] = 0.f; }
#pragma unroll 2
        for (int j4 = 0; j4 < 16; ++j4) {
            const f32x4 xw = *(const LAS f32x4*)(aW + t * 68 + 4 * j4), xa = *(const LAS f32x4*)(aA + t * 68 + 4 * j4);
            const f32x4 g0 = *(const LAS f32x4*)(aB + t * 68 + 4 * j4), g1 = *(const LAS f32x4*)(aG + t * 68 + 4 * j4);
#pragma unroll
            for (int jj = 0; jj < 4; ++jj) { const int j = 4 * j4 + jj;
                const f32x4 w2a = *(const f32x4*)(p.ev_w2 + (size_t)j * 512 + ch0), w2b = *(const f32x4*)(p.ev_w2 + (size_t)j * 512 + ch0 + 4);
                const f32x4 a2a = *(const f32x4*)(p.ev_a2 + (size_t)j * 512 + ch0), a2b = *(const f32x4*)(p.ev_a2 + (size_t)j * 512 + ch0 + 4);
                const f32x4 gla = *(const f32x4*)(p.ev_g2 + (size_t)j * 512 + ch0), glb = *(const f32x4*)(p.ev_g2 + (size_t)j * 512 + ch0 + 4);
                const f32x4 gha = *(const f32x4*)(p.ev_g2 + (size_t)(64 + j) * 512 + ch0), ghb = *(const f32x4*)(p.ev_g2 + (size_t)(64 + j) * 512 + ch0 + 4);
                const float xwv = xw[jj], xav = xa[jj], g0v = g0[jj], g1v = g1[jj];
#pragma unroll
                for (int i = 0; i < 4; ++i) { zw[i] += xwv * w2a[i]; zw[4 + i] += xwv * w2b[i]; za[i] += xav * a2a[i]; za[4 + i] += xav * a2b[i];
                    gg[i] += g0v * gla[i] + g1v * gha[i]; gg[4 + i] += g0v * glb[i] + g1v * ghb[i]; } }
        }
        float av[8], kkv[8]; float ss = 0.f;
        {
            const f32x4 kA = *(const LAS f32x4*)(aK + t * 68 + cg * 8), kB = *(const LAS f32x4*)(aK + t * 68 + cg * 8 + 4);
            const float kv[8] = {kA.x, kA.y, kA.z, kA.w, kB.x, kB.y, kB.z, kB.w};
            float dec[8], kp[8];
#pragma unroll
            for (int i = 0; i < 8; ++i) { const int ch = ch0 + i;
                const float u = -(p.ev_w0[ch] + zw[i]); const float sp = (u > 20.f) ? u : log1pf(__expf(u));
                const float w = -sp - 0.5f; dec[i] = __expf(-__expf(w));
                av[i] = sigmoidf_(p.ev_a0[ch] + za[i]);
                kkv[i] = kv[i] * p.ev_k_k[ch]; ss += kkv[i] * kkv[i];
                kp[i] = kv[i] * (1.0f + (av[i] - 1.0f) * p.ev_k_a[ch]); }
            red[t * 8 + cg] = ss;
            __syncthreads();
            *(LAS f32x4*)(aW + t * 68 + cg * 8) = (f32x4){dec[0], dec[1], dec[2], dec[3]}; *(LAS f32x4*)(aW + t * 68 + cg * 8 + 4) = (f32x4){dec[4], dec[5], dec[6], dec[7]};
            *(LAS f32x4*)(aK + t * 68 + cg * 8) = (f32x4){kp[0], kp[1], kp[2], kp[3]}; *(LAS f32x4*)(aK + t * 68 + cg * 8 + 4) = (f32x4){kp[4], kp[5], kp[6], kp[7]};
            *(LAS f32x4*)(aG + t * 68 + cg * 8) = (f32x4){gg[0], gg[1], gg[2], gg[3]}; *(LAS f32x4*)(aG + t * 68 + cg * 8 + 4) = (f32x4){gg[4], gg[5], gg[6], gg[7]};
            float tot = 0.f;
#pragma unroll
            for (int i = 0; i < 8; ++i) tot += red[t * 8 + i];
            const float inv = 1.0f / fmaxf(sqrtf(tot), 1e-12f);
            float an[8], bn[8];
#pragma unroll
            for (int i = 0; i < 8; ++i) { const float kn = kkv[i] * inv; an[i] = -kn; bn[i] = kn * av[i]; }
            *(LAS f32x4*)(aA + t * 68 + cg * 8) = (f32x4){an[0], an[1], an[2], an[3]}; *(LAS f32x4*)(aA + t * 68 + cg * 8 + 4) = (f32x4){an[4], an[5], an[6], an[7]};
            *(LAS f32x4*)(aB + t * 68 + cg * 8) = (f32x4){bn[0], bn[1], bn[2], bn[3]}; *(LAS f32x4*)(aB + t * 68 + cg * 8 + 4) = (f32x4){bn[4], bn[5], bn[6], bn[7]};
        }
        __syncthreads();
        if (wv == 0) {
            float S[64];
#pragma unroll
            for (int j4 = 0; j4 < 16; ++j4) { const f32x4 s4 = SL[j4 * 64 + lane]; S[4 * j4] = s4.x; S[4 * j4 + 1] = s4.y; S[4 * j4 + 2] = s4.z; S[4 * j4 + 3] = s4.w; }
#pragma unroll 1
            for (int tt = 0; tt < 64; ++tt) {
                const float vv = aV[tt * 68 + lane];
                float sa = 0.f;
#pragma unroll
                for (int j4 = 0; j4 < 16; ++j4) { const f32x4 a4 = *(const LAS f32x4*)(aA + tt * 68 + 4 * j4);
                    sa += S[4 * j4] * a4.x; sa += S[4 * j4 + 1] * a4.y; sa += S[4 * j4 + 2] * a4.z; sa += S[4 * j4 + 3] * a4.w; }
                float y = 0.f;
#pragma unroll
                for (int j4 = 0; j4 < 16; ++j4) {
                    const f32x4 d4 = *(const LAS f32x4*)(aW + tt * 68 + 4 * j4), b4 = *(const LAS f32x4*)(aB + tt * 68 + 4 * j4);
                    const f32x4 k4 = *(const LAS f32x4*)(aK + tt * 68 + 4 * j4), r4 = *(const LAS f32x4*)(aR + tt * 68 + 4 * j4);
#pragma unroll
                    for (int jj = 0; jj < 4; ++jj) { const int j = 4 * j4 + jj; S[j] = S[j] * d4[jj] + sa * b4[jj] + vv * k4[jj]; y += S[j] * r4[jj]; } }
                aY[tt * 68 + lane] = y;
            }
#pragma unroll
            for (int j4 = 0; j4 < 16; ++j4) SL[j4 * 64 + lane] = (f32x4){S[4 * j4], S[4 * j4 + 1], S[4 * j4 + 2], S[4 * j4 + 3]};
        }
        __syncthreads();
        {
            const f32x4 yA = *(const LAS f32x4*)(aY + t * 68 + cg * 8), yB = *(const LAS f32x4*)(aY + t * 68 + cg * 8 + 4);
            const f32x4 rA = *(const LAS f32x4*)(aR + t * 68 + cg * 8), rB = *(const LAS f32x4*)(aR + t * 68 + cg * 8 + 4);
            const f32x4 kA = *(const LAS f32x4*)(aK + t * 68 + cg * 8), kB = *(const LAS f32x4*)(aK + t * 68 + cg * 8 + 4);
            const f32x4 vA = *(const LAS f32x4*)(aV + t * 68 + cg * 8), vB = *(const LAS f32x4*)(aV + t * 68 + cg * 8 + 4);
            const f32x4 gA = *(const LAS f32x4*)(aG + t * 68 + cg * 8), gB = *(const LAS f32x4*)(aG + t * 68 + cg * 8 + 4);
            const float y[8] = {yA.x, yA.y, yA.z, yA.w, yB.x, yB.y, yB.z, yB.w}, r[8] = {rA.x, rA.y, rA.z, rA.w, rB.x, rB.y, rB.z, rB.w};
            const float k[8] = {kA.x, kA.y, kA.z, kA.w, kB.x, kB.y, kB.z, kB.w}, v[8] = {vA.x, vA.y, vA.z, vA.w, vB.x, vB.y, vB.z, vB.w};
            const float g[8] = {gA.x, gA.y, gA.z, gA.w, gB.x, gB.y, gB.z, gB.w};
            float s1 = 0.f, sb = 0.f;
#pragma unroll
            for (int i = 0; i < 8; ++i) { s1 += y[i]; sb += r[i] * k[i] * p.ev_r_k[ch0 + i]; }
            red[t * 8 + cg] = s1; red[512 + t * 8 + cg] = sb;
            __syncthreads();
            float m = 0.f, bon = 0.f;
#pragma unroll
            for (int i = 0; i < 8; ++i) { m += red[t * 8 + i]; bon += red[512 + t * 8 + i]; }
            m *= (1.0f / 64.0f);
            float s2 = 0.f;
#pragma unroll
            for (int i = 0; i < 8; ++i) s2 += (y[i] - m) * (y[i] - m);
            red[1024 + t * 8 + cg] = s2;
            __syncthreads();
            float var = 0.f;
#pragma unroll
            for (int i = 0; i < 8; ++i) var += red[1024 + t * 8 + i];
            const float rs = 1.0f / sqrtf(var * (1.0f / 64.0f) + 64e-5f);
            float o[8];
#pragma unroll
            for (int i = 0; i < 8; ++i) o[i] = ((y[i] - m) * rs * p.ev_lnx_w[ch0 + i] + p.ev_lnx_b[ch0 + i] + bon * v[i]) * g[i];
            u32x4 w; w.x = pk2(o[0], o[1]); w.y = pk2(o[2], o[3]); w.z = pk2(o[4], o[5]); w.w = pk2(o[6], o[7]);
            *(u32x4*)(MIX + (tg0 + t) * 1024 + 512 + ch0) = w;
        }
        __syncthreads();
    }
}

__device__ __forceinline__ void swa_naive(const Ctx& c, const Params& p, int unit) {
    const int b = unit >> 6, g = (unit >> 5) & 1, n = unit & 31, tid = c.tid, lane = c.lane, wv = c.wave;
    LAS bf16_t* Ks = (LAS bf16_t*)c.shm;
    LAS bf16_t* Vs = (LAS bf16_t*)(c.shm + 256 * 144);
    LAS float* qf = (LAS float*)(c.shm + 256 * 144 + 256 * 128) + wv * 320;
    LAS float* pr = qf + 64;
    const bf16_t* P = (const bf16_t*)(p.ws + OFF_P); bf16_t* MIX = (bf16_t*)(p.ws + OFF_H);
    __syncthreads();
#pragma unroll 1
    for (int i = 0; i < 8; ++i) {
        const int task = tid + 512 * i, which = task >> 11, r = (task >> 3) & 255, ck = task & 7;
        const int tk = n * 128 - 128 + r;
        u32x4 d = (u32x4){0u, 0u, 0u, 0u};
        if (tk >= 0) d = *(const u32x4*)(P + ((size_t)b * SEQ + tk) * EV_IN + 512 + which * 128 + g * 64 + ck * 8);
        if (which == 0) *(LAS u32x4*)(Ks + r * 72 + ck * 8) = d; else *(LAS u32x4*)(Vs + r * 64 + ck * 8) = d;
    }
    __syncthreads();
    const int head = g * 4 + (wv >> 1);
    const float sink = p.ev_sinks[head];
#pragma unroll 1
    for (int qq = 0; qq < 64; ++qq) {
        const int qi = (wv & 1) * 64 + qq;
        const size_t tq = (size_t)b * SEQ + n * 128 + qi;
        qf[lane] = bf2f(P[tq * EV_IN + head * 64 + lane]) * 0.125f;
        LDS_WAIT();
        float s[4];
#pragma unroll
        for (int j = 0; j < 4; ++j) { const int kp = lane + 64 * j; float a = 0.f;
#pragma unroll
            for (int ck = 0; ck < 8; ++ck) { const u32x4 kk = *(const LAS u32x4*)(Ks + kp * 72 + ck * 8);
                const f32x4 q0 = *(const LAS f32x4*)(qf + ck * 8), q1 = *(const LAS f32x4*)(qf + ck * 8 + 4);
                a += bflo(kk.x) * q0.x + bfhi(kk.x) * q0.y + bflo(kk.y) * q0.z + bfhi(kk.y) * q0.w + bflo(kk.z) * q1.x + bfhi(kk.z) * q1.y + bflo(kk.w) * q1.z + bfhi(kk.w) * q1.w; }
            const bool valid = (kp >= qi + 1) && (kp <= qi + 128) && (n > 0 || kp >= 128);
            s[j] = valid ? a : -INFINITY; }
        float m = fmaxf(fmaxf(s[0], s[1]), fmaxf(s[2], s[3])); m = fmaxf(wave_max(m), sink);
        float den = 0.f;
#pragma unroll
        for (int j = 0; j < 4; ++j) { const float e = __expf(s[j] - m); pr[lane + 64 * j] = e; den += e; }
        den = wave_sum(den) + __expf(sink - m);
        LDS_WAIT();
        float o = 0.f;
#pragma unroll 8
        for (int kp = qi + 1; kp <= qi + 128; ++kp) o += pr[kp] * bf2f(Vs[kp * 64 + lane]);
        MIX[tq * 1024 + head * 64 + lane] = (bf16_t)f2bf(o / den);
    }
}
__device__ __forceinline__ void gla_naive(const Ctx& c, const Params& p, int bh) {
    const int b = bh >> 2, hd = bh & 3, tid = c.tid, lane = c.lane, wv = c.wave;
    LAS float* qs = (LAS float*)c.shm; LAS float* ks = qs + 32 * 128; LAS float* es = ks + 32 * 128; LAS float* vs = es + 32 * 128; LAS float* os = vs + 32 * 256;
    const bf16_t* P = (const bf16_t*)(p.ws + OFF_P); const float* GK = (const float*)(p.ws + OFF_R); bf16_t* MIX = (bf16_t*)(p.ws + OFF_H);
    float S[128];
#pragma unroll
    for (int j = 0; j < 128; ++j) S[j] = 0.f;
    for (int tb = 0; tb < 128; ++tb) {
        const size_t tg0 = (size_t)b * SEQ + (size_t)tb * 32;
#pragma unroll 1
        for (int i = 0; i < 8; ++i) { const int idx = tid + 512 * i, tt = idx >> 7, j = idx & 127;
            const bf16_t* row = P + (tg0 + tt) * OD_IN;
            qs[idx] = bf2f(row[hd * 128 + j]) * 0.08838834764831845f; ks[idx] = bf2f(row[512 + hd * 128 + j]); es[idx] = __expf(GK[(tg0 + tt) * 512 + hd * 128 + j]); }
#pragma unroll 1
        for (int i = 0; i < 16; ++i) { const int idx = tid + 512 * i, tt = idx >> 8, j = idx & 255; vs[idx] = bf2f(P[(tg0 + tt) * OD_IN + 1024 + hd * 256 + j]); }
        __syncthreads();
        if (wv < 4) {
#pragma unroll 1
            for (int tt = 0; tt < 32; ++tt) {
                const float vv = vs[tt * 256 + tid]; float o = 0.f;
#pragma unroll
                for (int j4 = 0; j4 < 32; ++j4) {
                    const f32x4 e4 = *(const LAS f32x4*)(es + tt * 128 + 4 * j4), k4 = *(const LAS f32x4*)(ks + tt * 128 + 4 * j4), q4 = *(const LAS f32x4*)(qs + tt * 128 + 4 * j4);
#pragma unroll
                    for (int jj = 0; jj < 4; ++jj) { const int j = 4 * j4 + jj; S[j] = S[j] * e4[jj] + k4[jj] * vv; o += q4[jj] * S[j]; } }
                os[tt * 256 + tid] = o;
            }
        }
        __syncthreads();
#pragma unroll 1
        for (int i = 0; i < 4; ++i) { const int tt = wv + 8 * i;
            const f32x4 o4 = *(const LAS f32x4*)(os + tt * 256 + 4 * lane);
            const float ss = wave_sum(o4.x * o4.x + o4.y * o4.y + o4.z * o4.z + o4.w * o4.w);
            const float rs = 1.0f / sqrtf(ss * (1.0f / 256.0f) + 1e-6f);
            const f32x4 gn = *(const f32x4*)(p.od_onorm + 4 * lane);
            const u32x2 og = *(const u32x2*)(P + (tg0 + tt) * OD_IN + 2048 + hd * 256 + 4 * lane);
            const float g0 = bflo(og.x), g1 = bfhi(og.x), g2 = bflo(og.y), g3 = bfhi(og.y);
            u32x2 w; w.x = pk2(o4.x * rs * gn.x * g0 * sigmoidf_(g0), o4.y * rs * gn.y * g1 * sigmoidf_(g1)); w.y = pk2(o4.z * rs * gn.z * g2 * sigmoidf_(g2), o4.w * rs * gn.w * g3 * sigmoidf_(g3));
            *(u32x2*)(MIX + (tg0 + tt) * 1024 + hd * 256 + 4 * lane) = w; }
        __syncthreads();
    }
}

__device__ __forceinline__ void xattn_naive(const Ctx& c, const Params& p, int unit) {
    const int b = unit >> 5, hh = (unit >> 3) & 3, tblk = unit & 7, tid = c.tid, lane = c.lane, wv = c.wave;
    LAS bf16_t* Ks = (LAS bf16_t*)c.shm;
    LAS bf16_t* Vs = (LAS bf16_t*)(c.shm + 256 * 272);
    LAS float* qf = (LAS float*)(c.shm + 256 * 272 + 256 * 256) + wv * 384;
    LAS float* pr = qf + 128;
    const bf16_t* MKV = (const bf16_t*)(p.ws + OFF_MKV); const bf16_t* Q = (const bf16_t*)(p.ws + OFF_P); bf16_t* OA = (bf16_t*)(p.ws + OFF_P + 32 * MiB);
    __syncthreads();
#pragma unroll 1
    for (int i = 0; i < 16; ++i) {
        const int task = tid + 512 * i, which = task >> 12, r = (task >> 4) & 255, ck = task & 15;
        const u32x4 d = *(const u32x4*)(MKV + ((size_t)b * MEMLEN + r) * 1024 + which * 512 + hh * 128 + ck * 8);
        if (which == 0) *(LAS u32x4*)(Ks + r * 136 + ck * 8) = d; else *(LAS u32x4*)(Vs + r * 128 + ck * 8) = d;
    }
    __syncthreads();
#pragma unroll 1
    for (int qq = 0; qq < 64; ++qq) {
        const size_t tq = (size_t)b * SEQ + tblk * 512 + wv * 64 + qq;
        qf[lane] = bf2f(Q[tq * 512 + hh * 128 + lane]) * 0.08838834764831845f; qf[lane + 64] = bf2f(Q[tq * 512 + hh * 128 + 64 + lane]) * 0.08838834764831845f;
        LDS_WAIT();
        float s[4];
#pragma unroll
        for (int j = 0; j < 4; ++j) { const int kp = lane + 64 * j; float a = 0.f;
#pragma unroll
            for (int ck = 0; ck < 16; ++ck) { const u32x4 kk = *(const LAS u32x4*)(Ks + kp * 136 + ck * 8);
                const f32x4 q0 = *(const LAS f32x4*)(qf + ck * 8), q1 = *(const LAS f32x4*)(qf + ck * 8 + 4);
                a += bflo(kk.x) * q0.x + bfhi(kk.x) * q0.y + bflo(kk.y) * q0.z + bfhi(kk.y) * q0.w + bflo(kk.z) * q1.x + bfhi(kk.z) * q1.y + bflo(kk.w) * q1.z + bfhi(kk.w) * q1.w; }
            s[j] = a; }
        const float m = wave_max(fmaxf(fmaxf(s[0], s[1]), fmaxf(s[2], s[3])));
        float den = 0.f;
#pragma unroll
        for (int j = 0; j < 4; ++j) { const float e = __expf(s[j] - m); pr[lane + 64 * j] = e; den += e; }
        den = wave_sum(den);
        LDS_WAIT();
        float o0 = 0.f, o1 = 0.f;
#pragma unroll 4
        for (int k4 = 0; k4 < 64; ++k4) { const f32x4 p4 = *(const LAS f32x4*)(pr + 4 * k4);
#pragma unroll
            for (int kk = 0; kk < 4; ++kk) { const unsigned vv = *(const LAS unsigned*)(Vs + (4 * k4 + kk) * 128 + 2 * lane); o0 += p4[kk] * bflo(vv); o1 += p4[kk] * bfhi(vv); } }
        const float inv = 1.0f / den;
        *(unsigned*)(OA + tq * 512 + hh * 128 + 2 * lane) = pk2(o0 * inv, o1 * inv);
    }
}

__device__ __forceinline__ void moe_slots(const Ctx& c, const Params& p, int layer) {
    LAS int* sh = (LAS int*)c.shm;
    const int* cnt = (const int*)(p.ws + OFF_CTL + CTL_CNT) + layer * 32; int* cur = (int*)(p.ws + OFF_CTL + CTL_CUR) + layer * 32;
    int* blk = (int*)(p.ws + OFF_CTL + CTL_BLK) + layer * 1024;
    __syncthreads();
    if (c.tid == 0) { int acc = 0; for (int e = 0; e < NEXP; ++e) { sh[e] = acc; acc += (cnt[e] + 255) / 256 * 256; } sh[32] = acc; }
    __syncthreads();
    if (blockIdx.x == 0 && c.tid < NEXP) { const int e = c.tid, s = sh[e] / 256, en = (e == NEXP - 1 ? sh[32] : sh[e + 1]) / 256; for (int i = s; i < en; ++i) blk[1 + i] = e; if (e == 0) blk[0] = sh[32] / 256; }
    const int2* RE = (const int2*)(p.ws + OFF_ROUTE); int2* RP = (int2*)(p.ws + OFF_ROUTE + 512 * 1024);
    const bf16_t* H = (const bf16_t*)(p.ws + OFF_H); bf16_t* XB = (bf16_t*)(p.ws + OFF_P);
    for (int ck = c.gw; ck < T_TOK / 64; ck += c.ngw) {
        const int t = ck * 64 + c.lane; const int2 ee = RE[t]; int pos0 = 0, pos1 = 0;
#pragma unroll 1
        for (int e = 0; e < NEXP; ++e) {
            const unsigned long long m0 = __ballot(ee.x == e), m1 = __ballot(ee.y == e);
            const int n0 = __popcll(m0), n1 = __popcll(m1);
            if (n0 + n1 == 0) continue;
            int base = 0; if (c.lane == 0) base = atomicAdd(&cur[e], n0 + n1);
            base = __shfl(base, 0) + sh[e];
            const unsigned long long lt = (1ull << c.lane) - 1ull;
            if (ee.x == e) pos0 = base + __popcll(m0 & lt);
            if (ee.y == e) pos1 = base + n0 + __popcll(m1 & lt);
        }
        RP[t] = make_int2(pos0, pos1);
#pragma unroll 1
        for (int i = 0; i < 64; ++i) { const int ti = ck * 64 + i, q0 = __shfl(pos0, i), q1 = __shfl(pos1, i);
            const u32x4 a = *((const u32x4*)(H + (size_t)ti * 1024) + c.lane), bq = *((const u32x4*)(H + (size_t)ti * 1024) + 64 + c.lane);
            *((u32x4*)(XB + (size_t)q0 * 1024) + c.lane) = a; *((u32x4*)(XB + (size_t)q0 * 1024) + 64 + c.lane) = bq;
            *((u32x4*)(XB + (size_t)q1 * 1024) + c.lane) = a; *((u32x4*)(XB + (size_t)q1 * 1024) + 64 + c.lane) = bq; }
    }
}
typedef short bf16x8_t __attribute__((ext_vector_type(8)));
constexpr size_t R_GK = 0, R_QT = 64 * MiB, R_ATT = 96 * MiB, R_KHT = 112 * MiB, R_GDEC = 144 * MiB;
template <int CTRL, int RMASK> __device__ __forceinline__ float dpp_get0(float x) {
    return __builtin_bit_cast(float, __builtin_amdgcn_update_dpp(0, __builtin_bit_cast(int, x), CTRL, RMASK, 0xF, false)); }
__device__ __forceinline__ float wave_scan_incl(float x, int lane) {
    (void)lane;
    x += dpp_get0<0x111, 0xF>(x); x += dpp_get0<0x112, 0xF>(x); x += dpp_get0<0x114, 0xF>(x); x += dpp_get0<0x118, 0xF>(x);
    x += dpp_get0<0x142, 0xA>(x); x += dpp_get0<0x143, 0xC>(x);
    return x;
}
__device__ __forceinline__ float lane63(float x) { return __builtin_bit_cast(float, __builtin_amdgcn_readlane(__builtin_bit_cast(int, x), 63)); }
__device__ __forceinline__ int key_perm(int key) { const int kq = key & 31; return (key & ~31) + 8 * ((kq >> 2) & 3) + 4 * ((kq >> 4) & 1) + (kq & 3); }
__device__ __forceinline__ bf16x8_t zero_frag() { return (bf16x8_t){0, 0, 0, 0, 0, 0, 0, 0}; }
__device__ __forceinline__ bf16x8_t lds_frag(const LAS bf16_t* img, int pitch, int row, int col) { return *(const LAS bf16x8_t*)(img + row * pitch + col); }
__device__ __forceinline__ bf16x8_t pack8(const float (&v)[8]) {
    u32x4 w; w.x = pk2(v[0], v[1]); w.y = pk2(v[2], v[3]); w.z = pk2(v[4], v[5]); w.w = pk2(v[6], v[7]);
    return __builtin_bit_cast(bf16x8_t, w);
}
__device__ __forceinline__ void gla_prep(const Ctx& c, const Params& p, int unit) {
    const int bh = unit >> 6, ck = unit & 63, b = bh >> 2, hd = bh & 3, lane = c.lane, wv = c.wave;
    LAS bf16_t* Qs = (LAS bf16_t*)c.shm;
    LAS bf16_t* Ks = Qs + 64 * 136;
    const bf16_t* P = (const bf16_t*)(p.ws + OFF_P); unsigned char* R = p.ws + OFF_R;
    const float* GK = (const float*)(R + R_GK); bf16_t* QT = (bf16_t*)(R + R_QT) + (size_t)unit * 64 * 128; bf16_t* ATT = (bf16_t*)(R + R_ATT) + (size_t)unit * 64 * 64;
    bf16_t* KHT = (bf16_t*)(R + R_KHT) + (size_t)unit * 128 * 64; float* GDEC = (float*)(R + R_GDEC) + (size_t)unit * 128;
    const size_t tg = (size_t)b * SEQ + ck * 64 + lane; const int d0 = wv * 16;
    __syncthreads();
    {
        const bf16_t* row = P + tg * OD_IN;
        const u32x4 qa = *(const u32x4*)(row + hd * 128 + d0), qb = *(const u32x4*)(row + hd * 128 + d0 + 8);
        const u32x4 ka = *(const u32x4*)(row + 512 + hd * 128 + d0), kb = *(const u32x4*)(row + 512 + hd * 128 + d0 + 8);
        const unsigned qw[8] = {qa.x, qa.y, qa.z, qa.w, qb.x, qb.y, qb.z, qb.w}, kw[8] = {ka.x, ka.y, ka.z, ka.w, kb.x, kb.y, kb.z, kb.w};
        float qt[16], kt[16], kh[16];
#pragma unroll
        for (int i4 = 0; i4 < 4; ++i4) { const f32x4 g4 = *(const f32x4*)(GK + tg * 512 + hd * 128 + d0 + 4 * i4);
#pragma unroll
            for (int ii = 0; ii < 4; ++ii) { const int i = 4 * i4 + ii;
                const float bb = wave_scan_incl(g4[ii], lane); const float bl = lane63(bb);
                const float qv = (i & 1) ? bfhi(qw[i >> 1]) : bflo(qw[i >> 1]), kv = (i & 1) ? bfhi(kw[i >> 1]) : bflo(kw[i >> 1]);
                qt[i] = qv * 0.08838834764831845f * __expf(bb); kt[i] = kv * __expf(-bb); kh[i] = kv * __expf(bl - bb);
                if (lane == 63) GDEC[d0 + i] = __expf(bl); } }
        { u32x4 w0, w1; w0.x = pk2(qt[0], qt[1]); w0.y = pk2(qt[2], qt[3]); w0.z = pk2(qt[4], qt[5]); w0.w = pk2(qt[6], qt[7]); w1.x = pk2(qt[8], qt[9]); w1.y = pk2(qt[10], qt[11]); w1.z = pk2(qt[12], qt[13]); w1.w = pk2(qt[14], qt[15]);
          *(LAS u32x4*)(Qs + lane * 136 + d0) = w0; *(LAS u32x4*)(Qs + lane * 136 + d0 + 8) = w1; }
        { u32x4 w0, w1; w0.x = pk2(kt[0], kt[1]); w0.y = pk2(kt[2], kt[3]); w0.z = pk2(kt[4], kt[5]); w0.w = pk2(kt[6], kt[7]); w1.x = pk2(kt[8], kt[9]); w1.y = pk2(kt[10], kt[11]); w1.z = pk2(kt[12], kt[13]); w1.w = pk2(kt[14], kt[15]);
          *(LAS u32x4*)(Ks + lane * 136 + d0) = w0; *(LAS u32x4*)(Ks + lane * 136 + d0 + 8) = w1; }
        { const int sg = d0 >> 5, hb = (d0 >> 4) & 1;
#pragma unroll
          for (int x4 = 0; x4 < 4; ++x4) { u32x2 w; w.x = pk2(qt[4 * x4], qt[4 * x4 + 1]); w.y = pk2(qt[4 * x4 + 2], qt[4 * x4 + 3]);
              *(u32x2*)(QT + lane * 128 + 32 * sg + 8 * x4 + 4 * hb) = w; } }
        { const int sc = key_perm(lane);
#pragma unroll
          for (int i = 0; i < 16; ++i) KHT[(d0 + i) * 64 + sc] = (bf16_t)f2bf(kh[i]); }
    }
    __syncthreads();
    const int fr = lane & 15, fq = lane >> 4;
#pragma unroll
    for (int h2 = 0; h2 < 2; ++h2) { const int tile = 2 * wv + h2, si = tile >> 2, ti = tile & 3;
        f32x4 acc = (f32x4){0.f, 0.f, 0.f, 0.f};
        if (si <= ti) {
#pragma unroll
            for (int kk = 0; kk < 4; ++kk) { const bf16x8_t a = *(const LAS bf16x8_t*)(Ks + (16 * si + fr) * 136 + 32 * kk + 8 * fq), bq = *(const LAS bf16x8_t*)(Qs + (16 * ti + fr) * 136 + 32 * kk + 8 * fq);
                acc = __builtin_amdgcn_mfma_f32_16x16x32_bf16(a, bq, acc, 0, 0, 0); } }
        const int t = 16 * ti + fr, s0 = 16 * si + 4 * fq;
        u32x2 w; w.x = pk2(s0 <= t ? acc[0] : 0.f, s0 + 1 <= t ? acc[1] : 0.f); w.y = pk2(s0 + 2 <= t ? acc[2] : 0.f, s0 + 3 <= t ? acc[3] : 0.f);
        *(u32x2*)(ATT + t * 64 + 32 * (si >> 1) + 8 * fq + 4 * (si & 1)) = w; }
}
constexpr int GB_QT = 0, GB_ATT = 64 * 136 * 2, GB_KHT = GB_ATT + 64 * 72 * 2, GB_GD = GB_KHT + 128 * 72 * 2, GB_V = GB_GD + 512, GB_BYTES = GB_V + 64 * 72 * 2;
struct GlaFill { u32x4 r[25]; };
__device__ __forceinline__ void gla_fill_load(GlaFill& f, const Params& p, int unit, int ptid, const bf16_t* vsrc) {
    const unsigned char* R = p.ws + OFF_R;
    const bf16_t* QT = (const bf16_t*)(R + R_QT) + (size_t)unit * 64 * 128; const bf16_t* ATT = (const bf16_t*)(R + R_ATT) + (size_t)unit * 64 * 64;
    const bf16_t* KHT = (const bf16_t*)(R + R_KHT) + (size_t)unit * 128 * 64; const float* GDEC = (const float*)(R + R_GDEC) + (size_t)unit * 128;
#pragma unroll
    for (int i = 0; i < 8; ++i) f.r[i] = *((const u32x4*)QT + ptid + 128 * i);
#pragma unroll
    for (int i = 0; i < 4; ++i) f.r[8 + i] = *((const u32x4*)ATT + ptid + 128 * i);
#pragma unroll
    for (int i = 0; i < 8; ++i) f.r[12 + i] = *((const u32x4*)KHT + ptid + 128 * i);
    f.r[20] = (u32x4){0u, 0u, 0u, 0u}; if (ptid < 32) f.r[20] = *((const u32x4*)GDEC + ptid);
#pragma unroll
    for (int i = 0; i < 4; ++i) { const int idx = ptid + 128 * i; f.r[21 + i] = *(const u32x4*)(vsrc + (size_t)(idx >> 3) * OD_IN + (idx & 7) * 8); }
}
__device__ __forceinline__ void gla_fill_store(const GlaFill& f, unsigned char* buf, int ptid) {
#pragma unroll
    for (int i = 0; i < 8; ++i) { const int idx = ptid + 128 * i; *(LAS u32x4*)(buf + GB_QT + (idx >> 4) * 272 + (idx & 15) * 16) = f.r[i]; }
#pragma unroll
    for (int i = 0; i < 4; ++i) { const int idx = ptid + 128 * i; *(LAS u32x4*)(buf + GB_ATT + (idx >> 3) * 144 + (idx & 7) * 16) = f.r[8 + i]; }
#pragma unroll
    for (int i = 0; i < 8; ++i) { const int idx = ptid + 128 * i; *(LAS u32x4*)(buf + GB_KHT + (idx >> 3) * 144 + (idx & 7) * 16) = f.r[12 + i]; }
    if (ptid < 32) *(LAS u32x4*)(buf + GB_GD + ptid * 16) = f.r[20];
#pragma unroll
    for (int i = 0; i < 4; ++i) { const int idx = ptid + 128 * i; *(LAS u32x4*)(buf + GB_V + (idx >> 3) * 144 + (idx & 7) * 16) = f.r[21 + i]; }
}
#define GLA_STEP_BARRIER() do { asm volatile("s_waitcnt lgkmcnt(0)" ::: "memory"); __builtin_amdgcn_s_barrier(); asm volatile("" ::: "memory"); } while (0)
__device__ __forceinline__ void gla_state(const Ctx& c, const Params& p, int bh, int slice) {
    const int b = bh >> 2, hd = bh & 3, lane = c.lane, wv = c.wave, fr = lane & 15, fq = lane >> 4, jl = wv & 3, jt = slice * 4 + jl;
    const bf16_t* P = (const bf16_t*)(p.ws + OFF_P); bf16_t* O = (bf16_t*)p.out;
    unsigned char* sm = c.shm;
    const size_t tb = (size_t)b * SEQ; const bf16_t* vbase = P + tb * OD_IN + 1024 + hd * 256 + 64 * slice;
    __syncthreads();
    if (wv >= 4) {
        const int pg = (wv - 4) >> 1, ptid = c.tid & 127;
        GlaFill fs;
        if (pg == 1) { gla_fill_load(fs, p, bh * 64, ptid, vbase); gla_fill_store(fs, sm, ptid); gla_fill_load(fs, p, bh * 64 + 2, ptid, vbase + (size_t)128 * OD_IN); } else gla_fill_load(fs, p, bh * 64 + 1, ptid, vbase + (size_t)64 * OD_IN);
        GLA_STEP_BARRIER();
#pragma unroll 1
        for (int ck = 0; ck < 64; ++ck) {
            if (((ck + 1) & 1) != pg && ck + 1 < 64) { gla_fill_store(fs, sm + ((ck + 1) & 1) * GB_BYTES, ptid); if (ck + 3 < 64) gla_fill_load(fs, p, bh * 64 + ck + 3, ptid, vbase + (size_t)(ck + 3) * 64 * OD_IN); }
            GLA_STEP_BARRIER();
        }
    } else if (wv < 2) {
        f32x4 S[2][8];
#pragma unroll
        for (int h = 0; h < 2; ++h)
#pragma unroll
            for (int i = 0; i < 8; ++i) S[h][i] = (f32x4){0.f, 0.f, 0.f, 0.f};
        bf16x8_t idf;
        { float iv[8];
#pragma unroll
          for (int e = 0; e < 8; ++e) iv[e] = (8 * fq + e == fr) ? 1.0f : 0.0f;
          idf = pack8(iv); }
        const int jt0 = slice * 4 + 2 * wv;
        GLA_STEP_BARRIER();
#pragma unroll 1
        for (int ck = 0; ck < 64; ++ck) {
            unsigned char* buf = sm + (ck & 1) * GB_BYTES; const size_t t0 = tb + ck * 64;
            const LAS bf16_t* QT = (const LAS bf16_t*)(buf + GB_QT); const LAS bf16_t* ATT = (const LAS bf16_t*)(buf + GB_ATT); const LAS bf16_t* KHT = (const LAS bf16_t*)(buf + GB_KHT); const LAS float* GD = (const LAS float*)(buf + GB_GD);
            const LAS bf16_t* VS = (const LAS bf16_t*)(buf + GB_V);
            bf16x8_t va[2][4], qf[4][4], af[2][4];
#pragma unroll
            for (int h = 0; h < 2; ++h)
#pragma unroll
                for (int st = 0; st < 4; ++st) { va[h][st] = zero_frag(); if (fq < 2) va[h][st] = lds_frag(VS, 72, 16 * st + fr, 32 * wv + 16 * h + 8 * fq); }
#pragma unroll
            for (int sg = 0; sg < 4; ++sg)
#pragma unroll
                for (int ti = 0; ti < 4; ++ti) qf[sg][ti] = lds_frag(QT, 136, 16 * ti + fr, 32 * sg + 8 * fq);
#pragma unroll
            for (int s2 = 0; s2 < 2; ++s2)
#pragma unroll
                for (int ti = 0; ti < 4; ++ti) af[s2][ti] = lds_frag(ATT, 72, 16 * ti + fr, 32 * s2 + 8 * fq);
            asm volatile("s_waitcnt lgkmcnt(0)" ::: "memory");
            bf16x8_t vf[2][2];
#pragma unroll
            for (int h = 0; h < 2; ++h) { f32x4 vt[4];
#pragma unroll
                for (int st = 0; st < 4; ++st) vt[st] = __builtin_amdgcn_mfma_f32_16x16x32_bf16(va[h][st], idf, (f32x4){0.f, 0.f, 0.f, 0.f}, 0, 0, 0);
#pragma unroll
                for (int s2 = 0; s2 < 2; ++s2) { const float vv[8] = {vt[2 * s2][0], vt[2 * s2][1], vt[2 * s2][2], vt[2 * s2][3], vt[2 * s2 + 1][0], vt[2 * s2 + 1][1], vt[2 * s2 + 1][2], vt[2 * s2 + 1][3]}; vf[h][s2] = pack8(vv); } }
            f32x4 acc[2][4];
#pragma unroll
            for (int h = 0; h < 2; ++h)
#pragma unroll
                for (int ti = 0; ti < 4; ++ti) acc[h][ti] = (f32x4){0.f, 0.f, 0.f, 0.f};
#pragma unroll
            for (int sg = 0; sg < 4; ++sg)
#pragma unroll
                for (int h = 0; h < 2; ++h) { const float sv[8] = {S[h][2 * sg][0], S[h][2 * sg][1], S[h][2 * sg][2], S[h][2 * sg][3], S[h][2 * sg + 1][0], S[h][2 * sg + 1][1], S[h][2 * sg + 1][2], S[h][2 * sg + 1][3]};
                    const bf16x8_t a = pack8(sv);
#pragma unroll
                    for (int ti = 0; ti < 4; ++ti) acc[h][ti] = __builtin_amdgcn_mfma_f32_16x16x32_bf16(a, qf[sg][ti], acc[h][ti], 0, 0, 0); }
#pragma unroll
            for (int s2 = 0; s2 < 2; ++s2)
#pragma unroll
                for (int h = 0; h < 2; ++h)
#pragma unroll
                    for (int ti = 0; ti < 4; ++ti) acc[h][ti] = __builtin_amdgcn_mfma_f32_16x16x32_bf16(vf[h][s2], af[s2][ti], acc[h][ti], 0, 0, 0);
#pragma unroll
            for (int h = 0; h < 2; ++h)
#pragma unroll
                for (int ti = 0; ti < 4; ++ti) { u32x2 w; w.x = pk2(acc[h][ti][0], acc[h][ti][1]); w.y = pk2(acc[h][ti][2], acc[h][ti][3]);
                    *(u32x2*)(O + (t0 + 16 * ti + fr) * 1024 + hd * 256 + 16 * (jt0 + h) + 4 * fq) = w; }
#pragma unroll
            for (int rt = 0; rt < 8; ++rt) { const f32x4 g4 = *(const LAS f32x4*)(GD + 16 * rt + 4 * fq);
                const bf16x8_t k0 = lds_frag(KHT, 72, 16 * rt + fr, 8 * fq), k1 = lds_frag(KHT, 72, 16 * rt + fr, 32 + 8 * fq);
#pragma unroll
                for (int h = 0; h < 2; ++h) { f32x4 s = S[h][rt] * g4; s = __builtin_amdgcn_mfma_f32_16x16x32_bf16(k0, vf[h][0], s, 0, 0, 0); s = __builtin_amdgcn_mfma_f32_16x16x32_bf16(k1, vf[h][1], s, 0, 0, 0); S[h][rt] = s; } }
            GLA_STEP_BARRIER();
        }
    } else {
        GLA_STEP_BARRIER();
#pragma unroll 1
        for (int ck = 0; ck < 64; ++ck) GLA_STEP_BARRIER();
    }
}
__device__ __forceinline__ void gla_finish(const Ctx& c, const Params& p) {
    const bf16_t* P = (const bf16_t*)(p.ws + OFF_P); bf16_t* O = (bf16_t*)p.out;
    const f32x4 gn = *((const f32x4*)p.od_onorm + c.lane);
    for (int r0 = c.gw; r0 < T_TOK; r0 += 2 * c.ngw) {
        u32x2 ow[2][4], gw[2][4];
#pragma unroll
        for (int q = 0; q < 2; ++q)
#pragma unroll
            for (int j = 0; j < 4; ++j) { const size_t r = (size_t)(r0 + q * c.ngw); ow[q][j] = *((const u32x2*)(O + r * 1024 + 256 * j) + c.lane); gw[q][j] = *((const u32x2*)(P + r * OD_IN + 2048 + 256 * j) + c.lane); }
#pragma unroll
        for (int q = 0; q < 2; ++q)
#pragma unroll
            for (int j = 0; j < 4; ++j) { const size_t r = (size_t)(r0 + q * c.ngw);
                const float o0 = bflo(ow[q][j].x), o1 = bfhi(ow[q][j].x), o2 = bflo(ow[q][j].y), o3 = bfhi(ow[q][j].y);
                const float ss = wave_sum(o0 * o0 + o1 * o1 + o2 * o2 + o3 * o3); const float rs = 1.0f / sqrtf(ss * (1.0f / 256.0f) + 1e-6f);
                const float g0 = bflo(gw[q][j].x), g1 = bfhi(gw[q][j].x), g2 = bflo(gw[q][j].y), g3 = bfhi(gw[q][j].y);
                u32x2 w; w.x = pk2(o0 * rs * gn.x * g0 * sigmoidf_(g0), o1 * rs * gn.y * g1 * sigmoidf_(g1)); w.y = pk2(o2 * rs * gn.z * g2 * sigmoidf_(g2), o3 * rs * gn.w * g3 * sigmoidf_(g3));
                *((u32x2*)(O + r * 1024 + 256 * j) + c.lane) = w; }
    }
}
constexpr size_t R_MG = 0, R_NT = 32 * MiB, R_QG = 64 * MiB, R_Y0 = 96 * MiB, R_Z0 = 128 * MiB, R_GAM = 160 * MiB, R_BON = 161 * MiB, R_MEMN = 164 * MiB;
constexpr size_t WSM_W2T = 0, WSM_A2T = 64 * 1024;
constexpr size_t WSM_G2T = 512 * 1024;
constexpr int XI = 64 * 72 * 2;
constexpr int X_RHS = 11 * XI, X_DIAG = X_RHS + 34816, X_TI = X_DIAG + 4352, X_RED = X_TI + 3072;

struct RxPre { u32x4 c1[2], p1[2], cr[3], pr[3]; };
__device__ __forceinline__ void rwkv_x_fetch(RxPre& f, const bf16_t* P, int b, int hd, int ck, int tid, int lane, int wv) {
    const size_t tg0 = (size_t)b * SEQ + (size_t)ck * 64; const u32x4 z = (u32x4){0u, 0u, 0u, 0u};
#pragma unroll
    for (int i = 0; i < 2; ++i) { const int task = tid + 512 * i, tt = task >> 4, q = task & 15; const bf16_t* src = P + (tg0 + tt) * EV_IN + 768 + 1536 + 8 * q;
        f.c1[i] = *(const u32x4*)src; f.p1[i] = z; if (ck * 64 + tt > 0) f.p1[i] = *(const u32x4*)(src - EV_IN); }
    const bf16_t* src = P + (tg0 + lane) * EV_IN + 768 + hd * 64 + wv * 8; const bool hp = (ck * 64 + lane > 0);
#pragma unroll
    for (int w3 = 0; w3 < 3; ++w3) { f.cr[w3] = *(const u32x4*)(src + 512 * w3); f.pr[w3] = z; if (hp) f.pr[w3] = *(const u32x4*)(src + 512 * w3 - EV_IN); }
}
struct RxW { bf16x8_t wt[4][2]; };
__device__ __forceinline__ void rwkv_x_weights(RxW& k, const Params& p, int hd, int lane, int wv) {
    const int fr = lane & 15, fq = lane >> 4, mat = wv >> 2; const bf16_t* WT = (const bf16_t*)(p.ws + OFF_WSMALL + (mat ? WSM_A2T : WSM_W2T));
#pragma unroll
    for (int n = 0; n < 4; ++n) { const int tile = (wv & 3) * 4 + n, ct = tile >> 2;
#pragma unroll
        for (int kk = 0; kk < 2; ++kk) k.wt[n][kk] = *(const bf16x8_t*)(WT + (size_t)(hd * 64 + 16 * ct + fr) * 64 + 32 * kk + 8 * fq); }
}
__device__ __forceinline__ void rwkv_x(const Ctx& c, const Params& p, int unit, RxPre& pre, const RxW& kw, int nb, int nhd, int nck) {
    const int bh = unit >> 6, ck = unit & 63, b = bh >> 3, hd = bh & 7, tid = c.tid, lane = c.lane, wv = c.wave, fr = lane & 15, fq = lane >> 4;
    unsigned char* sm = c.shm;
    LAS bf16_t* At = (LAS bf16_t*)sm; LAS bf16_t* Bt = (LAS bf16_t*)(sm + XI); LAS bf16_t* Kt = (LAS bf16_t*)(sm + 2 * XI); LAS bf16_t* Rt = (LAS bf16_t*)(sm + 3 * XI);
    LAS bf16_t* BH = (LAS bf16_t*)(sm + 4 * XI); LAS bf16_t* KH = (LAS bf16_t*)(sm + 5 * XI); LAS bf16_t* VT = (LAS bf16_t*)(sm + 6 * XI);
    LAS bf16_t* AAB = (LAS bf16_t*)(sm + 7 * XI); LAS bf16_t* AAK = (LAS bf16_t*)(sm + 8 * XI); LAS bf16_t* ARB = (LAS bf16_t*)(sm + 9 * XI); LAS bf16_t* ARK = (LAS bf16_t*)(sm + 10 * XI);
    LAS bf16_t* XT = At;
    LAS bf16_t* YT = Kt;
    LAS float* RHS = (LAS float*)(sm + X_RHS);
    LAS float* sXW = RHS; LAS float* sXA = RHS + 64 * 68;
    LAS float* DIAG = (LAS float*)(sm + X_DIAG);
    LAS bf16_t* TI = (LAS bf16_t*)(sm + X_TI);
    LAS float* red = (LAS float*)(sm + X_RED);
    const LAS float* CT = (const LAS float*)(sm + X_RED + 4096);
    const bf16_t* P = (const bf16_t*)(p.ws + OFF_P); unsigned char* R = p.ws + OFF_R;
    const size_t tg0 = (size_t)b * SEQ + (size_t)ck * 64;
    const int t = lane, cg = wv, ch0 = hd * 64 + cg * 8;
    __syncthreads();
#pragma unroll
    for (int i = 0; i < 2; ++i) {
        const int task = tid + 512 * i, tt = task >> 4, q = task & 15;
        const int col = 1536 + 8 * q; LAS bf16_t* dst = (q < 8 ? At + tt * 72 + 8 * q : Bt + tt * 72 + 8 * (q - 8));
        const u32x4 cur = pre.c1[i], prv = pre.p1[i];
        const f32x4 m0 = *(const LAS f32x4*)(CT + 8 * q), m1 = *(const LAS f32x4*)(CT + 8 * q + 4); (void)col;
        const unsigned cw[4] = {cur.x, cur.y, cur.z, cur.w}, pw[4] = {prv.x, prv.y, prv.z, prv.w}; const float mu[8] = {m0.x, m0.y, m0.z, m0.w, m1.x, m1.y, m1.z, m1.w};
        float v[8];
#pragma unroll
        for (int k = 0; k < 4; ++k) { const float c0 = bflo(cw[k]), c1 = bfhi(cw[k]), p0 = bflo(pw[k]), p1 = bfhi(pw[k]); v[2 * k] = c0 + (p0 - c0) * mu[2 * k]; v[2 * k + 1] = c1 + (p1 - c1) * mu[2 * k + 1]; }
        if (q < 8) {
#pragma unroll
            for (int k = 0; k < 8; ++k) v[k] = tanhf_(v[k]); }
        { u32x4 w; w.x = pk2(v[0], v[1]); w.y = pk2(v[2], v[3]); w.z = pk2(v[4], v[5]); w.w = pk2(v[6], v[7]); *(LAS u32x4*)dst = w; }
    }
    float rv[8], kv[8], vv[8];
    {
#pragma unroll
        for (int w3 = 0; w3 < 3; ++w3) { const u32x4 cur = pre.cr[w3], prv = pre.pr[w3];
            const f32x4 m0 = *(const LAS f32x4*)(CT + 128 + 64 * w3 + cg * 8), m1 = *(const LAS f32x4*)(CT + 128 + 64 * w3 + cg * 8 + 4);
            const unsigned cw[4] = {cur.x, cur.y, cur.z, cur.w}, pw[4] = {prv.x, prv.y, prv.z, prv.w}; const float mu[8] = {m0.x, m0.y, m0.z, m0.w, m1.x, m1.y, m1.z, m1.w};
#pragma unroll
            for (int k = 0; k < 4; ++k) { const float c0 = bflo(cw[k]), c1 = bfhi(cw[k]), p0 = bflo(pw[k]), p1 = bfhi(pw[k]);
                const float x0 = c0 + (p0 - c0) * mu[2 * k], x1 = c1 + (p1 - c1) * mu[2 * k + 1];
                if (w3 == 0) { rv[2 * k] = x0; rv[2 * k + 1] = x1; } else if (w3 == 1) { kv[2 * k] = x0; kv[2 * k + 1] = x1; } else { vv[2 * k] = x0; vv[2 * k + 1] = x1; } } }
    }
    if (nck >= 0) rwkv_x_fetch(pre, P, nb, nhd, nck, tid, lane, wv);
    __syncthreads();
    {
        const int mat = wv >> 2; const LAS bf16_t* img = mat ? Bt : At; LAS float* dstm = mat ? sXA : sXW;
#pragma unroll
        for (int n = 0; n < 4; ++n) { const int tile = (wv & 3) * 4 + n, ct = tile >> 2, tt = tile & 3;
            f32x4 acc = (f32x4){0.f, 0.f, 0.f, 0.f};
#pragma unroll
            for (int kk = 0; kk < 2; ++kk) acc = __builtin_amdgcn_mfma_f32_16x16x32_bf16(kw.wt[n][kk], lds_frag(img, 72, 16 * tt + fr, 32 * kk + 8 * fq), acc, 0, 0, 0);
            *(LAS f32x4*)(dstm + (16 * tt + fr) * 68 + 16 * ct + 4 * fq) = acc; }
    }
    __syncthreads();
    float zw[8], za[8];
    { const f32x4 a0 = *(const LAS f32x4*)(sXW + t * 68 + cg * 8), a1 = *(const LAS f32x4*)(sXW + t * 68 + cg * 8 + 4), b0 = *(const LAS f32x4*)(sXA + t * 68 + cg * 8), b1 = *(const LAS f32x4*)(sXA + t * 68 + cg * 8 + 4);
      zw[0] = a0.x; zw[1] = a0.y; zw[2] = a0.z; zw[3] = a0.w; zw[4] = a1.x; zw[5] = a1.y; zw[6] = a1.z; zw[7] = a1.w;
      za[0] = b0.x; za[1] = b0.y; za[2] = b0.z; za[3] = b0.w; za[4] = b1.x; za[5] = b1.y; za[6] = b1.z; za[7] = b1.w; }
    float lw[8], av[8], kkv[8], kp[8]; float ss = 0.f, sb = 0.f;
#pragma unroll
    for (int i = 0; i < 8; ++i) { const int ch = ch0 + i;
        const float u = -(CT[320 + cg * 8 + i] + zw[i]); (void)ch; const float sp = (u > 20.f) ? u : __logf(1.0f + __expf(u));
        lw[i] = -__expf(-sp - 0.5f);
        av[i] = sigmoidf_(CT[384 + cg * 8 + i] + za[i]);
        kkv[i] = kv[i] * CT[448 + cg * 8 + i]; ss += kkv[i] * kkv[i];
        kp[i] = kv[i] * (1.0f + (av[i] - 1.0f) * CT[512 + cg * 8 + i]);
        sb += rv[i] * kp[i] * CT[576 + cg * 8 + i]; }
    red[t * 8 + cg] = ss; red[512 + t * 8 + cg] = sb;
    __syncthreads();
    {
        float tot = 0.f, bon = 0.f;
#pragma unroll
        for (int i = 0; i < 8; ++i) { tot += red[t * 8 + i]; bon += red[512 + t * 8 + i]; }
        if (cg == 0) ((float*)(R + R_BON))[(tg0 + t) * 8 + hd] = bon;
        const float inv = __builtin_amdgcn_rcpf(fmaxf(sqrtf(tot), 1e-12f));
        float at[8], rt_[8], bt[8], kt[8], bh_[8], kh_[8];
#pragma unroll
        for (int i = 0; i < 8; ++i) {
            const float cl = wave_scan_incl(lw[i], lane); const float cl63 = lane63(cl);
            const float e1 = __expf(cl), e0 = __expf(cl - lw[i]), en = __expf(-cl), eh = __expf(cl63 - cl);
            const float kn = kkv[i] * inv, A = -kn, Bv = kn * av[i];
            at[i] = A * e0; rt_[i] = rv[i] * e1; bt[i] = Bv * en; kt[i] = kp[i] * en; bh_[i] = Bv * eh; kh_[i] = kp[i] * eh;
            if (lane == 63) ((float*)(R + R_GAM))[(size_t)unit * 64 + cg * 8 + i] = __expf(cl63); }
        { u32x4 w; w.x = pk2(at[0], at[1]); w.y = pk2(at[2], at[3]); w.z = pk2(at[4], at[5]); w.w = pk2(at[6], at[7]); *(LAS u32x4*)(At + t * 72 + cg * 8) = w; }
        { u32x4 w; w.x = pk2(rt_[0], rt_[1]); w.y = pk2(rt_[2], rt_[3]); w.z = pk2(rt_[4], rt_[5]); w.w = pk2(rt_[6], rt_[7]); *(LAS u32x4*)(Rt + t * 72 + cg * 8) = w; }
        { u32x4 w; w.x = pk2(bt[0], bt[1]); w.y = pk2(bt[2], bt[3]); w.z = pk2(bt[4], bt[5]); w.w = pk2(bt[6], bt[7]); *(LAS u32x4*)(Bt + t * 72 + cg * 8) = w; }
        { u32x4 w; w.x = pk2(kt[0], kt[1]); w.y = pk2(kt[2], kt[3]); w.z = pk2(kt[4], kt[5]); w.w = pk2(kt[6], kt[7]); *(LAS u32x4*)(Kt + t * 72 + cg * 8) = w; }
        *(LAS f32x4*)(RHS + t * 132 + 64 + cg * 8) = (f32x4){at[0], at[1], at[2], at[3]}; *(LAS f32x4*)(RHS + t * 132 + 64 + cg * 8 + 4) = (f32x4){at[4], at[5], at[6], at[7]};
#pragma unroll
        for (int i = 0; i < 8; ++i) { BH[(cg * 8 + i) * 72 + t] = (bf16_t)f2bf(bh_[i]); KH[(cg * 8 + i) * 72 + t] = (bf16_t)f2bf(kh_[i]); VT[(cg * 8 + i) * 72 + t] = (bf16_t)f2bf(vv[i]); }
    }
    __syncthreads();
    {
        const int mat = wv >> 1;
        const LAS bf16_t* Ximg = (mat < 2) ? At : Rt; const LAS bf16_t* Yimg = (mat & 1) ? Kt : Bt;
        LAS bf16_t* Oimg = mat == 0 ? AAB : (mat == 1 ? AAK : (mat == 2 ? ARB : ARK));
#pragma unroll 4
        for (int n = 0; n < 8; ++n) { const int idx = (wv & 1) * 8 + n, si = idx >> 2, ti = idx & 3;
            f32x4 acc = (f32x4){0.f, 0.f, 0.f, 0.f};
            if (si <= ti) {
#pragma unroll
                for (int kk = 0; kk < 2; ++kk) acc = __builtin_amdgcn_mfma_f32_16x16x32_bf16(lds_frag(Yimg, 72, 16 * si + fr, 32 * kk + 8 * fq), lds_frag(Ximg, 72, 16 * ti + fr, 32 * kk + 8 * fq), acc, 0, 0, 0); }
            const int tt = 16 * ti + fr, s0 = 16 * si + 4 * fq; const int lim = (mat < 2) ? tt - 1 : tt;
            const float o0 = s0 <= lim ? acc[0] : 0.f, o1 = s0 + 1 <= lim ? acc[1] : 0.f, o2 = s0 + 2 <= lim ? acc[2] : 0.f, o3 = s0 + 3 <= lim ? acc[3] : 0.f;
            u32x2 w; w.x = pk2(o0, o1); w.y = pk2(o2, o3); *(LAS u32x2*)(Oimg + tt * 72 + s0) = w;
            if (mat == 0 && si == ti) { LAS float* d = DIAG + si * 272 + fr * 17 + 4 * fq; d[0] = o0; d[1] = o1; d[2] = o2; d[3] = o3; } }
    }
    __syncthreads();
    if (wv < 4) {
#pragma unroll
        for (int ti = 0; ti < 4; ++ti) { f32x4 acc = (f32x4){0.f, 0.f, 0.f, 0.f};
#pragma unroll
            for (int kk = 0; kk < 2; ++kk) acc = __builtin_amdgcn_mfma_f32_16x16x32_bf16(lds_frag(AAK, 72, 16 * ti + fr, 32 * kk + 8 * fq), lds_frag(VT, 72, 16 * wv + fr, 32 * kk + 8 * fq), acc, 0, 0, 0);
#pragma unroll
            for (int r = 0; r < 4; ++r) RHS[(16 * ti + 4 * fq + r) * 132 + 16 * wv + fr] = acc[r]; }
    } else if (lane < 16) { const int I = wv - 4; const LAS float* d = DIAG + I * 272; float T[16];
#pragma unroll
        for (int r = 0; r < 16; ++r) { float s = (r == lane) ? 1.f : 0.f;
#pragma unroll
            for (int q = 0; q < r; ++q) s += d[r * 17 + q] * T[q];
            T[r] = s; TI[I * 384 + r * 24 + lane] = (bf16_t)f2bf(s); } }
    __syncthreads();
#pragma unroll 1
    for (int I = 0; I < 4; ++I) {
        f32x4 acc;
#pragma unroll
        for (int r = 0; r < 4; ++r) acc[r] = RHS[(16 * I + 4 * fq + r) * 132 + 16 * wv + fr];
#pragma unroll 1
        for (int kk = 0; 32 * kk < 16 * I; ++kk) { const bool ok = (32 * kk + 8 * fq) < 16 * I;
            bf16x8_t a = zero_frag(), bq = zero_frag();
            if (ok) { a = lds_frag(AAB, 72, 16 * I + fr, 32 * kk + 8 * fq); bq = lds_frag(XT, 72, 16 * wv + fr, 32 * kk + 8 * fq); }
            acc = __builtin_amdgcn_mfma_f32_16x16x32_bf16(a, bq, acc, 0, 0, 0); }
        { u32x2 w; w.x = pk2(acc[0], acc[1]); w.y = pk2(acc[2], acc[3]); *(LAS u32x2*)(YT + (16 * wv + fr) * 24 + 4 * fq) = w; }
        LDS_WAIT();
        { bf16x8_t a = zero_frag(), bq = zero_frag();
          if (fq < 2) { a = *(const LAS bf16x8_t*)(TI + I * 384 + fr * 24 + 8 * fq); bq = *(const LAS bf16x8_t*)(YT + (16 * wv + fr) * 24 + 8 * fq); }
          f32x4 x = __builtin_amdgcn_mfma_f32_16x16x32_bf16(a, bq, (f32x4){0.f, 0.f, 0.f, 0.f}, 0, 0, 0);
          u32x2 w; w.x = pk2(x[0], x[1]); w.y = pk2(x[2], x[3]); *(LAS u32x2*)(XT + (16 * wv + fr) * 72 + 16 * I + 4 * fq) = w; }
        LDS_WAIT();
    }
    __syncthreads();
    {
        const int mat = wv >> 1;
        bf16_t* MG = (bf16_t*)(R + R_MG) + (size_t)unit * 4096; bf16_t* NT = (bf16_t*)(R + R_NT) + (size_t)unit * 4096;
        bf16_t* QG = (bf16_t*)(R + R_QG) + (size_t)unit * 4096; bf16_t* Y0G = (bf16_t*)(R + R_Y0) + (size_t)unit * 4096;
#pragma unroll 4
        for (int n = 0; n < 8; ++n) { const int idx = (wv & 1) * 8 + n, rt = idx >> 2, ct = idx & 3;
            f32x4 acc = (f32x4){0.f, 0.f, 0.f, 0.f};
            if (mat == 2) { const u32x2 r2 = *(const LAS u32x2*)(Rt + (16 * ct + fr) * 72 + 16 * rt + 4 * fq); acc = (f32x4){bflo(r2.x), bfhi(r2.x), bflo(r2.y), bfhi(r2.y)}; }
#pragma unroll
            for (int kk = 0; kk < 2; ++kk) { const int kc = 32 * kk + 8 * fq;
                if (mat == 0) acc = __builtin_amdgcn_mfma_f32_16x16x32_bf16(lds_frag(XT, 72, 64 + 16 * rt + fr, kc), lds_frag(BH, 72, 16 * ct + fr, kc), acc, 0, 0, 0);
                else if (mat == 1) { acc = __builtin_amdgcn_mfma_f32_16x16x32_bf16(lds_frag(BH, 72, 16 * rt + fr, kc), lds_frag(XT, 72, 16 * ct + fr, kc), acc, 0, 0, 0);
                                     acc = __builtin_amdgcn_mfma_f32_16x16x32_bf16(lds_frag(KH, 72, 16 * rt + fr, kc), lds_frag(VT, 72, 16 * ct + fr, kc), acc, 0, 0, 0); }
                else if (mat == 2) acc = __builtin_amdgcn_mfma_f32_16x16x32_bf16(lds_frag(XT, 72, 64 + 16 * rt + fr, kc), lds_frag(ARB, 72, 16 * ct + fr, kc), acc, 0, 0, 0);
                else { acc = __builtin_amdgcn_mfma_f32_16x16x32_bf16(lds_frag(XT, 72, 16 * rt + fr, kc), lds_frag(ARB, 72, 16 * ct + fr, kc), acc, 0, 0, 0);
                       acc = __builtin_amdgcn_mfma_f32_16x16x32_bf16(lds_frag(VT, 72, 16 * rt + fr, kc), lds_frag(ARK, 72, 16 * ct + fr, kc), acc, 0, 0, 0); } }
            u32x2 w; w.x = pk2(acc[0], acc[1]); w.y = pk2(acc[2], acc[3]);
            if (mat == 0) *(u32x2*)(MG + (16 * ct + fr) * 64 + 32 * (rt >> 1) + 8 * fq + 4 * (rt & 1)) = w;
            else if (mat == 1) *(u32x2*)(NT + (16 * ct + fr) * 64 + 16 * rt + 4 * fq) = w;
            else if (mat == 2) *(u32x2*)(QG + (16 * ct + fr) * 64 + 16 * rt + 4 * fq) = w;
            else *(u32x2*)(Y0G + (16 * ct + fr) * 64 + 16 * rt + 4 * fq) = w; }
    }
}

constexpr int RY_SLOT = 2 * 64 * 72 * 2 + 256;
struct RyFill { u32x4 m[8], n[8], g; };
__device__ __forceinline__ void rwkv_y_fetch(RyFill& f, const unsigned char* R, size_t unit, int lane) {
    const u32x4* MG = (const u32x4*)((const bf16_t*)(R + R_MG) + unit * 4096); const u32x4* NT = (const u32x4*)((const bf16_t*)(R + R_NT) + unit * 4096); const u32x4* GAM = (const u32x4*)((const float*)(R + R_GAM) + unit * 64);
#pragma unroll
    for (int i = 0; i < 8; ++i) { f.m[i] = MG[lane + 64 * i]; f.n[i] = NT[lane + 64 * i]; }
    f.g = (u32x4){0u, 0u, 0u, 0u}; if (lane < 16) f.g = GAM[lane];
}
__device__ __forceinline__ void rwkv_y_put(const RyFill& f, unsigned char* slot, int lane) {
#pragma unroll
    for (int i = 0; i < 8; ++i) { const int idx = lane + 64 * i; *(LAS u32x4*)(slot + (idx >> 3) * 144 + (idx & 7) * 16) = f.m[i]; *(LAS u32x4*)(slot + 9216 + (idx >> 3) * 144 + (idx & 7) * 16) = f.n[i]; }
    if (lane < 16) *(LAS u32x4*)(slot + 18432 + lane * 16) = f.g;
}
__device__ __forceinline__ void rwkv_y(const Ctx& c, const Params& p, int bh) {
    const int lane = c.lane, wv = c.wave, fr = lane & 15, fq = lane >> 4, jb = wv & 3, g = wv - 4; unsigned char* R = p.ws + OFF_R; unsigned char* sm = c.shm;
    f32x4 Z[4];
#pragma unroll
    for (int i = 0; i < 4; ++i) Z[i] = (f32x4){0.f, 0.f, 0.f, 0.f};
    RyFill fs;
    __syncthreads();
    if (wv >= 4) {
        if (g == 0) { rwkv_y_fetch(fs, R, (size_t)bh * 64, lane); rwkv_y_put(fs, sm, lane); rwkv_y_fetch(fs, R, (size_t)bh * 64 + 4, lane); }
        else rwkv_y_fetch(fs, R, (size_t)bh * 64 + g, lane);
    }
    __syncthreads();
#pragma unroll 1
    for (int ck = 0; ck < 64; ++ck) {
        if (wv >= 4) {
            if (((ck + 1) & 3) == g && ck + 1 < 64) { rwkv_y_put(fs, sm + ((ck + 1) & 7) * RY_SLOT, lane); if (ck + 5 < 64) rwkv_y_fetch(fs, R, (size_t)bh * 64 + ck + 5, lane); }
        } else {
            const size_t unit = (size_t)bh * 64 + ck; const unsigned char* slot = sm + (ck & 7) * RY_SLOT;
            const LAS bf16_t* MGs = (const LAS bf16_t*)slot; const LAS bf16_t* NTs = (const LAS bf16_t*)(slot + 9216); const LAS float* GMs = (const LAS float*)(slot + 18432);
            bf16x8_t mf[4][2]; u32x2 nn[4]; f32x4 gg[4];
#pragma unroll
            for (int rt = 0; rt < 4; ++rt) {
#pragma unroll
                for (int sg = 0; sg < 2; ++sg) mf[rt][sg] = lds_frag(MGs, 72, 16 * rt + fr, 32 * sg + 8 * fq);
                nn[rt] = *(const LAS u32x2*)(NTs + (16 * jb + fr) * 72 + 16 * rt + 4 * fq); gg[rt] = *(const LAS f32x4*)(GMs + 16 * rt + 4 * fq); }
            bf16_t* Z0 = (bf16_t*)(R + R_Z0) + unit * 4096;
            bf16x8_t zb[2];
#pragma unroll
            for (int sg = 0; sg < 2; ++sg) { const float zv[8] = {Z[2 * sg][0], Z[2 * sg][1], Z[2 * sg][2], Z[2 * sg][3], Z[2 * sg + 1][0], Z[2 * sg + 1][1], Z[2 * sg + 1][2], Z[2 * sg + 1][3]}; zb[sg] = pack8(zv); }
#pragma unroll
            for (int rt = 0; rt < 4; ++rt) { u32x2 w; w.x = pk2(Z[rt][0], Z[rt][1]); w.y = pk2(Z[rt][2], Z[rt][3]); *(u32x2*)(Z0 + (16 * jb + fr) * 64 + 16 * rt + 4 * fq) = w; }
            asm volatile("s_waitcnt lgkmcnt(0)" ::: "memory");
            f32x4 acc[4];
#pragma unroll
            for (int rt = 0; rt < 4; ++rt) { acc[rt] = (f32x4){bflo(nn[rt].x), bfhi(nn[rt].x), bflo(nn[rt].y), bfhi(nn[rt].y)} + gg[rt] * Z[rt];
#pragma unroll
                for (int sg = 0; sg < 2; ++sg) acc[rt] = __builtin_amdgcn_mfma_f32_16x16x32_bf16(mf[rt][sg], zb[sg], acc[rt], 0, 0, 0); }
#pragma unroll
            for (int rt = 0; rt < 4; ++rt) Z[rt] = acc[rt];
        }
        asm volatile("s_waitcnt lgkmcnt(0)" ::: "memory"); __builtin_amdgcn_s_barrier(); asm volatile("" ::: "memory");
    }
}

__device__ __forceinline__ void rwkv_z(const Ctx& c, const Params& p, int unit) {
    const int bh = unit >> 6, ck = unit & 63, b = bh >> 3, hd = bh & 7, lane = c.lane, fr = lane & 15, fq = lane >> 4; unsigned char* R = p.ws + OFF_R;
    const bf16_t* P = (const bf16_t*)(p.ws + OFF_P); bf16_t* MIX = (bf16_t*)p.out;
    const bf16_t* QG = (const bf16_t*)(R + R_QG) + (size_t)unit * 4096; const bf16_t* Y0G = (const bf16_t*)(R + R_Y0) + (size_t)unit * 4096; const bf16_t* Z0 = (const bf16_t*)(R + R_Z0) + (size_t)unit * 4096;
    const LAS bf16_t* G2s = (const LAS bf16_t*)c.shm;
    const size_t tg0 = (size_t)b * SEQ + (size_t)ck * 64;
    f32x4 y[4][4], g[4][4];
#pragma unroll
    for (int jt = 0; jt < 4; ++jt)
#pragma unroll
        for (int tt = 0; tt < 4; ++tt) { const u32x2 w = *(const u32x2*)(Y0G + (16 * tt + fr) * 64 + 16 * jt + 4 * fq); y[jt][tt] = (f32x4){bflo(w.x), bfhi(w.x), bflo(w.y), bfhi(w.y)}; g[jt][tt] = (f32x4){0.f, 0.f, 0.f, 0.f}; }
#pragma unroll
    for (int sg = 0; sg < 2; ++sg) { bf16x8_t qb[4];
#pragma unroll
        for (int tt = 0; tt < 4; ++tt) qb[tt] = *(const bf16x8_t*)(QG + (16 * tt + fr) * 64 + 32 * sg + 8 * fq);
#pragma unroll
        for (int jt = 0; jt < 4; ++jt) { const bf16x8_t a = *(const bf16x8_t*)(Z0 + (16 * jt + fr) * 64 + 32 * sg + 8 * fq);
#pragma unroll
            for (int tt = 0; tt < 4; ++tt) y[jt][tt] = __builtin_amdgcn_mfma_f32_16x16x32_bf16(a, qb[tt], y[jt][tt], 0, 0, 0); } }
#pragma unroll 1
    for (int kk = 0; kk < 4; ++kk) { bf16x8_t sgf[4];
        const int col = 1664 + 32 * kk + 8 * fq; const f32x4 m0 = *(const f32x4*)(p.ev_mu + col), m1 = *(const f32x4*)(p.ev_mu + col + 4); const float mu[8] = {m0.x, m0.y, m0.z, m0.w, m1.x, m1.y, m1.z, m1.w};
#pragma unroll
        for (int tt = 0; tt < 4; ++tt) { const int tl = 16 * tt + fr; const bf16_t* src = P + (tg0 + tl) * EV_IN + 768 + col;
            const u32x4 cur = *(const u32x4*)src; u32x4 prv = (u32x4){0u, 0u, 0u, 0u}; if (ck * 64 + tl > 0) prv = *(const u32x4*)(src - EV_IN);
            const unsigned cw[4] = {cur.x, cur.y, cur.z, cur.w}, pw[4] = {prv.x, prv.y, prv.z, prv.w}; float v[8];
#pragma unroll
            for (int k = 0; k < 4; ++k) { const float c0 = bflo(cw[k]), c1 = bfhi(cw[k]), p0 = bflo(pw[k]), p1 = bfhi(pw[k]); v[2 * k] = sigmoidf_(c0 + (p0 - c0) * mu[2 * k]); v[2 * k + 1] = sigmoidf_(c1 + (p1 - c1) * mu[2 * k + 1]); }
            sgf[tt] = pack8(v); }
#pragma unroll
        for (int jt = 0; jt < 4; ++jt) { const bf16x8_t a = lds_frag(G2s, 136, 16 * jt + fr, 32 * kk + 8 * fq);
#pragma unroll
            for (int tt = 0; tt < 4; ++tt) g[jt][tt] = __builtin_amdgcn_mfma_f32_16x16x32_bf16(a, sgf[tt], g[jt][tt], 0, 0, 0); } }
#pragma unroll
    for (int tt = 0; tt < 4; ++tt) { const int tl = 16 * tt + fr;
        float s1 = 0.f;
#pragma unroll
        for (int jt = 0; jt < 4; ++jt) s1 += (y[jt][tt][0] + y[jt][tt][1]) + (y[jt][tt][2] + y[jt][tt][3]);
        s1 += __shfl_xor(s1, 16); s1 += __shfl_xor(s1, 32); const float mean = s1 * (1.0f / 64.0f);
        float s2 = 0.f;
#pragma unroll
        for (int jt = 0; jt < 4; ++jt)
#pragma unroll
            for (int r = 0; r < 4; ++r) { const float d = y[jt][tt][r] - mean; s2 += d * d; }
        s2 += __shfl_xor(s2, 16); s2 += __shfl_xor(s2, 32); const float rs = 1.0f / sqrtf(s2 * (1.0f / 64.0f) + 64e-5f);
        const float bon = ((const float*)(R + R_BON))[(tg0 + tl) * 8 + hd]; const bool hp = (ck * 64 + tl > 0);
#pragma unroll
        for (int jt = 0; jt < 4; ++jt) { const int ch = hd * 64 + 16 * jt + 4 * fq;
            const bf16_t* src = P + (tg0 + tl) * EV_IN + 768 + 1024 + ch; const u32x2 cur = *(const u32x2*)src; u32x2 prv; prv.x = 0u; prv.y = 0u; if (hp) prv = *(const u32x2*)(src - EV_IN);
            const f32x4 mu = *(const f32x4*)(p.ev_mu + 1024 + ch), lw4 = *(const f32x4*)(p.ev_lnx_w + ch), lb4 = *(const f32x4*)(p.ev_lnx_b + ch);
            const float c0 = bflo(cur.x), c1 = bfhi(cur.x), c2 = bflo(cur.y), c3 = bfhi(cur.y), p0 = bflo(prv.x), p1 = bfhi(prv.x), p2 = bflo(prv.y), p3 = bfhi(prv.y);
            const float v0 = c0 + (p0 - c0) * mu.x, v1 = c1 + (p1 - c1) * mu.y, v2 = c2 + (p2 - c2) * mu.z, v3 = c3 + (p3 - c3) * mu.w;
            const f32x4 yy = y[jt][tt], gg = g[jt][tt];
            const float o0 = ((yy[0] - mean) * rs * lw4.x + lb4.x + bon * v0) * gg[0], o1 = ((yy[1] - mean) * rs * lw4.y + lb4.y + bon * v1) * gg[1];
            const float o2 = ((yy[2] - mean) * rs * lw4.z + lb4.z + bon * v2) * gg[2], o3 = ((yy[3] - mean) * rs * lw4.w + lb4.w + bon * v3) * gg[3];
            u32x2 w; w.x = pk2(o0, o1); w.y = pk2(o2, o3); *(u32x2*)(MIX + (tg0 + tl) * 1024 + 512 + ch) = w; } }
}

__device__ __forceinline__ void xattn_mfma(const Ctx& c, const Params& p, int unit) {
    const int b = unit >> 5, hh = (unit >> 3) & 3, tblk = unit & 7, tid = c.tid, lane = c.lane, wv = c.wave, fr = lane & 15, fq = lane >> 4;
    LAS bf16_t* Ks = (LAS bf16_t*)c.shm;
    LAS bf16_t* VTp = (LAS bf16_t*)(c.shm + 256 * 272);
    const bf16_t* MKV = (const bf16_t*)(p.ws + OFF_MKV); const bf16_t* Q = (const bf16_t*)(p.ws + OFF_P); bf16_t* OA = (bf16_t*)(p.ws + OFF_P + 32 * MiB);
    __syncthreads();
    {
        u32x4 dd[16];
#pragma unroll
        for (int i = 0; i < 16; ++i) { const int task = tid + 512 * i, which = task >> 12, r = (task >> 4) & 255, ck = task & 15;
            dd[i] = *(const u32x4*)(MKV + ((size_t)b * MEMLEN + r) * 1024 + which * 512 + hh * 128 + ck * 8); }
#pragma unroll
        for (int i = 0; i < 16; ++i) { const int task = tid + 512 * i, which = task >> 12, r = (task >> 4) & 255, ck = task & 15; const u32x4 d = dd[i];
            if (which == 0) *(LAS u32x4*)(Ks + r * 136 + ck * 8) = d;
            else { const int kc = key_perm(r); const unsigned w[4] = {d.x, d.y, d.z, d.w};
#pragma unroll
                for (int k = 0; k < 4; ++k) { VTp[(ck * 8 + 2 * k) * 264 + kc] = (bf16_t)(w[k] & 0xFFFFu); VTp[(ck * 8 + 2 * k + 1) * 264 + kc] = (bf16_t)(w[k] >> 16); } } }
    }
    __syncthreads();
    bf16x8_t qn[4]; f32x4 sn[4];
    { const size_t tq0 = (size_t)b * SEQ + tblk * 512 + wv * 64 + fr;
#pragma unroll
      for (int kk = 0; kk < 4; ++kk) qn[kk] = *(const bf16x8_t*)(Q + tq0 * 512 + hh * 128 + 32 * kk + 8 * fq);
      const f32x4* sp = (const f32x4*)((const float*)(p.ws + OFF_R + R_SSP) + tq0 * 16); sn[0] = sp[0]; sn[1] = sp[1]; sn[2] = sp[2]; sn[3] = sp[3]; }
#pragma unroll 1
    for (int qt = 0; qt < 4; ++qt) {
        const size_t tq = (size_t)b * SEQ + tblk * 512 + wv * 64 + qt * 16 + fr;
        bf16x8_t qf[4];
#pragma unroll
        for (int kk = 0; kk < 4; ++kk) qf[kk] = qn[kk];
        float qsc;
        { const f32x4 s0 = sn[0], s1 = sn[1], s2 = sn[2], s3 = sn[3];
          const float ssq = ((s0.x + s0.y) + (s0.z + s0.w)) + ((s1.x + s1.y) + (s1.z + s1.w)) + ((s2.x + s2.y) + (s2.z + s2.w)) + ((s3.x + s3.y) + (s3.z + s3.w));
          qsc = 0.08838834764831845f / sqrtf(ssq * (1.0f / 1024.0f) + 1e-6f); }
        if (qt + 1 < 4) { const size_t tn = tq + 16;
#pragma unroll
            for (int kk = 0; kk < 4; ++kk) qn[kk] = *(const bf16x8_t*)(Q + tn * 512 + hh * 128 + 32 * kk + 8 * fq);
            const f32x4* sp = (const f32x4*)((const float*)(p.ws + OFF_R + R_SSP) + tn * 16); sn[0] = sp[0]; sn[1] = sp[1]; sn[2] = sp[2]; sn[3] = sp[3]; }
        f32x4 s[16];
#pragma unroll
        for (int kt = 0; kt < 16; ++kt) { s[kt] = (f32x4){0.f, 0.f, 0.f, 0.f};
#pragma unroll
            for (int kk = 0; kk < 4; ++kk) s[kt] = __builtin_amdgcn_mfma_f32_16x16x32_bf16(lds_frag(Ks, 136, 16 * kt + fr, 32 * kk + 8 * fq), qf[kk], s[kt], 0, 0, 0);
            if (kt & 1) __builtin_amdgcn_sched_barrier(0); }
        float m = s[0][0];
#pragma unroll
        for (int kt = 0; kt < 16; ++kt) m = fmaxf(fmaxf(fmaxf(m, s[kt][0]), fmaxf(s[kt][1], s[kt][2])), s[kt][3]);
        m = fmaxf(m, __shfl_xor(m, 16)); m = fmaxf(m, __shfl_xor(m, 32));
        float den = 0.f;
#pragma unroll
        for (int kt = 0; kt < 16; ++kt)
#pragma unroll
            for (int r = 0; r < 4; ++r) { const float e = __expf((s[kt][r] - m) * qsc); s[kt][r] = e; den += e; }
        den += __shfl_xor(den, 16); den += __shfl_xor(den, 32);
        f32x4 o[8];
#pragma unroll
        for (int dt = 0; dt < 8; ++dt) o[dt] = (f32x4){0.f, 0.f, 0.f, 0.f};
#pragma unroll
        for (int sg = 0; sg < 8; ++sg) { const float pv[8] = {s[2 * sg][0], s[2 * sg][1], s[2 * sg][2], s[2 * sg][3], s[2 * sg + 1][0], s[2 * sg + 1][1], s[2 * sg + 1][2], s[2 * sg + 1][3]};
            const bf16x8_t pb = pack8(pv);
#pragma unroll
            for (int dt = 0; dt < 8; ++dt) o[dt] = __builtin_amdgcn_mfma_f32_16x16x32_bf16(lds_frag(VTp, 264, 16 * dt + fr, 32 * sg + 8 * fq), pb, o[dt], 0, 0, 0);
            __builtin_amdgcn_sched_barrier(0); }
        const float inv = 1.0f / den;
#pragma unroll
        for (int dt = 0; dt < 8; ++dt) { u32x2 w; w.x = pk2(o[dt][0] * inv, o[dt][1] * inv); w.y = pk2(o[dt][2] * inv, o[dt][3] * inv); *(u32x2*)(OA + tq * 512 + hh * 128 + 16 * dt + 4 * fq) = w; }
    }
}
__device__ __forceinline__ void swa_mfma(const Ctx& c, const Params& p, int unit) {
    const int b = unit >> 6, g = (unit >> 5) & 1, n = unit & 31, tid = c.tid, lane = c.lane, wv = c.wave, fr = lane & 15, fq = lane >> 4;
    LAS bf16_t* Ks = (LAS bf16_t*)c.shm;
    LAS bf16_t* VTp = (LAS bf16_t*)(c.shm + 256 * 144);
    const bf16_t* P = (const bf16_t*)(p.ws + OFF_P); bf16_t* MIX = (bf16_t*)p.out;
    __syncthreads();
    {
        u32x4 dd[8];
#pragma unroll
        for (int i = 0; i < 8; ++i) { const int task = tid + 512 * i, which = task >> 11, r = (task >> 3) & 255, ck = task & 7; const int tk = n * 128 - 128 + r;
            dd[i] = (u32x4){0u, 0u, 0u, 0u}; if (tk >= 0) dd[i] = *(const u32x4*)(P + ((size_t)b * SEQ + tk) * EV_IN + 512 + which * 128 + g * 64 + ck * 8); }
#pragma unroll
        for (int i = 0; i < 8; ++i) { const int task = tid + 512 * i, which = task >> 11, r = (task >> 3) & 255, ck = task & 7; const u32x4 d = dd[i];
            if (which == 0) *(LAS u32x4*)(Ks + r * 72 + ck * 8) = d;
            else { const int kc = key_perm(r); const unsigned w[4] = {d.x, d.y, d.z, d.w};
#pragma unroll
                for (int k = 0; k < 4; ++k) { VTp[(ck * 8 + 2 * k) * 264 + kc] = (bf16_t)(w[k] & 0xFFFFu); VTp[(ck * 8 + 2 * k + 1) * 264 + kc] = (bf16_t)(w[k] >> 16); } } }
    }
    __syncthreads();
#pragma unroll 1
    for (int it = 0; it < 4; ++it) {
        const int tile = wv * 4 + it, hql = tile >> 3, qb = tile & 7, head = g * 4 + hql, sg0 = qb >> 1;
        const int qi = 16 * qb + fr; const size_t tq = (size_t)b * SEQ + n * 128 + qi;
        const float sink = p.ev_sinks[head];
        bf16x8_t qf[2];
#pragma unroll
        for (int kk = 0; kk < 2; ++kk) qf[kk] = *(const bf16x8_t*)(P + tq * EV_IN + head * 64 + 32 * kk + 8 * fq);
        f32x4 s[10]; float m = sink;
#pragma unroll
        for (int i = 0; i < 10; ++i) { const int kt = 2 * sg0 + i; s[i] = (f32x4){0.f, 0.f, 0.f, 0.f};
#pragma unroll
            for (int kk = 0; kk < 2; ++kk) s[i] = __builtin_amdgcn_mfma_f32_16x16x32_bf16(lds_frag(Ks, 72, 16 * kt + fr, 32 * kk + 8 * fq), qf[kk], s[i], 0, 0, 0);
#pragma unroll
            for (int r = 0; r < 4; ++r) { const int kp = 16 * kt + 4 * fq + r; const bool valid = (kp >= qi + 1) && (kp <= qi + 128) && (n > 0 || kp >= 128);
                s[i][r] = valid ? s[i][r] * 0.125f : -INFINITY; m = fmaxf(m, s[i][r]); } }
        m = fmaxf(m, __shfl_xor(m, 16)); m = fmaxf(m, __shfl_xor(m, 32));
        float den = 0.f;
#pragma unroll
        for (int i = 0; i < 10; ++i)
#pragma unroll
            for (int r = 0; r < 4; ++r) { const float e = __expf(s[i][r] - m); s[i][r] = e; den += e; }
        den += __shfl_xor(den, 16); den += __shfl_xor(den, 32); den += __expf(sink - m);
        f32x4 o[4];
#pragma unroll
        for (int dt = 0; dt < 4; ++dt) o[dt] = (f32x4){0.f, 0.f, 0.f, 0.f};
#pragma unroll
        for (int i2 = 0; i2 < 5; ++i2) { const float pv[8] = {s[2 * i2][0], s[2 * i2][1], s[2 * i2][2], s[2 * i2][3], s[2 * i2 + 1][0], s[2 * i2 + 1][1], s[2 * i2 + 1][2], s[2 * i2 + 1][3]};
            const bf16x8_t pb = pack8(pv);
#pragma unroll
            for (int dt = 0; dt < 4; ++dt) o[dt] = __builtin_amdgcn_mfma_f32_16x16x32_bf16(lds_frag(VTp, 264, 16 * dt + fr, 32 * (sg0 + i2) + 8 * fq), pb, o[dt], 0, 0, 0); }
        const float inv = 1.0f / den;
#pragma unroll
        for (int dt = 0; dt < 4; ++dt) { u32x2 w; w.x = pk2(o[dt][0] * inv, o[dt][1] * inv); w.y = pk2(o[dt][2] * inv, o[dt][3] * inv); *(u32x2*)(MIX + tq * 1024 + head * 64 + 16 * dt + 4 * fq) = w; }
    }
}

constexpr size_t WSM_RT = 640 * 1024;
constexpr size_t CTL_WGCNT = 256 * 1024;
__device__ __forceinline__ void split8(const f32x4 a, const f32x4 b, bf16x8_t& hi, bf16x8_t& lo) {
    const float x[8] = {a.x, a.y, a.z, a.w, b.x, b.y, b.z, b.w}; float h[8], l[8];
#pragma unroll
    for (int i = 0; i < 8; ++i) { h[i] = bf2f(f2bf(x[i])); l[i] = x[i] - h[i]; }
    hi = pack8(h); lo = pack8(l);
}
__device__ __forceinline__ void moe_route(const Ctx& c, const Params& p, int layer) {
    const int lane = c.lane, wv = c.wave, fr = lane & 15, fq = lane >> 4;
    LAS float* LG = (LAS float*)c.shm + wv * (16 * 48 + 16);
    LAS float* RS = LG + 16 * 48;
    LAS int* hist = (LAS int*)(c.shm + 32 * 1024);
    if (c.tid < 32) hist[c.tid] = 0;
    __syncthreads();
    const int t0 = blockIdx.x * 128 + wv * 16;
    const bf16_t* xr = (const bf16_t*)(p.ws + OFF_H) + (size_t)(t0 + fr) * 1024 + 8 * fq;
    const bf16_t* TH = (const bf16_t*)(p.ws + OFF_WSMALL + WSM_RT) + (size_t)layer * 2 * 48 * 1024; const bf16_t* TL = TH + 48 * 1024;
    f32x4 acc[3];
#pragma unroll
    for (int i = 0; i < 3; ++i) acc[i] = (f32x4){0.f, 0.f, 0.f, 0.f};
    float ss = 0.f;
    u32x4 xall[32];
#pragma unroll
    for (int kk = 0; kk < 32; ++kk) xall[kk] = *(const u32x4*)(xr + 32 * kk);
    LAS bf16_t* TB = (LAS bf16_t*)(c.shm + 48 * 1024);
    u32x4 tr[3];
#pragma unroll
    for (int i = 0; i < 3; ++i) { const int idx = c.tid + 512 * i, row = idx >> 4, pc = idx & 15; tr[i] = *(const u32x4*)((row < 48 ? TH : TL) + (size_t)(row < 48 ? row : row - 48) * 1024 + 8 * pc); }
#pragma unroll
    for (int i = 0; i < 3; ++i) { const int idx = c.tid + 512 * i, row = idx >> 4, pc = idx & 15; *(LAS u32x4*)(TB + row * 136 + 8 * pc) = tr[i]; }
    __syncthreads();
#pragma unroll
    for (int g = 0; g < 8; ++g) {
        LAS bf16_t* Tb = TB + (g & 1) * (96 * 136);
        if (g + 1 < 8) {
#pragma unroll
            for (int i = 0; i < 3; ++i) { const int idx = c.tid + 512 * i, row = idx >> 4, pc = idx & 15; tr[i] = *(const u32x4*)((row < 48 ? TH : TL) + (size_t)(row < 48 ? row : row - 48) * 1024 + 128 * (g + 1) + 8 * pc); } }
#pragma unroll
        for (int kl = 0; kl < 4; ++kl) { const int kk = 4 * g + kl;
            const u32x4 xw = xall[kk]; const bf16x8_t xh = __builtin_bit_cast(bf16x8_t, xw);
            { const float x0 = bflo(xw.x), x1 = bfhi(xw.x), x2 = bflo(xw.y), x3 = bfhi(xw.y), x4 = bflo(xw.z), x5 = bfhi(xw.z), x6 = bflo(xw.w), x7 = bfhi(xw.w);
              ss += (x0 * x0 + x1 * x1) + (x2 * x2 + x3 * x3) + (x4 * x4 + x5 * x5) + (x6 * x6 + x7 * x7); }
#pragma unroll
            for (int ct = 0; ct < 3; ++ct) { const bf16x8_t wh = lds_frag(Tb, 136, 16 * ct + fr, 32 * kl + 8 * fq), wl = lds_frag(Tb, 136, 48 + 16 * ct + fr, 32 * kl + 8 * fq);
                acc[ct] = __builtin_amdgcn_mfma_f32_16x16x32_bf16(xh, wh, acc[ct], 0, 0, 0); acc[ct] = __builtin_amdgcn_mfma_f32_16x16x32_bf16(xh, wl, acc[ct], 0, 0, 0); } }
        if (g + 1 < 8) {
#pragma unroll
            for (int i = 0; i < 3; ++i) { const int idx = c.tid + 512 * i, row = idx >> 4, pc = idx & 15; *(LAS u32x4*)(TB + ((g + 1) & 1) * (96 * 136) + row * 136 + 8 * pc) = tr[i]; } }
        __syncthreads();
    }
    ss += __shfl_xor(ss, 16); ss += __shfl_xor(ss, 32);
    const float rstd = 1.0f / sqrtf(ss * (1.0f / 1024.0f) + 1e-6f);
    if (fq == 0) RS[fr] = rstd;
    LDS_WAIT();
#pragma unroll
    for (int ct = 0; ct < 3; ++ct)
#pragma unroll
        for (int r = 0; r < 4; ++r) LG[(4 * fq + r) * 48 + 16 * ct + fr] = acc[ct][r] * RS[4 * fq + r];
    LDS_WAIT();
    if (lane < 16) { int e0, e1; float g0, g1; route_row(LG + lane * 48, p.moe_b_group + layer * 4, p.moe_b_expert + layer * 32, e0, e1, g0, g1);
        const int t = t0 + lane; ((float*)(p.ws + OFF_ROUTE + ROUTE_RS))[t] = RS[lane]; ((int2*)(p.ws + OFF_ROUTE))[t] = make_int2(e0, e1); ((float2*)(p.ws + OFF_ROUTE + 256 * 1024))[t] = make_float2(g0, g1);
        atomicAdd((int*)&hist[e0], 1); atomicAdd((int*)&hist[e1], 1); }
    __syncthreads();
    if (c.tid < 32) ((int*)(p.ws + OFF_CTL + CTL_WGCNT))[(layer * 256 + blockIdx.x) * 32 + c.tid] = hist[c.tid];
}
__device__ __forceinline__ void moe_slots2(const Ctx& c, const Params& p, int layer) {
    LAS int* part = (LAS int*)c.shm;
    LAS int* base = part + 1024;
    LAS int* lcnt = base + 32;
    LAS int* posl = lcnt + 32;
    LAS int* pst = posl + 256;
    const int* wc = (const int*)(p.ws + OFF_CTL + CTL_WGCNT) + layer * 256 * 32; const int bid = blockIdx.x;
    __syncthreads();
    { const int e = c.tid & 31, pt = c.tid >> 5; int sa = 0, sb = 0;
      for (int w = pt * 16; w < pt * 16 + 16; ++w) { const int v = wc[w * 32 + e]; sa += v; sb += (w < bid) ? v : 0; }
      part[pt * 32 + e] = sa; part[512 + pt * 32 + e] = sb; }
    if (c.tid < 32) lcnt[c.tid] = 0;
    __syncthreads();
    if (c.tid < 32) { int sa = 0, sb = 0; for (int q = 0; q < 16; ++q) { sa += part[q * 32 + c.tid]; sb += part[512 + q * 32 + c.tid]; } part[c.tid] = sa; part[512 + c.tid] = sb; }
    __syncthreads();
    if (c.tid == 0) { int acc = 0; for (int e = 0; e < NEXP; ++e) { pst[e] = acc; acc += (part[e] + 255) / 256 * 256; } pst[32] = acc; }
    __syncthreads();
    if (c.tid < 32) base[c.tid] = pst[c.tid] + part[512 + c.tid];
    if (bid == 0 && c.tid < NEXP) { int* blk = (int*)(p.ws + OFF_CTL + CTL_BLK) + layer * 1024; const int e = c.tid, s = pst[e] / 256, en = pst[e + 1] / 256; for (int i = s; i < en; ++i) blk[1 + i] = e; if (e == 0) blk[0] = pst[32] / 256; }
    __syncthreads();
    if (c.tid < 256) { const int t = bid * 128 + (c.tid >> 1); const int2 ee = ((const int2*)(p.ws + OFF_ROUTE))[t]; const int e = (c.tid & 1) ? ee.y : ee.x;
        const int rk = atomicAdd((int*)&lcnt[e], 1); posl[c.tid] = base[e] + rk; }
    __syncthreads();
    if (c.tid < 128) ((int2*)(p.ws + OFF_ROUTE + 512 * 1024))[bid * 128 + c.tid] = make_int2(posl[2 * c.tid], posl[2 * c.tid + 1]);
    if (c.tid < 256) ((float*)(p.ws + OFF_R + R_RSS))[posl[c.tid]] = ((const float*)(p.ws + OFF_ROUTE + ROUTE_RS))[bid * 128 + (c.tid >> 1)];
    int* TOK = (int*)(p.ws + OFF_R + R_TOK);
    if (c.tid < 256) TOK[posl[c.tid]] = bid * 128 + (c.tid >> 1);
    if (bid == 0) { for (int e = 0; e < NEXP; ++e) { const int s = pst[e] + part[e], en = pst[e + 1]; for (int i = s + c.tid; i < en; i += 512) TOK[i] = 0; } }
}

constexpr size_t WSM_TGD = 128 * 1024, WSM_GUT = 192 * 1024;
__device__ __forceinline__ void combine_gk(const Ctx& c, const Params& p) {
    const int lane = c.lane, wv = c.wave, fr = lane & 15, fq = lane >> 4;
    LAS float* LG = (LAS float*)c.shm + wv * (16 * 16 + 16);
    LAS float* RS = LG + 256;
    const int t0 = blockIdx.x * 128 + wv * 16; const int trow = t0 + fr;
    bf16_t* hr = (bf16_t*)(p.ws + OFF_H) + (size_t)trow * 1024 + 8 * fq;
    const int2 ps = ((const int2*)(p.ws + OFF_ROUTE + 512 * 1024))[trow]; const float2 gt = ((const float2*)(p.ws + OFF_ROUTE + 256 * 1024))[trow];
    const bf16_t* y0 = (const bf16_t*)(p.ws + OFF_P) + (size_t)ps.x * 1024 + 8 * fq; const bf16_t* y1 = (const bf16_t*)(p.ws + OFF_P) + (size_t)ps.y * 1024 + 8 * fq;
    LAS bf16_t* TGs = (LAS bf16_t*)(c.shm + 16 * 1024);
    LAS bf16_t* GUs = (LAS bf16_t*)(c.shm + 16 * 1024 + 32 * 1032 * 2);
    { const bf16_t* TG = (const bf16_t*)(p.ws + OFF_WSMALL + WSM_TGD); const bf16_t* GU = (const bf16_t*)(p.ws + OFF_WSMALL + WSM_GUT);
      u32x4 tr[12];
#pragma unroll
      for (int i = 0; i < 8; ++i) tr[i] = *((const u32x4*)TG + c.tid + 512 * i);
#pragma unroll
      for (int i = 0; i < 4; ++i) tr[8 + i] = *((const u32x4*)GU + c.tid + 512 * i);
#pragma unroll
      for (int i = 0; i < 8; ++i) { const int idx = c.tid + 512 * i; *(LAS u32x4*)(TGs + (idx >> 7) * 1032 + (idx & 127) * 8) = tr[i]; }
#pragma unroll
      for (int i = 0; i < 4; ++i) *((LAS u32x4*)GUs + c.tid + 512 * i) = tr[8 + i]; }
    __syncthreads();
    f32x4 acc = (f32x4){0.f, 0.f, 0.f, 0.f}; float ss = 0.f;
#pragma unroll 8
    for (int kk = 0; kk < 32; ++kk) {
        const u32x4 xw = *(const u32x4*)(hr + 32 * kk), u0 = *(const u32x4*)(y0 + 32 * kk), u1 = *(const u32x4*)(y1 + 32 * kk);
        f32x4 a, bq;
        a.x = bflo(xw.x) + gt.x * bflo(u0.x) + gt.y * bflo(u1.x); a.y = bfhi(xw.x) + gt.x * bfhi(u0.x) + gt.y * bfhi(u1.x); a.z = bflo(xw.y) + gt.x * bflo(u0.y) + gt.y * bflo(u1.y); a.w = bfhi(xw.y) + gt.x * bfhi(u0.y) + gt.y * bfhi(u1.y);
        bq.x = bflo(xw.z) + gt.x * bflo(u0.z) + gt.y * bflo(u1.z); bq.y = bfhi(xw.z) + gt.x * bfhi(u0.z) + gt.y * bfhi(u1.z); bq.z = bflo(xw.w) + gt.x * bflo(u0.w) + gt.y * bflo(u1.w); bq.w = bfhi(xw.w) + gt.x * bfhi(u0.w) + gt.y * bfhi(u1.w);
        { u32x4 w; w.x = pk2(a.x, a.y); w.y = pk2(a.z, a.w); w.z = pk2(bq.x, bq.y); w.w = pk2(bq.z, bq.w); *(u32x4*)(hr + 32 * kk) = w; }
        ss += (a.x * a.x + a.y * a.y) + (a.z * a.z + a.w * a.w) + (bq.x * bq.x + bq.y * bq.y) + (bq.z * bq.z + bq.w * bq.w);
        bf16x8_t xh, xl; split8(a, bq, xh, xl);
        const bf16x8_t wh = lds_frag(TGs, 1032, fr, 32 * kk + 8 * fq), wl = lds_frag(TGs, 1032, 16 + fr, 32 * kk + 8 * fq);
        acc = __builtin_amdgcn_mfma_f32_16x16x32_bf16(xh, wh, acc, 0, 0, 0); acc = __builtin_amdgcn_mfma_f32_16x16x32_bf16(xh, wl, acc, 0, 0, 0); acc = __builtin_amdgcn_mfma_f32_16x16x32_bf16(xl, wh, acc, 0, 0, 0);
    }
    ss += __shfl_xor(ss, 16); ss += __shfl_xor(ss, 32);
    const float rstd = 1.0f / sqrtf(ss * (1.0f / 1024.0f) + 1e-6f);
    if (fq == 0) { RS[fr] = rstd; ((float*)(p.ws + OFF_ROUTE + ROUTE_RS))[trow] = rstd; }
    LDS_WAIT();
#pragma unroll
    for (int r = 0; r < 4; ++r) LG[(4 * fq + r) * 16 + fr] = acc[r] * RS[4 * fq + r];
    LDS_WAIT();
    bf16x8_t gh = zero_frag(), gl = zero_frag();
    if (fq < 2) { const f32x4 a = *(const LAS f32x4*)(LG + fr * 16 + 8 * fq), bq = *(const LAS f32x4*)(LG + fr * 16 + 8 * fq + 4); split8(a, bq, gh, gl); }
    float* gk = (float*)(p.ws + OFF_R + R_GK) + (size_t)trow * 512 + 4 * fq;
#pragma unroll 4
    for (int ct = 0; ct < 32; ++ct) {
        bf16x8_t uh = zero_frag(), ul = zero_frag();
        if (fq < 2) { uh = lds_frag(GUs, 16, 16 * ct + fr, 8 * fq); ul = lds_frag(GUs, 16, 512 + 16 * ct + fr, 8 * fq); }
        f32x4 g = *(const f32x4*)(p.od_gate_b + 16 * ct + 4 * fq);
        g = __builtin_amdgcn_mfma_f32_16x16x32_bf16(uh, gh, g, 0, 0, 0); g = __builtin_amdgcn_mfma_f32_16x16x32_bf16(uh, gl, g, 0, 0, 0); g = __builtin_amdgcn_mfma_f32_16x16x32_bf16(ul, gh, g, 0, 0, 0);
#pragma unroll
        for (int r = 0; r < 4; ++r) { const float xx = g[r]; g[r] = (fminf(xx, 0.f) - __logf(1.0f + __expf(-fabsf(xx)))) * (1.0f / 16.0f); }
        *(f32x4*)(gk + 16 * ct) = g;
    }
}

constexpr int LDS_BYTES = 160 * 1024 - 64;
constexpr int N_PHASES = 25;

typedef const __attribute__((address_space(4))) Params* KParamsPtr;
__device__ __forceinline__ Params kparams() {
#if defined(__HIP_DEVICE_COMPILE__)
    KParamsPtr k = (KParamsPtr)__builtin_amdgcn_kernarg_segment_ptr(); asm volatile("" : "+s"(k)); return *k;
#else
    return Params{};
#endif
}
__device__ __forceinline__ Ctx mkctx(unsigned char* shm) {
    int tz = threadIdx.x; asm volatile("" : "+v"(tz));
    Ctx c; c.tid = tz; c.wave = __builtin_amdgcn_readfirstlane(tz >> 6); c.lane = tz & 63; c.gw = blockIdx.x * 8 + c.wave; c.ngw = 2048; c.shm = shm; return c;
}
__global__ void __launch_bounds__(512, 2) hybrid_fwd(Params p_in) {
    extern __shared__ __attribute__((aligned(16))) unsigned char shm[];
    constexpr int G = 256; const int bid = blockIdx.x;
    uint4* xbw = (uint4*)(shm + LDS_BYTES - 16);
    if (threadIdx.x == 0) *xbw = make_uint4(0u, 0u, 0u, 0u);
    __syncthreads();
    XcdBarrier bar = xcd_barrier_post((unsigned*)(kparams().ws + OFF_CTL), (volatile LAS unsigned*)xbw);
#ifndef KEEPMASK
#define KEEPMASK 0xFFFFFFFFu
#endif
#define INS(k, s) (((KEEPMASK) >> (s)) & 1u)
#ifndef REPMASK
#define REPMASK 0u
#endif
#define REP(s) ((((REPMASK) >> (s)) & 1u) ? 3 : 1)
#define SEAM(k) do { XcdBarrier b2 = bar; b2.bar = (unsigned*)(kparams().ws + OFF_CTL); xcd_barrier(b2); } while (0)
#define PHASE_BEGIN const Params p = kparams(); const Ctx c = mkctx(shm); unsigned char* const ws = p.ws; (void)c; (void)ws;
#define glds ((PG8_LAS unsigned char*)shm)
#define WD ((bf16_t*)(ws + OFF_WD))
#define H ((bf16_t*)(ws + OFF_H))
#define P ((bf16_t*)(ws + OFF_P))
#define WS_F ((float*)(ws + OFF_WSMALL))
#define RE ((int2*)(ws + OFF_ROUTE))
#define RG ((float2*)(ws + OFF_ROUTE + 256 * 1024))
#define RP ((int2*)(ws + OFF_ROUTE + 512 * 1024))

    for (int layer = 0; layer < 2; ++layer) {
        const int pb = layer * 12;
        if (layer == 0) {
            if (INS(0, 0)) for (int rep_ = 0; rep_ < REP(0); ++rep_) { PHASE_BEGIN
                if (bid < 160) { Ctx c2 = c; c2.ngw = 160 * 8; norm_plain(c2, p.x, p.norm_mix, H, T_TOK); }
                else {
                Ctx c2 = c; c2.gw = (bid - 160) * 8 + c.wave; c2.ngw = 96 * 8; const int bid2 = bid - 160; constexpr int G2 = 96;
                tr_matrix(c2, p.ev_w_in, EV_IN, 0, 1024, EV_IN, WD + WE_EV_IN, 0, 0);
                tr_matrix(c2, p.ev_w_out, 1024, 0, 1024, 1024, WD + WE_EV_OUT, 0, 0);
                tr_matrix(c2, p.od_w_in, OD_IN_SRC, 0, 1024, OD_IN, WD + WE_OD_IN, 0, 1, p.norm_mix + 1024);
                tr_matrix(c2, p.od_w_out, 1024, 0, 1024, 1024, WD + WE_OD_OUT, 0, 0);
                tr_matrix(c2, p.mem_wk, 512, 0, 1024, 512, WD + WE_MKV, 0, 0);
                tr_matrix(c2, p.mem_wv, 512, 0, 1024, 512, WD + WE_MKV, 512, 0);
                for (int l = 0; l < 2; ++l) {
                    tr_matrix(c2, p.xa_wq + (size_t)l * 1024 * 512, 512, 0, 1024, 512, WD + WE_WQ + (size_t)l * 512 * 1024, 0, 0, p.norm_xattn + l * 1024);
                    tr_matrix(c2, p.xa_wo + (size_t)l * 512 * 1024, 1024, 0, 512, 1024, WD + WE_WO + (size_t)l * 1024 * 512, 0, 0);
                }
                for (int i = bid2 * 512 + c.tid; i < 16 * 1024 + 512 * 16; i += G2 * 512) {
                    if (i < 16 * 1024) { const int o = i >> 10, k = i & 1023; const float w = p.od_w_in[(size_t)k * OD_IN_SRC + 2048 + o] * p.norm_mix[1024 + k]; const unsigned hb = f2bf(w);
                        bf16_t* T = (bf16_t*)(ws + OFF_WSMALL + WSM_TGD); T[i] = (bf16_t)hb; T[16 * 1024 + i] = (bf16_t)f2bf(w - bf2f(hb)); }
                    else { const int r = i - 16 * 1024, ch = r >> 4, o = r & 15; const float w = p.od_gate_up[o * 512 + ch]; const unsigned hb = f2bf(w);
                        bf16_t* T = (bf16_t*)(ws + OFF_WSMALL + WSM_GUT); T[r] = (bf16_t)hb; T[512 * 16 + r] = (bf16_t)f2bf(w - bf2f(hb)); } }
                for (int i = bid2 * 512 + c.tid; i < 2 * 48 * 1024; i += G2 * 512) { const int l = i / (48 * 1024), r = i % (48 * 1024), o = r >> 10, k = r & 1023;
                    float w = 0.f; if (o < 4) w = p.moe_w_group[((size_t)l * 1024 + k) * 4 + o]; else if (o < 36) w = p.moe_w_expert[((size_t)l * 1024 + k) * 32 + (o - 4)];
                    w *= p.norm_moe[l * 1024 + k]; const unsigned hb = f2bf(w); bf16_t* T = (bf16_t*)(ws + OFF_WSMALL + WSM_RT) + (size_t)l * 2 * 48 * 1024;
                    T[r] = (bf16_t)hb; T[48 * 1024 + r] = (bf16_t)f2bf(w - bf2f(hb)); }
                for (int i = bid2 * 512 + c.tid; i < 2 * 512 * 64; i += G2 * 512) { const int wh = i >> 15, r = i & 32767, ch = r >> 6, k = r & 63;
                    ((bf16_t*)(ws + OFF_WSMALL + (wh ? WSM_A2T : WSM_W2T)))[r] = (bf16_t)f2bf((wh ? p.ev_a2 : p.ev_w2)[(size_t)k * 512 + ch]); }
                norm_plain(c2, p.mem, p.mem_norm, (bf16_t*)(ws + OFF_R + R_MEMN), NB * MEMLEN);
                for (int i = bid2 * 512 + c.tid; i < 512 * 128; i += G2 * 512) { const int ch = i >> 7, m = i & 127; ((bf16_t*)(ws + OFF_WSMALL + WSM_G2T))[i] = (bf16_t)f2bf(p.ev_g2[(size_t)m * 512 + ch]); }
                }
                __syncthreads();
                SEAM(0);
            }
            if (INS(1, 1)) for (int rep_ = 0; rep_ < REP(1); ++rep_) { PHASE_BEGIN
                { pg8::Gemm g{H, WD + WE_EV_IN, T_TOK, EV_IN, 1024, 0}; pg8::StaticOrder S; S.init(T_TOK, EV_IN, G, bid);
                  pg8::EpiB16 E{P, EV_IN, nullptr}; pg8::gemm_phase<pg8::EpiB16, pg8::StaticOrder, true, true>(glds, g, S, E); }
                SEAM(1);
            }
            if (INS(2, 2)) for (int rep_ = 0; rep_ < REP(2); ++rep_) { PHASE_BEGIN
#ifdef RWKV_NAIVE
                if (bid < 64) rwkv_naive(c, p, bid);
                else
#else
                {
                    RxPre pre; const int bh0 = bid >> 2, b0 = bh0 >> 3, hd0 = bh0 & 7, ck0 = (bid & 3) * 16;
                    rwkv_x_fetch(pre, (const bf16_t*)(ws + OFF_P), b0, hd0, ck0, c.tid, c.lane, c.wave);
                    RxW kw; rwkv_x_weights(kw, p, hd0, c.lane, c.wave);
                    {
                        LAS float* CTw = (LAS float*)(shm + X_RED + 4096); const int i = c.tid;
                        if (i < 128) CTw[i] = p.ev_mu[1536 + i];
                        else if (i < 320) { const int r = i - 128; CTw[i] = p.ev_mu[512 * (r >> 6) + hd0 * 64 + (r & 63)]; }
                        else if (i < 640) { const int r = i - 320, w = r >> 6, ch = hd0 * 64 + (r & 63); CTw[i] = (w == 0 ? p.ev_w0 : w == 1 ? p.ev_a0 : w == 2 ? p.ev_k_k : w == 3 ? p.ev_k_a : p.ev_r_k)[ch]; }
                        if (i < 128) CTw[512 + i] = (i < 64 ? p.ev_k_a : p.ev_r_k)[hd0 * 64 + (i & 63)];
                    }
#pragma unroll 1
                    for (int i = 0; i < 16; ++i) rwkv_x(c, p, bid * 16 + i, pre, kw, b0, hd0, i + 1 < 16 ? ck0 + i + 1 : -1);
                }
                __syncthreads();
                SEAM(2);
            }
            if (INS(2, 16)) for (int rep_ = 0; rep_ < REP(16); ++rep_) { PHASE_BEGIN
                if (bid < 64) { rwkv_y(c, p, bid); __syncthreads(); tr_moe_layer_w(c, p, 0, 1280 + bid * 8 + c.wave, 1792); }
                else
#endif
                {
                    for (int u = bid - 64; u < 512; u += G - 64) swa_mfma(c, p, u);
                    __syncthreads();
                    if (bid >= 96) tr_moe_layer_w(c, p, 0, (bid - 96) * 8 + c.wave, 1792);
                    if (bid < 96) {
                        pg8::Gemm g{(const bf16_t*)(ws + OFF_R + R_MEMN), WD + WE_MKV, NB * MEMLEN, 1024, 1024, 0}; pg8::StaticOrder S; S.init(NB * MEMLEN, 1024, 32, bid - 64);
                        pg8::EpiB16 E{(bf16_t*)(ws + OFF_MKV), 1024, nullptr}; pg8::gemm_phase<pg8::EpiB16, pg8::StaticOrder, true, true>(glds, g, S, E); }
                }
#ifndef RWKV_NAIVE
                __syncthreads();
                SEAM(2);
            }
            if (INS(2, 17)) for (int rep_ = 0; rep_ < REP(17); ++rep_) { PHASE_BEGIN
                {
                    const bf16_t* G2T = (const bf16_t*)(ws + OFF_WSMALL + WSM_G2T) + (size_t)((bid >> 3) & 7) * 64 * 128;
                    const u32x4 g0 = *((const u32x4*)G2T + c.tid), g1 = *((const u32x4*)G2T + 512 + c.tid);
                    __syncthreads();
                    *(LAS u32x4*)((LAS bf16_t*)shm + (c.tid >> 4) * 136 + (c.tid & 15) * 8) = g0; *(LAS u32x4*)((LAS bf16_t*)shm + ((c.tid + 512) >> 4) * 136 + (c.tid & 15) * 8) = g1;
                    __syncthreads();
                }
                for (int u = c.gw; u < 4096; u += c.ngw) rwkv_z(c, p, u);
#endif
                __syncthreads();
                SEAM(2);
            }
        } else {
            if (INS(12, 12)) for (int rep_ = 0; rep_ < REP(12); ++rep_) { PHASE_BEGIN
                combine_gk(c, p);
                __syncthreads();
                SEAM(12);
            }
            if (INS(13, 13)) for (int rep_ = 0; rep_ < REP(13); ++rep_) { PHASE_BEGIN
                pg8::Gemm g{H, WD + WE_OD_IN, T_TOK, OD_IN, 1024, 0}; pg8::StaticOrder S; S.init(T_TOK, OD_IN, G, bid);
                pg8::EpiB16 E{P, OD_IN, (const float*)(ws + OFF_ROUTE + ROUTE_RS)};   pg8::gemm_phase<pg8::EpiB16, pg8::StaticOrder, true, true>(glds, g, S, E);
                SEAM(13);
            }
            if (INS(14, 14)) for (int rep_ = 0; rep_ < REP(14); ++rep_) { PHASE_BEGIN
#ifdef GLA_NAIVE
                if (bid < 32) gla_naive(c, p, bid);
                __syncthreads();
                SEAM(14);
#else
                for (int u = bid; u < 2048; u += G) gla_prep(c, p, u);
                __syncthreads();
                SEAM(14);
#endif
            }
#ifndef GLA_NAIVE
            if (INS(14, 18)) for (int rep_ = 0; rep_ < REP(18); ++rep_) { PHASE_BEGIN
                if (bid < 128) gla_state(c, p, bid >> 2, bid & 3);
                else tr_moe_layer(c, p, 1, 128 * 8, 128 * 8);
                __syncthreads();
                SEAM(14);
            }
            if (INS(14, 19)) for (int rep_ = 0; rep_ < REP(19); ++rep_) { PHASE_BEGIN
                gla_finish(c, p);
                __syncthreads();
                SEAM(14);
            }
#endif
        }
        if (INS(pb + 3, 3)) for (int rep_ = 0; rep_ < REP(3); ++rep_) { PHASE_BEGIN
            pg8::Gemm g{(const bf16_t*)p.out, WD + (layer == 0 ? WE_EV_OUT : WE_OD_OUT), T_TOK, 1024, 1024, 0}; pg8::StaticOrder S; S.init(T_TOK, 1024, G, bid);
            pg8::EpiRes E{layer == 0 ? p.x : nullptr, H, 1024, (float*)(ws + OFF_R + R_SSP)};     pg8::gemm_phase<pg8::EpiRes, pg8::StaticOrder, true, true>(glds, g, S, E);
            SEAM(pb + 3);
        }
        if (INS(pb + 5, 5)) for (int rep_ = 0; rep_ < REP(5); ++rep_) { PHASE_BEGIN
            pg8::Gemm g{H, WD + WE_WQ + (size_t)layer * 512 * 1024, T_TOK, 512, 1024, 0}; pg8::StaticOrder S; S.init(T_TOK, 512, G, bid);
            pg8::EpiB16 E{P, 512, nullptr}; pg8::gemm_phase<pg8::EpiB16, pg8::StaticOrder, true, true>(glds, g, S, E);
            SEAM(pb + 5);
        }
        if (INS(pb + 6, 6)) for (int rep_ = 0; rep_ < REP(6); ++rep_) { PHASE_BEGIN for (int u = bid; u < 256; u += G) xattn_mfma(c, p, u); __syncthreads(); SEAM(pb + 6); }
        if (INS(pb + 7, 7)) for (int rep_ = 0; rep_ < REP(7); ++rep_) { PHASE_BEGIN
            pg8::Gemm g{(const bf16_t*)(ws + OFF_P + 32 * MiB), WD + WE_WO + (size_t)layer * 1024 * 512, T_TOK, 1024, 512, 0}; pg8::StaticOrder S; S.init(T_TOK, 1024, G, bid);
            pg8::EpiRes E{nullptr, H, 1024, nullptr}; pg8::gemm_phase<pg8::EpiRes, pg8::StaticOrder, true, true>(glds, g, S, E);
            SEAM(pb + 7);
        }
        if (INS(pb + 8, 8)) for (int rep_ = 0; rep_ < REP(8); ++rep_) { PHASE_BEGIN
            moe_route(c, p, layer);
            __syncthreads();
            SEAM(pb + 8);
        }
        if (INS(pb + 9, 9)) for (int rep_ = 0; rep_ < REP(9); ++rep_) { PHASE_BEGIN moe_slots2(c, p, layer); __syncthreads(); SEAM(pb + 9); }
        if (INS(pb + 10, 10)) for (int rep_ = 0; rep_ < REP(10); ++rep_) { PHASE_BEGIN
            const int* blk = (const int*)(ws + OFF_CTL + CTL_BLK) + layer * 1024; const int nblk = blk[0];
            pg8::Gemm g{H, (const bf16_t*)(ws + OFF_WMOE), nblk * 256, 1024, 1024, (size_t)1024 * 1024 * 2}; pg8::MoeOrder S{blk + 1, nblk * 4, 4, G, bid, (const int*)(ws + OFF_R + R_TOK)};
            pg8::EpiSwiglu E{(bf16_t*)(ws + OFF_R), 512, (const float*)(ws + OFF_R + R_RSS)}; pg8::gemm_phase<pg8::EpiSwiglu, pg8::MoeOrder, true, true>(glds, g, S, E);
            SEAM(pb + 10);
        }
        if (INS(pb + 11, 11)) for (int rep_ = 0; rep_ < REP(11); ++rep_) { PHASE_BEGIN
            const int* blk = (const int*)(ws + OFF_CTL + CTL_BLK) + layer * 1024; const int nblk = blk[0];
            pg8::Gemm g{(const bf16_t*)(ws + OFF_R), (const bf16_t*)(ws + OFF_WMOE + 64 * MiB), nblk * 256, 1024, 512, (size_t)1024 * 512 * 2}; pg8::MoeOrder S{blk + 1, nblk * 4, 4, G, bid, nullptr};
            pg8::EpiB16 E{P, 1024, nullptr}; pg8::gemm_phase<pg8::EpiB16, pg8::MoeOrder, true, true>(glds, g, S, E);
            SEAM(pb + 11);
        }
    }
    if (INS(24, 15)) for (int rep_ = 0; rep_ < REP(15); ++rep_) { PHASE_BEGIN
        for (int r0 = c.gw; r0 < T_TOK; r0 += 4 * c.ngw) {
            f32x4 v[4][4]; int2 ps[4]; float2 gt[4];
#pragma unroll
            for (int q = 0; q < 4; ++q) { const int r = r0 + q * c.ngw; ps[q] = RP[r]; gt[q] = RG[r];
#pragma unroll
                for (int j = 0; j < 4; ++j) { const u32x2 w = *((const u32x2*)(H + (size_t)r * 1024) + c.lane + 64 * j); v[q][j] = (f32x4){bflo(w.x), bfhi(w.x), bflo(w.y), bfhi(w.y)}; } }
#pragma unroll
            for (int q = 0; q < 4; ++q) row_combine(v[q], P, ps[q].x, ps[q].y, gt[q].x, gt[q].y, c.lane);
#pragma unroll
            for (int q = 0; q < 4; ++q) { const int r = r0 + q * c.ngw; const float rs = row_rstd(v[q]); row_scale(v[q], rs, p.norm_final, c.lane); row_store_f32(p.out + (size_t)r * 1024, c.lane, v[q]); }
        }
    }
}

extern "C" void kernel_launch(void* const* d_in, const int* in_sizes, int n_in, void* d_out, int out_size, void* d_ws, size_t ws_size, hipStream_t stream) {
    static int ready = 0;
    if (ready == 0) {
        if (n_in != 37 || out_size != T_TOK * DM || ws_size < WS_NEED) { fprintf(stderr, "kernel_launch: unexpected problem (n_in %d, out %d, ws %zu)\n", n_in, out_size, ws_size); ready = -1; return; }
        if (hipFuncSetAttribute((const void*)hybrid_fwd, hipFuncAttributeMaxDynamicSharedMemorySize, LDS_BYTES) != hipSuccess) { fprintf(stderr, "kernel_launch: hipFuncSetAttribute failed\n"); ready = -1; return; }
        ready = 1;
    }
    if (ready < 0) return;
    hipMemsetAsync((char*)d_ws + OFF_CTL, 0, CTL_ZERO_BYTES, stream);
    Params p{};
    const float** f = (const float**)&p;
    for (int i = 0; i < 37; ++i) f[i] = (const float*)d_in[i];
    p.out = (float*)d_out; p.ws = (unsigned char*)d_ws; p.ph_lo = 0; p.ph_hi = N_PHASES;
    hipLaunchKernelGGL(hybrid_fwd, dim3(256), dim3(512), LDS_BYTES, stream, p);
}
```

```cpp
#include <hip/hip_runtime.h>
#include <cstdint>
#include <cstdio>

#define LAS __attribute__((address_space(3)))
typedef unsigned short bf16_t;
typedef float f32x4 __attribute__((ext_vector_type(4)));
typedef float f32x2 __attribute__((ext_vector_type(2)));
typedef unsigned u32x4 __attribute__((ext_vector_type(4)));
typedef unsigned u32x2 __attribute__((ext_vector_type(2)));

constexpr int T_TOK = 32768, DM = 1024, SEQ = 4096, NB = 8, MEMLEN = 256;
constexpr int EV_IN = 2560, OD_IN = 3072  , OD_IN_SRC = 3088;
constexpr int NEXP = 32, MOE_FF = 512, PMAX = 65536 + NEXP * 256;

constexpr size_t MiB = 1024 * 1024;
constexpr size_t OFF_CTL = 0;
constexpr size_t CTL_ZERO_BYTES = 64 * 1024;
constexpr size_t CTL_CNT = 16384;
constexpr size_t CTL_CUR = 16384 + 1024;
constexpr size_t CTL_BLK = 128 * 1024;
constexpr size_t OFF_ROUTE = 1 * MiB;
constexpr size_t OFF_WSMALL = 2 * MiB;
constexpr size_t OFF_MKV = 3 * MiB;
constexpr size_t OFF_WD = 7 * MiB;
constexpr size_t OFF_WMOE = 28 * MiB;
constexpr size_t OFF_H = 124 * MiB;
constexpr size_t OFF_P = 188 * MiB;
constexpr size_t OFF_R = 380 * MiB;
constexpr size_t WS_NEED = 552 * MiB;
constexpr size_t WE_EV_IN = 0, WE_EV_OUT = 2560ull * 1024, WE_OD_IN = 3584ull * 1024, WE_OD_OUT = 6656ull * 1024, WE_MKV = 7680ull * 1024, WE_WQ = 8704ull * 1024, WE_WO = 9728ull * 1024;

constexpr size_t ROUTE_RS = 768 * 1024;
constexpr size_t R_TOK = 81 * MiB;
constexpr size_t R_SSP = 0, R_RSS = 80 * MiB;
constexpr size_t P_XB1 = 64 * MiB;
struct Params {
    const float *x, *mem, *norm_mix, *norm_xattn, *norm_moe, *norm_final;
    const float *ev_w_in, *ev_sinks, *ev_mu, *ev_w0, *ev_w2, *ev_a0, *ev_a2, *ev_g2, *ev_k_k, *ev_k_a, *ev_r_k, *ev_lnx_w, *ev_lnx_b, *ev_w_out;
    const float *od_w_in, *od_gate_up, *od_gate_b, *od_onorm, *od_w_out;
    const float *mem_norm, *mem_wk, *mem_wv, *xa_wq, *xa_wo;
    const float *moe_w_group, *moe_b_group, *moe_w_expert, *moe_b_expert, *moe_w1, *moe_w3, *moe_w2;
    float* out; unsigned char* ws; int ph_lo, ph_hi;
};

#define XB_TMO      128
#define XB_XCNT(j)  (256  + 64 * (j))
#define XB_XSUB(j)  (1280 + 64 * (j))
#define XB_XGEN(j)  (2304 + 64 * (j))
#define XB_TOP      3328
#define XB_TOPGEN   3392
#define XCD_BAR_WORDS 3456
#define XB_SPIN_CAP (1u << 18)
#define LAS __attribute__((address_space(3)))

__device__ __forceinline__ unsigned xb_ld(unsigned* p)              { return __hip_atomic_load(p, __ATOMIC_RELAXED, __HIP_MEMORY_SCOPE_AGENT); }
__device__ __forceinline__ unsigned xb_add(unsigned* p, unsigned v) { return __hip_atomic_fetch_add(p, v, __ATOMIC_RELAXED, __HIP_MEMORY_SCOPE_AGENT); }
__device__ __forceinline__ unsigned xb_xcc_id() { return (unsigned)__builtin_amdgcn_s_getreg((3 << 11) | 20) & 0xFu; }
#define XB_SPIN(cond, bar) do { unsigned _sp = 0; while (cond) { __builtin_amdgcn_s_sleep(1); \
    if ((++_sp & 255u) == 0u) { if (xb_ld(&(bar)[XB_TMO])) break; if (_sp > XB_SPIN_CAP) { atomicAdd(&(bar)[XB_TMO], 1u); break; } } } } while (0)

struct XcdBarrier {
    unsigned* bar; unsigned x;
    volatile LAS unsigned* st;
};

__device__ __forceinline__ XcdBarrier xcd_barrier_post(unsigned* bar, volatile LAS unsigned* st) {
    XcdBarrier b; b.bar = bar; b.x = xb_xcc_id(); b.st = st;
    if (threadIdx.x == 0) (void)xb_add(&bar[XB_XCNT(b.x)], 1u);
    return b;
}
__device__ __forceinline__ void xcd_barrier_complete(unsigned* bar, unsigned x, unsigned& nloc, unsigned& nx) {
    const unsigned G = gridDim.x * gridDim.y * gridDim.z;
    unsigned sum, cnt, mine, sp = 0u;
    for (;;) {
        sum = 0u; cnt = 0u; mine = 0u;
#pragma unroll
        for (unsigned j = 0; j < 16; ++j) { const unsigned c = xb_ld(&bar[XB_XCNT(j)]); sum += c; cnt += (c > 0u) ? 1u : 0u; mine = (j == x) ? c : mine; }
        if (sum == G) break;
        __builtin_amdgcn_s_sleep(1);
        if ((++sp & 255u) == 0u) { if (xb_ld(&bar[XB_TMO])) break; if (sp > XB_SPIN_CAP) { atomicAdd(&bar[XB_TMO], 1u); break; } }
    }
    nloc = mine > 0u ? mine : 1u; nx = cnt > 0u ? cnt : 1u;
}

__device__ __forceinline__ void xcd_barrier(const XcdBarrier& b, bool lead) {
    asm volatile("s_waitcnt vmcnt(0)" ::: "memory");
    __syncthreads();
    if (lead) {
        unsigned* bar = b.bar;
        __builtin_amdgcn_s_waitcnt(0);
        unsigned nloc = b.st[0], nx = b.st[1];
        if (nloc == 0u) { xcd_barrier_complete(bar, b.x, nloc, nx); b.st[0] = nloc; b.st[1] = nx; }
        const unsigned old = xb_add(&bar[XB_XSUB(b.x)], 1u);
        const unsigned gen = old / nloc;
        if (old + 1u == (gen + 1u) * nloc) {
            __builtin_amdgcn_fence(__ATOMIC_RELEASE, "agent");
            asm volatile("s_waitcnt vmcnt(0)" ::: "memory");
            const unsigned og = xb_add(&bar[XB_TOP], 1u);
            const unsigned tg = og / nx;
            if (og + 1u == (tg + 1u) * nx) xb_add(&bar[XB_TOPGEN], 1u);
            else XB_SPIN(xb_ld(&bar[XB_TOPGEN]) == tg, bar);
            __builtin_amdgcn_fence(__ATOMIC_ACQUIRE, "agent");
            xb_add(&bar[XB_XGEN(b.x)], 1u);
            asm volatile("s_waitcnt vmcnt(0)" ::: "memory");
        } else {
            XB_SPIN(xb_ld(&bar[XB_XGEN(b.x)]) == gen, bar);
            __builtin_amdgcn_fence(__ATOMIC_ACQUIRE, "agent");
            asm volatile("s_waitcnt vmcnt(0)" ::: "memory");
        }
    }
    __syncthreads();
}
namespace pg8 {
#define PG8_LAS __attribute__((address_space(3)))
typedef unsigned short bf16_t;
typedef short bf16x8 __attribute__((ext_vector_type(8)));
typedef float f32x4 __attribute__((ext_vector_type(4)));
typedef unsigned u32x4 __attribute__((ext_vector_type(4)));
constexpr int BM = 256, BK = 64, HALF = 128, HTB = HALF * BK * 2  , STAGE_BYTES = 8 * HTB, NXCD = 8, WGM = 8;

__host__ __device__ __forceinline__ int lds_byte(int r, int c) { const int st = (r >> 4) * 2 + (c >> 5), rr = r & 15, cc = c & 31, ob = rr * 64 + cc * 2; return st * 1024 + (ob ^ (((ob >> 9) & 1) << 5)); }
__host__ __device__ __forceinline__ void stage_rc(int b, int& R, int& C) { const int st = b / 1024, sb = b % 1024, swz = sb ^ (((sb >> 9) & 1) << 5); R = (st >> 1) * 16 + swz / 64; C = (st & 1) * 32 + (swz % 64) / 2; }
__host__ __device__ __forceinline__ int perm32(int rho) { const int n = rho >> 4, i = rho & 15; return 8 * (i >> 2) + 4 * n + (i & 3); }

struct Unit { int pm, pn, e; };
struct Gemm { const bf16_t* A; const bf16_t* Bt; int M, N, K; size_t bexp; };

struct StaticOrder {
    int nM, nN, nwg, G, c;
    __host__ __device__ void init(int M, int N, int G_, int c_) { nM = M / BM; nN = N / BM; nwg = nM * nN; G = G_; c = c_; }
    __host__ __device__ bool next(int i, Unit& u) const {
        const long L = (long)i * G + c; if (L >= nwg) return false;
        int wgid = (int)L; { const int q = nwg / NXCD, r = nwg % NXCD, xcd = wgid % NXCD, off = wgid / NXCD; wgid = (xcd < r ? xcd * (q + 1) : r * (q + 1) + (xcd - r) * q) + off; }
        const int nig = WGM * nN, gid = wgid / nig, fm = gid * WGM, gsz = (nM - fm) < WGM ? (nM - fm) : WGM;
        u.pm = fm + ((wgid % nig) % gsz); u.pn = (wgid % nig) / gsz; u.e = 0; return true;
    }
    __device__ __forceinline__ int arow(const Unit& u, int r) const { return u.pm * BM + r; }
    __device__ __forceinline__ void a_ready(const Unit&) const {}
    __device__ __forceinline__ void done(const Unit&) const {}
};
typedef __bf16 bf16x2_c __attribute__((ext_vector_type(2))); typedef float f32x2_c __attribute__((ext_vector_type(2)));
__device__ __forceinline__ unsigned cvt_pk_bf16(float lo, float hi) { const f32x2_c v = {lo, hi}; return __builtin_bit_cast(unsigned, __builtin_convertvector(v, bf16x2_c)); }

struct EpiB16 {
    static constexpr bool PERM = true, AFTER_DRAIN = false;
    bf16_t* O; int ldc; const float* rs;
    __device__ __forceinline__ void operator()(const f32x4 (&acc)[2][2][4][2], const Unit& u, int wr, int wc, int fr, int fq) const {
        const int row0 = u.pm * BM + wr * 64 + fr, col0 = u.pn * BM + wc * 32 + 8 * fq;
        float r1v[2][4];
#pragma unroll
        for (int ai = 0; ai < 2; ++ai)
#pragma unroll
            for (int m = 0; m < 4; ++m) r1v[ai][m] = rs ? rs[row0 + ai * HALF + m * 16] : 1.0f;
#pragma unroll
        for (int ai = 0; ai < 2; ++ai)
#pragma unroll
            for (int m = 0; m < 4; ++m) { bf16_t* rowp = O + (size_t)(row0 + ai * HALF + m * 16) * ldc + col0; const float r1 = r1v[ai][m];
#pragma unroll
                for (int bj = 0; bj < 2; ++bj) { const f32x4 v0 = acc[ai][bj][m][0] * r1, v1 = acc[ai][bj][m][1] * r1;
                    u32x4 w; w.x = cvt_pk_bf16(v0[0], v0[1]); w.y = cvt_pk_bf16(v0[2], v0[3]); w.z = cvt_pk_bf16(v1[0], v1[1]); w.w = cvt_pk_bf16(v1[2], v1[3]);
                    *(u32x4*)(rowp + bj * HALF) = w; } }
    }
};
struct EpiRes {
    static constexpr bool PERM = true, AFTER_DRAIN = false;
    const float* base32; bf16_t* X; int ldc; float* ssp;
    __device__ __forceinline__ void operator()(const f32x4 (&acc)[2][2][4][2], const Unit& u, int wr, int wc, int fr, int fq) const {
        const int row0 = u.pm * BM + wr * 64 + fr, col0 = u.pn * BM + wc * 32 + 8 * fq;
#pragma unroll
        for (int ai = 0; ai < 2; ++ai) {
            f32x4 bs[4][2][2];
            if (base32) {
#pragma unroll
                for (int m = 0; m < 4; ++m) { const size_t off = (size_t)(row0 + ai * HALF + m * 16) * ldc + col0;
#pragma unroll
                    for (int bj = 0; bj < 2; ++bj)
#pragma unroll
                        for (int n = 0; n < 2; ++n) bs[m][bj][n] = *(const f32x4*)(base32 + off + bj * HALF + 4 * n); }
            } else {
                u32x4 rb[4][2];
#pragma unroll
                for (int m = 0; m < 4; ++m) { const size_t off = (size_t)(row0 + ai * HALF + m * 16) * ldc + col0;
#pragma unroll
                    for (int bj = 0; bj < 2; ++bj) rb[m][bj] = *(const u32x4*)(X + off + bj * HALF); }
#pragma unroll
                for (int m = 0; m < 4; ++m)
#pragma unroll
                    for (int bj = 0; bj < 2; ++bj) { const u32x4 w = rb[m][bj];
                        bs[m][bj][0] = (f32x4){__uint_as_float(w.x << 16), __uint_as_float(w.x & 0xFFFF0000u), __uint_as_float(w.y << 16), __uint_as_float(w.y & 0xFFFF0000u)};
                        bs[m][bj][1] = (f32x4){__uint_as_float(w.z << 16), __uint_as_float(w.z & 0xFFFF0000u), __uint_as_float(w.w << 16), __uint_as_float(w.w & 0xFFFF0000u)}; }
            }
#pragma unroll
            for (int m = 0; m < 4; ++m) { const int row = row0 + ai * HALF + m * 16; const size_t off = (size_t)row * ldc + col0; float ss = 0.f;
#pragma unroll
                for (int bj = 0; bj < 2; ++bj) { const f32x4 o0 = bs[m][bj][0] + acc[ai][bj][m][0], o1 = bs[m][bj][1] + acc[ai][bj][m][1];
                    u32x4 w; w.x = cvt_pk_bf16(o0[0], o0[1]); w.y = cvt_pk_bf16(o0[2], o0[3]); w.z = cvt_pk_bf16(o1[0], o1[1]); w.w = cvt_pk_bf16(o1[2], o1[3]);
                    *(u32x4*)(X + off + bj * HALF) = w;
                    ss += ((o0[0] * o0[0] + o0[1] * o0[1]) + (o0[2] * o0[2] + o0[3] * o0[3])) + ((o1[0] * o1[0] + o1[1] * o1[1]) + (o1[2] * o1[2] + o1[3] * o1[3])); }
                if (ssp) { ss += __shfl_xor(ss, 16); ss += __shfl_xor(ss, 32); if (fq == 0) ssp[(size_t)row * 16 + 4 * u.pn + wc] = ss; } }
        }
    }
};
struct EpiSwiglu {
    static constexpr bool PERM = true, AFTER_DRAIN = false;
    bf16_t* O; int ldc; const float* rs;
    __device__ __forceinline__ void operator()(const f32x4 (&acc)[2][2][4][2], const Unit& u, int wr, int wc, int fr, int fq) const {
        const int row0 = u.pm * BM + wr * 64 + fr, col0 = (u.pn * BM + wc * 32 + 8 * fq) >> 1;
        typedef unsigned u32x2v __attribute__((ext_vector_type(2)));
        float r1v[2][4];
#pragma unroll
        for (int ai = 0; ai < 2; ++ai)
#pragma unroll
            for (int m = 0; m < 4; ++m) r1v[ai][m] = rs[row0 + ai * HALF + m * 16];
#pragma unroll
        for (int ai = 0; ai < 2; ++ai)
#pragma unroll
            for (int m = 0; m < 4; ++m) { bf16_t* rowp = O + (size_t)(row0 + ai * HALF + m * 16) * ldc + col0; const float r1 = r1v[ai][m];
#pragma unroll
                for (int bj = 0; bj < 2; ++bj) { const f32x4 a = acc[ai][bj][m][0] * r1, b = acc[ai][bj][m][1] * r1; float h[4];
#pragma unroll
                    for (int i = 0; i < 4; ++i) h[i] = a[i] * __builtin_amdgcn_rcpf(1.0f + __expf(-a[i])) * b[i];
                    u32x2v w; w.x = cvt_pk_bf16(h[0], h[1]); w.y = cvt_pk_bf16(h[2], h[3]);
                    *(u32x2v*)(rowp + bj * (HALF / 2)) = w; } }
    }
};
struct MoeOrder {
    const int* blk_e; int nunits, nN, G, c; const int* tok;
    __device__ __forceinline__ bool next(int i, Unit& u) const {
        const long L = (long)i * G + c; if (L >= nunits) return false;
        int w = (int)L; { const int q = nunits / NXCD, r = nunits % NXCD, xcd = w % NXCD, off = w / NXCD; w = (xcd < r ? xcd * (q + 1) : r * (q + 1) + (xcd - r) * q) + off; }
        u.pm = w / nN; u.pn = w % nN; u.e = blk_e[u.pm]; return true;
    }
    __device__ __forceinline__ int arow(const Unit& u, int r) const { return tok ? tok[u.pm * BM + r] : u.pm * BM + r; }
    __device__ __forceinline__ void a_ready(const Unit&) const {}
    __device__ __forceinline__ void done(const Unit&) const {}
};
template <class Epi, class Sched, bool ALIGN_EPI = false, bool SP2 = false>
__device__ __forceinline__ void gemm_phase(PG8_LAS unsigned char* lds, const Gemm g, const Sched& S, const Epi& E, int tid_in) {
    static_assert(SP2, "only the two-super-phase loop is kept in this file");
    int tid_ = tid_in; asm volatile("" : "+v"(tid_));
    const int tid = tid_, wid = __builtin_amdgcn_readfirstlane(tid >> 6), lane = tid & 63, wr = wid >> 2, wc = wid & 3, fr = lane & 15, fq = lane >> 4;
    const int K = g.K, nt = K / BK;
    unsigned voffB[2]; int RA[2], CA[2];
#pragma unroll
    for (int i = 0; i < 2; ++i) { int R, C; stage_rc(tid * 16 + i * 8192, R, C); const int Rb = Epi::PERM ? ((R & ~31) + perm32(R & 31)) : R;
        RA[i] = R; CA[i] = C; voffB[i] = (unsigned)(Rb * K + C) * 2u; }
    const size_t kstep = (size_t)(BK * 2);
    const size_t hstep = (size_t)HALF * K * 2;
    const size_t tstep = 2 * hstep;
    const unsigned ldsw = (unsigned)wid * 1024u;
    const int aoff = lds_byte(wr * 64 + fr, fq * 8), boff = lds_byte(wc * 32 + fr, fq * 8);
#define PG8_SA(b, h) (((b) * 2 + (h)) * HTB)
#define PG8_SB(b, h) ((4 + (b) * 2 + (h)) * HTB)
#define PG8_STAGE(bufoff, gbase, voff) do { _Pragma("unroll") for (int _i = 0; _i < 2; ++_i) \
        __builtin_amdgcn_global_load_lds((const unsigned*)((const char*)(gbase) + (voff)[_i]), (PG8_LAS unsigned*)(lds + (bufoff) + ldsw + _i * 8192), 16, 0, 0); } while (0)
#define PG8_AOFF(vo, u) do { _Pragma("unroll") for (int _h = 0; _h < 2; ++_h) _Pragma("unroll") for (int _i = 0; _i < 2; ++_i) \
        vo[_h][_i] = (unsigned)(S.arow(u, _h * HALF + RA[_i]) * K + CA[_i]) * 2u; } while (0)
#define PG8_LDA(dst, b, h) do { _Pragma("unroll") for (int m = 0; m < 4; ++m) _Pragma("unroll") for (int k = 0; k < 2; ++k) dst[m][k] = *(const PG8_LAS bf16x8*)(lds + PG8_SA(b, h) + aoff + m * 2048 + k * 1024); } while (0)
#define PG8_LDB(dst, b, h) do { _Pragma("unroll") for (int n = 0; n < 2; ++n) _Pragma("unroll") for (int k = 0; k < 2; ++k) dst[n][k] = *(const PG8_LAS bf16x8*)(lds + PG8_SB(b, h) + boff + n * 2048 + k * 1024); } while (0)
#define PG8_MMA(ai, bj, At, Bt) do { __builtin_amdgcn_s_setprio(1); _Pragma("unroll") for (int m = 0; m < 4; ++m) _Pragma("unroll") for (int n = 0; n < 2; ++n) _Pragma("unroll") for (int k = 0; k < 2; ++k) \
        acc[ai][bj][m][n] = __builtin_amdgcn_mfma_f32_16x16x32_bf16(Bt[n][k], At[m][k], acc[ai][bj][m][n], 0, 0, 0); __builtin_amdgcn_s_setprio(0); } while (0)
#define PG8_WAIT_V(n) asm volatile("s_waitcnt vmcnt(" #n ")" ::: "memory")
#define PG8_WAIT_L(n) asm volatile("s_waitcnt lgkmcnt(" #n ")" ::: "memory")
#define PG8_BAR __builtin_amdgcn_s_barrier()
#define PG8_SCHED __builtin_amdgcn_sched_barrier(0)
    Unit cur, nxt; int ui = 0;
    if (!S.next(0, cur)) return;
    f32x4 acc[2][2][4][2];
#pragma unroll
    for (int a = 0; a < 2; ++a)
#pragma unroll
        for (int b = 0; b < 2; ++b)
#pragma unroll
            for (int m = 0; m < 4; ++m)
#pragma unroll
                for (int n = 0; n < 2; ++n) acc[a][b][m][n] = (f32x4){0.f, 0.f, 0.f, 0.f};
    bf16x8 At[4][2], B0[2][2], B1[2][2];
    const char* Ab = (const char*)g.A;
    const char* cB = (const char*)g.Bt + (size_t)cur.pn * tstep + (size_t)cur.e * g.bexp;
    unsigned curA[2][2], nxtA[2][2];
    S.a_ready(cur);
    PG8_AOFF(curA, cur);
    PG8_STAGE(PG8_SB(0, 0), cB, voffB); PG8_STAGE(PG8_SB(0, 1), cB + hstep, voffB); PG8_STAGE(PG8_SA(0, 0), Ab, curA[0]); PG8_STAGE(PG8_SA(0, 1), Ab, curA[1]);
    if (wr == 1) PG8_BAR;
    PG8_WAIT_V(2); PG8_BAR;
    PG8_STAGE(PG8_SB(1, 0), cB + kstep, voffB); PG8_STAGE(PG8_SA(1, 0), Ab + kstep, curA[0]); PG8_STAGE(PG8_SB(1, 1), cB + hstep + kstep, voffB);
    PG8_WAIT_V(6); PG8_BAR;
    for (;;) {
        const bool has_next = S.next(ui + 1, nxt);
        const char* nB = has_next ? (const char*)g.Bt + (size_t)nxt.pn * tstep + (size_t)nxt.e * g.bexp : cB;
        if (has_next) { PG8_AOFF(nxtA, nxt); }
        else {
#pragma unroll
            for (int h = 0; h < 2; ++h)
#pragma unroll
                for (int i = 0; i < 2; ++i) nxtA[h][i] = curA[h][i]; }
        asm volatile(".p2align 6");
        for (int t = 0; t < nt; t += 2) {
            const bool last = (t == nt - 2);
            const char* a1 = Ab + (size_t)(t + 1) * kstep;
            const char* a2 = last ? Ab : Ab + (size_t)(t + 2) * kstep; const char* b2 = last ? nB : cB + (size_t)(t + 2) * kstep;
            const char* a3 = a2 + kstep; const char* b3 = b2 + kstep;
            unsigned vo2[2][2];
#pragma unroll
            for (int h = 0; h < 2; ++h)
#pragma unroll
                for (int i = 0; i < 2; ++i) vo2[h][i] = last ? nxtA[h][i] : curA[h][i];
            if (last && has_next) S.a_ready(nxt);
            PG8_LDB(B0, 0, 0); PG8_LDB(B1, 0, 1); PG8_SCHED; PG8_LDA(At, 0, 0); PG8_STAGE(PG8_SA(1, 1), a1, curA[1]);
            PG8_WAIT_V(8); PG8_WAIT_L(0); PG8_BAR; PG8_MMA(0, 0, At, B0); PG8_MMA(0, 1, At, B1); PG8_BAR; PG8_SCHED;
            PG8_LDA(At, 0, 1); PG8_STAGE(PG8_SB(0, 0), b2, voffB); PG8_STAGE(PG8_SB(0, 1), b2 + hstep, voffB); PG8_STAGE(PG8_SA(0, 0), a2, vo2[0]);
            PG8_WAIT_V(8); PG8_WAIT_L(0); PG8_BAR; PG8_MMA(1, 0, At, B0); PG8_MMA(1, 1, At, B1); PG8_BAR; PG8_SCHED;
            PG8_LDB(B0, 1, 0); PG8_LDB(B1, 1, 1); PG8_SCHED; PG8_LDA(At, 1, 0); PG8_STAGE(PG8_SA(0, 1), a2, vo2[1]);
            PG8_WAIT_V(8); PG8_WAIT_L(0); PG8_BAR; PG8_MMA(0, 0, At, B0); PG8_MMA(0, 1, At, B1); PG8_BAR; PG8_SCHED;
            PG8_LDA(At, 1, 1); PG8_STAGE(PG8_SB(1, 0), b3, voffB); PG8_STAGE(PG8_SB(1, 1), b3 + hstep, voffB); PG8_STAGE(PG8_SA(1, 0), a3, vo2[0]);
            PG8_WAIT_V(8); PG8_WAIT_L(0); PG8_BAR; PG8_MMA(1, 0, At, B0); PG8_MMA(1, 1, At, B1); PG8_BAR; PG8_SCHED;
        }
        if constexpr (ALIGN_EPI) { if (wr == 0) PG8_BAR; }
        if constexpr (!Epi::AFTER_DRAIN) { E(acc, cur, wr, wc, fr, fq); S.done(cur); }
        if (!has_next) break;
#pragma unroll
        for (int a = 0; a < 2; ++a)
#pragma unroll
            for (int b = 0; b < 2; ++b)
#pragma unroll
                for (int m = 0; m < 4; ++m)
#pragma unroll
                    for (int n = 0; n < 2; ++n) acc[a][b][m][n] = (f32x4){0.f, 0.f, 0.f, 0.f};
        cur = nxt; cB = nB; ++ui;
#pragma unroll
        for (int h = 0; h < 2; ++h)
#pragma unroll
            for (int i = 0; i < 2; ++i) curA[h][i] = nxtA[h][i];
        if constexpr (ALIGN_EPI) { if (wr == 1) PG8_BAR; }
    }
    PG8_WAIT_V(0);
    if constexpr (!ALIGN_EPI) { if (wr == 0) PG8_BAR; }
    PG8_BAR;
    if constexpr (Epi::AFTER_DRAIN) { E.fused(acc, cur, wr, wc, fr, fq, lds, wid, lane); S.done(cur); }
#undef PG8_SA
#undef PG8_SB
#undef PG8_STAGE
#undef PG8_AOFF
#undef PG8_LDA
#undef PG8_LDB
#undef PG8_MMA
#undef PG8_WAIT_V
#undef PG8_WAIT_L
#undef PG8_BAR
#undef PG8_SCHED
}
}
__device__ __forceinline__ float bf2f(unsigned v) { return __uint_as_float(v << 16); }
__device__ __forceinline__ unsigned f2bf(float f) { unsigned u = __float_as_uint(f); u += 0x7FFFu + ((u >> 16) & 1u); return u >> 16; }
typedef __bf16 bf16x2_t __attribute__((ext_vector_type(2)));
__device__ __forceinline__ unsigned pk2(float lo, float hi) { const f32x2 v = {lo, hi}; return __builtin_bit_cast(unsigned, __builtin_convertvector(v, bf16x2_t)); }
__device__ __forceinline__ float bflo(unsigned w) { return __uint_as_float(w << 16); }
__device__ __forceinline__ float bfhi(unsigned w) { return __uint_as_float(w & 0xFFFF0000u); }
__device__ __forceinline__ float wave_sum(float v) {
#pragma unroll
    for (int o = 1; o < 64; o <<= 1) v += __shfl_xor(v, o);
    return v;
}
__device__ __forceinline__ float wave_max(float v) {
#pragma unroll
    for (int o = 1; o < 64; o <<= 1) v = fmaxf(v, __shfl_xor(v, o));
    return v;
}
__device__ __forceinline__ float sigmoidf_(float x) { return __builtin_amdgcn_rcpf(1.0f + __expf(-x)); }
__device__ __forceinline__ float tanhf_(float x) { return 1.0f - 2.0f * __builtin_amdgcn_rcpf(__expf(2.0f * x) + 1.0f); }
#define LDS_WAIT() asm volatile("s_waitcnt lgkmcnt(0)" ::: "memory")
#define TOKBLK(b) ((((b) & 7) * 32) + ((b) >> 3))

struct Ctx { int tid, wave, lane, gw, ngw; unsigned char* shm; };

__device__ __forceinline__ int tr_src_col(int mode, int n, int scol0) { return mode == 1 ? (n < 2048 ? n : n + 16) : scol0 + n; }
__device__ __forceinline__ int tr_dst_row(int mode, int n, int drow0) { return mode == 2 ? 8 * (n >> 2) + (n & 3) : (mode == 3 ? 8 * (n >> 2) + 4 + (n & 3) : drow0 + n); }
struct TrD { const float* W; bf16_t* WT; const float* gain; int ldw, scol0, K, drow0, mode, item, nblk; };
__device__ __forceinline__ void tr_load(const TrD& d, int lane, f32x4 (&v)[8], float (&gn)[8]) {
    const int kb = d.item / d.nblk, nb = d.item % d.nblk, k0 = 64 * kb, n0 = 32 * nb;
    const int n4 = 4 * (lane & 7), sc = tr_src_col(d.mode, n0 + n4, d.scol0);
#pragma unroll
    for (int i = 0; i < 8; ++i) v[i] = __builtin_nontemporal_load((const f32x4*)(d.W + (size_t)(k0 + 8 * i + (lane >> 3)) * d.ldw + sc));
#pragma unroll
    for (int i = 0; i < 8; ++i) gn[i] = 1.0f;
    if (d.gain) {
#pragma unroll
        for (int i = 0; i < 8; ++i) gn[i] = d.gain[k0 + 8 * i + (lane >> 3)]; }
}
__device__ __forceinline__ void tr_finish(const TrD& d, int lane, f32x4 (&v)[8], const float (&gn)[8], LAS float* scr) {
    const int kb = d.item / d.nblk, nb = d.item % d.nblk, k0 = 64 * kb, n0 = 32 * nb, n4 = 4 * (lane & 7);
#pragma unroll
    for (int i = 0; i < 8; ++i) v[i] = v[i] * gn[i];
#pragma unroll
    for (int i = 0; i < 8; ++i) { LAS float* q = scr + (8 * i + (lane >> 3)) * 33 + n4; q[0] = v[i].x; q[1] = v[i].y; q[2] = v[i].z; q[3] = v[i].w; }
    LDS_WAIT(); asm volatile("" ::: "memory");
    const int c = lane & 7;
#pragma unroll
    for (int j = 0; j < 4; ++j) { const int n = (lane >> 3) + 8 * j; const LAS float* s = scr + (8 * c) * 33 + n;
        u32x4 o; o.x = pk2(s[0 * 33], s[1 * 33]); o.y = pk2(s[2 * 33], s[3 * 33]); o.z = pk2(s[4 * 33], s[5 * 33]); o.w = pk2(s[6 * 33], s[7 * 33]);
        __builtin_nontemporal_store(o, (u32x4*)(d.WT + (size_t)tr_dst_row(d.mode, n0 + n, d.drow0) * d.K + k0 + 8 * c)); }
    LDS_WAIT(); asm volatile("" ::: "memory");
}
__device__ __forceinline__ void tr_pair(const TrD& d0, const TrD& d1, bool has1, int lane, LAS float* scr) {
    f32x4 va[8], vb[8]; float ga[8], gb[8];
    tr_load(d0, lane, va, ga); if (has1) tr_load(d1, lane, vb, gb);
    tr_finish(d0, lane, va, ga, scr); if (has1) tr_finish(d1, lane, vb, gb, scr + 64 * 33);
}
__device__ __forceinline__ void tr_matrix(const Ctx& c, const float* W, int ldw, int scol0, int K, int ncols, bf16_t* WT, int drow0, int mode, const float* gain = nullptr) {
    LAS float* scr = (LAS float*)(c.shm) + c.wave * (2 * 64 * 33);
    const int nblk = ncols / 32, nitems = (K / 64) * nblk;
    for (int it = c.gw; it < nitems; it += 2 * c.ngw) { TrD d0{W, WT, gain, ldw, scol0, K, drow0, mode, it, nblk}; TrD d1 = d0; d1.item = it + c.ngw; tr_pair(d0, d1, it + c.ngw < nitems, c.lane, scr); }
}
__device__ __forceinline__ TrD tr_moe_desc(const Params& p, int layer, int it) {
    bf16_t* w13t = (bf16_t*)(p.ws + OFF_WMOE); bf16_t* w2t = (bf16_t*)(p.ws + OFF_WMOE + 64 * MiB);
    const float* w1 = p.moe_w1 + (size_t)layer * NEXP * 1024 * 512; const float* w3 = p.moe_w3 + (size_t)layer * NEXP * 1024 * 512; const float* w2 = p.moe_w2 + (size_t)layer * NEXP * 512 * 1024;
    const int e = it / 768, r = it % 768;
    if (r < 256) return TrD{w1 + (size_t)e * 1024 * 512, w13t + (size_t)e * 1024 * 1024, p.norm_moe + layer * 1024, 512, 0, 1024, 0, 2, r, 16};
    if (r < 512) return TrD{w3 + (size_t)e * 1024 * 512, w13t + (size_t)e * 1024 * 1024, p.norm_moe + layer * 1024, 512, 0, 1024, 0, 3, r - 256, 16};
    return TrD{w2 + (size_t)e * 512 * 1024, w2t + (size_t)e * 1024 * 512, nullptr, 1024, 0, 512, 0, 0, r - 512, 32};
}
__device__ __forceinline__ void tr_moe_range_w(const Ctx& c, const Params& p, int layer, int lo, int hi, int widx, int nw) {
    LAS float* scr = (LAS float*)(c.shm) + c.wave * (2 * 64 * 33);
    for (int it = lo + widx; it < hi; it += 2 * nw) { const bool has1 = it + nw < hi; const TrD d0 = tr_moe_desc(p, layer, it); const TrD d1 = tr_moe_desc(p, layer, has1 ? it + nw : it); tr_pair(d0, d1, has1, c.lane, scr); }
}
__device__ __forceinline__ void tr_moe_layer_w(const Ctx& c, const Params& p, int layer, int widx, int nw) {
    LAS float* scr = (LAS float*)(c.shm) + c.wave * (2 * 64 * 33);
    for (int it = widx; it < NEXP * 768; it += 2 * nw) { const bool has1 = it + nw < NEXP * 768; const TrD d0 = tr_moe_desc(p, layer, it); const TrD d1 = tr_moe_desc(p, layer, has1 ? it + nw : it); tr_pair(d0, d1, has1, c.lane, scr); }
}
__device__ __forceinline__ void tr_moe_layer(const Ctx& c, const Params& p, int layer, int gw0, int ngw) {
    LAS float* scr = (LAS float*)(c.shm) + c.wave * (2 * 64 * 33);
    for (int it = c.gw - gw0; it < NEXP * 768; it += 2 * ngw) { const bool has1 = it + ngw < NEXP * 768; const TrD d0 = tr_moe_desc(p, layer, it); const TrD d1 = tr_moe_desc(p, layer, has1 ? it + ngw : it); tr_pair(d0, d1, has1, c.lane, scr); }
}

__device__ __forceinline__ void row_load(const float* row, int lane, f32x4 (&v)[4]) {
#pragma unroll
    for (int j = 0; j < 4; ++j) v[j] = *((const f32x4*)row + lane + 64 * j);
}
__device__ __forceinline__ float row_rstd(const f32x4 (&v)[4]) {
    float s = 0.f;
#pragma unroll
    for (int j = 0; j < 4; ++j) s += (v[j].x * v[j].x + v[j].y * v[j].y) + (v[j].z * v[j].z + v[j].w * v[j].w);
    return 1.0f / sqrtf(wave_sum(s) * (1.0f / 1024.0f) + 1e-6f);
}
__device__ __forceinline__ void row_scale(f32x4 (&v)[4], float rstd, const float* gain, int lane) {
#pragma unroll
    for (int j = 0; j < 4; ++j) { const f32x4 g = *((const f32x4*)gain + lane + 64 * j); v[j] = v[j] * rstd * g; }
}
__device__ __forceinline__ void row_store_bf16(bf16_t* orow, int lane, const f32x4 (&v)[4]) {
#pragma unroll
    for (int j = 0; j < 4; ++j) { u32x2 o; o.x = pk2(v[j].x, v[j].y); o.y = pk2(v[j].z, v[j].w); *((u32x2*)orow + lane + 64 * j) = o; }
}
__device__ __forceinline__ void row_store_f32(float* orow, int lane, const f32x4 (&v)[4]) {
#pragma unroll
    for (int j = 0; j < 4; ++j) __builtin_nontemporal_store(v[j], (f32x4*)orow + lane + 64 * j);
}
__device__ __forceinline__ void row_combine(f32x4 (&v)[4], const bf16_t* yb, int p0, int p1, float g0, float g1, int lane) {
    const u32x2* r0 = (const u32x2*)(yb + (size_t)p0 * 1024); const u32x2* r1 = (const u32x2*)(yb + (size_t)p1 * 1024);
#pragma unroll
    for (int j = 0; j < 4; ++j) { const u32x2 a = __builtin_nontemporal_load(r0 + lane + 64 * j), b = __builtin_nontemporal_load(r1 + lane + 64 * j);
        v[j].x += g0 * bflo(a.x) + g1 * bflo(b.x); v[j].y += g0 * bfhi(a.x) + g1 * bfhi(b.x);
        v[j].z += g0 * bflo(a.y) + g1 * bflo(b.y); v[j].w += g0 * bfhi(a.y) + g1 * bfhi(b.y); }
}
__device__ __forceinline__ void row_logits(const f32x4 (&v)[4], const float* wT, int lane, int NL, LAS float* lg) {
#pragma unroll 1
    for (int o = 0; o < NL; ++o) { float s = 0.f;
#pragma unroll
        for (int j = 0; j < 4; ++j) { const f32x4 w = *((const f32x4*)(wT + o * 1024) + lane + 64 * j); s += (v[j].x * w.x + v[j].y * w.y) + (v[j].z * w.z + v[j].w * w.w); }
        s = wave_sum(s); if (lane == 0) lg[o] = s; }
    LDS_WAIT();
}

__device__ __forceinline__ void norm_plain(const Ctx& c, const float* src, const float* gain, bf16_t* H, int nrows) {
    for (int r0 = c.gw; r0 < nrows; r0 += 4 * c.ngw) {
        f32x4 v[4][4];
#pragma unroll
        for (int q = 0; q < 4; ++q) { const int r = r0 + q * c.ngw; if (r < nrows) row_load(src + (size_t)r * 1024, c.lane, v[q]); }
#pragma unroll
        for (int q = 0; q < 4; ++q) { const int r = r0 + q * c.ngw; if (r < nrows) { const float rs = row_rstd(v[q]); row_scale(v[q], rs, gain, c.lane); row_store_bf16(H + (size_t)r * 1024, c.lane, v[q]); } }
    }
}
__device__ __forceinline__ void copy_rstd(const Ctx& c, const float* src, bf16_t* H, float* rsout, int nrows) {
    for (int r0 = c.gw; r0 < nrows; r0 += 4 * c.ngw) {
        f32x4 v[4][4];
#pragma unroll
        for (int q = 0; q < 4; ++q) { const int r = r0 + q * c.ngw; if (r < nrows) {
#pragma unroll
            for (int j = 0; j < 4; ++j) v[q][j] = __builtin_nontemporal_load((const f32x4*)(src + (size_t)r * 1024) + c.lane + 64 * j); }     }
#pragma unroll
        for (int q = 0; q < 4; ++q) { const int r = r0 + q * c.ngw; if (r < nrows) { const float rs = row_rstd(v[q]); if (c.lane == 0) rsout[r] = rs; row_store_bf16(H + (size_t)r * 1024, c.lane, v[q]); } }
    }
}
__device__ __forceinline__ void route_row(const LAS float* lg, const float* bg, const float* be, int& e0, int& e1, float& g0, float& g1) {
    float gl[4]; int gt = 0; float gm;
#pragma unroll
    for (int i = 0; i < 4; ++i) gl[i] = lg[i] + bg[i];
    gm = gl[0];
#pragma unroll
    for (int i = 1; i < 4; ++i) if (gl[i] > gm) { gm = gl[i]; gt = i; }
    float gs = 0.f;
#pragma unroll
    for (int i = 0; i < 4; ++i) gs += __expf(gl[i] - gm);
    const float pg = 1.0f / gs;
    float el[8];
#pragma unroll
    for (int i = 0; i < 8; ++i) el[i] = lg[4 + 8 * gt + i] + be[8 * gt + i];
    int i0 = 0; float m0 = el[0];
#pragma unroll
    for (int i = 1; i < 8; ++i) if (el[i] > m0) { m0 = el[i]; i0 = i; }
    int i1 = -1; float m1 = -3.0e38f;
#pragma unroll
    for (int i = 0; i < 8; ++i) if (i != i0 && el[i] > m1) { m1 = el[i]; i1 = i; }
    float one = 1.0f; asm volatile("" : "+v"(one));
    const float q1 = __expf(m1 - m0); const float inv = one / (one + q1);
    e0 = gt * 8 + i0; e1 = gt * 8 + i1; g0 = pg * inv; g1 = pg * q1 * inv;
}
constexpr int RW_AS = 64 * 68;
__device__ __forceinline__ void rwkv_naive(const Ctx& c, const Params& p, int bh) {
    const int b = bh >> 3, hd = bh & 7, tid = c.tid, lane = c.lane, wv = c.wave;
    LAS float* L = (LAS float*)c.shm;
    LAS float* aR = L; LAS float* aK = L + RW_AS; LAS float* aV = L + 2 * RW_AS; LAS float* aW = L + 3 * RW_AS; LAS float* aA = L + 4 * RW_AS;
    LAS float* aB = L + 5 * RW_AS; LAS float* aG = L + 6 * RW_AS; LAS float* aY = L + 7 * RW_AS; LAS float* red = L + 8 * RW_AS;
    const bf16_t* P = (const bf16_t*)(p.ws + OFF_P); bf16_t* MIX = (bf16_t*)(p.ws + OFF_H);
    LAS f32x4* SL = (LAS f32x4*)(L + 8 * RW_AS + 1536);
    if (wv == 0) {
#pragma unroll
        for (int j4 = 0; j4 < 16; ++j4) SL[j4 * 64 + lane] = (f32x4){0.f, 0.f, 0.f, 0.f}; }
    const int t = lane, cg = wv;
    const int ch0 = hd * 64 + cg * 8;
    for (int tb = 0; tb < 64; ++tb) {
        const size_t tg0 = (size_t)b * SEQ + (size_t)tb * 64;
#pragma unroll 1
        for (int i = 0; i < 7; ++i) {
            const int task = tid + 512 * i, tt = task / 56, q = task % 56;
            int col; LAS float* dst; int kind = 0;
            if (q < 8) { col = hd * 64 + 8 * q; dst = aR + tt * 68 + 8 * q; }
            else if (q < 16) { col = 512 + hd * 64 + 8 * (q - 8); dst = aK + tt * 68 + 8 * (q - 8); }
            else if (q < 24) { col = 1024 + hd * 64 + 8 * (q - 16); dst = aV + tt * 68 + 8 * (q - 16); }
            else if (q < 32) { col = 1536 + 8 * (q - 24); dst = aW + tt * 68 + 8 * (q - 24); kind = 1; }
            else if (q < 40) { col = 1600 + 8 * (q - 32); dst = aA + tt * 68 + 8 * (q - 32); }
            else if (q < 48) { col = 1664 + 8 * (q - 40); dst = aB + tt * 68 + 8 * (q - 40); kind = 2; }
            else { col = 1664 + 8 * (q - 40); dst = aG + tt * 68 + 8 * (q - 48); kind = 2; }
            const bf16_t* src = P + (tg0 + tt) * EV_IN + 768 + col;
            const u32x4 cur = *(const u32x4*)src;
            u32x4 prv = (u32x4){0u, 0u, 0u, 0u};
            if (tb * 64 + tt > 0) prv = *(const u32x4*)(src - EV_IN);
            const f32x4 m0 = *(const f32x4*)(p.ev_mu + col), m1 = *(const f32x4*)(p.ev_mu + col + 4);
            float v[8];
            const unsigned cw[4] = {cur.x, cur.y, cur.z, cur.w}, pw[4] = {prv.x, prv.y, prv.z, prv.w};
            const float mu[8] = {m0.x, m0.y, m0.z, m0.w, m1.x, m1.y, m1.z, m1.w};
#pragma unroll
            for (int k = 0; k < 4; ++k) { const float c0 = bflo(cw[k]), c1 = bfhi(cw[k]), p0 = bflo(pw[k]), p1 = bfhi(pw[k]);
                v[2 * k] = c0 + (p0 - c0) * mu[2 * k]; v[2 * k + 1] = c1 + (p1 - c1) * mu[2 * k + 1]; }
            if (kind == 1) {
#pragma unroll
                for (int k = 0; k < 8; ++k) v[k] = tanhf(v[k]); }
            if (kind == 2) {
#pragma unroll
                for (int k = 0; k < 8; ++k) v[k] = sigmoidf_(v[k]); }
            *(LAS f32x4*)dst = (f32x4){v[0], v[1], v[2], v[3]}; *(LAS f32x4*)(dst + 4) = (f32x4){v[4], v[5], v[6], v[7]};
        }
        __syncthreads();
        float zw[8], za[8], gg[8];
#pragma unroll
        for (int i = 0; i < 8; ++i) { zw[i] = 0.f; za[i] = 0.f; gg[i] = 0.f; }
#pragma unroll 2
        for (int j4 = 0; j4 < 16; ++j4) {
            const f32x4 xw = *(const LAS f32x4*)(aW + t * 68 + 4 * j4), xa = *(const LAS f32x4*)(aA + t * 68 + 4 * j4);
            const f32x4 g0 = *(const LAS f32x4*)(aB + t * 68 + 4 * j4), g1 = *(const LAS f32x4*)(aG + t * 68 + 4 * j4);
#pragma unroll
            for (int jj = 0; jj < 4; ++jj) { const int j = 4 * j4 + jj;
                const f32x4 w2a = *(const f32x4*)(p.ev_w2 + (size_t)j * 512 + ch0), w2b = *(const f32x4*)(p.ev_w2 + (size_t)j * 512 + ch0 + 4);
                const f32x4 a2a = *(const f32x4*)(p.ev_a2 + (size_t)j * 512 + ch0), a2b = *(const f32x4*)(p.ev_a2 + (size_t)j * 512 + ch0 + 4);
                const f32x4 gla = *(const f32x4*)(p.ev_g2 + (size_t)j * 512 + ch0), glb = *(const f32x4*)(p.ev_g2 + (size_t)j * 512 + ch0 + 4);
                const f32x4 gha = *(const f32x4*)(p.ev_g2 + (size_t)(64 + j) * 512 + ch0), ghb = *(const f32x4*)(p.ev_g2 + (size_t)(64 + j) * 512 + ch0 + 4);
                const float xwv = xw[jj], xav = xa[jj], g0v = g0[jj], g1v = g1[jj];
#pragma unroll
                for (int i = 0; i < 4; ++i) { zw[i] += xwv * w2a[i]; zw[4 + i] += xwv * w2b[i]; za[i] += xav * a2a[i]; za[4 + i] += xav * a2b[i];
                    gg[i] += g0v * gla[i] + g1v * gha[i]; gg[4 + i] += g0v * glb[i] + g1v * ghb[i]; } }
        }
        float av[8], kkv[8]; float ss = 0.f;
        {
            const f32x4 kA = *(const LAS f32x4*)(aK + t * 68 + cg * 8), kB = *(const LAS f32x4*)(aK + t * 68 + cg * 8 + 4);
            const float kv[8] = {kA.x, kA.y, kA.z, kA.w, kB.x, kB.y, kB.z, kB.w};
            float dec[8], kp[8];
#pragma unroll
            for (int i = 0; i < 8; ++i) { const int ch = ch0 + i;
                const float u = -(p.ev_w0[ch] + zw[i]); const float sp = (u > 20.f) ? u : log1pf(__expf(u));
                const float w = -sp - 0.5f; dec[i] = __expf(-__expf(w));
                av[i] = sigmoidf_(p.ev_a0[ch] + za[i]);
                kkv[i] = kv[i] * p.ev_k_k[ch]; ss += kkv[i] * kkv[i];
                kp[i] = kv[i] * (1.0f + (av[i] - 1.0f) * p.ev_k_a[ch]); }
            red[t * 8 + cg] = ss;
            __syncthreads();
            *(LAS f32x4*)(aW + t * 68 + cg * 8) = (f32x4){dec[0], dec[1], dec[2], dec[3]}; *(LAS f32x4*)(aW + t * 68 + cg * 8 + 4) = (f32x4){dec[4], dec[5], dec[6], dec[7]};
            *(LAS f32x4*)(aK + t * 68 + cg * 8) = (f32x4){kp[0], kp[1], kp[2], kp[3]}; *(LAS f32x4*)(aK + t * 68 + cg * 8 + 4) = (f32x4){kp[4], kp[5], kp[6], kp[7]};
            *(LAS f32x4*)(aG + t * 68 + cg * 8) = (f32x4){gg[0], gg[1], gg[2], gg[3]}; *(LAS f32x4*)(aG + t * 68 + cg * 8 + 4) = (f32x4){gg[4], gg[5], gg[6], gg[7]};
            float tot = 0.f;
#pragma unroll
            for (int i = 0; i < 8; ++i) tot += red[t * 8 + i];
            const float inv = 1.0f / fmaxf(sqrtf(tot), 1e-12f);
            float an[8], bn[8];
#pragma unroll
            for (int i = 0; i < 8; ++i) { const float kn = kkv[i] * inv; an[i] = -kn; bn[i] = kn * av[i]; }
            *(LAS f32x4*)(aA + t * 68 + cg * 8) = (f32x4){an[0], an[1], an[2], an[3]}; *(LAS f32x4*)(aA + t * 68 + cg * 8 + 4) = (f32x4){an[4], an[5], an[6], an[7]};
            *(LAS f32x4*)(aB + t * 68 + cg * 8) = (f32x4){bn[0], bn[1], bn[2], bn[3]}; *(LAS f32x4*)(aB + t * 68 + cg * 8 + 4) = (f32x4){bn[4], bn[5], bn[6], bn[7]};
        }
        __syncthreads();
        if (wv == 0) {
            float S[64];
#pragma unroll
            for (int j4 = 0; j4 < 16; ++j4) { const f32x4 s4 = SL[j4 * 64 + lane]; S[4 * j4] = s4.x; S[4 * j4 + 1] = s4.y; S[4 * j4 + 2] = s4.z; S[4 * j4 + 3] = s4.w; }
#pragma unroll 1
            for (int tt = 0; tt < 64; ++tt) {
                const float vv = aV[tt * 68 + lane];
                float sa = 0.f;
#pragma unroll
                for (int j4 = 0; j4 < 16; ++j4) { const f32x4 a4 = *(const LAS f32x4*)(aA + tt * 68 + 4 * j4);
                    sa += S[4 * j4] * a4.x; sa += S[4 * j4 + 1] * a4.y; sa += S[4 * j4 + 2] * a4.z; sa += S[4 * j4 + 3] * a4.w; }
                float y = 0.f;
#pragma unroll
                for (int j4 = 0; j4 < 16; ++j4) {
                    const f32x4 d4 = *(const LAS f32x4*)(aW + tt * 68 + 4 * j4), b4 = *(const LAS f32x4*)(aB + tt * 68 + 4 * j4);
                    const f32x4 k4 = *(const LAS f32x4*)(aK + tt * 68 + 4 * j4), r4 = *(const LAS f32x4*)(aR + tt * 68 + 4 * j4);
#pragma unroll
                    for (int jj = 0; jj < 4; ++jj) { const int j = 4 * j4 + jj; S[j] = S[j] * d4[jj] + sa * b4[jj] + vv * k4[jj]; y += S[j] * r4[jj]; } }
                aY[tt * 68 + lane] = y;
            }
#pragma unroll
            for (int j4 = 0; j4 < 16; ++j4) SL[j4 * 64 + lane] = (f32x4){S[4 * j4], S[4 * j4 + 1], S[4 * j4 + 2], S[4 * j4 + 3]};
        }
        __syncthreads();
        {
            const f32x4 yA = *(const LAS f32x4*)(aY + t * 68 + cg * 8), yB = *(const LAS f32x4*)(aY + t * 68 + cg * 8 + 4);
            const f32x4 rA = *(const LAS f32x4*)(aR + t * 68 + cg * 8), rB = *(const LAS f32x4*)(aR + t * 68 + cg * 8 + 4);
            const f32x4 kA = *(const LAS f32x4*)(aK + t * 68 + cg * 8), kB = *(const LAS f32x4*)(aK + t * 68 + cg * 8 + 4);
            const f32x4 vA = *(const LAS f32x4*)(aV + t * 68 + cg * 8), vB = *(const LAS f32x4*)(aV + t * 68 + cg * 8 + 4);
            const f32x4 gA = *(const LAS f32x4*)(aG + t * 68 + cg * 8), gB = *(const LAS f32x4*)(aG + t * 68 + cg * 8 + 4);
            const float y[8] = {yA.x, yA.y, yA.z, yA.w, yB.x, yB.y, yB.z, yB.w}, r[8] = {rA.x, rA.y, rA.z, rA.w, rB.x, rB.y, rB.z, rB.w};
            const float k[8] = {kA.x, kA.y, kA.z, kA.w, kB.x, kB.y, kB.z, kB.w}, v[8] = {vA.x, vA.y, vA.z, vA.w, vB.x, vB.y, vB.z, vB.w};
            const float g[8] = {gA.x, gA.y, gA.z, gA.w, gB.x, gB.y, gB.z, gB.w};
            float s1 = 0.f, sb = 0.f;
#pragma unroll
            for (int i = 0; i < 8; ++i) { s1 += y[i]; sb += r[i] * k[i] * p.ev_r_k[ch0 + i]; }
            red[t * 8 + cg] = s1; red[512 + t * 8 + cg] = sb;
            __syncthreads();
            float m = 0.f, bon = 0.f;
#pragma unroll
            for (int i = 0; i < 8; ++i) { m += red[t * 8 + i]; bon += red[512 + t * 8 + i]; }
            m *= (1.0f / 64.0f);
            float s2 = 0.f;
#pragma unroll
            for (int i = 0; i < 8; ++i) s2 += (y[i] - m) * (y[i] - m);
            red[1024 + t * 8 + cg] = s2;
            __syncthreads();
            float var = 0.f;
#pragma unroll
            for (int i = 0; i < 8; ++i) var += red[1024 + t * 8 + i];
            const float rs = 1.0f / sqrtf(var * (1.0f / 64.0f) + 64e-5f);
            float o[8];
#pragma unroll
            for (int i = 0; i < 8; ++i) o[i] = ((y[i] - m) * rs * p.ev_lnx_w[ch0 + i] + p.ev_lnx_b[ch0 + i] + bon * v[i]) * g[i];
            u32x4 w; w.x = pk2(o[0], o[1]); w.y = pk2(o[2], o[3]); w.z = pk2(o[4], o[5]); w.w = pk2(o[6], o[7]);
            *(u32x4*)(MIX + (tg0 + t) * 1024 + 512 + ch0) = w;
        }
        __syncthreads();
    }
}

__device__ __forceinline__ void swa_naive(const Ctx& c, const Params& p, int unit) {
    const int b = unit >> 6, g = (unit >> 5) & 1, n = unit & 31, tid = c.tid, lane = c.lane, wv = c.wave;
    LAS bf16_t* Ks = (LAS bf16_t*)c.shm;
    LAS bf16_t* Vs = (LAS bf16_t*)(c.shm + 256 * 144);
    LAS float* qf = (LAS float*)(c.shm + 256 * 144 + 256 * 128) + wv * 320;
    LAS float* pr = qf + 64;
    const bf16_t* P = (const bf16_t*)(p.ws + OFF_P); bf16_t* MIX = (bf16_t*)(p.ws + OFF_H);
    __syncthreads();
#pragma unroll 1
    for (int i = 0; i < 8; ++i) {
        const int task = tid + 512 * i, which = task >> 11, r = (task >> 3) & 255, ck = task & 7;
        const int tk = n * 128 - 128 + r;
        u32x4 d = (u32x4){0u, 0u, 0u, 0u};
        if (tk >= 0) d = *(const u32x4*)(P + ((size_t)b * SEQ + tk) * EV_IN + 512 + which * 128 + g * 64 + ck * 8);
        if (which == 0) *(LAS u32x4*)(Ks + r * 72 + ck * 8) = d; else *(LAS u32x4*)(Vs + r * 64 + ck * 8) = d;
    }
    __syncthreads();
    const int head = g * 4 + (wv >> 1);
    const float sink = p.ev_sinks[head];
#pragma unroll 1
    for (int qq = 0; qq < 64; ++qq) {
        const int qi = (wv & 1) * 64 + qq;
        const size_t tq = (size_t)b * SEQ + n * 128 + qi;
        qf[lane] = bf2f(P[tq * EV_IN + head * 64 + lane]) * 0.125f;
        LDS_WAIT();
        float s[4];
#pragma unroll
        for (int j = 0; j < 4; ++j) { const int kp = lane + 64 * j; float a = 0.f;
#pragma unroll
            for (int ck = 0; ck < 8; ++ck) { const u32x4 kk = *(const LAS u32x4*)(Ks + kp * 72 + ck * 8);
                const f32x4 q0 = *(const LAS f32x4*)(qf + ck * 8), q1 = *(const LAS f32x4*)(qf + ck * 8 + 4);
                a += bflo(kk.x) * q0.x + bfhi(kk.x) * q0.y + bflo(kk.y) * q0.z + bfhi(kk.y) * q0.w + bflo(kk.z) * q1.x + bfhi(kk.z) * q1.y + bflo(kk.w) * q1.z + bfhi(kk.w) * q1.w; }
            const bool valid = (kp >= qi + 1) && (kp <= qi + 128) && (n > 0 || kp >= 128);
            s[j] = valid ? a : -INFINITY; }
        float m = fmaxf(fmaxf(s[0], s[1]), fmaxf(s[2], s[3])); m = fmaxf(wave_max(m), sink);
        float den = 0.f;
#pragma unroll
        for (int j = 0; j < 4; ++j) { const float e = __expf(s[j] - m); pr[lane + 64 * j] = e; den += e; }
        den = wave_sum(den) + __expf(sink - m);
        LDS_WAIT();
        float o = 0.f;
#pragma unroll 8
        for (int kp = qi + 1; kp <= qi + 128; ++kp) o += pr[kp] * bf2f(Vs[kp * 64 + lane]);
        MIX[tq * 1024 + head * 64 + lane] = (bf16_t)f2bf(o / den);
    }
}
__device__ __forceinline__ void gla_naive(const Ctx& c, const Params& p, int bh) {
    const int b = bh >> 2, hd = bh & 3, tid = c.tid, lane = c.lane, wv = c.wave;
    LAS float* qs = (LAS float*)c.shm; LAS float* ks = qs + 32 * 128; LAS float* es = ks + 32 * 128; LAS float* vs = es + 32 * 128; LAS float* os = vs + 32 * 256;
    const bf16_t* P = (const bf16_t*)(p.ws + OFF_P); const float* GK = (const float*)(p.ws + OFF_R); bf16_t* MIX = (bf16_t*)(p.ws + OFF_H);
    float S[128];
#pragma unroll
    for (int j = 0; j < 128; ++j) S[j] = 0.f;
    for (int tb = 0; tb < 128; ++tb) {
        const size_t tg0 = (size_t)b * SEQ + (size_t)tb * 32;
#pragma unroll 1
        for (int i = 0; i < 8; ++i) { const int idx = tid + 512 * i, tt = idx >> 7, j = idx & 127;
            const bf16_t* row = P + (tg0 + tt) * OD_IN;
            qs[idx] = bf2f(row[hd * 128 + j]) * 0.08838834764831845f; ks[idx] = bf2f(row[512 + hd * 128 + j]); es[idx] = __expf(GK[(tg0 + tt) * 512 + hd * 128 + j]); }
#pragma unroll 1
        for (int i = 0; i < 16; ++i) { const int idx = tid + 512 * i, tt = idx >> 8, j = idx & 255; vs[idx] = bf2f(P[(tg0 + tt) * OD_IN + 1024 + hd * 256 + j]); }
        __syncthreads();
        if (wv < 4) {
#pragma unroll 1
            for (int tt = 0; tt < 32; ++tt) {
                const float vv = vs[tt * 256 + tid]; float o = 0.f;
#pragma unroll
                for (int j4 = 0; j4 < 32; ++j4) {
                    const f32x4 e4 = *(const LAS f32x4*)(es + tt * 128 + 4 * j4), k4 = *(const LAS f32x4*)(ks + tt * 128 + 4 * j4), q4 = *(const LAS f32x4*)(qs + tt * 128 + 4 * j4);
#pragma unroll
                    for (int jj = 0; jj < 4; ++jj) { const int j = 4 * j4 + jj; S[j] = S[j] * e4[jj] + k4[jj] * vv; o += q4[jj] * S[j]; } }
                os[tt * 256 + tid] = o;
            }
        }
        __syncthreads();
#pragma unroll 1
        for (int i = 0; i < 4; ++i) { const int tt = wv + 8 * i;
            const f32x4 o4 = *(const LAS f32x4*)(os + tt * 256 + 4 * lane);
            const float ss = wave_sum(o4.x * o4.x + o4.y * o4.y + o4.z * o4.z + o4.w * o4.w);
            const float rs = 1.0f / sqrtf(ss * (1.0f / 256.0f) + 1e-6f);
            const f32x4 gn = *(const f32x4*)(p.od_onorm + 4 * lane);
            const u32x2 og = *(const u32x2*)(P + (tg0 + tt) * OD_IN + 2048 + hd * 256 + 4 * lane);
            const float g0 = bflo(og.x), g1 = bfhi(og.x), g2 = bflo(og.y), g3 = bfhi(og.y);
            u32x2 w; w.x = pk2(o4.x * rs * gn.x * g0 * sigmoidf_(g0), o4.y * rs * gn.y * g1 * sigmoidf_(g1)); w.y = pk2(o4.z * rs * gn.z * g2 * sigmoidf_(g2), o4.w * rs * gn.w * g3 * sigmoidf_(g3));
            *(u32x2*)(MIX + (tg0 + tt) * 1024 + hd * 256 + 4 * lane) = w; }
        __syncthreads();
    }
}

__device__ __forceinline__ void xattn_naive(const Ctx& c, const Params& p, int unit) {
    const int b = unit >> 5, hh = (unit >> 3) & 3, tblk = unit & 7, tid = c.tid, lane = c.lane, wv = c.wave;
    LAS bf16_t* Ks = (LAS bf16_t*)c.shm;
    LAS bf16_t* Vs = (LAS bf16_t*)(c.shm + 256 * 272);
    LAS float* qf = (LAS float*)(c.shm + 256 * 272 + 256 * 256) + wv * 384;
    LAS float* pr = qf + 128;
    const bf16_t* MKV = (const bf16_t*)(p.ws + OFF_MKV); const bf16_t* Q = (const bf16_t*)(p.ws + OFF_P); bf16_t* OA = (bf16_t*)(p.ws + OFF_P + 32 * MiB);
    __syncthreads();
#pragma unroll 1
    for (int i = 0; i < 16; ++i) {
        const int task = tid + 512 * i, which = task >> 12, r = (task >> 4) & 255, ck = task & 15;
        const u32x4 d = *(const u32x4*)(MKV + ((size_t)b * MEMLEN + r) * 1024 + which * 512 + hh * 128 + ck * 8);
        if (which == 0) *(LAS u32x4*)(Ks + r * 136 + ck * 8) = d; else *(LAS u32x4*)(Vs + r * 128 + ck * 8) = d;
    }
    __syncthreads();
#pragma unroll 1
    for (int qq = 0; qq < 64; ++qq) {
        const size_t tq = (size_t)b * SEQ + tblk * 512 + wv * 64 + qq;
        qf[lane] = bf2f(Q[tq * 512 + hh * 128 + lane]) * 0.08838834764831845f; qf[lane + 64] = bf2f(Q[tq * 512 + hh * 128 + 64 + lane]) * 0.08838834764831845f;
        LDS_WAIT();
        float s[4];
#pragma unroll
        for (int j = 0; j < 4; ++j) { const int kp = lane + 64 * j; float a = 0.f;
#pragma unroll
            for (int ck = 0; ck < 16; ++ck) { const u32x4 kk = *(const LAS u32x4*)(Ks + kp * 136 + ck * 8);
                const f32x4 q0 = *(const LAS f32x4*)(qf + ck * 8), q1 = *(const LAS f32x4*)(qf + ck * 8 + 4);
                a += bflo(kk.x) * q0.x + bfhi(kk.x) * q0.y + bflo(kk.y) * q0.z + bfhi(kk.y) * q0.w + bflo(kk.z) * q1.x + bfhi(kk.z) * q1.y + bflo(kk.w) * q1.z + bfhi(kk.w) * q1.w; }
            s[j] = a; }
        const float m = wave_max(fmaxf(fmaxf(s[0], s[1]), fmaxf(s[2], s[3])));
        float den = 0.f;
#pragma unroll
        for (int j = 0; j < 4; ++j) { const float e = __expf(s[j] - m); pr[lane + 64 * j] = e; den += e; }
        den = wave_sum(den);
        LDS_WAIT();
        float o0 = 0.f, o1 = 0.f;
#pragma unroll 4
        for (int k4 = 0; k4 < 64; ++k4) { const f32x4 p4 = *(const LAS f32x4*)(pr + 4 * k4);
#pragma unroll
            for (int kk = 0; kk < 4; ++kk) { const unsigned vv = *(const LAS unsigned*)(Vs + (4 * k4 + kk) * 128 + 2 * lane); o0 += p4[kk] * bflo(vv); o1 += p4[kk] * bfhi(vv); } }
        const float inv = 1.0f / den;
        *(unsigned*)(OA + tq * 512 + hh * 128 + 2 * lane) = pk2(o0 * inv, o1 * inv);
    }
}

__device__ __forceinline__ void moe_slots(const Ctx& c, const Params& p, int layer) {
    LAS int* sh = (LAS int*)c.shm;
    const int* cnt = (const int*)(p.ws + OFF_CTL + CTL_CNT) + layer * 32; int* cur = (int*)(p.ws + OFF_CTL + CTL_CUR) + layer * 32;
    int* blk = (int*)(p.ws + OFF_CTL + CTL_BLK) + layer * 1024;
    __syncthreads();
    if (c.tid == 0) { int acc = 0; for (int e = 0; e < NEXP; ++e) { sh[e] = acc; acc += (cnt[e] + 255) / 256 * 256; } sh[32] = acc; }
    __syncthreads();
    if (blockIdx.x == 0 && c.tid < NEXP) { const int e = c.tid, s = sh[e] / 256, en = (e == NEXP - 1 ? sh[32] : sh[e + 1]) / 256; for (int i = s; i < en; ++i) blk[1 + i] = e; if (e == 0) blk[0] = sh[32] / 256; }
    const int2* RE = (const int2*)(p.ws + OFF_ROUTE); int2* RP = (int2*)(p.ws + OFF_ROUTE + 512 * 1024);
    const bf16_t* H = (const bf16_t*)(p.ws + OFF_H); bf16_t* XB = (bf16_t*)(p.ws + OFF_P);
    for (int ck = c.gw; ck < T_TOK / 64; ck += c.ngw) {
        const int t = ck * 64 + c.lane; const int2 ee = RE[t]; int pos0 = 0, pos1 = 0;
#pragma unroll 1
        for (int e = 0; e < NEXP; ++e) {
            const unsigned long long m0 = __ballot(ee.x == e), m1 = __ballot(ee.y == e);
            const int n0 = __popcll(m0), n1 = __popcll(m1);
            if (n0 + n1 == 0) continue;
            int base = 0; if (c.lane == 0) base = atomicAdd(&cur[e], n0 + n1);
            base = __shfl(base, 0) + sh[e];
            const unsigned long long lt = (1ull << c.lane) - 1ull;
            if (ee.x == e) pos0 = base + __popcll(m0 & lt);
            if (ee.y == e) pos1 = base + n0 + __popcll(m1 & lt);
        }
        RP[t] = make_int2(pos0, pos1);
#pragma unroll 1
        for (int i = 0; i < 64; ++i) { const int ti = ck * 64 + i, q0 = __shfl(pos0, i), q1 = __shfl(pos1, i);
            const u32x4 a = *((const u32x4*)(H + (size_t)ti * 1024) + c.lane), bq = *((const u32x4*)(H + (size_t)ti * 1024) + 64 + c.lane);
            *((u32x4*)(XB + (size_t)q0 * 1024) + c.lane) = a; *((u32x4*)(XB + (size_t)q0 * 1024) + 64 + c.lane) = bq;
            *((u32x4*)(XB + (size_t)q1 * 1024) + c.lane) = a; *((u32x4*)(XB + (size_t)q1 * 1024) + 64 + c.lane) = bq; }
    }
}
typedef short bf16x8_t __attribute__((ext_vector_type(8)));
constexpr size_t R_GK = 0, R_QT = 64 * MiB, R_ATT = 96 * MiB, R_KHT = 112 * MiB, R_GDEC = 144 * MiB;
template <int CTRL, int RMASK> __device__ __forceinline__ float dpp_get0(float x) {
    return __builtin_bit_cast(float, __builtin_amdgcn_update_dpp(0, __builtin_bit_cast(int, x), CTRL, RMASK, 0xF, false)); }
__device__ __forceinline__ float wave_scan_incl(float x, int lane) {
    (void)lane;
    x += dpp_get0<0x111, 0xF>(x); x += dpp_get0<0x112, 0xF>(x); x += dpp_get0<0x114, 0xF>(x); x += dpp_get0<0x118, 0xF>(x);
    x += dpp_get0<0x142, 0xA>(x); x += dpp_get0<0x143, 0xC>(x);
    return x;
}
__device__ __forceinline__ float lane63(float x) { return __builtin_bit_cast(float, __builtin_amdgcn_readlane(__builtin_bit_cast(int, x), 63)); }
__device__ __forceinline__ int key_perm(int key) { const int kq = key & 31; return (key & ~31) + 8 * ((kq >> 2) & 3) + 4 * ((kq >> 4) & 1) + (kq & 3); }
__device__ __forceinline__ bf16x8_t zero_frag() { return (bf16x8_t){0, 0, 0, 0, 0, 0, 0, 0}; }
__device__ __forceinline__ bf16x8_t lds_frag(const LAS bf16_t* img, int pitch, int row, int col) { return *(const LAS bf16x8_t*)(img + row * pitch + col); }
__device__ __forceinline__ bf16x8_t pack8(const float (&v)[8]) {
    u32x4 w; w.x = pk2(v[0], v[1]); w.y = pk2(v[2], v[3]); w.z = pk2(v[4], v[5]); w.w = pk2(v[6], v[7]);
    return __builtin_bit_cast(bf16x8_t, w);
}
__device__ __forceinline__ void gla_prep(const Ctx& c, const Params& p, int unit) {
    const int bh = unit >> 6, ck = unit & 63, b = bh >> 2, hd = bh & 3, lane = c.lane, wv = c.wave;
    LAS bf16_t* Qs = (LAS bf16_t*)c.shm;
    LAS bf16_t* Ks = Qs + 64 * 136;
    const bf16_t* P = (const bf16_t*)(p.ws + OFF_P); unsigned char* R = p.ws + OFF_R;
    const bf16_t* GK = (const bf16_t*)(R + R_GK);   bf16_t* QT = (bf16_t*)(R + R_QT) + (size_t)unit * 64 * 128; bf16_t* ATT = (bf16_t*)(R + R_ATT) + (size_t)unit * 64 * 64;
    bf16_t* KHT = (bf16_t*)(R + R_KHT) + (size_t)unit * 128 * 64; float* GDEC = (float*)(R + R_GDEC) + (size_t)unit * 128;
    const size_t tg = (size_t)b * SEQ + ck * 64 + lane; const int d0 = wv * 16;
    __syncthreads();
    {
        const bf16_t* row = P + tg * OD_IN;
        const u32x4 qa = *(const u32x4*)(row + hd * 128 + d0), qb = *(const u32x4*)(row + hd * 128 + d0 + 8);
        const u32x4 ka = *(const u32x4*)(row + 512 + hd * 128 + d0), kb = *(const u32x4*)(row + 512 + hd * 128 + d0 + 8);
        const unsigned qw[8] = {qa.x, qa.y, qa.z, qa.w, qb.x, qb.y, qb.z, qb.w}, kw[8] = {ka.x, ka.y, ka.z, ka.w, kb.x, kb.y, kb.z, kb.w};
        float qt[16], kt[16], kh[16];
#pragma unroll
        for (int i4 = 0; i4 < 4; ++i4) { const u32x2 gw4 = *(const u32x2*)(GK + tg * 512 + hd * 128 + d0 + 4 * i4); const f32x4 g4 = (f32x4){bflo(gw4.x), bfhi(gw4.x), bflo(gw4.y), bfhi(gw4.y)};
#pragma unroll
            for (int ii = 0; ii < 4; ++ii) { const int i = 4 * i4 + ii;
                const float bb = wave_scan_incl(g4[ii], lane); const float bl = lane63(bb);
                const float qv = (i & 1) ? bfhi(qw[i >> 1]) : bflo(qw[i >> 1]), kv = (i & 1) ? bfhi(kw[i >> 1]) : bflo(kw[i >> 1]);
                qt[i] = qv * 0.08838834764831845f * __expf(bb); kt[i] = kv * __expf(-bb); kh[i] = kv * __expf(bl - bb);
                if (lane == 63) GDEC[d0 + i] = __expf(bl); } }
        { u32x4 w0, w1; w0.x = pk2(qt[0], qt[1]); w0.y = pk2(qt[2], qt[3]); w0.z = pk2(qt[4], qt[5]); w0.w = pk2(qt[6], qt[7]); w1.x = pk2(qt[8], qt[9]); w1.y = pk2(qt[10], qt[11]); w1.z = pk2(qt[12], qt[13]); w1.w = pk2(qt[14], qt[15]);
          *(LAS u32x4*)(Qs + lane * 136 + d0) = w0; *(LAS u32x4*)(Qs + lane * 136 + d0 + 8) = w1; }
        { u32x4 w0, w1; w0.x = pk2(kt[0], kt[1]); w0.y = pk2(kt[2], kt[3]); w0.z = pk2(kt[4], kt[5]); w0.w = pk2(kt[6], kt[7]); w1.x = pk2(kt[8], kt[9]); w1.y = pk2(kt[10], kt[11]); w1.z = pk2(kt[12], kt[13]); w1.w = pk2(kt[14], kt[15]);
          *(LAS u32x4*)(Ks + lane * 136 + d0) = w0; *(LAS u32x4*)(Ks + lane * 136 + d0 + 8) = w1; }
        { const int sg = d0 >> 5, hb = (d0 >> 4) & 1;
#pragma unroll
          for (int x4 = 0; x4 < 4; ++x4) { u32x2 w; w.x = pk2(qt[4 * x4], qt[4 * x4 + 1]); w.y = pk2(qt[4 * x4 + 2], qt[4 * x4 + 3]);
              *(u32x2*)(QT + lane * 128 + 32 * sg + 8 * x4 + 4 * hb) = w; } }
        { const int sc = key_perm(lane);
#pragma unroll
          for (int i = 0; i < 16; ++i) KHT[(d0 + i) * 64 + sc] = (bf16_t)f2bf(kh[i]); }
    }
    __syncthreads();
    const int fr = lane & 15, fq = lane >> 4;
#pragma unroll
    for (int h2 = 0; h2 < 2; ++h2) { const int tile = 2 * wv + h2, si = tile >> 2, ti = tile & 3;
        f32x4 acc = (f32x4){0.f, 0.f, 0.f, 0.f};
        if (si <= ti) {
#pragma unroll
            for (int kk = 0; kk < 4; ++kk) { const bf16x8_t a = *(const LAS bf16x8_t*)(Ks + (16 * si + fr) * 136 + 32 * kk + 8 * fq), bq = *(const LAS bf16x8_t*)(Qs + (16 * ti + fr) * 136 + 32 * kk + 8 * fq);
                acc = __builtin_amdgcn_mfma_f32_16x16x32_bf16(a, bq, acc, 0, 0, 0); } }
        const int t = 16 * ti + fr, s0 = 16 * si + 4 * fq;
        u32x2 w; w.x = pk2(s0 <= t ? acc[0] : 0.f, s0 + 1 <= t ? acc[1] : 0.f); w.y = pk2(s0 + 2 <= t ? acc[2] : 0.f, s0 + 3 <= t ? acc[3] : 0.f);
        *(u32x2*)(ATT + t * 64 + 32 * (si >> 1) + 8 * fq + 4 * (si & 1)) = w; }
}
constexpr int GB_QT = 0, GB_ATT = 64 * 136 * 2, GB_KHT = GB_ATT + 64 * 72 * 2, GB_GD = GB_KHT + 128 * 72 * 2, GB_V = GB_GD + 512, GB_BYTES = GB_V + 64 * 72 * 2;
struct GlaFill { u32x4 r[25]; };
__device__ __forceinline__ void gla_fill_load(GlaFill& f, const Params& p, int unit, int ptid, const bf16_t* vsrc) {
    const unsigned char* R = p.ws + OFF_R;
    const bf16_t* QT = (const bf16_t*)(R + R_QT) + (size_t)unit * 64 * 128; const bf16_t* ATT = (const bf16_t*)(R + R_ATT) + (size_t)unit * 64 * 64;
    const bf16_t* KHT = (const bf16_t*)(R + R_KHT) + (size_t)unit * 128 * 64; const float* GDEC = (const float*)(R + R_GDEC) + (size_t)unit * 128;
#pragma unroll
    for (int i = 0; i < 8; ++i) f.r[i] = *((const u32x4*)QT + ptid + 128 * i);
#pragma unroll
    for (int i = 0; i < 4; ++i) f.r[8 + i] = *((const u32x4*)ATT + ptid + 128 * i);
#pragma unroll
    for (int i = 0; i < 8; ++i) f.r[12 + i] = *((const u32x4*)KHT + ptid + 128 * i);
    f.r[20] = (u32x4){0u, 0u, 0u, 0u}; if (ptid < 32) f.r[20] = *((const u32x4*)GDEC + ptid);
#pragma unroll
    for (int i = 0; i < 4; ++i) { const int idx = ptid + 128 * i; f.r[21 + i] = __builtin_nontemporal_load((const u32x4*)(vsrc + (size_t)(idx >> 3) * OD_IN + (idx & 7) * 8)); }
}
__device__ __forceinline__ void gla_fill_store(const GlaFill& f, unsigned char* buf, int ptid) {
#pragma unroll
    for (int i = 0; i < 8; ++i) { const int idx = ptid + 128 * i; *(LAS u32x4*)(buf + GB_QT + (idx >> 4) * 272 + (idx & 15) * 16) = f.r[i]; }
#pragma unroll
    for (int i = 0; i < 4; ++i) { const int idx = ptid + 128 * i; *(LAS u32x4*)(buf + GB_ATT + (idx >> 3) * 144 + (idx & 7) * 16) = f.r[8 + i]; }
#pragma unroll
    for (int i = 0; i < 8; ++i) { const int idx = ptid + 128 * i; *(LAS u32x4*)(buf + GB_KHT + (idx >> 3) * 144 + (idx & 7) * 16) = f.r[12 + i]; }
    if (ptid < 32) *(LAS u32x4*)(buf + GB_GD + ptid * 16) = f.r[20];
#pragma unroll
    for (int i = 0; i < 4; ++i) { const int idx = ptid + 128 * i; *(LAS u32x4*)(buf + GB_V + (idx >> 3) * 144 + (idx & 7) * 16) = f.r[21 + i]; }
}
#define GLA_STEP_BARRIER() do { asm volatile("s_waitcnt lgkmcnt(0)" ::: "memory"); __builtin_amdgcn_s_barrier(); asm volatile("" ::: "memory"); } while (0)
__device__ __forceinline__ void gla_state(const Ctx& c, const Params& p, int bh, int slice) {
    const int b = bh >> 2, hd = bh & 3, lane = c.lane, wv = c.wave, fr = lane & 15, fq = lane >> 4, jl = wv & 3, jt = slice * 4 + jl;
    const bf16_t* P = (const bf16_t*)(p.ws + OFF_P); bf16_t* O = (bf16_t*)p.out;
    unsigned char* sm = c.shm;
    const size_t tb = (size_t)b * SEQ; const bf16_t* vbase = P + tb * OD_IN + 1024 + hd * 256 + 64 * slice;
    __syncthreads();
    if (wv >= 4) {
        const int pg = (wv - 4) >> 1, ptid = c.tid & 127;
        GlaFill fs;
        if (pg == 1) { gla_fill_load(fs, p, bh * 64, ptid, vbase); gla_fill_store(fs, sm, ptid); gla_fill_load(fs, p, bh * 64 + 2, ptid, vbase + (size_t)128 * OD_IN); } else gla_fill_load(fs, p, bh * 64 + 1, ptid, vbase + (size_t)64 * OD_IN);
        GLA_STEP_BARRIER();
#pragma unroll 1
        for (int ck = 0; ck < 64; ++ck) {
            if (((ck + 1) & 1) != pg && ck + 1 < 64) { gla_fill_store(fs, sm + ((ck + 1) & 1) * GB_BYTES, ptid); if (ck + 3 < 64) gla_fill_load(fs, p, bh * 64 + ck + 3, ptid, vbase + (size_t)(ck + 3) * 64 * OD_IN); }
            GLA_STEP_BARRIER();
        }
    } else if (wv < 2) {
        f32x4 S[2][8];
#pragma unroll
        for (int h = 0; h < 2; ++h)
#pragma unroll
            for (int i = 0; i < 8; ++i) S[h][i] = (f32x4){0.f, 0.f, 0.f, 0.f};
        bf16x8_t idf;
        { float iv[8];
#pragma unroll
          for (int e = 0; e < 8; ++e) iv[e] = (8 * fq + e == fr) ? 1.0f : 0.0f;
          idf = pack8(iv); }
        const int jt0 = slice * 4 + 2 * wv;
        GLA_STEP_BARRIER();
#pragma unroll 1
        for (int ck = 0; ck < 64; ++ck) {
            unsigned char* buf = sm + (ck & 1) * GB_BYTES; const size_t t0 = tb + ck * 64;
            const LAS bf16_t* QT = (const LAS bf16_t*)(buf + GB_QT); const LAS bf16_t* ATT = (const LAS bf16_t*)(buf + GB_ATT); const LAS bf16_t* KHT = (const LAS bf16_t*)(buf + GB_KHT); const LAS float* GD = (const LAS float*)(buf + GB_GD);
            const LAS bf16_t* VS = (const LAS bf16_t*)(buf + GB_V);
            bf16x8_t va[2][4], qf[4][4], af[2][4];
#pragma unroll
            for (int h = 0; h < 2; ++h)
#pragma unroll
                for (int st = 0; st < 4; ++st) { va[h][st] = zero_frag(); if (fq < 2) va[h][st] = lds_frag(VS, 72, 16 * st + fr, 32 * wv + 16 * h + 8 * fq); }
#pragma unroll
            for (int sg = 0; sg < 4; ++sg)
#pragma unroll
                for (int ti = 0; ti < 4; ++ti) qf[sg][ti] = lds_frag(QT, 136, 16 * ti + fr, 32 * sg + 8 * fq);
#pragma unroll
            for (int s2 = 0; s2 < 2; ++s2)
#pragma unroll
                for (int ti = 0; ti < 4; ++ti) af[s2][ti] = lds_frag(ATT, 72, 16 * ti + fr, 32 * s2 + 8 * fq);
            asm volatile("s_waitcnt lgkmcnt(0)" ::: "memory");
            bf16x8_t vf[2][2];
#pragma unroll
            for (int h = 0; h < 2; ++h) { f32x4 vt[4];
#pragma unroll
                for (int st = 0; st < 4; ++st) vt[st] = __builtin_amdgcn_mfma_f32_16x16x32_bf16(va[h][st], idf, (f32x4){0.f, 0.f, 0.f, 0.f}, 0, 0, 0);
#pragma unroll
                for (int s2 = 0; s2 < 2; ++s2) { const float vv[8] = {vt[2 * s2][0], vt[2 * s2][1], vt[2 * s2][2], vt[2 * s2][3], vt[2 * s2 + 1][0], vt[2 * s2 + 1][1], vt[2 * s2 + 1][2], vt[2 * s2 + 1][3]}; vf[h][s2] = pack8(vv); } }
            f32x4 acc[2][4];
#pragma unroll
            for (int h = 0; h < 2; ++h)
#pragma unroll
                for (int ti = 0; ti < 4; ++ti) acc[h][ti] = (f32x4){0.f, 0.f, 0.f, 0.f};
#pragma unroll
            for (int sg = 0; sg < 4; ++sg)
#pragma unroll
                for (int h = 0; h < 2; ++h) { const float sv[8] = {S[h][2 * sg][0], S[h][2 * sg][1], S[h][2 * sg][2], S[h][2 * sg][3], S[h][2 * sg + 1][0], S[h][2 * sg + 1][1], S[h][2 * sg + 1][2], S[h][2 * sg + 1][3]};
                    const bf16x8_t a = pack8(sv);
#pragma unroll
                    for (int ti = 0; ti < 4; ++ti) acc[h][ti] = __builtin_amdgcn_mfma_f32_16x16x32_bf16(a, qf[sg][ti], acc[h][ti], 0, 0, 0); }
#pragma unroll
            for (int s2 = 0; s2 < 2; ++s2)
#pragma unroll
                for (int h = 0; h < 2; ++h)
#pragma unroll
                    for (int ti = 0; ti < 4; ++ti) acc[h][ti] = __builtin_amdgcn_mfma_f32_16x16x32_bf16(vf[h][s2], af[s2][ti], acc[h][ti], 0, 0, 0);
#pragma unroll
            for (int h = 0; h < 2; ++h)
#pragma unroll
                for (int ti = 0; ti < 4; ++ti) { u32x2 w; w.x = pk2(acc[h][ti][0], acc[h][ti][1]); w.y = pk2(acc[h][ti][2], acc[h][ti][3]);
                    *(u32x2*)(O + (t0 + 16 * ti + fr) * 1024 + hd * 256 + 16 * (jt0 + h) + 4 * fq) = w; }
#pragma unroll
            for (int rt = 0; rt < 8; ++rt) { const f32x4 g4 = *(const LAS f32x4*)(GD + 16 * rt + 4 * fq);
                const bf16x8_t k0 = lds_frag(KHT, 72, 16 * rt + fr, 8 * fq), k1 = lds_frag(KHT, 72, 16 * rt + fr, 32 + 8 * fq);
#pragma unroll
                for (int h = 0; h < 2; ++h) { f32x4 s = S[h][rt] * g4; s = __builtin_amdgcn_mfma_f32_16x16x32_bf16(k0, vf[h][0], s, 0, 0, 0); s = __builtin_amdgcn_mfma_f32_16x16x32_bf16(k1, vf[h][1], s, 0, 0, 0); S[h][rt] = s; } }
            GLA_STEP_BARRIER();
        }
    } else {
        GLA_STEP_BARRIER();
#pragma unroll 1
        for (int ck = 0; ck < 64; ++ck) GLA_STEP_BARRIER();
    }
}
__device__ __forceinline__ void gla_finish(const Ctx& c, const Params& p) {
    const bf16_t* P = (const bf16_t*)(p.ws + OFF_P); bf16_t* O = (bf16_t*)p.out;
    const f32x4 gn = *((const f32x4*)p.od_onorm + c.lane);
    for (int jj = 0; jj < 8; ++jj) { const int r0 = (blockIdx.x & 7) * 4096 + (blockIdx.x >> 3) * 8 + c.wave + 512 * jj;
        u32x2 ow[2][4], gw[2][4];
#pragma unroll
        for (int q = 0; q < 2; ++q)
#pragma unroll
            for (int j = 0; j < 4; ++j) { const size_t r = (size_t)(r0 + q * 256); ow[q][j] = __builtin_nontemporal_load((const u32x2*)(O + r * 1024 + 256 * j) + c.lane); gw[q][j] = __builtin_nontemporal_load((const u32x2*)(P + r * OD_IN + 2048 + 256 * j) + c.lane); }
#pragma unroll
        for (int q = 0; q < 2; ++q)
#pragma unroll
            for (int j = 0; j < 4; ++j) { const size_t r = (size_t)(r0 + q * 256);
                const float o0 = bflo(ow[q][j].x), o1 = bfhi(ow[q][j].x), o2 = bflo(ow[q][j].y), o3 = bfhi(ow[q][j].y);
                const float ss = wave_sum(o0 * o0 + o1 * o1 + o2 * o2 + o3 * o3); const float rs = 1.0f / sqrtf(ss * (1.0f / 256.0f) + 1e-6f);
                const float g0 = bflo(gw[q][j].x), g1 = bfhi(gw[q][j].x), g2 = bflo(gw[q][j].y), g3 = bfhi(gw[q][j].y);
                u32x2 w; w.x = pk2(o0 * rs * gn.x * g0 * sigmoidf_(g0), o1 * rs * gn.y * g1 * sigmoidf_(g1)); w.y = pk2(o2 * rs * gn.z * g2 * sigmoidf_(g2), o3 * rs * gn.w * g3 * sigmoidf_(g3));
                *((u32x2*)(O + r * 1024 + 256 * j) + c.lane) = w; }
    }
}
constexpr size_t R_MG = 0, R_NT = 32 * MiB, R_QG = 64 * MiB, R_Y0 = 96 * MiB, R_Z0 = 128 * MiB, R_GAM = 160 * MiB, R_BON = 161 * MiB, R_MEMN = 164 * MiB;
constexpr size_t WSM_W2T = 0, WSM_A2T = 64 * 1024;
constexpr size_t WSM_G2T = 512 * 1024;
constexpr int XI = 64 * 72 * 2;
constexpr int X_RHS = 11 * XI, X_DIAG = X_RHS + 34816, X_TI = X_DIAG + 4352, X_RED = X_TI + 3072;

struct RxPre { u32x4 c1[2], p1[2], cr[3], prow; };
__device__ __forceinline__ void rwkv_x_fetch(RxPre& f, const bf16_t* P, int b, int hd, int ck, int tid, int lane, int wv) {
    const size_t tg0 = (size_t)b * SEQ + (size_t)ck * 64; const u32x4 z = (u32x4){0u, 0u, 0u, 0u};
#pragma unroll
    for (int i = 0; i < 2; ++i) { const int task = tid + 512 * i, tt = task >> 4, q = task & 15; const bf16_t* src = P + (tg0 + tt) * EV_IN + 768 + 1536 + 8 * q;
        f.c1[i] = *(const u32x4*)src; f.p1[i] = z; if (ck * 64 + tt > 0) f.p1[i] = *(const u32x4*)(src - EV_IN); }
    const bf16_t* src = P + (tg0 + (tid >> 3)) * EV_IN + 768 + hd * 64 + (tid & 7) * 8;
#pragma unroll
    for (int w3 = 0; w3 < 3; ++w3) f.cr[w3] = __builtin_nontemporal_load((const u32x4*)(src + 512 * w3));
    f.prow = z; if (tid < 24 && ck > 0) f.prow = *(const u32x4*)(P + (tg0 - 1) * EV_IN + 768 + 512 * (tid >> 3) + hd * 64 + (tid & 7) * 8);
    (void)lane; (void)wv;
}
struct RxW { bf16x8_t wt[4][2]; };
__device__ __forceinline__ void rwkv_x_weights(RxW& k, const Params& p, int hd, int lane, int wv) {
    const int fr = lane & 15, fq = lane >> 4, mat = wv >> 2; const bf16_t* WT = (const bf16_t*)(p.ws + OFF_WSMALL + (mat ? WSM_A2T : WSM_W2T));
#pragma unroll
    for (int n = 0; n < 4; ++n) { const int tile = (wv & 3) * 4 + n, ct = tile >> 2;
#pragma unroll
        for (int kk = 0; kk < 2; ++kk) k.wt[n][kk] = *(const bf16x8_t*)(WT + (size_t)(hd * 64 + 16 * ct + fr) * 64 + 32 * kk + 8 * fq); }
}
template <bool TWO>
__device__ __forceinline__ void rx_tiles(f32x4 (&acc)[2][4], const LAS bf16_t* A0, const LAS bf16_t* B0, const LAS bf16_t* A1, const LAS bf16_t* B1, int rt0, int fr, int fq) {
    bf16x8_t b0[4][2], b1[4][2], a0[2][2], a1[2][2];
#pragma unroll
    for (int ct = 0; ct < 4; ++ct)
#pragma unroll
        for (int kk = 0; kk < 2; ++kk) { b0[ct][kk] = lds_frag(B0, 72, 16 * ct + fr, 32 * kk + 8 * fq); if (TWO) b1[ct][kk] = lds_frag(B1, 72, 16 * ct + fr, 32 * kk + 8 * fq); }
#pragma unroll
    for (int r = 0; r < 2; ++r)
#pragma unroll
        for (int kk = 0; kk < 2; ++kk) { a0[r][kk] = lds_frag(A0, 72, 16 * (rt0 + r) + fr, 32 * kk + 8 * fq); if (TWO) a1[r][kk] = lds_frag(A1, 72, 16 * (rt0 + r) + fr, 32 * kk + 8 * fq); }
#pragma unroll
    for (int kk = 0; kk < 2; ++kk)
#pragma unroll
        for (int r = 0; r < 2; ++r)
#pragma unroll
            for (int ct = 0; ct < 4; ++ct) acc[r][ct] = __builtin_amdgcn_mfma_f32_16x16x32_bf16(a0[r][kk], b0[ct][kk], acc[r][ct], 0, 0, 0);
    if (TWO) {
#pragma unroll
        for (int kk = 0; kk < 2; ++kk)
#pragma unroll
            for (int r = 0; r < 2; ++r)
#pragma unroll
                for (int ct = 0; ct < 4; ++ct) acc[r][ct] = __builtin_amdgcn_mfma_f32_16x16x32_bf16(a1[r][kk], b1[ct][kk], acc[r][ct], 0, 0, 0); }
}
template <int HALF>
__device__ __forceinline__ void rx_s_half(const LAS bf16_t* Ximg, const LAS bf16_t* Yimg, LAS bf16_t* Oimg, LAS float* DIAG, int mat, int fr, int fq) {
    constexpr int SI0 = HALF ? 1 : 0, NS = HALF ? 3 : 2, TI0 = HALF ? 2 : 0, NT_ = HALF ? 2 : 4;
    bf16x8_t yf[NS][2], xf[NT_][2];
#pragma unroll
    for (int s = 0; s < NS; ++s)
#pragma unroll
        for (int kk = 0; kk < 2; ++kk) yf[s][kk] = lds_frag(Yimg, 72, 16 * (SI0 + s) + fr, 32 * kk + 8 * fq);
#pragma unroll
    for (int t = 0; t < NT_; ++t)
#pragma unroll
        for (int kk = 0; kk < 2; ++kk) xf[t][kk] = lds_frag(Ximg, 72, 16 * (TI0 + t) + fr, 32 * kk + 8 * fq);
    f32x4 acc[5];
#pragma unroll
    for (int n = 0; n < 5; ++n) { const int si = HALF ? (n < 2 ? 1 : (n < 4 ? 2 : 3)) : (n < 4 ? 0 : 1), ti = HALF ? (n == 4 ? 3 : 2 + (n & 1)) : (n < 4 ? n : 1);
        acc[n] = (f32x4){0.f, 0.f, 0.f, 0.f};
#pragma unroll
        for (int kk = 0; kk < 2; ++kk) acc[n] = __builtin_amdgcn_mfma_f32_16x16x32_bf16(yf[si - SI0][kk], xf[ti - TI0][kk], acc[n], 0, 0, 0); }
#pragma unroll
    for (int n = 0; n < 5; ++n) { const int si = HALF ? (n < 2 ? 1 : (n < 4 ? 2 : 3)) : (n < 4 ? 0 : 1), ti = HALF ? (n == 4 ? 3 : 2 + (n & 1)) : (n < 4 ? n : 1);
        const int tt = 16 * ti + fr, s0 = 16 * si + 4 * fq; float o0 = acc[n][0], o1 = acc[n][1], o2 = acc[n][2], o3 = acc[n][3];
        if (si == ti) { const int lim = (mat < 2) ? tt - 1 : tt;
            o0 = s0 <= lim ? o0 : 0.f; o1 = s0 + 1 <= lim ? o1 : 0.f; o2 = s0 + 2 <= lim ? o2 : 0.f; o3 = s0 + 3 <= lim ? o3 : 0.f;
            if (mat == 0) { LAS float* d = DIAG + si * 272 + fr * 17 + 4 * fq; d[0] = o0; d[1] = o1; d[2] = o2; d[3] = o3; } }
        u32x2 w; w.x = pk2(o0, o1); w.y = pk2(o2, o3); *(LAS u32x2*)(Oimg + tt * 72 + s0) = w; }
#pragma unroll
    for (int n = 0; n < 3; ++n) { const int si = HALF ? 3 : (n == 0 ? 1 : 2), ti = HALF ? n : (n == 2 ? 1 : 0);
        *(LAS u32x2*)(Oimg + (16 * ti + fr) * 72 + 16 * si + 4 * fq) = (u32x2){0u, 0u}; }
}
__device__ __forceinline__ void rwkv_x(const Ctx& c, const Params& p, int unit, RxPre& pre, const RxW& kw, int nb, int nhd, int nck) {
    const int bh = unit >> 6, ck = unit & 63, b = bh >> 3, hd = bh & 7, tid = c.tid, lane = c.lane, wv = c.wave, fr = lane & 15, fq = lane >> 4;
    unsigned char* sm = c.shm;
    LAS bf16_t* At = (LAS bf16_t*)sm; LAS bf16_t* Bt = (LAS bf16_t*)(sm + XI); LAS bf16_t* Kt = (LAS bf16_t*)(sm + 2 * XI); LAS bf16_t* Rt = (LAS bf16_t*)(sm + 3 * XI);
    LAS bf16_t* BH = (LAS bf16_t*)(sm + 4 * XI); LAS bf16_t* KH = (LAS bf16_t*)(sm + 5 * XI); LAS bf16_t* VT = (LAS bf16_t*)(sm + 6 * XI);
    LAS bf16_t* AAB = (LAS bf16_t*)(sm + 7 * XI); LAS bf16_t* AAK = (LAS bf16_t*)(sm + 8 * XI); LAS bf16_t* ARB = (LAS bf16_t*)(sm + 9 * XI); LAS bf16_t* ARK = (LAS bf16_t*)(sm + 10 * XI);
    LAS bf16_t* XT = At;
    LAS bf16_t* YT = Kt;
    LAS float* RHS = (LAS float*)(sm + X_RHS);
    LAS float* sXW = RHS; LAS float* sXA = RHS + 64 * 68;
    LAS float* DIAG = (LAS float*)(sm + X_DIAG);
    LAS bf16_t* TI = (LAS bf16_t*)(sm + X_TI);
    LAS float* red = (LAS float*)(sm + X_RED);
    const LAS float* CT = (const LAS float*)(sm + X_RED + 4096);
    const bf16_t* P = (const bf16_t*)(p.ws + OFF_P); unsigned char* R = p.ws + OFF_R;
    const size_t tg0 = (size_t)b * SEQ + (size_t)ck * 64;
    const int t = lane, cg = wv, ch0 = hd * 64 + cg * 8;
    GLA_STEP_BARRIER();
#pragma unroll
    for (int i = 0; i < 2; ++i) {
        const int task = tid + 512 * i, tt = task >> 4, q = task & 15;
        const int col = 1536 + 8 * q; LAS bf16_t* dst = (q < 8 ? At + tt * 72 + 8 * q : Bt + tt * 72 + 8 * (q - 8));
        const u32x4 cur = pre.c1[i], prv = pre.p1[i];
        const f32x4 m0 = *(const LAS f32x4*)(CT + 8 * q), m1 = *(const LAS f32x4*)(CT + 8 * q + 4); (void)col;
        const unsigned cw[4] = {cur.x, cur.y, cur.z, cur.w}, pw[4] = {prv.x, prv.y, prv.z, prv.w}; const float mu[8] = {m0.x, m0.y, m0.z, m0.w, m1.x, m1.y, m1.z, m1.w};
        float v[8];
#pragma unroll
        for (int k = 0; k < 4; ++k) { const float c0 = bflo(cw[k]), c1 = bfhi(cw[k]), p0 = bflo(pw[k]), p1 = bfhi(pw[k]); v[2 * k] = c0 + (p0 - c0) * mu[2 * k]; v[2 * k + 1] = c1 + (p1 - c1) * mu[2 * k + 1]; }
        if (q < 8) {
#pragma unroll
            for (int k = 0; k < 8; ++k) v[k] = tanhf_(v[k]); }
        { u32x4 w; w.x = pk2(v[0], v[1]); w.y = pk2(v[2], v[3]); w.z = pk2(v[4], v[5]); w.w = pk2(v[6], v[7]); *(LAS u32x4*)dst = w; }
    }
    {
        LAS bf16_t* STG = AAB; const int row = tid >> 3, pc = tid & 7;
#pragma unroll
        for (int w3 = 0; w3 < 3; ++w3) *(LAS u32x4*)(STG + (row + 1) * 200 + 64 * w3 + 8 * pc) = pre.cr[w3];
        if (tid < 24) *(LAS u32x4*)(STG + 64 * (tid >> 3) + 8 * (tid & 7)) = pre.prow;
    }
    if (nck >= 0) rwkv_x_fetch(pre, P, nb, nhd, nck, tid, lane, wv);
    GLA_STEP_BARRIER();
    {
        const int mat = wv >> 2; const LAS bf16_t* img = mat ? Bt : At; LAS float* dstm = mat ? sXA : sXW;
#pragma unroll
        for (int n = 0; n < 4; ++n) { const int tile = (wv & 3) * 4 + n, ct = tile >> 2, tt = tile & 3;
            f32x4 acc = (f32x4){0.f, 0.f, 0.f, 0.f};
#pragma unroll
            for (int kk = 0; kk < 2; ++kk) acc = __builtin_amdgcn_mfma_f32_16x16x32_bf16(kw.wt[n][kk], lds_frag(img, 72, 16 * tt + fr, 32 * kk + 8 * fq), acc, 0, 0, 0);
            *(LAS f32x4*)(dstm + (16 * tt + fr) * 68 + 16 * ct + 4 * fq) = acc; }
    }
    float rv[8], kv[8], vv[8];
    {
        const LAS bf16_t* STG = AAB;
#pragma unroll
        for (int w3 = 0; w3 < 3; ++w3) { const u32x4 cur = *(const LAS u32x4*)(STG + (t + 1) * 200 + 64 * w3 + cg * 8), prv = *(const LAS u32x4*)(STG + t * 200 + 64 * w3 + cg * 8);
            const f32x4 m0 = *(const LAS f32x4*)(CT + 128 + 64 * w3 + cg * 8), m1 = *(const LAS f32x4*)(CT + 128 + 64 * w3 + cg * 8 + 4);
            const unsigned cw[4] = {cur.x, cur.y, cur.z, cur.w}, pw[4] = {prv.x, prv.y, prv.z, prv.w}; const float mu[8] = {m0.x, m0.y, m0.z, m0.w, m1.x, m1.y, m1.z, m1.w};
#pragma unroll
            for (int k = 0; k < 4; ++k) { const float c0 = bflo(cw[k]), c1 = bfhi(cw[k]), p0 = bflo(pw[k]), p1 = bfhi(pw[k]);
                const float x0 = c0 + (p0 - c0) * mu[2 * k], x1 = c1 + (p1 - c1) * mu[2 * k + 1];
                if (w3 == 0) { rv[2 * k] = x0; rv[2 * k + 1] = x1; } else if (w3 == 1) { kv[2 * k] = x0; kv[2 * k + 1] = x1; } else { vv[2 * k] = x0; vv[2 * k + 1] = x1; } } }
    }
    GLA_STEP_BARRIER();
    float zw[8], za[8];
    { const f32x4 a0 = *(const LAS f32x4*)(sXW + t * 68 + cg * 8), a1 = *(const LAS f32x4*)(sXW + t * 68 + cg * 8 + 4), b0 = *(const LAS f32x4*)(sXA + t * 68 + cg * 8), b1 = *(const LAS f32x4*)(sXA + t * 68 + cg * 8 + 4);
      zw[0] = a0.x; zw[1] = a0.y; zw[2] = a0.z; zw[3] = a0.w; zw[4] = a1.x; zw[5] = a1.y; zw[6] = a1.z; zw[7] = a1.w;
      za[0] = b0.x; za[1] = b0.y; za[2] = b0.z; za[3] = b0.w; za[4] = b1.x; za[5] = b1.y; za[6] = b1.z; za[7] = b1.w; }
    float lw[8], av[8], kkv[8], kp[8]; float ss = 0.f, sb = 0.f;
#pragma unroll
    for (int i = 0; i < 8; ++i) { const int ch = ch0 + i;
        const float u = -(CT[320 + cg * 8 + i] + zw[i]); (void)ch; const float sp = (u > 20.f) ? u : __logf(1.0f + __expf(u));
        lw[i] = -__expf(-sp - 0.5f);
        av[i] = sigmoidf_(CT[384 + cg * 8 + i] + za[i]);
        kkv[i] = kv[i] * CT[448 + cg * 8 + i]; ss += kkv[i] * kkv[i];
        kp[i] = kv[i] * (1.0f + (av[i] - 1.0f) * CT[512 + cg * 8 + i]);
        sb += rv[i] * kp[i] * CT[576 + cg * 8 + i]; }
    red[t * 8 + cg] = ss; red[512 + t * 8 + cg] = sb;
    GLA_STEP_BARRIER();
    {
        float tot = 0.f, bon = 0.f;
#pragma unroll
        for (int i = 0; i < 8; ++i) { tot += red[t * 8 + i]; bon += red[512 + t * 8 + i]; }
        if (cg == 0) ((float*)(R + R_BON))[(tg0 + t) * 8 + hd] = bon;
        const float inv = __builtin_amdgcn_rcpf(fmaxf(sqrtf(tot), 1e-12f));
        float at[8], rt_[8], bt[8], kt[8], bh_[8], kh_[8];
#pragma unroll
        for (int i = 0; i < 8; ++i) {
            const float cl = wave_scan_incl(lw[i], lane); const float cl63 = lane63(cl);
            const float e1 = __expf(cl), e0 = __expf(cl - lw[i]), en = __expf(-cl), eh = __expf(cl63 - cl);
            const float kn = kkv[i] * inv, A = -kn, Bv = kn * av[i];
            at[i] = A * e0; rt_[i] = rv[i] * e1; bt[i] = Bv * en; kt[i] = kp[i] * en; bh_[i] = Bv * eh; kh_[i] = kp[i] * eh;
            if (lane == 63) ((float*)(R + R_GAM))[(size_t)unit * 64 + cg * 8 + i] = __expf(cl63); }
        { u32x4 w; w.x = pk2(at[0], at[1]); w.y = pk2(at[2], at[3]); w.z = pk2(at[4], at[5]); w.w = pk2(at[6], at[7]); *(LAS u32x4*)(At + t * 72 + cg * 8) = w; }
        { u32x4 w; w.x = pk2(rt_[0], rt_[1]); w.y = pk2(rt_[2], rt_[3]); w.z = pk2(rt_[4], rt_[5]); w.w = pk2(rt_[6], rt_[7]); *(LAS u32x4*)(Rt + t * 72 + cg * 8) = w; }
        { u32x4 w; w.x = pk2(bt[0], bt[1]); w.y = pk2(bt[2], bt[3]); w.z = pk2(bt[4], bt[5]); w.w = pk2(bt[6], bt[7]); *(LAS u32x4*)(Bt + t * 72 + cg * 8) = w; }
        { u32x4 w; w.x = pk2(kt[0], kt[1]); w.y = pk2(kt[2], kt[3]); w.z = pk2(kt[4], kt[5]); w.w = pk2(kt[6], kt[7]); *(LAS u32x4*)(Kt + t * 72 + cg * 8) = w; }
        *(LAS f32x4*)(RHS + t * 132 + 64 + cg * 8) = (f32x4){at[0], at[1], at[2], at[3]}; *(LAS f32x4*)(RHS + t * 132 + 64 + cg * 8 + 4) = (f32x4){at[4], at[5], at[6], at[7]};
#pragma unroll
        for (int i = 0; i < 8; ++i) { BH[(cg * 8 + i) * 72 + t] = (bf16_t)f2bf(bh_[i]); KH[(cg * 8 + i) * 72 + t] = (bf16_t)f2bf(kh_[i]); VT[(cg * 8 + i) * 72 + t] = (bf16_t)f2bf(vv[i]); }
    }
    GLA_STEP_BARRIER();
    {
        const int mat = wv >> 1;
        const LAS bf16_t* Ximg = (mat < 2) ? At : Rt; const LAS bf16_t* Yimg = (mat & 1) ? Kt : Bt;
        LAS bf16_t* Oimg = mat == 0 ? AAB : (mat == 1 ? AAK : (mat == 2 ? ARB : ARK));
        if ((wv & 1) == 0) rx_s_half<0>(Ximg, Yimg, Oimg, DIAG, mat, fr, fq); else rx_s_half<1>(Ximg, Yimg, Oimg, DIAG, mat, fr, fq);
    }
    GLA_STEP_BARRIER();
    if (wv < 4) {
#pragma unroll
        for (int ti = 0; ti < 4; ++ti) { f32x4 acc = (f32x4){0.f, 0.f, 0.f, 0.f};
#pragma unroll
            for (int kk = 0; kk < 2; ++kk) acc = __builtin_amdgcn_mfma_f32_16x16x32_bf16(lds_frag(AAK, 72, 16 * ti + fr, 32 * kk + 8 * fq), lds_frag(VT, 72, 16 * wv + fr, 32 * kk + 8 * fq), acc, 0, 0, 0);
#pragma unroll
            for (int r = 0; r < 4; ++r) RHS[(16 * ti + 4 * fq + r) * 132 + 16 * wv + fr] = acc[r]; }
    } else if (lane < 16) { const int I = wv - 4; const LAS float* d = DIAG + I * 272; float T[16];
#pragma unroll
        for (int r = 0; r < 16; ++r) { float s = (r == lane) ? 1.f : 0.f;
#pragma unroll
            for (int q = 0; q < r; ++q) s += d[r * 17 + q] * T[q];
            T[r] = s; TI[I * 384 + r * 24 + lane] = (bf16_t)f2bf(s); } }
    GLA_STEP_BARRIER();
#pragma unroll 1
    for (int I = 0; I < 4; ++I) {
        f32x4 acc;
#pragma unroll
        for (int r = 0; r < 4; ++r) acc[r] = RHS[(16 * I + 4 * fq + r) * 132 + 16 * wv + fr];
#pragma unroll 1
        for (int kk = 0; 32 * kk < 16 * I; ++kk) { const bool ok = (32 * kk + 8 * fq) < 16 * I;
            bf16x8_t a = zero_frag(), bq = zero_frag();
            if (ok) { a = lds_frag(AAB, 72, 16 * I + fr, 32 * kk + 8 * fq); bq = lds_frag(XT, 72, 16 * wv + fr, 32 * kk + 8 * fq); }
            acc = __builtin_amdgcn_mfma_f32_16x16x32_bf16(a, bq, acc, 0, 0, 0); }
        { u32x2 w; w.x = pk2(acc[0], acc[1]); w.y = pk2(acc[2], acc[3]); *(LAS u32x2*)(YT + (16 * wv + fr) * 24 + 4 * fq) = w; }
        LDS_WAIT();
        { bf16x8_t a = zero_frag(), bq = zero_frag();
          if (fq < 2) { a = *(const LAS bf16x8_t*)(TI + I * 384 + fr * 24 + 8 * fq); bq = *(const LAS bf16x8_t*)(YT + (16 * wv + fr) * 24 + 8 * fq); }
          f32x4 x = __builtin_amdgcn_mfma_f32_16x16x32_bf16(a, bq, (f32x4){0.f, 0.f, 0.f, 0.f}, 0, 0, 0);
          u32x2 w; w.x = pk2(x[0], x[1]); w.y = pk2(x[2], x[3]); *(LAS u32x2*)(XT + (16 * wv + fr) * 72 + 16 * I + 4 * fq) = w; }
        LDS_WAIT();
    }
    GLA_STEP_BARRIER();
    {
        const int mat = wv >> 1, rt0 = 2 * (wv & 1);
        f32x4 acc[2][4];
#pragma unroll
        for (int r = 0; r < 2; ++r)
#pragma unroll
            for (int ct = 0; ct < 4; ++ct) acc[r][ct] = (f32x4){0.f, 0.f, 0.f, 0.f};
        if (mat == 0) rx_tiles<false>(acc, XT + 64 * 72, BH, XT, BH, rt0, fr, fq);
        else if (mat == 1) rx_tiles<true>(acc, BH, XT, KH, VT, rt0, fr, fq);
        else if (mat == 2) {
#pragma unroll
            for (int r = 0; r < 2; ++r)
#pragma unroll
                for (int ct = 0; ct < 4; ++ct) { const u32x2 r2 = *(const LAS u32x2*)(Rt + (16 * ct + fr) * 72 + 16 * (rt0 + r) + 4 * fq); acc[r][ct] = (f32x4){bflo(r2.x), bfhi(r2.x), bflo(r2.y), bfhi(r2.y)}; }
            rx_tiles<false>(acc, XT + 64 * 72, ARB, XT, ARB, rt0, fr, fq); }
        else rx_tiles<true>(acc, XT, ARB, VT, ARK, rt0, fr, fq);
        bf16_t* dst = (bf16_t*)(R + (mat == 0 ? R_MG : mat == 1 ? R_NT : mat == 2 ? R_QG : R_Y0)) + (size_t)unit * 4096 + fr * 64;
#pragma unroll
        for (int r = 0; r < 2; ++r) { const int rt = rt0 + r; const int ro = (mat == 0) ? 32 * (rt >> 1) + 8 * fq + 4 * (rt & 1) : 16 * rt + 4 * fq;
#pragma unroll
            for (int ct = 0; ct < 4; ++ct) { u32x2 w; w.x = pk2(acc[r][ct][0], acc[r][ct][1]); w.y = pk2(acc[r][ct][2], acc[r][ct][3]); *(u32x2*)(dst + 16 * ct * 64 + ro) = w; } }
    }
}

constexpr int RY_SLOT = 2 * 64 * 72 * 2 + 256;
struct RyFill { u32x4 m[8], n[8], g; };
__device__ __forceinline__ void rwkv_y_fetch(RyFill& f, const unsigned char* R, size_t unit, int lane) {
    const u32x4* MG = (const u32x4*)((const bf16_t*)(R + R_MG) + unit * 4096); const u32x4* NT = (const u32x4*)((const bf16_t*)(R + R_NT) + unit * 4096); const u32x4* GAM = (const u32x4*)((const float*)(R + R_GAM) + unit * 64);
#pragma unroll
    for (int i = 0; i < 8; ++i) { f.m[i] = __builtin_nontemporal_load(MG + lane + 64 * i); f.n[i] = __builtin_nontemporal_load(NT + lane + 64 * i); }
    f.g = (u32x4){0u, 0u, 0u, 0u}; if (lane < 16) f.g = GAM[lane];
}
__device__ __forceinline__ void rwkv_y_put(const RyFill& f, unsigned char* slot, int lane) {
#pragma unroll
    for (int i = 0; i < 8; ++i) { const int idx = lane + 64 * i; *(LAS u32x4*)(slot + (idx >> 3) * 144 + (idx & 7) * 16) = f.m[i]; *(LAS u32x4*)(slot + 9216 + (idx >> 3) * 144 + (idx & 7) * 16) = f.n[i]; }
    if (lane < 16) *(LAS u32x4*)(slot + 18432 + lane * 16) = f.g;
}
__device__ __forceinline__ void rwkv_y(const Ctx& c, const Params& p, int bh) {
    const int lane = c.lane, wv = c.wave, fr = lane & 15, fq = lane >> 4, jb = wv & 3, g = wv - 4; unsigned char* R = p.ws + OFF_R; unsigned char* sm = c.shm;
    f32x4 Z[4];
#pragma unroll
    for (int i = 0; i < 4; ++i) Z[i] = (f32x4){0.f, 0.f, 0.f, 0.f};
    RyFill fs;
    __syncthreads();
    if (wv >= 4) {
        if (g == 0) { rwkv_y_fetch(fs, R, (size_t)bh * 64, lane); rwkv_y_put(fs, sm, lane); rwkv_y_fetch(fs, R, (size_t)bh * 64 + 4, lane); }
        else rwkv_y_fetch(fs, R, (size_t)bh * 64 + g, lane);
    }
    __syncthreads();
#pragma unroll 1
    for (int ck = 0; ck < 64; ++ck) {
        if (wv >= 4) {
            if (((ck + 1) & 3) == g && ck + 1 < 64) { rwkv_y_put(fs, sm + ((ck + 1) & 7) * RY_SLOT, lane); if (ck + 5 < 64) rwkv_y_fetch(fs, R, (size_t)bh * 64 + ck + 5, lane); }
        } else {
            const size_t unit = (size_t)bh * 64 + ck; const unsigned char* slot = sm + (ck & 7) * RY_SLOT;
            const LAS bf16_t* MGs = (const LAS bf16_t*)slot; const LAS bf16_t* NTs = (const LAS bf16_t*)(slot + 9216); const LAS float* GMs = (const LAS float*)(slot + 18432);
            bf16x8_t mf[4][2]; u32x2 nn[4]; f32x4 gg[4];
#pragma unroll
            for (int rt = 0; rt < 4; ++rt) {
#pragma unroll
                for (int sg = 0; sg < 2; ++sg) mf[rt][sg] = lds_frag(MGs, 72, 16 * rt + fr, 32 * sg + 8 * fq);
                nn[rt] = *(const LAS u32x2*)(NTs + (16 * jb + fr) * 72 + 16 * rt + 4 * fq); gg[rt] = *(const LAS f32x4*)(GMs + 16 * rt + 4 * fq); }
            bf16_t* Z0 = (bf16_t*)(R + R_Z0) + unit * 4096;
            bf16x8_t zb[2];
#pragma unroll
            for (int sg = 0; sg < 2; ++sg) { const float zv[8] = {Z[2 * sg][0], Z[2 * sg][1], Z[2 * sg][2], Z[2 * sg][3], Z[2 * sg + 1][0], Z[2 * sg + 1][1], Z[2 * sg + 1][2], Z[2 * sg + 1][3]}; zb[sg] = pack8(zv); }
#pragma unroll
            for (int rt = 0; rt < 4; ++rt) { u32x2 w; w.x = pk2(Z[rt][0], Z[rt][1]); w.y = pk2(Z[rt][2], Z[rt][3]); *(u32x2*)(Z0 + (16 * jb + fr) * 64 + 16 * rt + 4 * fq) = w; }
            asm volatile("s_waitcnt lgkmcnt(0)" ::: "memory");
            f32x4 acc[4];
#pragma unroll
            for (int rt = 0; rt < 4; ++rt) { acc[rt] = (f32x4){bflo(nn[rt].x), bfhi(nn[rt].x), bflo(nn[rt].y), bfhi(nn[rt].y)} + gg[rt] * Z[rt];
#pragma unroll
                for (int sg = 0; sg < 2; ++sg) acc[rt] = __builtin_amdgcn_mfma_f32_16x16x32_bf16(mf[rt][sg], zb[sg], acc[rt], 0, 0, 0); }
#pragma unroll
            for (int rt = 0; rt < 4; ++rt) Z[rt] = acc[rt];
        }
        asm volatile("s_waitcnt lgkmcnt(0)" ::: "memory"); __builtin_amdgcn_s_barrier(); asm volatile("" ::: "memory");
    }
}

__device__ __forceinline__ unsigned dpp_shr1_or(unsigned old, unsigned v) { return (unsigned)__builtin_amdgcn_update_dpp((int)old, (int)v, 0x111, 0xF, 0xF, false); }
__device__ __forceinline__ unsigned dpp_ror1(unsigned v) { return (unsigned)__builtin_amdgcn_update_dpp(0, (int)v, 0x121, 0xF, 0xF, false); }
__device__ __forceinline__ void rwkv_z(const Ctx& c, const Params& p, int unit) {
    const int bh = unit >> 6, ck = unit & 63, b = bh >> 3, hd = bh & 7, lane = c.lane, fr = lane & 15, fq = lane >> 4; unsigned char* R = p.ws + OFF_R;
    const bf16_t* P = (const bf16_t*)(p.ws + OFF_P); bf16_t* MIX = (bf16_t*)p.out;
    const bf16_t* QG = (const bf16_t*)(R + R_QG) + (size_t)unit * 4096; const bf16_t* Y0G = (const bf16_t*)(R + R_Y0) + (size_t)unit * 4096; const bf16_t* Z0 = (const bf16_t*)(R + R_Z0) + (size_t)unit * 4096;
    const LAS bf16_t* G2s = (const LAS bf16_t*)c.shm;
    const LAS float* CZ = (const LAS float*)(c.shm + 17408);
    const size_t tg0 = (size_t)b * SEQ + (size_t)ck * 64;
    const bool hp0 = (ck * 64 + fr > 0);
    u32x2 gp[4][4];
    {
        f32x4 g[4][4];
        const bf16_t* Grow = P + (tg0 + fr) * EV_IN + 768 + 1664 + 8 * fq;
        u32x4 cu[4][4], pv[4];
#pragma unroll
        for (int kk = 0; kk < 4; ++kk) {
#pragma unroll
            for (int tt = 0; tt < 4; ++tt) cu[kk][tt] = *(const u32x4*)(Grow + (size_t)(16 * tt) * EV_IN + 32 * kk);
            pv[kk] = (u32x4){0u, 0u, 0u, 0u}; if (hp0) pv[kk] = *(const u32x4*)(Grow - EV_IN + 32 * kk); }
#pragma unroll
        for (int jt = 0; jt < 4; ++jt)
#pragma unroll
            for (int tt = 0; tt < 4; ++tt) g[jt][tt] = (f32x4){0.f, 0.f, 0.f, 0.f};
#pragma unroll
        for (int kk = 0; kk < 4; ++kk) { bf16x8_t sgf[4];
            const f32x4 m0 = *(const LAS f32x4*)(CZ + 32 * kk + 8 * fq), m1 = *(const LAS f32x4*)(CZ + 32 * kk + 8 * fq + 4); const float mu[8] = {m0.x, m0.y, m0.z, m0.w, m1.x, m1.y, m1.z, m1.w};
#pragma unroll
            for (int tt = 0; tt < 4; ++tt) { const u32x4 cur = cu[kk][tt]; u32x4 edge = pv[kk];
                if (tt > 0) { edge.x = dpp_ror1(cu[kk][tt - 1].x); edge.y = dpp_ror1(cu[kk][tt - 1].y); edge.z = dpp_ror1(cu[kk][tt - 1].z); edge.w = dpp_ror1(cu[kk][tt - 1].w); }
                const unsigned cw[4] = {cur.x, cur.y, cur.z, cur.w}, pw[4] = {dpp_shr1_or(edge.x, cur.x), dpp_shr1_or(edge.y, cur.y), dpp_shr1_or(edge.z, cur.z), dpp_shr1_or(edge.w, cur.w)}; float v[8];
#pragma unroll
                for (int k = 0; k < 4; ++k) { const float c0 = bflo(cw[k]), c1 = bfhi(cw[k]), p0 = bflo(pw[k]), p1 = bfhi(pw[k]); v[2 * k] = sigmoidf_(c0 + (p0 - c0) * mu[2 * k]); v[2 * k + 1] = sigmoidf_(c1 + (p1 - c1) * mu[2 * k + 1]); }
                sgf[tt] = pack8(v); }
#pragma unroll
            for (int jt = 0; jt < 4; ++jt) { const bf16x8_t a = lds_frag(G2s, 136, 16 * jt + fr, 32 * kk + 8 * fq);
#pragma unroll
                for (int tt = 0; tt < 4; ++tt) g[jt][tt] = __builtin_amdgcn_mfma_f32_16x16x32_bf16(a, sgf[tt], g[jt][tt], 0, 0, 0); } }
#pragma unroll
        for (int jt = 0; jt < 4; ++jt)
#pragma unroll
            for (int tt = 0; tt < 4; ++tt) { gp[jt][tt].x = pk2(g[jt][tt][0], g[jt][tt][1]); gp[jt][tt].y = pk2(g[jt][tt][2], g[jt][tt][3]); }
    }
    __builtin_amdgcn_sched_barrier(0);
    f32x4 y[4][4];
    {
        u32x2 y0r[4][4]; bf16x8_t qb[2][4], za[2][4];
#pragma unroll
        for (int jt = 0; jt < 4; ++jt)
#pragma unroll
            for (int tt = 0; tt < 4; ++tt) y0r[jt][tt] = __builtin_nontemporal_load((const u32x2*)(Y0G + (16 * tt + fr) * 64 + 16 * jt + 4 * fq));
#pragma unroll
        for (int sg = 0; sg < 2; ++sg)
#pragma unroll
            for (int tt = 0; tt < 4; ++tt) { qb[sg][tt] = __builtin_nontemporal_load((const bf16x8_t*)(QG + (16 * tt + fr) * 64 + 32 * sg + 8 * fq)); za[sg][tt] = __builtin_nontemporal_load((const bf16x8_t*)(Z0 + (16 * tt + fr) * 64 + 32 * sg + 8 * fq)); }
        __builtin_amdgcn_sched_barrier(0);
#pragma unroll
        for (int jt = 0; jt < 4; ++jt)
#pragma unroll
            for (int tt = 0; tt < 4; ++tt) { const u32x2 w = y0r[jt][tt]; y[jt][tt] = (f32x4){bflo(w.x), bfhi(w.x), bflo(w.y), bfhi(w.y)}; }
#pragma unroll
        for (int sg = 0; sg < 2; ++sg)
#pragma unroll
            for (int jt = 0; jt < 4; ++jt)
#pragma unroll
                for (int tt = 0; tt < 4; ++tt) y[jt][tt] = __builtin_amdgcn_mfma_f32_16x16x32_bf16(za[sg][jt], qb[sg][tt], y[jt][tt], 0, 0, 0);
    }
    __builtin_amdgcn_sched_barrier(0);
    u32x2 vc[4][4], vp0[4]; float bonv[4];
    { const bf16_t* Vrow = P + (tg0 + fr) * EV_IN + 768 + 1024 + hd * 64 + 4 * fq;
#pragma unroll
      for (int tt = 0; tt < 4; ++tt)
#pragma unroll
          for (int jt = 0; jt < 4; ++jt) vc[tt][jt] = *(const u32x2*)(Vrow + (size_t)(16 * tt) * EV_IN + 16 * jt);
#pragma unroll
      for (int jt = 0; jt < 4; ++jt) { vp0[jt].x = 0u; vp0[jt].y = 0u; if (hp0) vp0[jt] = *(const u32x2*)(Vrow - EV_IN + 16 * jt); }
#pragma unroll
      for (int tt = 0; tt < 4; ++tt) bonv[tt] = ((const float*)(R + R_BON))[(tg0 + 16 * tt + fr) * 8 + hd]; }
    __builtin_amdgcn_sched_barrier(0);
#pragma unroll
    for (int tt = 0; tt < 4; ++tt) { const int tl = 16 * tt + fr;
        float s1 = 0.f;
#pragma unroll
        for (int jt = 0; jt < 4; ++jt) s1 += (y[jt][tt][0] + y[jt][tt][1]) + (y[jt][tt][2] + y[jt][tt][3]);
        s1 += __shfl_xor(s1, 16); s1 += __shfl_xor(s1, 32); const float mean = s1 * (1.0f / 64.0f);
        float s2 = 0.f;
#pragma unroll
        for (int jt = 0; jt < 4; ++jt)
#pragma unroll
            for (int r = 0; r < 4; ++r) { const float d = y[jt][tt][r] - mean; s2 += d * d; }
        s2 += __shfl_xor(s2, 16); s2 += __shfl_xor(s2, 32); const float rs = 1.0f / sqrtf(s2 * (1.0f / 64.0f) + 64e-5f);
        const float bon = bonv[tt];
#pragma unroll
        for (int jt = 0; jt < 4; ++jt) { const int ch = hd * 64 + 16 * jt + 4 * fq;
            const u32x2 cur = vc[tt][jt]; u32x2 edge = vp0[jt]; if (tt > 0) { edge.x = dpp_ror1(vc[tt - 1][jt].x); edge.y = dpp_ror1(vc[tt - 1][jt].y); }
            u32x2 prv; prv.x = dpp_shr1_or(edge.x, cur.x); prv.y = dpp_shr1_or(edge.y, cur.y);
            const f32x4 mu = *(const LAS f32x4*)(CZ + 128 + 16 * jt + 4 * fq), lw4 = *(const LAS f32x4*)(CZ + 192 + 16 * jt + 4 * fq), lb4 = *(const LAS f32x4*)(CZ + 256 + 16 * jt + 4 * fq);
            const float c0 = bflo(cur.x), c1 = bfhi(cur.x), c2 = bflo(cur.y), c3 = bfhi(cur.y), p0 = bflo(prv.x), p1 = bfhi(prv.x), p2 = bflo(prv.y), p3 = bfhi(prv.y);
            const float v0 = c0 + (p0 - c0) * mu.x, v1 = c1 + (p1 - c1) * mu.y, v2 = c2 + (p2 - c2) * mu.z, v3 = c3 + (p3 - c3) * mu.w;
            const f32x4 yy = y[jt][tt]; const float g0 = bflo(gp[jt][tt].x), g1 = bfhi(gp[jt][tt].x), g2 = bflo(gp[jt][tt].y), g3 = bfhi(gp[jt][tt].y);
            const float o0 = ((yy[0] - mean) * rs * lw4.x + lb4.x + bon * v0) * g0, o1 = ((yy[1] - mean) * rs * lw4.y + lb4.y + bon * v1) * g1;
            const float o2 = ((yy[2] - mean) * rs * lw4.z + lb4.z + bon * v2) * g2, o3 = ((yy[3] - mean) * rs * lw4.w + lb4.w + bon * v3) * g3;
            u32x2 w; w.x = pk2(o0, o1); w.y = pk2(o2, o3); *(u32x2*)(MIX + (tg0 + tl) * 1024 + 512 + ch) = w; } }
}

__device__ __forceinline__ void xattn_mfma(const Ctx& c, const Params& p, int unit) {
    const int b = unit >> 5, hh = (unit >> 3) & 3, tblk = unit & 7, tid = c.tid, lane = c.lane, wv = c.wave, fr = lane & 15, fq = lane >> 4;
    LAS bf16_t* Ks = (LAS bf16_t*)c.shm;
    LAS bf16_t* VTp = (LAS bf16_t*)(c.shm + 256 * 272);
    const bf16_t* MKV = (const bf16_t*)(p.ws + OFF_MKV); const bf16_t* Q = (const bf16_t*)(p.ws + OFF_P); bf16_t* OA = (bf16_t*)(p.ws + OFF_P + 32 * MiB);
    __syncthreads();
    {
        u32x4 dd[16];
#pragma unroll
        for (int i = 0; i < 16; ++i) { const int task = tid + 512 * i, which = task >> 12, r = (task >> 4) & 255, ck = task & 15;
            dd[i] = *(const u32x4*)(MKV + ((size_t)b * MEMLEN + r) * 1024 + which * 512 + hh * 128 + ck * 8); }
#pragma unroll
        for (int i = 0; i < 16; ++i) { const int task = tid + 512 * i, which = task >> 12, r = (task >> 4) & 255, ck = task & 15; const u32x4 d = dd[i];
            if (which == 0) *(LAS u32x4*)(Ks + r * 136 + ck * 8) = d;
            else { const int kc = key_perm(r); const unsigned w[4] = {d.x, d.y, d.z, d.w};
#pragma unroll
                for (int k = 0; k < 4; ++k) { VTp[(ck * 8 + 2 * k) * 264 + (kc ^ (8 * (ck & 7)))] = (bf16_t)(w[k] & 0xFFFFu); VTp[(ck * 8 + 2 * k + 1) * 264 + (kc ^ (8 * (ck & 7)))] = (bf16_t)(w[k] >> 16); } } }
    }
    __syncthreads();
    const int lpE = 8 * ((fq & 1) ^ (fr >> 3)) + 16 * (fq >> 1), lpO = lpE ^ 16;
    bf16x8_t qn[4]; f32x4 sn;
    { const size_t tq0 = (size_t)b * SEQ + tblk * 512 + wv * 64 + fr;
#pragma unroll
      for (int kk = 0; kk < 4; ++kk) qn[kk] = *(const bf16x8_t*)(Q + tq0 * 512 + hh * 128 + 32 * kk + 8 * fq);
      sn = ((const f32x4*)((const float*)(p.ws + OFF_R + R_SSP) + tq0 * 16))[fq]; }
#pragma unroll 1
    for (int qt = 0; qt < 4; ++qt) {
        const size_t tq = (size_t)b * SEQ + tblk * 512 + wv * 64 + qt * 16 + fr;
        bf16x8_t qf[4];
#pragma unroll
        for (int kk = 0; kk < 4; ++kk) qf[kk] = qn[kk];
        float qsc;
        { float ssq = (sn.x + sn.y) + (sn.z + sn.w); ssq += __shfl_xor(ssq, 16); ssq += __shfl_xor(ssq, 32);
          qsc = 0.08838834764831845f / sqrtf(ssq * (1.0f / 1024.0f) + 1e-6f); }
        if (qt + 1 < 4) { const size_t tn = tq + 16;
#pragma unroll
            for (int kk = 0; kk < 4; ++kk) qn[kk] = *(const bf16x8_t*)(Q + tn * 512 + hh * 128 + 32 * kk + 8 * fq);
            sn = ((const f32x4*)((const float*)(p.ws + OFF_R + R_SSP) + tn * 16))[fq]; }
        f32x4 s[16];
#pragma unroll
        for (int kt = 0; kt < 16; ++kt) { s[kt] = (f32x4){0.f, 0.f, 0.f, 0.f};
#pragma unroll
            for (int kk = 0; kk < 4; ++kk) s[kt] = __builtin_amdgcn_mfma_f32_16x16x32_bf16(lds_frag(Ks, 136, 16 * kt + fr, 32 * kk + 8 * fq), qf[kk], s[kt], 0, 0, 0);
            if (kt & 1) __builtin_amdgcn_sched_barrier(0); }
        float m = s[0][0];
#pragma unroll
        for (int kt = 0; kt < 16; ++kt) m = fmaxf(fmaxf(fmaxf(m, s[kt][0]), fmaxf(s[kt][1], s[kt][2])), s[kt][3]);
        m = fmaxf(m, __shfl_xor(m, 16)); m = fmaxf(m, __shfl_xor(m, 32));
        float den = 0.f;
#pragma unroll
        for (int kt = 0; kt < 16; ++kt)
#pragma unroll
            for (int r = 0; r < 4; ++r) { const float e = __expf((s[kt][r] - m) * qsc); s[kt][r] = e; den += e; }
        den += __shfl_xor(den, 16); den += __shfl_xor(den, 32);
        f32x4 o[8];
#pragma unroll
        for (int dt = 0; dt < 8; ++dt) o[dt] = (f32x4){0.f, 0.f, 0.f, 0.f};
#pragma unroll
        for (int sg = 0; sg < 8; ++sg) { const float pv[8] = {s[2 * sg][0], s[2 * sg][1], s[2 * sg][2], s[2 * sg][3], s[2 * sg + 1][0], s[2 * sg + 1][1], s[2 * sg + 1][2], s[2 * sg + 1][3]};
            const bf16x8_t pb = pack8(pv);
#pragma unroll
            for (int dt = 0; dt < 8; ++dt) o[dt] = __builtin_amdgcn_mfma_f32_16x16x32_bf16(lds_frag(VTp, 264, 16 * dt + fr, ((dt & 1) ? lpO : lpE) + 32 * (sg ^ ((dt >> 1) & 1))), pb, o[dt], 0, 0, 0);
            __builtin_amdgcn_sched_barrier(0); }
        const float inv = 1.0f / den;
#pragma unroll
        for (int dt = 0; dt < 8; ++dt) { u32x2 w; w.x = pk2(o[dt][0] * inv, o[dt][1] * inv); w.y = pk2(o[dt][2] * inv, o[dt][3] * inv); *(u32x2*)(OA + tq * 512 + hh * 128 + 16 * dt + 4 * fq) = w; }
    }
}
__device__ __forceinline__ void swa_mfma(const Ctx& c, const Params& p, int unit) {
    const int b = unit >> 6, g = (unit >> 5) & 1, n = unit & 31, tid = c.tid, lane = c.lane, wv = c.wave, fr = lane & 15, fq = lane >> 4;
    LAS bf16_t* Ks = (LAS bf16_t*)c.shm;
    LAS bf16_t* VTp = (LAS bf16_t*)(c.shm + 256 * 144);
    const bf16_t* P = (const bf16_t*)(p.ws + OFF_P); bf16_t* MIX = (bf16_t*)p.out;
    __syncthreads();
    {
        u32x4 dd[8];
#pragma unroll
        for (int i = 0; i < 8; ++i) { const int task = tid + 512 * i, which = task >> 11, r = (task >> 3) & 255, ck = task & 7; const int tk = n * 128 - 128 + r;
            dd[i] = (u32x4){0u, 0u, 0u, 0u}; if (tk >= 0) dd[i] = *(const u32x4*)(P + ((size_t)b * SEQ + tk) * EV_IN + 512 + which * 128 + g * 64 + ck * 8); }
#pragma unroll
        for (int i = 0; i < 8; ++i) { const int task = tid + 512 * i, which = task >> 11, r = (task >> 3) & 255, ck = task & 7; const u32x4 d = dd[i];
            if (which == 0) *(LAS u32x4*)(Ks + r * 72 + ck * 8) = d;
            else { const int kc = key_perm(r); const unsigned w[4] = {d.x, d.y, d.z, d.w};
#pragma unroll
                for (int k = 0; k < 4; ++k) { VTp[(ck * 8 + 2 * k) * 264 + (kc ^ (8 * (ck & 3)))] = (bf16_t)(w[k] & 0xFFFFu); VTp[(ck * 8 + 2 * k + 1) * 264 + (kc ^ (8 * (ck & 3)))] = (bf16_t)(w[k] >> 16); } } }
    }
    __syncthreads();
    const int lpE = 8 * ((fq & 1) ^ (fr >> 3)) + 16 * (fq >> 1), lpO = lpE ^ 16;
    bf16x8_t qn[2]; float sinkn;
    { const int tile0 = wv * 4, head0 = g * 4 + (tile0 >> 3); const size_t tq0 = (size_t)b * SEQ + n * 128 + 16 * (tile0 & 7) + fr;
#pragma unroll
      for (int kk = 0; kk < 2; ++kk) qn[kk] = *(const bf16x8_t*)(P + tq0 * EV_IN + head0 * 64 + 32 * kk + 8 * fq);
      sinkn = p.ev_sinks[head0]; }
#pragma unroll 1
    for (int it = 0; it < 4; ++it) {
        const int tile = wv * 4 + it, hql = tile >> 3, qb = tile & 7, head = g * 4 + hql, sg0 = qb >> 1;
        const int qi = 16 * qb + fr; const size_t tq = (size_t)b * SEQ + n * 128 + qi;
        const float sink = sinkn;
        bf16x8_t qf[2];
#pragma unroll
        for (int kk = 0; kk < 2; ++kk) qf[kk] = qn[kk];
        if (it + 1 < 4) { const int tile1 = tile + 1, head1 = g * 4 + (tile1 >> 3); const size_t tq1 = (size_t)b * SEQ + n * 128 + 16 * (tile1 & 7) + fr;
#pragma unroll
            for (int kk = 0; kk < 2; ++kk) qn[kk] = *(const bf16x8_t*)(P + tq1 * EV_IN + head1 * 64 + 32 * kk + 8 * fq);
            sinkn = p.ev_sinks[head1]; }
        f32x4 s[10]; float m = sink;
#pragma unroll
        for (int i = 0; i < 10; ++i) { const int kt = 2 * sg0 + i; s[i] = (f32x4){0.f, 0.f, 0.f, 0.f};
#pragma unroll
            for (int kk = 0; kk < 2; ++kk) s[i] = __builtin_amdgcn_mfma_f32_16x16x32_bf16(lds_frag(Ks, 72, 16 * kt + fr, 32 * kk + 8 * fq), qf[kk], s[i], 0, 0, 0);
#pragma unroll
            for (int r = 0; r < 4; ++r) { const int kp = 16 * kt + 4 * fq + r; const bool valid = (kp >= qi + 1) && (kp <= qi + 128) && (n > 0 || kp >= 128);
                s[i][r] = valid ? s[i][r] * 0.125f : -INFINITY; m = fmaxf(m, s[i][r]); } }
        m = fmaxf(m, __shfl_xor(m, 16)); m = fmaxf(m, __shfl_xor(m, 32));
        float den = 0.f;
#pragma unroll
        for (int i = 0; i < 10; ++i)
#pragma unroll
            for (int r = 0; r < 4; ++r) { const float e = __expf(s[i][r] - m); s[i][r] = e; den += e; }
        den += __shfl_xor(den, 16); den += __shfl_xor(den, 32); den += __expf(sink - m);
        f32x4 o[4];
#pragma unroll
        for (int dt = 0; dt < 4; ++dt) o[dt] = (f32x4){0.f, 0.f, 0.f, 0.f};
#pragma unroll
        for (int i2 = 0; i2 < 5; ++i2) { const float pv[8] = {s[2 * i2][0], s[2 * i2][1], s[2 * i2][2], s[2 * i2][3], s[2 * i2 + 1][0], s[2 * i2 + 1][1], s[2 * i2 + 1][2], s[2 * i2 + 1][3]};
            const bf16x8_t pb = pack8(pv);
#pragma unroll
            for (int dt = 0; dt < 4; ++dt) o[dt] = __builtin_amdgcn_mfma_f32_16x16x32_bf16(lds_frag(VTp, 264, 16 * dt + fr, ((dt & 1) ? lpO : lpE) + 32 * (sg0 + i2)), pb, o[dt], 0, 0, 0); }
        const float inv = 1.0f / den;
#pragma unroll
        for (int dt = 0; dt < 4; ++dt) { u32x2 w; w.x = pk2(o[dt][0] * inv, o[dt][1] * inv); w.y = pk2(o[dt][2] * inv, o[dt][3] * inv); *(u32x2*)(MIX + tq * 1024 + head * 64 + 16 * dt + 4 * fq) = w; }
    }
}

constexpr size_t WSM_RT = 640 * 1024;
constexpr size_t CTL_WGCNT = 256 * 1024;
__device__ __forceinline__ void split8(const f32x4 a, const f32x4 b, bf16x8_t& hi, bf16x8_t& lo) {
    const float x[8] = {a.x, a.y, a.z, a.w, b.x, b.y, b.z, b.w}; float h[8], l[8];
#pragma unroll
    for (int i = 0; i < 8; ++i) { h[i] = bf2f(f2bf(x[i])); l[i] = x[i] - h[i]; }
    hi = pack8(h); lo = pack8(l);
}
__device__ __forceinline__ void moe_route(const Ctx& c, const Params& p, int layer) {
    const int lane = c.lane, wv = c.wave, fr = lane & 15, fq = lane >> 4;
    LAS float* LG = (LAS float*)c.shm + wv * (16 * 48 + 16);
    LAS float* RS = LG + 16 * 48;
    LAS int* hist = (LAS int*)(c.shm + 32 * 1024);
    if (c.tid < 32) hist[c.tid] = 0;
    __syncthreads();
    const int t0 = TOKBLK(blockIdx.x) * 128 + wv * 16;
    const bf16_t* xr = (const bf16_t*)(p.ws + OFF_H) + (size_t)(t0 + fr) * 1024 + 8 * fq;
    const bf16_t* TH = (const bf16_t*)(p.ws + OFF_WSMALL + WSM_RT) + (size_t)layer * 2 * 48 * 1024; const bf16_t* TL = TH + 48 * 1024;
    f32x4 acc[3];
#pragma unroll
    for (int i = 0; i < 3; ++i) acc[i] = (f32x4){0.f, 0.f, 0.f, 0.f};
    float ss = 0.f;
    u32x4 xall[32];
#pragma unroll
    for (int kk = 0; kk < 32; ++kk) xall[kk] = *(const u32x4*)(xr + 32 * kk);
    LAS bf16_t* TB = (LAS bf16_t*)(c.shm + 48 * 1024);
    u32x4 tr[3];
#pragma unroll
    for (int i = 0; i < 3; ++i) { const int idx = c.tid + 512 * i, row = idx >> 4, pc = idx & 15; tr[i] = *(const u32x4*)((row < 48 ? TH : TL) + (size_t)(row < 48 ? row : row - 48) * 1024 + 8 * pc); }
#pragma unroll
    for (int i = 0; i < 3; ++i) { const int idx = c.tid + 512 * i, row = idx >> 4, pc = idx & 15; *(LAS u32x4*)(TB + row * 136 + 8 * pc) = tr[i]; }
    __syncthreads();
#pragma unroll
    for (int g = 0; g < 8; ++g) {
        LAS bf16_t* Tb = TB + (g & 1) * (96 * 136);
        if (g + 1 < 8) {
#pragma unroll
            for (int i = 0; i < 3; ++i) { const int idx = c.tid + 512 * i, row = idx >> 4, pc = idx & 15; tr[i] = *(const u32x4*)((row < 48 ? TH : TL) + (size_t)(row < 48 ? row : row - 48) * 1024 + 128 * (g + 1) + 8 * pc); } }
#pragma unroll
        for (int kl = 0; kl < 4; ++kl) { const int kk = 4 * g + kl;
            const u32x4 xw = xall[kk]; const bf16x8_t xh = __builtin_bit_cast(bf16x8_t, xw);
            { const float x0 = bflo(xw.x), x1 = bfhi(xw.x), x2 = bflo(xw.y), x3 = bfhi(xw.y), x4 = bflo(xw.z), x5 = bfhi(xw.z), x6 = bflo(xw.w), x7 = bfhi(xw.w);
              ss += (x0 * x0 + x1 * x1) + (x2 * x2 + x3 * x3) + (x4 * x4 + x5 * x5) + (x6 * x6 + x7 * x7); }
#pragma unroll
            for (int ct = 0; ct < 3; ++ct) { const bf16x8_t wh = lds_frag(Tb, 136, 16 * ct + fr, 32 * kl + 8 * fq), wl = lds_frag(Tb, 136, 48 + 16 * ct + fr, 32 * kl + 8 * fq);
                acc[ct] = __builtin_amdgcn_mfma_f32_16x16x32_bf16(xh, wh, acc[ct], 0, 0, 0); acc[ct] = __builtin_amdgcn_mfma_f32_16x16x32_bf16(xh, wl, acc[ct], 0, 0, 0); } }
        if (g + 1 < 8) {
#pragma unroll
            for (int i = 0; i < 3; ++i) { const int idx = c.tid + 512 * i, row = idx >> 4, pc = idx & 15; *(LAS u32x4*)(TB + ((g + 1) & 1) * (96 * 136) + row * 136 + 8 * pc) = tr[i]; } }
        __syncthreads();
    }
    ss += __shfl_xor(ss, 16); ss += __shfl_xor(ss, 32);
    const float rstd = 1.0f / sqrtf(ss * (1.0f / 1024.0f) + 1e-6f);
    if (fq == 0) RS[fr] = rstd;
    LDS_WAIT();
#pragma unroll
    for (int ct = 0; ct < 3; ++ct)
#pragma unroll
        for (int r = 0; r < 4; ++r) LG[(4 * fq + r) * 48 + 16 * ct + fr] = acc[ct][r] * RS[4 * fq + r];
    LDS_WAIT();
    if (lane < 16) { int e0, e1; float g0, g1; route_row(LG + lane * 48, p.moe_b_group + layer * 4, p.moe_b_expert + layer * 32, e0, e1, g0, g1);
        const int t = t0 + lane; ((float*)(p.ws + OFF_ROUTE + ROUTE_RS))[t] = RS[lane]; ((int2*)(p.ws + OFF_ROUTE))[t] = make_int2(e0, e1); ((float2*)(p.ws + OFF_ROUTE + 256 * 1024))[t] = make_float2(g0, g1);
        atomicAdd((int*)&hist[e0], 1); atomicAdd((int*)&hist[e1], 1); }
    __syncthreads();
    if (c.tid < 32) ((int*)(p.ws + OFF_CTL + CTL_WGCNT))[(layer * 256 + blockIdx.x) * 32 + c.tid] = hist[c.tid];
}
__device__ __forceinline__ void moe_slots2(const Ctx& c, const Params& p, int layer) {
    LAS int* part = (LAS int*)c.shm;
    LAS int* base = part + 1024;
    LAS int* lcnt = base + 32;
    LAS int* posl = lcnt + 32;
    LAS int* pst = posl + 256;
    const int* wc = (const int*)(p.ws + OFF_CTL + CTL_WGCNT) + layer * 256 * 32; const int bid = blockIdx.x;
    __syncthreads();
    { const int e = c.tid & 31, pt = c.tid >> 5; int sa = 0, sb = 0;
      for (int w = pt * 16; w < pt * 16 + 16; ++w) { const int v = wc[w * 32 + e]; sa += v; sb += (w < bid) ? v : 0; }
      part[pt * 32 + e] = sa; part[512 + pt * 32 + e] = sb; }
    if (c.tid < 32) lcnt[c.tid] = 0;
    __syncthreads();
    if (c.tid < 32) { int sa = 0, sb = 0; for (int q = 0; q < 16; ++q) { sa += part[q * 32 + c.tid]; sb += part[512 + q * 32 + c.tid]; } part[c.tid] = sa; part[512 + c.tid] = sb; }
    __syncthreads();
    if (c.tid == 0) { int acc = 0; for (int e = 0; e < NEXP; ++e) { pst[e] = acc; acc += (part[e] + 255) / 256 * 256; } pst[32] = acc; }
    __syncthreads();
    if (c.tid < 32) base[c.tid] = pst[c.tid] + part[512 + c.tid];
    if (bid == 0 && c.tid < NEXP) { int* blk = (int*)(p.ws + OFF_CTL + CTL_BLK) + layer * 1024; const int e = c.tid, s = pst[e] / 256, en = pst[e + 1] / 256; for (int i = s; i < en; ++i) blk[1 + i] = e; if (e == 0) blk[0] = pst[32] / 256; }
    __syncthreads();
    if (c.tid < 256) { const int t = TOKBLK(bid) * 128 + (c.tid >> 1); const int2 ee = ((const int2*)(p.ws + OFF_ROUTE))[t]; const int e = (c.tid & 1) ? ee.y : ee.x;
        const int rk = atomicAdd((int*)&lcnt[e], 1); posl[c.tid] = base[e] + rk; }
    __syncthreads();
    if (c.tid < 128) ((int2*)(p.ws + OFF_ROUTE + 512 * 1024))[TOKBLK(bid) * 128 + c.tid] = make_int2(posl[2 * c.tid], posl[2 * c.tid + 1]);
    if (c.tid < 256) ((float*)(p.ws + OFF_R + R_RSS))[posl[c.tid]] = ((const float*)(p.ws + OFF_ROUTE + ROUTE_RS))[TOKBLK(bid) * 128 + (c.tid >> 1)];
    int* TOK = (int*)(p.ws + OFF_R + R_TOK);
    if (c.tid < 256) TOK[posl[c.tid]] = TOKBLK(bid) * 128 + (c.tid >> 1);
    if (bid == 0) { for (int e = 0; e < NEXP; ++e) { const int s = pst[e] + part[e], en = pst[e + 1]; for (int i = s + c.tid; i < en; i += 512) TOK[i] = 0; } }
}

constexpr size_t WSM_TGD = 128 * 1024, WSM_GUT = 192 * 1024;
__device__ __forceinline__ void combine_gk(const Ctx& c, const Params& p) {
    const int lane = c.lane, wv = c.wave, fr = lane & 15, fq = lane >> 4;
    LAS float* LG = (LAS float*)c.shm + wv * (16 * 16 + 16);
    LAS float* RS = LG + 256;
    const int t0 = blockIdx.x * 128 + wv * 16; const int trow = t0 + fr;
    bf16_t* hr = (bf16_t*)(p.ws + OFF_H) + (size_t)trow * 1024 + 8 * fq;
    const int2 ps = ((const int2*)(p.ws + OFF_ROUTE + 512 * 1024))[trow]; const float2 gt = ((const float2*)(p.ws + OFF_ROUTE + 256 * 1024))[trow];
    const bf16_t* y0 = (const bf16_t*)(p.ws + OFF_P) + (size_t)ps.x * 1024 + 8 * fq; const bf16_t* y1 = (const bf16_t*)(p.ws + OFF_P) + (size_t)ps.y * 1024 + 8 * fq;
    LAS bf16_t* TGs = (LAS bf16_t*)(c.shm + 16 * 1024);
    LAS bf16_t* GUs = (LAS bf16_t*)(c.shm + 16 * 1024 + 32 * 1032 * 2);
    LAS float* GBs = (LAS float*)(c.shm + 16 * 1024 + 32 * 1032 * 2 + 1024 * 16 * 2);
    { const bf16_t* TG = (const bf16_t*)(p.ws + OFF_WSMALL + WSM_TGD); const bf16_t* GU = (const bf16_t*)(p.ws + OFF_WSMALL + WSM_GUT);
      u32x4 tr[12];
#pragma unroll
      for (int i = 0; i < 8; ++i) tr[i] = *((const u32x4*)TG + c.tid + 512 * i);
#pragma unroll
      for (int i = 0; i < 4; ++i) tr[8 + i] = *((const u32x4*)GU + c.tid + 512 * i);
#pragma unroll
      for (int i = 0; i < 8; ++i) { const int idx = c.tid + 512 * i; *(LAS u32x4*)(TGs + (idx >> 7) * 1032 + (idx & 127) * 8) = tr[i]; }
#pragma unroll
      for (int i = 0; i < 4; ++i) *((LAS u32x4*)GUs + c.tid + 512 * i) = tr[8 + i];
      GBs[c.tid] = p.od_gate_b[c.tid]; }
    __syncthreads();
    f32x4 acc = (f32x4){0.f, 0.f, 0.f, 0.f}; float ss = 0.f;
#define CGK_LOAD(X, Y0, Y1, bdn) { _Pragma("unroll") for (int j = 0; j < 4; ++j) { const int kn = 4 * (bdn) + j; X[j] = *(const u32x4*)(hr + 32 * kn); Y0[j] = __builtin_nontemporal_load((const u32x4*)(y0 + 32 * kn)); Y1[j] = __builtin_nontemporal_load((const u32x4*)(y1 + 32 * kn)); } }
#define CGK_BODY(X, Y0, Y1, bdc) { _Pragma("unroll") for (int j = 0; j < 4; ++j) { const int kk = 4 * (bdc) + j; const u32x4 xw = X[j], u0 = Y0[j], u1 = Y1[j]; \
            f32x4 a, bq; \
            a.x = bflo(xw.x) + gt.x * bflo(u0.x) + gt.y * bflo(u1.x); a.y = bfhi(xw.x) + gt.x * bfhi(u0.x) + gt.y * bfhi(u1.x); a.z = bflo(xw.y) + gt.x * bflo(u0.y) + gt.y * bflo(u1.y); a.w = bfhi(xw.y) + gt.x * bfhi(u0.y) + gt.y * bfhi(u1.y); \
            bq.x = bflo(xw.z) + gt.x * bflo(u0.z) + gt.y * bflo(u1.z); bq.y = bfhi(xw.z) + gt.x * bfhi(u0.z) + gt.y * bfhi(u1.z); bq.z = bflo(xw.w) + gt.x * bflo(u0.w) + gt.y * bflo(u1.w); bq.w = bfhi(xw.w) + gt.x * bfhi(u0.w) + gt.y * bfhi(u1.w); \
            { u32x4 w; w.x = pk2(a.x, a.y); w.y = pk2(a.z, a.w); w.z = pk2(bq.x, bq.y); w.w = pk2(bq.z, bq.w); *(u32x4*)(hr + 32 * kk) = w; } \
            ss += (a.x * a.x + a.y * a.y) + (a.z * a.z + a.w * a.w) + (bq.x * bq.x + bq.y * bq.y) + (bq.z * bq.z + bq.w * bq.w); \
            bf16x8_t xh, xl; split8(a, bq, xh, xl); \
            const bf16x8_t wh = lds_frag(TGs, 1032, fr, 32 * kk + 8 * fq), wl = lds_frag(TGs, 1032, 16 + fr, 32 * kk + 8 * fq); \
            acc = __builtin_amdgcn_mfma_f32_16x16x32_bf16(xh, wh, acc, 0, 0, 0); acc = __builtin_amdgcn_mfma_f32_16x16x32_bf16(xh, wl, acc, 0, 0, 0); acc = __builtin_amdgcn_mfma_f32_16x16x32_bf16(xl, wh, acc, 0, 0, 0); } }
    u32x4 ax[4], a0[4], a1[4], bx[4], b0[4], b1[4];
    CGK_LOAD(ax, a0, a1, 0)
#pragma unroll 1
    for (int bd = 0; bd < 8; bd += 2) {
        CGK_LOAD(bx, b0, b1, bd + 1)
        CGK_BODY(ax, a0, a1, bd)
        CGK_LOAD(ax, a0, a1, (bd + 2 < 8 ? bd + 2 : 7))
        CGK_BODY(bx, b0, b1, bd + 1)
    }
#undef CGK_LOAD
#undef CGK_BODY
    ss += __shfl_xor(ss, 16); ss += __shfl_xor(ss, 32);
    const float rstd = 1.0f / sqrtf(ss * (1.0f / 1024.0f) + 1e-6f);
    if (fq == 0) { RS[fr] = rstd; ((float*)(p.ws + OFF_ROUTE + ROUTE_RS))[trow] = rstd; }
    LDS_WAIT();
#pragma unroll
    for (int r = 0; r < 4; ++r) LG[(4 * fq + r) * 16 + fr] = acc[r] * RS[4 * fq + r];
    LDS_WAIT();
    bf16x8_t gh = zero_frag(), gl = zero_frag();
    if (fq < 2) { const f32x4 a = *(const LAS f32x4*)(LG + fr * 16 + 8 * fq), bq = *(const LAS f32x4*)(LG + fr * 16 + 8 * fq + 4); split8(a, bq, gh, gl); }
    bf16_t* gk = (bf16_t*)(p.ws + OFF_R + R_GK) + (size_t)trow * 512 + 4 * fq;
#pragma unroll 4
    for (int ct = 0; ct < 32; ++ct) {
        bf16x8_t uh = zero_frag(), ul = zero_frag();
        if (fq < 2) { uh = lds_frag(GUs, 16, 16 * ct + fr, 8 * fq); ul = lds_frag(GUs, 16, 512 + 16 * ct + fr, 8 * fq); }
        f32x4 g = *(const LAS f32x4*)(GBs + 16 * ct + 4 * fq);
        g = __builtin_amdgcn_mfma_f32_16x16x32_bf16(uh, gh, g, 0, 0, 0); g = __builtin_amdgcn_mfma_f32_16x16x32_bf16(uh, gl, g, 0, 0, 0); g = __builtin_amdgcn_mfma_f32_16x16x32_bf16(ul, gh, g, 0, 0, 0);
#pragma unroll
        for (int r = 0; r < 4; ++r) { const float xx = g[r]; g[r] = (fminf(xx, 0.f) - __logf(1.0f + __expf(-fabsf(xx)))) * (1.0f / 16.0f); }
        { u32x2 w; w.x = pk2(g[0], g[1]); w.y = pk2(g[2], g[3]); *(u32x2*)(gk + 16 * ct) = w; }
    }
}

constexpr int LDS_BYTES = 160 * 1024 - 64;
constexpr int N_PHASES = 25;

typedef const __attribute__((address_space(4))) Params* KParamsPtr;
__device__ __forceinline__ Params kparams() {
#if defined(__HIP_DEVICE_COMPILE__)
    KParamsPtr k = (KParamsPtr)__builtin_amdgcn_kernarg_segment_ptr(); asm volatile("" : "+s"(k)); return *k;
#else
    return Params{};
#endif
}
__device__ __forceinline__ Ctx mkctx(unsigned char* shm, int wave_s) {
    int ln; asm volatile("v_mbcnt_lo_u32_b32 %0, -1, 0\n\tv_mbcnt_hi_u32_b32 %0, -1, %0" : "=v"(ln));
    int tz = wave_s * 64 + ln; asm volatile("" : "+v"(tz));
    Ctx c; c.tid = tz; c.wave = __builtin_amdgcn_readfirstlane(tz >> 6); c.lane = tz & 63; c.gw = blockIdx.x * 8 + c.wave; c.ngw = 2048; c.shm = shm; return c;
}
constexpr int TR0_SPLIT = 19200;
__global__ void __launch_bounds__(512, 2) hybrid_fwd(Params p_in) {
    extern __shared__ __attribute__((aligned(16))) unsigned char shm[];
    constexpr int G = 256; const int bid = blockIdx.x;
    uint4* xbw = (uint4*)(shm + LDS_BYTES - 16);
    const int wave_s = __builtin_amdgcn_readfirstlane((int)threadIdx.x >> 6);
    if (threadIdx.x == 0) *xbw = make_uint4(0u, 0u, 0u, 0u);
    __syncthreads();
    XcdBarrier bar = xcd_barrier_post((unsigned*)(kparams().ws + OFF_CTL), (volatile LAS unsigned*)xbw);
#ifndef KEEPMASK
#define KEEPMASK 0xFFFFFFFFu
#endif
#define INS(k, s) (((KEEPMASK) >> (s)) & 1u)
#ifndef REPMASK
#define REPMASK 0u
#endif
#define REP(s) ((((REPMASK) >> (s)) & 1u) ? 3 : 1)
#define SEAM(k) do { XcdBarrier b2 = bar; b2.bar = (unsigned*)(kparams().ws + OFF_CTL); xcd_barrier(b2, c.tid == 0); } while (0)
#define PHASE_BEGIN asm volatile(".p2align 8"); const Params p = kparams(); const Ctx c = mkctx(shm, wave_s); unsigned char* const ws = p.ws; (void)c; (void)ws;
#define glds ((PG8_LAS unsigned char*)shm)
#define WD ((bf16_t*)(ws + OFF_WD))
#define H ((bf16_t*)(ws + OFF_H))
#define P ((bf16_t*)(ws + OFF_P))
#define WS_F ((float*)(ws + OFF_WSMALL))
#define RE ((int2*)(ws + OFF_ROUTE))
#define RG ((float2*)(ws + OFF_ROUTE + 256 * 1024))
#define RP ((int2*)(ws + OFF_ROUTE + 512 * 1024))

    for (int layer = 0; layer < 2; ++layer) {
        const int pb = layer * 12;
        if (layer == 0) {
            if (INS(0, 0)) for (int rep_ = 0; rep_ < REP(0); ++rep_) { PHASE_BEGIN
                if (bid < 160) { Ctx c2 = c; c2.ngw = 160 * 8; copy_rstd(c2, p.x, H, (float*)(ws + OFF_ROUTE + ROUTE_RS), T_TOK); }
                else {
                Ctx c2 = c; c2.gw = (bid - 160) * 8 + c.wave; c2.ngw = 96 * 8; const int bid2 = bid - 160; constexpr int G2 = 96;
                tr_matrix(c2, p.ev_w_in, EV_IN, 0, 1024, EV_IN, WD + WE_EV_IN, 0, 0, p.norm_mix);
                tr_matrix(c2, p.ev_w_out, 1024, 0, 1024, 1024, WD + WE_EV_OUT, 0, 0);
                tr_matrix(c2, p.od_w_in, OD_IN_SRC, 0, 1024, OD_IN, WD + WE_OD_IN, 0, 1, p.norm_mix + 1024);
                tr_matrix(c2, p.od_w_out, 1024, 0, 1024, 1024, WD + WE_OD_OUT, 0, 0);
                tr_matrix(c2, p.mem_wk, 512, 0, 1024, 512, WD + WE_MKV, 0, 0);
                tr_matrix(c2, p.mem_wv, 512, 0, 1024, 512, WD + WE_MKV, 512, 0);
                for (int l = 0; l < 2; ++l) {
                    tr_matrix(c2, p.xa_wq + (size_t)l * 1024 * 512, 512, 0, 1024, 512, WD + WE_WQ + (size_t)l * 512 * 1024, 0, 0, p.norm_xattn + l * 1024);
                    tr_matrix(c2, p.xa_wo + (size_t)l * 512 * 1024, 1024, 0, 512, 1024, WD + WE_WO + (size_t)l * 1024 * 512, 0, 0);
                }
                for (int i = bid2 * 512 + c.tid; i < 16 * 1024 + 512 * 16; i += G2 * 512) {
                    if (i < 16 * 1024) { const int o = i >> 10, k = i & 1023; const float w = p.od_w_in[(size_t)k * OD_IN_SRC + 2048 + o] * p.norm_mix[1024 + k]; const unsigned hb = f2bf(w);
                        bf16_t* T = (bf16_t*)(ws + OFF_WSMALL + WSM_TGD); T[i] = (bf16_t)hb; T[16 * 1024 + i] = (bf16_t)f2bf(w - bf2f(hb)); }
                    else { const int r = i - 16 * 1024, ch = r >> 4, o = r & 15; const float w = p.od_gate_up[o * 512 + ch]; const unsigned hb = f2bf(w);
                        bf16_t* T = (bf16_t*)(ws + OFF_WSMALL + WSM_GUT); T[r] = (bf16_t)hb; T[512 * 16 + r] = (bf16_t)f2bf(w - bf2f(hb)); } }
                for (int i = bid2 * 512 + c.tid; i < 2 * 48 * 1024; i += G2 * 512) { const int l = i / (48 * 1024), r = i % (48 * 1024), o = r >> 10, k = r & 1023;
                    float w = 0.f; if (o < 4) w = p.moe_w_group[((size_t)l * 1024 + k) * 4 + o]; else if (o < 36) w = p.moe_w_expert[((size_t)l * 1024 + k) * 32 + (o - 4)];
                    w *= p.norm_moe[l * 1024 + k]; const unsigned hb = f2bf(w); bf16_t* T = (bf16_t*)(ws + OFF_WSMALL + WSM_RT) + (size_t)l * 2 * 48 * 1024;
                    T[r] = (bf16_t)hb; T[48 * 1024 + r] = (bf16_t)f2bf(w - bf2f(hb)); }
                for (int i = bid2 * 512 + c.tid; i < 2 * 512 * 64; i += G2 * 512) { const int wh = i >> 15, r = i & 32767, ch = r >> 6, k = r & 63;
                    ((bf16_t*)(ws + OFF_WSMALL + (wh ? WSM_A2T : WSM_W2T)))[r] = (bf16_t)f2bf((wh ? p.ev_a2 : p.ev_w2)[(size_t)k * 512 + ch]); }
                norm_plain(c2, p.mem, p.mem_norm, (bf16_t*)(ws + OFF_R + R_MEMN), NB * MEMLEN);
                for (int i = bid2 * 512 + c.tid; i < 512 * 128; i += G2 * 512) { const int ch = i >> 7, m = i & 127; ((bf16_t*)(ws + OFF_WSMALL + WSM_G2T))[i] = (bf16_t)f2bf(p.ev_g2[(size_t)m * 512 + ch]); }
                }
                __syncthreads();
                SEAM(0);
            }
            if (INS(1, 1)) for (int rep_ = 0; rep_ < REP(1); ++rep_) { PHASE_BEGIN
                { pg8::Gemm g{H, WD + WE_EV_IN, T_TOK, EV_IN, 1024, 0}; pg8::StaticOrder S; S.init(T_TOK, EV_IN, G, bid);
                  pg8::EpiB16 E{P, EV_IN, (const float*)(ws + OFF_ROUTE + ROUTE_RS)};   pg8::gemm_phase<pg8::EpiB16, pg8::StaticOrder, true, true>(glds, g, S, E, c.tid); }
                SEAM(1);
            }
            if (INS(2, 2)) for (int rep_ = 0; rep_ < REP(2); ++rep_) { PHASE_BEGIN
#ifdef RWKV_NAIVE
                if (bid < 64) rwkv_naive(c, p, bid);
                else
#else
                {
                    RxPre pre; const int bh0 = (bid & 7) * 8 + ((bid >> 3) & 7), b0 = bh0 >> 3, hd0 = bh0 & 7, ck0 = (bid >> 6) * 16;
                    rwkv_x_fetch(pre, (const bf16_t*)(ws + OFF_P), b0, hd0, ck0, c.tid, c.lane, c.wave);
                    RxW kw; rwkv_x_weights(kw, p, hd0, c.lane, c.wave);
                    {
                        LAS float* CTw = (LAS float*)(shm + X_RED + 4096); const int i = c.tid;
                        if (i < 128) CTw[i] = p.ev_mu[1536 + i];
                        else if (i < 320) { const int r = i - 128; CTw[i] = p.ev_mu[512 * (r >> 6) + hd0 * 64 + (r & 63)]; }
                        else if (i < 640) { const int r = i - 320, w = r >> 6, ch = hd0 * 64 + (r & 63); CTw[i] = (w == 0 ? p.ev_w0 : w == 1 ? p.ev_a0 : w == 2 ? p.ev_k_k : w == 3 ? p.ev_k_a : p.ev_r_k)[ch]; }
                        if (i < 128) CTw[512 + i] = (i < 64 ? p.ev_k_a : p.ev_r_k)[hd0 * 64 + (i & 63)];
                    }
#pragma unroll
                    for (int n = 0; n < 4; ++n) { asm volatile("" : "+v"(kw.wt[n][0])); asm volatile("" : "+v"(kw.wt[n][1])); }
#pragma unroll 1
                    for (int i = 0; i < 16; ++i) rwkv_x(c, p, bh0 * 64 + ck0 + i, pre, kw, b0, hd0, i + 1 < 16 ? ck0 + i + 1 : -1);
                }
                __syncthreads();
                SEAM(2);
            }
            if (INS(2, 16)) for (int rep_ = 0; rep_ < REP(16); ++rep_) { PHASE_BEGIN
                if (bid < 64) { rwkv_y(c, p, (bid & 7) * 8 + (bid >> 3)); __syncthreads(); tr_moe_range_w(c, p, 0, TR0_SPLIT, NEXP * 768, bid * 8 + c.wave, 512); }
                else
#endif
                {
                    for (int u = bid - 64; u < 512; u += G - 64) swa_mfma(c, p, (u & 7) * 64 + (u >> 3));
                    __syncthreads();
                    if (bid >= 96) tr_moe_range_w(c, p, 0, 0, TR0_SPLIT, (bid - 96) * 8 + c.wave, 1280);
                    if (bid < 96) {
                        pg8::Gemm g{(const bf16_t*)(ws + OFF_R + R_MEMN), WD + WE_MKV, NB * MEMLEN, 1024, 1024, 0}; pg8::StaticOrder S; S.init(NB * MEMLEN, 1024, 32, bid - 64);
                        pg8::EpiB16 E{(bf16_t*)(ws + OFF_MKV), 1024, nullptr}; pg8::gemm_phase<pg8::EpiB16, pg8::StaticOrder, true, true>(glds, g, S, E, c.tid); }
                }
#ifndef RWKV_NAIVE
                __syncthreads();
                SEAM(2);
            }
            if (INS(2, 17)) for (int rep_ = 0; rep_ < REP(17); ++rep_) { PHASE_BEGIN
                {
                    const bf16_t* G2T = (const bf16_t*)(ws + OFF_WSMALL + WSM_G2T) + (size_t)((bid >> 3) & 7) * 64 * 128;
                    const u32x4 g0 = *((const u32x4*)G2T + c.tid), g1 = *((const u32x4*)G2T + 512 + c.tid);
                    __syncthreads();
                    *(LAS u32x4*)((LAS bf16_t*)shm + (c.tid >> 4) * 136 + (c.tid & 15) * 8) = g0; *(LAS u32x4*)((LAS bf16_t*)shm + ((c.tid + 512) >> 4) * 136 + (c.tid & 15) * 8) = g1;
                    if (c.tid < 320) { const int i = c.tid, hdz = (bid >> 3) & 7;
                        ((LAS float*)(shm + 17408))[i] = i < 128 ? p.ev_mu[1664 + i] : (i < 192 ? p.ev_mu[1024 + hdz * 64 + (i - 128)] : (i < 256 ? p.ev_lnx_w[hdz * 64 + (i - 192)] : p.ev_lnx_b[hdz * 64 + (i - 256)])); }
                    __syncthreads();
                }
                for (int k = 0; k < 2; ++k) rwkv_z(c, p, ((((bid & 7) * 8 + ((bid >> 3) & 7)) << 6) + (bid >> 6) * 16 + c.wave + 8 * k));
#endif
                __syncthreads();
                SEAM(2);
            }
        } else {
            if (INS(12, 12)) for (int rep_ = 0; rep_ < REP(12); ++rep_) { PHASE_BEGIN
                combine_gk(c, p);
                __syncthreads();
                SEAM(12);
            }
            if (INS(13, 13)) for (int rep_ = 0; rep_ < REP(13); ++rep_) { PHASE_BEGIN
                pg8::Gemm g{H, WD + WE_OD_IN, T_TOK, OD_IN, 1024, 0}; pg8::StaticOrder S; S.init(T_TOK, OD_IN, G, bid);
                pg8::EpiB16 E{P, OD_IN, (const float*)(ws + OFF_ROUTE + ROUTE_RS)};   pg8::gemm_phase<pg8::EpiB16, pg8::StaticOrder, true, true>(glds, g, S, E, c.tid);
                SEAM(13);
            }
            if (INS(14, 14)) for (int rep_ = 0; rep_ < REP(14); ++rep_) { PHASE_BEGIN
#ifdef GLA_NAIVE
                if (bid < 32) gla_naive(c, p, bid);
                __syncthreads();
                SEAM(14);
#else
                for (int k = 0; k < 8; ++k) gla_prep(c, p, ((((bid & 7) * 4 + ((bid >> 3) & 3)) << 6) + (bid >> 5) * 8 + k));
                __syncthreads();
                SEAM(14);
#endif
            }
#ifndef GLA_NAIVE
            if (INS(14, 18)) for (int rep_ = 0; rep_ < REP(18); ++rep_) { PHASE_BEGIN
                if (bid < 128) gla_state(c, p, (bid & 7) * 4 + ((bid >> 3) & 3), bid >> 5);
                else tr_moe_layer(c, p, 1, 128 * 8, 128 * 8);
                __syncthreads();
                SEAM(14);
            }
            if (INS(14, 19)) for (int rep_ = 0; rep_ < REP(19); ++rep_) { PHASE_BEGIN
                gla_finish(c, p);
                __syncthreads();
                SEAM(14);
            }
#endif
        }
        if (INS(pb + 3, 3)) for (int rep_ = 0; rep_ < REP(3); ++rep_) { PHASE_BEGIN
            pg8::Gemm g{(const bf16_t*)p.out, WD + (layer == 0 ? WE_EV_OUT : WE_OD_OUT), T_TOK, 1024, 1024, 0}; pg8::StaticOrder S; S.init(T_TOK, 1024, G, bid);
            pg8::EpiRes E{nullptr, H, 1024, (float*)(ws + OFF_R + R_SSP)};     pg8::gemm_phase<pg8::EpiRes, pg8::StaticOrder, true, true>(glds, g, S, E, c.tid);
            SEAM(pb + 3);
        }
        if (INS(pb + 5, 5)) for (int rep_ = 0; rep_ < REP(5); ++rep_) { PHASE_BEGIN
            pg8::Gemm g{H, WD + WE_WQ + (size_t)layer * 512 * 1024, T_TOK, 512, 1024, 0}; pg8::StaticOrder S; S.init(T_TOK, 512, G, bid);
            pg8::EpiB16 E{P, 512, nullptr}; pg8::gemm_phase<pg8::EpiB16, pg8::StaticOrder, true, true>(glds, g, S, E, c.tid);
            SEAM(pb + 5);
        }
        if (INS(pb + 6, 6)) for (int rep_ = 0; rep_ < REP(6); ++rep_) { PHASE_BEGIN for (int u = bid; u < 256; u += G) xattn_mfma(c, p, (u & 7) * 32 + (u >> 3));   __syncthreads(); SEAM(pb + 6); }
        if (INS(pb + 7, 7)) for (int rep_ = 0; rep_ < REP(7); ++rep_) { PHASE_BEGIN
            pg8::Gemm g{(const bf16_t*)(ws + OFF_P + 32 * MiB), WD + WE_WO + (size_t)layer * 1024 * 512, T_TOK, 1024, 512, 0}; pg8::StaticOrder S; S.init(T_TOK, 1024, G, bid);
            pg8::EpiRes E{nullptr, H, 1024, nullptr}; pg8::gemm_phase<pg8::EpiRes, pg8::StaticOrder, true, true>(glds, g, S, E, c.tid);
            SEAM(pb + 7);
        }
        if (INS(pb + 8, 8)) for (int rep_ = 0; rep_ < REP(8); ++rep_) { PHASE_BEGIN
            moe_route(c, p, layer);
            __syncthreads();
            SEAM(pb + 8);
        }
        if (INS(pb + 9, 9)) for (int rep_ = 0; rep_ < REP(9); ++rep_) { PHASE_BEGIN moe_slots2(c, p, layer); __syncthreads(); SEAM(pb + 9); }
        if (INS(pb + 10, 10)) for (int rep_ = 0; rep_ < REP(10); ++rep_) { PHASE_BEGIN
            const int* blk = (const int*)(ws + OFF_CTL + CTL_BLK) + layer * 1024; const int nblk = blk[0];
            pg8::Gemm g{H, (const bf16_t*)(ws + OFF_WMOE), nblk * 256, 1024, 1024, (size_t)1024 * 1024 * 2}; pg8::MoeOrder S{blk + 1, nblk * 4, 4, G, bid, (const int*)(ws + OFF_R + R_TOK)};
            pg8::EpiSwiglu E{(bf16_t*)(ws + OFF_R), 512, (const float*)(ws + OFF_R + R_RSS)}; pg8::gemm_phase<pg8::EpiSwiglu, pg8::MoeOrder, true, true>(glds, g, S, E, c.tid);
            SEAM(pb + 10);
        }
        if (INS(pb + 11, 11)) for (int rep_ = 0; rep_ < REP(11); ++rep_) { PHASE_BEGIN
            const int* blk = (const int*)(ws + OFF_CTL + CTL_BLK) + layer * 1024; const int nblk = blk[0];
            pg8::Gemm g{(const bf16_t*)(ws + OFF_R), (const bf16_t*)(ws + OFF_WMOE + 64 * MiB), nblk * 256, 1024, 512, (size_t)1024 * 512 * 2}; pg8::MoeOrder S{blk + 1, nblk * 4, 4, G, bid, nullptr};
            pg8::EpiB16 E{P, 1024, nullptr}; pg8::gemm_phase<pg8::EpiB16, pg8::MoeOrder, true, true>(glds, g, S, E, c.tid);
            SEAM(pb + 11);
        }
    }
    if (INS(24, 15)) for (int rep_ = 0; rep_ < REP(15); ++rep_) { PHASE_BEGIN
        for (int r0 = c.gw; r0 < T_TOK; r0 += 4 * c.ngw) {
            f32x4 v[4][4]; int2 ps[4]; float2 gt[4];
#pragma unroll
            for (int q = 0; q < 4; ++q) { const int r = r0 + q * c.ngw; ps[q] = RP[r]; gt[q] = RG[r];
#pragma unroll
                for (int j = 0; j < 4; ++j) { const u32x2 w = __builtin_nontemporal_load((const u32x2*)(H + (size_t)r * 1024) + c.lane + 64 * j); v[q][j] = (f32x4){bflo(w.x), bfhi(w.x), bflo(w.y), bfhi(w.y)}; } }
#pragma unroll
            for (int q = 0; q < 4; ++q) row_combine(v[q], P, ps[q].x, ps[q].y, gt[q].x, gt[q].y, c.lane);
#pragma unroll
            for (int q = 0; q < 4; ++q) { const int r = r0 + q * c.ngw; const float rs = row_rstd(v[q]); row_scale(v[q], rs, p.norm_final, c.lane); row_store_f32(p.out + (size_t)r * 1024, c.lane, v[q]); }
        }
    }
}

extern "C" void kernel_launch(void* const* d_in, const int* in_sizes, int n_in, void* d_out, int out_size, void* d_ws, size_t ws_size, hipStream_t stream) {
    static int ready = 0;
    if (ready == 0) {
        if (n_in != 37 || out_size != T_TOK * DM || ws_size < WS_NEED) { fprintf(stderr, "kernel_launch: unexpected problem (n_in %d, out %d, ws %zu)\n", n_in, out_size, ws_size); ready = -1; return; }
        if (hipFuncSetAttribute((const void*)hybrid_fwd, hipFuncAttributeMaxDynamicSharedMemorySize, LDS_BYTES) != hipSuccess) { fprintf(stderr, "kernel_launch: hipFuncSetAttribute failed\n"); ready = -1; return; }
        ready = 1;
    }
    if (ready < 0) return;
    hipMemsetAsync((char*)d_ws + OFF_CTL, 0, CTL_ZERO_BYTES, stream);
    Params p{};
    const float** f = (const float**)&p;
    for (int i = 0; i < 37; ++i) f[i] = (const float*)d_in[i];
    p.out = (float*)d_out; p.ws = (unsigned char*)d_ws; p.ph_lo = 0; p.ph_hi = N_PHASES;
    hipLaunchKernelGGL(hybrid_fwd, dim3(256), dim3(512), LDS_BYTES, stream, p);
}
```
